# Optimizing an MI355X kernel written in HIP

```python
import math
import jax
import jax.numpy as jnp
from jax import lax
import numpy as np


D_MODEL = 2048
BATCH = 2
SEQ = 16384
DEPTH = 2

GRID_W = 64
CTX_LEN = 256
D_MIX = D_MODEL
S5_WIDTH = D_MIX // 4
POOL_WIDTH = D_MIX // 4
RWKV_WIDTH = D_MIX // 2
S5_GROUP = 16
S5_GROUPS = S5_WIDTH // S5_GROUP
S5_STATE = 64
POOL_WINDOWS = (2, 4, 8, 16)
POOL_GROUP = POOL_WIDTH // len(POOL_WINDOWS)
RWKV_HEAD = 64
RWKV_HEADS = RWKV_WIDTH // RWKV_HEAD
RWKV_LORA = 64
RWKV_CONV = 3
N_DIR = 2
IN_SIZES = (S5_WIDTH, S5_WIDTH, POOL_WIDTH, POOL_WIDTH, 3 * RWKV_WIDTH, RWKV_WIDTH, N_DIR * RWKV_LORA, N_DIR * RWKV_LORA)
IN_OFFSETS = tuple(int(s) for s in np.cumsum(IN_SIZES)[:-1])
D_IN = sum(IN_SIZES)
DEEPNORM_ALPHA = (2 * DEPTH) ** 0.25
DEEPNORM_BETA = (8 * DEPTH) ** -0.25
RWKV_DECAY_SCALE = 0.606531
S5_MAX_RE = -1e-4
ADALN_EPS = 1e-6
LN_EPS = 1e-5
GN_EPS = 64e-5
L2_EPS = 1e-12
F32 = jnp.float32

kernel_name = "hybrid_s5_pool_rwkv7_prefix_dit"


def _layernorm(x, eps):
    x = x.astype(F32)
    mu = jnp.mean(x, axis=-1, keepdims=True)
    var = jnp.mean(jnp.square(x - mu), axis=-1, keepdims=True)
    return (x - mu) * lax.rsqrt(var + eps)


def _modulation(cond, w_ada, b_ada):
    m = jax.nn.silu(cond.astype(F32)) @ w_ada + b_ada
    return jnp.split(m, 3, axis=-1)


def _split_in(z):
    return jnp.split(z, IN_OFFSETS, axis=-1)


def _short_conv(z, w):
    n = z.shape[1]
    pad = w.shape[0] // 2
    zp = jnp.pad(z.astype(F32), ((0, 0), (pad, pad), (0, 0)))
    out = zp[:, 0:n] * w[0]
    for i in range(1, w.shape[0]):
        out = out + zp[:, i:i + n] * w[i]
    return out


def _s5_discretize(lam_re, lam_im, log_step):
    lam = lax.complex(jnp.minimum(lam_re.astype(F32), S5_MAX_RE), lam_im.astype(F32))
    step = jnp.exp(log_step.astype(F32))[..., None]
    log_lam_bar = lam * step
    b_scale = (jnp.exp(log_lam_bar) - 1.0) / lam
    return log_lam_bar, b_scale


def _s5_scan(bu, log_lam_bar, x0, reverse):
    n = bu.shape[0]
    first = n - 1 if reverse else 0
    bu = bu.at[first].add(jnp.exp(log_lam_bar) * x0)
    counts = jnp.ones((n, 1, 1, 1), F32)

    def combine(earlier, later):
        n_e, b_e = earlier
        n_l, b_l = later
        return n_e + n_l, jnp.exp(log_lam_bar * n_l) * b_e + b_l

    _, states = lax.associative_scan(combine, (counts, bu), reverse=reverse)
    return states


def _s5_states(u, init_states, log_lam_bar, b_scale, b_re, b_im):
    bsz, n, _ = u.shape
    ug = u.astype(F32).reshape(bsz, n, S5_GROUPS, S5_GROUP)
    bu = lax.complex(jnp.einsum('bngi,gpi->nbgp', ug, b_re.astype(F32)),
                     jnp.einsum('bngi,gpi->nbgp', ug, b_im.astype(F32)))
    return [_s5_scan(b_scale[d] * bu, log_lam_bar[d], init_states[d], reverse=(d == 1)) for d in range(N_DIR)]


def _s5_readout(u, states, c_re, c_im, d_skip, w_glu, b_glu):
    u = u.astype(F32)
    bsz, n, _ = u.shape
    y = d_skip * u
    for d in range(N_DIR):
        y_d = (jnp.einsum('nbgp,gip->bngi', states[d].real, c_re[d])
               - jnp.einsum('nbgp,gip->bngi', states[d].imag, c_im[d]))
        y = y + y_d.reshape(bsz, n, S5_WIDTH)
    y = jax.nn.gelu(y)
    return y * jax.nn.sigmoid(y @ w_glu + b_glu)


def _box_mean(z, w, axis):
    n = z.shape[axis]
    lo_off = w // 2
    idx = jnp.arange(n)
    lo = jnp.clip(idx - lo_off, 0, n - 1)
    hi = jnp.clip(idx - lo_off + w - 1, 0, n - 1)
    cs = jnp.cumsum(z, axis=axis)
    cs = jnp.concatenate([jnp.zeros_like(lax.slice_in_dim(cs, 0, 1, axis=axis)), cs], axis=axis)
    total = jnp.take(cs, hi + 1, axis=axis) - jnp.take(cs, lo, axis=axis)
    shape = [1] * z.ndim
    shape[axis] = n
    cnt = (hi - lo + 1).astype(z.dtype).reshape(shape)
    return total / cnt


def _pool_branch(u, w_pool, pool_scale, on_grid):
    u = u.astype(F32)
    bsz, n, _ = u.shape
    outs = []
    for g, (ug, win) in enumerate(zip(jnp.split(u, len(POOL_WINDOWS), axis=-1), POOL_WINDOWS)):
        if on_grid:
            rows = n // GRID_W
            grid = ug.reshape(bsz, rows, GRID_W, POOL_GROUP)
            m = _box_mean(_box_mean(grid, win, 1), win, 2).reshape(bsz, n, POOL_GROUP)
        else:
            m = _box_mean(ug, win, 1)
        outs.append((m - ug) @ w_pool[g])
    return jnp.concatenate(outs, axis=-1) * pool_scale


def _rwkv_scan(s0, r, w, k, v, kk, kka, reverse, want_out):
    def step(s, inp):
        w_t, k_t, v_t, kk_t, kka_t = inp[:5]
        s_kk = jnp.einsum('bhvk,bhk->bhv', s, kk_t)
        s = (s * w_t[:, :, None, :] - s_kk[..., None] * kka_t[:, :, None, :]
             + v_t[..., None] * k_t[:, :, None, :])
        if want_out:
            return s, jnp.einsum('bhvk,bhk->bhv', s, inp[5])
        return s, None

    xs = (w, k, v, kk, kka) + ((r,) if want_out else ())
    s_fin, o = lax.scan(step, s0, tuple(jnp.moveaxis(t, 1, 0) for t in xs), reverse=reverse)
    return s_fin, (jnp.moveaxis(o, 0, 1) if want_out else None)


def _rwkv_sequence(rkv, w_codes, a_codes, init_states, w0, w2, a0, a2, k_k, k_a, r_k, gn_w, gn_b, want_out):
    bsz, n = rkv.shape[:2]

    def heads(t):
        return t.astype(F32).reshape(bsz, n, RWKV_HEADS, RWKV_HEAD)

    r, k, v = (heads(t) for t in jnp.split(rkv, 3, axis=-1))
    kk = k * k_k.reshape(RWKV_HEADS, RWKV_HEAD)
    kk = kk / jnp.maximum(jnp.sqrt(jnp.sum(jnp.square(kk), axis=-1, keepdims=True)), L2_EPS)
    k_a_h = k_a.reshape(RWKV_HEADS, RWKV_HEAD)
    w_codes = w_codes.astype(F32).reshape(bsz, n, N_DIR, RWKV_LORA)
    a_codes = a_codes.astype(F32).reshape(bsz, n, N_DIR, RWKV_LORA)
    finals = []
    o_sum = 0.0
    k_sum = 0.0
    for d in range(N_DIR):
        w = heads(jnp.exp(-RWKV_DECAY_SCALE * jax.nn.sigmoid(w0[d] + jnp.tanh(w_codes[:, :, d]) @ w2[d])))
        a = heads(jax.nn.sigmoid(a0[d] + a_codes[:, :, d] @ a2[d]))
        k_d = k * (1.0 + (a - 1.0) * k_a_h)
        s_fin, o = _rwkv_scan(init_states[d], r, w, k_d, v, kk, kk * a, reverse=(d == 1), want_out=want_out)
        finals.append(s_fin)
        if want_out:
            o_sum = o_sum + o
            k_sum = k_sum + k_d
    if not want_out:
        return None, finals
    mu = jnp.mean(o_sum, axis=-1, keepdims=True)
    var = jnp.mean(jnp.square(o_sum - mu), axis=-1, keepdims=True)
    on = ((o_sum - mu) * lax.rsqrt(var + GN_EPS)).reshape(bsz, n, RWKV_WIDTH) * gn_w + gn_b
    bonus = jnp.sum(r * k_sum * r_k, axis=-1, keepdims=True) * v
    return on + bonus.reshape(bsz, n, RWKV_WIDTH), finals


def _merge(ys, gates, w_out):
    return jnp.concatenate([y * jax.nn.silu(g.astype(F32)) for y, g in zip(ys, gates)], axis=-1) @ w_out


def _layer(x, xc, c, c_ctx, w_ada, b_ada, w_in, conv_rkv, s5_lam_re, s5_lam_im, s5_log_step,
           s5_b_re, s5_b_im, s5_c_re, s5_c_im, s5_d, w_glu, b_glu, w_pool, pool_scale,
           rwkv_w0, rwkv_w2, rwkv_a0, rwkv_a2, rwkv_k_k, rwkv_k_a, rwkv_r_k, gn_w, gn_b,
           w_out, ln_g, ln_b, ctx_out):
    bsz = x.shape[0]
    shift, scale, gate = _modulation(c, w_ada, b_ada)
    shift_c, scale_c, gate_c = _modulation(c_ctx, w_ada, b_ada)
    h = _layernorm(x, ADALN_EPS) * (1.0 + scale[:, None]) + shift[:, None]
    hc = _layernorm(xc, ADALN_EPS) * (1.0 + scale_c) + shift_c
    s5_u, s5_g, pool_u, pool_g, rkv, rwkv_g, w_codes, a_codes = _split_in(h @ w_in)
    s5_uc, s5_gc, pool_uc, pool_gc, rkv_c, rwkv_gc, w_codes_c, a_codes_c = _split_in(hc @ w_in)

    log_lam_bar, b_scale = _s5_discretize(s5_lam_re, s5_lam_im, s5_log_step)
    zero_s5 = jnp.zeros((bsz, S5_GROUPS, S5_STATE), jnp.complex64)
    st_c = _s5_states(s5_uc, (zero_s5, zero_s5), log_lam_bar, b_scale, s5_b_re, s5_b_im)
    st = _s5_states(s5_u, (st_c[0][-1], st_c[1][0]), log_lam_bar, b_scale, s5_b_re, s5_b_im)
    y_s5 = _s5_readout(s5_u, st, s5_c_re, s5_c_im, s5_d, w_glu, b_glu)

    y_pool = _pool_branch(pool_u, w_pool, pool_scale, on_grid=True)

    rwkv_p = (rwkv_w0, rwkv_w2, rwkv_a0, rwkv_a2, rwkv_k_k, rwkv_k_a, rwkv_r_k, gn_w, gn_b)
    zero_rw = jnp.zeros((bsz, RWKV_HEADS, RWKV_HEAD, RWKV_HEAD), F32)
    y_rwkv_c, fin_c = _rwkv_sequence(_short_conv(rkv_c, conv_rkv), w_codes_c, a_codes_c,
                                     (zero_rw, zero_rw), *rwkv_p, want_out=ctx_out)
    y_rwkv, _ = _rwkv_sequence(_short_conv(rkv, conv_rkv), w_codes, a_codes, fin_c, *rwkv_p, want_out=True)

    out = _merge((y_s5, y_pool, y_rwkv), (s5_g, pool_g, rwkv_g), w_out)
    x_new = _layernorm(DEEPNORM_ALPHA * x + gate[:, None] * out, LN_EPS) * ln_g + ln_b

    xc_new = None
    if ctx_out:
        y_s5_c = _s5_readout(s5_uc, st_c, s5_c_re, s5_c_im, s5_d, w_glu, b_glu)
        y_pool_c = _pool_branch(pool_uc, w_pool, pool_scale, on_grid=False)
        out_c = _merge((y_s5_c, y_pool_c, y_rwkv_c), (s5_gc, pool_gc, rwkv_gc), w_out)
        xc_new = _layernorm(DEEPNORM_ALPHA * xc + gate_c * out_c, LN_EPS) * ln_g + ln_b
    return x_new, xc_new


def setup_inputs(seed: int = 0) -> dict:
    key = jax.random.key(seed)
    ks = iter(jax.random.split(key, 40))
    L = DEPTH

    def nrm(shape, s):
        return jax.random.normal(next(ks), shape, F32) * s

    x = nrm((BATCH, SEQ, D_MODEL), 1.0)
    c = nrm((BATCH, D_MODEL), 1.0)
    ctx = nrm((BATCH, CTX_LEN, D_MODEL), 1.0)
    c_ctx = nrm((D_MODEL,), 1.0)
    w_ada = nrm((L, D_MODEL, 3 * D_MODEL), 0.5 * D_MODEL ** -0.5)
    b_ada = nrm((L, 3 * D_MODEL), 0.02)
    w_in = nrm((L, D_MODEL, D_IN), D_MODEL ** -0.5)
    conv_rkv = jnp.array([0.25, 0.5, 0.25], F32)[:, None] + nrm((L, RWKV_CONV, 3 * RWKV_WIDTH), 0.1)
    s5_lam_re = -0.5 + nrm((L, N_DIR, S5_GROUPS, S5_STATE), 0.01)
    s5_lam_im = jnp.pi * jnp.arange(S5_STATE, dtype=F32) + nrm((L, N_DIR, S5_GROUPS, S5_STATE), 0.01)
    s5_log_step = jax.random.uniform(next(ks), (L, N_DIR, S5_GROUPS), F32, math.log(1e-3), math.log(1e-1))
    s5_b_re = nrm((L, S5_GROUPS, S5_STATE, S5_GROUP), (2 * S5_GROUP) ** -0.5)
    s5_b_im = nrm((L, S5_GROUPS, S5_STATE, S5_GROUP), (2 * S5_GROUP) ** -0.5)
    s5_c_re = nrm((L, N_DIR, S5_GROUPS, S5_GROUP, S5_STATE), S5_STATE ** -0.5)
    s5_c_im = nrm((L, N_DIR, S5_GROUPS, S5_GROUP, S5_STATE), S5_STATE ** -0.5)
    s5_d = nrm((L, S5_WIDTH), 1.0)
    w_glu = nrm((L, S5_WIDTH, S5_WIDTH), S5_WIDTH ** -0.5)
    b_glu = nrm((L, S5_WIDTH), 0.02)
    w_pool = nrm((L, len(POOL_WINDOWS), POOL_GROUP, POOL_GROUP), POOL_GROUP ** -0.5)
    pool_scale = 1.0 + nrm((L, POOL_WIDTH), 0.1)
    rwkv_w0 = -0.5 + nrm((L, N_DIR, RWKV_WIDTH), 0.5)
    rwkv_w2 = nrm((L, N_DIR, RWKV_LORA, RWKV_WIDTH), 0.1)
    rwkv_a0 = nrm((L, N_DIR, RWKV_WIDTH), 0.1)
    rwkv_a2 = nrm((L, N_DIR, RWKV_LORA, RWKV_WIDTH), 0.1)
    rwkv_k_k = 0.85 + nrm((L, RWKV_WIDTH), 0.02)
    rwkv_k_a = 1.0 + nrm((L, RWKV_WIDTH), 0.02)
    rwkv_r_k = nrm((L, RWKV_HEADS, RWKV_HEAD), 0.1)
    gn_w = 1.0 + nrm((L, RWKV_WIDTH), 0.02)
    gn_b = nrm((L, RWKV_WIDTH), 0.02)
    w_out = nrm((L, D_MIX, D_MODEL), DEEPNORM_BETA * D_MIX ** -0.5)
    ln_g = 1.0 + nrm((L, D_MODEL), 0.02)
    ln_b = nrm((L, D_MODEL), 0.02)
    return {"x": x, "c": c, "ctx": ctx, "c_ctx": c_ctx, "w_ada": w_ada, "b_ada": b_ada,
            "w_in": w_in, "conv_rkv": conv_rkv, "s5_lam_re": s5_lam_re, "s5_lam_im": s5_lam_im,
            "s5_log_step": s5_log_step, "s5_b_re": s5_b_re, "s5_b_im": s5_b_im,
            "s5_c_re": s5_c_re, "s5_c_im": s5_c_im, "s5_d": s5_d, "w_glu": w_glu, "b_glu": b_glu,
            "w_pool": w_pool, "pool_scale": pool_scale, "rwkv_w0": rwkv_w0, "rwkv_w2": rwkv_w2,
            "rwkv_a0": rwkv_a0, "rwkv_a2": rwkv_a2, "rwkv_k_k": rwkv_k_k, "rwkv_k_a": rwkv_k_a,
            "rwkv_r_k": rwkv_r_k, "gn_w": gn_w, "gn_b": gn_b, "w_out": w_out,
            "ln_g": ln_g, "ln_b": ln_b}


def reference(x, c, ctx, c_ctx, w_ada, b_ada, w_in, conv_rkv, s5_lam_re, s5_lam_im, s5_log_step,
              s5_b_re, s5_b_im, s5_c_re, s5_c_im, s5_d, w_glu, b_glu, w_pool, pool_scale,
              rwkv_w0, rwkv_w2, rwkv_a0, rwkv_a2, rwkv_k_k, rwkv_k_a, rwkv_r_k, gn_w, gn_b,
              w_out, ln_g, ln_b):
    xc = ctx
    for l in range(DEPTH):
        x, xc = _layer(x, xc, c, c_ctx, w_ada[l], b_ada[l], w_in[l], conv_rkv[l],
                       s5_lam_re[l], s5_lam_im[l], s5_log_step[l], s5_b_re[l], s5_b_im[l],
                       s5_c_re[l], s5_c_im[l], s5_d[l], w_glu[l], b_glu[l], w_pool[l], pool_scale[l],
                       rwkv_w0[l], rwkv_w2[l], rwkv_a0[l], rwkv_a2[l], rwkv_k_k[l], rwkv_k_a[l],
                       rwkv_r_k[l], gn_w[l], gn_b[l], w_out[l], ln_g[l], ln_b[l],
                       ctx_out=(l < DEPTH - 1))
    return x
```

```cpp
#include <hip/hip_runtime.h>
#include <hip/hip_cooperative_groups.h>
#include <cstdio>
namespace cg = cooperative_groups;

typedef unsigned short bf16_t;
typedef _Float16 h16;
using bf16x8 = __attribute__((ext_vector_type(8))) short;
using f32x4 = __attribute__((ext_vector_type(4))) float;
using h16x4 = __attribute__((ext_vector_type(4))) _Float16;
using h16x8 = __attribute__((ext_vector_type(8))) _Float16;

#define DEV __device__ __forceinline__

constexpr int D = 2048, NLAT = 32768, MTOT = 33280, ZR = 3072, ZC = 3328;
constexpr int NTHREADS = 512;
constexpr int LDS_BYTES = 147456;
constexpr float ALPHA = 1.41421356237f;
constexpr float DECAY_SCALE = 0.606531f;

constexpr size_t al256(size_t x) { return (x + 255) & ~size_t(255); }
constexpr size_t ARR = (size_t)MTOT * 1024;
constexpr size_t OFF_MODS = 0;
constexpr size_t OFF_S5F = al256(OFF_MODS + 2 * 3 * 6144 * 4);
constexpr size_t OFF_PREC = al256(OFF_S5F + (size_t)2 * 32 * 65 * 2 * 64 * 8);
constexpr size_t OFF_WT = al256(OFF_PREC + (size_t)512 * 2048 * 4);
constexpr size_t WT_IN = 0, WT_OUT = 26214400, WT_W2 = 34603008, WT_A2 = 34865152, WT_POOL = 35127296, WT_GLU = 35258368, WT_SIZE = 35782656;
constexpr size_t OFF_ZREST = al256(OFF_WT + 2 * WT_SIZE);
constexpr size_t OFF_REG2 = al256(OFF_ZREST + (size_t)MTOT * ZR * 2);
constexpr size_t OFF_S5Y = OFF_REG2 + 2 * ARR * 2;
constexpr size_t OFF_SCAN = al256(OFF_REG2 + (size_t)MTOT * ZC * 2);
constexpr size_t OFF_H = OFF_SCAN;
constexpr size_t OFF_YM = OFF_SCAN + 6 * ARR * 2;
constexpr size_t WS_END = OFF_SCAN + 8 * ARR * 2;

struct Params {
  const float *x, *c, *ctx, *c_ctx, *w_ada, *b_ada, *w_in, *conv_rkv, *s5_lam_re, *s5_lam_im, *s5_log_step,
      *s5_b_re, *s5_b_im, *s5_c_re, *s5_c_im, *s5_d, *w_glu, *b_glu, *w_pool, *pool_scale,
      *rwkv_w0, *rwkv_w2, *rwkv_a0, *rwkv_a2, *rwkv_k_k, *rwkv_k_a, *rwkv_r_k, *gn_w, *gn_b,
      *w_out, *ln_g, *ln_b;
  float* out;
  char* ws;
};
struct Ctx { int tid, bid, nblk; };

DEV float sigmoid_f(float x) { return 1.f / (1.f + __expf(-x)); }
DEV float silu_f(float x) { return x / (1.f + __expf(-x)); }
DEV float tanh_f(float x) { float e = __expf(2.f * x); return 1.f - 2.f / (e + 1.f); }
DEV float gelu_f(float y) { return 0.5f * y * (1.f + tanh_f(0.7978845608f * (y + 0.044715f * y * y * y))); }
DEV unsigned f2bf(float f) { unsigned u = __float_as_uint(f); return (u + 0x7fffu + ((u >> 16) & 1u)) >> 16; }
DEV unsigned pack_bf2(float a, float b) { return f2bf(a) | (f2bf(b) << 16); }
DEV float bf_hi(float f) { return __uint_as_float(f2bf(f) << 16); }
template <int CTRL> DEV float dpp_mov(float v) {
  return __int_as_float(__builtin_amdgcn_update_dpp(0, __float_as_int(v), CTRL, 0xf, 0xf, true));
}
DEV float allreduce16(float v) {
  v += dpp_mov<0xB1>(v);
  v += dpp_mov<0x4E>(v);
  v += dpp_mov<0x141>(v);
  v += dpp_mov<0x140>(v);
  return v;
}
DEV float wave_sum(float v) {
  v = allreduce16(v);
  return __builtin_amdgcn_readlane(__float_as_int(v), 0) == 0 && false ? 0.f :
         __int_as_float(__builtin_amdgcn_readlane(__float_as_int(v), 0)) + __int_as_float(__builtin_amdgcn_readlane(__float_as_int(v), 16)) +
         __int_as_float(__builtin_amdgcn_readlane(__float_as_int(v), 32)) + __int_as_float(__builtin_amdgcn_readlane(__float_as_int(v), 48));
}
DEV float allreduce8(float v) {
  v += dpp_mov<0xB1>(v);
  v += dpp_mov<0x4E>(v);
  v += dpp_mov<0x141>(v);
  return v;
}
DEV void lds_fence() { asm volatile("s_waitcnt lgkmcnt(0)" ::: "memory"); }

DEV void p0_mods_item(const Params& p, const Ctx& cx, int item, char* smem) {
  float* red = (float*)smem;
  float* mods = (float*)(p.ws + OFF_MODS);
  int l = item / 96, chunk = item % 96;
  int tid = cx.tid, kq = tid >> 6, col = tid & 63;
  int n = chunk * 64 + col;
  const float* W = p.w_ada + (size_t)l * 2048 * 6144;
  float a0 = 0, a1 = 0, a2 = 0;
#pragma unroll 8
  for (int k = kq; k < 2048; k += 8) {
    float w = W[(size_t)k * 6144 + n];
    a0 += silu_f(p.c[k]) * w;
    a1 += silu_f(p.c[2048 + k]) * w;
    a2 += silu_f(p.c_ctx[k]) * w;
  }
  red[(kq * 3 + 0) * 64 + col] = a0;
  red[(kq * 3 + 1) * 64 + col] = a1;
  red[(kq * 3 + 2) * 64 + col] = a2;
  __syncthreads();
  if (tid < 192) {
    int r = tid >> 6, cc = tid & 63;
    float s = 0;
#pragma unroll
    for (int q = 0; q < 8; ++q) s += red[(q * 3 + r) * 64 + cc];
    mods[(size_t)(l * 3 + r) * 6144 + chunk * 64 + cc] = s + p.b_ada[(size_t)l * 6144 + chunk * 64 + cc];
  }
}

DEV void p0_transpose_tile(const Params& p, const Ctx& cx, const float* __restrict__ src, bf16_t* __restrict__ dst, int K, int N, int tk, int tn, char* smem) {
  float* T = (float*)smem;
  int tid = cx.tid;
  int k0 = tk * 64, n0 = tn * 64;
  int kk = tid >> 4, n4 = tid & 15;
#pragma unroll
  for (int i = 0; i < 2; ++i) {
    int k = kk + 32 * i;
    float4 v = *(const float4*)(src + (size_t)(k0 + k) * N + n0 + n4 * 4);
    T[k * 65 + n4 * 4 + 0] = v.x; T[k * 65 + n4 * 4 + 1] = v.y; T[k * 65 + n4 * 4 + 2] = v.z; T[k * 65 + n4 * 4 + 3] = v.w;
  }
  __syncthreads();
  int n = tid >> 3, k8 = tid & 7;
  uint4 o;
  o.x = pack_bf2(T[(k8 * 8 + 0) * 65 + n], T[(k8 * 8 + 1) * 65 + n]);
  o.y = pack_bf2(T[(k8 * 8 + 2) * 65 + n], T[(k8 * 8 + 3) * 65 + n]);
  o.z = pack_bf2(T[(k8 * 8 + 4) * 65 + n], T[(k8 * 8 + 5) * 65 + n]);
  o.w = pack_bf2(T[(k8 * 8 + 6) * 65 + n], T[(k8 * 8 + 7) * 65 + n]);
  *(uint4*)(dst + (size_t)(n0 + n) * K + k0 + k8 * 8) = o;
}

DEV void phase0(const Params& p, const Ctx& cx, char* smem) {
  const int NTR = 4368;
  const int total = 192 + 2 * NTR;
  for (int item = cx.bid; item < total; item += cx.nblk) {
    __syncthreads();
    if (item < 192) { p0_mods_item(p, cx, item, smem); continue; }
    int it = item - 192;
    int l = it / NTR, i = it % NTR;
    char* wt = p.ws + OFF_WT + (size_t)l * WT_SIZE;
    if (i < 3200) {
      p0_transpose_tile(p, cx, p.w_in + (size_t)l * 2048 * 6400, (bf16_t*)(wt + WT_IN), 2048, 6400, i / 100, i % 100, smem);
    } else if (i < 4224) {
      int j = i - 3200;
      p0_transpose_tile(p, cx, p.w_out + (size_t)l * 2048 * 2048, (bf16_t*)(wt + WT_OUT), 2048, 2048, j / 32, j % 32, smem);
    } else if (i < 4256) {
      int j = i - 4224, d = j / 16;
      p0_transpose_tile(p, cx, p.rwkv_w2 + (size_t)(l * 2 + d) * 64 * 1024, (bf16_t*)(wt + WT_W2) + (size_t)d * 1024 * 64, 64, 1024, 0, j % 16, smem);
    } else if (i < 4288) {
      int j = i - 4256, d = j / 16;
      p0_transpose_tile(p, cx, p.rwkv_a2 + (size_t)(l * 2 + d) * 64 * 1024, (bf16_t*)(wt + WT_A2) + (size_t)d * 1024 * 64, 64, 1024, 0, j % 16, smem);
    } else if (i < 4304) {
      int j = i - 4288, g = j / 4;
      p0_transpose_tile(p, cx, p.w_pool + (size_t)(l * 4 + g) * 128 * 128, (bf16_t*)(wt + WT_POOL) + (size_t)g * 128 * 128, 128, 128, (j % 4) / 2, j % 2, smem);
    } else {
      int j = i - 4304;
      p0_transpose_tile(p, cx, p.w_glu + (size_t)l * 512 * 512, (bf16_t*)(wt + WT_GLU), 512, 512, j / 8, j % 8, smem);
    }
  }
}

DEV void phase_adaln0(const Params& p, const Ctx& cx) {
  const float* mods = (const float*)(p.ws + OFF_MODS);
  bf16_t* hbuf = (bf16_t*)(p.ws + OFF_H);
  int lane = cx.tid & 63;
  int gw = cx.bid * 8 + (cx.tid >> 6), nw = cx.nblk * 8;
  for (int row = gw; row < MTOT; row += nw) {
    const float* src = row < NLAT ? p.x + (size_t)row * D : p.ctx + (size_t)(row - NLAT) * D;
    int mr = row < NLAT ? (row >> 14) : 2;
    const float* md = mods + (size_t)mr * 6144;
    float4 v[8];
    float s = 0;
#pragma unroll
    for (int i = 0; i < 8; ++i) { v[i] = *(const float4*)(src + i * 256 + lane * 4); s += v[i].x + v[i].y + v[i].z + v[i].w; }
    float mu = wave_sum(s) * (1.f / 2048.f);
    float q = 0;
#pragma unroll
    for (int i = 0; i < 8; ++i) { v[i].x -= mu; v[i].y -= mu; v[i].z -= mu; v[i].w -= mu; q += v[i].x * v[i].x + v[i].y * v[i].y + v[i].z * v[i].z + v[i].w * v[i].w; }
    float rstd = rsqrtf(wave_sum(q) * (1.f / 2048.f) + 1e-6f);
#pragma unroll
    for (int i = 0; i < 8; ++i) {
      int col = i * 256 + lane * 4;
      float4 sh = *(const float4*)(md + col), sc = *(const float4*)(md + 2048 + col);
      uint2 o;
      o.x = pack_bf2(v[i].x * rstd * (1.f + sc.x) + sh.x, v[i].y * rstd * (1.f + sc.y) + sh.y);
      o.y = pack_bf2(v[i].z * rstd * (1.f + sc.z) + sh.z, v[i].w * rstd * (1.f + sc.w) + sh.w);
      *(uint2*)(hbuf + (size_t)row * D + col) = o;
    }
  }
}

DEV void phase_finln(const Params& p, const Ctx& cx, int l) {
  const float* mods = (const float*)(p.ws + OFF_MODS);
  bf16_t* hbuf = (bf16_t*)(p.ws + OFF_H);
  float* prec = (float*)(p.ws + OFF_PREC);
  int lane = cx.tid & 63;
  int gw = cx.bid * 8 + (cx.tid >> 6), nw = cx.nblk * 8;
  const int nrows = (l == 0) ? MTOT : NLAT;
  for (int row = gw; row < nrows; row += nw) {
    float* src = row < NLAT ? p.out + (size_t)row * D : prec + (size_t)(row - NLAT) * D;
    float4 v[8];
    float s = 0;
#pragma unroll
    for (int i = 0; i < 8; ++i) { v[i] = *(const float4*)(src + i * 256 + lane * 4); s += v[i].x + v[i].y + v[i].z + v[i].w; }
    float mu = wave_sum(s) * (1.f / 2048.f);
    float q = 0;
#pragma unroll
    for (int i = 0; i < 8; ++i) { v[i].x -= mu; v[i].y -= mu; v[i].z -= mu; v[i].w -= mu; q += v[i].x * v[i].x + v[i].y * v[i].y + v[i].z * v[i].z + v[i].w * v[i].w; }
    float rstd = rsqrtf(wave_sum(q) * (1.f / 2048.f) + 1e-5f);
    float s2 = 0;
#pragma unroll
    for (int i = 0; i < 8; ++i) {
      int col = i * 256 + lane * 4;
      float4 g = *(const float4*)(p.ln_g + (size_t)l * D + col), b = *(const float4*)(p.ln_b + (size_t)l * D + col);
      v[i].x = v[i].x * rstd * g.x + b.x; v[i].y = v[i].y * rstd * g.y + b.y; v[i].z = v[i].z * rstd * g.z + b.z; v[i].w = v[i].w * rstd * g.w + b.w;
      if (row < NLAT) *(float4*)(src + col) = v[i];
      s2 += v[i].x + v[i].y + v[i].z + v[i].w;
    }
    if (l == 0) {
      int mr = row < NLAT ? (row >> 14) : 2;
      const float* md = mods + (size_t)(3 + mr) * 6144;
      float mu2 = wave_sum(s2) * (1.f / 2048.f);
      float q2 = 0;
#pragma unroll
      for (int i = 0; i < 8; ++i) { v[i].x -= mu2; v[i].y -= mu2; v[i].z -= mu2; v[i].w -= mu2; q2 += v[i].x * v[i].x + v[i].y * v[i].y + v[i].z * v[i].z + v[i].w * v[i].w; }
      float rstd2 = rsqrtf(wave_sum(q2) * (1.f / 2048.f) + 1e-6f);
#pragma unroll
      for (int i = 0; i < 8; ++i) {
        int col = i * 256 + lane * 4;
        float4 sh = *(const float4*)(md + col), sc = *(const float4*)(md + 2048 + col);
        uint2 o;
        o.x = pack_bf2(v[i].x * rstd2 * (1.f + sc.x) + sh.x, v[i].y * rstd2 * (1.f + sc.y) + sh.y);
        o.y = pack_bf2(v[i].z * rstd2 * (1.f + sc.z) + sh.z, v[i].w * rstd2 * (1.f + sc.w) + sh.w);
        *(uint2*)(hbuf + (size_t)row * D + col) = o;
      }
    }
  }
}

template <class Epi>
DEV void gemm_phase(const Params& p, const Ctx& cx, const bf16_t* __restrict__ A, const bf16_t* __restrict__ Bt, int K, int nM, int nN, char* smem, Epi epi) {
  const int tid = cx.tid, lane = tid & 63, wid = tid >> 6;
  const int wr = wid >> 2, wc = wid & 3, fr = lane & 15, fq = lane >> 4;
  const int nt = K / 64;
  const int ntiles = nM * nN;
  const int srow = tid >> 3, sc16 = tid & 7;
  for (int tile = cx.bid; tile < ntiles; tile += cx.nblk) {
    const int pm = tile / nN, pn = tile % nN;
    const int brow = pm * 256, bcol = pn * 256;
    const char* Ab = (const char*)(A + (size_t)brow * K);
    const char* Bb = (const char*)(Bt + (size_t)bcol * K);
    const unsigned voff = (unsigned)(srow * K + sc16 * 8) * 2u;
    const size_t rs = (size_t)64 * K * 2;
    f32x4 acc[8][4];
#pragma unroll
    for (int i = 0; i < 8; ++i)
#pragma unroll
      for (int j = 0; j < 4; ++j) acc[i][j] = f32x4{0.f, 0.f, 0.f, 0.f};
    uint4 ra0, ra1, ra2, ra3, rb0, rb1, rb2, rb3;
#define G_LD(ko) { const char* a_ = Ab + (size_t)(ko) * 2; const char* b_ = Bb + (size_t)(ko) * 2; \
                 ra0 = *(const uint4*)(a_ + voff); ra1 = *(const uint4*)(a_ + rs + voff); ra2 = *(const uint4*)(a_ + 2 * rs + voff); ra3 = *(const uint4*)(a_ + 3 * rs + voff); \
                 rb0 = *(const uint4*)(b_ + voff); rb1 = *(const uint4*)(b_ + rs + voff); rb2 = *(const uint4*)(b_ + 2 * rs + voff); rb3 = *(const uint4*)(b_ + 3 * rs + voff); }
#define G_ST(sp) { *(uint4*)(sp) = ra0; *(uint4*)((sp) + 64 * 144) = ra1; *(uint4*)((sp) + 128 * 144) = ra2; *(uint4*)((sp) + 192 * 144) = ra3; \
                 *(uint4*)((sp) + 36864) = rb0; *(uint4*)((sp) + 36864 + 64 * 144) = rb1; *(uint4*)((sp) + 36864 + 128 * 144) = rb2; *(uint4*)((sp) + 36864 + 192 * 144) = rb3; }
    char* const sbase = smem + srow * 144 + sc16 * 16;
    G_LD(0);
    G_ST(sbase);
    if (nt > 1) G_LD(64);
    for (int kt = 0; kt < nt; ++kt) {
      __syncthreads();
      if (kt + 1 < nt) { char* s1 = sbase + ((kt + 1) & 1) * 73728; G_ST(s1); }
      if (kt + 2 < nt) G_LD((kt + 2) * 64);
      const char* As = smem + (kt & 1) * 73728;
      const char* Bs = As + 36864;
#pragma unroll
      for (int kh = 0; kh < 2; ++kh) {
        bf16x8 bfr[4];
#pragma unroll
        for (int jn = 0; jn < 4; ++jn) bfr[jn] = *(const bf16x8*)(Bs + (wc * 64 + jn * 16 + fr) * 144 + kh * 64 + fq * 16);
#pragma unroll
        for (int i = 0; i < 8; ++i) {
          bf16x8 af = *(const bf16x8*)(As + (wr * 128 + i * 16 + fr) * 144 + kh * 64 + fq * 16);
#pragma unroll
          for (int jn = 0; jn < 4; ++jn) acc[i][jn] = __builtin_amdgcn_mfma_f32_16x16x32_bf16(bfr[jn], af, acc[i][jn], 0, 0, 0);
        }
      }
    }
    __syncthreads();
#pragma unroll
    for (int i = 0; i < 8; ++i)
#pragma unroll
      for (int jn = 0; jn < 4; ++jn) epi(brow + wr * 128 + i * 16 + fr, bcol + wc * 64 + jn * 16 + fq * 4, acc[i][jn]);
  }
}

template <int K, int NT, class Epi>
DEV void small_gemm(const Params& p, const Ctx& cx, const char* As, int astride, const bf16_t* __restrict__ Bt, int n0, Epi epi) {
  const int lane = cx.tid & 63, fr = lane & 15, fq = lane >> 4;
  f32x4 acc[4][NT];
#pragma unroll
  for (int i = 0; i < 4; ++i)
#pragma unroll
    for (int j = 0; j < NT; ++j) acc[i][j] = f32x4{0.f, 0.f, 0.f, 0.f};
#pragma unroll 2
  for (int k0 = 0; k0 < K; k0 += 32) {
    bf16x8 af[4];
#pragma unroll
    for (int i = 0; i < 4; ++i) af[i] = *(const bf16x8*)(As + (i * 16 + fr) * astride + (k0 + fq * 8) * 2);
#pragma unroll
    for (int jn = 0; jn < NT; ++jn) {
      bf16x8 bf = *(const bf16x8*)(Bt + (size_t)(n0 + jn * 16 + fr) * K + k0 + fq * 8);
#pragma unroll
      for (int i = 0; i < 4; ++i) acc[i][jn] = __builtin_amdgcn_mfma_f32_16x16x32_bf16(bf, af[i], acc[i][jn], 0, 0, 0);
    }
  }
#pragma unroll
  for (int i = 0; i < 4; ++i)
#pragma unroll
    for (int jn = 0; jn < NT; ++jn) epi(i * 16 + fr, n0 + jn * 16 + fq * 4, acc[i][jn]);
}

struct S5P { float ar, ai, br, bi; };
DEV S5P s5_params(const Params& p, const Ctx& cx, int l, int d, int g, int lane) {
  int idx = ((l * 2 + d) * 32 + g) * 64 + lane;
  float lr = fminf(p.s5_lam_re[idx], -1e-4f), li = p.s5_lam_im[idx];
  float step = expf(p.s5_log_step[(l * 2 + d) * 32 + g]);
  float xr = lr * step, xi = li * step;
  float e = expf(xr), cs = cosf(xi), sn = sinf(xi);
  S5P r;
  r.ar = e * cs; r.ai = e * sn;
  float sh = sinf(0.5f * xi);
  float nr = expm1f(xr) * cs - 2.f * sh * sh, ni = e * sn;
  float inv = 1.f / (lr * lr + li * li);
  r.br = (nr * lr + ni * li) * inv;
  r.bi = (ni * lr - nr * li) * inv;
  return r;
}

DEV void s5_load_u(const h16* zrest, int rowbase, int g, char* ulds, int lane) {
#pragma unroll
  for (int i = 0; i < 8; ++i) {
    int e = i * 64 + lane;
    int r = e >> 1, hf = e & 1;
    uint4 v = *(const uint4*)(zrest + (size_t)(rowbase + r) * ZR + g * 16 + hf * 8);
    *(uint4*)(ulds + r * 32 + hf * 16) = v;
  }
  lds_fence();
}

DEV int s5_rowbase(int b, int c) { return c == 0 ? NLAT + b * 256 : b * 16384 + (c - 1) * 256; }

DEV void s5_pass1_unit(const Params& p, const Ctx& cx, int l, int unit, char* wl, int lane) {
  int c = unit % 65, bg = unit / 65, g = bg & 31, b = bg >> 5;
  const h16* zrest = (const h16*)(p.ws + OFF_ZREST);
  float2* F = (float2*)(p.ws + OFF_S5F);
  s5_load_u(zrest, s5_rowbase(b, c), g, wl, lane);
  float Br[16], Bi[16];
  {
    const float* pr = p.s5_b_re + ((size_t)(l * 32 + g) * 64 + lane) * 16;
    const float* pi = p.s5_b_im + ((size_t)(l * 32 + g) * 64 + lane) * 16;
#pragma unroll
    for (int i = 0; i < 16; i += 4) {
      float4 a = *(const float4*)(pr + i), bq = *(const float4*)(pi + i);
      Br[i] = a.x; Br[i + 1] = a.y; Br[i + 2] = a.z; Br[i + 3] = a.w;
      Bi[i] = bq.x; Bi[i + 1] = bq.y; Bi[i + 2] = bq.z; Bi[i + 3] = bq.w;
    }
  }
  S5P pf = s5_params(p, cx, l, 0, g, lane), pb = s5_params(p, cx, l, 1, g, lane);
  float xr = 0, xi = 0, yr = 0, yi = 0, pwr = 1.f, pwi = 0.f;
#pragma unroll 4
  for (int t = 0; t < 256; ++t) {
    h16x8 u0 = *(const h16x8*)(wl + t * 32), u1 = *(const h16x8*)(wl + t * 32 + 16);
    float br = 0, bi = 0;
#pragma unroll
    for (int i = 0; i < 8; ++i) { float u = (float)u0[i]; br = fmaf(u, Br[i], br); bi = fmaf(u, Bi[i], bi); }
#pragma unroll
    for (int i = 0; i < 8; ++i) { float u = (float)u1[i]; br = fmaf(u, Br[8 + i], br); bi = fmaf(u, Bi[8 + i], bi); }
    float vr = pf.br * br - pf.bi * bi, vi = pf.br * bi + pf.bi * br;
    float nxr = pf.ar * xr - pf.ai * xi + vr, nxi = pf.ar * xi + pf.ai * xr + vi;
    xr = nxr; xi = nxi;
    float wr_ = pb.br * br - pb.bi * bi, wi_ = pb.br * bi + pb.bi * br;
    yr += pwr * wr_ - pwi * wi_; yi += pwr * wi_ + pwi * wr_;
    float npr = pwr * pb.ar - pwi * pb.ai, npi = pwr * pb.ai + pwi * pb.ar;
    pwr = npr; pwi = npi;
  }
  size_t fi = (((size_t)(b * 32 + g) * 65 + c) * 2) * 64 + lane;
  F[fi] = make_float2(xr, xi);
  F[fi + 64] = make_float2(yr, yi);
}

DEV void s5_pass3_unit(const Params& p, const Ctx& cx, int l, int unit, char* wl, int lane) {
  int c = unit % 65, bg = unit / 65, g = bg & 31, b = bg >> 5;
  const int fr = lane & 15, fq = lane >> 4;
  const h16* zrest = (const h16*)(p.ws + OFF_ZREST);
  const float2* F = (const float2*)(p.ws + OFF_S5F);
  float* S5Y = (float*)(p.ws + OFF_S5Y);
  const int rowbase = s5_rowbase(b, c);
  char* ulds = wl;
  char* tile = wl + 8192;
  s5_load_u(zrest, rowbase, g, ulds, lane);
  float Br[16], Bi[16];
  {
    const float* pr = p.s5_b_re + ((size_t)(l * 32 + g) * 64 + lane) * 16;
    const float* pi = p.s5_b_im + ((size_t)(l * 32 + g) * 64 + lane) * 16;
#pragma unroll
    for (int i = 0; i < 16; i += 4) {
      float4 a = *(const float4*)(pr + i), bq = *(const float4*)(pi + i);
      Br[i] = a.x; Br[i + 1] = a.y; Br[i + 2] = a.z; Br[i + 3] = a.w;
      Bi[i] = bq.x; Bi[i + 1] = bq.y; Bi[i + 2] = bq.z; Bi[i + 3] = bq.w;
    }
  }
  const float dsk = p.s5_d[(size_t)l * 512 + g * 16 + fr];
  const size_t fbase = ((size_t)(b * 32 + g) * 65) * 2 * 64 + lane;
#pragma unroll 1
  for (int d = 0; d < 2; ++d) {
    S5P pp = s5_params(p, cx, l, d, g, lane);
    float qr = pp.ar, qi = pp.ai;
#pragma unroll
    for (int i = 0; i < 8; ++i) { float t = qr * qr - qi * qi; qi = 2.f * qr * qi; qr = t; }
    float xr = 0, xi = 0;
    if (d == 0) {
      for (int cc = 0; cc < c; ++cc) {
        float2 f = F[fbase + (size_t)(cc * 2 + 0) * 64];
        float t = qr * xr - qi * xi + f.x; xi = qr * xi + qi * xr + f.y; xr = t;
      }
    } else if (c > 0) {
      float2 f0 = F[fbase + (size_t)(0 * 2 + 1) * 64];
      xr = f0.x; xi = f0.y;
      for (int cc = 64; cc > c; --cc) {
        float2 f = F[fbase + (size_t)(cc * 2 + 1) * 64];
        float t = qr * xr - qi * xi + f.x; xi = qr * xi + qi * xr + f.y; xr = t;
      }
    }
    bf16x8 chi[4], clo[4];
    {
      const float* cr = p.s5_c_re + ((size_t)((l * 2 + d) * 32 + g) * 16 + fr) * 64;
      const float* ci = p.s5_c_im + ((size_t)((l * 2 + d) * 32 + g) * 16 + fr) * 64;
#pragma unroll
      for (int ks = 0; ks < 4; ++ks) {
        float4 a = *(const float4*)(cr + ks * 16 + fq * 4), bq = *(const float4*)(ci + ks * 16 + fq * 4);
        float vals[8] = {a.x, -bq.x, a.y, -bq.y, a.z, -bq.z, a.w, -bq.w};
#pragma unroll
        for (int j = 0; j < 8; ++j) {
          unsigned hb = f2bf(vals[j]);
          float hv = __uint_as_float(hb << 16);
          chi[ks][j] = (short)hb;
          clo[ks][j] = (short)f2bf(vals[j] - hv);
        }
      }
    }
#pragma unroll 1
    for (int sb = 0; sb < 16; ++sb) {
      const int sub = d == 0 ? sb : 15 - sb;
#pragma unroll 4
      for (int q = 0; q < 16; ++q) {
        const int tt = d == 0 ? q : 15 - q;
        const int t = sub * 16 + tt;
        h16x8 u0 = *(const h16x8*)(ulds + t * 32), u1 = *(const h16x8*)(ulds + t * 32 + 16);
        float br = 0, bi = 0;
#pragma unroll
        for (int i = 0; i < 8; ++i) { float u = (float)u0[i]; br = fmaf(u, Br[i], br); bi = fmaf(u, Bi[i], bi); }
#pragma unroll
        for (int i = 0; i < 8; ++i) { float u = (float)u1[i]; br = fmaf(u, Br[8 + i], br); bi = fmaf(u, Bi[8 + i], bi); }
        float vr = pp.br * br - pp.bi * bi, vi = pp.br * bi + pp.bi * br;
        float nxr = pp.ar * xr - pp.ai * xi + vr, nxi = pp.ar * xi + pp.ai * xr + vi;
        xr = nxr; xi = nxi;
        unsigned hr = f2bf(xr), hi_ = f2bf(xi);
        float lr_ = xr - __uint_as_float(hr << 16), li_ = xi - __uint_as_float(hi_ << 16);
        *(unsigned*)(tile + tt * 272 + lane * 4) = hr | (hi_ << 16);
        *(unsigned*)(tile + 4352 + tt * 272 + lane * 4) = pack_bf2(lr_, li_);
      }
      lds_fence();
      f32x4 acc = f32x4{0.f, 0.f, 0.f, 0.f};
#pragma unroll
      for (int ks = 0; ks < 4; ++ks) {
        bf16x8 ah = *(const bf16x8*)(tile + fr * 272 + ks * 64 + fq * 16);
        bf16x8 alo = *(const bf16x8*)(tile + 4352 + fr * 272 + ks * 64 + fq * 16);
        acc = __builtin_amdgcn_mfma_f32_16x16x32_bf16(ah, chi[ks], acc, 0, 0, 0);
        acc = __builtin_amdgcn_mfma_f32_16x16x32_bf16(alo, chi[ks], acc, 0, 0, 0);
        acc = __builtin_amdgcn_mfma_f32_16x16x32_bf16(ah, clo[ks], acc, 0, 0, 0);
      }
      lds_fence();
#pragma unroll
      for (int r = 0; r < 4; ++r) {
        int tl = sub * 16 + fq * 4 + r;
        float* yp = S5Y + (size_t)(rowbase + tl) * 512 + g * 16 + fr;
        if (d == 0) {
          float u = (float)*(const h16*)(ulds + tl * 32 + fr * 2);
          *yp = acc[r] + dsk * u;
        } else {
          *yp = gelu_f(*yp + acc[r]);
        }
      }
    }
  }
}

DEV void prep_item(const Params& p, const Ctx& cx, int l, int item, char* smem) {
  const int tile = item >> 2, q = item & 3;
  const int row0 = tile * 64;
  const int tid = cx.tid;
  const h16* zc = (const h16*)(p.ws + OFF_REG2);
  h16* SC = (h16*)(p.ws + OFF_SCAN);
  const char* wt = p.ws + OFF_WT + (size_t)l * WT_SIZE;
  {
    const int d = q >> 1, isA = q & 1;
    const int coff = isA ? 3200 + d * 64 : 3072 + d * 64;
    int tok = tid >> 3, c8 = tid & 7;
    h16x8 cv = *(const h16x8*)(zc + (size_t)(row0 + tok) * ZC + coff + c8 * 8);
    float f[8];
#pragma unroll
    for (int j = 0; j < 8; ++j) { f[j] = (float)cv[j]; if (!isA) f[j] = tanh_f(f[j]); }
    uint4 o;
    o.x = pack_bf2(f[0], f[1]); o.y = pack_bf2(f[2], f[3]); o.z = pack_bf2(f[4], f[5]); o.w = pack_bf2(f[6], f[7]);
    *(uint4*)(smem + tok * 144 + c8 * 16) = o;
    __syncthreads();
    const bf16_t* Bt = (const bf16_t*)(wt + (isA ? WT_A2 : WT_W2)) + (size_t)d * 1024 * 64;
    const float* biasw = p.rwkv_w0 + (size_t)(l * 2 + d) * 1024;
    const float* biasa = p.rwkv_a0 + (size_t)(l * 2 + d) * 1024;
    h16* dst = SC + (size_t)(isA ? 4 + d : 6 + d) * ARR;
    for (int hf = 0; hf < 2; ++hf) small_gemm<64, 4>(p, cx, smem, 144, Bt, (tid >> 6) * 128 + hf * 64, [&](int m, int n, f32x4 v) {
      float4 bbw = *(const float4*)(biasw + n), bba = *(const float4*)(biasa + n);
      float4 bb = isA ? bba : bbw;
      float r0 = sigmoid_f(v[0] + bb.x), r1 = sigmoid_f(v[1] + bb.y), r2 = sigmoid_f(v[2] + bb.z), r3 = sigmoid_f(v[3] + bb.w);
      if (!isA) { r0 = __expf(-DECAY_SCALE * r0); r1 = __expf(-DECAY_SCALE * r1); r2 = __expf(-DECAY_SCALE * r2); r3 = __expf(-DECAY_SCALE * r3); }
      h16x4 o4 = {(h16)r0, (h16)r1, (h16)r2, (h16)r3};
      *(h16x4*)(dst + (size_t)(row0 + m) * 1024 + n) = o4;
    });
  }
  {
    const float* cw = p.conv_rkv + (size_t)l * 3 * 3072;
#pragma unroll 1
    for (int it = 0; it < 4; ++it) {
      int idx = tid + it * 512;
      int grp = idx & 7, hh = (idx >> 3) & 3, tok = idx >> 5;
      int row = row0 + tok;
      int c0 = (4 * q + hh) * 64 + grp * 8;
      bool hasp, hasn;
      if (row < NLAT) { hasp = (row & 16383) != 0; hasn = (row & 16383) != 16383; }
      else { hasp = (row & 255) != 0; hasn = (row & 255) != 255; }
      size_t off = (size_t)row * 1024 + c0;
      float kv[8];
#pragma unroll
      for (int s = 0; s < 3; ++s) {
        int ch = s * 1024 + c0;
        const h16* zp = zc + (size_t)row * ZC + ch;
        h16x8 cur = *(const h16x8*)zp;
        h16x8 prv = cur, nxt = cur;
        if (hasp) prv = *(const h16x8*)(zp - ZC);
        if (hasn) nxt = *(const h16x8*)(zp + ZC);
        float ov[8];
#pragma unroll
        for (int j = 0; j < 8; j += 4) {
          float4 a = *(const float4*)(cw + ch + j), bq = *(const float4*)(cw + 3072 + ch + j), cq = *(const float4*)(cw + 6144 + ch + j);
          float w0[4] = {a.x, a.y, a.z, a.w}, w1[4] = {bq.x, bq.y, bq.z, bq.w}, w2[4] = {cq.x, cq.y, cq.z, cq.w};
#pragma unroll
          for (int jj = 0; jj < 4; ++jj) {
            float pv = hasp ? (float)prv[j + jj] : 0.f, nv = hasn ? (float)nxt[j + jj] : 0.f;
            ov[j + jj] = w0[jj] * pv + w1[jj] * (float)cur[j + jj] + w2[jj] * nv;
          }
        }
        h16x8 o;
#pragma unroll
        for (int j = 0; j < 8; ++j) o[j] = (h16)ov[j];
        *(h16x8*)(SC + (size_t)s * ARR + off) = o;
        if (s == 1) {
#pragma unroll
          for (int j = 0; j < 8; ++j) kv[j] = ov[j];
        }
      }
      float kk[8], ss = 0;
#pragma unroll
      for (int j = 0; j < 8; j += 4) {
        float4 kq = *(const float4*)(p.rwkv_k_k + (size_t)l * 1024 + c0 + j);
        kk[j] = kv[j] * kq.x; kk[j + 1] = kv[j + 1] * kq.y; kk[j + 2] = kv[j + 2] * kq.z; kk[j + 3] = kv[j + 3] * kq.w;
      }
#pragma unroll
      for (int j = 0; j < 8; ++j) ss += kk[j] * kk[j];
      ss = allreduce8(ss);
      float inv = 1.f / fmaxf(sqrtf(ss), 1e-12f);
      h16x8 o;
#pragma unroll
      for (int j = 0; j < 8; ++j) o[j] = (h16)(kk[j] * inv);
      *(h16x8*)(SC + 3 * ARR + off) = o;
    }
  }
}

DEV void phase_prep(const Params& p, const Ctx& cx, int l, char* smem) {
  const int NPREP = 520 * 4, NS5 = 520;
  const int lane = cx.tid & 63, wid = cx.tid >> 6;
  for (int item = cx.bid; item < NPREP + NS5; item += cx.nblk) {
    __syncthreads();
    if (item < NPREP) prep_item(p, cx, l, item, smem);
    else s5_pass1_unit(p, cx, l, (item - NPREP) * 8 + wid, smem + wid * 8192, lane);
  }
}

struct RIn { h16x4 w, a, kk, k, r; h16 v; };

DEV void rwkv_task(const Params& p, const Ctx& cx, int l, int task, int lane) {
  const int unit = task >> 4, d = unit & 1, h = (unit >> 1) & 15, b = unit >> 5;
  const int j = lane >> 4, s = lane & 15;
  const int myrow = (task & 15) * 4 + j;
  const h16* SC = (const h16*)(p.ws + OFF_SCAN);
  const h16* pR = SC + 0 * ARR + h * 64 + 4 * s;
  const h16* pK = SC + 1 * ARR + h * 64 + 4 * s;
  const h16* pV = SC + 2 * ARR + h * 64 + myrow;
  const h16* pKK = SC + 3 * ARR + h * 64 + 4 * s;
  const h16* pA = SC + (size_t)(4 + d) * ARR + h * 64 + 4 * s;
  const h16* pW = SC + (size_t)(6 + d) * ARR + h * 64 + 4 * s;
  h16* pO = (h16*)(p.ws + OFF_REG2) + (size_t)d * ARR + h * 64 + myrow;
  float ka[4], omka[4];
  {
    float4 t = *(const float4*)(p.rwkv_k_a + (size_t)l * 1024 + h * 64 + 4 * s);
    ka[0] = t.x; ka[1] = t.y; ka[2] = t.z; ka[3] = t.w;
#pragma unroll
    for (int i = 0; i < 4; ++i) omka[i] = 1.f - ka[i];
  }
  float S[4] = {0.f, 0.f, 0.f, 0.f};
  constexpr int U = 4, NG = 16640 / U;
  RIn bufA[U], bufB[U];

#define RW_ROW0(gq, row0, stp)                                                     \
  {                                                                                \
    int q0 = (gq) * U;                                                             \
    if (q0 < 256) { row0 = NLAT + b * 256 + (d ? 255 - q0 : q0); }                 \
    else { int t0 = q0 - 256; row0 = b * 16384 + (d ? 16383 - t0 : t0); }          \
    stp = d ? -1 : 1;                                                              \
  }
#define RW_LOAD(buf, gq)                                                           \
  {                                                                                \
    int row0, stp; RW_ROW0(gq, row0, stp);                                         \
    _Pragma("unroll") for (int u = 0; u < U; ++u) {                                \
      size_t off = (size_t)(row0 + u * stp) * 1024;                                \
      buf[u].w = *(const h16x4*)(pW + off); buf[u].a = *(const h16x4*)(pA + off);  \
      buf[u].kk = *(const h16x4*)(pKK + off); buf[u].k = *(const h16x4*)(pK + off);\
      buf[u].r = *(const h16x4*)(pR + off); buf[u].v = pV[off];                    \
    }                                                                              \
  }
#define RW_COMPUTE(buf, gq)                                                        \
  {                                                                                \
    int row0, stp; RW_ROW0(gq, row0, stp);                                         \
    _Pragma("unroll") for (int u = 0; u < U; ++u) {                                \
      float vj = (float)buf[u].v;                                                  \
      float kka[4], vk[4], d1 = 0.f;                                               \
      _Pragma("unroll") for (int i = 0; i < 4; ++i) {                              \
        float a_ = (float)buf[u].a[i], kk_ = (float)buf[u].kk[i], k_ = (float)buf[u].k[i]; \
        kka[i] = kk_ * a_;                                                         \
        vk[i] = vj * (k_ * fmaf(a_, ka[i], omka[i]));                              \
        d1 = fmaf(S[i], kk_, d1);                                                  \
      }                                                                            \
      d1 = allreduce16(d1);                                                        \
      float d2 = 0.f;                                                              \
      _Pragma("unroll") for (int i = 0; i < 4; ++i) {                              \
        S[i] = fmaf(-d1, kka[i], fmaf(S[i], (float)buf[u].w[i], vk[i]));           \
        d2 = fmaf(S[i], (float)buf[u].r[i], d2);                                   \
      }                                                                            \
      d2 = allreduce16(d2);                                                        \
      if (s == 0) pO[(size_t)(row0 + u * stp) * 1024] = (h16)d2;                   \
    }                                                                              \
  }

  RW_LOAD(bufA, 0);
#pragma unroll 1
  for (int g = 0; g < NG; g += 2) {
    RW_LOAD(bufB, g + 1);
    RW_COMPUTE(bufA, g);
    if (g + 2 < NG) RW_LOAD(bufA, g + 2);
    RW_COMPUTE(bufB, g + 1);
  }
#undef RW_ROW0
#undef RW_LOAD
#undef RW_COMPUTE
}

DEV void phase_scan(const Params& p, const Ctx& cx, int l, char* smem) {
  const int lane = cx.tid & 63, wid = cx.tid >> 6;
  char* wl = smem + wid * 17408;
  const int NS5U = 2 * 32 * 65;
  if (wid < 4) {
    for (int task = cx.bid * 4 + wid; task < 1024; task += cx.nblk * 4) rwkv_task(p, cx, l, task, lane);
  } else {
    for (int u = cx.bid * 4 + (wid - 4); u < NS5U; u += cx.nblk * 4) {
      if (l == 1 && (u % 65) == 0) continue;
      s5_pass3_unit(p, cx, l, u, wl, lane);
    }
  }
}

DEV void pool_item(const Params& p, const Ctx& cx, int l, int item, char* smem) {
  const int tid = cx.tid;
  const h16* zrest = (const h16*)(p.ws + OFF_ZREST);
  bf16_t* ym = (bf16_t*)(p.ws + OFF_YM);
  const char* wt = p.ws + OFF_WT + (size_t)l * WT_SIZE;
  float* V = (float*)smem;
  char* At = smem + 43008;
  int g, rowout0, Lseq, p0, rlo, rhi, rstride, rowsrc0;
  if (item < 2048) {
    g = item & 3; int r = (item >> 2) & 255, b = item >> 10;
    int w = 2 << g;
    rlo = max(r - w / 2, 0); rhi = min(r + w / 2 - 1, 255);
    rowsrc0 = b * 16384; rstride = 64;
    rowout0 = b * 16384 + r * 64; Lseq = 64; p0 = 0;
  } else {
    int it = item - 2048;
    g = it & 3; int tq = (it >> 2) & 3, b = it >> 4;
    rlo = 0; rhi = 0; rowsrc0 = NLAT + b * 256; rstride = 0;
    rowout0 = NLAT + b * 256 + tq * 64; Lseq = 256; p0 = tq * 64;
  }
  const int w = 2 << g;
  const float invr = 1.f / (float)(rhi - rlo + 1);
  for (int unit = tid; unit < 80 * 16; unit += NTHREADS) {
    int lp = unit >> 4, ch8 = unit & 15;
    int pos = p0 - 8 + lp;
    float acc[8] = {0, 0, 0, 0, 0, 0, 0, 0};
    if (pos >= 0 && pos < Lseq) {
      for (int rr = rlo; rr <= rhi; ++rr) {
        h16x8 v = *(const h16x8*)(zrest + (size_t)(rowsrc0 + rr * rstride + pos) * ZR + 1024 + g * 128 + ch8 * 8);
#pragma unroll
        for (int j = 0; j < 8; ++j) acc[j] += (float)v[j];
      }
    }
    float* vp = V + lp * 132 + ch8 * 8;
#pragma unroll
    for (int j = 0; j < 8; ++j) vp[j] = acc[j] * invr;
  }
  __syncthreads();
  for (int unit = tid; unit < 64 * 16; unit += NTHREADS) {
    int c = unit >> 4, ch8 = unit & 15;
    int pos = p0 + c;
    int lo = max(pos - w / 2, 0), hi = min(pos + w / 2 - 1, Lseq - 1);
    float acc[8] = {0, 0, 0, 0, 0, 0, 0, 0};
    for (int pp = lo; pp <= hi; ++pp) {
      const float* vp = V + (pp - p0 + 8) * 132 + ch8 * 8;
#pragma unroll
      for (int j = 0; j < 8; ++j) acc[j] += vp[j];
    }
    float invc = 1.f / (float)(hi - lo + 1);
    h16x8 uc = *(const h16x8*)(zrest + (size_t)(rowout0 + c) * ZR + 1024 + g * 128 + ch8 * 8);
    uint4 o;
    o.x = pack_bf2(acc[0] * invc - (float)uc[0], acc[1] * invc - (float)uc[1]);
    o.y = pack_bf2(acc[2] * invc - (float)uc[2], acc[3] * invc - (float)uc[3]);
    o.z = pack_bf2(acc[4] * invc - (float)uc[4], acc[5] * invc - (float)uc[5]);
    o.w = pack_bf2(acc[6] * invc - (float)uc[6], acc[7] * invc - (float)uc[7]);
    *(uint4*)(At + c * 272 + ch8 * 16) = o;
  }
  __syncthreads();
  const bf16_t* Bt = (const bf16_t*)(wt + WT_POOL) + (size_t)g * 128 * 128;
  const float* ps = p.pool_scale + (size_t)l * 512 + g * 128;
  small_gemm<128, 1>(p, cx, At, 272, Bt, (tid >> 6) * 16, [&](int m, int n, f32x4 v) {
    int row = rowout0 + m;
    float4 sc = *(const float4*)(ps + n);
    h16x4 gt = *(const h16x4*)(zrest + (size_t)row * ZR + 1536 + g * 128 + n);
    uint2 o;
    o.x = pack_bf2(v[0] * sc.x * silu_f((float)gt[0]), v[1] * sc.y * silu_f((float)gt[1]));
    o.y = pack_bf2(v[2] * sc.z * silu_f((float)gt[2]), v[3] * sc.w * silu_f((float)gt[3]));
    *(uint2*)(ym + (size_t)row * D + 512 + g * 128 + n) = o;
  });
}

DEV void glu_item(const Params& p, const Ctx& cx, int l, int tile, char* smem) {
  const int tid = cx.tid;
  const int row0 = tile * 64;
  const float* S5Y = (const float*)(p.ws + OFF_S5Y);
  const h16* zrest = (const h16*)(p.ws + OFF_ZREST);
  bf16_t* ym = (bf16_t*)(p.ws + OFF_YM);
  const char* wt = p.ws + OFF_WT + (size_t)l * WT_SIZE;
#pragma unroll
  for (int it = 0; it < 8; ++it) {
    int unit = tid + it * NTHREADS;
    int r = unit >> 6, c8 = unit & 63;
    const float* sp = S5Y + (size_t)(row0 + r) * 512 + c8 * 8;
    float4 a = *(const float4*)sp, bq = *(const float4*)(sp + 4);
    uint4 o;
    o.x = pack_bf2(a.x, a.y); o.y = pack_bf2(a.z, a.w); o.z = pack_bf2(bq.x, bq.y); o.w = pack_bf2(bq.z, bq.w);
    *(uint4*)(smem + r * 1040 + c8 * 16) = o;
  }
  __syncthreads();
  const bf16_t* Bt = (const bf16_t*)(wt + WT_GLU);
  const float* bg = p.b_glu + (size_t)l * 512;
  small_gemm<512, 4>(p, cx, smem, 1040, Bt, (tid >> 6) * 64, [&](int m, int n, f32x4 v) {
    int row = row0 + m;
    float4 y = *(const float4*)(S5Y + (size_t)row * 512 + n);
    float4 bb = *(const float4*)(bg + n);
    h16x4 gt = *(const h16x4*)(zrest + (size_t)row * ZR + 512 + n);
    uint2 o;
    o.x = pack_bf2(y.x * sigmoid_f(v[0] + bb.x) * silu_f((float)gt[0]), y.y * sigmoid_f(v[1] + bb.y) * silu_f((float)gt[1]));
    o.y = pack_bf2(y.z * sigmoid_f(v[2] + bb.z) * silu_f((float)gt[2]), y.w * sigmoid_f(v[3] + bb.w) * silu_f((float)gt[3]));
    *(uint2*)(ym + (size_t)row * D + n) = o;
  });
}

DEV void rwkvmerge_item(const Params& p, const Ctx& cx, int l, int tile) {
  const int tid = cx.tid;
  const int row0 = tile * 64;
  const h16* SC = (const h16*)(p.ws + OFF_SCAN);
  const h16* O = (const h16*)(p.ws + OFF_REG2);
  const h16* zrest = (const h16*)(p.ws + OFF_ZREST);
  bf16_t* ym = (bf16_t*)(p.ws + OFF_YM);
#pragma unroll 1
  for (int it = 0; it < 16; ++it) {
    int idx = tid + it * NTHREADS;
    int grp = idx & 7, h = (idx >> 3) & 15, tok = idx >> 7;
    int row = row0 + tok;
    int c0 = h * 64 + grp * 8;
    size_t off = (size_t)row * 1024 + c0;
    h16x8 of = *(const h16x8*)(O + off), ob = *(const h16x8*)(O + ARR + off);
    float o[8], sm = 0;
#pragma unroll
    for (int j = 0; j < 8; ++j) { o[j] = (float)of[j] + (float)ob[j]; sm += o[j]; }
    sm = allreduce8(sm);
    float mu = sm * (1.f / 64.f), vq = 0;
#pragma unroll
    for (int j = 0; j < 8; ++j) { o[j] -= mu; vq += o[j] * o[j]; }
    vq = allreduce8(vq);
    float rstd = rsqrtf(vq * (1.f / 64.f) + 64e-5f);
    h16x8 r8 = *(const h16x8*)(SC + 0 * ARR + off), k8 = *(const h16x8*)(SC + 1 * ARR + off), v8 = *(const h16x8*)(SC + 2 * ARR + off);
    h16x8 af = *(const h16x8*)(SC + 4 * ARR + off), ab = *(const h16x8*)(SC + 5 * ARR + off);
    float pk[8], rk[8], gw[8], gb[8];
#pragma unroll
    for (int j = 0; j < 8; j += 4) {
      float4 t0 = *(const float4*)(p.rwkv_k_a + (size_t)l * 1024 + c0 + j), t1 = *(const float4*)(p.rwkv_r_k + (size_t)l * 1024 + c0 + j);
      float4 t2 = *(const float4*)(p.gn_w + (size_t)l * 1024 + c0 + j), t3 = *(const float4*)(p.gn_b + (size_t)l * 1024 + c0 + j);
      pk[j] = t0.x; pk[j + 1] = t0.y; pk[j + 2] = t0.z; pk[j + 3] = t0.w;
      rk[j] = t1.x; rk[j + 1] = t1.y; rk[j + 2] = t1.z; rk[j + 3] = t1.w;
      gw[j] = t2.x; gw[j + 1] = t2.y; gw[j + 2] = t2.z; gw[j + 3] = t2.w;
      gb[j] = t3.x; gb[j + 1] = t3.y; gb[j + 2] = t3.z; gb[j + 3] = t3.w;
    }
    float part = 0;
#pragma unroll
    for (int j = 0; j < 8; ++j) {
      float ksum = (float)k8[j] * (2.f + ((float)af[j] + (float)ab[j] - 2.f) * pk[j]);
      part += (float)r8[j] * ksum * rk[j];
    }
    part = allreduce8(part);
    h16x8 gt = *(const h16x8*)(zrest + (size_t)row * ZR + 2048 + c0);
    float res[8];
#pragma unroll
    for (int j = 0; j < 8; ++j) {
      float y = o[j] * rstd * gw[j] + gb[j] + part * (float)v8[j];
      res[j] = y * silu_f((float)gt[j]);
    }
    uint4 ov;
    ov.x = pack_bf2(res[0], res[1]); ov.y = pack_bf2(res[2], res[3]); ov.z = pack_bf2(res[4], res[5]); ov.w = pack_bf2(res[6], res[7]);
    *(uint4*)(ym + (size_t)row * D + 1024 + c0) = ov;
  }
}

DEV void phase_merge(const Params& p, const Ctx& cx, int l, char* smem) {
  const int ntile = (l == 0) ? 520 : 512;
  const int npool = (l == 0) ? 2048 + 32 : 2048;
  const int total = npool + 2 * ntile;
  for (int item = cx.bid; item < total; item += cx.nblk) {
    __syncthreads();
    if (item < npool) pool_item(p, cx, l, item, smem);
    else if (item < npool + ntile) glu_item(p, cx, l, item - npool, smem);
    else rwkvmerge_item(p, cx, l, item - npool - ntile);
  }
}

__global__ void __launch_bounds__(NTHREADS) mega_fwd(Params p, int ph0, int ph1) {
  extern __shared__ __attribute__((aligned(16))) char smem[];
  cg::grid_group grid = cg::this_grid();
  const int wave_s = __builtin_amdgcn_readfirstlane((int)(threadIdx.x >> 6));
  for (int ph = ph0; ph < ph1; ++ph) {
    if (ph > ph0) grid.sync();
    Ctx cx;
    {
      int t_, b_ = blockIdx.x, n_ = gridDim.x;
      asm volatile("v_mbcnt_lo_u32_b32 %0, -1, 0\n\tv_mbcnt_hi_u32_b32 %0, -1, %0\n\tv_lshl_add_u32 %0, %1, 6, %0" : "=&v"(t_) : "s"(wave_s));
      asm volatile("" : "+s"(b_), "+s"(n_));
      cx.tid = t_; cx.bid = b_; cx.nblk = n_;
    }
    const int l = ph >= 8 ? 1 : 0;
    const int lp = ph >= 8 ? ph - 6 : ph;
#ifndef PHMASK
#define PHMASK 0xff
#endif
    if (ph == 0) { if (PHMASK & 1) phase0(p, cx, smem); }
    else if (ph == 1) { if (PHMASK & 2) phase_adaln0(p, cx); }
    else if (lp == 2 && (PHMASK & 4)) {
      h16* zrest = (h16*)(p.ws + OFF_ZREST);
      h16* zc = (h16*)(p.ws + OFF_REG2);
      gemm_phase(p, cx, (const bf16_t*)(p.ws + OFF_H), (const bf16_t*)(p.ws + OFF_WT + (size_t)l * WT_SIZE + WT_IN), 2048, 130, 25, smem,
                 [&](int row, int col, f32x4 v) {
                   h16* dst;
                   if (col < 2048) dst = zrest + (size_t)row * ZR + col;
                   else if (col < 5120) dst = zc + (size_t)row * ZC + (col - 2048);
                   else if (col < 6144) dst = zrest + (size_t)row * ZR + 2048 + (col - 5120);
                   else dst = zc + (size_t)row * ZC + 3072 + (col - 6144);
                   h16x4 o = {(h16)v[0], (h16)v[1], (h16)v[2], (h16)v[3]};
                   *(h16x4*)dst = o;
                 });
    } else if (lp == 3) { if (PHMASK & 8) phase_prep(p, cx, l, smem); }
    else if (lp == 4) { if (PHMASK & 16) phase_scan(p, cx, l, smem); }
    else if (lp == 5) { if (PHMASK & 32) phase_merge(p, cx, l, smem); }
    else if (lp == 6 && (PHMASK & 64)) {
      const float* mods = (const float*)(p.ws + OFF_MODS);
      float* prec = (float*)(p.ws + OFF_PREC);
      const float* xin = (l == 0) ? p.x : p.out;
      gemm_phase(p, cx, (const bf16_t*)(p.ws + OFF_YM), (const bf16_t*)(p.ws + OFF_WT + (size_t)l * WT_SIZE + WT_OUT), 2048, l == 0 ? 130 : 128, 8, smem,
                 [&](int row, int col, f32x4 v) {
                   if (row < NLAT) {
                     float4 xv = *(const float4*)(xin + (size_t)row * D + col);
                     float4 gv = *(const float4*)(mods + (size_t)(l * 3 + (row >> 14)) * 6144 + 4096 + col);
                     float4 r;
                     r.x = ALPHA * xv.x + gv.x * v[0]; r.y = ALPHA * xv.y + gv.y * v[1]; r.z = ALPHA * xv.z + gv.z * v[2]; r.w = ALPHA * xv.w + gv.w * v[3];
                     *(float4*)(p.out + (size_t)row * D + col) = r;
                   } else {
                     float4 xv = *(const float4*)(p.ctx + (size_t)(row - NLAT) * D + col);
                     float4 gv = *(const float4*)(mods + (size_t)(l * 3 + 2) * 6144 + 4096 + col);
                     float4 r;
                     r.x = ALPHA * xv.x + gv.x * v[0]; r.y = ALPHA * xv.y + gv.y * v[1]; r.z = ALPHA * xv.z + gv.z * v[2]; r.w = ALPHA * xv.w + gv.w * v[3];
                     *(float4*)(prec + (size_t)(row - NLAT) * D + col) = r;
                   }
                 });
    } else if (lp == 7) { if (PHMASK & 128) phase_finln(p, cx, l); }
  }
}

constexpr int NPHASES = 14;

extern "C" void kernel_launch(void* const* d_in, const int* in_sizes, int n_in, void* d_out, int out_size, void* d_ws, size_t ws_size,
                              hipStream_t stream) {
  static int grid_blocks = 0;
  if (grid_blocks == 0) {
    if (n_in != 32 || ws_size < WS_END) { fprintf(stderr, "kernel_launch: unexpected n_in %d / ws %zu (need %zu)\n", n_in, ws_size, (size_t)WS_END); grid_blocks = -1; return; }
    int dev = 0, cus = 0, per_cu = 0;
    hipGetDevice(&dev);
    hipDeviceGetAttribute(&cus, hipDeviceAttributeMultiprocessorCount, dev);
    if (hipFuncSetAttribute((const void*)mega_fwd, hipFuncAttributeMaxDynamicSharedMemorySize, LDS_BYTES) != hipSuccess) { fprintf(stderr, "hipFuncSetAttribute failed\n"); grid_blocks = -1; return; }
    if (hipOccupancyMaxActiveBlocksPerMultiprocessor(&per_cu, (const void*)mega_fwd, NTHREADS, LDS_BYTES) != hipSuccess || per_cu < 1) {
      fprintf(stderr, "occupancy query gave %d\n", per_cu); (void)hipGetLastError(); per_cu = 1;
    }
    grid_blocks = cus * per_cu;
  }
  if (grid_blocks < 0) return;
  Params p{};
  const float** pp = (const float**)&p;
  for (int i = 0; i < 32; ++i) pp[i] = (const float*)d_in[i];
  p.out = (float*)d_out;
  p.ws = (char*)d_ws;
  int ph0 = 0, ph1 = NPHASES;
  void* args[] = {&p, &ph0, &ph1};
  hipError_t e = hipLaunchCooperativeKernel((const void*)mega_fwd, dim3(grid_blocks), dim3(NTHREADS), args, LDS_BYTES, stream);
  if (e != hipSuccess) fprintf(stderr, "cooperative launch failed: %s (grid %d)\n", hipGetErrorString(e), grid_blocks);
}
```

```cpp
#include <hip/hip_runtime.h>
#include <hip/hip_cooperative_groups.h>
#include <cstdio>
namespace cg = cooperative_groups;

typedef unsigned short bf16_t;
typedef _Float16 h16;
using bf16x8 = __attribute__((ext_vector_type(8))) _Float16;
using f32x4 = __attribute__((ext_vector_type(4))) float;
using h16x4 = __attribute__((ext_vector_type(4))) _Float16;
using h16x8 = __attribute__((ext_vector_type(8))) _Float16;

#define DEV __device__ __forceinline__

constexpr int D = 2048, NLAT = 32768, MTOT = 33280, ZR = 3072, ZC = 3328;
constexpr int NTHREADS = 512;
constexpr int LDS_BYTES = 147456;
constexpr float ALPHA = 1.41421356237f;
constexpr float DECAY_SCALE = 0.606531f;

constexpr size_t al256(size_t x) { return (x + 255) & ~size_t(255); }
constexpr size_t ARR = (size_t)MTOT * 1024;
constexpr size_t OFF_MODS = 0;
constexpr size_t OFF_S5F = al256(OFF_MODS + 2 * 3 * 6144 * 4);
constexpr size_t OFF_PREC = al256(OFF_S5F + (size_t)2 * 32 * 65 * 2 * 64 * 8);
constexpr size_t OFF_WT = al256(OFF_PREC + (size_t)512 * 2048 * 4);
constexpr size_t WT_IN = 0, WT_OUT = 26214400, WT_W2 = 34603008, WT_A2 = 34865152, WT_POOL = 35127296, WT_GLU = 35258368, WT_SIZE = 35782656;
constexpr size_t OFF_ZREST = al256(OFF_WT + 2 * WT_SIZE);
constexpr size_t OFF_REG2 = al256(OFF_ZREST + (size_t)MTOT * ZR * 2);
constexpr size_t OFF_S5Y = OFF_REG2 + 2 * ARR * 2;
constexpr size_t OFF_SCAN = al256(OFF_REG2 + (size_t)MTOT * ZC * 2);
constexpr size_t OFF_H = OFF_SCAN;
constexpr size_t OFF_YM = OFF_SCAN + 6 * ARR * 2;
constexpr size_t WS_END = OFF_SCAN + 8 * ARR * 2;

#ifndef PH_SEQ
#define PH_SEQ 0xDCBA9876543210ull
#define PH_NSTEPS 14
#endif
struct Params {
  const float *x, *c, *ctx, *c_ctx, *w_ada, *b_ada, *w_in, *conv_rkv, *s5_lam_re, *s5_lam_im, *s5_log_step,
      *s5_b_re, *s5_b_im, *s5_c_re, *s5_c_im, *s5_d, *w_glu, *b_glu, *w_pool, *pool_scale,
      *rwkv_w0, *rwkv_w2, *rwkv_a0, *rwkv_a2, *rwkv_k_k, *rwkv_k_a, *rwkv_r_k, *gn_w, *gn_b,
      *w_out, *ln_g, *ln_b;
  float* out;
  char* ws;
};
struct Ctx { int tid, bid, nblk; };

DEV float sigmoid_f(float x) { return 1.f / (1.f + __expf(-x)); }
DEV float silu_f(float x) { return x / (1.f + __expf(-x)); }
DEV float tanh_f(float x) { float e = __expf(2.f * x); return 1.f - 2.f / (e + 1.f); }
DEV float gelu_f(float y) { return 0.5f * y * (1.f + tanh_f(0.7978845608f * (y + 0.044715f * y * y * y))); }
using h16x2 = __attribute__((ext_vector_type(2))) _Float16;
DEV unsigned pack_bf2(float a, float b) { h16x2 v = {(h16)a, (h16)b}; return __builtin_bit_cast(unsigned, v); }
template <int CTRL> DEV float dpp_mov(float v) {
  return __int_as_float(__builtin_amdgcn_update_dpp(0, __float_as_int(v), CTRL, 0xf, 0xf, true));
}
DEV float allreduce16(float v) {
  v += dpp_mov<0xB1>(v);
  v += dpp_mov<0x4E>(v);
  v += dpp_mov<0x141>(v);
  v += dpp_mov<0x140>(v);
  return v;
}
DEV float wave_sum(float v) {
  v = allreduce16(v);
  return __builtin_amdgcn_readlane(__float_as_int(v), 0) == 0 && false ? 0.f :
         __int_as_float(__builtin_amdgcn_readlane(__float_as_int(v), 0)) + __int_as_float(__builtin_amdgcn_readlane(__float_as_int(v), 16)) +
         __int_as_float(__builtin_amdgcn_readlane(__float_as_int(v), 32)) + __int_as_float(__builtin_amdgcn_readlane(__float_as_int(v), 48));
}
DEV float allreduce8(float v) {
  v += dpp_mov<0xB1>(v);
  v += dpp_mov<0x4E>(v);
  v += dpp_mov<0x141>(v);
  return v;
}
DEV void lds_fence() { asm volatile("s_waitcnt lgkmcnt(0)" ::: "memory"); }

DEV void p0_mods_item(const Params& p, const Ctx& cx, int item, char* smem) {
  float* red = (float*)smem;
  float* mods = (float*)(p.ws + OFF_MODS);
  int l = item / 96, chunk = item % 96;
  int tid = cx.tid, kq = tid >> 6, col = tid & 63;
  int n = chunk * 64 + col;
  const float* W = p.w_ada + (size_t)l * 2048 * 6144;
  float a0 = 0, a1 = 0, a2 = 0;
#pragma unroll 8
  for (int k = kq; k < 2048; k += 8) {
    float w = W[(size_t)k * 6144 + n];
    a0 += silu_f(p.c[k]) * w;
    a1 += silu_f(p.c[2048 + k]) * w;
    a2 += silu_f(p.c_ctx[k]) * w;
  }
  red[(kq * 3 + 0) * 64 + col] = a0;
  red[(kq * 3 + 1) * 64 + col] = a1;
  red[(kq * 3 + 2) * 64 + col] = a2;
  __syncthreads();
  if (tid < 192) {
    int r = tid >> 6, cc = tid & 63;
    float s = 0;
#pragma unroll
    for (int q = 0; q < 8; ++q) s += red[(q * 3 + r) * 64 + cc];
    mods[(size_t)(l * 3 + r) * 6144 + chunk * 64 + cc] = s + p.b_ada[(size_t)l * 6144 + chunk * 64 + cc];
  }
}

DEV void p0_transpose_tile(const Params& p, const Ctx& cx, const float* __restrict__ src, bf16_t* __restrict__ dst, int K, int N, int tk, int tn, char* smem) {
  float* T = (float*)smem;
  int tid = cx.tid;
  int k0 = tk * 64, n0 = tn * 64;
  int kk = tid >> 4, n4 = tid & 15;
#pragma unroll
  for (int i = 0; i < 2; ++i) {
    int k = kk + 32 * i;
    float4 v = *(const float4*)(src + (size_t)(k0 + k) * N + n0 + n4 * 4);
    T[k * 65 + n4 * 4 + 0] = v.x; T[k * 65 + n4 * 4 + 1] = v.y; T[k * 65 + n4 * 4 + 2] = v.z; T[k * 65 + n4 * 4 + 3] = v.w;
  }
  __syncthreads();
  int n = tid >> 3, k8 = tid & 7;
  uint4 o;
  o.x = pack_bf2(T[(k8 * 8 + 0) * 65 + n], T[(k8 * 8 + 1) * 65 + n]);
  o.y = pack_bf2(T[(k8 * 8 + 2) * 65 + n], T[(k8 * 8 + 3) * 65 + n]);
  o.z = pack_bf2(T[(k8 * 8 + 4) * 65 + n], T[(k8 * 8 + 5) * 65 + n]);
  o.w = pack_bf2(T[(k8 * 8 + 6) * 65 + n], T[(k8 * 8 + 7) * 65 + n]);
  *(uint4*)(dst + (size_t)(n0 + n) * K + k0 + k8 * 8) = o;
}

DEV void phase0(const Params& p, const Ctx& cx0, char* smem) {
  const int NTR = 4368;
  const int total = 192 + 2 * NTR;
  for (int item = cx0.bid; item < total; item += cx0.nblk) {
    __syncthreads();
    Ctx cx = cx0; asm volatile("" : "+v"(cx.tid));
    if (item < 192) { p0_mods_item(p, cx, item, smem); continue; }
    int it = item - 192;
    int l = it / NTR, i = it % NTR;
    char* wt = p.ws + OFF_WT + (size_t)l * WT_SIZE;
    if (i < 3200) {
      p0_transpose_tile(p, cx, p.w_in + (size_t)l * 2048 * 6400, (bf16_t*)(wt + WT_IN), 2048, 6400, i / 100, i % 100, smem);
    } else if (i < 4224) {
      int j = i - 3200;
      p0_transpose_tile(p, cx, p.w_out + (size_t)l * 2048 * 2048, (bf16_t*)(wt + WT_OUT), 2048, 2048, j / 32, j % 32, smem);
    } else if (i < 4256) {
      int j = i - 4224, d = j / 16;
      p0_transpose_tile(p, cx, p.rwkv_w2 + (size_t)(l * 2 + d) * 64 * 1024, (bf16_t*)(wt + WT_W2) + (size_t)d * 1024 * 64, 64, 1024, 0, j % 16, smem);
    } else if (i < 4288) {
      int j = i - 4256, d = j / 16;
      p0_transpose_tile(p, cx, p.rwkv_a2 + (size_t)(l * 2 + d) * 64 * 1024, (bf16_t*)(wt + WT_A2) + (size_t)d * 1024 * 64, 64, 1024, 0, j % 16, smem);
    } else if (i < 4304) {
      int j = i - 4288, g = j / 4;
      p0_transpose_tile(p, cx, p.w_pool + (size_t)(l * 4 + g) * 128 * 128, (bf16_t*)(wt + WT_POOL) + (size_t)g * 128 * 128, 128, 128, (j % 4) / 2, j % 2, smem);
    } else {
      int j = i - 4304;
      p0_transpose_tile(p, cx, p.w_glu + (size_t)l * 512 * 512, (bf16_t*)(wt + WT_GLU), 512, 512, j / 8, j % 8, smem);
    }
  }
}

DEV void phase_adaln0(const Params& p, const Ctx& cx) {
  const float* mods = (const float*)(p.ws + OFF_MODS);
  bf16_t* hbuf = (bf16_t*)(p.ws + OFF_H);
  int lane = cx.tid & 63;
  int gw = cx.bid * 8 + (cx.tid >> 6), nw = cx.nblk * 8;
  for (int row = gw; row < MTOT; row += nw) {
    const float* src = row < NLAT ? p.x + (size_t)row * D : p.ctx + (size_t)(row - NLAT) * D;
    int mr = row < NLAT ? (row >> 14) : 2;
    const float* md = mods + (size_t)mr * 6144;
    float4 v[8];
    float s = 0;
#pragma unroll
    for (int i = 0; i < 8; ++i) { v[i] = *(const float4*)(src + i * 256 + lane * 4); s += v[i].x + v[i].y + v[i].z + v[i].w; }
    float mu = wave_sum(s) * (1.f / 2048.f);
    float q = 0;
#pragma unroll
    for (int i = 0; i < 8; ++i) { v[i].x -= mu; v[i].y -= mu; v[i].z -= mu; v[i].w -= mu; q += v[i].x * v[i].x + v[i].y * v[i].y + v[i].z * v[i].z + v[i].w * v[i].w; }
    float rstd = rsqrtf(wave_sum(q) * (1.f / 2048.f) + 1e-6f);
#pragma unroll
    for (int i = 0; i < 8; ++i) {
      int col = i * 256 + lane * 4;
      float4 sh = *(const float4*)(md + col), sc = *(const float4*)(md + 2048 + col);
      uint2 o;
      o.x = pack_bf2(v[i].x * rstd * (1.f + sc.x) + sh.x, v[i].y * rstd * (1.f + sc.y) + sh.y);
      o.y = pack_bf2(v[i].z * rstd * (1.f + sc.z) + sh.z, v[i].w * rstd * (1.f + sc.w) + sh.w);
      *(uint2*)(hbuf + (size_t)row * D + col) = o;
    }
  }
}

DEV void phase_finln(const Params& p, const Ctx& cx, int l) {
  const float* mods = (const float*)(p.ws + OFF_MODS);
  bf16_t* hbuf = (bf16_t*)(p.ws + OFF_H);
  float* prec = (float*)(p.ws + OFF_PREC);
  int lane = cx.tid & 63;
  int gw = cx.bid * 8 + (cx.tid >> 6), nw = cx.nblk * 8;
  const int nrows = (l == 0) ? MTOT : NLAT;
  for (int row = gw; row < nrows; row += nw) {
    float* src = row < NLAT ? p.out + (size_t)row * D : prec + (size_t)(row - NLAT) * D;
    float4 v[8];
    float s = 0;
#pragma unroll
    for (int i = 0; i < 8; ++i) { v[i] = *(const float4*)(src + i * 256 + lane * 4); s += v[i].x + v[i].y + v[i].z + v[i].w; }
    float mu = wave_sum(s) * (1.f / 2048.f);
    float q = 0;
#pragma unroll
    for (int i = 0; i < 8; ++i) { v[i].x -= mu; v[i].y -= mu; v[i].z -= mu; v[i].w -= mu; q += v[i].x * v[i].x + v[i].y * v[i].y + v[i].z * v[i].z + v[i].w * v[i].w; }
    float rstd = rsqrtf(wave_sum(q) * (1.f / 2048.f) + 1e-5f);
    float s2 = 0;
#pragma unroll
    for (int i = 0; i < 8; ++i) {
      int col = i * 256 + lane * 4;
      float4 g = *(const float4*)(p.ln_g + (size_t)l * D + col), b = *(const float4*)(p.ln_b + (size_t)l * D + col);
      v[i].x = v[i].x * rstd * g.x + b.x; v[i].y = v[i].y * rstd * g.y + b.y; v[i].z = v[i].z * rstd * g.z + b.z; v[i].w = v[i].w * rstd * g.w + b.w;
      if (row < NLAT) *(float4*)(src + col) = v[i];
      s2 += v[i].x + v[i].y + v[i].z + v[i].w;
    }
    if (l == 0) {
      int mr = row < NLAT ? (row >> 14) : 2;
      const float* md = mods + (size_t)(3 + mr) * 6144;
      float mu2 = wave_sum(s2) * (1.f / 2048.f);
      float q2 = 0;
#pragma unroll
      for (int i = 0; i < 8; ++i) { v[i].x -= mu2; v[i].y -= mu2; v[i].z -= mu2; v[i].w -= mu2; q2 += v[i].x * v[i].x + v[i].y * v[i].y + v[i].z * v[i].z + v[i].w * v[i].w; }
      float rstd2 = rsqrtf(wave_sum(q2) * (1.f / 2048.f) + 1e-6f);
#pragma unroll
      for (int i = 0; i < 8; ++i) {
        int col = i * 256 + lane * 4;
        float4 sh = *(const float4*)(md + col), sc = *(const float4*)(md + 2048 + col);
        uint2 o;
        o.x = pack_bf2(v[i].x * rstd2 * (1.f + sc.x) + sh.x, v[i].y * rstd2 * (1.f + sc.y) + sh.y);
        o.y = pack_bf2(v[i].z * rstd2 * (1.f + sc.z) + sh.z, v[i].w * rstd2 * (1.f + sc.w) + sh.w);
        *(uint2*)(hbuf + (size_t)row * D + col) = o;
      }
    }
  }
}

template <class Epi>
DEV void gemm_phase(const Params& p, const Ctx& cx, const bf16_t* __restrict__ A, const bf16_t* __restrict__ Bt, int K, int nM, int nN, char* smem, Epi epi) {
  const int tid = cx.tid, lane = tid & 63, wid = tid >> 6;
  const int wr = wid >> 2, wc = wid & 3, fr = lane & 15, fq = lane >> 4;
  const int nt = K / 64;
  const int ntiles = nM * nN;
  const int srow = tid >> 3, sc16 = tid & 7;
  for (int tile = cx.bid; tile < ntiles; tile += cx.nblk) {
    const int pm = tile / nN, pn = tile % nN;
    const int brow = pm * 256, bcol = pn * 256;
    const char* Ab = (const char*)(A + (size_t)brow * K);
    const char* Bb = (const char*)(Bt + (size_t)bcol * K);
    const unsigned voff = (unsigned)(srow * K + sc16 * 8) * 2u;
    const size_t rs = (size_t)64 * K * 2;
    f32x4 acc[8][4];
#pragma unroll
    for (int i = 0; i < 8; ++i)
#pragma unroll
      for (int j = 0; j < 4; ++j) acc[i][j] = f32x4{0.f, 0.f, 0.f, 0.f};
    uint4 ra0, ra1, ra2, ra3, rb0, rb1, rb2, rb3;
#define G_LD(ko) { const char* a_ = Ab + (size_t)(ko) * 2; const char* b_ = Bb + (size_t)(ko) * 2; \
                 ra0 = *(const uint4*)(a_ + voff); ra1 = *(const uint4*)(a_ + rs + voff); ra2 = *(const uint4*)(a_ + 2 * rs + voff); ra3 = *(const uint4*)(a_ + 3 * rs + voff); \
                 rb0 = *(const uint4*)(b_ + voff); rb1 = *(const uint4*)(b_ + rs + voff); rb2 = *(const uint4*)(b_ + 2 * rs + voff); rb3 = *(const uint4*)(b_ + 3 * rs + voff); }
#define G_ST(sp) { *(uint4*)(sp) = ra0; *(uint4*)((sp) + 64 * 144) = ra1; *(uint4*)((sp) + 128 * 144) = ra2; *(uint4*)((sp) + 192 * 144) = ra3; \
                 *(uint4*)((sp) + 36864) = rb0; *(uint4*)((sp) + 36864 + 64 * 144) = rb1; *(uint4*)((sp) + 36864 + 128 * 144) = rb2; *(uint4*)((sp) + 36864 + 192 * 144) = rb3; }
    char* const sbase = smem + srow * 144 + sc16 * 16;
    G_LD(0);
    G_ST(sbase);
    if (nt > 1) G_LD(64);
    for (int kt = 0; kt < nt; ++kt) {
      __syncthreads();
      if (kt + 1 < nt) { char* s1 = sbase + ((kt + 1) & 1) * 73728; G_ST(s1); }
      if (kt + 2 < nt) G_LD((kt + 2) * 64);
      const char* As = smem + (kt & 1) * 73728;
      const char* Bs = As + 36864;
#pragma unroll
      for (int kh = 0; kh < 2; ++kh) {
        bf16x8 bfr[4];
#pragma unroll
        for (int jn = 0; jn < 4; ++jn) bfr[jn] = *(const bf16x8*)(Bs + (wc * 64 + jn * 16 + fr) * 144 + kh * 64 + fq * 16);
#pragma unroll
        for (int i = 0; i < 8; ++i) {
          bf16x8 af = *(const bf16x8*)(As + (wr * 128 + i * 16 + fr) * 144 + kh * 64 + fq * 16);
#pragma unroll
          for (int jn = 0; jn < 4; ++jn) acc[i][jn] = __builtin_amdgcn_mfma_f32_16x16x32_f16(bfr[jn], af, acc[i][jn], 0, 0, 0);
        }
      }
    }
    __syncthreads();
#pragma unroll
    for (int i = 0; i < 8; ++i)
#pragma unroll
      for (int jn = 0; jn < 4; ++jn) epi(brow + wr * 128 + i * 16 + fr, bcol + wc * 64 + jn * 16 + fq * 4, acc[i][jn]);
  }
}

template <int K, int NT, class Epi>
DEV void small_gemm(const Params& p, const Ctx& cx, const char* As, int astride, const bf16_t* __restrict__ Bt, int n0, Epi epi) {
  const int lane = cx.tid & 63, fr = lane & 15, fq = lane >> 4;
  f32x4 acc[4][NT];
#pragma unroll
  for (int i = 0; i < 4; ++i)
#pragma unroll
    for (int j = 0; j < NT; ++j) acc[i][j] = f32x4{0.f, 0.f, 0.f, 0.f};
#pragma unroll 2
  for (int k0 = 0; k0 < K; k0 += 32) {
    bf16x8 af[4];
#pragma unroll
    for (int i = 0; i < 4; ++i) af[i] = *(const bf16x8*)(As + (i * 16 + fr) * astride + (k0 + fq * 8) * 2);
#pragma unroll
    for (int jn = 0; jn < NT; ++jn) {
      bf16x8 bf = *(const bf16x8*)(Bt + (size_t)(n0 + jn * 16 + fr) * K + k0 + fq * 8);
#pragma unroll
      for (int i = 0; i < 4; ++i) acc[i][jn] = __builtin_amdgcn_mfma_f32_16x16x32_f16(bf, af[i], acc[i][jn], 0, 0, 0);
    }
  }
#pragma unroll
  for (int i = 0; i < 4; ++i)
#pragma unroll
    for (int jn = 0; jn < NT; ++jn) epi(i * 16 + fr, n0 + jn * 16 + fq * 4, acc[i][jn]);
}

struct S5P { float ar, ai, br, bi; };
DEV S5P s5_params(const Params& p, const Ctx& cx, int l, int d, int g, int lane) {
  int idx = ((l * 2 + d) * 32 + g) * 64 + lane;
  float lr = fminf(p.s5_lam_re[idx], -1e-4f), li = p.s5_lam_im[idx];
  float step = expf(p.s5_log_step[(l * 2 + d) * 32 + g]);
  float xr = lr * step, xi = li * step;
  float e = expf(xr), cs = cosf(xi), sn = sinf(xi);
  S5P r;
  r.ar = e * cs; r.ai = e * sn;
  float sh = sinf(0.5f * xi);
  float nr = expm1f(xr) * cs - 2.f * sh * sh, ni = e * sn;
  float inv = 1.f / (lr * lr + li * li);
  r.br = (nr * lr + ni * li) * inv;
  r.bi = (ni * lr - nr * li) * inv;
  return r;
}

DEV void s5_load_u(const h16* zrest, int rowbase, int g, char* ulds, int lane) {
#pragma unroll
  for (int i = 0; i < 8; ++i) {
    int e = i * 64 + lane;
    int r = e >> 1, hf = e & 1;
    uint4 v = *(const uint4*)(zrest + (size_t)(rowbase + r) * ZR + g * 16 + hf * 8);
    *(uint4*)(ulds + r * 32 + hf * 16) = v;
  }
  lds_fence();
}

DEV int s5_rowbase(int b, int c) { return c == 0 ? NLAT + b * 256 : b * 16384 + (c - 1) * 256; }

DEV void s5_pass1_unit(const Params& p, const Ctx& cx, int l, int unit, char* wl, int lane) {
  int c = unit % 65, bg = unit / 65, g = bg & 31, b = bg >> 5;
  const h16* zrest = (const h16*)(p.ws + OFF_ZREST);
  float2* F = (float2*)(p.ws + OFF_S5F);
  s5_load_u(zrest, s5_rowbase(b, c), g, wl, lane);
  float Br[16], Bi[16];
  {
    const float* pr = p.s5_b_re + ((size_t)(l * 32 + g) * 64 + lane) * 16;
    const float* pi = p.s5_b_im + ((size_t)(l * 32 + g) * 64 + lane) * 16;
#pragma unroll
    for (int i = 0; i < 16; i += 4) {
      float4 a = *(const float4*)(pr + i), bq = *(const float4*)(pi + i);
      Br[i] = a.x; Br[i + 1] = a.y; Br[i + 2] = a.z; Br[i + 3] = a.w;
      Bi[i] = bq.x; Bi[i + 1] = bq.y; Bi[i + 2] = bq.z; Bi[i + 3] = bq.w;
    }
  }
  S5P pf = s5_params(p, cx, l, 0, g, lane), pb = s5_params(p, cx, l, 1, g, lane);
  float xr = 0, xi = 0, yr = 0, yi = 0, pwr = 1.f, pwi = 0.f;
#pragma unroll 4
  for (int t = 0; t < 256; ++t) {
    h16x8 u0 = *(const h16x8*)(wl + t * 32), u1 = *(const h16x8*)(wl + t * 32 + 16);
    float br = 0, bi = 0;
#pragma unroll
    for (int i = 0; i < 8; ++i) { float u = (float)u0[i]; br = fmaf(u, Br[i], br); bi = fmaf(u, Bi[i], bi); }
#pragma unroll
    for (int i = 0; i < 8; ++i) { float u = (float)u1[i]; br = fmaf(u, Br[8 + i], br); bi = fmaf(u, Bi[8 + i], bi); }
    float vr = pf.br * br - pf.bi * bi, vi = pf.br * bi + pf.bi * br;
    float nxr = pf.ar * xr - pf.ai * xi + vr, nxi = pf.ar * xi + pf.ai * xr + vi;
    xr = nxr; xi = nxi;
    float wr_ = pb.br * br - pb.bi * bi, wi_ = pb.br * bi + pb.bi * br;
    yr += pwr * wr_ - pwi * wi_; yi += pwr * wi_ + pwi * wr_;
    float npr = pwr * pb.ar - pwi * pb.ai, npi = pwr * pb.ai + pwi * pb.ar;
    pwr = npr; pwi = npi;
  }
  size_t fi = (((size_t)(b * 32 + g) * 65 + c) * 2) * 64 + lane;
  F[fi] = make_float2(xr, xi);
  F[fi + 64] = make_float2(yr, yi);
}

DEV void s5_pass3_unit(const Params& p, const Ctx& cx, int l, int unit, char* wl, int lane) {
  int c = unit % 65, bg = unit / 65, g = bg & 31, b = bg >> 5;
  const int fr = lane & 15, fq = lane >> 4;
  const h16* zrest = (const h16*)(p.ws + OFF_ZREST);
  const float2* F = (const float2*)(p.ws + OFF_S5F);
  float* S5Y = (float*)(p.ws + OFF_S5Y);
  const int rowbase = s5_rowbase(b, c);
  char* ulds = wl;
  char* tile = wl + 8192;
  s5_load_u(zrest, rowbase, g, ulds, lane);
  float Br[16], Bi[16];
  {
    const float* pr = p.s5_b_re + ((size_t)(l * 32 + g) * 64 + lane) * 16;
    const float* pi = p.s5_b_im + ((size_t)(l * 32 + g) * 64 + lane) * 16;
#pragma unroll
    for (int i = 0; i < 16; i += 4) {
      float4 a = *(const float4*)(pr + i), bq = *(const float4*)(pi + i);
      Br[i] = a.x; Br[i + 1] = a.y; Br[i + 2] = a.z; Br[i + 3] = a.w;
      Bi[i] = bq.x; Bi[i + 1] = bq.y; Bi[i + 2] = bq.z; Bi[i + 3] = bq.w;
    }
  }
  const float dsk = p.s5_d[(size_t)l * 512 + g * 16 + fr];
  const size_t fbase = ((size_t)(b * 32 + g) * 65) * 2 * 64 + lane;
#pragma unroll 1
  for (int d = 0; d < 2; ++d) {
    S5P pp = s5_params(p, cx, l, d, g, lane);
    float qr = pp.ar, qi = pp.ai;
#pragma unroll
    for (int i = 0; i < 8; ++i) { float t = qr * qr - qi * qi; qi = 2.f * qr * qi; qr = t; }
    float xr = 0, xi = 0;
    if (d == 0) {
      for (int cc = 0; cc < c; ++cc) {
        float2 f = F[fbase + (size_t)(cc * 2 + 0) * 64];
        float t = qr * xr - qi * xi + f.x; xi = qr * xi + qi * xr + f.y; xr = t;
      }
    } else if (c > 0) {
      float2 f0 = F[fbase + (size_t)(0 * 2 + 1) * 64];
      xr = f0.x; xi = f0.y;
      for (int cc = 64; cc > c; --cc) {
        float2 f = F[fbase + (size_t)(cc * 2 + 1) * 64];
        float t = qr * xr - qi * xi + f.x; xi = qr * xi + qi * xr + f.y; xr = t;
      }
    }
    bf16x8 chi[4], clo[4];
    {
      const float* cr = p.s5_c_re + ((size_t)((l * 2 + d) * 32 + g) * 16 + fr) * 64;
      const float* ci = p.s5_c_im + ((size_t)((l * 2 + d) * 32 + g) * 16 + fr) * 64;
#pragma unroll
      for (int ks = 0; ks < 4; ++ks) {
        float4 a = *(const float4*)(cr + ks * 16 + fq * 4), bq = *(const float4*)(ci + ks * 16 + fq * 4);
        float vals[8] = {a.x, -bq.x, a.y, -bq.y, a.z, -bq.z, a.w, -bq.w};
#pragma unroll
        for (int j = 0; j < 8; ++j) {
          h16 hh = (h16)vals[j];
          chi[ks][j] = hh;
          clo[ks][j] = (h16)(vals[j] - (float)hh);
        }
      }
    }
#pragma unroll 1
    for (int sb = 0; sb < 16; ++sb) {
      const int sub = d == 0 ? sb : 15 - sb;
#pragma unroll 4
      for (int q = 0; q < 16; ++q) {
        const int tt = d == 0 ? q : 15 - q;
        const int t = sub * 16 + tt;
        h16x8 u0 = *(const h16x8*)(ulds + t * 32), u1 = *(const h16x8*)(ulds + t * 32 + 16);
        float br = 0, bi = 0;
#pragma unroll
        for (int i = 0; i < 8; ++i) { float u = (float)u0[i]; br = fmaf(u, Br[i], br); bi = fmaf(u, Bi[i], bi); }
#pragma unroll
        for (int i = 0; i < 8; ++i) { float u = (float)u1[i]; br = fmaf(u, Br[8 + i], br); bi = fmaf(u, Bi[8 + i], bi); }
        float vr = pp.br * br - pp.bi * bi, vi = pp.br * bi + pp.bi * br;
        float nxr = pp.ar * xr - pp.ai * xi + vr, nxi = pp.ar * xi + pp.ai * xr + vi;
        xr = nxr; xi = nxi;
        h16x2 hv2 = {(h16)xr, (h16)xi};
        float lr_ = xr - (float)hv2[0], li_ = xi - (float)hv2[1];
        *(unsigned*)(tile + tt * 272 + lane * 4) = __builtin_bit_cast(unsigned, hv2);
        *(unsigned*)(tile + 4352 + tt * 272 + lane * 4) = pack_bf2(lr_, li_);
      }
      lds_fence();
      f32x4 acc = f32x4{0.f, 0.f, 0.f, 0.f};
#pragma unroll
      for (int ks = 0; ks < 4; ++ks) {
        bf16x8 ah = *(const bf16x8*)(tile + fr * 272 + ks * 64 + fq * 16);
        bf16x8 alo = *(const bf16x8*)(tile + 4352 + fr * 272 + ks * 64 + fq * 16);
        acc = __builtin_amdgcn_mfma_f32_16x16x32_f16(ah, chi[ks], acc, 0, 0, 0);
        acc = __builtin_amdgcn_mfma_f32_16x16x32_f16(alo, chi[ks], acc, 0, 0, 0);
        acc = __builtin_amdgcn_mfma_f32_16x16x32_f16(ah, clo[ks], acc, 0, 0, 0);
      }
      lds_fence();
#pragma unroll
      for (int r = 0; r < 4; ++r) {
        int tl = sub * 16 + fq * 4 + r;
        float* yp = S5Y + (size_t)(rowbase + tl) * 512 + g * 16 + fr;
        if (d == 0) {
          float u = (float)*(const h16*)(ulds + tl * 32 + fr * 2);
          *yp = acc[r] + dsk * u;
        } else {
          *yp = gelu_f(*yp + acc[r]);
        }
      }
    }
  }
}

DEV void prep_item(const Params& p, const Ctx& cx, int l, int item, char* smem) {
  const int tile = item >> 2, q = item & 3;
  const int row0 = tile * 64;
  const int tid = cx.tid;
  const h16* zc = (const h16*)(p.ws + OFF_REG2);
  h16* SC = (h16*)(p.ws + OFF_SCAN);
  const char* wt = p.ws + OFF_WT + (size_t)l * WT_SIZE;
  {
    const int d = q >> 1, isA = q & 1;
    const int coff = isA ? 3200 + d * 64 : 3072 + d * 64;
    int tok = tid >> 3, c8 = tid & 7;
    h16x8 cv = *(const h16x8*)(zc + (size_t)(row0 + tok) * ZC + coff + c8 * 8);
    float f[8];
#pragma unroll
    for (int j = 0; j < 8; ++j) { f[j] = (float)cv[j]; if (!isA) f[j] = tanh_f(f[j]); }
    uint4 o;
    o.x = pack_bf2(f[0], f[1]); o.y = pack_bf2(f[2], f[3]); o.z = pack_bf2(f[4], f[5]); o.w = pack_bf2(f[6], f[7]);
    *(uint4*)(smem + tok * 144 + c8 * 16) = o;
    __syncthreads();
    const bf16_t* Bt = (const bf16_t*)(wt + (isA ? WT_A2 : WT_W2)) + (size_t)d * 1024 * 64;
    const float* biasw = p.rwkv_w0 + (size_t)(l * 2 + d) * 1024;
    const float* biasa = p.rwkv_a0 + (size_t)(l * 2 + d) * 1024;
    h16* dst = SC + (size_t)(isA ? 4 + d : 6 + d) * ARR;
#pragma unroll 1
    for (int hf = 0; hf < 2; ++hf) small_gemm<64, 4>(p, cx, smem, 144, Bt, (tid >> 6) * 128 + hf * 64, [&](int m, int n, f32x4 v) {
      float4 bbw = *(const float4*)(biasw + n), bba = *(const float4*)(biasa + n);
      float4 bb = isA ? bba : bbw;
      float r0 = sigmoid_f(v[0] + bb.x), r1 = sigmoid_f(v[1] + bb.y), r2 = sigmoid_f(v[2] + bb.z), r3 = sigmoid_f(v[3] + bb.w);
      if (!isA) { r0 = __expf(-DECAY_SCALE * r0); r1 = __expf(-DECAY_SCALE * r1); r2 = __expf(-DECAY_SCALE * r2); r3 = __expf(-DECAY_SCALE * r3); }
      h16x4 o4 = {(h16)r0, (h16)r1, (h16)r2, (h16)r3};
      *(h16x4*)(dst + (size_t)(row0 + m) * 1024 + n) = o4;
    });
  }
  {
    const float* cw = p.conv_rkv + (size_t)l * 3 * 3072;
#pragma unroll 1
    for (int it = 0; it < 4; ++it) {
      int idx = tid + it * 512;
      int grp = idx & 7, hh = (idx >> 3) & 3, tok = idx >> 5;
      int row = row0 + tok;
      int c0 = (4 * q + hh) * 64 + grp * 8;
      bool hasp, hasn;
      if (row < NLAT) { hasp = (row & 16383) != 0; hasn = (row & 16383) != 16383; }
      else { hasp = (row & 255) != 0; hasn = (row & 255) != 255; }
      size_t off = (size_t)row * 1024 + c0;
      float kv[8];
#pragma unroll 1
      for (int s = 0; s < 3; ++s) {
        int ch = s * 1024 + c0;
        const h16* zp = zc + (size_t)row * ZC + ch;
        h16x8 cur = *(const h16x8*)zp;
        h16x8 prv = cur, nxt = cur;
        if (hasp) prv = *(const h16x8*)(zp - ZC);
        if (hasn) nxt = *(const h16x8*)(zp + ZC);
        float ov[8];
#pragma unroll
        for (int j = 0; j < 8; j += 4) {
          float4 a = *(const float4*)(cw + ch + j), bq = *(const float4*)(cw + 3072 + ch + j), cq = *(const float4*)(cw + 6144 + ch + j);
          float w0[4] = {a.x, a.y, a.z, a.w}, w1[4] = {bq.x, bq.y, bq.z, bq.w}, w2[4] = {cq.x, cq.y, cq.z, cq.w};
#pragma unroll
          for (int jj = 0; jj < 4; ++jj) {
            float pv = hasp ? (float)prv[j + jj] : 0.f, nv = hasn ? (float)nxt[j + jj] : 0.f;
            ov[j + jj] = w0[jj] * pv + w1[jj] * (float)cur[j + jj] + w2[jj] * nv;
          }
        }
        h16x8 o;
#pragma unroll
        for (int j = 0; j < 8; ++j) o[j] = (h16)ov[j];
        *(h16x8*)(SC + (size_t)s * ARR + off) = o;
        if (s == 1) {
#pragma unroll
          for (int j = 0; j < 8; ++j) kv[j] = ov[j];
        }
      }
      float kk[8], ss = 0;
#pragma unroll
      for (int j = 0; j < 8; j += 4) {
        float4 kq = *(const float4*)(p.rwkv_k_k + (size_t)l * 1024 + c0 + j);
        kk[j] = kv[j] * kq.x; kk[j + 1] = kv[j + 1] * kq.y; kk[j + 2] = kv[j + 2] * kq.z; kk[j + 3] = kv[j + 3] * kq.w;
      }
#pragma unroll
      for (int j = 0; j < 8; ++j) ss += kk[j] * kk[j];
      ss = allreduce8(ss);
      float inv = 1.f / fmaxf(sqrtf(ss), 1e-12f);
      h16x8 o;
#pragma unroll
      for (int j = 0; j < 8; ++j) o[j] = (h16)(kk[j] * inv);
      *(h16x8*)(SC + 3 * ARR + off) = o;
    }
  }
}

DEV void phase_prep(const Params& p, const Ctx& cx0, int l, char* smem) {
  const int NPREP = 520 * 4, NS5 = 520;
  const Ctx& cx_ = cx0;
  for (int item = cx_.bid; item < NPREP + NS5; item += cx_.nblk) {
    __syncthreads();
    Ctx cx = cx0; asm volatile("" : "+v"(cx.tid));
    const int lane = cx.tid & 63, wid = cx.tid >> 6;
#ifndef NO_PREPITEM
    if (item < NPREP) prep_item(p, cx, l, item, smem);
    else
#endif
#ifndef NO_S5P1
      s5_pass1_unit(p, cx, l, (item - NPREP) * 8 + wid, smem + wid * 8192, lane);
#else
    {}
#endif
  }
}

struct RIn { h16x4 w, a, kk, k, r; h16 v; };

DEV void rwkv_task(const Params& p, const Ctx& cx, int l, int task, int lane) {
  const int unit = task >> 4, d = unit & 1, h = (unit >> 1) & 15, b = unit >> 5;
  const int j = lane >> 4, s = lane & 15;
  const int myrow = (task & 15) * 4 + j;
  const h16* SC = (const h16*)(p.ws + OFF_SCAN);
  const char* pR = (const char*)(SC + 0 * ARR + h * 64);
  const char* pK = (const char*)(SC + 1 * ARR + h * 64);
  const char* pV = (const char*)(SC + 2 * ARR + h * 64);
  const char* pKK = (const char*)(SC + 3 * ARR + h * 64);
  const char* pA = (const char*)(SC + (size_t)(4 + d) * ARR + h * 64);
  const char* pW = (const char*)(SC + (size_t)(6 + d) * ARR + h * 64);
  char* pO = (char*)((h16*)(p.ws + OFF_REG2) + (size_t)d * ARR + h * 64);
  const unsigned vo0 = (unsigned)(s * 8);
  const unsigned vov0 = (unsigned)(myrow * 2);
  float ka[4], omka[4];
  {
    float4 t = *(const float4*)(p.rwkv_k_a + (size_t)l * 1024 + h * 64 + 4 * s);
    ka[0] = t.x; ka[1] = t.y; ka[2] = t.z; ka[3] = t.w;
#pragma unroll
    for (int i = 0; i < 4; ++i) omka[i] = 1.f - ka[i];
  }
  float S[4] = {0.f, 0.f, 0.f, 0.f};
  constexpr int U = 4, NG = 16640 / U;
  RIn b0[U], b1[U], b2[U];
  static_assert((NG - 2) % 3 == 0, "ring");

#define RW_ROW0(gq, row0, stp)                                                     \
  {                                                                                \
    const int q0 = (gq) * U;                                                       \
    const int isl = q0 >= 256;                                                     \
    const int base_ = isl ? b * 16384 : NLAT + b * 256;                            \
    const int t0_ = isl ? q0 - 256 : q0;                                           \
    const int last_ = isl ? 16383 : 255;                                           \
    row0 = base_ + (d ? last_ - t0_ : t0_);                                        \
    stp = d ? -1 : 1;                                                              \
  }
#define RW_LOAD(buf, gq)                                                           \
  {                                                                                \
    int row0, stp; RW_ROW0(gq, row0, stp);                                         \
    unsigned vo = vo0, vov = vov0; asm volatile("" : "+v"(vo), "+v"(vov));         \
    _Pragma("unroll") for (int u = 0; u < U; ++u) {                                \
      size_t off = (size_t)(row0 + u * stp) * 2048;                                \
      buf[u].w = *(const h16x4*)(pW + off + vo); buf[u].a = *(const h16x4*)(pA + off + vo);  \
      buf[u].kk = *(const h16x4*)(pKK + off + vo); buf[u].k = *(const h16x4*)(pK + off + vo);\
      buf[u].r = *(const h16x4*)(pR + off + vo); buf[u].v = *(const h16*)(pV + off + vov);   \
    }                                                                              \
  }
#define RW_COMPUTE(buf, gq)                                                        \
  {                                                                                \
    int row0, stp; RW_ROW0(gq, row0, stp);                                         \
    float dres[U];                                                                 \
    _Pragma("unroll") for (int u = 0; u < U; ++u) {                                \
      float vj = (float)buf[u].v;                                                  \
      float kka[4], vk[4], pd[4];                                                  \
      _Pragma("unroll") for (int i = 0; i < 4; ++i) {                              \
        float a_ = (float)buf[u].a[i], kk_ = (float)buf[u].kk[i], k_ = (float)buf[u].k[i]; \
        kka[i] = kk_ * a_;                                                         \
        vk[i] = vj * (k_ * fmaf(a_, ka[i], omka[i]));                              \
        pd[i] = S[i] * kk_;                                                        \
      }                                                                            \
      float d1 = allreduce16((pd[0] + pd[1]) + (pd[2] + pd[3]));                   \
      float pe[4];                                                                 \
      _Pragma("unroll") for (int i = 0; i < 4; ++i) {                              \
        S[i] = fmaf(-d1, kka[i], fmaf(S[i], (float)buf[u].w[i], vk[i]));           \
        pe[i] = S[i] * (float)buf[u].r[i];                                         \
      }                                                                            \
      dres[u] = allreduce16((pe[0] + pe[1]) + (pe[2] + pe[3]));                    \
    }                                                                              \
    {                                                                              \
      const int su = s & 3;                                                        \
      unsigned vov = vov0; asm volatile("" : "+v"(vov));                           \
      float val = su == 0 ? dres[0] : (su == 1 ? dres[1] : (su == 2 ? dres[2] : dres[3])); \
      *(h16*)(pO + (size_t)(row0 + su * stp) * 2048 + vov) = (h16)val;             \
    }                                                                              \
  }

  RW_LOAD(b0, 0); RW_LOAD(b1, 1);
#pragma unroll 1
  for (int g = 0; g < NG - 2; g += 3) {
    RW_LOAD(b2, g + 2);
    __builtin_amdgcn_sched_barrier(0);
    RW_COMPUTE(b0, g);
    __builtin_amdgcn_sched_barrier(0);
    RW_LOAD(b0, g + 3);
    __builtin_amdgcn_sched_barrier(0);
    RW_COMPUTE(b1, g + 1);
    __builtin_amdgcn_sched_barrier(0);
    RW_LOAD(b1, g + 4);
    __builtin_amdgcn_sched_barrier(0);
    RW_COMPUTE(b2, g + 2);
    __builtin_amdgcn_sched_barrier(0);
  }
  RW_COMPUTE(b0, NG - 2);
  RW_COMPUTE(b1, NG - 1);
#undef RW_ROW0
#undef RW_LOAD
#undef RW_COMPUTE
}

DEV void phase_scan(const Params& p, const Ctx& cx, int l, char* smem) {
  const int lane = cx.tid & 63, wid = __builtin_amdgcn_readfirstlane(cx.tid >> 6);
  char* wl = smem + wid * 17408;
  const int NS5U = 2 * 32 * 65;
  if (wid < 4) {
    for (int slot = cx.bid; slot < 256; slot += cx.nblk) {
      const int task = ((slot & 63) << 4) | ((slot >> 6) << 2) | wid;
#ifndef NO_RWKV
      rwkv_task(p, cx, l, task, lane);
#endif
    }
  } else {
    for (int u = cx.bid * 4 + (wid - 4); u < NS5U; u += cx.nblk * 4) {
      if (l == 1 && (u % 65) == 0) continue;
#ifndef NO_S5P3
      s5_pass3_unit(p, cx, l, u, wl, lane);
#endif
    }
  }
}

DEV void pool_item(const Params& p, const Ctx& cx, int l, int item, char* smem) {
  const int tid = cx.tid;
  const h16* zrest = (const h16*)(p.ws + OFF_ZREST);
  bf16_t* ym = (bf16_t*)(p.ws + OFF_YM);
  const char* wt = p.ws + OFF_WT + (size_t)l * WT_SIZE;
  float* V = (float*)smem;
  char* At = smem + 43008;
  int g, rowout0, Lseq, p0, rlo, rhi, rstride, rowsrc0;
  if (item < 2048) {
    g = item & 3; int r = (item >> 2) & 255, b = item >> 10;
    int w = 2 << g;
    rlo = max(r - w / 2, 0); rhi = min(r + w / 2 - 1, 255);
    rowsrc0 = b * 16384; rstride = 64;
    rowout0 = b * 16384 + r * 64; Lseq = 64; p0 = 0;
  } else {
    int it = item - 2048;
    g = it & 3; int tq = (it >> 2) & 3, b = it >> 4;
    rlo = 0; rhi = 0; rowsrc0 = NLAT + b * 256; rstride = 0;
    rowout0 = NLAT + b * 256 + tq * 64; Lseq = 256; p0 = tq * 64;
  }
  const int w = 2 << g;
  const float invr = 1.f / (float)(rhi - rlo + 1);
  for (int unit = tid; unit < 80 * 16; unit += NTHREADS) {
    int lp = unit >> 4, ch8 = unit & 15;
    int pos = p0 - 8 + lp;
    float acc[8] = {0, 0, 0, 0, 0, 0, 0, 0};
    if (pos >= 0 && pos < Lseq) {
      for (int rr = rlo; rr <= rhi; ++rr) {
        h16x8 v = *(const h16x8*)(zrest + (size_t)(rowsrc0 + rr * rstride + pos) * ZR + 1024 + g * 128 + ch8 * 8);
#pragma unroll
        for (int j = 0; j < 8; ++j) acc[j] += (float)v[j];
      }
    }
    float* vp = V + lp * 132 + ch8 * 8;
#pragma unroll
    for (int j = 0; j < 8; ++j) vp[j] = acc[j] * invr;
  }
  __syncthreads();
  for (int unit = tid; unit < 64 * 16; unit += NTHREADS) {
    int c = unit >> 4, ch8 = unit & 15;
    int pos = p0 + c;
    int lo = max(pos - w / 2, 0), hi = min(pos + w / 2 - 1, Lseq - 1);
    float acc[8] = {0, 0, 0, 0, 0, 0, 0, 0};
    for (int pp = lo; pp <= hi; ++pp) {
      const float* vp = V + (pp - p0 + 8) * 132 + ch8 * 8;
#pragma unroll
      for (int j = 0; j < 8; ++j) acc[j] += vp[j];
    }
    float invc = 1.f / (float)(hi - lo + 1);
    h16x8 uc = *(const h16x8*)(zrest + (size_t)(rowout0 + c) * ZR + 1024 + g * 128 + ch8 * 8);
    uint4 o;
    o.x = pack_bf2(acc[0] * invc - (float)uc[0], acc[1] * invc - (float)uc[1]);
    o.y = pack_bf2(acc[2] * invc - (float)uc[2], acc[3] * invc - (float)uc[3]);
    o.z = pack_bf2(acc[4] * invc - (float)uc[4], acc[5] * invc - (float)uc[5]);
    o.w = pack_bf2(acc[6] * invc - (float)uc[6], acc[7] * invc - (float)uc[7]);
    *(uint4*)(At + c * 272 + ch8 * 16) = o;
  }
  __syncthreads();
  const bf16_t* Bt = (const bf16_t*)(wt + WT_POOL) + (size_t)g * 128 * 128;
  const float* ps = p.pool_scale + (size_t)l * 512 + g * 128;
  small_gemm<128, 1>(p, cx, At, 272, Bt, (tid >> 6) * 16, [&](int m, int n, f32x4 v) {
    int row = rowout0 + m;
    float4 sc = *(const float4*)(ps + n);
    h16x4 gt = *(const h16x4*)(zrest + (size_t)row * ZR + 1536 + g * 128 + n);
    uint2 o;
    o.x = pack_bf2(v[0] * sc.x * silu_f((float)gt[0]), v[1] * sc.y * silu_f((float)gt[1]));
    o.y = pack_bf2(v[2] * sc.z * silu_f((float)gt[2]), v[3] * sc.w * silu_f((float)gt[3]));
    *(uint2*)(ym + (size_t)row * D + 512 + g * 128 + n) = o;
  });
}

DEV void glu_item(const Params& p, const Ctx& cx, int l, int tile, char* smem) {
  const int tid = cx.tid;
  const int row0 = tile * 64;
  const float* S5Y = (const float*)(p.ws + OFF_S5Y);
  const h16* zrest = (const h16*)(p.ws + OFF_ZREST);
  bf16_t* ym = (bf16_t*)(p.ws + OFF_YM);
  const char* wt = p.ws + OFF_WT + (size_t)l * WT_SIZE;
#pragma unroll
  for (int it = 0; it < 8; ++it) {
    int unit = tid + it * NTHREADS;
    int r = unit >> 6, c8 = unit & 63;
    const float* sp = S5Y + (size_t)(row0 + r) * 512 + c8 * 8;
    float4 a = *(const float4*)sp, bq = *(const float4*)(sp + 4);
    uint4 o;
    o.x = pack_bf2(a.x, a.y); o.y = pack_bf2(a.z, a.w); o.z = pack_bf2(bq.x, bq.y); o.w = pack_bf2(bq.z, bq.w);
    *(uint4*)(smem + r * 1040 + c8 * 16) = o;
  }
  __syncthreads();
  const bf16_t* Bt = (const bf16_t*)(wt + WT_GLU);
  const float* bg = p.b_glu + (size_t)l * 512;
  small_gemm<512, 4>(p, cx, smem, 1040, Bt, (tid >> 6) * 64, [&](int m, int n, f32x4 v) {
    int row = row0 + m;
    float4 y = *(const float4*)(S5Y + (size_t)row * 512 + n);
    float4 bb = *(const float4*)(bg + n);
    h16x4 gt = *(const h16x4*)(zrest + (size_t)row * ZR + 512 + n);
    uint2 o;
    o.x = pack_bf2(y.x * sigmoid_f(v[0] + bb.x) * silu_f((float)gt[0]), y.y * sigmoid_f(v[1] + bb.y) * silu_f((float)gt[1]));
    o.y = pack_bf2(y.z * sigmoid_f(v[2] + bb.z) * silu_f((float)gt[2]), y.w * sigmoid_f(v[3] + bb.w) * silu_f((float)gt[3]));
    *(uint2*)(ym + (size_t)row * D + n) = o;
  });
}

DEV void rwkvmerge_item(const Params& p, const Ctx& cx, int l, int tile) {
  const int tid = cx.tid;
  const int row0 = tile * 64;
  const h16* SC = (const h16*)(p.ws + OFF_SCAN);
  const h16* O = (const h16*)(p.ws + OFF_REG2);
  const h16* zrest = (const h16*)(p.ws + OFF_ZREST);
  bf16_t* ym = (bf16_t*)(p.ws + OFF_YM);
#pragma unroll 1
  for (int it = 0; it < 16; ++it) {
    int idx = tid + it * NTHREADS;
    int grp = idx & 7, h = (idx >> 3) & 15, tok = idx >> 7;
    int row = row0 + tok;
    int c0 = h * 64 + grp * 8;
    size_t off = (size_t)row * 1024 + c0;
    h16x8 of = *(const h16x8*)(O + off), ob = *(const h16x8*)(O + ARR + off);
    float o[8], sm = 0;
#pragma unroll
    for (int j = 0; j < 8; ++j) { o[j] = (float)of[j] + (float)ob[j]; sm += o[j]; }
    sm = allreduce8(sm);
    float mu = sm * (1.f / 64.f), vq = 0;
#pragma unroll
    for (int j = 0; j < 8; ++j) { o[j] -= mu; vq += o[j] * o[j]; }
    vq = allreduce8(vq);
    float rstd = rsqrtf(vq * (1.f / 64.f) + 64e-5f);
    h16x8 r8 = *(const h16x8*)(SC + 0 * ARR + off), k8 = *(const h16x8*)(SC + 1 * ARR + off), v8 = *(const h16x8*)(SC + 2 * ARR + off);
    h16x8 af = *(const h16x8*)(SC + 4 * ARR + off), ab = *(const h16x8*)(SC + 5 * ARR + off);
    float pk[8], rk[8], gw[8], gb[8];
#pragma unroll
    for (int j = 0; j < 8; j += 4) {
      float4 t0 = *(const float4*)(p.rwkv_k_a + (size_t)l * 1024 + c0 + j), t1 = *(const float4*)(p.rwkv_r_k + (size_t)l * 1024 + c0 + j);
      float4 t2 = *(const float4*)(p.gn_w + (size_t)l * 1024 + c0 + j), t3 = *(const float4*)(p.gn_b + (size_t)l * 1024 + c0 + j);
      pk[j] = t0.x; pk[j + 1] = t0.y; pk[j + 2] = t0.z; pk[j + 3] = t0.w;
      rk[j] = t1.x; rk[j + 1] = t1.y; rk[j + 2] = t1.z; rk[j + 3] = t1.w;
      gw[j] = t2.x; gw[j + 1] = t2.y; gw[j + 2] = t2.z; gw[j + 3] = t2.w;
      gb[j] = t3.x; gb[j + 1] = t3.y; gb[j + 2] = t3.z; gb[j + 3] = t3.w;
    }
    float part = 0;
#pragma unroll
    for (int j = 0; j < 8; ++j) {
      float ksum = (float)k8[j] * (2.f + ((float)af[j] + (float)ab[j] - 2.f) * pk[j]);
      part += (float)r8[j] * ksum * rk[j];
    }
    part = allreduce8(part);
    h16x8 gt = *(const h16x8*)(zrest + (size_t)row * ZR + 2048 + c0);
    float res[8];
#pragma unroll
    for (int j = 0; j < 8; ++j) {
      float y = o[j] * rstd * gw[j] + gb[j] + part * (float)v8[j];
      res[j] = y * silu_f((float)gt[j]);
    }
    uint4 ov;
    ov.x = pack_bf2(res[0], res[1]); ov.y = pack_bf2(res[2], res[3]); ov.z = pack_bf2(res[4], res[5]); ov.w = pack_bf2(res[6], res[7]);
    *(uint4*)(ym + (size_t)row * D + 1024 + c0) = ov;
  }
}

DEV void phase_merge(const Params& p, const Ctx& cx0, int l, char* smem) {
  const int ntile = (l == 0) ? 520 : 512;
  const int npool = (l == 0) ? 2048 + 32 : 2048;
  const int total = npool + 2 * ntile;
  for (int item = cx0.bid; item < total; item += cx0.nblk) {
    __syncthreads();
    Ctx cx = cx0; asm volatile("" : "+v"(cx.tid));
    if (item < npool) pool_item(p, cx, l, item, smem);
    else if (item < npool + ntile) glu_item(p, cx, l, item - npool, smem);
    else rwkvmerge_item(p, cx, l, item - npool - ntile);
  }
}

#define LCX Ctx c2 = cx; asm volatile("" : "+v"(c2.tid))
__global__ void __launch_bounds__(NTHREADS) mega_fwd(Params p, int ph0, int ph1) {
  extern __shared__ __attribute__((aligned(16))) char smem[];
  cg::grid_group grid = cg::this_grid();
  const int wave_s = __builtin_amdgcn_readfirstlane((int)(threadIdx.x >> 6));
  for (int step = ph0; step < ph1; ++step) {
    if (step > ph0) grid.sync();
    const int ph = (int)((PH_SEQ >> (4 * step)) & 15ull);
    Ctx cx;
    {
      int t_, b_ = blockIdx.x, n_ = gridDim.x;
      asm volatile("v_mbcnt_lo_u32_b32 %0, -1, 0\n\tv_mbcnt_hi_u32_b32 %0, -1, %0\n\tv_lshl_add_u32 %0, %1, 6, %0" : "=&v"(t_) : "s"(wave_s));
      asm volatile("" : "+s"(b_), "+s"(n_));
      cx.tid = t_; cx.bid = b_; cx.nblk = n_;
    }
    const int l = ph >= 8 ? 1 : 0;
    const int lp = ph >= 8 ? ph - 6 : ph;
#ifndef PHMASK
#define PHMASK 0xff
#endif
    if (ph == 0) { if (PHMASK & 1) { LCX; phase0(p, c2, smem); } }
    else if (ph == 1) { if (PHMASK & 2) { LCX; phase_adaln0(p, c2); } }
    else if (lp == 2 && (PHMASK & 4)) {
      LCX;
      h16* zrest = (h16*)(p.ws + OFF_ZREST);
      h16* zc = (h16*)(p.ws + OFF_REG2);
      gemm_phase(p, c2, (const bf16_t*)(p.ws + OFF_H), (const bf16_t*)(p.ws + OFF_WT + (size_t)l * WT_SIZE + WT_IN), 2048, 130, 25, smem,
                 [&](int row, int col, f32x4 v) {
                   h16* dst;
                   if (col < 2048) dst = zrest + (size_t)row * ZR + col;
                   else if (col < 5120) dst = zc + (size_t)row * ZC + (col - 2048);
                   else if (col < 6144) dst = zrest + (size_t)row * ZR + 2048 + (col - 5120);
                   else dst = zc + (size_t)row * ZC + 3072 + (col - 6144);
                   h16x4 o = {(h16)v[0], (h16)v[1], (h16)v[2], (h16)v[3]};
                   *(h16x4*)dst = o;
                 });
    } else if (lp == 3) { if (PHMASK & 8) { LCX; phase_prep(p, c2, l, smem); } }
    else if (lp == 4) { if (PHMASK & 16) { LCX; phase_scan(p, c2, l, smem); } }
    else if (lp == 5) { if (PHMASK & 32) { LCX; phase_merge(p, c2, l, smem); } }
    else if (lp == 6 && (PHMASK & 64)) {
      LCX;
      const float* mods = (const float*)(p.ws + OFF_MODS);
      float* prec = (float*)(p.ws + OFF_PREC);
      const float* xin = (l == 0) ? p.x : p.out;
      gemm_phase(p, c2, (const bf16_t*)(p.ws + OFF_YM), (const bf16_t*)(p.ws + OFF_WT + (size_t)l * WT_SIZE + WT_OUT), 2048, l == 0 ? 130 : 128, 8, smem,
                 [&](int row, int col, f32x4 v) {
                   if (row < NLAT) {
                     float4 xv = *(const float4*)(xin + (size_t)row * D + col);
                     float4 gv = *(const float4*)(mods + (size_t)(l * 3 + (row >> 14)) * 6144 + 4096 + col);
                     float4 r;
                     r.x = ALPHA * xv.x + gv.x * v[0]; r.y = ALPHA * xv.y + gv.y * v[1]; r.z = ALPHA * xv.z + gv.z * v[2]; r.w = ALPHA * xv.w + gv.w * v[3];
                     *(float4*)(p.out + (size_t)row * D + col) = r;
                   } else {
                     float4 xv = *(const float4*)(p.ctx + (size_t)(row - NLAT) * D + col);
                     float4 gv = *(const float4*)(mods + (size_t)(l * 3 + 2) * 6144 + 4096 + col);
                     float4 r;
                     r.x = ALPHA * xv.x + gv.x * v[0]; r.y = ALPHA * xv.y + gv.y * v[1]; r.z = ALPHA * xv.z + gv.z * v[2]; r.w = ALPHA * xv.w + gv.w * v[3];
                     *(float4*)(prec + (size_t)(row - NLAT) * D + col) = r;
                   }
                 });
    } else if (lp == 7) { if (PHMASK & 128) { LCX; phase_finln(p, c2, l); } }
  }
}

constexpr int NPHASES = PH_NSTEPS;

extern "C" void kernel_launch(void* const* d_in, const int* in_sizes, int n_in, void* d_out, int out_size, void* d_ws, size_t ws_size,
                              hipStream_t stream) {
  static int grid_blocks = 0;
  if (grid_blocks == 0) {
    if (n_in != 32 || ws_size < WS_END) { fprintf(stderr, "kernel_launch: unexpected n_in %d / ws %zu (need %zu)\n", n_in, ws_size, (size_t)WS_END); grid_blocks = -1; return; }
    int dev = 0, cus = 0, per_cu = 0;
    hipGetDevice(&dev);
    hipDeviceGetAttribute(&cus, hipDeviceAttributeMultiprocessorCount, dev);
    if (hipFuncSetAttribute((const void*)mega_fwd, hipFuncAttributeMaxDynamicSharedMemorySize, LDS_BYTES) != hipSuccess) { fprintf(stderr, "hipFuncSetAttribute failed\n"); grid_blocks = -1; return; }
    if (hipOccupancyMaxActiveBlocksPerMultiprocessor(&per_cu, (const void*)mega_fwd, NTHREADS, LDS_BYTES) != hipSuccess || per_cu < 1) {
      fprintf(stderr, "occupancy query gave %d\n", per_cu); (void)hipGetLastError(); per_cu = 1;
    }
    grid_blocks = cus * per_cu;
  }
  if (grid_blocks < 0) return;
  Params p{};
  const float** pp = (const float**)&p;
  for (int i = 0; i < 32; ++i) pp[i] = (const float*)d_in[i];
  p.out = (float*)d_out;
  p.ws = (char*)d_ws;
  int ph0 = 0, ph1 = NPHASES;
  void* args[] = {&p, &ph0, &ph1};
  hipError_t e = hipLaunchCooperativeKernel((const void*)mega_fwd, dim3(grid_blocks), dim3(NTHREADS), args, LDS_BYTES, stream);
  if (e != hipSuccess) fprintf(stderr, "cooperative launch failed: %s (grid %d)\n", hipGetErrorString(e), grid_blocks);
}
```

```cpp
#include <hip/hip_runtime.h>
#include <hip/hip_cooperative_groups.h>
#include <cstdio>
namespace cg = cooperative_groups;

typedef unsigned short bf16_t;
typedef _Float16 h16;
using bf16x8 = __attribute__((ext_vector_type(8))) _Float16;
using f32x4 = __attribute__((ext_vector_type(4))) float;
using h16x4 = __attribute__((ext_vector_type(4))) _Float16;
using h16x8 = __attribute__((ext_vector_type(8))) _Float16;

#define DEV __device__ __forceinline__

constexpr int D = 2048, NLAT = 32768, MTOT = 33280, ZR = 3072, ZC = 3328;
constexpr int NTHREADS = 512;
constexpr int LDS_BYTES = 147456;
constexpr float ALPHA = 1.41421356237f;
constexpr float DECAY_SCALE = 0.606531f;

constexpr size_t al256(size_t x) { return (x + 255) & ~size_t(255); }
constexpr size_t ARR = (size_t)MTOT * 1024;
constexpr size_t OFF_MODS = 0;
constexpr size_t OFF_S5F = al256(OFF_MODS + 2 * 3 * 6144 * 4);
constexpr size_t OFF_PREC = al256(OFF_S5F + (size_t)2 * 32 * 65 * 2 * 64 * 8);
constexpr size_t OFF_WT = al256(OFF_PREC + (size_t)512 * 2048 * 4);
constexpr size_t WT_IN = 0, WT_OUT = 26214400, WT_W2 = 34603008, WT_A2 = 34865152, WT_POOL = 35127296, WT_GLU = 35258368, WT_SIZE = 35782656;
constexpr size_t OFF_ZREST = al256(OFF_WT + 2 * WT_SIZE);
constexpr size_t OFF_REG2 = al256(OFF_ZREST + (size_t)MTOT * ZR * 2);
constexpr size_t OFF_S5Y = OFF_REG2 + 2 * ARR * 2;
constexpr size_t OFF_SCAN = al256(OFF_REG2 + (size_t)MTOT * ZC * 2);
constexpr size_t OFF_H = OFF_SCAN;
constexpr size_t OFF_YM = OFF_SCAN + 6 * ARR * 2;
constexpr size_t WS_END = OFF_SCAN + 8 * ARR * 2;

#ifndef PH_SEQ
#define PH_SEQ 0xDCBA9876543210ull
#define PH_NSTEPS 14
#endif
struct Params {
  const float *x, *c, *ctx, *c_ctx, *w_ada, *b_ada, *w_in, *conv_rkv, *s5_lam_re, *s5_lam_im, *s5_log_step,
      *s5_b_re, *s5_b_im, *s5_c_re, *s5_c_im, *s5_d, *w_glu, *b_glu, *w_pool, *pool_scale,
      *rwkv_w0, *rwkv_w2, *rwkv_a0, *rwkv_a2, *rwkv_k_k, *rwkv_k_a, *rwkv_r_k, *gn_w, *gn_b,
      *w_out, *ln_g, *ln_b;
  float* out;
  char* ws;
};
struct Ctx { int tid, bid, nblk; };

DEV float rcp_f(float x) { return __builtin_amdgcn_rcpf(x); }
DEV float sigmoid_f(float x) { return rcp_f(1.f + __expf(-x)); }
DEV float silu_f(float x) { return x * rcp_f(1.f + __expf(-x)); }
DEV float tanh_f(float x) { float e = __expf(2.f * x); return 1.f - 2.f * rcp_f(e + 1.f); }
DEV float gelu_f(float y) { return 0.5f * y * (1.f + tanh_f(0.7978845608f * (y + 0.044715f * y * y * y))); }
using h16x2 = __attribute__((ext_vector_type(2))) _Float16;
DEV unsigned pack_bf2(float a, float b) { h16x2 v = {(h16)a, (h16)b}; return __builtin_bit_cast(unsigned, v); }
template <int CTRL> DEV float dpp_mov(float v) {
  return __int_as_float(__builtin_amdgcn_update_dpp(0, __float_as_int(v), CTRL, 0xf, 0xf, true));
}
DEV float allreduce16(float v) {
  v += dpp_mov<0xB1>(v);
  v += dpp_mov<0x4E>(v);
  v += dpp_mov<0x141>(v);
  v += dpp_mov<0x140>(v);
  return v;
}
DEV float wave_sum(float v) {
  v = allreduce16(v);
  return __builtin_amdgcn_readlane(__float_as_int(v), 0) == 0 && false ? 0.f :
         __int_as_float(__builtin_amdgcn_readlane(__float_as_int(v), 0)) + __int_as_float(__builtin_amdgcn_readlane(__float_as_int(v), 16)) +
         __int_as_float(__builtin_amdgcn_readlane(__float_as_int(v), 32)) + __int_as_float(__builtin_amdgcn_readlane(__float_as_int(v), 48));
}
DEV float allreduce8(float v) {
  v += dpp_mov<0xB1>(v);
  v += dpp_mov<0x4E>(v);
  v += dpp_mov<0x141>(v);
  return v;
}
DEV void lds_fence() { asm volatile("s_waitcnt lgkmcnt(0)" ::: "memory"); }

DEV void p0_mods_item(const Params& p, const Ctx& cx, int item, char* smem) {
  float* red = (float*)smem;
  float* mods = (float*)(p.ws + OFF_MODS);
  int l = item / 96, chunk = item % 96;
  int tid = cx.tid, kq = tid >> 6, col = tid & 63;
  int n = chunk * 64 + col;
  const float* W = p.w_ada + (size_t)l * 2048 * 6144;
  float a0 = 0, a1 = 0, a2 = 0;
#pragma unroll 8
  for (int k = kq; k < 2048; k += 8) {
    float w = W[(size_t)k * 6144 + n];
    a0 += silu_f(p.c[k]) * w;
    a1 += silu_f(p.c[2048 + k]) * w;
    a2 += silu_f(p.c_ctx[k]) * w;
  }
  red[(kq * 3 + 0) * 64 + col] = a0;
  red[(kq * 3 + 1) * 64 + col] = a1;
  red[(kq * 3 + 2) * 64 + col] = a2;
  __syncthreads();
  if (tid < 192) {
    int r = tid >> 6, cc = tid & 63;
    float s = 0;
#pragma unroll
    for (int q = 0; q < 8; ++q) s += red[(q * 3 + r) * 64 + cc];
    mods[(size_t)(l * 3 + r) * 6144 + chunk * 64 + cc] = s + p.b_ada[(size_t)l * 6144 + chunk * 64 + cc];
  }
}

DEV void p0_transpose_tile(const Params& p, const Ctx& cx, const float* __restrict__ src, bf16_t* __restrict__ dst, int K, int N, int tk, int tn, char* smem) {
  float* T = (float*)smem;
  int tid = cx.tid;
  int k0 = tk * 64, n0 = tn * 64;
  int kk = tid >> 4, n4 = tid & 15;
#pragma unroll
  for (int i = 0; i < 2; ++i) {
    int k = kk + 32 * i;
    float4 v = *(const float4*)(src + (size_t)(k0 + k) * N + n0 + n4 * 4);
    T[k * 65 + n4 * 4 + 0] = v.x; T[k * 65 + n4 * 4 + 1] = v.y; T[k * 65 + n4 * 4 + 2] = v.z; T[k * 65 + n4 * 4 + 3] = v.w;
  }
  __syncthreads();
  int n = tid >> 3, k8 = tid & 7;
  uint4 o;
  o.x = pack_bf2(T[(k8 * 8 + 0) * 65 + n], T[(k8 * 8 + 1) * 65 + n]);
  o.y = pack_bf2(T[(k8 * 8 + 2) * 65 + n], T[(k8 * 8 + 3) * 65 + n]);
  o.z = pack_bf2(T[(k8 * 8 + 4) * 65 + n], T[(k8 * 8 + 5) * 65 + n]);
  o.w = pack_bf2(T[(k8 * 8 + 6) * 65 + n], T[(k8 * 8 + 7) * 65 + n]);
  *(uint4*)(dst + (size_t)(n0 + n) * K + k0 + k8 * 8) = o;
}

DEV void phase0(const Params& p, const Ctx& cx0, char* smem) {
  const int NTR = 4368;
  const int total = 192 + 2 * NTR;
  for (int item = cx0.bid; item < total; item += cx0.nblk) {
    __syncthreads();
    Ctx cx = cx0; asm volatile("" : "+v"(cx.tid));
    if (item < 192) { p0_mods_item(p, cx, item, smem); continue; }
    int it = item - 192;
    int l = it / NTR, i = it % NTR;
    char* wt = p.ws + OFF_WT + (size_t)l * WT_SIZE;
    if (i < 3200) {
      p0_transpose_tile(p, cx, p.w_in + (size_t)l * 2048 * 6400, (bf16_t*)(wt + WT_IN), 2048, 6400, i / 100, i % 100, smem);
    } else if (i < 4224) {
      int j = i - 3200;
      p0_transpose_tile(p, cx, p.w_out + (size_t)l * 2048 * 2048, (bf16_t*)(wt + WT_OUT), 2048, 2048, j / 32, j % 32, smem);
    } else if (i < 4256) {
      int j = i - 4224, d = j / 16;
      p0_transpose_tile(p, cx, p.rwkv_w2 + (size_t)(l * 2 + d) * 64 * 1024, (bf16_t*)(wt + WT_W2) + (size_t)d * 1024 * 64, 64, 1024, 0, j % 16, smem);
    } else if (i < 4288) {
      int j = i - 4256, d = j / 16;
      p0_transpose_tile(p, cx, p.rwkv_a2 + (size_t)(l * 2 + d) * 64 * 1024, (bf16_t*)(wt + WT_A2) + (size_t)d * 1024 * 64, 64, 1024, 0, j % 16, smem);
    } else if (i < 4304) {
      int j = i - 4288, g = j / 4;
      p0_transpose_tile(p, cx, p.w_pool + (size_t)(l * 4 + g) * 128 * 128, (bf16_t*)(wt + WT_POOL) + (size_t)g * 128 * 128, 128, 128, (j % 4) / 2, j % 2, smem);
    } else {
      int j = i - 4304;
      p0_transpose_tile(p, cx, p.w_glu + (size_t)l * 512 * 512, (bf16_t*)(wt + WT_GLU), 512, 512, j / 8, j % 8, smem);
    }
  }
}

DEV void phase_adaln0(const Params& p, const Ctx& cx) {
  const float* mods = (const float*)(p.ws + OFF_MODS);
  bf16_t* hbuf = (bf16_t*)(p.ws + OFF_H);
  int lane = cx.tid & 63;
  int gw = cx.bid * 8 + (cx.tid >> 6), nw = cx.nblk * 8;
  for (int row = gw; row < MTOT; row += nw) {
    const float* src = row < NLAT ? p.x + (size_t)row * D : p.ctx + (size_t)(row - NLAT) * D;
    int mr = row < NLAT ? (row >> 14) : 2;
    const float* md = mods + (size_t)mr * 6144;
    float4 v[8];
    float s = 0;
#pragma unroll
    for (int i = 0; i < 8; ++i) { v[i] = *(const float4*)(src + i * 256 + lane * 4); s += v[i].x + v[i].y + v[i].z + v[i].w; }
    float mu = wave_sum(s) * (1.f / 2048.f);
    float q = 0;
#pragma unroll
    for (int i = 0; i < 8; ++i) { v[i].x -= mu; v[i].y -= mu; v[i].z -= mu; v[i].w -= mu; q += v[i].x * v[i].x + v[i].y * v[i].y + v[i].z * v[i].z + v[i].w * v[i].w; }
    float rstd = rsqrtf(wave_sum(q) * (1.f / 2048.f) + 1e-6f);
#pragma unroll
    for (int i = 0; i < 8; ++i) {
      int col = i * 256 + lane * 4;
      float4 sh = *(const float4*)(md + col), sc = *(const float4*)(md + 2048 + col);
      uint2 o;
      o.x = pack_bf2(v[i].x * rstd * (1.f + sc.x) + sh.x, v[i].y * rstd * (1.f + sc.y) + sh.y);
      o.y = pack_bf2(v[i].z * rstd * (1.f + sc.z) + sh.z, v[i].w * rstd * (1.f + sc.w) + sh.w);
      *(uint2*)(hbuf + (size_t)row * D + col) = o;
    }
  }
}

DEV void phase_finln(const Params& p, const Ctx& cx, int l) {
  const float* mods = (const float*)(p.ws + OFF_MODS);
  bf16_t* hbuf = (bf16_t*)(p.ws + OFF_H);
  float* prec = (float*)(p.ws + OFF_PREC);
  int lane = cx.tid & 63;
  int gw = cx.bid * 8 + (cx.tid >> 6), nw = cx.nblk * 8;
  const int nrows = (l == 0) ? MTOT : NLAT;
  for (int row = gw; row < nrows; row += nw) {
    float* src = row < NLAT ? p.out + (size_t)row * D : prec + (size_t)(row - NLAT) * D;
    float4 v[8];
    float s = 0;
#pragma unroll
    for (int i = 0; i < 8; ++i) { v[i] = *(const float4*)(src + i * 256 + lane * 4); s += v[i].x + v[i].y + v[i].z + v[i].w; }
    float mu = wave_sum(s) * (1.f / 2048.f);
    float q = 0;
#pragma unroll
    for (int i = 0; i < 8; ++i) { v[i].x -= mu; v[i].y -= mu; v[i].z -= mu; v[i].w -= mu; q += v[i].x * v[i].x + v[i].y * v[i].y + v[i].z * v[i].z + v[i].w * v[i].w; }
    float rstd = rsqrtf(wave_sum(q) * (1.f / 2048.f) + 1e-5f);
    float s2 = 0;
#pragma unroll
    for (int i = 0; i < 8; ++i) {
      int col = i * 256 + lane * 4;
      float4 g = *(const float4*)(p.ln_g + (size_t)l * D + col), b = *(const float4*)(p.ln_b + (size_t)l * D + col);
      v[i].x = v[i].x * rstd * g.x + b.x; v[i].y = v[i].y * rstd * g.y + b.y; v[i].z = v[i].z * rstd * g.z + b.z; v[i].w = v[i].w * rstd * g.w + b.w;
      if (row < NLAT) *(float4*)(src + col) = v[i];
      s2 += v[i].x + v[i].y + v[i].z + v[i].w;
    }
    if (l == 0) {
      int mr = row < NLAT ? (row >> 14) : 2;
      const float* md = mods + (size_t)(3 + mr) * 6144;
      float mu2 = wave_sum(s2) * (1.f / 2048.f);
      float q2 = 0;
#pragma unroll
      for (int i = 0; i < 8; ++i) { v[i].x -= mu2; v[i].y -= mu2; v[i].z -= mu2; v[i].w -= mu2; q2 += v[i].x * v[i].x + v[i].y * v[i].y + v[i].z * v[i].z + v[i].w * v[i].w; }
      float rstd2 = rsqrtf(wave_sum(q2) * (1.f / 2048.f) + 1e-6f);
#pragma unroll
      for (int i = 0; i < 8; ++i) {
        int col = i * 256 + lane * 4;
        float4 sh = *(const float4*)(md + col), sc = *(const float4*)(md + 2048 + col);
        uint2 o;
        o.x = pack_bf2(v[i].x * rstd2 * (1.f + sc.x) + sh.x, v[i].y * rstd2 * (1.f + sc.y) + sh.y);
        o.y = pack_bf2(v[i].z * rstd2 * (1.f + sc.z) + sh.z, v[i].w * rstd2 * (1.f + sc.w) + sh.w);
        *(uint2*)(hbuf + (size_t)row * D + col) = o;
      }
    }
  }
}

template <class Epi>
DEV void gemm_phase(const Params& p, const Ctx& cx, const bf16_t* __restrict__ A, const bf16_t* __restrict__ Bt, int K, int nM, int nN, char* smem, Epi epi) {
  const int tid = cx.tid, lane = tid & 63, wid = tid >> 6;
  const int wr = wid >> 2, wc = wid & 3, fr = lane & 15, fq = lane >> 4;
  const int nt = K / 64;
  const int ntiles = nM * nN;
  const int srow = tid >> 3, sc16 = tid & 7;
  const int nxcd = (cx.nblk & 7) == 0 ? 8 : 1;
  const int xcd = cx.bid % nxcd, xidx = cx.bid / nxcd, xper = cx.nblk / nxcd;
  const int t_lo = (int)(((long)ntiles * xcd) / nxcd), t_hi = (int)(((long)ntiles * (xcd + 1)) / nxcd);
  for (int tt = t_lo + xidx; tt < t_hi; tt += xper) {
    const int band = tt / (16 * nN);
    const int brows = min(16, nM - band * 16);
    const int rem = tt - band * 16 * nN;
    const int pn = rem / brows, pm = band * 16 + rem % brows;
    const int brow = pm * 256, bcol = pn * 256;
    const char* Ab = (const char*)(A + (size_t)brow * K);
    const char* Bb = (const char*)(Bt + (size_t)bcol * K);
    const unsigned voff = (unsigned)(srow * K + sc16 * 8) * 2u;
    const size_t rs = (size_t)64 * K * 2;
    f32x4 acc[8][4];
#pragma unroll
    for (int i = 0; i < 8; ++i)
#pragma unroll
      for (int j = 0; j < 4; ++j) acc[i][j] = f32x4{0.f, 0.f, 0.f, 0.f};
    uint4 ra0, ra1, ra2, ra3, rb0, rb1, rb2, rb3;
#define G_LD(ko) { const char* a_ = Ab + (size_t)(ko) * 2; const char* b_ = Bb + (size_t)(ko) * 2; \
                 ra0 = *(const uint4*)(a_ + voff); ra1 = *(const uint4*)(a_ + rs + voff); ra2 = *(const uint4*)(a_ + 2 * rs + voff); ra3 = *(const uint4*)(a_ + 3 * rs + voff); \
                 rb0 = *(const uint4*)(b_ + voff); rb1 = *(const uint4*)(b_ + rs + voff); rb2 = *(const uint4*)(b_ + 2 * rs + voff); rb3 = *(const uint4*)(b_ + 3 * rs + voff); }
#define G_ST(sp) { *(uint4*)(sp) = ra0; *(uint4*)((sp) + 64 * 144) = ra1; *(uint4*)((sp) + 128 * 144) = ra2; *(uint4*)((sp) + 192 * 144) = ra3; \
                 *(uint4*)((sp) + 36864) = rb0; *(uint4*)((sp) + 36864 + 64 * 144) = rb1; *(uint4*)((sp) + 36864 + 128 * 144) = rb2; *(uint4*)((sp) + 36864 + 192 * 144) = rb3; }
    char* const sbase = smem + srow * 144 + sc16 * 16;
    G_LD(0);
    G_ST(sbase);
    if (nt > 1) G_LD(64);
    for (int kt = 0; kt < nt; ++kt) {
      __syncthreads();
      if (kt + 1 < nt) { char* s1 = sbase + ((kt + 1) & 1) * 73728; G_ST(s1); }
      if (kt + 2 < nt) G_LD((kt + 2) * 64);
      const char* As = smem + (kt & 1) * 73728;
      const char* Bs = As + 36864;
#pragma unroll
      for (int kh = 0; kh < 2; ++kh) {
        bf16x8 bfr[4];
#pragma unroll
        for (int jn = 0; jn < 4; ++jn) bfr[jn] = *(const bf16x8*)(Bs + (wc * 64 + jn * 16 + fr) * 144 + kh * 64 + fq * 16);
#pragma unroll
        for (int i = 0; i < 8; ++i) {
          bf16x8 af = *(const bf16x8*)(As + (wr * 128 + i * 16 + fr) * 144 + kh * 64 + fq * 16);
#pragma unroll
          for (int jn = 0; jn < 4; ++jn) acc[i][jn] = __builtin_amdgcn_mfma_f32_16x16x32_f16(bfr[jn], af, acc[i][jn], 0, 0, 0);
        }
      }
    }
    __syncthreads();
#pragma unroll
    for (int i = 0; i < 8; ++i)
#pragma unroll
      for (int jn = 0; jn < 4; ++jn) epi(brow + wr * 128 + i * 16 + fr, bcol + wc * 64 + jn * 16 + fq * 4, acc[i][jn]);
  }
}

#define LAS3 __attribute__((address_space(3)))
DEV int g2_lds_byte(int r, int c) { const int st = (r >> 4) * 2 + (c >> 5), rr = r & 15, cc = c & 31, ob = rr * 64 + cc * 2; return st * 1024 + (ob ^ (((ob >> 9) & 1) << 5)); }
DEV void g2_stage_rc(int b, int& R, int& C) { const int st = b / 1024, sb = b % 1024, swz = sb ^ (((sb >> 9) & 1) << 5); R = (st >> 1) * 16 + swz / 64; C = (st & 1) * 32 + (swz % 64) / 2; }

template <class Epi>
DEV void gemm_phase2(const Params& p, const Ctx& cx, const bf16_t* __restrict__ A, const bf16_t* __restrict__ Bt, int K, int nM, int nN, char* smem, Epi epi) {
  constexpr int HTB = 128 * 64 * 2;
  LAS3 unsigned char* lds = (LAS3 unsigned char*)smem;
  const int tid = cx.tid, wid = __builtin_amdgcn_readfirstlane(tid >> 6), lane = tid & 63, wr = wid >> 2, wc = wid & 3, fr = lane & 15, fq = lane >> 4;
  const int nt = K / 64;
  const int ntiles = nM * nN;
  const int nxcd = (cx.nblk & 7) == 0 ? 8 : 1;
  const int xcd = cx.bid % nxcd, xidx = cx.bid / nxcd, xper = cx.nblk / nxcd;
  const int t_lo = (int)(((long)ntiles * xcd) / nxcd), t_hi = (int)(((long)ntiles * (xcd + 1)) / nxcd);
  auto unit_at = [&](int i, int& pm, int& pn) -> bool {
    const int tt = t_lo + xidx + i * xper;
    if (tt >= t_hi) return false;
    const int band = tt / (16 * nN);
    const int brows = min(16, nM - band * 16);
    const int rem = tt - band * 16 * nN;
    pn = rem / brows; pm = band * 16 + rem % brows;
    return true;
  };
  unsigned voffA[2];
#pragma unroll
  for (int i = 0; i < 2; ++i) { int R, C; g2_stage_rc(tid * 16 + i * 8192, R, C); voffA[i] = (unsigned)(R * K + C) * 2u; }
  const size_t kstep = (size_t)(64 * 2);
  const size_t hstep = (size_t)128 * K * 2;
  const size_t tstep = 2 * hstep;
  const unsigned ldsw = (unsigned)wid * 1024u;
  const int aoff = g2_lds_byte(wr * 64 + fr, fq * 8), boff = g2_lds_byte(wc * 32 + fr, fq * 8);
#define G2_SA(b, h) (((b) * 2 + (h)) * HTB)
#define G2_SB(b, h) ((4 + (b) * 2 + (h)) * HTB)
#define G2_STAGE(bufoff, gbase) do { _Pragma("unroll") for (int _i = 0; _i < 2; ++_i) \
    __builtin_amdgcn_global_load_lds((const unsigned*)((const char*)(gbase) + voffA[_i]), (LAS3 unsigned*)(lds + (bufoff) + ldsw + _i * 8192), 16, 0, 0); } while (0)
#define G2_LDA(dst, b, h) do { _Pragma("unroll") for (int m = 0; m < 4; ++m) _Pragma("unroll") for (int k = 0; k < 2; ++k) dst[m][k] = *(const LAS3 bf16x8*)(lds + G2_SA(b, h) + aoff + m * 2048 + k * 1024); } while (0)
#define G2_LDB(dst, b, h) do { _Pragma("unroll") for (int n = 0; n < 2; ++n) _Pragma("unroll") for (int k = 0; k < 2; ++k) dst[n][k] = *(const LAS3 bf16x8*)(lds + G2_SB(b, h) + boff + n * 2048 + k * 1024); } while (0)
#define G2_MMA(ai, bj, At_, Bt_) do { __builtin_amdgcn_s_setprio(1); _Pragma("unroll") for (int m = 0; m < 4; ++m) _Pragma("unroll") for (int n = 0; n < 2; ++n) _Pragma("unroll") for (int k = 0; k < 2; ++k) \
    acc[ai][bj][m][n] = __builtin_amdgcn_mfma_f32_16x16x32_f16(Bt_[n][k], At_[m][k], acc[ai][bj][m][n], 0, 0, 0); __builtin_amdgcn_s_setprio(0); } while (0)
#define G2_WAIT_V(n) asm volatile("s_waitcnt vmcnt(" #n ")" ::: "memory")
#define G2_WAIT_L(n) asm volatile("s_waitcnt lgkmcnt(" #n ")" ::: "memory")
#define G2_BAR __builtin_amdgcn_s_barrier()
#define G2_SCHED __builtin_amdgcn_sched_barrier(0)
  int cpm, cpn, npm = 0, npn = 0, ui = 0;
  if (!unit_at(0, cpm, cpn)) return;
  f32x4 acc[2][2][4][2];
#pragma unroll
  for (int a = 0; a < 2; ++a)
#pragma unroll
    for (int b = 0; b < 2; ++b)
#pragma unroll
      for (int m = 0; m < 4; ++m)
#pragma unroll
        for (int n = 0; n < 2; ++n) acc[a][b][m][n] = f32x4{0.f, 0.f, 0.f, 0.f};
  bf16x8 At[4][2], B0[2][2], B1[2][2];
  const char* cA = (const char*)A + (size_t)cpm * tstep;
  const char* cB = (const char*)Bt + (size_t)cpn * tstep;
  G2_STAGE(G2_SB(0, 0), cB); G2_STAGE(G2_SA(0, 0), cA); G2_STAGE(G2_SB(0, 1), cB + hstep); G2_STAGE(G2_SA(0, 1), cA + hstep);
  if (wr == 1) G2_BAR;
  G2_WAIT_V(4); G2_BAR;
  G2_STAGE(G2_SB(1, 0), cB + kstep); G2_STAGE(G2_SA(1, 0), cA + kstep); G2_STAGE(G2_SB(1, 1), cB + hstep + kstep);
  G2_WAIT_V(6); G2_BAR;
  for (;;) {
    const bool has_next = unit_at(ui + 1, npm, npn);
    const char* nA = has_next ? (const char*)A + (size_t)npm * tstep : cA;
    const char* nB = has_next ? (const char*)Bt + (size_t)npn * tstep : cB;
    for (int t = 0; t < nt; t += 2) {
      const bool last = (t == nt - 2);
      const char* a1 = cA + (size_t)(t + 1) * kstep;
      const char* a2 = last ? nA : cA + (size_t)(t + 2) * kstep;
      const char* b2 = last ? nB : cB + (size_t)(t + 2) * kstep;
      const char* a3 = a2 + kstep;
      const char* b3 = b2 + kstep;
      G2_LDB(B0, 0, 0); G2_SCHED; G2_LDA(At, 0, 0); G2_STAGE(G2_SA(1, 1), a1 + hstep);
      G2_WAIT_L(8); G2_BAR; G2_WAIT_L(0); G2_MMA(0, 0, At, B0); G2_BAR; G2_SCHED;
      G2_LDB(B1, 0, 1); G2_STAGE(G2_SB(0, 0), b2);
      G2_BAR; G2_WAIT_L(0); G2_MMA(0, 1, At, B1); G2_BAR;
      G2_LDA(At, 0, 1); G2_STAGE(G2_SA(0, 0), a2);
      G2_BAR; G2_WAIT_L(0); G2_MMA(1, 0, At, B0); G2_BAR; G2_SCHED;
      G2_STAGE(G2_SB(0, 1), b2 + hstep);
      G2_WAIT_V(6); G2_BAR; G2_MMA(1, 1, At, B1); G2_BAR;
      G2_LDB(B0, 1, 0); G2_SCHED; G2_LDA(At, 1, 0); G2_STAGE(G2_SA(0, 1), a2 + hstep);
      G2_WAIT_L(8); G2_BAR; G2_WAIT_L(0); G2_MMA(0, 0, At, B0); G2_BAR; G2_SCHED;
      G2_LDB(B1, 1, 1); G2_STAGE(G2_SB(1, 0), b3);
      G2_BAR; G2_WAIT_L(0); G2_MMA(0, 1, At, B1); G2_BAR;
      G2_LDA(At, 1, 1); G2_STAGE(G2_SA(1, 0), a3);
      G2_BAR; G2_WAIT_L(0); G2_MMA(1, 0, At, B0); G2_BAR; G2_SCHED;
      G2_STAGE(G2_SB(1, 1), b3 + hstep);
      G2_WAIT_V(6); G2_BAR; G2_MMA(1, 1, At, B1); G2_BAR;
    }
    {
      const int row0 = cpm * 256 + wr * 64 + fr, col0 = cpn * 256 + wc * 32 + 4 * fq;
#pragma unroll
      for (int ai = 0; ai < 2; ++ai)
#pragma unroll
        for (int m = 0; m < 4; ++m)
#pragma unroll
          for (int bj = 0; bj < 2; ++bj)
#pragma unroll
            for (int n = 0; n < 2; ++n) epi(row0 + ai * 128 + m * 16, col0 + bj * 128 + n * 16, acc[ai][bj][m][n]);
    }
    if (!has_next) break;
#pragma unroll
    for (int a = 0; a < 2; ++a)
#pragma unroll
      for (int b = 0; b < 2; ++b)
#pragma unroll
        for (int m = 0; m < 4; ++m)
#pragma unroll
          for (int n = 0; n < 2; ++n) acc[a][b][m][n] = f32x4{0.f, 0.f, 0.f, 0.f};
    cpm = npm; cpn = npn; cA = nA; cB = nB; ++ui;
  }
  G2_WAIT_V(0);
  if (wr == 0) G2_BAR;
  G2_BAR;
#undef G2_SA
#undef G2_SB
#undef G2_STAGE
#undef G2_LDA
#undef G2_LDB
#undef G2_MMA
#undef G2_WAIT_V
#undef G2_WAIT_L
#undef G2_BAR
#undef G2_SCHED
}

template <int K, int NT, class Epi>
DEV void small_gemm(const Params& p, const Ctx& cx, const char* As, int astride, const bf16_t* __restrict__ Bt, int n0, Epi epi) {
  const int lane = cx.tid & 63, fr = lane & 15, fq = lane >> 4;
  f32x4 acc[4][NT];
#pragma unroll
  for (int i = 0; i < 4; ++i)
#pragma unroll
    for (int j = 0; j < NT; ++j) acc[i][j] = f32x4{0.f, 0.f, 0.f, 0.f};
#pragma unroll 2
  for (int k0 = 0; k0 < K; k0 += 32) {
    bf16x8 af[4];
#pragma unroll
    for (int i = 0; i < 4; ++i) af[i] = *(const bf16x8*)(As + (i * 16 + fr) * astride + (k0 + fq * 8) * 2);
#pragma unroll
    for (int jn = 0; jn < NT; ++jn) {
      bf16x8 bf = *(const bf16x8*)(Bt + (size_t)(n0 + jn * 16 + fr) * K + k0 + fq * 8);
#pragma unroll
      for (int i = 0; i < 4; ++i) acc[i][jn] = __builtin_amdgcn_mfma_f32_16x16x32_f16(bf, af[i], acc[i][jn], 0, 0, 0);
    }
  }
#pragma unroll
  for (int i = 0; i < 4; ++i)
#pragma unroll
    for (int jn = 0; jn < NT; ++jn) epi(i * 16 + fr, n0 + jn * 16 + fq * 4, acc[i][jn]);
}

struct S5P { float ar, ai, br, bi; };
DEV S5P s5_params(const Params& p, const Ctx& cx, int l, int d, int g, int lane) {
  int idx = ((l * 2 + d) * 32 + g) * 64 + lane;
  float lr = fminf(p.s5_lam_re[idx], -1e-4f), li = p.s5_lam_im[idx];
  float step = expf(p.s5_log_step[(l * 2 + d) * 32 + g]);
  float xr = lr * step, xi = li * step;
  float e = expf(xr), cs = cosf(xi), sn = sinf(xi);
  S5P r;
  r.ar = e * cs; r.ai = e * sn;
  float sh = sinf(0.5f * xi);
  float nr = expm1f(xr) * cs - 2.f * sh * sh, ni = e * sn;
  float inv = 1.f / (lr * lr + li * li);
  r.br = (nr * lr + ni * li) * inv;
  r.bi = (ni * lr - nr * li) * inv;
  return r;
}

DEV void s5_load_u(const h16* zrest, int rowbase, int g, char* ulds, int lane) {
#pragma unroll
  for (int i = 0; i < 8; ++i) {
    int e = i * 64 + lane;
    int r = e >> 1, hf = e & 1;
    uint4 v = *(const uint4*)(zrest + (size_t)(rowbase + r) * ZR + g * 16 + hf * 8);
    *(uint4*)(ulds + r * 32 + hf * 16) = v;
  }
  lds_fence();
}

DEV int s5_rowbase(int b, int c) { return c == 0 ? NLAT + b * 256 : b * 16384 + (c - 1) * 256; }

DEV void s5_pass1_unit(const Params& p, const Ctx& cx, int l, int unit, char* wl, int lane) {
  int c = unit % 65, bg = unit / 65, g = bg & 31, b = bg >> 5;
  const h16* zrest = (const h16*)(p.ws + OFF_ZREST);
  float2* F = (float2*)(p.ws + OFF_S5F);
  s5_load_u(zrest, s5_rowbase(b, c), g, wl, lane);
  float Br[16], Bi[16];
  {
    const float* pr = p.s5_b_re + ((size_t)(l * 32 + g) * 64 + lane) * 16;
    const float* pi = p.s5_b_im + ((size_t)(l * 32 + g) * 64 + lane) * 16;
#pragma unroll
    for (int i = 0; i < 16; i += 4) {
      float4 a = *(const float4*)(pr + i), bq = *(const float4*)(pi + i);
      Br[i] = a.x; Br[i + 1] = a.y; Br[i + 2] = a.z; Br[i + 3] = a.w;
      Bi[i] = bq.x; Bi[i + 1] = bq.y; Bi[i + 2] = bq.z; Bi[i + 3] = bq.w;
    }
  }
  S5P pf = s5_params(p, cx, l, 0, g, lane), pb = s5_params(p, cx, l, 1, g, lane);
  float xr = 0, xi = 0, yr = 0, yi = 0, pwr = 1.f, pwi = 0.f;
#pragma unroll 4
  for (int t = 0; t < 256; ++t) {
    h16x8 u0 = *(const h16x8*)(wl + t * 32), u1 = *(const h16x8*)(wl + t * 32 + 16);
    float br = 0, bi = 0;
#pragma unroll
    for (int i = 0; i < 8; ++i) { float u = (float)u0[i]; br = fmaf(u, Br[i], br); bi = fmaf(u, Bi[i], bi); }
#pragma unroll
    for (int i = 0; i < 8; ++i) { float u = (float)u1[i]; br = fmaf(u, Br[8 + i], br); bi = fmaf(u, Bi[8 + i], bi); }
    float vr = pf.br * br - pf.bi * bi, vi = pf.br * bi + pf.bi * br;
    float nxr = pf.ar * xr - pf.ai * xi + vr, nxi = pf.ar * xi + pf.ai * xr + vi;
    xr = nxr; xi = nxi;
    float wr_ = pb.br * br - pb.bi * bi, wi_ = pb.br * bi + pb.bi * br;
    yr += pwr * wr_ - pwi * wi_; yi += pwr * wi_ + pwi * wr_;
    float npr = pwr * pb.ar - pwi * pb.ai, npi = pwr * pb.ai + pwi * pb.ar;
    pwr = npr; pwi = npi;
  }
  size_t fi = (((size_t)(b * 32 + g) * 65 + c) * 2) * 64 + lane;
  F[fi] = make_float2(xr, xi);
  F[fi + 64] = make_float2(yr, yi);
}

DEV void s5_pass3_unit(const Params& p, const Ctx& cx, int l, int unit, char* wl, int lane) {
  int c = unit % 65, bg = unit / 65, g = bg & 31, b = bg >> 5;
  const int fr = lane & 15, fq = lane >> 4;
  const h16* zrest = (const h16*)(p.ws + OFF_ZREST);
  const float2* F = (const float2*)(p.ws + OFF_S5F);
  float* S5Y = (float*)(p.ws + OFF_S5Y);
  const int rowbase = s5_rowbase(b, c);
  char* ulds = wl;
  char* tile = wl + 8192;
  s5_load_u(zrest, rowbase, g, ulds, lane);
  float Br[16], Bi[16];
  {
    const float* pr = p.s5_b_re + ((size_t)(l * 32 + g) * 64 + lane) * 16;
    const float* pi = p.s5_b_im + ((size_t)(l * 32 + g) * 64 + lane) * 16;
#pragma unroll
    for (int i = 0; i < 16; i += 4) {
      float4 a = *(const float4*)(pr + i), bq = *(const float4*)(pi + i);
      Br[i] = a.x; Br[i + 1] = a.y; Br[i + 2] = a.z; Br[i + 3] = a.w;
      Bi[i] = bq.x; Bi[i + 1] = bq.y; Bi[i + 2] = bq.z; Bi[i + 3] = bq.w;
    }
  }
  const float dsk = p.s5_d[(size_t)l * 512 + g * 16 + fr];
  const size_t fbase = ((size_t)(b * 32 + g) * 65) * 2 * 64 + lane;
#pragma unroll 1
  for (int d = 0; d < 2; ++d) {
    S5P pp = s5_params(p, cx, l, d, g, lane);
    float qr = pp.ar, qi = pp.ai;
#pragma unroll
    for (int i = 0; i < 8; ++i) { float t = qr * qr - qi * qi; qi = 2.f * qr * qi; qr = t; }
    float xr = 0, xi = 0;
    if (d == 0) {
      for (int cc = 0; cc < c; ++cc) {
        float2 f = F[fbase + (size_t)(cc * 2 + 0) * 64];
        float t = qr * xr - qi * xi + f.x; xi = qr * xi + qi * xr + f.y; xr = t;
      }
    } else if (c > 0) {
      float2 f0 = F[fbase + (size_t)(0 * 2 + 1) * 64];
      xr = f0.x; xi = f0.y;
      for (int cc = 64; cc > c; --cc) {
        float2 f = F[fbase + (size_t)(cc * 2 + 1) * 64];
        float t = qr * xr - qi * xi + f.x; xi = qr * xi + qi * xr + f.y; xr = t;
      }
    }
    bf16x8 chi[4], clo[4];
    {
      const float* cr = p.s5_c_re + ((size_t)((l * 2 + d) * 32 + g) * 16 + fr) * 64;
      const float* ci = p.s5_c_im + ((size_t)((l * 2 + d) * 32 + g) * 16 + fr) * 64;
#pragma unroll
      for (int ks = 0; ks < 4; ++ks) {
        float4 a = *(const float4*)(cr + ks * 16 + fq * 4), bq = *(const float4*)(ci + ks * 16 + fq * 4);
        float vals[8] = {a.x, -bq.x, a.y, -bq.y, a.z, -bq.z, a.w, -bq.w};
#pragma unroll
        for (int j = 0; j < 8; ++j) {
          h16 hh = (h16)vals[j];
          chi[ks][j] = hh;
          clo[ks][j] = (h16)(vals[j] - (float)hh);
        }
      }
    }
#pragma unroll 1
    for (int sb = 0; sb < 16; ++sb) {
      const int sub = d == 0 ? sb : 15 - sb;
#pragma unroll 4
      for (int q = 0; q < 16; ++q) {
        const int tt = d == 0 ? q : 15 - q;
        const int t = sub * 16 + tt;
        h16x8 u0 = *(const h16x8*)(ulds + t * 32), u1 = *(const h16x8*)(ulds + t * 32 + 16);
        float br = 0, bi = 0;
#pragma unroll
        for (int i = 0; i < 8; ++i) { float u = (float)u0[i]; br = fmaf(u, Br[i], br); bi = fmaf(u, Bi[i], bi); }
#pragma unroll
        for (int i = 0; i < 8; ++i) { float u = (float)u1[i]; br = fmaf(u, Br[8 + i], br); bi = fmaf(u, Bi[8 + i], bi); }
        float vr = pp.br * br - pp.bi * bi, vi = pp.br * bi + pp.bi * br;
        float nxr = pp.ar * xr - pp.ai * xi + vr, nxi = pp.ar * xi + pp.ai * xr + vi;
        xr = nxr; xi = nxi;
        h16x2 hv2 = {(h16)xr, (h16)xi};
        float lr_ = xr - (float)hv2[0], li_ = xi - (float)hv2[1];
        *(unsigned*)(tile + tt * 272 + lane * 4) = __builtin_bit_cast(unsigned, hv2);
        *(unsigned*)(tile + 4352 + tt * 272 + lane * 4) = pack_bf2(lr_, li_);
      }
      lds_fence();
      f32x4 acc = f32x4{0.f, 0.f, 0.f, 0.f};
#pragma unroll
      for (int ks = 0; ks < 4; ++ks) {
        bf16x8 ah = *(const bf16x8*)(tile + fr * 272 + ks * 64 + fq * 16);
        bf16x8 alo = *(const bf16x8*)(tile + 4352 + fr * 272 + ks * 64 + fq * 16);
        acc = __builtin_amdgcn_mfma_f32_16x16x32_f16(ah, chi[ks], acc, 0, 0, 0);
        acc = __builtin_amdgcn_mfma_f32_16x16x32_f16(alo, chi[ks], acc, 0, 0, 0);
        acc = __builtin_amdgcn_mfma_f32_16x16x32_f16(ah, clo[ks], acc, 0, 0, 0);
      }
      lds_fence();
#pragma unroll
      for (int r = 0; r < 4; ++r) {
        int tl = sub * 16 + fq * 4 + r;
        float* yp = S5Y + (size_t)(rowbase + tl) * 512 + g * 16 + fr;
        if (d == 0) {
          float u = (float)*(const h16*)(ulds + tl * 32 + fr * 2);
          *yp = acc[r] + dsk * u;
        } else {
          *yp = gelu_f(*yp + acc[r]);
        }
      }
    }
  }
}

DEV void prep_item(const Params& p, const Ctx& cx, int l, int item, char* smem) {
  const int tile = item >> 2, q = item & 3;
  const int row0 = tile * 64;
  const int tid = cx.tid;
  const h16* zc = (const h16*)(p.ws + OFF_REG2);
  h16* SC = (h16*)(p.ws + OFF_SCAN);
  const char* wt = p.ws + OFF_WT + (size_t)l * WT_SIZE;
  {
    const int d = q >> 1, isA = q & 1;
    const int coff = isA ? 3200 + d * 64 : 3072 + d * 64;
    int tok = tid >> 3, c8 = tid & 7;
    h16x8 cv = *(const h16x8*)(zc + (size_t)(row0 + tok) * ZC + coff + c8 * 8);
    float f[8];
#pragma unroll
    for (int j = 0; j < 8; ++j) { f[j] = (float)cv[j]; if (!isA) f[j] = tanh_f(f[j]); }
    uint4 o;
    o.x = pack_bf2(f[0], f[1]); o.y = pack_bf2(f[2], f[3]); o.z = pack_bf2(f[4], f[5]); o.w = pack_bf2(f[6], f[7]);
    *(uint4*)(smem + tok * 144 + c8 * 16) = o;
    __syncthreads();
    const bf16_t* Bt = (const bf16_t*)(wt + (isA ? WT_A2 : WT_W2)) + (size_t)d * 1024 * 64;
    const float* biasw = p.rwkv_w0 + (size_t)(l * 2 + d) * 1024;
    const float* biasa = p.rwkv_a0 + (size_t)(l * 2 + d) * 1024;
    h16* dst = SC + (size_t)(isA ? 4 + d : 6 + d) * ARR;
#pragma unroll 1
    for (int hf = 0; hf < 2; ++hf) small_gemm<64, 4>(p, cx, smem, 144, Bt, (tid >> 6) * 128 + hf * 64, [&](int m, int n, f32x4 v) {
      float4 bbw = *(const float4*)(biasw + n), bba = *(const float4*)(biasa + n);
      float4 bb = isA ? bba : bbw;
      float r0 = sigmoid_f(v[0] + bb.x), r1 = sigmoid_f(v[1] + bb.y), r2 = sigmoid_f(v[2] + bb.z), r3 = sigmoid_f(v[3] + bb.w);
      if (!isA) { r0 = __expf(-DECAY_SCALE * r0); r1 = __expf(-DECAY_SCALE * r1); r2 = __expf(-DECAY_SCALE * r2); r3 = __expf(-DECAY_SCALE * r3); }
      h16x4 o4 = {(h16)r0, (h16)r1, (h16)r2, (h16)r3};
      *(h16x4*)(dst + (size_t)(row0 + m) * 1024 + n) = o4;
    });
  }
  {
    const float* cw = p.conv_rkv + (size_t)l * 3 * 3072;
#pragma unroll 1
    for (int it = 0; it < 4; ++it) {
      int idx = tid + it * 512;
      int grp = idx & 7, hh = (idx >> 3) & 3, tok = idx >> 5;
      int row = row0 + tok;
      int c0 = (4 * q + hh) * 64 + grp * 8;
      bool hasp, hasn;
      if (row < NLAT) { hasp = (row & 16383) != 0; hasn = (row & 16383) != 16383; }
      else { hasp = (row & 255) != 0; hasn = (row & 255) != 255; }
      size_t off = (size_t)row * 1024 + c0;
      float kv[8];
#pragma unroll 1
      for (int s = 0; s < 3; ++s) {
        int ch = s * 1024 + c0;
        const h16* zp = zc + (size_t)row * ZC + ch;
        h16x8 cur = *(const h16x8*)zp;
        h16x8 prv = cur, nxt = cur;
        if (hasp) prv = *(const h16x8*)(zp - ZC);
        if (hasn) nxt = *(const h16x8*)(zp + ZC);
        float ov[8];
#pragma unroll
        for (int j = 0; j < 8; j += 4) {
          float4 a = *(const float4*)(cw + ch + j), bq = *(const float4*)(cw + 3072 + ch + j), cq = *(const float4*)(cw + 6144 + ch + j);
          float w0[4] = {a.x, a.y, a.z, a.w}, w1[4] = {bq.x, bq.y, bq.z, bq.w}, w2[4] = {cq.x, cq.y, cq.z, cq.w};
#pragma unroll
          for (int jj = 0; jj < 4; ++jj) {
            float pv = hasp ? (float)prv[j + jj] : 0.f, nv = hasn ? (float)nxt[j + jj] : 0.f;
            ov[j + jj] = w0[jj] * pv + w1[jj] * (float)cur[j + jj] + w2[jj] * nv;
          }
        }
        h16x8 o;
#pragma unroll
        for (int j = 0; j < 8; ++j) o[j] = (h16)ov[j];
        *(h16x8*)(SC + (size_t)s * ARR + off) = o;
        if (s == 1) {
#pragma unroll
          for (int j = 0; j < 8; ++j) kv[j] = ov[j];
        }
      }
      float kk[8], ss = 0;
#pragma unroll
      for (int j = 0; j < 8; j += 4) {
        float4 kq = *(const float4*)(p.rwkv_k_k + (size_t)l * 1024 + c0 + j);
        kk[j] = kv[j] * kq.x; kk[j + 1] = kv[j + 1] * kq.y; kk[j + 2] = kv[j + 2] * kq.z; kk[j + 3] = kv[j + 3] * kq.w;
      }
#pragma unroll
      for (int j = 0; j < 8; ++j) ss += kk[j] * kk[j];
      ss = allreduce8(ss);
      float inv = rcp_f(fmaxf(sqrtf(ss), 1e-12f));
      h16x8 o;
#pragma unroll
      for (int j = 0; j < 8; ++j) o[j] = (h16)(kk[j] * inv);
      *(h16x8*)(SC + 3 * ARR + off) = o;
    }
  }
}

DEV void phase_prep(const Params& p, const Ctx& cx0, int l, char* smem) {
  const int NPREP = 520 * 4, NS5 = 520;
  const Ctx& cx_ = cx0;
  for (int item = cx_.bid; item < NPREP + NS5; item += cx_.nblk) {
    __syncthreads();
    Ctx cx = cx0; asm volatile("" : "+v"(cx.tid));
    const int lane = cx.tid & 63, wid = cx.tid >> 6;
#ifndef NO_PREPITEM
    if (item < NPREP) prep_item(p, cx, l, item, smem);
    else
#endif
#ifndef NO_S5P1
      s5_pass1_unit(p, cx, l, (item - NPREP) * 8 + wid, smem + wid * 8192, lane);
#else
    {}
#endif
  }
}

typedef unsigned u2v __attribute__((ext_vector_type(2)));
struct RG { u2v w, a, kk, k, r; h16 v; };

DEV void rwkv_task(const Params& p, const Ctx& cx, int l, int task, int lane, char* wl) {
  const int unit = task >> 4, d = unit & 1, h = (unit >> 1) & 15, b = unit >> 5;
  const int j = lane >> 4, s = lane & 15;
  const int myrow = (task & 15) * 4 + j;
  const h16* SC = (const h16*)(p.ws + OFF_SCAN);
  const char* pR = (const char*)(SC + 0 * ARR + h * 64);
  const char* pK = (const char*)(SC + 1 * ARR + h * 64);
  const char* pV = (const char*)(SC + 2 * ARR + h * 64);
  const char* pKK = (const char*)(SC + 3 * ARR + h * 64);
  const char* pA = (const char*)(SC + (size_t)(4 + d) * ARR + h * 64);
  const char* pW = (const char*)(SC + (size_t)(6 + d) * ARR + h * 64);
  char* pO = (char*)((h16*)(p.ws + OFF_REG2) + (size_t)d * ARR + h * 64);
  const int jm = d ? 3 - j : j;
  const int sm = d ? 3 - (s & 3) : (s & 3);
  const unsigned vo0 = (unsigned)(jm * 2048 + s * 8);
  const unsigned vov0 = (unsigned)(sm * 2048 + myrow * 2);
  typedef float f4 __attribute__((ext_vector_type(4)));
  f4 ka4, om4;
  {
    float4 t = *(const float4*)(p.rwkv_k_a + (size_t)l * 1024 + h * 64 + 4 * s);
    ka4 = f4{t.x, t.y, t.z, t.w};
    om4 = 1.f - ka4;
  }
  f4 S = {0.f, 0.f, 0.f, 0.f};
  constexpr int NG = 16640 / 4;
  static_assert(NG % 8 == 0, "ring");
  RG q0, q1, q2, q3, q4, q5, q6, q7;
  const unsigned wofs = (unsigned)(j * 256 + s * 16);
  const unsigned vwofs = (unsigned)(5120 + (s & 3) * 8 + j * 2);
  const unsigned rofs = (unsigned)(s * 16);
  const unsigned vrofs = (unsigned)(5120 + j * 2);

#define RW_RLO(gq, rlo)                                                            \
  {                                                                                \
    const int gg = (gq) < NG ? (gq) : NG - 1;                                      \
    const int q0_ = gg * 4;                                                        \
    const int isl = q0_ >= 256;                                                    \
    const int base_ = isl ? b * 16384 : NLAT + b * 256;                            \
    const int t0_ = isl ? q0_ - 256 : q0_;                                         \
    const int last_ = isl ? 16383 : 255;                                           \
    rlo = base_ + (d ? last_ - t0_ - 3 : t0_);                                     \
  }
#define RW_LOAD(q, gq)                                                             \
  {                                                                                \
    int rlo; RW_RLO(gq, rlo);                                                      \
    unsigned vo = vo0, vov = vov0; asm volatile("" : "+v"(vo), "+v"(vov));         \
    const size_t off = (size_t)rlo * 2048;                                         \
    q.w = *(const u2v*)(pW + off + vo); q.a = *(const u2v*)(pA + off + vo);        \
    q.kk = *(const u2v*)(pKK + off + vo); q.k = *(const u2v*)(pK + off + vo);      \
    q.r = *(const u2v*)(pR + off + vo); q.v = *(const h16*)(pV + off + vov);       \
  }
#define CV4(uv) __builtin_convertvector(__builtin_bit_cast(h16x4, uv), f4)
#define RW_STAGE(q, gq)                                                            \
  {     \
    char* sl = wl + ((gq) & 1) * 5248;                                             \
    const f4 a_ = CV4(q.a), kk_ = CV4(q.kk);                                       \
    *(f4*)(sl + 0 * 1024 + wofs) = CV4(q.w);                                       \
    *(f4*)(sl + 1 * 1024 + wofs) = kk_;                                            \
    *(f4*)(sl + 2 * 1024 + wofs) = kk_ * a_;                                       \
    *(f4*)(sl + 3 * 1024 + wofs) = CV4(q.k) * (a_ * ka4 + om4);                    \
    *(f4*)(sl + 4 * 1024 + wofs) = CV4(q.r);                                       \
    *(h16*)(sl + vwofs) = q.v;                                                     \
  }
#define RW_COMPUTE(gq)                                                             \
  {                                                                                \
    const char* sl = wl + ((gq) & 1) * 5248;                                       \
    float dres[4];                                                                 \
    _Pragma("unroll") for (int u = 0; u < 4; ++u) {                                \
      const f4 w_ = *(const f4*)(sl + 0 * 1024 + u * 256 + rofs);                  \
      const f4 kk_ = *(const f4*)(sl + 1 * 1024 + u * 256 + rofs);                 \
      const f4 kka_ = *(const f4*)(sl + 2 * 1024 + u * 256 + rofs);                \
      const f4 kd_ = *(const f4*)(sl + 3 * 1024 + u * 256 + rofs);                 \
      const f4 r_ = *(const f4*)(sl + 4 * 1024 + u * 256 + rofs);                  \
      const float vj = (float)*(const h16*)(sl + u * 8 + vrofs);                   \
      const f4 pd = S * kk_;                                                       \
      const float d1 = allreduce16((pd.x + pd.y) + (pd.z + pd.w));                 \
      S = S * w_ + kd_ * vj;                                                       \
      S = S - kka_ * d1;                                                           \
      const f4 pe = S * r_;                                                        \
      dres[u] = allreduce16((pe.x + pe.y) + (pe.z + pe.w));                        \
    }                                                                              \
    {                                                                              \
      int rlo; RW_RLO(gq, rlo);                                                    \
      const int su = s & 3;                                                        \
      unsigned vov = vov0; asm volatile("" : "+v"(vov));                           \
      float val = su == 0 ? dres[0] : (su == 1 ? dres[1] : (su == 2 ? dres[2] : dres[3])); \
      *(h16*)(pO + (size_t)rlo * 2048 + vov) = (h16)val;                           \
    }                                                                              \
  }
#define SB __builtin_amdgcn_sched_barrier(0)

#define CB asm volatile("" ::: "memory")
  RW_LOAD(q0, 0); RW_LOAD(q1, 1); RW_LOAD(q2, 2); RW_LOAD(q3, 3); RW_LOAD(q4, 4); RW_LOAD(q5, 5); RW_LOAD(q6, 6); RW_LOAD(q7, 7);
  RW_STAGE(q0, 0); CB;
#pragma unroll 1
  for (int g = 0; g < NG; g += 8) {
    RW_STAGE(q1, g + 1); RW_LOAD(q0, g + 8); RW_COMPUTE(g); CB; SB;
    RW_STAGE(q2, g + 2); RW_LOAD(q1, g + 9); RW_COMPUTE(g + 1); CB; SB;
    RW_STAGE(q3, g + 3); RW_LOAD(q2, g + 10); RW_COMPUTE(g + 2); CB; SB;
    RW_STAGE(q4, g + 4); RW_LOAD(q3, g + 11); RW_COMPUTE(g + 3); CB; SB;
    RW_STAGE(q5, g + 5); RW_LOAD(q4, g + 12); RW_COMPUTE(g + 4); CB; SB;
    RW_STAGE(q6, g + 6); RW_LOAD(q5, g + 13); RW_COMPUTE(g + 5); CB; SB;
    RW_STAGE(q7, g + 7); RW_LOAD(q6, g + 14); RW_COMPUTE(g + 6); CB; SB;
    RW_STAGE(q0, g + 8); RW_LOAD(q7, g + 15); RW_COMPUTE(g + 7); CB; SB;
  }
#undef CB
#undef SB
#undef RW_RLO
#undef RW_LOAD
#undef RW_COMPUTE
#undef RW_STAGE
#undef CV4
}

DEV void phase_scan(const Params& p, const Ctx& cx, int l, char* smem) {
  const int lane = cx.tid & 63, wid = __builtin_amdgcn_readfirstlane(cx.tid >> 6);
  char* wl = smem + wid * 17408;
  const int NS5U = 2 * 32 * 65;
  if (wid < 4) {
    for (int slot = cx.bid; slot < 256; slot += cx.nblk) {
      const int task = ((slot & 63) << 4) | ((slot >> 6) << 2) | wid;
#ifndef NO_RWKV
      rwkv_task(p, cx, l, task, lane, wl);
#endif
    }
  } else {
    for (int u = cx.bid * 4 + (wid - 4); u < NS5U; u += cx.nblk * 4) {
      if (l == 1 && (u % 65) == 0) continue;
#ifndef NO_S5P3
      s5_pass3_unit(p, cx, l, u, wl, lane);
#endif
    }
  }
}

DEV void pool_item(const Params& p, const Ctx& cx, int l, int item, char* smem) {
  const int tid = cx.tid;
  const h16* zrest = (const h16*)(p.ws + OFF_ZREST);
  bf16_t* ym = (bf16_t*)(p.ws + OFF_YM);
  const char* wt = p.ws + OFF_WT + (size_t)l * WT_SIZE;
  float* V = (float*)smem;
  char* At = smem + 43008;
  int g, rowout0, Lseq, p0, rlo, rhi, rstride, rowsrc0;
  if (item < 2048) {
    g = item & 3; int r = (item >> 2) & 255, b = item >> 10;
    int w = 2 << g;
    rlo = max(r - w / 2, 0); rhi = min(r + w / 2 - 1, 255);
    rowsrc0 = b * 16384; rstride = 64;
    rowout0 = b * 16384 + r * 64; Lseq = 64; p0 = 0;
  } else {
    int it = item - 2048;
    g = it & 3; int tq = (it >> 2) & 3, b = it >> 4;
    rlo = 0; rhi = 0; rowsrc0 = NLAT + b * 256; rstride = 0;
    rowout0 = NLAT + b * 256 + tq * 64; Lseq = 256; p0 = tq * 64;
  }
  const int w = 2 << g;
  const float invr = 1.f / (float)(rhi - rlo + 1);
  for (int unit = tid; unit < 80 * 16; unit += NTHREADS) {
    int lp = unit >> 4, ch8 = unit & 15;
    int pos = p0 - 8 + lp;
    float acc[8] = {0, 0, 0, 0, 0, 0, 0, 0};
    if (pos >= 0 && pos < Lseq) {
      for (int rr = rlo; rr <= rhi; ++rr) {
        h16x8 v = *(const h16x8*)(zrest + (size_t)(rowsrc0 + rr * rstride + pos) * ZR + 1024 + g * 128 + ch8 * 8);
#pragma unroll
        for (int j = 0; j < 8; ++j) acc[j] += (float)v[j];
      }
    }
    float* vp = V + lp * 132 + ch8 * 8;
#pragma unroll
    for (int j = 0; j < 8; ++j) vp[j] = acc[j] * invr;
  }
  __syncthreads();
  for (int unit = tid; unit < 64 * 16; unit += NTHREADS) {
    int c = unit >> 4, ch8 = unit & 15;
    int pos = p0 + c;
    int lo = max(pos - w / 2, 0), hi = min(pos + w / 2 - 1, Lseq - 1);
    float acc[8] = {0, 0, 0, 0, 0, 0, 0, 0};
    for (int pp = lo; pp <= hi; ++pp) {
      const float* vp = V + (pp - p0 + 8) * 132 + ch8 * 8;
#pragma unroll
      for (int j = 0; j < 8; ++j) acc[j] += vp[j];
    }
    float invc = 1.f / (float)(hi - lo + 1);
    h16x8 uc = *(const h16x8*)(zrest + (size_t)(rowout0 + c) * ZR + 1024 + g * 128 + ch8 * 8);
    uint4 o;
    o.x = pack_bf2(acc[0] * invc - (float)uc[0], acc[1] * invc - (float)uc[1]);
    o.y = pack_bf2(acc[2] * invc - (float)uc[2], acc[3] * invc - (float)uc[3]);
    o.z = pack_bf2(acc[4] * invc - (float)uc[4], acc[5] * invc - (float)uc[5]);
    o.w = pack_bf2(acc[6] * invc - (float)uc[6], acc[7] * invc - (float)uc[7]);
    *(uint4*)(At + c * 272 + ch8 * 16) = o;
  }
  __syncthreads();
  const bf16_t* Bt = (const bf16_t*)(wt + WT_POOL) + (size_t)g * 128 * 128;
  const float* ps = p.pool_scale + (size_t)l * 512 + g * 128;
  small_gemm<128, 1>(p, cx, At, 272, Bt, (tid >> 6) * 16, [&](int m, int n, f32x4 v) {
    int row = rowout0 + m;
    float4 sc = *(const float4*)(ps + n);
    h16x4 gt = *(const h16x4*)(zrest + (size_t)row * ZR + 1536 + g * 128 + n);
    uint2 o;
    o.x = pack_bf2(v[0] * sc.x * silu_f((float)gt[0]), v[1] * sc.y * silu_f((float)gt[1]));
    o.y = pack_bf2(v[2] * sc.z * silu_f((float)gt[2]), v[3] * sc.w * silu_f((float)gt[3]));
    *(uint2*)(ym + (size_t)row * D + 512 + g * 128 + n) = o;
  });
}

DEV void glu_item(const Params& p, const Ctx& cx, int l, int tile, char* smem) {
  const int tid = cx.tid;
  const int row0 = tile * 64;
  const float* S5Y = (const float*)(p.ws + OFF_S5Y);
  const h16* zrest = (const h16*)(p.ws + OFF_ZREST);
  bf16_t* ym = (bf16_t*)(p.ws + OFF_YM);
  const char* wt = p.ws + OFF_WT + (size_t)l * WT_SIZE;
#pragma unroll
  for (int it = 0; it < 8; ++it) {
    int unit = tid + it * NTHREADS;
    int r = unit >> 6, c8 = unit & 63;
    const float* sp = S5Y + (size_t)(row0 + r) * 512 + c8 * 8;
    float4 a = *(const float4*)sp, bq = *(const float4*)(sp + 4);
    uint4 o;
    o.x = pack_bf2(a.x, a.y); o.y = pack_bf2(a.z, a.w); o.z = pack_bf2(bq.x, bq.y); o.w = pack_bf2(bq.z, bq.w);
    *(uint4*)(smem + r * 1040 + c8 * 16) = o;
  }
  __syncthreads();
  const bf16_t* Bt = (const bf16_t*)(wt + WT_GLU);
  const float* bg = p.b_glu + (size_t)l * 512;
  small_gemm<512, 4>(p, cx, smem, 1040, Bt, (tid >> 6) * 64, [&](int m, int n, f32x4 v) {
    int row = row0 + m;
    float4 y = *(const float4*)(S5Y + (size_t)row * 512 + n);
    float4 bb = *(const float4*)(bg + n);
    h16x4 gt = *(const h16x4*)(zrest + (size_t)row * ZR + 512 + n);
    uint2 o;
    o.x = pack_bf2(y.x * sigmoid_f(v[0] + bb.x) * silu_f((float)gt[0]), y.y * sigmoid_f(v[1] + bb.y) * silu_f((float)gt[1]));
    o.y = pack_bf2(y.z * sigmoid_f(v[2] + bb.z) * silu_f((float)gt[2]), y.w * sigmoid_f(v[3] + bb.w) * silu_f((float)gt[3]));
    *(uint2*)(ym + (size_t)row * D + n) = o;
  });
}

DEV void rwkvmerge_item(const Params& p, const Ctx& cx, int l, int tile) {
  const int tid = cx.tid;
  const int row0 = tile * 64;
  const h16* SC = (const h16*)(p.ws + OFF_SCAN);
  const h16* O = (const h16*)(p.ws + OFF_REG2);
  const h16* zrest = (const h16*)(p.ws + OFF_ZREST);
  bf16_t* ym = (bf16_t*)(p.ws + OFF_YM);
#pragma unroll 1
  for (int it = 0; it < 16; ++it) {
    int idx = tid + it * NTHREADS;
    int grp = idx & 7, h = (idx >> 3) & 15, tok = idx >> 7;
    int row = row0 + tok;
    int c0 = h * 64 + grp * 8;
    size_t off = (size_t)row * 1024 + c0;
    h16x8 of = *(const h16x8*)(O + off), ob = *(const h16x8*)(O + ARR + off);
    float o[8], sm = 0;
#pragma unroll
    for (int j = 0; j < 8; ++j) { o[j] = (float)of[j] + (float)ob[j]; sm += o[j]; }
    sm = allreduce8(sm);
    float mu = sm * (1.f / 64.f), vq = 0;
#pragma unroll
    for (int j = 0; j < 8; ++j) { o[j] -= mu; vq += o[j] * o[j]; }
    vq = allreduce8(vq);
    float rstd = rsqrtf(vq * (1.f / 64.f) + 64e-5f);
    h16x8 r8 = *(const h16x8*)(SC + 0 * ARR + off), k8 = *(const h16x8*)(SC + 1 * ARR + off), v8 = *(const h16x8*)(SC + 2 * ARR + off);
    h16x8 af = *(const h16x8*)(SC + 4 * ARR + off), ab = *(const h16x8*)(SC + 5 * ARR + off);
    float pk[8], rk[8], gw[8], gb[8];
#pragma unroll
    for (int j = 0; j < 8; j += 4) {
      float4 t0 = *(const float4*)(p.rwkv_k_a + (size_t)l * 1024 + c0 + j), t1 = *(const float4*)(p.rwkv_r_k + (size_t)l * 1024 + c0 + j);
      float4 t2 = *(const float4*)(p.gn_w + (size_t)l * 1024 + c0 + j), t3 = *(const float4*)(p.gn_b + (size_t)l * 1024 + c0 + j);
      pk[j] = t0.x; pk[j + 1] = t0.y; pk[j + 2] = t0.z; pk[j + 3] = t0.w;
      rk[j] = t1.x; rk[j + 1] = t1.y; rk[j + 2] = t1.z; rk[j + 3] = t1.w;
      gw[j] = t2.x; gw[j + 1] = t2.y; gw[j + 2] = t2.z; gw[j + 3] = t2.w;
      gb[j] = t3.x; gb[j + 1] = t3.y; gb[j + 2] = t3.z; gb[j + 3] = t3.w;
    }
    float part = 0;
#pragma unroll
    for (int j = 0; j < 8; ++j) {
      float ksum = (float)k8[j] * (2.f + ((float)af[j] + (float)ab[j] - 2.f) * pk[j]);
      part += (float)r8[j] * ksum * rk[j];
    }
    part = allreduce8(part);
    h16x8 gt = *(const h16x8*)(zrest + (size_t)row * ZR + 2048 + c0);
    float res[8];
#pragma unroll
    for (int j = 0; j < 8; ++j) {
      float y = o[j] * rstd * gw[j] + gb[j] + part * (float)v8[j];
      res[j] = y * silu_f((float)gt[j]);
    }
    uint4 ov;
    ov.x = pack_bf2(res[0], res[1]); ov.y = pack_bf2(res[2], res[3]); ov.z = pack_bf2(res[4], res[5]); ov.w = pack_bf2(res[6], res[7]);
    *(uint4*)(ym + (size_t)row * D + 1024 + c0) = ov;
  }
}

DEV void phase_merge(const Params& p, const Ctx& cx0, int l, char* smem) {
  const int ntile = (l == 0) ? 520 : 512;
  const int npool = (l == 0) ? 2048 + 32 : 2048;
  const int total = npool + 2 * ntile;
  for (int item = cx0.bid; item < total; item += cx0.nblk) {
    __syncthreads();
    Ctx cx = cx0; asm volatile("" : "+v"(cx.tid));
    if (item < npool) pool_item(p, cx, l, item, smem);
    else if (item < npool + ntile) glu_item(p, cx, l, item - npool, smem);
    else rwkvmerge_item(p, cx, l, item - npool - ntile);
  }
}

#define LCX Ctx c2 = cx; asm volatile("" : "+v"(c2.tid))
#ifndef GEMM_FN
#define GEMM_FN gemm_phase2
#endif
__global__ void __launch_bounds__(NTHREADS) mega_fwd(Params p, int ph0, int ph1) {
  extern __shared__ __attribute__((aligned(16))) char smem[];
  cg::grid_group grid = cg::this_grid();
  const int wave_s = __builtin_amdgcn_readfirstlane((int)(threadIdx.x >> 6));
  for (int step = ph0; step < ph1; ++step) {
    if (step > ph0) grid.sync();
    const int ph = (int)((PH_SEQ >> (4 * step)) & 15ull);
    Ctx cx;
    {
      int t_, b_ = blockIdx.x, n_ = gridDim.x;
      asm volatile("v_mbcnt_lo_u32_b32 %0, -1, 0\n\tv_mbcnt_hi_u32_b32 %0, -1, %0\n\tv_lshl_add_u32 %0, %1, 6, %0" : "=&v"(t_) : "s"(wave_s));
      asm volatile("" : "+s"(b_), "+s"(n_));
      cx.tid = t_; cx.bid = b_; cx.nblk = n_;
    }
    const int l = ph >= 8 ? 1 : 0;
    const int lp = ph >= 8 ? ph - 6 : ph;
#ifndef PHMASK
#define PHMASK 0xff
#endif
    if (ph == 0) { if (PHMASK & 1) { LCX; phase0(p, c2, smem); } }
    else if (ph == 1) { if (PHMASK & 2) { LCX; phase_adaln0(p, c2); } }
    else if (lp == 2 && (PHMASK & 4)) {
      LCX;
      h16* zrest = (h16*)(p.ws + OFF_ZREST);
      h16* zc = (h16*)(p.ws + OFF_REG2);
      GEMM_FN(p, c2, (const bf16_t*)(p.ws + OFF_H), (const bf16_t*)(p.ws + OFF_WT + (size_t)l * WT_SIZE + WT_IN), 2048, 130, 25, smem,
                 [&](int row, int col, f32x4 v) {
                   h16* dst;
                   if (col < 2048) dst = zrest + (size_t)row * ZR + col;
                   else if (col < 5120) dst = zc + (size_t)row * ZC + (col - 2048);
                   else if (col < 6144) dst = zrest + (size_t)row * ZR + 2048 + (col - 5120);
                   else dst = zc + (size_t)row * ZC + 3072 + (col - 6144);
                   h16x4 o = {(h16)v[0], (h16)v[1], (h16)v[2], (h16)v[3]};
                   *(h16x4*)dst = o;
                 });
    } else if (lp == 3) { if (PHMASK & 8) { LCX; phase_prep(p, c2, l, smem); } }
    else if (lp == 4) { if (PHMASK & 16) { LCX; phase_scan(p, c2, l, smem); } }
    else if (lp == 5) { if (PHMASK & 32) { LCX; phase_merge(p, c2, l, smem); } }
    else if (lp == 6 && (PHMASK & 64)) {
      LCX;
      const float* mods = (const float*)(p.ws + OFF_MODS);
      float* prec = (float*)(p.ws + OFF_PREC);
      const float* xin = (l == 0) ? p.x : p.out;
      GEMM_FN(p, c2, (const bf16_t*)(p.ws + OFF_YM), (const bf16_t*)(p.ws + OFF_WT + (size_t)l * WT_SIZE + WT_OUT), 2048, l == 0 ? 130 : 128, 8, smem,
                 [&](int row, int col, f32x4 v) {
                   if (row < NLAT) {
                     float4 xv = *(const float4*)(xin + (size_t)row * D + col);
                     float4 gv = *(const float4*)(mods + (size_t)(l * 3 + (row >> 14)) * 6144 + 4096 + col);
                     float4 r;
                     r.x = ALPHA * xv.x + gv.x * v[0]; r.y = ALPHA * xv.y + gv.y * v[1]; r.z = ALPHA * xv.z + gv.z * v[2]; r.w = ALPHA * xv.w + gv.w * v[3];
                     *(float4*)(p.out + (size_t)row * D + col) = r;
                   } else {
                     float4 xv = *(const float4*)(p.ctx + (size_t)(row - NLAT) * D + col);
                     float4 gv = *(const float4*)(mods + (size_t)(l * 3 + 2) * 6144 + 4096 + col);
                     float4 r;
                     r.x = ALPHA * xv.x + gv.x * v[0]; r.y = ALPHA * xv.y + gv.y * v[1]; r.z = ALPHA * xv.z + gv.z * v[2]; r.w = ALPHA * xv.w + gv.w * v[3];
                     *(float4*)(prec + (size_t)(row - NLAT) * D + col) = r;
                   }
                 });
    } else if (lp == 7) { if (PHMASK & 128) { LCX; phase_finln(p, c2, l); } }
  }
}

constexpr int NPHASES = PH_NSTEPS;

extern "C" void kernel_launch(void* const* d_in, const int* in_sizes, int n_in, void* d_out, int out_size, void* d_ws, size_t ws_size,
                              hipStream_t stream) {
  static int grid_blocks = 0;
  if (grid_blocks == 0) {
    if (n_in != 32 || ws_size < WS_END) { fprintf(stderr, "kernel_launch: unexpected n_in %d / ws %zu (need %zu)\n", n_in, ws_size, (size_t)WS_END); grid_blocks = -1; return; }
    int dev = 0, cus = 0, per_cu = 0;
    hipGetDevice(&dev);
    hipDeviceGetAttribute(&cus, hipDeviceAttributeMultiprocessorCount, dev);
    if (hipFuncSetAttribute((const void*)mega_fwd, hipFuncAttributeMaxDynamicSharedMemorySize, LDS_BYTES) != hipSuccess) { fprintf(stderr, "hipFuncSetAttribute failed\n"); grid_blocks = -1; return; }
    if (hipOccupancyMaxActiveBlocksPerMultiprocessor(&per_cu, (const void*)mega_fwd, NTHREADS, LDS_BYTES) != hipSuccess || per_cu < 1) {
      fprintf(stderr, "occupancy query gave %d\n", per_cu); (void)hipGetLastError(); per_cu = 1;
    }
    grid_blocks = cus * per_cu;
  }
  if (grid_blocks < 0) return;
  Params p{};
  const float** pp = (const float**)&p;
  for (int i = 0; i < 32; ++i) pp[i] = (const float*)d_in[i];
  p.out = (float*)d_out;
  p.ws = (char*)d_ws;
  int ph0 = 0, ph1 = NPHASES;
  void* args[] = {&p, &ph0, &ph1};
  hipError_t e = hipLaunchCooperativeKernel((const void*)mega_fwd, dim3(grid_blocks), dim3(NTHREADS), args, LDS_BYTES, stream);
  if (e != hipSuccess) fprintf(stderr, "cooperative launch failed: %s (grid %d)\n", hipGetErrorString(e), grid_blocks);
}
```

```cpp
#include <hip/hip_runtime.h>
#include <hip/hip_cooperative_groups.h>
#include <cstdio>
namespace cg = cooperative_groups;

typedef unsigned short bf16_t;
typedef _Float16 h16;
using bf16x8 = __attribute__((ext_vector_type(8))) _Float16;
using f32x4 = __attribute__((ext_vector_type(4))) float;
using h16x4 = __attribute__((ext_vector_type(4))) _Float16;
using h16x8 = __attribute__((ext_vector_type(8))) _Float16;

#define DEV __device__ __forceinline__

constexpr int D = 2048, NLAT = 32768, MTOT = 33280, ZR = 3072, ZC = 3328;
constexpr int NTHREADS = 512;
constexpr int LDS_BYTES = 147456;
constexpr float ALPHA = 1.41421356237f;
constexpr float DECAY_SCALE = 0.606531f;

constexpr size_t al256(size_t x) { return (x + 255) & ~size_t(255); }
constexpr size_t ARR = (size_t)MTOT * 1024;
constexpr size_t OFF_MODS = 0;
constexpr size_t OFF_S5F = al256(OFF_MODS + 2 * 3 * 6144 * 4);
constexpr size_t OFF_PREC = al256(OFF_S5F + (size_t)2 * 32 * 65 * 2 * 64 * 8);
constexpr size_t OFF_WT = al256(OFF_PREC + (size_t)512 * 2048 * 4);
constexpr size_t WT_IN = 0, WT_OUT = 26214400, WT_W2 = 34603008, WT_A2 = 34865152, WT_POOL = 35127296, WT_GLU = 35258368, WT_SIZE = 35782656;
constexpr size_t OFF_ZREST = al256(OFF_WT + 2 * WT_SIZE);
constexpr size_t OFF_REG2 = al256(OFF_ZREST + (size_t)MTOT * ZR * 2);
constexpr size_t OFF_S5Y = OFF_REG2 + 2 * ARR * 2;
constexpr size_t OFF_SCAN = al256(OFF_REG2 + (size_t)MTOT * ZC * 2);
constexpr size_t OFF_H = OFF_SCAN;
constexpr size_t OFF_YM = OFF_SCAN + 6 * ARR * 2;
constexpr size_t WS_END = OFF_SCAN + 8 * ARR * 2;

#ifndef PH_SEQ
#define PH_SEQ 0xDCBA9876543210ull
#define PH_NSTEPS 14
#endif
struct Params {
  const float *x, *c, *ctx, *c_ctx, *w_ada, *b_ada, *w_in, *conv_rkv, *s5_lam_re, *s5_lam_im, *s5_log_step,
      *s5_b_re, *s5_b_im, *s5_c_re, *s5_c_im, *s5_d, *w_glu, *b_glu, *w_pool, *pool_scale,
      *rwkv_w0, *rwkv_w2, *rwkv_a0, *rwkv_a2, *rwkv_k_k, *rwkv_k_a, *rwkv_r_k, *gn_w, *gn_b,
      *w_out, *ln_g, *ln_b;
  float* out;
  char* ws;
};
struct Ctx { int tid, bid, nblk; };

DEV float rcp_f(float x) { return __builtin_amdgcn_rcpf(x); }
DEV float sigmoid_f(float x) { return rcp_f(1.f + __expf(-x)); }
DEV float silu_f(float x) { return x * rcp_f(1.f + __expf(-x)); }
DEV float tanh_f(float x) { float e = __expf(2.f * x); return 1.f - 2.f * rcp_f(e + 1.f); }
DEV float gelu_f(float y) { return 0.5f * y * (1.f + tanh_f(0.7978845608f * (y + 0.044715f * y * y * y))); }
using h16x2 = __attribute__((ext_vector_type(2))) _Float16;
DEV unsigned pack_bf2(float a, float b) { h16x2 v = {(h16)a, (h16)b}; return __builtin_bit_cast(unsigned, v); }
template <int CTRL> DEV float dpp_mov(float v) {
  return __int_as_float(__builtin_amdgcn_update_dpp(0, __float_as_int(v), CTRL, 0xf, 0xf, true));
}
DEV float allreduce16(float v) {
  v += dpp_mov<0xB1>(v);
  v += dpp_mov<0x4E>(v);
  v += dpp_mov<0x141>(v);
  v += dpp_mov<0x140>(v);
  return v;
}
DEV float wave_sum(float v) {
  v = allreduce16(v);
  return __builtin_amdgcn_readlane(__float_as_int(v), 0) == 0 && false ? 0.f :
         __int_as_float(__builtin_amdgcn_readlane(__float_as_int(v), 0)) + __int_as_float(__builtin_amdgcn_readlane(__float_as_int(v), 16)) +
         __int_as_float(__builtin_amdgcn_readlane(__float_as_int(v), 32)) + __int_as_float(__builtin_amdgcn_readlane(__float_as_int(v), 48));
}
DEV float allreduce8(float v) {
  v += dpp_mov<0xB1>(v);
  v += dpp_mov<0x4E>(v);
  v += dpp_mov<0x141>(v);
  return v;
}
DEV void lds_fence() { asm volatile("s_waitcnt lgkmcnt(0)" ::: "memory"); }

DEV void p0_mods_item(const Params& p, const Ctx& cx, int item, char* smem) {
  float* red = (float*)smem;
  float* mods = (float*)(p.ws + OFF_MODS);
  int l = item / 96, chunk = item % 96;
  int tid = cx.tid, kq = tid >> 6, col = tid & 63;
  int n = chunk * 64 + col;
  const float* W = p.w_ada + (size_t)l * 2048 * 6144;
  float a0 = 0, a1 = 0, a2 = 0;
#pragma unroll 8
  for (int k = kq; k < 2048; k += 8) {
    float w = W[(size_t)k * 6144 + n];
    a0 += silu_f(p.c[k]) * w;
    a1 += silu_f(p.c[2048 + k]) * w;
    a2 += silu_f(p.c_ctx[k]) * w;
  }
  red[(kq * 3 + 0) * 64 + col] = a0;
  red[(kq * 3 + 1) * 64 + col] = a1;
  red[(kq * 3 + 2) * 64 + col] = a2;
  __syncthreads();
  if (tid < 192) {
    int r = tid >> 6, cc = tid & 63;
    float s = 0;
#pragma unroll
    for (int q = 0; q < 8; ++q) s += red[(q * 3 + r) * 64 + cc];
    mods[(size_t)(l * 3 + r) * 6144 + chunk * 64 + cc] = s + p.b_ada[(size_t)l * 6144 + chunk * 64 + cc];
  }
}

DEV void p0_transpose_tile(const Params& p, const Ctx& cx, const float* __restrict__ src, bf16_t* __restrict__ dst, int K, int N, int tk, int tn, char* smem) {
  float* T = (float*)smem;
  int tid = cx.tid;
  int k0 = tk * 64, n0 = tn * 64;
  int kk = tid >> 4, n4 = tid & 15;
#pragma unroll
  for (int i = 0; i < 2; ++i) {
    int k = kk + 32 * i;
    float4 v = *(const float4*)(src + (size_t)(k0 + k) * N + n0 + n4 * 4);
    T[k * 65 + n4 * 4 + 0] = v.x; T[k * 65 + n4 * 4 + 1] = v.y; T[k * 65 + n4 * 4 + 2] = v.z; T[k * 65 + n4 * 4 + 3] = v.w;
  }
  __syncthreads();
  int n = tid >> 3, k8 = tid & 7;
  uint4 o;
  o.x = pack_bf2(T[(k8 * 8 + 0) * 65 + n], T[(k8 * 8 + 1) * 65 + n]);
  o.y = pack_bf2(T[(k8 * 8 + 2) * 65 + n], T[(k8 * 8 + 3) * 65 + n]);
  o.z = pack_bf2(T[(k8 * 8 + 4) * 65 + n], T[(k8 * 8 + 5) * 65 + n]);
  o.w = pack_bf2(T[(k8 * 8 + 6) * 65 + n], T[(k8 * 8 + 7) * 65 + n]);
  *(uint4*)(dst + (size_t)(n0 + n) * K + k0 + k8 * 8) = o;
}

DEV void phase0(const Params& p, const Ctx& cx0, char* smem) {
  const int NTR = 4368;
  const int total = 192 + 2 * NTR;
  for (int item = cx0.bid; item < total; item += cx0.nblk) {
    __syncthreads();
    Ctx cx = cx0; asm volatile("" : "+v"(cx.tid));
    if (item < 192) { p0_mods_item(p, cx, item, smem); continue; }
    int it = item - 192;
    int l = it / NTR, i = it % NTR;
    char* wt = p.ws + OFF_WT + (size_t)l * WT_SIZE;
    if (i < 3200) {
      p0_transpose_tile(p, cx, p.w_in + (size_t)l * 2048 * 6400, (bf16_t*)(wt + WT_IN), 2048, 6400, i / 100, i % 100, smem);
    } else if (i < 4224) {
      int j = i - 3200;
      p0_transpose_tile(p, cx, p.w_out + (size_t)l * 2048 * 2048, (bf16_t*)(wt + WT_OUT), 2048, 2048, j / 32, j % 32, smem);
    } else if (i < 4256) {
      int j = i - 4224, d = j / 16;
      p0_transpose_tile(p, cx, p.rwkv_w2 + (size_t)(l * 2 + d) * 64 * 1024, (bf16_t*)(wt + WT_W2) + (size_t)d * 1024 * 64, 64, 1024, 0, j % 16, smem);
    } else if (i < 4288) {
      int j = i - 4256, d = j / 16;
      p0_transpose_tile(p, cx, p.rwkv_a2 + (size_t)(l * 2 + d) * 64 * 1024, (bf16_t*)(wt + WT_A2) + (size_t)d * 1024 * 64, 64, 1024, 0, j % 16, smem);
    } else if (i < 4304) {
      int j = i - 4288, g = j / 4;
      p0_transpose_tile(p, cx, p.w_pool + (size_t)(l * 4 + g) * 128 * 128, (bf16_t*)(wt + WT_POOL) + (size_t)g * 128 * 128, 128, 128, (j % 4) / 2, j % 2, smem);
    } else {
      int j = i - 4304;
      p0_transpose_tile(p, cx, p.w_glu + (size_t)l * 512 * 512, (bf16_t*)(wt + WT_GLU), 512, 512, j / 8, j % 8, smem);
    }
  }
}

DEV void phase_adaln0(const Params& p, const Ctx& cx) {
  const float* mods = (const float*)(p.ws + OFF_MODS);
  bf16_t* hbuf = (bf16_t*)(p.ws + OFF_H);
  int lane = cx.tid & 63;
  int gw = cx.bid * 8 + (cx.tid >> 6), nw = cx.nblk * 8;
  for (int row = gw; row < MTOT; row += nw) {
    const float* src = row < NLAT ? p.x + (size_t)row * D : p.ctx + (size_t)(row - NLAT) * D;
    int mr = row < NLAT ? (row >> 14) : 2;
    const float* md = mods + (size_t)mr * 6144;
    float4 v[8];
    float s = 0;
#pragma unroll
    for (int i = 0; i < 8; ++i) { v[i] = *(const float4*)(src + i * 256 + lane * 4); s += v[i].x + v[i].y + v[i].z + v[i].w; }
    float mu = wave_sum(s) * (1.f / 2048.f);
    float q = 0;
#pragma unroll
    for (int i = 0; i < 8; ++i) { v[i].x -= mu; v[i].y -= mu; v[i].z -= mu; v[i].w -= mu; q += v[i].x * v[i].x + v[i].y * v[i].y + v[i].z * v[i].z + v[i].w * v[i].w; }
    float rstd = rsqrtf(wave_sum(q) * (1.f / 2048.f) + 1e-6f);
#pragma unroll
    for (int i = 0; i < 8; ++i) {
      int col = i * 256 + lane * 4;
      float4 sh = *(const float4*)(md + col), sc = *(const float4*)(md + 2048 + col);
      uint2 o;
      o.x = pack_bf2(v[i].x * rstd * (1.f + sc.x) + sh.x, v[i].y * rstd * (1.f + sc.y) + sh.y);
      o.y = pack_bf2(v[i].z * rstd * (1.f + sc.z) + sh.z, v[i].w * rstd * (1.f + sc.w) + sh.w);
      *(uint2*)(hbuf + (size_t)row * D + col) = o;
    }
  }
}

DEV void phase_finln(const Params& p, const Ctx& cx, int l) {
  const float* mods = (const float*)(p.ws + OFF_MODS);
  bf16_t* hbuf = (bf16_t*)(p.ws + OFF_H);
  float* prec = (float*)(p.ws + OFF_PREC);
  int lane = cx.tid & 63;
  int gw = cx.bid * 8 + (cx.tid >> 6), nw = cx.nblk * 8;
  const int nrows = (l == 0) ? MTOT : NLAT;
  for (int row = gw; row < nrows; row += nw) {
    float* src = row < NLAT ? p.out + (size_t)row * D : prec + (size_t)(row - NLAT) * D;
    float4 v[8];
    float s = 0;
#pragma unroll
    for (int i = 0; i < 8; ++i) { v[i] = *(const float4*)(src + i * 256 + lane * 4); s += v[i].x + v[i].y + v[i].z + v[i].w; }
    float mu = wave_sum(s) * (1.f / 2048.f);
    float q = 0;
#pragma unroll
    for (int i = 0; i < 8; ++i) { v[i].x -= mu; v[i].y -= mu; v[i].z -= mu; v[i].w -= mu; q += v[i].x * v[i].x + v[i].y * v[i].y + v[i].z * v[i].z + v[i].w * v[i].w; }
    float rstd = rsqrtf(wave_sum(q) * (1.f / 2048.f) + 1e-5f);
    float s2 = 0;
#pragma unroll
    for (int i = 0; i < 8; ++i) {
      int col = i * 256 + lane * 4;
      float4 g = *(const float4*)(p.ln_g + (size_t)l * D + col), b = *(const float4*)(p.ln_b + (size_t)l * D + col);
      v[i].x = v[i].x * rstd * g.x + b.x; v[i].y = v[i].y * rstd * g.y + b.y; v[i].z = v[i].z * rstd * g.z + b.z; v[i].w = v[i].w * rstd * g.w + b.w;
      if (row < NLAT) *(float4*)(src + col) = v[i];
      s2 += v[i].x + v[i].y + v[i].z + v[i].w;
    }
    if (l == 0) {
      int mr = row < NLAT ? (row >> 14) : 2;
      const float* md = mods + (size_t)(3 + mr) * 6144;
      float mu2 = wave_sum(s2) * (1.f / 2048.f);
      float q2 = 0;
#pragma unroll
      for (int i = 0; i < 8; ++i) { v[i].x -= mu2; v[i].y -= mu2; v[i].z -= mu2; v[i].w -= mu2; q2 += v[i].x * v[i].x + v[i].y * v[i].y + v[i].z * v[i].z + v[i].w * v[i].w; }
      float rstd2 = rsqrtf(wave_sum(q2) * (1.f / 2048.f) + 1e-6f);
#pragma unroll
      for (int i = 0; i < 8; ++i) {
        int col = i * 256 + lane * 4;
        float4 sh = *(const float4*)(md + col), sc = *(const float4*)(md + 2048 + col);
        uint2 o;
        o.x = pack_bf2(v[i].x * rstd2 * (1.f + sc.x) + sh.x, v[i].y * rstd2 * (1.f + sc.y) + sh.y);
        o.y = pack_bf2(v[i].z * rstd2 * (1.f + sc.z) + sh.z, v[i].w * rstd2 * (1.f + sc.w) + sh.w);
        *(uint2*)(hbuf + (size_t)row * D + col) = o;
      }
    }
  }
}

template <class Epi>
DEV void gemm_phase(const Params& p, const Ctx& cx, const bf16_t* __restrict__ A, const bf16_t* __restrict__ Bt, int K, int nM, int nN, char* smem, Epi epi) {
  const int tid = cx.tid, lane = tid & 63, wid = tid >> 6;
  const int wr = wid >> 2, wc = wid & 3, fr = lane & 15, fq = lane >> 4;
  const int nt = K / 64;
  const int ntiles = nM * nN;
  const int srow = tid >> 3, sc16 = tid & 7;
  const int nxcd = (cx.nblk & 7) == 0 ? 8 : 1;
  const int xcd = cx.bid % nxcd, xidx = cx.bid / nxcd, xper = cx.nblk / nxcd;
  const int t_lo = (int)(((long)ntiles * xcd) / nxcd), t_hi = (int)(((long)ntiles * (xcd + 1)) / nxcd);
  for (int tt = t_lo + xidx; tt < t_hi; tt += xper) {
    const int band = tt / (16 * nN);
    const int brows = min(16, nM - band * 16);
    const int rem = tt - band * 16 * nN;
    const int pn = rem / brows, pm = band * 16 + rem % brows;
    const int brow = pm * 256, bcol = pn * 256;
    const char* Ab = (const char*)(A + (size_t)brow * K);
    const char* Bb = (const char*)(Bt + (size_t)bcol * K);
    const unsigned voff = (unsigned)(srow * K + sc16 * 8) * 2u;
    const size_t rs = (size_t)64 * K * 2;
    f32x4 acc[8][4];
#pragma unroll
    for (int i = 0; i < 8; ++i)
#pragma unroll
      for (int j = 0; j < 4; ++j) acc[i][j] = f32x4{0.f, 0.f, 0.f, 0.f};
    uint4 ra0, ra1, ra2, ra3, rb0, rb1, rb2, rb3;
#define G_LD(ko) { const char* a_ = Ab + (size_t)(ko) * 2; const char* b_ = Bb + (size_t)(ko) * 2; \
                 ra0 = *(const uint4*)(a_ + voff); ra1 = *(const uint4*)(a_ + rs + voff); ra2 = *(const uint4*)(a_ + 2 * rs + voff); ra3 = *(const uint4*)(a_ + 3 * rs + voff); \
                 rb0 = *(const uint4*)(b_ + voff); rb1 = *(const uint4*)(b_ + rs + voff); rb2 = *(const uint4*)(b_ + 2 * rs + voff); rb3 = *(const uint4*)(b_ + 3 * rs + voff); }
#define G_ST(sp) { *(uint4*)(sp) = ra0; *(uint4*)((sp) + 64 * 144) = ra1; *(uint4*)((sp) + 128 * 144) = ra2; *(uint4*)((sp) + 192 * 144) = ra3; \
                 *(uint4*)((sp) + 36864) = rb0; *(uint4*)((sp) + 36864 + 64 * 144) = rb1; *(uint4*)((sp) + 36864 + 128 * 144) = rb2; *(uint4*)((sp) + 36864 + 192 * 144) = rb3; }
    char* const sbase = smem + srow * 144 + sc16 * 16;
    G_LD(0);
    G_ST(sbase);
    if (nt > 1) G_LD(64);
    for (int kt = 0; kt < nt; ++kt) {
      __syncthreads();
      if (kt + 1 < nt) { char* s1 = sbase + ((kt + 1) & 1) * 73728; G_ST(s1); }
      if (kt + 2 < nt) G_LD((kt + 2) * 64);
      const char* As = smem + (kt & 1) * 73728;
      const char* Bs = As + 36864;
#pragma unroll
      for (int kh = 0; kh < 2; ++kh) {
        bf16x8 bfr[4];
#pragma unroll
        for (int jn = 0; jn < 4; ++jn) bfr[jn] = *(const bf16x8*)(Bs + (wc * 64 + jn * 16 + fr) * 144 + kh * 64 + fq * 16);
#pragma unroll
        for (int i = 0; i < 8; ++i) {
          bf16x8 af = *(const bf16x8*)(As + (wr * 128 + i * 16 + fr) * 144 + kh * 64 + fq * 16);
#pragma unroll
          for (int jn = 0; jn < 4; ++jn) acc[i][jn] = __builtin_amdgcn_mfma_f32_16x16x32_f16(bfr[jn], af, acc[i][jn], 0, 0, 0);
        }
      }
    }
    __syncthreads();
#pragma unroll
    for (int i = 0; i < 8; ++i)
#pragma unroll
      for (int jn = 0; jn < 4; ++jn) epi(brow + wr * 128 + i * 16 + fr, bcol + wc * 64 + jn * 16 + fq * 4, acc[i][jn]);
  }
}

#define LAS3 __attribute__((address_space(3)))
DEV int g2_lds_byte(int r, int c) { const int st = (r >> 4) * 2 + (c >> 5), rr = r & 15, cc = c & 31, ob = rr * 64 + cc * 2; return st * 1024 + (ob ^ (((ob >> 9) & 1) << 5)); }
DEV void g2_stage_rc(int b, int& R, int& C) { const int st = b / 1024, sb = b % 1024, swz = sb ^ (((sb >> 9) & 1) << 5); R = (st >> 1) * 16 + swz / 64; C = (st & 1) * 32 + (swz % 64) / 2; }

template <class Epi>
DEV void gemm_phase2(const Params& p, const Ctx& cx, const bf16_t* __restrict__ A, const bf16_t* __restrict__ Bt, int K, int nM, int nN, char* smem, Epi epi) {
  constexpr int HTB = 128 * 64 * 2;
  LAS3 unsigned char* lds = (LAS3 unsigned char*)smem;
  const int tid = cx.tid, wid = __builtin_amdgcn_readfirstlane(tid >> 6), lane = tid & 63, wr = wid >> 2, wc = wid & 3, fr = lane & 15, fq = lane >> 4;
  const int nt = K / 64;
  const int ntiles = nM * nN;
  const int nxcd = (cx.nblk & 7) == 0 ? 8 : 1;
  const int xcd = cx.bid % nxcd, xidx = cx.bid / nxcd, xper = cx.nblk / nxcd;
  const int t_lo = (int)(((long)ntiles * xcd) / nxcd), t_hi = (int)(((long)ntiles * (xcd + 1)) / nxcd);
  auto unit_at = [&](int i, int& pm, int& pn) -> bool {
    const int tt = t_lo + xidx + i * xper;
    if (tt >= t_hi) return false;
    const int band = tt / (16 * nN);
    const int brows = min(16, nM - band * 16);
    const int rem = tt - band * 16 * nN;
    pn = rem / brows; pm = band * 16 + rem % brows;
    return true;
  };
  unsigned voffA[2];
#pragma unroll
  for (int i = 0; i < 2; ++i) { int R, C; g2_stage_rc(tid * 16 + i * 8192, R, C); voffA[i] = (unsigned)(R * K + C) * 2u; }
  const size_t kstep = (size_t)(64 * 2);
  const size_t hstep = (size_t)128 * K * 2;
  const size_t tstep = 2 * hstep;
  const unsigned ldsw = (unsigned)wid * 1024u;
  const int aoff = g2_lds_byte(wr * 64 + fr, fq * 8), boff = g2_lds_byte(wc * 32 + fr, fq * 8);
#define G2_SA(b, h) (((b) * 2 + (h)) * HTB)
#define G2_SB(b, h) ((4 + (b) * 2 + (h)) * HTB)
#define G2_STAGE(bufoff, gbase) do { _Pragma("unroll") for (int _i = 0; _i < 2; ++_i) \
    __builtin_amdgcn_global_load_lds((const unsigned*)((const char*)(gbase) + voffA[_i]), (LAS3 unsigned*)(lds + (bufoff) + ldsw + _i * 8192), 16, 0, 0); } while (0)
#define G2_LDA(dst, b, h) do { _Pragma("unroll") for (int m = 0; m < 4; ++m) _Pragma("unroll") for (int k = 0; k < 2; ++k) dst[m][k] = *(const LAS3 bf16x8*)(lds + G2_SA(b, h) + aoff + m * 2048 + k * 1024); } while (0)
#define G2_LDB(dst, b, h) do { _Pragma("unroll") for (int n = 0; n < 2; ++n) _Pragma("unroll") for (int k = 0; k < 2; ++k) dst[n][k] = *(const LAS3 bf16x8*)(lds + G2_SB(b, h) + boff + n * 2048 + k * 1024); } while (0)
#define G2_MMA(ai, bj, At_, Bt_) do { __builtin_amdgcn_s_setprio(1); _Pragma("unroll") for (int m = 0; m < 4; ++m) _Pragma("unroll") for (int n = 0; n < 2; ++n) _Pragma("unroll") for (int k = 0; k < 2; ++k) \
    acc[ai][bj][m][n] = __builtin_amdgcn_mfma_f32_16x16x32_f16(Bt_[n][k], At_[m][k], acc[ai][bj][m][n], 0, 0, 0); __builtin_amdgcn_s_setprio(0); } while (0)
#define G2_WAIT_V(n) asm volatile("s_waitcnt vmcnt(" #n ")" ::: "memory")
#define G2_WAIT_L(n) asm volatile("s_waitcnt lgkmcnt(" #n ")" ::: "memory")
#define G2_BAR __builtin_amdgcn_s_barrier()
#define G2_SCHED __builtin_amdgcn_sched_barrier(0)
  int cpm, cpn, npm = 0, npn = 0, ui = 0;
  if (!unit_at(0, cpm, cpn)) return;
  f32x4 acc[2][2][4][2];
#pragma unroll
  for (int a = 0; a < 2; ++a)
#pragma unroll
    for (int b = 0; b < 2; ++b)
#pragma unroll
      for (int m = 0; m < 4; ++m)
#pragma unroll
        for (int n = 0; n < 2; ++n) acc[a][b][m][n] = f32x4{0.f, 0.f, 0.f, 0.f};
  bf16x8 At[4][2], B0[2][2], B1[2][2];
  const char* cA = (const char*)A + (size_t)cpm * tstep;
  const char* cB = (const char*)Bt + (size_t)cpn * tstep;
  G2_STAGE(G2_SB(0, 0), cB); G2_STAGE(G2_SA(0, 0), cA); G2_STAGE(G2_SB(0, 1), cB + hstep); G2_STAGE(G2_SA(0, 1), cA + hstep);
  if (wr == 1) G2_BAR;
  G2_WAIT_V(4); G2_BAR;
  G2_STAGE(G2_SB(1, 0), cB + kstep); G2_STAGE(G2_SA(1, 0), cA + kstep); G2_STAGE(G2_SB(1, 1), cB + hstep + kstep);
  G2_WAIT_V(6); G2_BAR;
  for (;;) {
    const bool has_next = unit_at(ui + 1, npm, npn);
    const char* nA = has_next ? (const char*)A + (size_t)npm * tstep : cA;
    const char* nB = has_next ? (const char*)Bt + (size_t)npn * tstep : cB;
    for (int t = 0; t < nt; t += 2) {
      const bool last = (t == nt - 2);
      const char* a1 = cA + (size_t)(t + 1) * kstep;
      const char* a2 = last ? nA : cA + (size_t)(t + 2) * kstep;
      const char* b2 = last ? nB : cB + (size_t)(t + 2) * kstep;
      const char* a3 = a2 + kstep;
      const char* b3 = b2 + kstep;
      G2_LDB(B0, 0, 0); G2_SCHED; G2_LDA(At, 0, 0); G2_STAGE(G2_SA(1, 1), a1 + hstep);
      G2_WAIT_L(8); G2_BAR; G2_WAIT_L(0); G2_MMA(0, 0, At, B0); G2_BAR; G2_SCHED;
      G2_LDB(B1, 0, 1); G2_STAGE(G2_SB(0, 0), b2);
      G2_BAR; G2_WAIT_L(0); G2_MMA(0, 1, At, B1); G2_BAR;
      G2_LDA(At, 0, 1); G2_STAGE(G2_SA(0, 0), a2);
      G2_BAR; G2_WAIT_L(0); G2_MMA(1, 0, At, B0); G2_BAR; G2_SCHED;
      G2_STAGE(G2_SB(0, 1), b2 + hstep);
      G2_WAIT_V(6); G2_BAR; G2_MMA(1, 1, At, B1); G2_BAR;
      G2_LDB(B0, 1, 0); G2_SCHED; G2_LDA(At, 1, 0); G2_STAGE(G2_SA(0, 1), a2 + hstep);
      G2_WAIT_L(8); G2_BAR; G2_WAIT_L(0); G2_MMA(0, 0, At, B0); G2_BAR; G2_SCHED;
      G2_LDB(B1, 1, 1); G2_STAGE(G2_SB(1, 0), b3);
      G2_BAR; G2_WAIT_L(0); G2_MMA(0, 1, At, B1); G2_BAR;
      G2_LDA(At, 1, 1); G2_STAGE(G2_SA(1, 0), a3);
      G2_BAR; G2_WAIT_L(0); G2_MMA(1, 0, At, B0); G2_BAR; G2_SCHED;
      G2_STAGE(G2_SB(1, 1), b3 + hstep);
      G2_WAIT_V(6); G2_BAR; G2_MMA(1, 1, At, B1); G2_BAR;
    }
    {
      const int row0 = cpm * 256 + wr * 64 + fr, col0 = cpn * 256 + wc * 32 + 4 * fq;
#pragma unroll
      for (int ai = 0; ai < 2; ++ai)
#pragma unroll
        for (int m = 0; m < 4; ++m)
#pragma unroll
          for (int bj = 0; bj < 2; ++bj)
#pragma unroll
            for (int n = 0; n < 2; ++n) epi(row0 + ai * 128 + m * 16, col0 + bj * 128 + n * 16, acc[ai][bj][m][n]);
    }
    if (!has_next) break;
#pragma unroll
    for (int a = 0; a < 2; ++a)
#pragma unroll
      for (int b = 0; b < 2; ++b)
#pragma unroll
        for (int m = 0; m < 4; ++m)
#pragma unroll
          for (int n = 0; n < 2; ++n) acc[a][b][m][n] = f32x4{0.f, 0.f, 0.f, 0.f};
    cpm = npm; cpn = npn; cA = nA; cB = nB; ++ui;
  }
  G2_WAIT_V(0);
  if (wr == 0) G2_BAR;
  G2_BAR;
#undef G2_SA
#undef G2_SB
#undef G2_STAGE
#undef G2_LDA
#undef G2_LDB
#undef G2_MMA
#undef G2_WAIT_V
#undef G2_WAIT_L
#undef G2_BAR
#undef G2_SCHED
}

template <int K, int NT, class Epi>
DEV void small_gemm(const Params& p, const Ctx& cx, const char* As, int astride, const bf16_t* __restrict__ Bt, int n0, Epi epi) {
  const int lane = cx.tid & 63, fr = lane & 15, fq = lane >> 4;
  f32x4 acc[4][NT];
#pragma unroll
  for (int i = 0; i < 4; ++i)
#pragma unroll
    for (int j = 0; j < NT; ++j) acc[i][j] = f32x4{0.f, 0.f, 0.f, 0.f};
#pragma unroll 2
  for (int k0 = 0; k0 < K; k0 += 32) {
    bf16x8 af[4];
#pragma unroll
    for (int i = 0; i < 4; ++i) af[i] = *(const bf16x8*)(As + (i * 16 + fr) * astride + (k0 + fq * 8) * 2);
#pragma unroll
    for (int jn = 0; jn < NT; ++jn) {
      bf16x8 bf = *(const bf16x8*)(Bt + (size_t)(n0 + jn * 16 + fr) * K + k0 + fq * 8);
#pragma unroll
      for (int i = 0; i < 4; ++i) acc[i][jn] = __builtin_amdgcn_mfma_f32_16x16x32_f16(bf, af[i], acc[i][jn], 0, 0, 0);
    }
  }
#pragma unroll
  for (int i = 0; i < 4; ++i)
#pragma unroll
    for (int jn = 0; jn < NT; ++jn) epi(i * 16 + fr, n0 + jn * 16 + fq * 4, acc[i][jn]);
}

struct S5P { float ar, ai, br, bi; };
DEV S5P s5_params(const Params& p, const Ctx& cx, int l, int d, int g, int lane) {
  int idx = ((l * 2 + d) * 32 + g) * 64 + lane;
  float lr = fminf(p.s5_lam_re[idx], -1e-4f), li = p.s5_lam_im[idx];
  float step = expf(p.s5_log_step[(l * 2 + d) * 32 + g]);
  float xr = lr * step, xi = li * step;
  float e = expf(xr), cs = cosf(xi), sn = sinf(xi);
  S5P r;
  r.ar = e * cs; r.ai = e * sn;
  float sh = sinf(0.5f * xi);
  float nr = expm1f(xr) * cs - 2.f * sh * sh, ni = e * sn;
  float inv = 1.f / (lr * lr + li * li);
  r.br = (nr * lr + ni * li) * inv;
  r.bi = (ni * lr - nr * li) * inv;
  return r;
}

DEV void s5_load_u(const h16* zrest, int rowbase, int g, char* ulds, int lane) {
#pragma unroll
  for (int i = 0; i < 8; ++i) {
    int e = i * 64 + lane;
    int r = e >> 1, hf = e & 1;
    uint4 v = *(const uint4*)(zrest + (size_t)(rowbase + r) * ZR + g * 16 + hf * 8);
    *(uint4*)(ulds + r * 32 + hf * 16) = v;
  }
  lds_fence();
}

DEV int s5_rowbase(int b, int c) { return c == 0 ? NLAT + b * 256 : b * 16384 + (c - 1) * 256; }

DEV void s5_pass1_unit(const Params& p, const Ctx& cx, int l, int unit, char* wl, int lane) {
  int c = unit % 65, bg = unit / 65, g = bg & 31, b = bg >> 5;
  const h16* zrest = (const h16*)(p.ws + OFF_ZREST);
  float2* F = (float2*)(p.ws + OFF_S5F);
  s5_load_u(zrest, s5_rowbase(b, c), g, wl, lane);
  float Br[16], Bi[16];
  {
    const float* pr = p.s5_b_re + ((size_t)(l * 32 + g) * 64 + lane) * 16;
    const float* pi = p.s5_b_im + ((size_t)(l * 32 + g) * 64 + lane) * 16;
#pragma unroll
    for (int i = 0; i < 16; i += 4) {
      float4 a = *(const float4*)(pr + i), bq = *(const float4*)(pi + i);
      Br[i] = a.x; Br[i + 1] = a.y; Br[i + 2] = a.z; Br[i + 3] = a.w;
      Bi[i] = bq.x; Bi[i + 1] = bq.y; Bi[i + 2] = bq.z; Bi[i + 3] = bq.w;
    }
  }
  S5P pf = s5_params(p, cx, l, 0, g, lane), pb = s5_params(p, cx, l, 1, g, lane);
  float xr = 0, xi = 0, yr = 0, yi = 0, pwr = 1.f, pwi = 0.f;
#pragma unroll 4
  for (int t = 0; t < 256; ++t) {
    h16x8 u0 = *(const h16x8*)(wl + t * 32), u1 = *(const h16x8*)(wl + t * 32 + 16);
    float br = 0, bi = 0;
#pragma unroll
    for (int i = 0; i < 8; ++i) { float u = (float)u0[i]; br = fmaf(u, Br[i], br); bi = fmaf(u, Bi[i], bi); }
#pragma unroll
    for (int i = 0; i < 8; ++i) { float u = (float)u1[i]; br = fmaf(u, Br[8 + i], br); bi = fmaf(u, Bi[8 + i], bi); }
    float vr = pf.br * br - pf.bi * bi, vi = pf.br * bi + pf.bi * br;
    float nxr = pf.ar * xr - pf.ai * xi + vr, nxi = pf.ar * xi + pf.ai * xr + vi;
    xr = nxr; xi = nxi;
    float wr_ = pb.br * br - pb.bi * bi, wi_ = pb.br * bi + pb.bi * br;
    yr += pwr * wr_ - pwi * wi_; yi += pwr * wi_ + pwi * wr_;
    float npr = pwr * pb.ar - pwi * pb.ai, npi = pwr * pb.ai + pwi * pb.ar;
    pwr = npr; pwi = npi;
  }
  size_t fi = (((size_t)(b * 32 + g) * 65 + c) * 2) * 64 + lane;
  F[fi] = make_float2(xr, xi);
  F[fi + 64] = make_float2(yr, yi);
}

DEV void s5_pass3_unit(const Params& p, const Ctx& cx, int l, int unit, char* wl, int lane) {
  int c = unit % 65, bg = unit / 65, g = bg & 31, b = bg >> 5;
  const int fr = lane & 15, fq = lane >> 4;
  const h16* zrest = (const h16*)(p.ws + OFF_ZREST);
  const float2* F = (const float2*)(p.ws + OFF_S5F);
  float* S5Y = (float*)(p.ws + OFF_S5Y);
  const int rowbase = s5_rowbase(b, c);
  char* ulds = wl;
  char* tile = wl + 8192;
  s5_load_u(zrest, rowbase, g, ulds, lane);
  float Br[16], Bi[16];
  {
    const float* pr = p.s5_b_re + ((size_t)(l * 32 + g) * 64 + lane) * 16;
    const float* pi = p.s5_b_im + ((size_t)(l * 32 + g) * 64 + lane) * 16;
#pragma unroll
    for (int i = 0; i < 16; i += 4) {
      float4 a = *(const float4*)(pr + i), bq = *(const float4*)(pi + i);
      Br[i] = a.x; Br[i + 1] = a.y; Br[i + 2] = a.z; Br[i + 3] = a.w;
      Bi[i] = bq.x; Bi[i + 1] = bq.y; Bi[i + 2] = bq.z; Bi[i + 3] = bq.w;
    }
  }
  const float dsk = p.s5_d[(size_t)l * 512 + g * 16 + fr];
  const size_t fbase = ((size_t)(b * 32 + g) * 65) * 2 * 64 + lane;
#pragma unroll 1
  for (int d = 0; d < 2; ++d) {
    S5P pp = s5_params(p, cx, l, d, g, lane);
    float qr = pp.ar, qi = pp.ai;
#pragma unroll
    for (int i = 0; i < 8; ++i) { float t = qr * qr - qi * qi; qi = 2.f * qr * qi; qr = t; }
    float xr = 0, xi = 0;
    if (d == 0) {
      for (int cc = 0; cc < c; ++cc) {
        float2 f = F[fbase + (size_t)(cc * 2 + 0) * 64];
        float t = qr * xr - qi * xi + f.x; xi = qr * xi + qi * xr + f.y; xr = t;
      }
    } else if (c > 0) {
      float2 f0 = F[fbase + (size_t)(0 * 2 + 1) * 64];
      xr = f0.x; xi = f0.y;
      for (int cc = 64; cc > c; --cc) {
        float2 f = F[fbase + (size_t)(cc * 2 + 1) * 64];
        float t = qr * xr - qi * xi + f.x; xi = qr * xi + qi * xr + f.y; xr = t;
      }
    }
    bf16x8 chi[4], clo[4];
    {
      const float* cr = p.s5_c_re + ((size_t)((l * 2 + d) * 32 + g) * 16 + fr) * 64;
      const float* ci = p.s5_c_im + ((size_t)((l * 2 + d) * 32 + g) * 16 + fr) * 64;
#pragma unroll
      for (int ks = 0; ks < 4; ++ks) {
        float4 a = *(const float4*)(cr + ks * 16 + fq * 4), bq = *(const float4*)(ci + ks * 16 + fq * 4);
        float vals[8] = {a.x, -bq.x, a.y, -bq.y, a.z, -bq.z, a.w, -bq.w};
#pragma unroll
        for (int j = 0; j < 8; ++j) {
          h16 hh = (h16)vals[j];
          chi[ks][j] = hh;
          clo[ks][j] = (h16)(vals[j] - (float)hh);
        }
      }
    }
#pragma unroll 1
    for (int sb = 0; sb < 16; ++sb) {
      const int sub = d == 0 ? sb : 15 - sb;
#pragma unroll 4
      for (int q = 0; q < 16; ++q) {
        const int tt = d == 0 ? q : 15 - q;
        const int t = sub * 16 + tt;
        h16x8 u0 = *(const h16x8*)(ulds + t * 32), u1 = *(const h16x8*)(ulds + t * 32 + 16);
        float br = 0, bi = 0;
#pragma unroll
        for (int i = 0; i < 8; ++i) { float u = (float)u0[i]; br = fmaf(u, Br[i], br); bi = fmaf(u, Bi[i], bi); }
#pragma unroll
        for (int i = 0; i < 8; ++i) { float u = (float)u1[i]; br = fmaf(u, Br[8 + i], br); bi = fmaf(u, Bi[8 + i], bi); }
        float vr = pp.br * br - pp.bi * bi, vi = pp.br * bi + pp.bi * br;
        float nxr = pp.ar * xr - pp.ai * xi + vr, nxi = pp.ar * xi + pp.ai * xr + vi;
        xr = nxr; xi = nxi;
        h16x2 hv2 = {(h16)xr, (h16)xi};
        float lr_ = xr - (float)hv2[0], li_ = xi - (float)hv2[1];
        *(unsigned*)(tile + tt * 272 + lane * 4) = __builtin_bit_cast(unsigned, hv2);
        *(unsigned*)(tile + 4352 + tt * 272 + lane * 4) = pack_bf2(lr_, li_);
      }
      lds_fence();
      f32x4 acc = f32x4{0.f, 0.f, 0.f, 0.f};
#pragma unroll
      for (int ks = 0; ks < 4; ++ks) {
        bf16x8 ah = *(const bf16x8*)(tile + fr * 272 + ks * 64 + fq * 16);
        bf16x8 alo = *(const bf16x8*)(tile + 4352 + fr * 272 + ks * 64 + fq * 16);
        acc = __builtin_amdgcn_mfma_f32_16x16x32_f16(ah, chi[ks], acc, 0, 0, 0);
        acc = __builtin_amdgcn_mfma_f32_16x16x32_f16(alo, chi[ks], acc, 0, 0, 0);
        acc = __builtin_amdgcn_mfma_f32_16x16x32_f16(ah, clo[ks], acc, 0, 0, 0);
      }
      lds_fence();
#pragma unroll
      for (int r = 0; r < 4; ++r) {
        int tl = sub * 16 + fq * 4 + r;
        float* yp = S5Y + (size_t)(rowbase + tl) * 512 + g * 16 + fr;
        if (d == 0) {
          float u = (float)*(const h16*)(ulds + tl * 32 + fr * 2);
          *yp = acc[r] + dsk * u;
        } else {
          *yp = gelu_f(*yp + acc[r]);
        }
      }
    }
  }
}

DEV void prep_item(const Params& p, const Ctx& cx, int l, int item, char* smem) {
  const int tile = item >> 2, q = item & 3;
  const int row0 = tile * 64;
  const int tid = cx.tid;
  const h16* zc = (const h16*)(p.ws + OFF_REG2);
  h16* SC = (h16*)(p.ws + OFF_SCAN);
  const char* wt = p.ws + OFF_WT + (size_t)l * WT_SIZE;
  {
    const int d = q >> 1, isA = q & 1;
    const int coff = isA ? 3200 + d * 64 : 3072 + d * 64;
    int tok = tid >> 3, c8 = tid & 7;
    h16x8 cv = *(const h16x8*)(zc + (size_t)(row0 + tok) * ZC + coff + c8 * 8);
    float f[8];
#pragma unroll
    for (int j = 0; j < 8; ++j) { f[j] = (float)cv[j]; if (!isA) f[j] = tanh_f(f[j]); }
    uint4 o;
    o.x = pack_bf2(f[0], f[1]); o.y = pack_bf2(f[2], f[3]); o.z = pack_bf2(f[4], f[5]); o.w = pack_bf2(f[6], f[7]);
    *(uint4*)(smem + tok * 144 + c8 * 16) = o;
    __syncthreads();
    const bf16_t* Bt = (const bf16_t*)(wt + (isA ? WT_A2 : WT_W2)) + (size_t)d * 1024 * 64;
    const float* biasw = p.rwkv_w0 + (size_t)(l * 2 + d) * 1024;
    const float* biasa = p.rwkv_a0 + (size_t)(l * 2 + d) * 1024;
    h16* dst = SC + (size_t)(isA ? 4 + d : 6 + d) * ARR;
#pragma unroll 1
    for (int hf = 0; hf < 2; ++hf) small_gemm<64, 4>(p, cx, smem, 144, Bt, (tid >> 6) * 128 + hf * 64, [&](int m, int n, f32x4 v) {
      float4 bbw = *(const float4*)(biasw + n), bba = *(const float4*)(biasa + n);
      float4 bb = isA ? bba : bbw;
      float r0 = sigmoid_f(v[0] + bb.x), r1 = sigmoid_f(v[1] + bb.y), r2 = sigmoid_f(v[2] + bb.z), r3 = sigmoid_f(v[3] + bb.w);
      if (!isA) { r0 = __expf(-DECAY_SCALE * r0); r1 = __expf(-DECAY_SCALE * r1); r2 = __expf(-DECAY_SCALE * r2); r3 = __expf(-DECAY_SCALE * r3); }
      h16x4 o4 = {(h16)r0, (h16)r1, (h16)r2, (h16)r3};
      *(h16x4*)(dst + (size_t)(row0 + m) * 1024 + n) = o4;
    });
  }
  {
    const float* cw = p.conv_rkv + (size_t)l * 3 * 3072;
    const int grp = tid & 7, hh = (tid >> 3) & 3;
    const int c0 = (4 * q + hh) * 64 + grp * 8;
    float cwt[3][3][8];
#pragma unroll
    for (int s = 0; s < 3; ++s)
#pragma unroll
      for (int tp = 0; tp < 3; ++tp)
#pragma unroll
        for (int j = 0; j < 8; j += 4) {
          float4 a = *(const float4*)(cw + tp * 3072 + s * 1024 + c0 + j);
          cwt[s][tp][j] = a.x; cwt[s][tp][j + 1] = a.y; cwt[s][tp][j + 2] = a.z; cwt[s][tp][j + 3] = a.w;
        }
    float kkw[8];
#pragma unroll
    for (int j = 0; j < 8; j += 4) {
      float4 kq = *(const float4*)(p.rwkv_k_k + (size_t)l * 1024 + c0 + j);
      kkw[j] = kq.x; kkw[j + 1] = kq.y; kkw[j + 2] = kq.z; kkw[j + 3] = kq.w;
    }
#pragma unroll 1
    for (int it = 0; it < 4; ++it) {
      const int tok = (tid >> 5) + it * 16;
      const int row = row0 + tok;
      bool hasp, hasn;
      if (row < NLAT) { hasp = (row & 16383) != 0; hasn = (row & 16383) != 16383; }
      else { hasp = (row & 255) != 0; hasn = (row & 255) != 255; }
      const size_t off = (size_t)row * 1024 + c0;
      const h16* zp = zc + (size_t)row * ZC + c0;
      const h16* zpp = hasp ? zp - ZC : zp;
      const h16* zpn = hasn ? zp + ZC : zp;
      h16x8 cur[3], prv[3], nxt[3];
#pragma unroll
      for (int s = 0; s < 3; ++s) { cur[s] = *(const h16x8*)(zp + s * 1024); prv[s] = *(const h16x8*)(zpp + s * 1024); nxt[s] = *(const h16x8*)(zpn + s * 1024); }
      const float fp = hasp ? 1.f : 0.f, fn = hasn ? 1.f : 0.f;
      float kv[8];
#pragma unroll
      for (int s = 0; s < 3; ++s) {
        h16x8 o;
#pragma unroll
        for (int j = 0; j < 8; ++j) {
          float ov = cwt[s][0][j] * (fp * (float)prv[s][j]) + cwt[s][1][j] * (float)cur[s][j] + cwt[s][2][j] * (fn * (float)nxt[s][j]);
          o[j] = (h16)ov;
          if (s == 1) kv[j] = ov;
        }
        *(h16x8*)(SC + (size_t)s * ARR + off) = o;
      }
      float kk[8], ss = 0;
#pragma unroll
      for (int j = 0; j < 8; ++j) { kk[j] = kv[j] * kkw[j]; ss += kk[j] * kk[j]; }
      ss = allreduce8(ss);
      float inv = rcp_f(fmaxf(sqrtf(ss), 1e-12f));
      h16x8 o;
#pragma unroll
      for (int j = 0; j < 8; ++j) o[j] = (h16)(kk[j] * inv);
      *(h16x8*)(SC + 3 * ARR + off) = o;
    }
  }
}

DEV void phase_prep(const Params& p, const Ctx& cx0, int l, char* smem) {
  const int NPREP = 520 * 4, NS5 = 520;
  const Ctx& cx_ = cx0;
  for (int item = cx_.bid; item < NPREP + NS5; item += cx_.nblk) {
    __syncthreads();
    Ctx cx = cx0; asm volatile("" : "+v"(cx.tid));
    const int lane = cx.tid & 63, wid = cx.tid >> 6;
#ifndef NO_PREPITEM
    if (item < NPREP) prep_item(p, cx, l, item, smem);
    else
#endif
#ifndef NO_S5P1
      s5_pass1_unit(p, cx, l, (item - NPREP) * 8 + wid, smem + wid * 8192, lane);
#else
    {}
#endif
  }
}

typedef unsigned u2v __attribute__((ext_vector_type(2)));
struct RG { u2v w, a, kk, k, r; h16 v; };

DEV void rwkv_task(const Params& p, const Ctx& cx, int l, int task, int lane, char* wl) {
  const int unit = task >> 4, d = unit & 1, h = (unit >> 1) & 15, b = unit >> 5;
  const int j = lane >> 4, s = lane & 15;
  const int myrow = (task & 15) * 4 + j;
  const h16* SC = (const h16*)(p.ws + OFF_SCAN);
  const char* pR = (const char*)(SC + 0 * ARR + h * 64);
  const char* pK = (const char*)(SC + 1 * ARR + h * 64);
  const char* pV = (const char*)(SC + 2 * ARR + h * 64);
  const char* pKK = (const char*)(SC + 3 * ARR + h * 64);
  const char* pA = (const char*)(SC + (size_t)(4 + d) * ARR + h * 64);
  const char* pW = (const char*)(SC + (size_t)(6 + d) * ARR + h * 64);
  char* pO = (char*)((h16*)(p.ws + OFF_REG2) + (size_t)d * ARR + h * 64);
  const int jm = d ? 3 - j : j;
  const int sm = d ? 3 - (s & 3) : (s & 3);
  const unsigned vo0 = (unsigned)(jm * 2048 + s * 8);
  const unsigned vov0 = (unsigned)(sm * 2048 + myrow * 2);
  typedef float f4 __attribute__((ext_vector_type(4)));
  f4 ka4, om4;
  {
    float4 t = *(const float4*)(p.rwkv_k_a + (size_t)l * 1024 + h * 64 + 4 * s);
    ka4 = f4{t.x, t.y, t.z, t.w};
    om4 = 1.f - ka4;
  }
  f4 S = {0.f, 0.f, 0.f, 0.f};
  constexpr int NG = 16640 / 4;
  static_assert(NG % 8 == 0, "ring");
  RG q0, q1, q2, q3, q4, q5, q6, q7;
  const unsigned wofs = (unsigned)(j * 256 + s * 16);
  const unsigned vwofs = (unsigned)(5120 + (s & 3) * 8 + j * 2);
  const unsigned rofs = (unsigned)(s * 16);
  const unsigned vrofs = (unsigned)(5120 + j * 2);

#define RW_RLO(gq, rlo)                                                            \
  {                                                                                \
    const int gg = (gq) < NG ? (gq) : NG - 1;                                      \
    const int q0_ = gg * 4;                                                        \
    const int isl = q0_ >= 256;                                                    \
    const int base_ = isl ? b * 16384 : NLAT + b * 256;                            \
    const int t0_ = isl ? q0_ - 256 : q0_;                                         \
    const int last_ = isl ? 16383 : 255;                                           \
    rlo = base_ + (d ? last_ - t0_ - 3 : t0_);                                     \
  }
#define RW_LOAD(q, gq)                                                             \
  {                                                                                \
    int rlo; RW_RLO(gq, rlo);                                                      \
    unsigned vo = vo0, vov = vov0; asm volatile("" : "+v"(vo), "+v"(vov));         \
    const size_t off = (size_t)rlo * 2048;                                         \
    q.w = *(const u2v*)(pW + off + vo); q.a = *(const u2v*)(pA + off + vo);        \
    q.kk = *(const u2v*)(pKK + off + vo); q.k = *(const u2v*)(pK + off + vo);      \
    q.r = *(const u2v*)(pR + off + vo); q.v = *(const h16*)(pV + off + vov);       \
  }
#define CV4(uv) __builtin_convertvector(__builtin_bit_cast(h16x4, uv), f4)
#define RW_STAGE(q, gq)                                                            \
  {     \
    char* sl = wl + ((gq) & 1) * 5248;                                             \
    const f4 a_ = CV4(q.a), kk_ = CV4(q.kk);                                       \
    *(f4*)(sl + 0 * 1024 + wofs) = CV4(q.w);                                       \
    *(f4*)(sl + 1 * 1024 + wofs) = kk_;                                            \
    *(f4*)(sl + 2 * 1024 + wofs) = kk_ * a_;                                       \
    *(f4*)(sl + 3 * 1024 + wofs) = CV4(q.k) * (a_ * ka4 + om4);                    \
    *(f4*)(sl + 4 * 1024 + wofs) = CV4(q.r);                                       \
    *(h16*)(sl + vwofs) = q.v;                                                     \
  }
#define RW_COMPUTE(gq)                                                             \
  {                                                                                \
    const char* sl = wl + ((gq) & 1) * 5248;                                       \
    float dres[4];                                                                 \
    _Pragma("unroll") for (int u = 0; u < 4; ++u) {                                \
      const f4 w_ = *(const f4*)(sl + 0 * 1024 + u * 256 + rofs);                  \
      const f4 kk_ = *(const f4*)(sl + 1 * 1024 + u * 256 + rofs);                 \
      const f4 kka_ = *(const f4*)(sl + 2 * 1024 + u * 256 + rofs);                \
      const f4 kd_ = *(const f4*)(sl + 3 * 1024 + u * 256 + rofs);                 \
      const f4 r_ = *(const f4*)(sl + 4 * 1024 + u * 256 + rofs);                  \
      const float vj = (float)*(const h16*)(sl + u * 8 + vrofs);                   \
      const f4 pd = S * kk_;                                                       \
      const float d1 = allreduce16((pd.x + pd.y) + (pd.z + pd.w));                 \
      S = S * w_ + kd_ * vj;                                                       \
      S = S - kka_ * d1;                                                           \
      const f4 pe = S * r_;                                                        \
      dres[u] = (pe.x + pe.y) + (pe.z + pe.w);     \
    }                                                                              \
    {                                                                              \
      int rlo; RW_RLO(gq, rlo);                                                    \
      const int su = s & 3;                                                        \
      unsigned vov = vov0; asm volatile("" : "+v"(vov));                           \
        \
      const bool p1_ = (s & 1) != 0, p2_ = (s & 2) != 0;                           \
      const float a_ = (p1_ ? dres[1] : dres[0]) + dpp_mov<0xB1>(p1_ ? dres[0] : dres[1]); \
      const float b_ = (p1_ ? dres[3] : dres[2]) + dpp_mov<0xB1>(p1_ ? dres[2] : dres[3]); \
      float val = (p2_ ? b_ : a_) + dpp_mov<0x4E>(p2_ ? a_ : b_);                  \
      val += dpp_mov<0x124>(val);                                                  \
      val += dpp_mov<0x128>(val);                                                  \
      (void)su;                                                                    \
      *(h16*)(pO + (size_t)rlo * 2048 + vov) = (h16)val;                           \
    }                                                                              \
  }
#define SB __builtin_amdgcn_sched_barrier(0)

#define CB asm volatile("" ::: "memory")
  RW_LOAD(q0, 0); RW_LOAD(q1, 1); RW_LOAD(q2, 2); RW_LOAD(q3, 3); RW_LOAD(q4, 4); RW_LOAD(q5, 5); RW_LOAD(q6, 6); RW_LOAD(q7, 7);
  RW_STAGE(q0, 0); CB;
#pragma unroll 1
  for (int g = 0; g < NG; g += 8) {
    RW_STAGE(q1, g + 1); RW_LOAD(q0, g + 8); RW_COMPUTE(g); CB; SB;
    RW_STAGE(q2, g + 2); RW_LOAD(q1, g + 9); RW_COMPUTE(g + 1); CB; SB;
    RW_STAGE(q3, g + 3); RW_LOAD(q2, g + 10); RW_COMPUTE(g + 2); CB; SB;
    RW_STAGE(q4, g + 4); RW_LOAD(q3, g + 11); RW_COMPUTE(g + 3); CB; SB;
    RW_STAGE(q5, g + 5); RW_LOAD(q4, g + 12); RW_COMPUTE(g + 4); CB; SB;
    RW_STAGE(q6, g + 6); RW_LOAD(q5, g + 13); RW_COMPUTE(g + 5); CB; SB;
    RW_STAGE(q7, g + 7); RW_LOAD(q6, g + 14); RW_COMPUTE(g + 6); CB; SB;
    RW_STAGE(q0, g + 8); RW_LOAD(q7, g + 15); RW_COMPUTE(g + 7); CB; SB;
  }
#undef CB
#undef SB
#undef RW_RLO
#undef RW_LOAD
#undef RW_COMPUTE
#undef RW_STAGE
#undef CV4
}

DEV void phase_scan(const Params& p, const Ctx& cx, int l, char* smem) {
  const int lane = cx.tid & 63, wid = __builtin_amdgcn_readfirstlane(cx.tid >> 6);
  char* wl = smem + wid * 17408;
  const int NS5U = 2 * 32 * 65;
  if (wid < 4) {
    for (int slot = cx.bid; slot < 256; slot += cx.nblk) {
      const int task = ((slot & 63) << 4) | ((slot >> 6) << 2) | wid;
#ifndef NO_RWKV
      rwkv_task(p, cx, l, task, lane, wl);
#endif
    }
  } else {
    for (int u = cx.bid * 4 + (wid - 4); u < NS5U; u += cx.nblk * 4) {
      if (l == 1 && (u % 65) == 0) continue;
#ifndef NO_S5P3
      s5_pass3_unit(p, cx, l, u, wl, lane);
#endif
    }
  }
}

DEV void pool_item(const Params& p, const Ctx& cx, int l, int item, char* smem) {
  const int tid = cx.tid;
  const h16* zrest = (const h16*)(p.ws + OFF_ZREST);
  bf16_t* ym = (bf16_t*)(p.ws + OFF_YM);
  const char* wt = p.ws + OFF_WT + (size_t)l * WT_SIZE;
  float* V = (float*)smem;
  char* At = smem + 43008;
  int g, rowout0, Lseq, p0, rlo, rhi, rstride, rowsrc0;
  if (item < 2048) {
    g = item & 3; int r = (item >> 2) & 255, b = item >> 10;
    int w = 2 << g;
    rlo = max(r - w / 2, 0); rhi = min(r + w / 2 - 1, 255);
    rowsrc0 = b * 16384; rstride = 64;
    rowout0 = b * 16384 + r * 64; Lseq = 64; p0 = 0;
  } else {
    int it = item - 2048;
    g = it & 3; int tq = (it >> 2) & 3, b = it >> 4;
    rlo = 0; rhi = 0; rowsrc0 = NLAT + b * 256; rstride = 0;
    rowout0 = NLAT + b * 256 + tq * 64; Lseq = 256; p0 = tq * 64;
  }
  const int w = 2 << g;
  const float invr = 1.f / (float)(rhi - rlo + 1);
  for (int unit = tid; unit < 80 * 16; unit += NTHREADS) {
    int lp = unit >> 4, ch8 = unit & 15;
    int pos = p0 - 8 + lp;
    float acc[8] = {0, 0, 0, 0, 0, 0, 0, 0};
    if (pos >= 0 && pos < Lseq) {
      const h16* bp = zrest + (size_t)(rowsrc0 + pos) * ZR + 1024 + g * 128 + ch8 * 8;
      const int nr = rhi - rlo + 1;
      for (int k0 = 0; k0 < nr; k0 += 4) {
        h16x8 v[4]; float wv[4];
#pragma unroll
        for (int i = 0; i < 4; ++i) {
          const int kk_ = min(k0 + i, nr - 1);
          wv[i] = (k0 + i < nr) ? 1.f : 0.f;
          v[i] = *(const h16x8*)(bp + (size_t)((rlo + kk_) * rstride) * ZR);
        }
#pragma unroll
        for (int i = 0; i < 4; ++i)
#pragma unroll
          for (int j = 0; j < 8; ++j) acc[j] += wv[i] * (float)v[i][j];
      }
    }
    float* vp = V + lp * 132 + ch8 * 8;
#pragma unroll
    for (int j = 0; j < 8; ++j) vp[j] = acc[j] * invr;
  }
  __syncthreads();
  for (int unit = tid; unit < 64 * 16; unit += NTHREADS) {
    int c = unit >> 4, ch8 = unit & 15;
    int pos = p0 + c;
    int lo = max(pos - w / 2, 0), hi = min(pos + w / 2 - 1, Lseq - 1);
    float acc[8] = {0, 0, 0, 0, 0, 0, 0, 0};
    for (int pp = lo; pp <= hi; ++pp) {
      const float* vp = V + (pp - p0 + 8) * 132 + ch8 * 8;
#pragma unroll
      for (int j = 0; j < 8; ++j) acc[j] += vp[j];
    }
    float invc = 1.f / (float)(hi - lo + 1);
    h16x8 uc = *(const h16x8*)(zrest + (size_t)(rowout0 + c) * ZR + 1024 + g * 128 + ch8 * 8);
    uint4 o;
    o.x = pack_bf2(acc[0] * invc - (float)uc[0], acc[1] * invc - (float)uc[1]);
    o.y = pack_bf2(acc[2] * invc - (float)uc[2], acc[3] * invc - (float)uc[3]);
    o.z = pack_bf2(acc[4] * invc - (float)uc[4], acc[5] * invc - (float)uc[5]);
    o.w = pack_bf2(acc[6] * invc - (float)uc[6], acc[7] * invc - (float)uc[7]);
    *(uint4*)(At + c * 272 + ch8 * 16) = o;
  }
  __syncthreads();
  const bf16_t* Bt = (const bf16_t*)(wt + WT_POOL) + (size_t)g * 128 * 128;
  const float* ps = p.pool_scale + (size_t)l * 512 + g * 128;
  small_gemm<128, 1>(p, cx, At, 272, Bt, (tid >> 6) * 16, [&](int m, int n, f32x4 v) {
    int row = rowout0 + m;
    float4 sc = *(const float4*)(ps + n);
    h16x4 gt = *(const h16x4*)(zrest + (size_t)row * ZR + 1536 + g * 128 + n);
    uint2 o;
    o.x = pack_bf2(v[0] * sc.x * silu_f((float)gt[0]), v[1] * sc.y * silu_f((float)gt[1]));
    o.y = pack_bf2(v[2] * sc.z * silu_f((float)gt[2]), v[3] * sc.w * silu_f((float)gt[3]));
    *(uint2*)(ym + (size_t)row * D + 512 + g * 128 + n) = o;
  });
}

DEV void glu_item(const Params& p, const Ctx& cx, int l, int tile, char* smem) {
  const int tid = cx.tid;
  const int row0 = tile * 64;
  const float* S5Y = (const float*)(p.ws + OFF_S5Y);
  const h16* zrest = (const h16*)(p.ws + OFF_ZREST);
  bf16_t* ym = (bf16_t*)(p.ws + OFF_YM);
  const char* wt = p.ws + OFF_WT + (size_t)l * WT_SIZE;
#pragma unroll
  for (int it = 0; it < 8; ++it) {
    int unit = tid + it * NTHREADS;
    int r = unit >> 6, c8 = unit & 63;
    const float* sp = S5Y + (size_t)(row0 + r) * 512 + c8 * 8;
    float4 a = *(const float4*)sp, bq = *(const float4*)(sp + 4);
    uint4 o;
    o.x = pack_bf2(a.x, a.y); o.y = pack_bf2(a.z, a.w); o.z = pack_bf2(bq.x, bq.y); o.w = pack_bf2(bq.z, bq.w);
    *(uint4*)(smem + r * 1040 + c8 * 16) = o;
  }
  __syncthreads();
  const bf16_t* Bt = (const bf16_t*)(wt + WT_GLU);
  const float* bg = p.b_glu + (size_t)l * 512;
  small_gemm<512, 4>(p, cx, smem, 1040, Bt, (tid >> 6) * 64, [&](int m, int n, f32x4 v) {
    int row = row0 + m;
    float4 y = *(const float4*)(S5Y + (size_t)row * 512 + n);
    float4 bb = *(const float4*)(bg + n);
    h16x4 gt = *(const h16x4*)(zrest + (size_t)row * ZR + 512 + n);
    uint2 o;
    o.x = pack_bf2(y.x * sigmoid_f(v[0] + bb.x) * silu_f((float)gt[0]), y.y * sigmoid_f(v[1] + bb.y) * silu_f((float)gt[1]));
    o.y = pack_bf2(y.z * sigmoid_f(v[2] + bb.z) * silu_f((float)gt[2]), y.w * sigmoid_f(v[3] + bb.w) * silu_f((float)gt[3]));
    *(uint2*)(ym + (size_t)row * D + n) = o;
  });
}

DEV void rwkvmerge_item(const Params& p, const Ctx& cx, int l, int tile) {
  const int tid = cx.tid;
  const int row0 = tile * 64;
  const h16* SC = (const h16*)(p.ws + OFF_SCAN);
  const h16* O = (const h16*)(p.ws + OFF_REG2);
  const h16* zrest = (const h16*)(p.ws + OFF_ZREST);
  bf16_t* ym = (bf16_t*)(p.ws + OFF_YM);
  const int grp = tid & 7, h = (tid >> 3) & 15;
  const int c0 = h * 64 + grp * 8;
  float pk[8], rk[8], gw[8], gb[8];
#pragma unroll
  for (int j = 0; j < 8; j += 4) {
    float4 t0 = *(const float4*)(p.rwkv_k_a + (size_t)l * 1024 + c0 + j), t1 = *(const float4*)(p.rwkv_r_k + (size_t)l * 1024 + c0 + j);
    float4 t2 = *(const float4*)(p.gn_w + (size_t)l * 1024 + c0 + j), t3 = *(const float4*)(p.gn_b + (size_t)l * 1024 + c0 + j);
    pk[j] = t0.x; pk[j + 1] = t0.y; pk[j + 2] = t0.z; pk[j + 3] = t0.w;
    rk[j] = t1.x; rk[j + 1] = t1.y; rk[j + 2] = t1.z; rk[j + 3] = t1.w;
    gw[j] = t2.x; gw[j + 1] = t2.y; gw[j + 2] = t2.z; gw[j + 3] = t2.w;
    gb[j] = t3.x; gb[j + 1] = t3.y; gb[j + 2] = t3.z; gb[j + 3] = t3.w;
  }
#pragma unroll 2
  for (int it = 0; it < 16; ++it) {
    const int tok = (tid >> 7) + it * 4;
    int row = row0 + tok;
    size_t off = (size_t)row * 1024 + c0;
    h16x8 of = *(const h16x8*)(O + off), ob = *(const h16x8*)(O + ARR + off);
    h16x8 r8 = *(const h16x8*)(SC + 0 * ARR + off), k8 = *(const h16x8*)(SC + 1 * ARR + off), v8 = *(const h16x8*)(SC + 2 * ARR + off);
    h16x8 af = *(const h16x8*)(SC + 4 * ARR + off), ab = *(const h16x8*)(SC + 5 * ARR + off);
    h16x8 gt = *(const h16x8*)(zrest + (size_t)row * ZR + 2048 + c0);
    float o[8], sm = 0;
#pragma unroll
    for (int j = 0; j < 8; ++j) { o[j] = (float)of[j] + (float)ob[j]; sm += o[j]; }
    sm = allreduce8(sm);
    float mu = sm * (1.f / 64.f), vq = 0;
#pragma unroll
    for (int j = 0; j < 8; ++j) { o[j] -= mu; vq += o[j] * o[j]; }
    vq = allreduce8(vq);
    float rstd = rsqrtf(vq * (1.f / 64.f) + 64e-5f);
    float part = 0;
#pragma unroll
    for (int j = 0; j < 8; ++j) {
      float ksum = (float)k8[j] * (2.f + ((float)af[j] + (float)ab[j] - 2.f) * pk[j]);
      part += (float)r8[j] * ksum * rk[j];
    }
    part = allreduce8(part);
    float res[8];
#pragma unroll
    for (int j = 0; j < 8; ++j) {
      float y = o[j] * rstd * gw[j] + gb[j] + part * (float)v8[j];
      res[j] = y * silu_f((float)gt[j]);
    }
    uint4 ov;
    ov.x = pack_bf2(res[0], res[1]); ov.y = pack_bf2(res[2], res[3]); ov.z = pack_bf2(res[4], res[5]); ov.w = pack_bf2(res[6], res[7]);
    *(uint4*)(ym + (size_t)row * D + 1024 + c0) = ov;
  }
}

DEV void phase_merge(const Params& p, const Ctx& cx0, int l, char* smem) {
  const int ntile = (l == 0) ? 520 : 512;
  const int npool = (l == 0) ? 2048 + 32 : 2048;
  const int total = npool + 2 * ntile;
  for (int item = cx0.bid; item < total; item += cx0.nblk) {
    __syncthreads();
    Ctx cx = cx0; asm volatile("" : "+v"(cx.tid));
    if (item < npool) pool_item(p, cx, l, item, smem);
    else if (item < npool + ntile) glu_item(p, cx, l, item - npool, smem);
    else rwkvmerge_item(p, cx, l, item - npool - ntile);
  }
}

#define LCX Ctx c2 = cx; asm volatile("" : "+v"(c2.tid))
#ifndef GEMM_FN
#define GEMM_FN gemm_phase2
#endif
__global__ void __launch_bounds__(NTHREADS) mega_fwd(Params p, int ph0, int ph1) {
  extern __shared__ __attribute__((aligned(16))) char smem[];
  cg::grid_group grid = cg::this_grid();
  const int wave_s = __builtin_amdgcn_readfirstlane((int)(threadIdx.x >> 6));
  for (int step = ph0; step < ph1; ++step) {
    if (step > ph0) grid.sync();
    const int ph = (int)((PH_SEQ >> (4 * step)) & 15ull);
    Ctx cx;
    {
      int t_, b_ = blockIdx.x, n_ = gridDim.x;
      asm volatile("v_mbcnt_lo_u32_b32 %0, -1, 0\n\tv_mbcnt_hi_u32_b32 %0, -1, %0\n\tv_lshl_add_u32 %0, %1, 6, %0" : "=&v"(t_) : "s"(wave_s));
      asm volatile("" : "+s"(b_), "+s"(n_));
      cx.tid = t_; cx.bid = b_; cx.nblk = n_;
    }
    const int l = ph >= 8 ? 1 : 0;
    const int lp = ph >= 8 ? ph - 6 : ph;
#ifndef PHMASK
#define PHMASK 0xff
#endif
    if (ph == 0) { if (PHMASK & 1) { LCX; phase0(p, c2, smem); } }
    else if (ph == 1) { if (PHMASK & 2) { LCX; phase_adaln0(p, c2); } }
    else if (lp == 2 && (PHMASK & 4)) {
      LCX;
      h16* zrest = (h16*)(p.ws + OFF_ZREST);
      h16* zc = (h16*)(p.ws + OFF_REG2);
      GEMM_FN(p, c2, (const bf16_t*)(p.ws + OFF_H), (const bf16_t*)(p.ws + OFF_WT + (size_t)l * WT_SIZE + WT_IN), 2048, 130, 25, smem,
                 [&](int row, int col, f32x4 v) {
                   h16* dst;
                   if (col < 2048) dst = zrest + (size_t)row * ZR + col;
                   else if (col < 5120) dst = zc + (size_t)row * ZC + (col - 2048);
                   else if (col < 6144) dst = zrest + (size_t)row * ZR + 2048 + (col - 5120);
                   else dst = zc + (size_t)row * ZC + 3072 + (col - 6144);
                   h16x4 o = {(h16)v[0], (h16)v[1], (h16)v[2], (h16)v[3]};
                   *(h16x4*)dst = o;
                 });
    } else if (lp == 3) { if (PHMASK & 8) { LCX; phase_prep(p, c2, l, smem); } }
    else if (lp == 4) { if (PHMASK & 16) { LCX; phase_scan(p, c2, l, smem); } }
    else if (lp == 5) { if (PHMASK & 32) { LCX; phase_merge(p, c2, l, smem); } }
    else if (lp == 6 && (PHMASK & 64)) {
      LCX;
      const float* mods = (const float*)(p.ws + OFF_MODS);
      float* prec = (float*)(p.ws + OFF_PREC);
      const float* xin = (l == 0) ? p.x : p.out;
      GEMM_FN(p, c2, (const bf16_t*)(p.ws + OFF_YM), (const bf16_t*)(p.ws + OFF_WT + (size_t)l * WT_SIZE + WT_OUT), 2048, l == 0 ? 130 : 128, 8, smem,
                 [&](int row, int col, f32x4 v) {
                   if (row < NLAT) {
                     float4 xv = *(const float4*)(xin + (size_t)row * D + col);
                     float4 gv = *(const float4*)(mods + (size_t)(l * 3 + (row >> 14)) * 6144 + 4096 + col);
                     float4 r;
                     r.x = ALPHA * xv.x + gv.x * v[0]; r.y = ALPHA * xv.y + gv.y * v[1]; r.z = ALPHA * xv.z + gv.z * v[2]; r.w = ALPHA * xv.w + gv.w * v[3];
                     *(float4*)(p.out + (size_t)row * D + col) = r;
                   } else {
                     float4 xv = *(const float4*)(p.ctx + (size_t)(row - NLAT) * D + col);
                     float4 gv = *(const float4*)(mods + (size_t)(l * 3 + 2) * 6144 + 4096 + col);
                     float4 r;
                     r.x = ALPHA * xv.x + gv.x * v[0]; r.y = ALPHA * xv.y + gv.y * v[1]; r.z = ALPHA * xv.z + gv.z * v[2]; r.w = ALPHA * xv.w + gv.w * v[3];
                     *(float4*)(prec + (size_t)(row - NLAT) * D + col) = r;
                   }
                 });
    } else if (lp == 7) { if (PHMASK & 128) { LCX; phase_finln(p, c2, l); } }
  }
}

constexpr int NPHASES = PH_NSTEPS;

extern "C" void kernel_launch(void* const* d_in, const int* in_sizes, int n_in, void* d_out, int out_size, void* d_ws, size_t ws_size,
                              hipStream_t stream) {
  static int grid_blocks = 0;
  if (grid_blocks == 0) {
    if (n_in != 32 || ws_size < WS_END) { fprintf(stderr, "kernel_launch: unexpected n_in %d / ws %zu (need %zu)\n", n_in, ws_size, (size_t)WS_END); grid_blocks = -1; return; }
    int dev = 0, cus = 0, per_cu = 0;
    hipGetDevice(&dev);
    hipDeviceGetAttribute(&cus, hipDeviceAttributeMultiprocessorCount, dev);
    if (hipFuncSetAttribute((const void*)mega_fwd, hipFuncAttributeMaxDynamicSharedMemorySize, LDS_BYTES) != hipSuccess) { fprintf(stderr, "hipFuncSetAttribute failed\n"); grid_blocks = -1; return; }
    if (hipOccupancyMaxActiveBlocksPerMultiprocessor(&per_cu, (const void*)mega_fwd, NTHREADS, LDS_BYTES) != hipSuccess || per_cu < 1) {
      fprintf(stderr, "occupancy query gave %d\n", per_cu); (void)hipGetLastError(); per_cu = 1;
    }
    grid_blocks = cus * per_cu;
  }
  if (grid_blocks < 0) return;
  Params p{};
  const float** pp = (const float**)&p;
  for (int i = 0; i < 32; ++i) pp[i] = (const float*)d_in[i];
  p.out = (float*)d_out;
  p.ws = (char*)d_ws;
  int ph0 = 0, ph1 = NPHASES;
  void* args[] = {&p, &ph0, &ph1};
  hipError_t e = hipLaunchCooperativeKernel((const void*)mega_fwd, dim3(grid_blocks), dim3(NTHREADS), args, LDS_BYTES, stream);
  if (e != hipSuccess) fprintf(stderr, "cooperative launch failed: %s (grid %d)\n", hipGetErrorString(e), grid_blocks);
}
```

```cpp
#include <hip/hip_runtime.h>
#include <hip/hip_cooperative_groups.h>
#include <cstdio>
namespace cg = cooperative_groups;

typedef unsigned short bf16_t;
typedef _Float16 h16;
using bf16x8 = __attribute__((ext_vector_type(8))) _Float16;
using f32x4 = __attribute__((ext_vector_type(4))) float;
using h16x4 = __attribute__((ext_vector_type(4))) _Float16;
using h16x8 = __attribute__((ext_vector_type(8))) _Float16;

#define DEV __device__ __forceinline__

constexpr int D = 2048, NLAT = 32768, MTOT = 33280, ZR = 3072, ZC = 3328;
constexpr int NTHREADS = 512;
constexpr int LDS_BYTES = 147456;
constexpr float ALPHA = 1.41421356237f;
constexpr float DECAY_SCALE = 0.606531f;

constexpr size_t al256(size_t x) { return (x + 255) & ~size_t(255); }
constexpr size_t ARR = (size_t)MTOT * 1024;
constexpr size_t OFF_MODS = 0;
constexpr size_t OFF_S5F = al256(OFF_MODS + 2 * 3 * 6144 * 4);
constexpr size_t OFF_PREC = al256(OFF_S5F + (size_t)2 * 32 * 65 * 2 * 64 * 8);
constexpr size_t OFF_WT = al256(OFF_PREC + (size_t)512 * 2048 * 4);
constexpr size_t WT_IN = 0, WT_OUT = 26214400, WT_W2 = 34603008, WT_A2 = 34865152, WT_POOL = 35127296, WT_GLU = 35258368, WT_SIZE = 35782656;
constexpr size_t OFF_ZREST = al256(OFF_WT + 2 * WT_SIZE);
constexpr size_t OFF_REG2 = al256(OFF_ZREST + (size_t)MTOT * ZR * 2);
constexpr size_t OFF_S5Y = OFF_REG2 + 2 * ARR * 2;
constexpr size_t OFF_SCAN = al256(OFF_REG2 + (size_t)MTOT * ZC * 2);
constexpr size_t OFF_H = OFF_SCAN;
constexpr size_t OFF_YM = OFF_SCAN + 6 * ARR * 2;
constexpr size_t WS_END = OFF_SCAN + 8 * ARR * 2;

#ifndef PH_SEQ
#define PH_SEQ 0xDCBA9876543210ull
#define PH_NSTEPS 14
#endif
struct Params {
  const float *x, *c, *ctx, *c_ctx, *w_ada, *b_ada, *w_in, *conv_rkv, *s5_lam_re, *s5_lam_im, *s5_log_step,
      *s5_b_re, *s5_b_im, *s5_c_re, *s5_c_im, *s5_d, *w_glu, *b_glu, *w_pool, *pool_scale,
      *rwkv_w0, *rwkv_w2, *rwkv_a0, *rwkv_a2, *rwkv_k_k, *rwkv_k_a, *rwkv_r_k, *gn_w, *gn_b,
      *w_out, *ln_g, *ln_b;
  float* out;
  char* ws;
};
struct Ctx { int tid, bid, nblk; };

DEV float rcp_f(float x) { return __builtin_amdgcn_rcpf(x); }
DEV float sigmoid_f(float x) { return rcp_f(1.f + __expf(-x)); }
DEV float silu_f(float x) { return x * rcp_f(1.f + __expf(-x)); }
DEV float tanh_f(float x) { float e = __expf(2.f * x); return 1.f - 2.f * rcp_f(e + 1.f); }
DEV float gelu_f(float y) { return 0.5f * y * (1.f + tanh_f(0.7978845608f * (y + 0.044715f * y * y * y))); }
using h16x2 = __attribute__((ext_vector_type(2))) _Float16;
DEV unsigned pack_bf2(float a, float b) { h16x2 v = {(h16)a, (h16)b}; return __builtin_bit_cast(unsigned, v); }
template <int CTRL> DEV float dpp_mov(float v) {
  return __int_as_float(__builtin_amdgcn_update_dpp(0, __float_as_int(v), CTRL, 0xf, 0xf, true));
}
DEV float allreduce16(float v) {
  v += dpp_mov<0xB1>(v);
  v += dpp_mov<0x4E>(v);
  v += dpp_mov<0x141>(v);
  v += dpp_mov<0x140>(v);
  return v;
}
DEV float wave_sum(float v) {
  v = allreduce16(v);
  return __builtin_amdgcn_readlane(__float_as_int(v), 0) == 0 && false ? 0.f :
         __int_as_float(__builtin_amdgcn_readlane(__float_as_int(v), 0)) + __int_as_float(__builtin_amdgcn_readlane(__float_as_int(v), 16)) +
         __int_as_float(__builtin_amdgcn_readlane(__float_as_int(v), 32)) + __int_as_float(__builtin_amdgcn_readlane(__float_as_int(v), 48));
}
DEV float allreduce8(float v) {
  v += dpp_mov<0xB1>(v);
  v += dpp_mov<0x4E>(v);
  v += dpp_mov<0x141>(v);
  return v;
}
DEV void lds_fence() { asm volatile("s_waitcnt lgkmcnt(0)" ::: "memory"); }

DEV void p0_mods_item(const Params& p, const Ctx& cx, int item, char* smem) {
  float* red = (float*)smem;
  float* mods = (float*)(p.ws + OFF_MODS);
  int l = item / 96, chunk = item % 96;
  int tid = cx.tid, kq = tid >> 6, col = tid & 63;
  int n = chunk * 64 + col;
  const float* W = p.w_ada + (size_t)l * 2048 * 6144;
  float a0 = 0, a1 = 0, a2 = 0;
#pragma unroll 8
  for (int k = kq; k < 2048; k += 8) {
    float w = W[(size_t)k * 6144 + n];
    a0 += silu_f(p.c[k]) * w;
    a1 += silu_f(p.c[2048 + k]) * w;
    a2 += silu_f(p.c_ctx[k]) * w;
  }
  red[(kq * 3 + 0) * 64 + col] = a0;
  red[(kq * 3 + 1) * 64 + col] = a1;
  red[(kq * 3 + 2) * 64 + col] = a2;
  __syncthreads();
  if (tid < 192) {
    int r = tid >> 6, cc = tid & 63;
    float s = 0;
#pragma unroll
    for (int q = 0; q < 8; ++q) s += red[(q * 3 + r) * 64 + cc];
    mods[(size_t)(l * 3 + r) * 6144 + chunk * 64 + cc] = s + p.b_ada[(size_t)l * 6144 + chunk * 64 + cc];
  }
}

DEV void p0_transpose_tile(const Params& p, const Ctx& cx, const float* __restrict__ src, bf16_t* __restrict__ dst, int K, int N, int tk, int tn, char* smem) {
  float* T = (float*)smem;
  int tid = cx.tid;
  int k0 = tk * 64, n0 = tn * 64;
  int kk = tid >> 4, n4 = tid & 15;
#pragma unroll
  for (int i = 0; i < 2; ++i) {
    int k = kk + 32 * i;
    float4 v = *(const float4*)(src + (size_t)(k0 + k) * N + n0 + n4 * 4);
    T[k * 65 + n4 * 4 + 0] = v.x; T[k * 65 + n4 * 4 + 1] = v.y; T[k * 65 + n4 * 4 + 2] = v.z; T[k * 65 + n4 * 4 + 3] = v.w;
  }
  __syncthreads();
  int n = tid >> 3, k8 = tid & 7;
  uint4 o;
  o.x = pack_bf2(T[(k8 * 8 + 0) * 65 + n], T[(k8 * 8 + 1) * 65 + n]);
  o.y = pack_bf2(T[(k8 * 8 + 2) * 65 + n], T[(k8 * 8 + 3) * 65 + n]);
  o.z = pack_bf2(T[(k8 * 8 + 4) * 65 + n], T[(k8 * 8 + 5) * 65 + n]);
  o.w = pack_bf2(T[(k8 * 8 + 6) * 65 + n], T[(k8 * 8 + 7) * 65 + n]);
  *(uint4*)(dst + (size_t)(n0 + n) * K + k0 + k8 * 8) = o;
}

DEV void phase0(const Params& p, const Ctx& cx0, char* smem) {
  const int NTR = 4368;
  const int total = 192 + 2 * NTR;
  for (int item = cx0.bid; item < total; item += cx0.nblk) {
    __syncthreads();
    Ctx cx = cx0; asm volatile("" : "+v"(cx.tid));
    if (item < 192) { p0_mods_item(p, cx, item, smem); continue; }
    int it = item - 192;
    int l = it / NTR, i = it % NTR;
    char* wt = p.ws + OFF_WT + (size_t)l * WT_SIZE;
    if (i < 3200) {
      p0_transpose_tile(p, cx, p.w_in + (size_t)l * 2048 * 6400, (bf16_t*)(wt + WT_IN), 2048, 6400, i / 100, i % 100, smem);
    } else if (i < 4224) {
      int j = i - 3200;
      p0_transpose_tile(p, cx, p.w_out + (size_t)l * 2048 * 2048, (bf16_t*)(wt + WT_OUT), 2048, 2048, j / 32, j % 32, smem);
    } else if (i < 4256) {
      int j = i - 4224, d = j / 16;
      p0_transpose_tile(p, cx, p.rwkv_w2 + (size_t)(l * 2 + d) * 64 * 1024, (bf16_t*)(wt + WT_W2) + (size_t)d * 1024 * 64, 64, 1024, 0, j % 16, smem);
    } else if (i < 4288) {
      int j = i - 4256, d = j / 16;
      p0_transpose_tile(p, cx, p.rwkv_a2 + (size_t)(l * 2 + d) * 64 * 1024, (bf16_t*)(wt + WT_A2) + (size_t)d * 1024 * 64, 64, 1024, 0, j % 16, smem);
    } else if (i < 4304) {
      int j = i - 4288, g = j / 4;
      p0_transpose_tile(p, cx, p.w_pool + (size_t)(l * 4 + g) * 128 * 128, (bf16_t*)(wt + WT_POOL) + (size_t)g * 128 * 128, 128, 128, (j % 4) / 2, j % 2, smem);
    } else {
      int j = i - 4304;
      p0_transpose_tile(p, cx, p.w_glu + (size_t)l * 512 * 512, (bf16_t*)(wt + WT_GLU), 512, 512, j / 8, j % 8, smem);
    }
  }
}

DEV void phase_adaln0(const Params& p, const Ctx& cx) {
  const float* mods = (const float*)(p.ws + OFF_MODS);
  bf16_t* hbuf = (bf16_t*)(p.ws + OFF_H);
  int lane = cx.tid & 63;
  int gw = cx.bid * 8 + (cx.tid >> 6), nw = cx.nblk * 8;
  for (int row = gw; row < MTOT; row += nw) {
    const float* src = row < NLAT ? p.x + (size_t)row * D : p.ctx + (size_t)(row - NLAT) * D;
    int mr = row < NLAT ? (row >> 14) : 2;
    const float* md = mods + (size_t)mr * 6144;
    float4 v[8];
    float s = 0;
#pragma unroll
    for (int i = 0; i < 8; ++i) { v[i] = *(const float4*)(src + i * 256 + lane * 4); s += v[i].x + v[i].y + v[i].z + v[i].w; }
    float mu = wave_sum(s) * (1.f / 2048.f);
    float q = 0;
#pragma unroll
    for (int i = 0; i < 8; ++i) { v[i].x -= mu; v[i].y -= mu; v[i].z -= mu; v[i].w -= mu; q += v[i].x * v[i].x + v[i].y * v[i].y + v[i].z * v[i].z + v[i].w * v[i].w; }
    float rstd = rsqrtf(wave_sum(q) * (1.f / 2048.f) + 1e-6f);
#pragma unroll
    for (int i = 0; i < 8; ++i) {
      int col = i * 256 + lane * 4;
      float4 sh = *(const float4*)(md + col), sc = *(const float4*)(md + 2048 + col);
      uint2 o;
      o.x = pack_bf2(v[i].x * rstd * (1.f + sc.x) + sh.x, v[i].y * rstd * (1.f + sc.y) + sh.y);
      o.y = pack_bf2(v[i].z * rstd * (1.f + sc.z) + sh.z, v[i].w * rstd * (1.f + sc.w) + sh.w);
      *(uint2*)(hbuf + (size_t)row * D + col) = o;
    }
  }
}

DEV void phase_finln(const Params& p, const Ctx& cx, int l) {
  const float* mods = (const float*)(p.ws + OFF_MODS);
  bf16_t* hbuf = (bf16_t*)(p.ws + OFF_H);
  float* prec = (float*)(p.ws + OFF_PREC);
  int lane = cx.tid & 63;
  int gw = cx.bid * 8 + (cx.tid >> 6), nw = cx.nblk * 8;
  const int nrows = (l == 0) ? MTOT : NLAT;
  for (int row = gw; row < nrows; row += nw) {
    float* src = row < NLAT ? p.out + (size_t)row * D : prec + (size_t)(row - NLAT) * D;
    float4 v[8];
    float s = 0;
#pragma unroll
    for (int i = 0; i < 8; ++i) { v[i] = *(const float4*)(src + i * 256 + lane * 4); s += v[i].x + v[i].y + v[i].z + v[i].w; }
    float mu = wave_sum(s) * (1.f / 2048.f);
    float q = 0;
#pragma unroll
    for (int i = 0; i < 8; ++i) { v[i].x -= mu; v[i].y -= mu; v[i].z -= mu; v[i].w -= mu; q += v[i].x * v[i].x + v[i].y * v[i].y + v[i].z * v[i].z + v[i].w * v[i].w; }
    float rstd = rsqrtf(wave_sum(q) * (1.f / 2048.f) + 1e-5f);
    float s2 = 0;
#pragma unroll
    for (int i = 0; i < 8; ++i) {
      int col = i * 256 + lane * 4;
      float4 g = *(const float4*)(p.ln_g + (size_t)l * D + col), b = *(const float4*)(p.ln_b + (size_t)l * D + col);
      v[i].x = v[i].x * rstd * g.x + b.x; v[i].y = v[i].y * rstd * g.y + b.y; v[i].z = v[i].z * rstd * g.z + b.z; v[i].w = v[i].w * rstd * g.w + b.w;
      if (row < NLAT) *(float4*)(src + col) = v[i];
      s2 += v[i].x + v[i].y + v[i].z + v[i].w;
    }
    if (l == 0) {
      int mr = row < NLAT ? (row >> 14) : 2;
      const float* md = mods + (size_t)(3 + mr) * 6144;
      float mu2 = wave_sum(s2) * (1.f / 2048.f);
      float q2 = 0;
#pragma unroll
      for (int i = 0; i < 8; ++i) { v[i].x -= mu2; v[i].y -= mu2; v[i].z -= mu2; v[i].w -= mu2; q2 += v[i].x * v[i].x + v[i].y * v[i].y + v[i].z * v[i].z + v[i].w * v[i].w; }
      float rstd2 = rsqrtf(wave_sum(q2) * (1.f / 2048.f) + 1e-6f);
#pragma unroll
      for (int i = 0; i < 8; ++i) {
        int col = i * 256 + lane * 4;
        float4 sh = *(const float4*)(md + col), sc = *(const float4*)(md + 2048 + col);
        uint2 o;
        o.x = pack_bf2(v[i].x * rstd2 * (1.f + sc.x) + sh.x, v[i].y * rstd2 * (1.f + sc.y) + sh.y);
        o.y = pack_bf2(v[i].z * rstd2 * (1.f + sc.z) + sh.z, v[i].w * rstd2 * (1.f + sc.w) + sh.w);
        *(uint2*)(hbuf + (size_t)row * D + col) = o;
      }
    }
  }
}

template <class Epi>
DEV void gemm_phase(const Params& p, const Ctx& cx, const bf16_t* __restrict__ A, const bf16_t* __restrict__ Bt, int K, int nM, int nN, char* smem, Epi epi) {
  const int tid = cx.tid, lane = tid & 63, wid = tid >> 6;
  const int wr = wid >> 2, wc = wid & 3, fr = lane & 15, fq = lane >> 4;
  const int nt = K / 64;
  const int ntiles = nM * nN;
  const int srow = tid >> 3, sc16 = tid & 7;
  const int nxcd = (cx.nblk & 7) == 0 ? 8 : 1;
  const int xcd = cx.bid % nxcd, xidx = cx.bid / nxcd, xper = cx.nblk / nxcd;
  const int t_lo = (int)(((long)ntiles * xcd) / nxcd), t_hi = (int)(((long)ntiles * (xcd + 1)) / nxcd);
  for (int tt = t_lo + xidx; tt < t_hi; tt += xper) {
    const int band = tt / (16 * nN);
    const int brows = min(16, nM - band * 16);
    const int rem = tt - band * 16 * nN;
    const int pn = rem / brows, pm = band * 16 + rem % brows;
    const int brow = pm * 256, bcol = pn * 256;
    const char* Ab = (const char*)(A + (size_t)brow * K);
    const char* Bb = (const char*)(Bt + (size_t)bcol * K);
    const unsigned voff = (unsigned)(srow * K + sc16 * 8) * 2u;
    const size_t rs = (size_t)64 * K * 2;
    f32x4 acc[8][4];
#pragma unroll
    for (int i = 0; i < 8; ++i)
#pragma unroll
      for (int j = 0; j < 4; ++j) acc[i][j] = f32x4{0.f, 0.f, 0.f, 0.f};
    uint4 ra0, ra1, ra2, ra3, rb0, rb1, rb2, rb3;
#define G_LD(ko) { const char* a_ = Ab + (size_t)(ko) * 2; const char* b_ = Bb + (size_t)(ko) * 2; \
                 ra0 = *(const uint4*)(a_ + voff); ra1 = *(const uint4*)(a_ + rs + voff); ra2 = *(const uint4*)(a_ + 2 * rs + voff); ra3 = *(const uint4*)(a_ + 3 * rs + voff); \
                 rb0 = *(const uint4*)(b_ + voff); rb1 = *(const uint4*)(b_ + rs + voff); rb2 = *(const uint4*)(b_ + 2 * rs + voff); rb3 = *(const uint4*)(b_ + 3 * rs + voff); }
#define G_ST(sp) { *(uint4*)(sp) = ra0; *(uint4*)((sp) + 64 * 144) = ra1; *(uint4*)((sp) + 128 * 144) = ra2; *(uint4*)((sp) + 192 * 144) = ra3; \
                 *(uint4*)((sp) + 36864) = rb0; *(uint4*)((sp) + 36864 + 64 * 144) = rb1; *(uint4*)((sp) + 36864 + 128 * 144) = rb2; *(uint4*)((sp) + 36864 + 192 * 144) = rb3; }
    char* const sbase = smem + srow * 144 + sc16 * 16;
    G_LD(0);
    G_ST(sbase);
    if (nt > 1) G_LD(64);
    for (int kt = 0; kt < nt; ++kt) {
      __syncthreads();
      if (kt + 1 < nt) { char* s1 = sbase + ((kt + 1) & 1) * 73728; G_ST(s1); }
      if (kt + 2 < nt) G_LD((kt + 2) * 64);
      const char* As = smem + (kt & 1) * 73728;
      const char* Bs = As + 36864;
#pragma unroll
      for (int kh = 0; kh < 2; ++kh) {
        bf16x8 bfr[4];
#pragma unroll
        for (int jn = 0; jn < 4; ++jn) bfr[jn] = *(const bf16x8*)(Bs + (wc * 64 + jn * 16 + fr) * 144 + kh * 64 + fq * 16);
#pragma unroll
        for (int i = 0; i < 8; ++i) {
          bf16x8 af = *(const bf16x8*)(As + (wr * 128 + i * 16 + fr) * 144 + kh * 64 + fq * 16);
#pragma unroll
          for (int jn = 0; jn < 4; ++jn) acc[i][jn] = __builtin_amdgcn_mfma_f32_16x16x32_f16(bfr[jn], af, acc[i][jn], 0, 0, 0);
        }
      }
    }
    __syncthreads();
#pragma unroll
    for (int i = 0; i < 8; ++i)
#pragma unroll
      for (int jn = 0; jn < 4; ++jn) epi(brow + wr * 128 + i * 16 + fr, bcol + wc * 64 + jn * 16 + fq * 4, acc[i][jn]);
  }
}

#define LAS3 __attribute__((address_space(3)))
DEV int g2_lds_byte(int r, int c) { const int st = (r >> 4) * 2 + (c >> 5), rr = r & 15, cc = c & 31, ob = rr * 64 + cc * 2; return st * 1024 + (ob ^ (((ob >> 9) & 1) << 5)); }
DEV void g2_stage_rc(int b, int& R, int& C) { const int st = b / 1024, sb = b % 1024, swz = sb ^ (((sb >> 9) & 1) << 5); R = (st >> 1) * 16 + swz / 64; C = (st & 1) * 32 + (swz % 64) / 2; }

template <class Epi>
DEV void gemm_phase2(const Params& p, const Ctx& cx, const bf16_t* __restrict__ A, const bf16_t* __restrict__ Bt, int K, int nM, int nN, char* smem, Epi epi) {
  constexpr int HTB = 128 * 64 * 2;
  LAS3 unsigned char* lds = (LAS3 unsigned char*)smem;
  const int tid = cx.tid, wid = __builtin_amdgcn_readfirstlane(tid >> 6), lane = tid & 63, wr = wid >> 2, wc = wid & 3, fr = lane & 15, fq = lane >> 4;
  const int nt = K / 64;
  const int ntiles = nM * nN;
  const int nxcd = (cx.nblk & 7) == 0 ? 8 : 1;
  const int xcd = cx.bid % nxcd, xidx = cx.bid / nxcd, xper = cx.nblk / nxcd;
  const int t_lo = (int)(((long)ntiles * xcd) / nxcd), t_hi = (int)(((long)ntiles * (xcd + 1)) / nxcd);
  auto unit_at = [&](int i, int& pm, int& pn) -> bool {
    const int tt = t_lo + xidx + i * xper;
    if (tt >= t_hi) return false;
    const int band = tt / (16 * nN);
    const int brows = min(16, nM - band * 16);
    const int rem = tt - band * 16 * nN;
    pn = rem / brows; pm = band * 16 + rem % brows;
    return true;
  };
  unsigned voffA[2], voffB[2];
#pragma unroll
  for (int i = 0; i < 2; ++i) {
    int R, C; g2_stage_rc(tid * 16 + i * 8192, R, C);
    const int rho = R & 31, Rb = (R & ~31) + 8 * ((rho & 15) >> 2) + 4 * (rho >> 4) + (rho & 3);
    voffA[i] = (unsigned)(R * K + C) * 2u; voffB[i] = (unsigned)(Rb * K + C) * 2u;
  }
  const size_t kstep = (size_t)(64 * 2);
  const size_t hstep = (size_t)128 * K * 2;
  const size_t tstep = 2 * hstep;
  const unsigned ldsw = (unsigned)wid * 1024u;
  const int aoff = g2_lds_byte(wr * 64 + fr, fq * 8), boff = g2_lds_byte(wc * 32 + fr, fq * 8);
#define G2_SA(b, h) (((b) * 2 + (h)) * HTB)
#define G2_SB(b, h) ((4 + (b) * 2 + (h)) * HTB)
#define G2_STAGE_(bufoff, gbase, vo_) do { _Pragma("unroll") for (int _i = 0; _i < 2; ++_i) \
    __builtin_amdgcn_global_load_lds((const unsigned*)((const char*)(gbase) + vo_[_i]), (LAS3 unsigned*)(lds + (bufoff) + ldsw + _i * 8192), 16, 0, 0); } while (0)
#define G2_STAGE(bufoff, gbase) G2_STAGE_(bufoff, gbase, voffA)
#define G2_STAGEB(bufoff, gbase) G2_STAGE_(bufoff, gbase, voffB)
#define G2_LDA(dst, b, h) do { _Pragma("unroll") for (int m = 0; m < 4; ++m) _Pragma("unroll") for (int k = 0; k < 2; ++k) dst[m][k] = *(const LAS3 bf16x8*)(lds + G2_SA(b, h) + aoff + m * 2048 + k * 1024); } while (0)
#define G2_LDB(dst, b, h) do { _Pragma("unroll") for (int n = 0; n < 2; ++n) _Pragma("unroll") for (int k = 0; k < 2; ++k) dst[n][k] = *(const LAS3 bf16x8*)(lds + G2_SB(b, h) + boff + n * 2048 + k * 1024); } while (0)
#define G2_MMA(ai, bj, At_, Bt_) do { __builtin_amdgcn_s_setprio(1); _Pragma("unroll") for (int m = 0; m < 4; ++m) _Pragma("unroll") for (int n = 0; n < 2; ++n) _Pragma("unroll") for (int k = 0; k < 2; ++k) \
    acc[ai][bj][m][n] = __builtin_amdgcn_mfma_f32_16x16x32_f16(Bt_[n][k], At_[m][k], acc[ai][bj][m][n], 0, 0, 0); __builtin_amdgcn_s_setprio(0); } while (0)
#define G2_WAIT_V(n) asm volatile("s_waitcnt vmcnt(" #n ")" ::: "memory")
#define G2_WAIT_L(n) asm volatile("s_waitcnt lgkmcnt(" #n ")" ::: "memory")
#define G2_BAR __builtin_amdgcn_s_barrier()
#define G2_SCHED __builtin_amdgcn_sched_barrier(0)
  int cpm, cpn, npm = 0, npn = 0, ui = 0;
  if (!unit_at(0, cpm, cpn)) return;
  f32x4 acc[2][2][4][2];
#pragma unroll
  for (int a = 0; a < 2; ++a)
#pragma unroll
    for (int b = 0; b < 2; ++b)
#pragma unroll
      for (int m = 0; m < 4; ++m)
#pragma unroll
        for (int n = 0; n < 2; ++n) acc[a][b][m][n] = f32x4{0.f, 0.f, 0.f, 0.f};
  bf16x8 At[4][2], B0[2][2], B1[2][2];
  const char* cA = (const char*)A + (size_t)cpm * tstep;
  const char* cB = (const char*)Bt + (size_t)cpn * tstep;
  G2_STAGEB(G2_SB(0, 0), cB); G2_STAGE(G2_SA(0, 0), cA); G2_STAGEB(G2_SB(0, 1), cB + hstep); G2_STAGE(G2_SA(0, 1), cA + hstep);
  if (wr == 1) G2_BAR;
  G2_WAIT_V(4); G2_BAR;
  G2_STAGEB(G2_SB(1, 0), cB + kstep); G2_STAGE(G2_SA(1, 0), cA + kstep); G2_STAGEB(G2_SB(1, 1), cB + hstep + kstep);
  G2_WAIT_V(6); G2_BAR;
  for (;;) {
    const bool has_next = unit_at(ui + 1, npm, npn);
    const char* nA = has_next ? (const char*)A + (size_t)npm * tstep : cA;
    const char* nB = has_next ? (const char*)Bt + (size_t)npn * tstep : cB;
    for (int t = 0; t < nt; t += 2) {
      const bool last = (t == nt - 2);
      const char* a1 = cA + (size_t)(t + 1) * kstep;
      const char* a2 = last ? nA : cA + (size_t)(t + 2) * kstep;
      const char* b2 = last ? nB : cB + (size_t)(t + 2) * kstep;
      const char* a3 = a2 + kstep;
      const char* b3 = b2 + kstep;
      G2_LDB(B0, 0, 0); G2_SCHED; G2_LDA(At, 0, 0); G2_STAGE(G2_SA(1, 1), a1 + hstep);
      G2_WAIT_L(8); G2_BAR; G2_WAIT_L(0); G2_MMA(0, 0, At, B0); G2_BAR; G2_SCHED;
      G2_LDB(B1, 0, 1); G2_STAGEB(G2_SB(0, 0), b2);
      G2_BAR; G2_WAIT_L(0); G2_MMA(0, 1, At, B1); G2_BAR;
      G2_LDA(At, 0, 1); G2_STAGE(G2_SA(0, 0), a2);
      G2_BAR; G2_WAIT_L(0); G2_MMA(1, 0, At, B0); G2_BAR; G2_SCHED;
      G2_STAGEB(G2_SB(0, 1), b2 + hstep);
      G2_WAIT_V(6); G2_BAR; G2_MMA(1, 1, At, B1); G2_BAR;
      G2_LDB(B0, 1, 0); G2_SCHED; G2_LDA(At, 1, 0); G2_STAGE(G2_SA(0, 1), a2 + hstep);
      G2_WAIT_L(8); G2_BAR; G2_WAIT_L(0); G2_MMA(0, 0, At, B0); G2_BAR; G2_SCHED;
      G2_LDB(B1, 1, 1); G2_STAGEB(G2_SB(1, 0), b3);
      G2_BAR; G2_WAIT_L(0); G2_MMA(0, 1, At, B1); G2_BAR;
      G2_LDA(At, 1, 1); G2_STAGE(G2_SA(1, 0), a3);
      G2_BAR; G2_WAIT_L(0); G2_MMA(1, 0, At, B0); G2_BAR; G2_SCHED;
      G2_STAGEB(G2_SB(1, 1), b3 + hstep);
      G2_WAIT_V(6); G2_BAR; G2_MMA(1, 1, At, B1); G2_BAR;
    }
    {
      const int row0 = cpm * 256 + wr * 64 + fr, col0 = cpn * 256 + wc * 32 + 8 * fq;
#pragma unroll
      for (int ai = 0; ai < 2; ++ai)
#pragma unroll
        for (int m = 0; m < 4; ++m)
#pragma unroll
          for (int bj = 0; bj < 2; ++bj) epi(row0 + ai * 128 + m * 16, col0 + bj * 128, acc[ai][bj][m][0], acc[ai][bj][m][1]);
    }
    if (!has_next) break;
#pragma unroll
    for (int a = 0; a < 2; ++a)
#pragma unroll
      for (int b = 0; b < 2; ++b)
#pragma unroll
        for (int m = 0; m < 4; ++m)
#pragma unroll
          for (int n = 0; n < 2; ++n) acc[a][b][m][n] = f32x4{0.f, 0.f, 0.f, 0.f};
    cpm = npm; cpn = npn; cA = nA; cB = nB; ++ui;
  }
  G2_WAIT_V(0);
  if (wr == 0) G2_BAR;
  G2_BAR;
#undef G2_SA
#undef G2_SB
#undef G2_STAGE
#undef G2_STAGEB
#undef G2_STAGE_
#undef G2_LDA
#undef G2_LDB
#undef G2_MMA
#undef G2_WAIT_V
#undef G2_WAIT_L
#undef G2_BAR
#undef G2_SCHED
}

template <int K, int NT, class Epi>
DEV void small_gemm(const Params& p, const Ctx& cx, const char* As, int astride, const bf16_t* __restrict__ Bt, int n0, Epi epi) {
  const int lane = cx.tid & 63, fr = lane & 15, fq = lane >> 4;
  f32x4 acc[4][NT];
#pragma unroll
  for (int i = 0; i < 4; ++i)
#pragma unroll
    for (int j = 0; j < NT; ++j) acc[i][j] = f32x4{0.f, 0.f, 0.f, 0.f};
#pragma unroll 2
  for (int k0 = 0; k0 < K; k0 += 32) {
    bf16x8 af[4];
#pragma unroll
    for (int i = 0; i < 4; ++i) af[i] = *(const bf16x8*)(As + (i * 16 + fr) * astride + (k0 + fq * 8) * 2);
#pragma unroll
    for (int jn = 0; jn < NT; ++jn) {
      bf16x8 bf = *(const bf16x8*)(Bt + (size_t)(n0 + jn * 16 + fr) * K + k0 + fq * 8);
#pragma unroll
      for (int i = 0; i < 4; ++i) acc[i][jn] = __builtin_amdgcn_mfma_f32_16x16x32_f16(bf, af[i], acc[i][jn], 0, 0, 0);
    }
  }
#pragma unroll
  for (int i = 0; i < 4; ++i)
#pragma unroll
    for (int jn = 0; jn < NT; ++jn) epi(i * 16 + fr, n0 + jn * 16 + fq * 4, acc[i][jn]);
}

struct S5P { float ar, ai, br, bi; };
DEV S5P s5_params(const Params& p, const Ctx& cx, int l, int d, int g, int lane) {
  int idx = ((l * 2 + d) * 32 + g) * 64 + lane;
  float lr = fminf(p.s5_lam_re[idx], -1e-4f), li = p.s5_lam_im[idx];
  float step = expf(p.s5_log_step[(l * 2 + d) * 32 + g]);
  float xr = lr * step, xi = li * step;
  float e = expf(xr), cs = cosf(xi), sn = sinf(xi);
  S5P r;
  r.ar = e * cs; r.ai = e * sn;
  float sh = sinf(0.5f * xi);
  float nr = expm1f(xr) * cs - 2.f * sh * sh, ni = e * sn;
  float inv = 1.f / (lr * lr + li * li);
  r.br = (nr * lr + ni * li) * inv;
  r.bi = (ni * lr - nr * li) * inv;
  return r;
}

DEV void s5_load_u(const h16* zrest, int rowbase, int g, char* ulds, int lane) {
#pragma unroll
  for (int i = 0; i < 8; ++i) {
    int e = i * 64 + lane;
    int r = e >> 1, hf = e & 1;
    uint4 v = *(const uint4*)(zrest + (size_t)(rowbase + r) * ZR + g * 16 + hf * 8);
    *(uint4*)(ulds + r * 32 + hf * 16) = v;
  }
  lds_fence();
}

DEV int s5_rowbase(int b, int c) { return c == 0 ? NLAT + b * 256 : b * 16384 + (c - 1) * 256; }

DEV void s5_pass1_unit(const Params& p, const Ctx& cx, int l, int unit, char* wl, int lane) {
  int c = unit % 65, bg = unit / 65, g = bg & 31, b = bg >> 5;
  const h16* zrest = (const h16*)(p.ws + OFF_ZREST);
  float2* F = (float2*)(p.ws + OFF_S5F);
  s5_load_u(zrest, s5_rowbase(b, c), g, wl, lane);
  float Br[16], Bi[16];
  {
    const float* pr = p.s5_b_re + ((size_t)(l * 32 + g) * 64 + lane) * 16;
    const float* pi = p.s5_b_im + ((size_t)(l * 32 + g) * 64 + lane) * 16;
#pragma unroll
    for (int i = 0; i < 16; i += 4) {
      float4 a = *(const float4*)(pr + i), bq = *(const float4*)(pi + i);
      Br[i] = a.x; Br[i + 1] = a.y; Br[i + 2] = a.z; Br[i + 3] = a.w;
      Bi[i] = bq.x; Bi[i + 1] = bq.y; Bi[i + 2] = bq.z; Bi[i + 3] = bq.w;
    }
  }
  S5P pf = s5_params(p, cx, l, 0, g, lane), pb = s5_params(p, cx, l, 1, g, lane);
  float xr = 0, xi = 0, yr = 0, yi = 0, pwr = 1.f, pwi = 0.f;
#pragma unroll 4
  for (int t = 0; t < 256; ++t) {
    h16x8 u0 = *(const h16x8*)(wl + t * 32), u1 = *(const h16x8*)(wl + t * 32 + 16);
    float br = 0, bi = 0;
#pragma unroll
    for (int i = 0; i < 8; ++i) { float u = (float)u0[i]; br = fmaf(u, Br[i], br); bi = fmaf(u, Bi[i], bi); }
#pragma unroll
    for (int i = 0; i < 8; ++i) { float u = (float)u1[i]; br = fmaf(u, Br[8 + i], br); bi = fmaf(u, Bi[8 + i], bi); }
    float vr = pf.br * br - pf.bi * bi, vi = pf.br * bi + pf.bi * br;
    float nxr = pf.ar * xr - pf.ai * xi + vr, nxi = pf.ar * xi + pf.ai * xr + vi;
    xr = nxr; xi = nxi;
    float wr_ = pb.br * br - pb.bi * bi, wi_ = pb.br * bi + pb.bi * br;
    yr += pwr * wr_ - pwi * wi_; yi += pwr * wi_ + pwi * wr_;
    float npr = pwr * pb.ar - pwi * pb.ai, npi = pwr * pb.ai + pwi * pb.ar;
    pwr = npr; pwi = npi;
  }
  size_t fi = (((size_t)(b * 32 + g) * 65 + c) * 2) * 64 + lane;
  F[fi] = make_float2(xr, xi);
  F[fi + 64] = make_float2(yr, yi);
}

DEV void s5_pass3_unit(const Params& p, const Ctx& cx, int l, int unit, char* wl, int lane) {
  int c = unit % 65, bg = unit / 65, g = bg & 31, b = bg >> 5;
  const int fr = lane & 15, fq = lane >> 4;
  const h16* zrest = (const h16*)(p.ws + OFF_ZREST);
  const float2* F = (const float2*)(p.ws + OFF_S5F);
  float* S5Y = (float*)(p.ws + OFF_S5Y);
  const int rowbase = s5_rowbase(b, c);
  char* ulds = wl;
  char* tile = wl + 8192;
  s5_load_u(zrest, rowbase, g, ulds, lane);
  float Br[16], Bi[16];
  {
    const float* pr = p.s5_b_re + ((size_t)(l * 32 + g) * 64 + lane) * 16;
    const float* pi = p.s5_b_im + ((size_t)(l * 32 + g) * 64 + lane) * 16;
#pragma unroll
    for (int i = 0; i < 16; i += 4) {
      float4 a = *(const float4*)(pr + i), bq = *(const float4*)(pi + i);
      Br[i] = a.x; Br[i + 1] = a.y; Br[i + 2] = a.z; Br[i + 3] = a.w;
      Bi[i] = bq.x; Bi[i + 1] = bq.y; Bi[i + 2] = bq.z; Bi[i + 3] = bq.w;
    }
  }
  const float dsk = p.s5_d[(size_t)l * 512 + g * 16 + fr];
  const size_t fbase = ((size_t)(b * 32 + g) * 65) * 2 * 64 + lane;
#pragma unroll 1
  for (int d = 0; d < 2; ++d) {
    S5P pp = s5_params(p, cx, l, d, g, lane);
    float qr = pp.ar, qi = pp.ai;
#pragma unroll
    for (int i = 0; i < 8; ++i) { float t = qr * qr - qi * qi; qi = 2.f * qr * qi; qr = t; }
    float xr = 0, xi = 0;
    if (d == 0) {
      for (int cc = 0; cc < c; ++cc) {
        float2 f = F[fbase + (size_t)(cc * 2 + 0) * 64];
        float t = qr * xr - qi * xi + f.x; xi = qr * xi + qi * xr + f.y; xr = t;
      }
    } else if (c > 0) {
      float2 f0 = F[fbase + (size_t)(0 * 2 + 1) * 64];
      xr = f0.x; xi = f0.y;
      for (int cc = 64; cc > c; --cc) {
        float2 f = F[fbase + (size_t)(cc * 2 + 1) * 64];
        float t = qr * xr - qi * xi + f.x; xi = qr * xi + qi * xr + f.y; xr = t;
      }
    }
    bf16x8 chi[4], clo[4];
    {
      const float* cr = p.s5_c_re + ((size_t)((l * 2 + d) * 32 + g) * 16 + fr) * 64;
      const float* ci = p.s5_c_im + ((size_t)((l * 2 + d) * 32 + g) * 16 + fr) * 64;
#pragma unroll
      for (int ks = 0; ks < 4; ++ks) {
        float4 a = *(const float4*)(cr + ks * 16 + fq * 4), bq = *(const float4*)(ci + ks * 16 + fq * 4);
        float vals[8] = {a.x, -bq.x, a.y, -bq.y, a.z, -bq.z, a.w, -bq.w};
#pragma unroll
        for (int j = 0; j < 8; ++j) {
          h16 hh = (h16)vals[j];
          chi[ks][j] = hh;
          clo[ks][j] = (h16)(vals[j] - (float)hh);
        }
      }
    }
#pragma unroll 1
    for (int sb = 0; sb < 16; ++sb) {
      const int sub = d == 0 ? sb : 15 - sb;
#pragma unroll 4
      for (int q = 0; q < 16; ++q) {
        const int tt = d == 0 ? q : 15 - q;
        const int t = sub * 16 + tt;
        h16x8 u0 = *(const h16x8*)(ulds + t * 32), u1 = *(const h16x8*)(ulds + t * 32 + 16);
        float br = 0, bi = 0;
#pragma unroll
        for (int i = 0; i < 8; ++i) { float u = (float)u0[i]; br = fmaf(u, Br[i], br); bi = fmaf(u, Bi[i], bi); }
#pragma unroll
        for (int i = 0; i < 8; ++i) { float u = (float)u1[i]; br = fmaf(u, Br[8 + i], br); bi = fmaf(u, Bi[8 + i], bi); }
        float vr = pp.br * br - pp.bi * bi, vi = pp.br * bi + pp.bi * br;
        float nxr = pp.ar * xr - pp.ai * xi + vr, nxi = pp.ar * xi + pp.ai * xr + vi;
        xr = nxr; xi = nxi;
        h16x2 hv2 = {(h16)xr, (h16)xi};
        float lr_ = xr - (float)hv2[0], li_ = xi - (float)hv2[1];
        *(unsigned*)(tile + tt * 272 + lane * 4) = __builtin_bit_cast(unsigned, hv2);
        *(unsigned*)(tile + 4352 + tt * 272 + lane * 4) = pack_bf2(lr_, li_);
      }
      lds_fence();
      f32x4 acc = f32x4{0.f, 0.f, 0.f, 0.f};
#pragma unroll
      for (int ks = 0; ks < 4; ++ks) {
        bf16x8 ah = *(const bf16x8*)(tile + fr * 272 + ks * 64 + fq * 16);
        bf16x8 alo = *(const bf16x8*)(tile + 4352 + fr * 272 + ks * 64 + fq * 16);
        acc = __builtin_amdgcn_mfma_f32_16x16x32_f16(ah, chi[ks], acc, 0, 0, 0);
        acc = __builtin_amdgcn_mfma_f32_16x16x32_f16(alo, chi[ks], acc, 0, 0, 0);
        acc = __builtin_amdgcn_mfma_f32_16x16x32_f16(ah, clo[ks], acc, 0, 0, 0);
      }
      lds_fence();
#pragma unroll
      for (int r = 0; r < 4; ++r) {
        int tl = sub * 16 + fq * 4 + r;
        float* yp = S5Y + (size_t)(rowbase + tl) * 512 + g * 16 + fr;
        if (d == 0) {
          float u = (float)*(const h16*)(ulds + tl * 32 + fr * 2);
          *yp = acc[r] + dsk * u;
        } else {
          *yp = gelu_f(*yp + acc[r]);
        }
      }
    }
  }
}

DEV void prep_item(const Params& p, const Ctx& cx, int l, int item, char* smem) {
  const int tile = item >> 2, q = item & 3;
  const int row0 = tile * 64;
  const int tid = cx.tid;
  const h16* zc = (const h16*)(p.ws + OFF_REG2);
  h16* SC = (h16*)(p.ws + OFF_SCAN);
  const char* wt = p.ws + OFF_WT + (size_t)l * WT_SIZE;
  {
    const int d = q >> 1, isA = q & 1;
    const int coff = isA ? 3200 + d * 64 : 3072 + d * 64;
    int tok = tid >> 3, c8 = tid & 7;
    h16x8 cv = *(const h16x8*)(zc + (size_t)(row0 + tok) * ZC + coff + c8 * 8);
    float f[8];
#pragma unroll
    for (int j = 0; j < 8; ++j) { f[j] = (float)cv[j]; if (!isA) f[j] = tanh_f(f[j]); }
    uint4 o;
    o.x = pack_bf2(f[0], f[1]); o.y = pack_bf2(f[2], f[3]); o.z = pack_bf2(f[4], f[5]); o.w = pack_bf2(f[6], f[7]);
    *(uint4*)(smem + tok * 144 + c8 * 16) = o;
    __syncthreads();
    const bf16_t* Bt = (const bf16_t*)(wt + (isA ? WT_A2 : WT_W2)) + (size_t)d * 1024 * 64;
    const float* biasw = p.rwkv_w0 + (size_t)(l * 2 + d) * 1024;
    const float* biasa = p.rwkv_a0 + (size_t)(l * 2 + d) * 1024;
    h16* dst = SC + (size_t)(isA ? 4 + d : 6 + d) * ARR;
#pragma unroll 1
    for (int hf = 0; hf < 2; ++hf) small_gemm<64, 4>(p, cx, smem, 144, Bt, (tid >> 6) * 128 + hf * 64, [&](int m, int n, f32x4 v) {
      float4 bbw = *(const float4*)(biasw + n), bba = *(const float4*)(biasa + n);
      float4 bb = isA ? bba : bbw;
      float r0 = sigmoid_f(v[0] + bb.x), r1 = sigmoid_f(v[1] + bb.y), r2 = sigmoid_f(v[2] + bb.z), r3 = sigmoid_f(v[3] + bb.w);
      if (!isA) { r0 = __expf(-DECAY_SCALE * r0); r1 = __expf(-DECAY_SCALE * r1); r2 = __expf(-DECAY_SCALE * r2); r3 = __expf(-DECAY_SCALE * r3); }
      h16x4 o4 = {(h16)r0, (h16)r1, (h16)r2, (h16)r3};
      *(h16x4*)(dst + (size_t)(row0 + m) * 1024 + n) = o4;
    });
  }
  {
    const float* cw = p.conv_rkv + (size_t)l * 3 * 3072;
    const int grp = tid & 7, hh = (tid >> 3) & 3;
    const int c0 = (4 * q + hh) * 64 + grp * 8;
    float cwt[3][3][8];
#pragma unroll
    for (int s = 0; s < 3; ++s)
#pragma unroll
      for (int tp = 0; tp < 3; ++tp)
#pragma unroll
        for (int j = 0; j < 8; j += 4) {
          float4 a = *(const float4*)(cw + tp * 3072 + s * 1024 + c0 + j);
          cwt[s][tp][j] = a.x; cwt[s][tp][j + 1] = a.y; cwt[s][tp][j + 2] = a.z; cwt[s][tp][j + 3] = a.w;
        }
    float kkw[8];
#pragma unroll
    for (int j = 0; j < 8; j += 4) {
      float4 kq = *(const float4*)(p.rwkv_k_k + (size_t)l * 1024 + c0 + j);
      kkw[j] = kq.x; kkw[j + 1] = kq.y; kkw[j + 2] = kq.z; kkw[j + 3] = kq.w;
    }
#pragma unroll 1
    for (int it = 0; it < 4; ++it) {
      const int tok = (tid >> 5) + it * 16;
      const int row = row0 + tok;
      bool hasp, hasn;
      if (row < NLAT) { hasp = (row & 16383) != 0; hasn = (row & 16383) != 16383; }
      else { hasp = (row & 255) != 0; hasn = (row & 255) != 255; }
      const size_t off = (size_t)row * 1024 + c0;
      const h16* zp = zc + (size_t)row * ZC + c0;
      const h16* zpp = hasp ? zp - ZC : zp;
      const h16* zpn = hasn ? zp + ZC : zp;
      h16x8 cur[3], prv[3], nxt[3];
#pragma unroll
      for (int s = 0; s < 3; ++s) { cur[s] = *(const h16x8*)(zp + s * 1024); prv[s] = *(const h16x8*)(zpp + s * 1024); nxt[s] = *(const h16x8*)(zpn + s * 1024); }
      const float fp = hasp ? 1.f : 0.f, fn = hasn ? 1.f : 0.f;
      float kv[8];
#pragma unroll
      for (int s = 0; s < 3; ++s) {
        h16x8 o;
#pragma unroll
        for (int j = 0; j < 8; ++j) {
          float ov = cwt[s][0][j] * (fp * (float)prv[s][j]) + cwt[s][1][j] * (float)cur[s][j] + cwt[s][2][j] * (fn * (float)nxt[s][j]);
          o[j] = (h16)ov;
          if (s == 1) kv[j] = ov;
        }
        *(h16x8*)(SC + (size_t)s * ARR + off) = o;
      }
      float kk[8], ss = 0;
#pragma unroll
      for (int j = 0; j < 8; ++j) { kk[j] = kv[j] * kkw[j]; ss += kk[j] * kk[j]; }
      ss = allreduce8(ss);
      float inv = rcp_f(fmaxf(sqrtf(ss), 1e-12f));
      h16x8 o;
#pragma unroll
      for (int j = 0; j < 8; ++j) o[j] = (h16)(kk[j] * inv);
      *(h16x8*)(SC + 3 * ARR + off) = o;
    }
  }
}

DEV void phase_prep(const Params& p, const Ctx& cx0, int l, char* smem) {
  const int NPREP = 520 * 4, NS5 = 520;
  const Ctx& cx_ = cx0;
  for (int item = cx_.bid; item < NPREP + NS5; item += cx_.nblk) {
    __syncthreads();
    Ctx cx = cx0; asm volatile("" : "+v"(cx.tid));
    const int lane = cx.tid & 63, wid = cx.tid >> 6;
#ifndef NO_PREPITEM
    if (item < NPREP) prep_item(p, cx, l, item, smem);
    else
#endif
#ifndef NO_S5P1
      s5_pass1_unit(p, cx, l, (item - NPREP) * 8 + wid, smem + wid * 8192, lane);
#else
    {}
#endif
  }
}

typedef unsigned u2v __attribute__((ext_vector_type(2)));
struct RG { u2v w, a, kk, k, r; h16 v; };

DEV void rwkv_task(const Params& p, const Ctx& cx, int l, int task, int lane, char* wl) {
  const int unit = task >> 4, d = unit & 1, h = (unit >> 1) & 15, b = unit >> 5;
  const int j = lane >> 4, s = lane & 15;
  const int myrow = (task & 15) * 4 + j;
  const h16* SC = (const h16*)(p.ws + OFF_SCAN);
  const char* pR = (const char*)(SC + 0 * ARR + h * 64);
  const char* pK = (const char*)(SC + 1 * ARR + h * 64);
  const char* pV = (const char*)(SC + 2 * ARR + h * 64);
  const char* pKK = (const char*)(SC + 3 * ARR + h * 64);
  const char* pA = (const char*)(SC + (size_t)(4 + d) * ARR + h * 64);
  const char* pW = (const char*)(SC + (size_t)(6 + d) * ARR + h * 64);
  char* pO = (char*)((h16*)(p.ws + OFF_REG2) + (size_t)d * ARR + h * 64);
  const int jm = d ? 3 - j : j;
  const int sm = d ? 3 - (s & 3) : (s & 3);
  const unsigned vo0 = (unsigned)(jm * 2048 + s * 8);
  const unsigned vov0 = (unsigned)(sm * 2048 + myrow * 2);
  typedef float f4 __attribute__((ext_vector_type(4)));
  f4 ka4, om4;
  {
    float4 t = *(const float4*)(p.rwkv_k_a + (size_t)l * 1024 + h * 64 + 4 * s);
    ka4 = f4{t.x, t.y, t.z, t.w};
    om4 = 1.f - ka4;
  }
  f4 S = {0.f, 0.f, 0.f, 0.f};
  constexpr int NG = 16640 / 4;
  static_assert(NG % 8 == 0, "ring");
  RG q0, q1, q2, q3, q4, q5, q6, q7;
  const unsigned wofs = (unsigned)(j * 256 + s * 16);
  const unsigned vwofs = (unsigned)(5120 + (s & 3) * 8 + j * 2);
  const unsigned rofs = (unsigned)(s * 16);
  const unsigned vrofs = (unsigned)(5120 + j * 2);

#define RW_RLO(gq, rlo)                                                            \
  {                                                                                \
    const int gg = (gq) < NG ? (gq) : NG - 1;                                      \
    const int q0_ = gg * 4;                                                        \
    const int isl = q0_ >= 256;                                                    \
    const int base_ = isl ? b * 16384 : NLAT + b * 256;                            \
    const int t0_ = isl ? q0_ - 256 : q0_;                                         \
    const int last_ = isl ? 16383 : 255;                                           \
    rlo = base_ + (d ? last_ - t0_ - 3 : t0_);                                     \
  }
#define RW_LOAD(q, gq)                                                             \
  {                                                                                \
    int rlo; RW_RLO(gq, rlo);                                                      \
    unsigned vo = vo0, vov = vov0; asm volatile("" : "+v"(vo), "+v"(vov));         \
    const size_t off = (size_t)rlo * 2048;                                         \
    q.w = *(const u2v*)(pW + off + vo); q.a = *(const u2v*)(pA + off + vo);        \
    q.kk = *(const u2v*)(pKK + off + vo); q.k = *(const u2v*)(pK + off + vo);      \
    q.r = *(const u2v*)(pR + off + vo); q.v = *(const h16*)(pV + off + vov);       \
  }
#define CV4(uv) __builtin_convertvector(__builtin_bit_cast(h16x4, uv), f4)
#define RW_STAGE(q, gq)                                                            \
  {     \
    char* sl = wl + ((gq) & 1) * 5248;                                             \
    const f4 a_ = CV4(q.a), kk_ = CV4(q.kk);                                       \
    *(f4*)(sl + 0 * 1024 + wofs) = CV4(q.w);                                       \
    *(f4*)(sl + 1 * 1024 + wofs) = kk_;                                            \
    *(f4*)(sl + 2 * 1024 + wofs) = kk_ * a_;                                       \
    *(f4*)(sl + 3 * 1024 + wofs) = CV4(q.k) * (a_ * ka4 + om4);                    \
    *(f4*)(sl + 4 * 1024 + wofs) = CV4(q.r);                                       \
    *(h16*)(sl + vwofs) = q.v;                                                     \
  }
#define RW_COMPUTE(gq)                                                             \
  {                                                                                \
    const char* sl = wl + ((gq) & 1) * 5248;                                       \
    float dres[4];                                                                 \
    _Pragma("unroll") for (int u = 0; u < 4; ++u) {                                \
      const f4 w_ = *(const f4*)(sl + 0 * 1024 + u * 256 + rofs);                  \
      const f4 kk_ = *(const f4*)(sl + 1 * 1024 + u * 256 + rofs);                 \
      const f4 kka_ = *(const f4*)(sl + 2 * 1024 + u * 256 + rofs);                \
      const f4 kd_ = *(const f4*)(sl + 3 * 1024 + u * 256 + rofs);                 \
      const f4 r_ = *(const f4*)(sl + 4 * 1024 + u * 256 + rofs);                  \
      const float vj = (float)*(const h16*)(sl + u * 8 + vrofs);                   \
      const f4 pd = S * kk_;                                                       \
      const float d1 = allreduce16((pd.x + pd.y) + (pd.z + pd.w));                 \
      S = S * w_ + kd_ * vj;                                                       \
      S = S - kka_ * d1;                                                           \
      const f4 pe = S * r_;                                                        \
      dres[u] = (pe.x + pe.y) + (pe.z + pe.w);     \
    }                                                                              \
    {                                                                              \
      int rlo; RW_RLO(gq, rlo);                                                    \
      const int su = s & 3;                                                        \
      unsigned vov = vov0; asm volatile("" : "+v"(vov));                           \
        \
      const bool p1_ = (s & 1) != 0, p2_ = (s & 2) != 0;                           \
      const float a_ = (p1_ ? dres[1] : dres[0]) + dpp_mov<0xB1>(p1_ ? dres[0] : dres[1]); \
      const float b_ = (p1_ ? dres[3] : dres[2]) + dpp_mov<0xB1>(p1_ ? dres[2] : dres[3]); \
      float val = (p2_ ? b_ : a_) + dpp_mov<0x4E>(p2_ ? a_ : b_);                  \
      val += dpp_mov<0x124>(val);                                                  \
      val += dpp_mov<0x128>(val);                                                  \
      (void)su;                                                                    \
      *(h16*)(pO + (size_t)rlo * 2048 + vov) = (h16)val;                           \
    }                                                                              \
  }
#define SB __builtin_amdgcn_sched_barrier(0)

#define CB asm volatile("" ::: "memory")
  RW_LOAD(q0, 0); RW_LOAD(q1, 1); RW_LOAD(q2, 2); RW_LOAD(q3, 3); RW_LOAD(q4, 4); RW_LOAD(q5, 5); RW_LOAD(q6, 6); RW_LOAD(q7, 7);
  RW_STAGE(q0, 0); CB;
#pragma unroll 1
  for (int g = 0; g < NG; g += 8) {
    RW_STAGE(q1, g + 1); RW_LOAD(q0, g + 8); RW_COMPUTE(g); CB; SB;
    RW_STAGE(q2, g + 2); RW_LOAD(q1, g + 9); RW_COMPUTE(g + 1); CB; SB;
    RW_STAGE(q3, g + 3); RW_LOAD(q2, g + 10); RW_COMPUTE(g + 2); CB; SB;
    RW_STAGE(q4, g + 4); RW_LOAD(q3, g + 11); RW_COMPUTE(g + 3); CB; SB;
    RW_STAGE(q5, g + 5); RW_LOAD(q4, g + 12); RW_COMPUTE(g + 4); CB; SB;
    RW_STAGE(q6, g + 6); RW_LOAD(q5, g + 13); RW_COMPUTE(g + 5); CB; SB;
    RW_STAGE(q7, g + 7); RW_LOAD(q6, g + 14); RW_COMPUTE(g + 6); CB; SB;
    RW_STAGE(q0, g + 8); RW_LOAD(q7, g + 15); RW_COMPUTE(g + 7); CB; SB;
  }
#undef CB
#undef SB
#undef RW_RLO
#undef RW_LOAD
#undef RW_COMPUTE
#undef RW_STAGE
#undef CV4
}

DEV void phase_scan(const Params& p, const Ctx& cx, int l, char* smem) {
  const int lane = cx.tid & 63, wid = __builtin_amdgcn_readfirstlane(cx.tid >> 6);
  char* wl = smem + wid * 17408;
  const int NS5U = 2 * 32 * 65;
  if (wid < 4) {
    for (int slot = cx.bid; slot < 256; slot += cx.nblk) {
      const int task = ((slot & 63) << 4) | ((slot >> 6) << 2) | wid;
#ifndef NO_RWKV
      rwkv_task(p, cx, l, task, lane, wl);
#endif
    }
  } else {
    for (int u = cx.bid * 4 + (wid - 4); u < NS5U; u += cx.nblk * 4) {
      if (l == 1 && (u % 65) == 0) continue;
#ifndef NO_S5P3
      s5_pass3_unit(p, cx, l, u, wl, lane);
#endif
    }
  }
}

DEV void pool_item(const Params& p, const Ctx& cx, int l, int item, char* smem) {
  const int tid = cx.tid;
  const h16* zrest = (const h16*)(p.ws + OFF_ZREST);
  bf16_t* ym = (bf16_t*)(p.ws + OFF_YM);
  const char* wt = p.ws + OFF_WT + (size_t)l * WT_SIZE;
  float* V = (float*)smem;
  char* At = smem + 43008;
  int g, rowout0, Lseq, p0, rlo, rhi, rstride, rowsrc0;
  if (item < 2048) {
    g = item & 3; int r = (item >> 2) & 255, b = item >> 10;
    int w = 2 << g;
    rlo = max(r - w / 2, 0); rhi = min(r + w / 2 - 1, 255);
    rowsrc0 = b * 16384; rstride = 64;
    rowout0 = b * 16384 + r * 64; Lseq = 64; p0 = 0;
  } else {
    int it = item - 2048;
    g = it & 3; int tq = (it >> 2) & 3, b = it >> 4;
    rlo = 0; rhi = 0; rowsrc0 = NLAT + b * 256; rstride = 0;
    rowout0 = NLAT + b * 256 + tq * 64; Lseq = 256; p0 = tq * 64;
  }
  const int w = 2 << g;
  const float invr = 1.f / (float)(rhi - rlo + 1);
  for (int unit = tid; unit < 80 * 16; unit += NTHREADS) {
    int lp = unit >> 4, ch8 = unit & 15;
    int pos = p0 - 8 + lp;
    float acc[8] = {0, 0, 0, 0, 0, 0, 0, 0};
    if (pos >= 0 && pos < Lseq) {
      const h16* bp = zrest + (size_t)(rowsrc0 + pos) * ZR + 1024 + g * 128 + ch8 * 8;
      const int nr = rhi - rlo + 1;
      for (int k0 = 0; k0 < nr; k0 += 4) {
        h16x8 v[4]; float wv[4];
#pragma unroll
        for (int i = 0; i < 4; ++i) {
          const int kk_ = min(k0 + i, nr - 1);
          wv[i] = (k0 + i < nr) ? 1.f : 0.f;
          v[i] = *(const h16x8*)(bp + (size_t)((rlo + kk_) * rstride) * ZR);
        }
#pragma unroll
        for (int i = 0; i < 4; ++i)
#pragma unroll
          for (int j = 0; j < 8; ++j) acc[j] += wv[i] * (float)v[i][j];
      }
    }
    float* vp = V + lp * 132 + ch8 * 8;
#pragma unroll
    for (int j = 0; j < 8; ++j) vp[j] = acc[j] * invr;
  }
  __syncthreads();
  for (int unit = tid; unit < 64 * 16; unit += NTHREADS) {
    int c = unit >> 4, ch8 = unit & 15;
    int pos = p0 + c;
    int lo = max(pos - w / 2, 0), hi = min(pos + w / 2 - 1, Lseq - 1);
    float acc[8] = {0, 0, 0, 0, 0, 0, 0, 0};
    for (int pp = lo; pp <= hi; ++pp) {
      const float* vp = V + (pp - p0 + 8) * 132 + ch8 * 8;
#pragma unroll
      for (int j = 0; j < 8; ++j) acc[j] += vp[j];
    }
    float invc = 1.f / (float)(hi - lo + 1);
    h16x8 uc = *(const h16x8*)(zrest + (size_t)(rowout0 + c) * ZR + 1024 + g * 128 + ch8 * 8);
    uint4 o;
    o.x = pack_bf2(acc[0] * invc - (float)uc[0], acc[1] * invc - (float)uc[1]);
    o.y = pack_bf2(acc[2] * invc - (float)uc[2], acc[3] * invc - (float)uc[3]);
    o.z = pack_bf2(acc[4] * invc - (float)uc[4], acc[5] * invc - (float)uc[5]);
    o.w = pack_bf2(acc[6] * invc - (float)uc[6], acc[7] * invc - (float)uc[7]);
    *(uint4*)(At + c * 272 + ch8 * 16) = o;
  }
  __syncthreads();
  const bf16_t* Bt = (const bf16_t*)(wt + WT_POOL) + (size_t)g * 128 * 128;
  const float* ps = p.pool_scale + (size_t)l * 512 + g * 128;
  small_gemm<128, 1>(p, cx, At, 272, Bt, (tid >> 6) * 16, [&](int m, int n, f32x4 v) {
    int row = rowout0 + m;
    float4 sc = *(const float4*)(ps + n);
    h16x4 gt = *(const h16x4*)(zrest + (size_t)row * ZR + 1536 + g * 128 + n);
    uint2 o;
    o.x = pack_bf2(v[0] * sc.x * silu_f((float)gt[0]), v[1] * sc.y * silu_f((float)gt[1]));
    o.y = pack_bf2(v[2] * sc.z * silu_f((float)gt[2]), v[3] * sc.w * silu_f((float)gt[3]));
    *(uint2*)(ym + (size_t)row * D + 512 + g * 128 + n) = o;
  });
}

DEV void glu_item(const Params& p, const Ctx& cx, int l, int tile, char* smem) {
  const int tid = cx.tid;
  const int row0 = tile * 64;
  const float* S5Y = (const float*)(p.ws + OFF_S5Y);
  const h16* zrest = (const h16*)(p.ws + OFF_ZREST);
  bf16_t* ym = (bf16_t*)(p.ws + OFF_YM);
  const char* wt = p.ws + OFF_WT + (size_t)l * WT_SIZE;
#pragma unroll
  for (int it = 0; it < 8; ++it) {
    int unit = tid + it * NTHREADS;
    int r = unit >> 6, c8 = unit & 63;
    const float* sp = S5Y + (size_t)(row0 + r) * 512 + c8 * 8;
    float4 a = *(const float4*)sp, bq = *(const float4*)(sp + 4);
    uint4 o;
    o.x = pack_bf2(a.x, a.y); o.y = pack_bf2(a.z, a.w); o.z = pack_bf2(bq.x, bq.y); o.w = pack_bf2(bq.z, bq.w);
    *(uint4*)(smem + r * 1040 + c8 * 16) = o;
  }
  __syncthreads();
  const bf16_t* Bt = (const bf16_t*)(wt + WT_GLU);
  const float* bg = p.b_glu + (size_t)l * 512;
  small_gemm<512, 4>(p, cx, smem, 1040, Bt, (tid >> 6) * 64, [&](int m, int n, f32x4 v) {
    int row = row0 + m;
    float4 y = *(const float4*)(S5Y + (size_t)row * 512 + n);
    float4 bb = *(const float4*)(bg + n);
    h16x4 gt = *(const h16x4*)(zrest + (size_t)row * ZR + 512 + n);
    uint2 o;
    o.x = pack_bf2(y.x * sigmoid_f(v[0] + bb.x) * silu_f((float)gt[0]), y.y * sigmoid_f(v[1] + bb.y) * silu_f((float)gt[1]));
    o.y = pack_bf2(y.z * sigmoid_f(v[2] + bb.z) * silu_f((float)gt[2]), y.w * sigmoid_f(v[3] + bb.w) * silu_f((float)gt[3]));
    *(uint2*)(ym + (size_t)row * D + n) = o;
  });
}

DEV void rwkvmerge_item(const Params& p, const Ctx& cx, int l, int tile) {
  const int tid = cx.tid;
  const int row0 = tile * 64;
  const h16* SC = (const h16*)(p.ws + OFF_SCAN);
  const h16* O = (const h16*)(p.ws + OFF_REG2);
  const h16* zrest = (const h16*)(p.ws + OFF_ZREST);
  bf16_t* ym = (bf16_t*)(p.ws + OFF_YM);
  const int grp = tid & 7, h = (tid >> 3) & 15;
  const int c0 = h * 64 + grp * 8;
  float pk[8], rk[8], gw[8], gb[8];
#pragma unroll
  for (int j = 0; j < 8; j += 4) {
    float4 t0 = *(const float4*)(p.rwkv_k_a + (size_t)l * 1024 + c0 + j), t1 = *(const float4*)(p.rwkv_r_k + (size_t)l * 1024 + c0 + j);
    float4 t2 = *(const float4*)(p.gn_w + (size_t)l * 1024 + c0 + j), t3 = *(const float4*)(p.gn_b + (size_t)l * 1024 + c0 + j);
    pk[j] = t0.x; pk[j + 1] = t0.y; pk[j + 2] = t0.z; pk[j + 3] = t0.w;
    rk[j] = t1.x; rk[j + 1] = t1.y; rk[j + 2] = t1.z; rk[j + 3] = t1.w;
    gw[j] = t2.x; gw[j + 1] = t2.y; gw[j + 2] = t2.z; gw[j + 3] = t2.w;
    gb[j] = t3.x; gb[j + 1] = t3.y; gb[j + 2] = t3.z; gb[j + 3] = t3.w;
  }
#pragma unroll 2
  for (int it = 0; it < 16; ++it) {
    const int tok = (tid >> 7) + it * 4;
    int row = row0 + tok;
    size_t off = (size_t)row * 1024 + c0;
    h16x8 of = *(const h16x8*)(O + off), ob = *(const h16x8*)(O + ARR + off);
    h16x8 r8 = *(const h16x8*)(SC + 0 * ARR + off), k8 = *(const h16x8*)(SC + 1 * ARR + off), v8 = *(const h16x8*)(SC + 2 * ARR + off);
    h16x8 af = *(const h16x8*)(SC + 4 * ARR + off), ab = *(const h16x8*)(SC + 5 * ARR + off);
    h16x8 gt = *(const h16x8*)(zrest + (size_t)row * ZR + 2048 + c0);
    float o[8], sm = 0;
#pragma unroll
    for (int j = 0; j < 8; ++j) { o[j] = (float)of[j] + (float)ob[j]; sm += o[j]; }
    sm = allreduce8(sm);
    float mu = sm * (1.f / 64.f), vq = 0;
#pragma unroll
    for (int j = 0; j < 8; ++j) { o[j] -= mu; vq += o[j] * o[j]; }
    vq = allreduce8(vq);
    float rstd = rsqrtf(vq * (1.f / 64.f) + 64e-5f);
    float part = 0;
#pragma unroll
    for (int j = 0; j < 8; ++j) {
      float ksum = (float)k8[j] * (2.f + ((float)af[j] + (float)ab[j] - 2.f) * pk[j]);
      part += (float)r8[j] * ksum * rk[j];
    }
    part = allreduce8(part);
    float res[8];
#pragma unroll
    for (int j = 0; j < 8; ++j) {
      float y = o[j] * rstd * gw[j] + gb[j] + part * (float)v8[j];
      res[j] = y * silu_f((float)gt[j]);
    }
    uint4 ov;
    ov.x = pack_bf2(res[0], res[1]); ov.y = pack_bf2(res[2], res[3]); ov.z = pack_bf2(res[4], res[5]); ov.w = pack_bf2(res[6], res[7]);
    *(uint4*)(ym + (size_t)row * D + 1024 + c0) = ov;
  }
}

DEV void phase_merge(const Params& p, const Ctx& cx0, int l, char* smem) {
  const int ntile = (l == 0) ? 520 : 512;
  const int npool = (l == 0) ? 2048 + 32 : 2048;
  const int total = npool + 2 * ntile;
  for (int item = cx0.bid; item < total; item += cx0.nblk) {
    __syncthreads();
    Ctx cx = cx0; asm volatile("" : "+v"(cx.tid));
    if (item < npool) pool_item(p, cx, l, item, smem);
    else if (item < npool + ntile) glu_item(p, cx, l, item - npool, smem);
    else rwkvmerge_item(p, cx, l, item - npool - ntile);
  }
}

#define LCX Ctx c2 = cx; asm volatile("" : "+v"(c2.tid))
#ifndef GEMM_FN
#define GEMM_FN gemm_phase2
#endif
__global__ void __launch_bounds__(NTHREADS) mega_fwd(Params p, int ph0, int ph1) {
  extern __shared__ __attribute__((aligned(16))) char smem[];
  cg::grid_group grid = cg::this_grid();
  const int wave_s = __builtin_amdgcn_readfirstlane((int)(threadIdx.x >> 6));
  for (int step = ph0; step < ph1; ++step) {
    if (step > ph0) grid.sync();
    const int ph = (int)((PH_SEQ >> (4 * step)) & 15ull);
    Ctx cx;
    {
      int t_, b_ = blockIdx.x, n_ = gridDim.x;
      asm volatile("v_mbcnt_lo_u32_b32 %0, -1, 0\n\tv_mbcnt_hi_u32_b32 %0, -1, %0\n\tv_lshl_add_u32 %0, %1, 6, %0" : "=&v"(t_) : "s"(wave_s));
      asm volatile("" : "+s"(b_), "+s"(n_));
      cx.tid = t_; cx.bid = b_; cx.nblk = n_;
    }
    const int l = ph >= 8 ? 1 : 0;
    const int lp = ph >= 8 ? ph - 6 : ph;
#ifndef PHMASK
#define PHMASK 0xff
#endif
    if (ph == 0) { if (PHMASK & 1) { LCX; phase0(p, c2, smem); } }
    else if (ph == 1) { if (PHMASK & 2) { LCX; phase_adaln0(p, c2); } }
    else if (lp == 2 && (PHMASK & 4)) {
      LCX;
      h16* zrest = (h16*)(p.ws + OFF_ZREST);
      h16* zc = (h16*)(p.ws + OFF_REG2);
      GEMM_FN(p, c2, (const bf16_t*)(p.ws + OFF_H), (const bf16_t*)(p.ws + OFF_WT + (size_t)l * WT_SIZE + WT_IN), 2048, 130, 25, smem,
                 [&](int row, int col, f32x4 v, f32x4 u) {
                   h16* dst;
                   if (col < 2048) dst = zrest + (size_t)row * ZR + col;
                   else if (col < 5120) dst = zc + (size_t)row * ZC + (col - 2048);
                   else if (col < 6144) dst = zrest + (size_t)row * ZR + 2048 + (col - 5120);
                   else dst = zc + (size_t)row * ZC + 3072 + (col - 6144);
                   h16x8 o = {(h16)v[0], (h16)v[1], (h16)v[2], (h16)v[3], (h16)u[0], (h16)u[1], (h16)u[2], (h16)u[3]};
                   *(h16x8*)dst = o;
                 });
    } else if (lp == 3) { if (PHMASK & 8) { LCX; phase_prep(p, c2, l, smem); } }
    else if (lp == 4) { if (PHMASK & 16) { LCX; phase_scan(p, c2, l, smem); } }
    else if (lp == 5) { if (PHMASK & 32) { LCX; phase_merge(p, c2, l, smem); } }
    else if (lp == 6 && (PHMASK & 64)) {
      LCX;
      const float* mods = (const float*)(p.ws + OFF_MODS);
      float* prec = (float*)(p.ws + OFF_PREC);
      const float* xin = (l == 0) ? p.x : p.out;
      GEMM_FN(p, c2, (const bf16_t*)(p.ws + OFF_YM), (const bf16_t*)(p.ws + OFF_WT + (size_t)l * WT_SIZE + WT_OUT), 2048, l == 0 ? 130 : 128, 8, smem,
                 [&](int row, int col, f32x4 v, f32x4 u) {
                   const float* xr; const float* gr; float* dr;
                   if (row < NLAT) {
                     xr = xin + (size_t)row * D + col; gr = mods + (size_t)(l * 3 + (row >> 14)) * 6144 + 4096 + col; dr = p.out + (size_t)row * D + col;
                   } else {
                     xr = p.ctx + (size_t)(row - NLAT) * D + col; gr = mods + (size_t)(l * 3 + 2) * 6144 + 4096 + col; dr = prec + (size_t)(row - NLAT) * D + col;
                   }
                   const float4 x0 = *(const float4*)xr, x1 = *(const float4*)(xr + 4), g0 = *(const float4*)gr, g1 = *(const float4*)(gr + 4);
                   float4 r0, r1;
                   r0.x = ALPHA * x0.x + g0.x * v[0]; r0.y = ALPHA * x0.y + g0.y * v[1]; r0.z = ALPHA * x0.z + g0.z * v[2]; r0.w = ALPHA * x0.w + g0.w * v[3];
                   r1.x = ALPHA * x1.x + g1.x * u[0]; r1.y = ALPHA * x1.y + g1.y * u[1]; r1.z = ALPHA * x1.z + g1.z * u[2]; r1.w = ALPHA * x1.w + g1.w * u[3];
                   *(float4*)dr = r0; *(float4*)(dr + 4) = r1;
                 });
    } else if (lp == 7) { if (PHMASK & 128) { LCX; phase_finln(p, c2, l); } }
  }
}

constexpr int NPHASES = PH_NSTEPS;

extern "C" void kernel_launch(void* const* d_in, const int* in_sizes, int n_in, void* d_out, int out_size, void* d_ws, size_t ws_size,
                              hipStream_t stream) {
  static int grid_blocks = 0;
  if (grid_blocks == 0) {
    if (n_in != 32 || ws_size < WS_END) { fprintf(stderr, "kernel_launch: unexpected n_in %d / ws %zu (need %zu)\n", n_in, ws_size, (size_t)WS_END); grid_blocks = -1; return; }
    int dev = 0, cus = 0, per_cu = 0;
    hipGetDevice(&dev);
    hipDeviceGetAttribute(&cus, hipDeviceAttributeMultiprocessorCount, dev);
    if (hipFuncSetAttribute((const void*)mega_fwd, hipFuncAttributeMaxDynamicSharedMemorySize, LDS_BYTES) != hipSuccess) { fprintf(stderr, "hipFuncSetAttribute failed\n"); grid_blocks = -1; return; }
    if (hipOccupancyMaxActiveBlocksPerMultiprocessor(&per_cu, (const void*)mega_fwd, NTHREADS, LDS_BYTES) != hipSuccess || per_cu < 1) {
      fprintf(stderr, "occupancy query gave %d\n", per_cu); (void)hipGetLastError(); per_cu = 1;
    }
    grid_blocks = cus * per_cu;
  }
  if (grid_blocks < 0) return;
  Params p{};
  const float** pp = (const float**)&p;
  for (int i = 0; i < 32; ++i) pp[i] = (const float*)d_in[i];
  p.out = (float*)d_out;
  p.ws = (char*)d_ws;
  int ph0 = 0, ph1 = NPHASES;
  void* args[] = {&p, &ph0, &ph1};
  hipError_t e = hipLaunchCooperativeKernel((const void*)mega_fwd, dim3(grid_blocks), dim3(NTHREADS), args, LDS_BYTES, stream);
  if (e != hipSuccess) fprintf(stderr, "cooperative launch failed: %s (grid %d)\n", hipGetErrorString(e), grid_blocks);
}
```

```cpp
#include <hip/hip_runtime.h>
#include <hip/hip_cooperative_groups.h>
#include <cstdio>
namespace cg = cooperative_groups;

typedef unsigned short bf16_t;
typedef _Float16 h16;
using bf16x8 = __attribute__((ext_vector_type(8))) _Float16;
using f32x4 = __attribute__((ext_vector_type(4))) float;
using h16x4 = __attribute__((ext_vector_type(4))) _Float16;
using h16x8 = __attribute__((ext_vector_type(8))) _Float16;

#define DEV __device__ __forceinline__

constexpr int D = 2048, NLAT = 32768, MTOT = 33280, ZR = 3072, ZC = 3328;
constexpr int NTHREADS = 512;
constexpr int LDS_BYTES = 147456;
constexpr float ALPHA = 1.41421356237f;
constexpr float DECAY_SCALE = 0.606531f;

constexpr size_t al256(size_t x) { return (x + 255) & ~size_t(255); }
constexpr size_t ARR = (size_t)MTOT * 1024;
constexpr size_t OFF_MODS = 0;
constexpr size_t OFF_S5F = al256(OFF_MODS + 2 * 3 * 6144 * 4);
constexpr size_t OFF_PREC = al256(OFF_S5F + (size_t)2 * 32 * 65 * 2 * 64 * 8);
constexpr size_t OFF_WT = al256(OFF_PREC + (size_t)512 * 2048 * 4);
constexpr size_t WT_IN = 0, WT_OUT = 26214400, WT_W2 = 34603008, WT_A2 = 34865152, WT_POOL = 35127296, WT_GLU = 35258368, WT_SIZE = 35782656;
constexpr size_t OFF_ZREST = al256(OFF_WT + 2 * WT_SIZE);
constexpr size_t OFF_REG2 = al256(OFF_ZREST + (size_t)MTOT * ZR * 2);
constexpr size_t OFF_S5Y = OFF_REG2 + 2 * ARR * 2;
constexpr size_t OFF_SCAN = al256(OFF_REG2 + (size_t)MTOT * ZC * 2);
constexpr size_t OFF_H = OFF_SCAN;
constexpr size_t OFF_YM = OFF_SCAN + 6 * ARR * 2;
constexpr size_t WS_END = OFF_SCAN + 8 * ARR * 2;

#ifndef PH_SEQ
#define PH_SEQ 0xDCBA9876543210ull
#define PH_NSTEPS 14
#endif
struct Params {
  const float *x, *c, *ctx, *c_ctx, *w_ada, *b_ada, *w_in, *conv_rkv, *s5_lam_re, *s5_lam_im, *s5_log_step,
      *s5_b_re, *s5_b_im, *s5_c_re, *s5_c_im, *s5_d, *w_glu, *b_glu, *w_pool, *pool_scale,
      *rwkv_w0, *rwkv_w2, *rwkv_a0, *rwkv_a2, *rwkv_k_k, *rwkv_k_a, *rwkv_r_k, *gn_w, *gn_b,
      *w_out, *ln_g, *ln_b;
  float* out;
  char* ws;
};
struct Ctx { int tid, bid, nblk; };

DEV float rcp_f(float x) { return __builtin_amdgcn_rcpf(x); }
DEV float sigmoid_f(float x) { return rcp_f(1.f + __expf(-x)); }
DEV float silu_f(float x) { return x * rcp_f(1.f + __expf(-x)); }
DEV float tanh_f(float x) { float e = __expf(2.f * x); return 1.f - 2.f * rcp_f(e + 1.f); }
DEV float gelu_f(float y) { return 0.5f * y * (1.f + tanh_f(0.7978845608f * (y + 0.044715f * y * y * y))); }
using h16x2 = __attribute__((ext_vector_type(2))) _Float16;
DEV unsigned pack_bf2(float a, float b) { h16x2 v = {(h16)a, (h16)b}; return __builtin_bit_cast(unsigned, v); }
template <int CTRL> DEV float dpp_mov(float v) {
  return __int_as_float(__builtin_amdgcn_update_dpp(0, __float_as_int(v), CTRL, 0xf, 0xf, true));
}
DEV float allreduce16(float v) {
  v += dpp_mov<0xB1>(v);
  v += dpp_mov<0x4E>(v);
  v += dpp_mov<0x141>(v);
  v += dpp_mov<0x140>(v);
  return v;
}
DEV float wave_sum(float v) {
  v = allreduce16(v);
  return __builtin_amdgcn_readlane(__float_as_int(v), 0) == 0 && false ? 0.f :
         __int_as_float(__builtin_amdgcn_readlane(__float_as_int(v), 0)) + __int_as_float(__builtin_amdgcn_readlane(__float_as_int(v), 16)) +
         __int_as_float(__builtin_amdgcn_readlane(__float_as_int(v), 32)) + __int_as_float(__builtin_amdgcn_readlane(__float_as_int(v), 48));
}
DEV float allreduce8(float v) {
  v += dpp_mov<0xB1>(v);
  v += dpp_mov<0x4E>(v);
  v += dpp_mov<0x141>(v);
  return v;
}
DEV void lds_fence() { asm volatile("s_waitcnt lgkmcnt(0)" ::: "memory"); }

DEV void p0_mods_item(const Params& p, const Ctx& cx, int item, char* smem) {
  float* red = (float*)smem;
  float* mods = (float*)(p.ws + OFF_MODS);
  int l = item / 96, chunk = item % 96;
  int tid = cx.tid, kq = tid >> 6, col = tid & 63;
  int n = chunk * 64 + col;
  const float* W = p.w_ada + (size_t)l * 2048 * 6144;
  float a0 = 0, a1 = 0, a2 = 0;
#pragma unroll 8
  for (int k = kq; k < 2048; k += 8) {
    float w = W[(size_t)k * 6144 + n];
    a0 += silu_f(p.c[k]) * w;
    a1 += silu_f(p.c[2048 + k]) * w;
    a2 += silu_f(p.c_ctx[k]) * w;
  }
  red[(kq * 3 + 0) * 64 + col] = a0;
  red[(kq * 3 + 1) * 64 + col] = a1;
  red[(kq * 3 + 2) * 64 + col] = a2;
  __syncthreads();
  if (tid < 192) {
    int r = tid >> 6, cc = tid & 63;
    float s = 0;
#pragma unroll
    for (int q = 0; q < 8; ++q) s += red[(q * 3 + r) * 64 + cc];
    mods[(size_t)(l * 3 + r) * 6144 + chunk * 64 + cc] = s + p.b_ada[(size_t)l * 6144 + chunk * 64 + cc];
  }
}

DEV void p0_transpose_tile(const Params& p, const Ctx& cx, const float* __restrict__ src, bf16_t* __restrict__ dst, int K, int N, int tk, int tn, char* smem) {
  float* T = (float*)smem;
  int tid = cx.tid;
  int k0 = tk * 64, n0 = tn * 64;
  int kk = tid >> 4, n4 = tid & 15;
#pragma unroll
  for (int i = 0; i < 2; ++i) {
    int k = kk + 32 * i;
    float4 v = *(const float4*)(src + (size_t)(k0 + k) * N + n0 + n4 * 4);
    T[k * 65 + n4 * 4 + 0] = v.x; T[k * 65 + n4 * 4 + 1] = v.y; T[k * 65 + n4 * 4 + 2] = v.z; T[k * 65 + n4 * 4 + 3] = v.w;
  }
  __syncthreads();
  int n = tid >> 3, k8 = tid & 7;
  uint4 o;
  o.x = pack_bf2(T[(k8 * 8 + 0) * 65 + n], T[(k8 * 8 + 1) * 65 + n]);
  o.y = pack_bf2(T[(k8 * 8 + 2) * 65 + n], T[(k8 * 8 + 3) * 65 + n]);
  o.z = pack_bf2(T[(k8 * 8 + 4) * 65 + n], T[(k8 * 8 + 5) * 65 + n]);
  o.w = pack_bf2(T[(k8 * 8 + 6) * 65 + n], T[(k8 * 8 + 7) * 65 + n]);
  *(uint4*)(dst + (size_t)(n0 + n) * K + k0 + k8 * 8) = o;
}

DEV void phase0(const Params& p, const Ctx& cx0, char* smem) {
  const int NTR = 4368;
  const int total = 192 + 2 * NTR;
  for (int item = cx0.bid; item < total; item += cx0.nblk) {
    __syncthreads();
    Ctx cx = cx0; asm volatile("" : "+v"(cx.tid));
    if (item < 192) { p0_mods_item(p, cx, item, smem); continue; }
    int it = item - 192;
    int l = it / NTR, i = it % NTR;
    char* wt = p.ws + OFF_WT + (size_t)l * WT_SIZE;
    if (i < 3200) {
      p0_transpose_tile(p, cx, p.w_in + (size_t)l * 2048 * 6400, (bf16_t*)(wt + WT_IN), 2048, 6400, i / 100, i % 100, smem);
    } else if (i < 4224) {
      int j = i - 3200;
      p0_transpose_tile(p, cx, p.w_out + (size_t)l * 2048 * 2048, (bf16_t*)(wt + WT_OUT), 2048, 2048, j / 32, j % 32, smem);
    } else if (i < 4256) {
      int j = i - 4224, d = j / 16;
      p0_transpose_tile(p, cx, p.rwkv_w2 + (size_t)(l * 2 + d) * 64 * 1024, (bf16_t*)(wt + WT_W2) + (size_t)d * 1024 * 64, 64, 1024, 0, j % 16, smem);
    } else if (i < 4288) {
      int j = i - 4256, d = j / 16;
      p0_transpose_tile(p, cx, p.rwkv_a2 + (size_t)(l * 2 + d) * 64 * 1024, (bf16_t*)(wt + WT_A2) + (size_t)d * 1024 * 64, 64, 1024, 0, j % 16, smem);
    } else if (i < 4304) {
      int j = i - 4288, g = j / 4;
      p0_transpose_tile(p, cx, p.w_pool + (size_t)(l * 4 + g) * 128 * 128, (bf16_t*)(wt + WT_POOL) + (size_t)g * 128 * 128, 128, 128, (j % 4) / 2, j % 2, smem);
    } else {
      int j = i - 4304;
      p0_transpose_tile(p, cx, p.w_glu + (size_t)l * 512 * 512, (bf16_t*)(wt + WT_GLU), 512, 512, j / 8, j % 8, smem);
    }
  }
}

DEV void phase_adaln0(const Params& p, const Ctx& cx) {
  const float* mods = (const float*)(p.ws + OFF_MODS);
  bf16_t* hbuf = (bf16_t*)(p.ws + OFF_H);
  int lane = cx.tid & 63;
  int gw = cx.bid * 8 + (cx.tid >> 6), nw = cx.nblk * 8;
  for (int row = gw; row < MTOT; row += nw) {
    const float* src = row < NLAT ? p.x + (size_t)row * D : p.ctx + (size_t)(row - NLAT) * D;
    int mr = row < NLAT ? (row >> 14) : 2;
    const float* md = mods + (size_t)mr * 6144;
    float4 v[8];
    float s = 0;
#pragma unroll
    for (int i = 0; i < 8; ++i) { v[i] = *(const float4*)(src + i * 256 + lane * 4); s += v[i].x + v[i].y + v[i].z + v[i].w; }
    float mu = wave_sum(s) * (1.f / 2048.f);
    float q = 0;
#pragma unroll
    for (int i = 0; i < 8; ++i) { v[i].x -= mu; v[i].y -= mu; v[i].z -= mu; v[i].w -= mu; q += v[i].x * v[i].x + v[i].y * v[i].y + v[i].z * v[i].z + v[i].w * v[i].w; }
    float rstd = rsqrtf(wave_sum(q) * (1.f / 2048.f) + 1e-6f);
#pragma unroll
    for (int i = 0; i < 8; ++i) {
      int col = i * 256 + lane * 4;
      float4 sh = *(const float4*)(md + col), sc = *(const float4*)(md + 2048 + col);
      uint2 o;
      o.x = pack_bf2(v[i].x * rstd * (1.f + sc.x) + sh.x, v[i].y * rstd * (1.f + sc.y) + sh.y);
      o.y = pack_bf2(v[i].z * rstd * (1.f + sc.z) + sh.z, v[i].w * rstd * (1.f + sc.w) + sh.w);
      *(uint2*)(hbuf + (size_t)row * D + col) = o;
    }
  }
}

DEV void phase_finln(const Params& p, const Ctx& cx, int l) {
  const float* mods = (const float*)(p.ws + OFF_MODS);
  bf16_t* hbuf = (bf16_t*)(p.ws + OFF_H);
  float* prec = (float*)(p.ws + OFF_PREC);
  int lane = cx.tid & 63;
  int gw = cx.bid * 8 + (cx.tid >> 6), nw = cx.nblk * 8;
  const int nrows = (l == 0) ? MTOT : NLAT;
  for (int row = gw; row < nrows; row += nw) {
    float* src = row < NLAT ? p.out + (size_t)row * D : prec + (size_t)(row - NLAT) * D;
    float4 v[8];
    float s = 0;
#pragma unroll
    for (int i = 0; i < 8; ++i) { v[i] = *(const float4*)(src + i * 256 + lane * 4); s += v[i].x + v[i].y + v[i].z + v[i].w; }
    float mu = wave_sum(s) * (1.f / 2048.f);
    float q = 0;
#pragma unroll
    for (int i = 0; i < 8; ++i) { v[i].x -= mu; v[i].y -= mu; v[i].z -= mu; v[i].w -= mu; q += v[i].x * v[i].x + v[i].y * v[i].y + v[i].z * v[i].z + v[i].w * v[i].w; }
    float rstd = rsqrtf(wave_sum(q) * (1.f / 2048.f) + 1e-5f);
    float s2 = 0;
#pragma unroll
    for (int i = 0; i < 8; ++i) {
      int col = i * 256 + lane * 4;
      float4 g = *(const float4*)(p.ln_g + (size_t)l * D + col), b = *(const float4*)(p.ln_b + (size_t)l * D + col);
      v[i].x = v[i].x * rstd * g.x + b.x; v[i].y = v[i].y * rstd * g.y + b.y; v[i].z = v[i].z * rstd * g.z + b.z; v[i].w = v[i].w * rstd * g.w + b.w;
      if (row < NLAT) *(float4*)(src + col) = v[i];
      s2 += v[i].x + v[i].y + v[i].z + v[i].w;
    }
    if (l == 0) {
      int mr = row < NLAT ? (row >> 14) : 2;
      const float* md = mods + (size_t)(3 + mr) * 6144;
      float mu2 = wave_sum(s2) * (1.f / 2048.f);
      float q2 = 0;
#pragma unroll
      for (int i = 0; i < 8; ++i) { v[i].x -= mu2; v[i].y -= mu2; v[i].z -= mu2; v[i].w -= mu2; q2 += v[i].x * v[i].x + v[i].y * v[i].y + v[i].z * v[i].z + v[i].w * v[i].w; }
      float rstd2 = rsqrtf(wave_sum(q2) * (1.f / 2048.f) + 1e-6f);
#pragma unroll
      for (int i = 0; i < 8; ++i) {
        int col = i * 256 + lane * 4;
        float4 sh = *(const float4*)(md + col), sc = *(const float4*)(md + 2048 + col);
        uint2 o;
        o.x = pack_bf2(v[i].x * rstd2 * (1.f + sc.x) + sh.x, v[i].y * rstd2 * (1.f + sc.y) + sh.y);
        o.y = pack_bf2(v[i].z * rstd2 * (1.f + sc.z) + sh.z, v[i].w * rstd2 * (1.f + sc.w) + sh.w);
        *(uint2*)(hbuf + (size_t)row * D + col) = o;
      }
    }
  }
}

template <class Epi>
DEV void gemm_phase(const Params& p, const Ctx& cx, const bf16_t* __restrict__ A, const bf16_t* __restrict__ Bt, int K, int nM, int nN, char* smem, Epi epi) {
  const int tid = cx.tid, lane = tid & 63, wid = tid >> 6;
  const int wr = wid >> 2, wc = wid & 3, fr = lane & 15, fq = lane >> 4;
  const int nt = K / 64;
  const int ntiles = nM * nN;
  const int srow = tid >> 3, sc16 = tid & 7;
  const int nxcd = (cx.nblk & 7) == 0 ? 8 : 1;
  const int xcd = cx.bid % nxcd, xidx = cx.bid / nxcd, xper = cx.nblk / nxcd;
  const int t_lo = (int)(((long)ntiles * xcd) / nxcd), t_hi = (int)(((long)ntiles * (xcd + 1)) / nxcd);
  for (int tt = t_lo + xidx; tt < t_hi; tt += xper) {
    const int band = tt / (16 * nN);
    const int brows = min(16, nM - band * 16);
    const int rem = tt - band * 16 * nN;
    const int pn = rem / brows, pm = band * 16 + rem % brows;
    const int brow = pm * 256, bcol = pn * 256;
    const char* Ab = (const char*)(A + (size_t)brow * K);
    const char* Bb = (const char*)(Bt + (size_t)bcol * K);
    const unsigned voff = (unsigned)(srow * K + sc16 * 8) * 2u;
    const size_t rs = (size_t)64 * K * 2;
    f32x4 acc[8][4];
#pragma unroll
    for (int i = 0; i < 8; ++i)
#pragma unroll
      for (int j = 0; j < 4; ++j) acc[i][j] = f32x4{0.f, 0.f, 0.f, 0.f};
    uint4 ra0, ra1, ra2, ra3, rb0, rb1, rb2, rb3;
#define G_LD(ko) { const char* a_ = Ab + (size_t)(ko) * 2; const char* b_ = Bb + (size_t)(ko) * 2; \
                 ra0 = *(const uint4*)(a_ + voff); ra1 = *(const uint4*)(a_ + rs + voff); ra2 = *(const uint4*)(a_ + 2 * rs + voff); ra3 = *(const uint4*)(a_ + 3 * rs + voff); \
                 rb0 = *(const uint4*)(b_ + voff); rb1 = *(const uint4*)(b_ + rs + voff); rb2 = *(const uint4*)(b_ + 2 * rs + voff); rb3 = *(const uint4*)(b_ + 3 * rs + voff); }
#define G_ST(sp) { *(uint4*)(sp) = ra0; *(uint4*)((sp) + 64 * 144) = ra1; *(uint4*)((sp) + 128 * 144) = ra2; *(uint4*)((sp) + 192 * 144) = ra3; \
                 *(uint4*)((sp) + 36864) = rb0; *(uint4*)((sp) + 36864 + 64 * 144) = rb1; *(uint4*)((sp) + 36864 + 128 * 144) = rb2; *(uint4*)((sp) + 36864 + 192 * 144) = rb3; }
    char* const sbase = smem + srow * 144 + sc16 * 16;
    G_LD(0);
    G_ST(sbase);
    if (nt > 1) G_LD(64);
    for (int kt = 0; kt < nt; ++kt) {
      __syncthreads();
      if (kt + 1 < nt) { char* s1 = sbase + ((kt + 1) & 1) * 73728; G_ST(s1); }
      if (kt + 2 < nt) G_LD((kt + 2) * 64);
      const char* As = smem + (kt & 1) * 73728;
      const char* Bs = As + 36864;
#pragma unroll
      for (int kh = 0; kh < 2; ++kh) {
        bf16x8 bfr[4];
#pragma unroll
        for (int jn = 0; jn < 4; ++jn) bfr[jn] = *(const bf16x8*)(Bs + (wc * 64 + jn * 16 + fr) * 144 + kh * 64 + fq * 16);
#pragma unroll
        for (int i = 0; i < 8; ++i) {
          bf16x8 af = *(const bf16x8*)(As + (wr * 128 + i * 16 + fr) * 144 + kh * 64 + fq * 16);
#pragma unroll
          for (int jn = 0; jn < 4; ++jn) acc[i][jn] = __builtin_amdgcn_mfma_f32_16x16x32_f16(bfr[jn], af, acc[i][jn], 0, 0, 0);
        }
      }
    }
    __syncthreads();
#pragma unroll
    for (int i = 0; i < 8; ++i)
#pragma unroll
      for (int jn = 0; jn < 4; ++jn) epi(brow + wr * 128 + i * 16 + fr, bcol + wc * 64 + jn * 16 + fq * 4, acc[i][jn]);
  }
}

#define LAS3 __attribute__((address_space(3)))
DEV int g2_lds_byte(int r, int c) { const int st = (r >> 4) * 2 + (c >> 5), rr = r & 15, cc = c & 31, ob = rr * 64 + cc * 2; return st * 1024 + (ob ^ (((ob >> 9) & 1) << 5)); }
DEV void g2_stage_rc(int b, int& R, int& C) { const int st = b / 1024, sb = b % 1024, swz = sb ^ (((sb >> 9) & 1) << 5); R = (st >> 1) * 16 + swz / 64; C = (st & 1) * 32 + (swz % 64) / 2; }

template <class Epi>
DEV void gemm_phase2(const Params& p, const Ctx& cx, const bf16_t* __restrict__ A, const bf16_t* __restrict__ Bt, int K, int nM, int nN, char* smem, Epi epi) {
  constexpr int HTB = 128 * 64 * 2;
  LAS3 unsigned char* lds = (LAS3 unsigned char*)smem;
  const int tid = cx.tid, wid = __builtin_amdgcn_readfirstlane(tid >> 6), lane = tid & 63, wr = wid >> 2, wc = wid & 3, fr = lane & 15, fq = lane >> 4;
  const int nt = K / 64;
  const int ntiles = nM * nN;
  const int nxcd = (cx.nblk & 7) == 0 ? 8 : 1;
  const int xcd = cx.bid % nxcd, xidx = cx.bid / nxcd, xper = cx.nblk / nxcd;
  const int t_lo = (int)(((long)ntiles * xcd) / nxcd), t_hi = (int)(((long)ntiles * (xcd + 1)) / nxcd);
  auto unit_at = [&](int i, int& pm, int& pn) -> bool {
    const int tt = t_lo + xidx + i * xper;
    if (tt >= t_hi) return false;
    const int band = tt / (16 * nN);
    const int brows = min(16, nM - band * 16);
    const int rem = tt - band * 16 * nN;
    pn = rem / brows; pm = band * 16 + rem % brows;
    return true;
  };
  unsigned voffA[2], voffB[2];
#pragma unroll
  for (int i = 0; i < 2; ++i) {
    int R, C; g2_stage_rc(tid * 16 + i * 8192, R, C);
    const int rho = R & 31, Rb = (R & ~31) + 8 * ((rho & 15) >> 2) + 4 * (rho >> 4) + (rho & 3);
    voffA[i] = (unsigned)(R * K + C) * 2u; voffB[i] = (unsigned)(Rb * K + C) * 2u;
  }
  const size_t kstep = (size_t)(64 * 2);
  const size_t hstep = (size_t)128 * K * 2;
  const size_t tstep = 2 * hstep;
  const unsigned ldsw = (unsigned)wid * 1024u;
  const int aoff = g2_lds_byte(wr * 64 + fr, fq * 8), boff = g2_lds_byte(wc * 32 + fr, fq * 8);
#define G2_SA(b, h) (((b) * 2 + (h)) * HTB)
#define G2_SB(b, h) ((4 + (b) * 2 + (h)) * HTB)
#define G2_STAGE_(bufoff, gbase, vo_) do { _Pragma("unroll") for (int _i = 0; _i < 2; ++_i) \
    __builtin_amdgcn_global_load_lds((const unsigned*)((const char*)(gbase) + vo_[_i]), (LAS3 unsigned*)(lds + (bufoff) + ldsw + _i * 8192), 16, 0, 0); } while (0)
#define G2_STAGE(bufoff, gbase) G2_STAGE_(bufoff, gbase, voffA)
#define G2_STAGEB(bufoff, gbase) G2_STAGE_(bufoff, gbase, voffB)
#define G2_LDA(dst, b, h) do { _Pragma("unroll") for (int m = 0; m < 4; ++m) _Pragma("unroll") for (int k = 0; k < 2; ++k) dst[m][k] = *(const LAS3 bf16x8*)(lds + G2_SA(b, h) + aoff + m * 2048 + k * 1024); } while (0)
#define G2_LDB(dst, b, h) do { _Pragma("unroll") for (int n = 0; n < 2; ++n) _Pragma("unroll") for (int k = 0; k < 2; ++k) dst[n][k] = *(const LAS3 bf16x8*)(lds + G2_SB(b, h) + boff + n * 2048 + k * 1024); } while (0)
#define G2_MMA(ai, bj, At_, Bt_) do { __builtin_amdgcn_s_setprio(1); _Pragma("unroll") for (int m = 0; m < 4; ++m) _Pragma("unroll") for (int n = 0; n < 2; ++n) _Pragma("unroll") for (int k = 0; k < 2; ++k) \
    acc[ai][bj][m][n] = __builtin_amdgcn_mfma_f32_16x16x32_f16(Bt_[n][k], At_[m][k], acc[ai][bj][m][n], 0, 0, 0); __builtin_amdgcn_s_setprio(0); } while (0)
#define G2_WAIT_V(n) asm volatile("s_waitcnt vmcnt(" #n ")" ::: "memory")
#define G2_WAIT_L(n) asm volatile("s_waitcnt lgkmcnt(" #n ")" ::: "memory")
#define G2_BAR __builtin_amdgcn_s_barrier()
#define G2_SCHED __builtin_amdgcn_sched_barrier(0)
  int cpm, cpn, npm = 0, npn = 0, ui = 0;
  if (!unit_at(0, cpm, cpn)) return;
  f32x4 acc[2][2][4][2];
#pragma unroll
  for (int a = 0; a < 2; ++a)
#pragma unroll
    for (int b = 0; b < 2; ++b)
#pragma unroll
      for (int m = 0; m < 4; ++m)
#pragma unroll
        for (int n = 0; n < 2; ++n) acc[a][b][m][n] = f32x4{0.f, 0.f, 0.f, 0.f};
  bf16x8 At[4][2], B0[2][2], B1[2][2];
  const char* cA = (const char*)A + (size_t)cpm * tstep;
  const char* cB = (const char*)Bt + (size_t)cpn * tstep;
  G2_STAGEB(G2_SB(0, 0), cB); G2_STAGE(G2_SA(0, 0), cA); G2_STAGEB(G2_SB(0, 1), cB + hstep); G2_STAGE(G2_SA(0, 1), cA + hstep);
  if (wr == 1) G2_BAR;
  G2_WAIT_V(4); G2_BAR;
  G2_STAGEB(G2_SB(1, 0), cB + kstep); G2_STAGE(G2_SA(1, 0), cA + kstep); G2_STAGEB(G2_SB(1, 1), cB + hstep + kstep);
  G2_WAIT_V(6); G2_BAR;
  for (;;) {
    const bool has_next = unit_at(ui + 1, npm, npn);
    const char* nA = has_next ? (const char*)A + (size_t)npm * tstep : cA;
    const char* nB = has_next ? (const char*)Bt + (size_t)npn * tstep : cB;
    for (int t = 0; t < nt; t += 2) {
      const bool last = (t == nt - 2);
      const char* a1 = cA + (size_t)(t + 1) * kstep;
      const char* a2 = last ? nA : cA + (size_t)(t + 2) * kstep;
      const char* b2 = last ? nB : cB + (size_t)(t + 2) * kstep;
      const char* a3 = a2 + kstep;
      const char* b3 = b2 + kstep;
      G2_LDB(B0, 0, 0); G2_SCHED; G2_LDA(At, 0, 0); G2_STAGE(G2_SA(1, 1), a1 + hstep);
      G2_WAIT_L(8); G2_BAR; G2_WAIT_L(0); G2_MMA(0, 0, At, B0); G2_BAR; G2_SCHED;
      G2_LDB(B1, 0, 1); G2_STAGEB(G2_SB(0, 0), b2);
      G2_BAR; G2_WAIT_L(0); G2_MMA(0, 1, At, B1); G2_BAR;
      G2_LDA(At, 0, 1); G2_STAGE(G2_SA(0, 0), a2);
      G2_BAR; G2_WAIT_L(0); G2_MMA(1, 0, At, B0); G2_BAR; G2_SCHED;
      G2_STAGEB(G2_SB(0, 1), b2 + hstep);
      G2_WAIT_V(6); G2_BAR; G2_MMA(1, 1, At, B1); G2_BAR;
      G2_LDB(B0, 1, 0); G2_SCHED; G2_LDA(At, 1, 0); G2_STAGE(G2_SA(0, 1), a2 + hstep);
      G2_WAIT_L(8); G2_BAR; G2_WAIT_L(0); G2_MMA(0, 0, At, B0); G2_BAR; G2_SCHED;
      G2_LDB(B1, 1, 1); G2_STAGEB(G2_SB(1, 0), b3);
      G2_BAR; G2_WAIT_L(0); G2_MMA(0, 1, At, B1); G2_BAR;
      G2_LDA(At, 1, 1); G2_STAGE(G2_SA(1, 0), a3);
      G2_BAR; G2_WAIT_L(0); G2_MMA(1, 0, At, B0); G2_BAR; G2_SCHED;
      G2_STAGEB(G2_SB(1, 1), b3 + hstep);
      G2_WAIT_V(6); G2_BAR; G2_MMA(1, 1, At, B1); G2_BAR;
    }
    {
      const int row0 = cpm * 256 + wr * 64 + fr, col0 = cpn * 256 + wc * 32 + 8 * fq;
#pragma unroll
      for (int ai = 0; ai < 2; ++ai)
#pragma unroll
        for (int m = 0; m < 4; ++m)
#pragma unroll
          for (int bj = 0; bj < 2; ++bj) epi(row0 + ai * 128 + m * 16, col0 + bj * 128, acc[ai][bj][m][0], acc[ai][bj][m][1]);
    }
    if (!has_next) break;
#pragma unroll
    for (int a = 0; a < 2; ++a)
#pragma unroll
      for (int b = 0; b < 2; ++b)
#pragma unroll
        for (int m = 0; m < 4; ++m)
#pragma unroll
          for (int n = 0; n < 2; ++n) acc[a][b][m][n] = f32x4{0.f, 0.f, 0.f, 0.f};
    cpm = npm; cpn = npn; cA = nA; cB = nB; ++ui;
  }
  G2_WAIT_V(0);
  if (wr == 0) G2_BAR;
  G2_BAR;
#undef G2_SA
#undef G2_SB
#undef G2_STAGE
#undef G2_STAGEB
#undef G2_STAGE_
#undef G2_LDA
#undef G2_LDB
#undef G2_MMA
#undef G2_WAIT_V
#undef G2_WAIT_L
#undef G2_BAR
#undef G2_SCHED
}

template <int K, int NT, class Epi>
DEV void small_gemm(const Params& p, const Ctx& cx, const char* As, int astride, const bf16_t* __restrict__ Bt, int n0, Epi epi) {
  const int lane = cx.tid & 63, fr = lane & 15, fq = lane >> 4;
  f32x4 acc[4][NT];
#pragma unroll
  for (int i = 0; i < 4; ++i)
#pragma unroll
    for (int j = 0; j < NT; ++j) acc[i][j] = f32x4{0.f, 0.f, 0.f, 0.f};
#pragma unroll 2
  for (int k0 = 0; k0 < K; k0 += 32) {
    bf16x8 af[4];
#pragma unroll
    for (int i = 0; i < 4; ++i) af[i] = *(const bf16x8*)(As + (i * 16 + fr) * astride + (k0 + fq * 8) * 2);
#pragma unroll
    for (int jn = 0; jn < NT; ++jn) {
      bf16x8 bf = *(const bf16x8*)(Bt + (size_t)(n0 + jn * 16 + fr) * K + k0 + fq * 8);
#pragma unroll
      for (int i = 0; i < 4; ++i) acc[i][jn] = __builtin_amdgcn_mfma_f32_16x16x32_f16(bf, af[i], acc[i][jn], 0, 0, 0);
    }
  }
#pragma unroll
  for (int i = 0; i < 4; ++i)
#pragma unroll
    for (int jn = 0; jn < NT; ++jn) epi(i * 16 + fr, n0 + jn * 16 + fq * 4, acc[i][jn]);
}

struct S5P { float ar, ai, br, bi; };
DEV S5P s5_params(const Params& p, const Ctx& cx, int l, int d, int g, int lane) {
  int idx = ((l * 2 + d) * 32 + g) * 64 + lane;
  float lr = fminf(p.s5_lam_re[idx], -1e-4f), li = p.s5_lam_im[idx];
  float step = expf(p.s5_log_step[(l * 2 + d) * 32 + g]);
  float xr = lr * step, xi = li * step;
  float e = expf(xr), cs = cosf(xi), sn = sinf(xi);
  S5P r;
  r.ar = e * cs; r.ai = e * sn;
  float sh = sinf(0.5f * xi);
  float nr = expm1f(xr) * cs - 2.f * sh * sh, ni = e * sn;
  float inv = 1.f / (lr * lr + li * li);
  r.br = (nr * lr + ni * li) * inv;
  r.bi = (ni * lr - nr * li) * inv;
  return r;
}

DEV void s5_load_u(const h16* zrest, int rowbase, int g, char* ulds, int lane) {
#pragma unroll
  for (int i = 0; i < 8; ++i) {
    int e = i * 64 + lane;
    int r = e >> 1, hf = e & 1;
    uint4 v = *(const uint4*)(zrest + (size_t)(rowbase + r) * ZR + g * 16 + hf * 8);
    *(uint4*)(ulds + r * 32 + hf * 16) = v;
  }
  lds_fence();
}

DEV int s5_rowbase(int b, int c) { return c == 0 ? NLAT + b * 256 : b * 16384 + (c - 1) * 256; }

DEV void s5_pass1_unit(const Params& p, const Ctx& cx, int l, int unit, char* wl, int lane) {
  int c = unit % 65, bg = unit / 65, g = bg & 31, b = bg >> 5;
  const h16* zrest = (const h16*)(p.ws + OFF_ZREST);
  float2* F = (float2*)(p.ws + OFF_S5F);
  s5_load_u(zrest, s5_rowbase(b, c), g, wl, lane);
  float Br[16], Bi[16];
  {
    const float* pr = p.s5_b_re + ((size_t)(l * 32 + g) * 64 + lane) * 16;
    const float* pi = p.s5_b_im + ((size_t)(l * 32 + g) * 64 + lane) * 16;
#pragma unroll
    for (int i = 0; i < 16; i += 4) {
      float4 a = *(const float4*)(pr + i), bq = *(const float4*)(pi + i);
      Br[i] = a.x; Br[i + 1] = a.y; Br[i + 2] = a.z; Br[i + 3] = a.w;
      Bi[i] = bq.x; Bi[i + 1] = bq.y; Bi[i + 2] = bq.z; Bi[i + 3] = bq.w;
    }
  }
  S5P pf = s5_params(p, cx, l, 0, g, lane), pb = s5_params(p, cx, l, 1, g, lane);
  float xr = 0, xi = 0, yr = 0, yi = 0, pwr = 1.f, pwi = 0.f;
#pragma unroll 4
  for (int t = 0; t < 256; ++t) {
    h16x8 u0 = *(const h16x8*)(wl + t * 32), u1 = *(const h16x8*)(wl + t * 32 + 16);
    float br = 0, bi = 0;
#pragma unroll
    for (int i = 0; i < 8; ++i) { float u = (float)u0[i]; br = fmaf(u, Br[i], br); bi = fmaf(u, Bi[i], bi); }
#pragma unroll
    for (int i = 0; i < 8; ++i) { float u = (float)u1[i]; br = fmaf(u, Br[8 + i], br); bi = fmaf(u, Bi[8 + i], bi); }
    float vr = pf.br * br - pf.bi * bi, vi = pf.br * bi + pf.bi * br;
    float nxr = pf.ar * xr - pf.ai * xi + vr, nxi = pf.ar * xi + pf.ai * xr + vi;
    xr = nxr; xi = nxi;
    float wr_ = pb.br * br - pb.bi * bi, wi_ = pb.br * bi + pb.bi * br;
    yr += pwr * wr_ - pwi * wi_; yi += pwr * wi_ + pwi * wr_;
    float npr = pwr * pb.ar - pwi * pb.ai, npi = pwr * pb.ai + pwi * pb.ar;
    pwr = npr; pwi = npi;
  }
  size_t fi = (((size_t)(b * 32 + g) * 65 + c) * 2) * 64 + lane;
  F[fi] = make_float2(xr, xi);
  F[fi + 64] = make_float2(yr, yi);
}

DEV void s5_pass3_unit(const Params& p, const Ctx& cx, int l, int unit, char* wl, int lane) {
  int c = unit % 65, bg = unit / 65, g = bg & 31, b = bg >> 5;
  const int fr = lane & 15, fq = lane >> 4;
  const h16* zrest = (const h16*)(p.ws + OFF_ZREST);
  const float2* F = (const float2*)(p.ws + OFF_S5F);
  float* S5Y = (float*)(p.ws + OFF_S5Y);
  const int rowbase = s5_rowbase(b, c);
  char* ulds = wl;
  char* tile = wl + 8192;
  s5_load_u(zrest, rowbase, g, ulds, lane);
  float Br[16], Bi[16];
  {
    const float* pr = p.s5_b_re + ((size_t)(l * 32 + g) * 64 + lane) * 16;
    const float* pi = p.s5_b_im + ((size_t)(l * 32 + g) * 64 + lane) * 16;
#pragma unroll
    for (int i = 0; i < 16; i += 4) {
      float4 a = *(const float4*)(pr + i), bq = *(const float4*)(pi + i);
      Br[i] = a.x; Br[i + 1] = a.y; Br[i + 2] = a.z; Br[i + 3] = a.w;
      Bi[i] = bq.x; Bi[i + 1] = bq.y; Bi[i + 2] = bq.z; Bi[i + 3] = bq.w;
    }
  }
  const float dsk = p.s5_d[(size_t)l * 512 + g * 16 + fr];
  const size_t fbase = ((size_t)(b * 32 + g) * 65) * 2 * 64 + lane;
#pragma unroll 1
  for (int d = 0; d < 2; ++d) {
    S5P pp = s5_params(p, cx, l, d, g, lane);
    float qr = pp.ar, qi = pp.ai;
#pragma unroll
    for (int i = 0; i < 8; ++i) { float t = qr * qr - qi * qi; qi = 2.f * qr * qi; qr = t; }
    float xr = 0, xi = 0;
    if (d == 0) {
      for (int cc = 0; cc < c; ++cc) {
        float2 f = F[fbase + (size_t)(cc * 2 + 0) * 64];
        float t = qr * xr - qi * xi + f.x; xi = qr * xi + qi * xr + f.y; xr = t;
      }
    } else if (c > 0) {
      float2 f0 = F[fbase + (size_t)(0 * 2 + 1) * 64];
      xr = f0.x; xi = f0.y;
      for (int cc = 64; cc > c; --cc) {
        float2 f = F[fbase + (size_t)(cc * 2 + 1) * 64];
        float t = qr * xr - qi * xi + f.x; xi = qr * xi + qi * xr + f.y; xr = t;
      }
    }
    bf16x8 chi[4], clo[4];
    {
      const float* cr = p.s5_c_re + ((size_t)((l * 2 + d) * 32 + g) * 16 + fr) * 64;
      const float* ci = p.s5_c_im + ((size_t)((l * 2 + d) * 32 + g) * 16 + fr) * 64;
#pragma unroll
      for (int ks = 0; ks < 4; ++ks) {
        float4 a = *(const float4*)(cr + ks * 16 + fq * 4), bq = *(const float4*)(ci + ks * 16 + fq * 4);
        float vals[8] = {a.x, -bq.x, a.y, -bq.y, a.z, -bq.z, a.w, -bq.w};
#pragma unroll
        for (int j = 0; j < 8; ++j) {
          h16 hh = (h16)vals[j];
          chi[ks][j] = hh;
          clo[ks][j] = (h16)(vals[j] - (float)hh);
        }
      }
    }
#pragma unroll 1
    for (int sb = 0; sb < 16; ++sb) {
      const int sub = d == 0 ? sb : 15 - sb;
#pragma unroll 4
      for (int q = 0; q < 16; ++q) {
        const int tt = d == 0 ? q : 15 - q;
        const int t = sub * 16 + tt;
        h16x8 u0 = *(const h16x8*)(ulds + t * 32), u1 = *(const h16x8*)(ulds + t * 32 + 16);
        float br = 0, bi = 0;
#pragma unroll
        for (int i = 0; i < 8; ++i) { float u = (float)u0[i]; br = fmaf(u, Br[i], br); bi = fmaf(u, Bi[i], bi); }
#pragma unroll
        for (int i = 0; i < 8; ++i) { float u = (float)u1[i]; br = fmaf(u, Br[8 + i], br); bi = fmaf(u, Bi[8 + i], bi); }
        float vr = pp.br * br - pp.bi * bi, vi = pp.br * bi + pp.bi * br;
        float nxr = pp.ar * xr - pp.ai * xi + vr, nxi = pp.ar * xi + pp.ai * xr + vi;
        xr = nxr; xi = nxi;
        h16x2 hv2 = {(h16)xr, (h16)xi};
        float lr_ = xr - (float)hv2[0], li_ = xi - (float)hv2[1];
        *(unsigned*)(tile + tt * 272 + lane * 4) = __builtin_bit_cast(unsigned, hv2);
        *(unsigned*)(tile + 4352 + tt * 272 + lane * 4) = pack_bf2(lr_, li_);
      }
      lds_fence();
      f32x4 acc = f32x4{0.f, 0.f, 0.f, 0.f};
#pragma unroll
      for (int ks = 0; ks < 4; ++ks) {
        bf16x8 ah = *(const bf16x8*)(tile + fr * 272 + ks * 64 + fq * 16);
        bf16x8 alo = *(const bf16x8*)(tile + 4352 + fr * 272 + ks * 64 + fq * 16);
        acc = __builtin_amdgcn_mfma_f32_16x16x32_f16(ah, chi[ks], acc, 0, 0, 0);
        acc = __builtin_amdgcn_mfma_f32_16x16x32_f16(alo, chi[ks], acc, 0, 0, 0);
        acc = __builtin_amdgcn_mfma_f32_16x16x32_f16(ah, clo[ks], acc, 0, 0, 0);
      }
      lds_fence();
#pragma unroll
      for (int r = 0; r < 4; ++r) {
        int tl = sub * 16 + fq * 4 + r;
        float* yp = S5Y + (size_t)(rowbase + tl) * 512 + g * 16 + fr;
        if (d == 0) {
          float u = (float)*(const h16*)(ulds + tl * 32 + fr * 2);
          *yp = acc[r] + dsk * u;
        } else {
          *yp = gelu_f(*yp + acc[r]);
        }
      }
    }
  }
}

DEV void prep_item(const Params& p, const Ctx& cx, int l, int item, char* smem) {
  const int tile = item >> 2, q = item & 3;
  const int row0 = tile * 64;
  const int tid = cx.tid;
  const h16* zc = (const h16*)(p.ws + OFF_REG2);
  h16* SC = (h16*)(p.ws + OFF_SCAN);
  const char* wt = p.ws + OFF_WT + (size_t)l * WT_SIZE;
  {
    const int d = q >> 1, isA = q & 1;
    const int coff = isA ? 3200 + d * 64 : 3072 + d * 64;
    int tok = tid >> 3, c8 = tid & 7;
    h16x8 cv = *(const h16x8*)(zc + (size_t)(row0 + tok) * ZC + coff + c8 * 8);
    float f[8];
#pragma unroll
    for (int j = 0; j < 8; ++j) { f[j] = (float)cv[j]; if (!isA) f[j] = tanh_f(f[j]); }
    uint4 o;
    o.x = pack_bf2(f[0], f[1]); o.y = pack_bf2(f[2], f[3]); o.z = pack_bf2(f[4], f[5]); o.w = pack_bf2(f[6], f[7]);
    *(uint4*)(smem + tok * 144 + c8 * 16) = o;
    __syncthreads();
    const bf16_t* Bt = (const bf16_t*)(wt + (isA ? WT_A2 : WT_W2)) + (size_t)d * 1024 * 64;
    const float* biasw = p.rwkv_w0 + (size_t)(l * 2 + d) * 1024;
    const float* biasa = p.rwkv_a0 + (size_t)(l * 2 + d) * 1024;
    h16* dst = SC + (size_t)(isA ? 4 + d : 6 + d) * ARR;
#pragma unroll 1
    for (int hf = 0; hf < 2; ++hf) small_gemm<64, 4>(p, cx, smem, 144, Bt, (tid >> 6) * 128 + hf * 64, [&](int m, int n, f32x4 v) {
      float4 bbw = *(const float4*)(biasw + n), bba = *(const float4*)(biasa + n);
      float4 bb = isA ? bba : bbw;
      float r0 = sigmoid_f(v[0] + bb.x), r1 = sigmoid_f(v[1] + bb.y), r2 = sigmoid_f(v[2] + bb.z), r3 = sigmoid_f(v[3] + bb.w);
      if (!isA) { r0 = __expf(-DECAY_SCALE * r0); r1 = __expf(-DECAY_SCALE * r1); r2 = __expf(-DECAY_SCALE * r2); r3 = __expf(-DECAY_SCALE * r3); }
      h16x4 o4 = {(h16)r0, (h16)r1, (h16)r2, (h16)r3};
      *(h16x4*)(dst + (size_t)(row0 + m) * 1024 + n) = o4;
    });
  }
  {
    const float* cw = p.conv_rkv + (size_t)l * 3 * 3072;
    const int grp = tid & 7, hh = (tid >> 3) & 3;
    const int c0 = (4 * q + hh) * 64 + grp * 8;
    float cwt[3][3][8];
#pragma unroll
    for (int s = 0; s < 3; ++s)
#pragma unroll
      for (int tp = 0; tp < 3; ++tp)
#pragma unroll
        for (int j = 0; j < 8; j += 4) {
          float4 a = *(const float4*)(cw + tp * 3072 + s * 1024 + c0 + j);
          cwt[s][tp][j] = a.x; cwt[s][tp][j + 1] = a.y; cwt[s][tp][j + 2] = a.z; cwt[s][tp][j + 3] = a.w;
        }
    float kkw[8];
#pragma unroll
    for (int j = 0; j < 8; j += 4) {
      float4 kq = *(const float4*)(p.rwkv_k_k + (size_t)l * 1024 + c0 + j);
      kkw[j] = kq.x; kkw[j + 1] = kq.y; kkw[j + 2] = kq.z; kkw[j + 3] = kq.w;
    }
#pragma unroll 1
    for (int it = 0; it < 4; ++it) {
      const int tok = (tid >> 5) + it * 16;
      const int row = row0 + tok;
      bool hasp, hasn;
      if (row < NLAT) { hasp = (row & 16383) != 0; hasn = (row & 16383) != 16383; }
      else { hasp = (row & 255) != 0; hasn = (row & 255) != 255; }
      const size_t off = (size_t)row * 1024 + c0;
      const h16* zp = zc + (size_t)row * ZC + c0;
      const h16* zpp = hasp ? zp - ZC : zp;
      const h16* zpn = hasn ? zp + ZC : zp;
      h16x8 cur[3], prv[3], nxt[3];
#pragma unroll
      for (int s = 0; s < 3; ++s) { cur[s] = *(const h16x8*)(zp + s * 1024); prv[s] = *(const h16x8*)(zpp + s * 1024); nxt[s] = *(const h16x8*)(zpn + s * 1024); }
      const float fp = hasp ? 1.f : 0.f, fn = hasn ? 1.f : 0.f;
      float kv[8];
#pragma unroll
      for (int s = 0; s < 3; ++s) {
        h16x8 o;
#pragma unroll
        for (int j = 0; j < 8; ++j) {
          float ov = cwt[s][0][j] * (fp * (float)prv[s][j]) + cwt[s][1][j] * (float)cur[s][j] + cwt[s][2][j] * (fn * (float)nxt[s][j]);
          o[j] = (h16)ov;
          if (s == 1) kv[j] = ov;
        }
        *(h16x8*)(SC + (size_t)s * ARR + off) = o;
      }
      float kk[8], ss = 0;
#pragma unroll
      for (int j = 0; j < 8; ++j) { kk[j] = kv[j] * kkw[j]; ss += kk[j] * kk[j]; }
      ss = allreduce8(ss);
      float inv = rcp_f(fmaxf(sqrtf(ss), 1e-12f));
      h16x8 o;
#pragma unroll
      for (int j = 0; j < 8; ++j) o[j] = (h16)(kk[j] * inv);
      *(h16x8*)(SC + 3 * ARR + off) = o;
    }
  }
}

DEV void phase_prep(const Params& p, const Ctx& cx0, int l, char* smem) {
  const int NPREP = 520 * 4, NS5 = 520;
  const Ctx& cx_ = cx0;
  for (int item = cx_.bid; item < NPREP + NS5; item += cx_.nblk) {
    __syncthreads();
    Ctx cx = cx0; asm volatile("" : "+v"(cx.tid));
    const int lane = cx.tid & 63, wid = cx.tid >> 6;
#ifndef NO_PREPITEM
    if (item < NPREP) prep_item(p, cx, l, item, smem);
    else
#endif
#ifndef NO_S5P1
      s5_pass1_unit(p, cx, l, (item - NPREP) * 8 + wid, smem + wid * 8192, lane);
#else
    {}
#endif
  }
}

typedef unsigned u2v __attribute__((ext_vector_type(2)));
struct RG { u2v w, a, kk, k, r; h16 v; };

constexpr int RW_NSLOT = 8, RW_SLOTB = 5760;
constexpr int RW_FLAGS = RW_NSLOT * RW_SLOTB;
constexpr int RW_NG = 16640 / 4;
typedef float f4v __attribute__((ext_vector_type(4)));

#define RW_RLO(gq, rlo)                                                            \
  {                                                                                \
    const int gg = (gq) < RW_NG ? (gq) : RW_NG - 1;                                \
    const int q0_ = gg * 4;                                                        \
    const int isl = q0_ >= 256;                                                    \
    const int base_ = isl ? b * 16384 : NLAT + b * 256;                            \
    const int t0_ = isl ? q0_ - 256 : q0_;                                         \
    const int last_ = isl ? 16383 : 255;                                           \
    rlo = base_ + (d ? last_ - t0_ - 3 : t0_);                                     \
  }

DEV void rwkv_helper(const Params& p, const Ctx& cx, int l, int unit, int lane, char* ring) {
  const int d = unit & 1, h = (unit >> 1) & 15, b = unit >> 5;
  const int j = lane >> 4, s = lane & 15;
  const h16* SC = (const h16*)(p.ws + OFF_SCAN);
  const char* pR = (const char*)(SC + 0 * ARR + h * 64);
  const char* pK = (const char*)(SC + 1 * ARR + h * 64);
  const char* pV = (const char*)(SC + 2 * ARR + h * 64);
  const char* pKK = (const char*)(SC + 3 * ARR + h * 64);
  const char* pA = (const char*)(SC + (size_t)(4 + d) * ARR + h * 64);
  const char* pW = (const char*)(SC + (size_t)(6 + d) * ARR + h * 64);
  const int jm = d ? 3 - j : j;
  const unsigned vo0 = (unsigned)(jm * 2048 + s * 8);
  f4v ka4, om4;
  {
    float4 t = *(const float4*)(p.rwkv_k_a + (size_t)l * 1024 + h * 64 + 4 * s);
    ka4 = f4v{t.x, t.y, t.z, t.w};
    om4 = 1.f - ka4;
  }
  struct RGH { u2v w, a, kk, k, r, v; };
  RGH q0, q1, q2, q3, q4, q5, q6, q7;
  const unsigned wofs = (unsigned)(j * 256 + s * 16);
  const unsigned vwofs = (unsigned)(5120 + j * 128 + s * 8);
  LAS3 volatile int* pflag = (LAS3 volatile int*)(ring + RW_FLAGS);
  LAS3 volatile int* cflag = (LAS3 volatile int*)(ring + RW_FLAGS + 64);
  int cmin = 0;
#define CV4(uv) __builtin_convertvector(__builtin_bit_cast(h16x4, uv), f4v)
#define RH_LOAD(q, gq)                                                             \
  {                                                                                \
    int rlo; RW_RLO(gq, rlo);                                                      \
    unsigned vo = vo0; asm volatile("" : "+v"(vo));                                \
    const size_t off = (size_t)rlo * 2048;                                         \
    q.w = *(const u2v*)(pW + off + vo); q.a = *(const u2v*)(pA + off + vo);        \
    q.kk = *(const u2v*)(pKK + off + vo); q.k = *(const u2v*)(pK + off + vo);      \
    q.r = *(const u2v*)(pR + off + vo); q.v = *(const u2v*)(pV + off + vo);        \
  }
#define RH_STEP(q, gq)                                                             \
  {                                                                                \
    if ((gq) >= RW_NSLOT && cmin < (gq) - RW_NSLOT + 1) {                          \
      do {                                                                         \
        const int c0_ = cflag[0], c1_ = cflag[1], c2_ = cflag[2], c3_ = cflag[3];  \
        cmin = __builtin_amdgcn_readfirstlane(min(min(c0_, c1_), min(c2_, c3_)));  \
        if (cmin < (gq) - RW_NSLOT + 1) __builtin_amdgcn_s_sleep(1);               \
      } while (cmin < (gq) - RW_NSLOT + 1);                                        \
    }                                                                              \
    asm volatile("" ::: "memory");                                                 \
    char* sl = ring + ((gq) % RW_NSLOT) * RW_SLOTB;                                \
    const f4v a_ = CV4(q.a), kk_ = CV4(q.kk);                                      \
    *(f4v*)(sl + 0 * 1024 + wofs) = CV4(q.w);                                      \
    *(f4v*)(sl + 1 * 1024 + wofs) = kk_;                                           \
    *(f4v*)(sl + 2 * 1024 + wofs) = kk_ * a_;                                      \
    *(f4v*)(sl + 3 * 1024 + wofs) = CV4(q.k) * (a_ * ka4 + om4);                   \
    *(f4v*)(sl + 4 * 1024 + wofs) = CV4(q.r);                                      \
    *(u2v*)(sl + vwofs) = q.v;                                                     \
    asm volatile("s_waitcnt lgkmcnt(0)" ::: "memory");     \
    *pflag = (gq) + 1;                                                             \
  }
  RH_LOAD(q0, 0); RH_LOAD(q1, 1); RH_LOAD(q2, 2); RH_LOAD(q3, 3); RH_LOAD(q4, 4); RH_LOAD(q5, 5); RH_LOAD(q6, 6); RH_LOAD(q7, 7);
#pragma unroll 1
  for (int g = 0; g < RW_NG; g += 8) {
    RH_STEP(q0, g); RH_LOAD(q0, g + 8); __builtin_amdgcn_sched_barrier(0);
    RH_STEP(q1, g + 1); RH_LOAD(q1, g + 9); __builtin_amdgcn_sched_barrier(0);
    RH_STEP(q2, g + 2); RH_LOAD(q2, g + 10); __builtin_amdgcn_sched_barrier(0);
    RH_STEP(q3, g + 3); RH_LOAD(q3, g + 11); __builtin_amdgcn_sched_barrier(0);
    RH_STEP(q4, g + 4); RH_LOAD(q4, g + 12); __builtin_amdgcn_sched_barrier(0);
    RH_STEP(q5, g + 5); RH_LOAD(q5, g + 13); __builtin_amdgcn_sched_barrier(0);
    RH_STEP(q6, g + 6); RH_LOAD(q6, g + 14); __builtin_amdgcn_sched_barrier(0);
    RH_STEP(q7, g + 7); RH_LOAD(q7, g + 15); __builtin_amdgcn_sched_barrier(0);
  }
#undef RH_LOAD
#undef RH_STEP
#undef CV4
}

DEV void rwkv_consumer(const Params& p, const Ctx& cx, int l, int task, int lane, const char* ring, int widx) {
  const int unit = task >> 4, d = unit & 1, h = (unit >> 1) & 15, b = unit >> 5;
  const int j = lane >> 4, s = lane & 15;
  const int myrow = (task & 15) * 4 + j;
  char* pO = (char*)((h16*)(p.ws + OFF_REG2) + (size_t)d * ARR + h * 64);
  const int sm = d ? 3 - (s & 3) : (s & 3);
  const unsigned vov0 = (unsigned)(sm * 2048 + myrow * 2);
  const unsigned rofs = (unsigned)(s * 16);
  const unsigned vrofs = (unsigned)(5120 + myrow * 2);
  LAS3 volatile int* pflag = (LAS3 volatile int*)(ring + RW_FLAGS);
  LAS3 volatile int* cflag = (LAS3 volatile int*)(ring + RW_FLAGS + 64) + widx;
  f4v S = {0.f, 0.f, 0.f, 0.f};
  int pseen = 0, slotc = 0;
#pragma unroll 1
  for (int g = 0; g < RW_NG; ++g) {
    if (pseen <= g) {
      do {
        pseen = __builtin_amdgcn_readfirstlane(*pflag);
        if (pseen <= g) __builtin_amdgcn_s_sleep(1);
      } while (pseen <= g);
    }
    asm volatile("" ::: "memory");
    const char* sl = ring + slotc * RW_SLOTB;
    float dres[4];
#pragma unroll
    for (int u = 0; u < 4; ++u) {
      const f4v w_ = *(const f4v*)(sl + 0 * 1024 + u * 256 + rofs);
      const f4v kk_ = *(const f4v*)(sl + 1 * 1024 + u * 256 + rofs);
      const f4v kka_ = *(const f4v*)(sl + 2 * 1024 + u * 256 + rofs);
      const f4v kd_ = *(const f4v*)(sl + 3 * 1024 + u * 256 + rofs);
      const f4v r_ = *(const f4v*)(sl + 4 * 1024 + u * 256 + rofs);
      const float vj = (float)*(const h16*)(sl + u * 128 + vrofs);
      const f4v pd = S * kk_;
      const float d1 = allreduce16((pd.x + pd.y) + (pd.z + pd.w));
      S = S * w_ + kd_ * vj;
      S = S - kka_ * d1;
      const f4v pe = S * r_;
      dres[u] = (pe.x + pe.y) + (pe.z + pe.w);
    }
    asm volatile("s_waitcnt lgkmcnt(0)" ::: "memory");
    *cflag = g + 1;
    {
      int rlo; RW_RLO(g, rlo);
      unsigned vov = vov0; asm volatile("" : "+v"(vov));
      const bool p1_ = (s & 1) != 0, p2_ = (s & 2) != 0;
      const float a_ = (p1_ ? dres[1] : dres[0]) + dpp_mov<0xB1>(p1_ ? dres[0] : dres[1]);
      const float b_ = (p1_ ? dres[3] : dres[2]) + dpp_mov<0xB1>(p1_ ? dres[2] : dres[3]);
      float val = (p2_ ? b_ : a_) + dpp_mov<0x4E>(p2_ ? a_ : b_);
      val += dpp_mov<0x124>(val);
      val += dpp_mov<0x128>(val);
      *(h16*)(pO + (size_t)rlo * 2048 + vov) = (h16)val;
    }
    slotc = (slotc == RW_NSLOT - 1) ? 0 : slotc + 1;
  }
}
#undef RW_RLO

DEV void phase_scan(const Params& p, const Ctx& cx, int l, char* smem) {
  const int lane = cx.tid & 63, wid = __builtin_amdgcn_readfirstlane(cx.tid >> 6);
  for (int slot = cx.bid; slot < 256; slot += cx.nblk) {
    __syncthreads();
    if (wid == 4 && lane < 8) *(LAS3 volatile int*)(smem + RW_FLAGS + (lane == 0 ? 0 : 64 + (lane & 3) * 4)) = 0;
    __syncthreads();
    const int unit = slot & 63;
#ifndef NO_RWKV
    if (wid < 4) rwkv_consumer(p, cx, l, (unit << 4) | ((slot >> 6) << 2) | wid, lane, smem, wid);
    else if (wid == 4) rwkv_helper(p, cx, l, unit, lane, smem);
#endif
  }
  if (wid >= 5) {
    char* wl = smem + 49152 + (wid - 5) * 17408;
    for (int u = cx.bid * 3 + (wid - 5); u < 2 * 32 * 65; u += cx.nblk * 3) {
      if (l == 1 && (u % 65) == 0) continue;
#ifndef NO_S5P3
      s5_pass3_unit(p, cx, l, u, wl, lane);
#endif
    }
  }
}

DEV void pool_item(const Params& p, const Ctx& cx, int l, int item, char* smem) {
  const int tid = cx.tid;
  const h16* zrest = (const h16*)(p.ws + OFF_ZREST);
  bf16_t* ym = (bf16_t*)(p.ws + OFF_YM);
  const char* wt = p.ws + OFF_WT + (size_t)l * WT_SIZE;
  float* V = (float*)smem;
  char* At = smem + 43008;
  int g, rowout0, Lseq, p0, rlo, rhi, rstride, rowsrc0;
  if (item < 2048) {
    g = item & 3; int r = (item >> 2) & 255, b = item >> 10;
    int w = 2 << g;
    rlo = max(r - w / 2, 0); rhi = min(r + w / 2 - 1, 255);
    rowsrc0 = b * 16384; rstride = 64;
    rowout0 = b * 16384 + r * 64; Lseq = 64; p0 = 0;
  } else {
    int it = item - 2048;
    g = it & 3; int tq = (it >> 2) & 3, b = it >> 4;
    rlo = 0; rhi = 0; rowsrc0 = NLAT + b * 256; rstride = 0;
    rowout0 = NLAT + b * 256 + tq * 64; Lseq = 256; p0 = tq * 64;
  }
  const int w = 2 << g;
  const float invr = 1.f / (float)(rhi - rlo + 1);
  for (int unit = tid; unit < 80 * 16; unit += NTHREADS) {
    int lp = unit >> 4, ch8 = unit & 15;
    int pos = p0 - 8 + lp;
    float acc[8] = {0, 0, 0, 0, 0, 0, 0, 0};
    if (pos >= 0 && pos < Lseq) {
      const h16* bp = zrest + (size_t)(rowsrc0 + pos) * ZR + 1024 + g * 128 + ch8 * 8;
      const int nr = rhi - rlo + 1;
      for (int k0 = 0; k0 < nr; k0 += 4) {
        h16x8 v[4]; float wv[4];
#pragma unroll
        for (int i = 0; i < 4; ++i) {
          const int kk_ = min(k0 + i, nr - 1);
          wv[i] = (k0 + i < nr) ? 1.f : 0.f;
          v[i] = *(const h16x8*)(bp + (size_t)((rlo + kk_) * rstride) * ZR);
        }
#pragma unroll
        for (int i = 0; i < 4; ++i)
#pragma unroll
          for (int j = 0; j < 8; ++j) acc[j] += wv[i] * (float)v[i][j];
      }
    }
    float* vp = V + lp * 132 + ch8 * 8;
#pragma unroll
    for (int j = 0; j < 8; ++j) vp[j] = acc[j] * invr;
  }
  __syncthreads();
  for (int unit = tid; unit < 64 * 16; unit += NTHREADS) {
    int c = unit >> 4, ch8 = unit & 15;
    int pos = p0 + c;
    int lo = max(pos - w / 2, 0), hi = min(pos + w / 2 - 1, Lseq - 1);
    float acc[8] = {0, 0, 0, 0, 0, 0, 0, 0};
    for (int pp = lo; pp <= hi; ++pp) {
      const float* vp = V + (pp - p0 + 8) * 132 + ch8 * 8;
#pragma unroll
      for (int j = 0; j < 8; ++j) acc[j] += vp[j];
    }
    float invc = 1.f / (float)(hi - lo + 1);
    h16x8 uc = *(const h16x8*)(zrest + (size_t)(rowout0 + c) * ZR + 1024 + g * 128 + ch8 * 8);
    uint4 o;
    o.x = pack_bf2(acc[0] * invc - (float)uc[0], acc[1] * invc - (float)uc[1]);
    o.y = pack_bf2(acc[2] * invc - (float)uc[2], acc[3] * invc - (float)uc[3]);
    o.z = pack_bf2(acc[4] * invc - (float)uc[4], acc[5] * invc - (float)uc[5]);
    o.w = pack_bf2(acc[6] * invc - (float)uc[6], acc[7] * invc - (float)uc[7]);
    *(uint4*)(At + c * 272 + ch8 * 16) = o;
  }
  __syncthreads();
  const bf16_t* Bt = (const bf16_t*)(wt + WT_POOL) + (size_t)g * 128 * 128;
  const float* ps = p.pool_scale + (size_t)l * 512 + g * 128;
  small_gemm<128, 1>(p, cx, At, 272, Bt, (tid >> 6) * 16, [&](int m, int n, f32x4 v) {
    int row = rowout0 + m;
    float4 sc = *(const float4*)(ps + n);
    h16x4 gt = *(const h16x4*)(zrest + (size_t)row * ZR + 1536 + g * 128 + n);
    uint2 o;
    o.x = pack_bf2(v[0] * sc.x * silu_f((float)gt[0]), v[1] * sc.y * silu_f((float)gt[1]));
    o.y = pack_bf2(v[2] * sc.z * silu_f((float)gt[2]), v[3] * sc.w * silu_f((float)gt[3]));
    *(uint2*)(ym + (size_t)row * D + 512 + g * 128 + n) = o;
  });
}

DEV void glu_item(const Params& p, const Ctx& cx, int l, int tile, char* smem) {
  const int tid = cx.tid;
  const int row0 = tile * 64;
  const float* S5Y = (const float*)(p.ws + OFF_S5Y);
  const h16* zrest = (const h16*)(p.ws + OFF_ZREST);
  bf16_t* ym = (bf16_t*)(p.ws + OFF_YM);
  const char* wt = p.ws + OFF_WT + (size_t)l * WT_SIZE;
#pragma unroll
  for (int it = 0; it < 8; ++it) {
    int unit = tid + it * NTHREADS;
    int r = unit >> 6, c8 = unit & 63;
    const float* sp = S5Y + (size_t)(row0 + r) * 512 + c8 * 8;
    float4 a = *(const float4*)sp, bq = *(const float4*)(sp + 4);
    uint4 o;
    o.x = pack_bf2(a.x, a.y); o.y = pack_bf2(a.z, a.w); o.z = pack_bf2(bq.x, bq.y); o.w = pack_bf2(bq.z, bq.w);
    *(uint4*)(smem + r * 1040 + c8 * 16) = o;
  }
  __syncthreads();
  const bf16_t* Bt = (const bf16_t*)(wt + WT_GLU);
  const float* bg = p.b_glu + (size_t)l * 512;
  small_gemm<512, 4>(p, cx, smem, 1040, Bt, (tid >> 6) * 64, [&](int m, int n, f32x4 v) {
    int row = row0 + m;
    float4 y = *(const float4*)(S5Y + (size_t)row * 512 + n);
    float4 bb = *(const float4*)(bg + n);
    h16x4 gt = *(const h16x4*)(zrest + (size_t)row * ZR + 512 + n);
    uint2 o;
    o.x = pack_bf2(y.x * sigmoid_f(v[0] + bb.x) * silu_f((float)gt[0]), y.y * sigmoid_f(v[1] + bb.y) * silu_f((float)gt[1]));
    o.y = pack_bf2(y.z * sigmoid_f(v[2] + bb.z) * silu_f((float)gt[2]), y.w * sigmoid_f(v[3] + bb.w) * silu_f((float)gt[3]));
    *(uint2*)(ym + (size_t)row * D + n) = o;
  });
}

DEV void rwkvmerge_item(const Params& p, const Ctx& cx, int l, int tile) {
  const int tid = cx.tid;
  const int row0 = tile * 64;
  const h16* SC = (const h16*)(p.ws + OFF_SCAN);
  const h16* O = (const h16*)(p.ws + OFF_REG2);
  const h16* zrest = (const h16*)(p.ws + OFF_ZREST);
  bf16_t* ym = (bf16_t*)(p.ws + OFF_YM);
  const int grp = tid & 7, h = (tid >> 3) & 15;
  const int c0 = h * 64 + grp * 8;
  float pk[8], rk[8], gw[8], gb[8];
#pragma unroll
  for (int j = 0; j < 8; j += 4) {
    float4 t0 = *(const float4*)(p.rwkv_k_a + (size_t)l * 1024 + c0 + j), t1 = *(const float4*)(p.rwkv_r_k + (size_t)l * 1024 + c0 + j);
    float4 t2 = *(const float4*)(p.gn_w + (size_t)l * 1024 + c0 + j), t3 = *(const float4*)(p.gn_b + (size_t)l * 1024 + c0 + j);
    pk[j] = t0.x; pk[j + 1] = t0.y; pk[j + 2] = t0.z; pk[j + 3] = t0.w;
    rk[j] = t1.x; rk[j + 1] = t1.y; rk[j + 2] = t1.z; rk[j + 3] = t1.w;
    gw[j] = t2.x; gw[j + 1] = t2.y; gw[j + 2] = t2.z; gw[j + 3] = t2.w;
    gb[j] = t3.x; gb[j + 1] = t3.y; gb[j + 2] = t3.z; gb[j + 3] = t3.w;
  }
#pragma unroll 2
  for (int it = 0; it < 16; ++it) {
    const int tok = (tid >> 7) + it * 4;
    int row = row0 + tok;
    size_t off = (size_t)row * 1024 + c0;
    h16x8 of = *(const h16x8*)(O + off), ob = *(const h16x8*)(O + ARR + off);
    h16x8 r8 = *(const h16x8*)(SC + 0 * ARR + off), k8 = *(const h16x8*)(SC + 1 * ARR + off), v8 = *(const h16x8*)(SC + 2 * ARR + off);
    h16x8 af = *(const h16x8*)(SC + 4 * ARR + off), ab = *(const h16x8*)(SC + 5 * ARR + off);
    h16x8 gt = *(const h16x8*)(zrest + (size_t)row * ZR + 2048 + c0);
    float o[8], sm = 0;
#pragma unroll
    for (int j = 0; j < 8; ++j) { o[j] = (float)of[j] + (float)ob[j]; sm += o[j]; }
    sm = allreduce8(sm);
    float mu = sm * (1.f / 64.f), vq = 0;
#pragma unroll
    for (int j = 0; j < 8; ++j) { o[j] -= mu; vq += o[j] * o[j]; }
    vq = allreduce8(vq);
    float rstd = rsqrtf(vq * (1.f / 64.f) + 64e-5f);
    float part = 0;
#pragma unroll
    for (int j = 0; j < 8; ++j) {
      float ksum = (float)k8[j] * (2.f + ((float)af[j] + (float)ab[j] - 2.f) * pk[j]);
      part += (float)r8[j] * ksum * rk[j];
    }
    part = allreduce8(part);
    float res[8];
#pragma unroll
    for (int j = 0; j < 8; ++j) {
      float y = o[j] * rstd * gw[j] + gb[j] + part * (float)v8[j];
      res[j] = y * silu_f((float)gt[j]);
    }
    uint4 ov;
    ov.x = pack_bf2(res[0], res[1]); ov.y = pack_bf2(res[2], res[3]); ov.z = pack_bf2(res[4], res[5]); ov.w = pack_bf2(res[6], res[7]);
    *(uint4*)(ym + (size_t)row * D + 1024 + c0) = ov;
  }
}

DEV void phase_merge(const Params& p, const Ctx& cx0, int l, char* smem) {
  const int ntile = (l == 0) ? 520 : 512;
  const int npool = (l == 0) ? 2048 + 32 : 2048;
  const int total = npool + 2 * ntile;
  for (int item = cx0.bid; item < total; item += cx0.nblk) {
    __syncthreads();
    Ctx cx = cx0; asm volatile("" : "+v"(cx.tid));
    if (item < npool) pool_item(p, cx, l, item, smem);
    else if (item < npool + ntile) glu_item(p, cx, l, item - npool, smem);
    else rwkvmerge_item(p, cx, l, item - npool - ntile);
  }
}

#define LCX Ctx c2 = cx; asm volatile("" : "+v"(c2.tid))
#ifndef GEMM_FN
#define GEMM_FN gemm_phase2
#endif
__global__ void __launch_bounds__(NTHREADS) mega_fwd(Params p, int ph0, int ph1) {
  extern __shared__ __attribute__((aligned(16))) char smem[];
  cg::grid_group grid = cg::this_grid();
  const int wave_s = __builtin_amdgcn_readfirstlane((int)(threadIdx.x >> 6));
  for (int step = ph0; step < ph1; ++step) {
    if (step > ph0) grid.sync();
    const int ph = (int)((PH_SEQ >> (4 * step)) & 15ull);
    Ctx cx;
    {
      int t_, b_ = blockIdx.x, n_ = gridDim.x;
      asm volatile("v_mbcnt_lo_u32_b32 %0, -1, 0\n\tv_mbcnt_hi_u32_b32 %0, -1, %0\n\tv_lshl_add_u32 %0, %1, 6, %0" : "=&v"(t_) : "s"(wave_s));
      asm volatile("" : "+s"(b_), "+s"(n_));
      cx.tid = t_; cx.bid = b_; cx.nblk = n_;
    }
    const int l = ph >= 8 ? 1 : 0;
    const int lp = ph >= 8 ? ph - 6 : ph;
#ifndef PHMASK
#define PHMASK 0xff
#endif
    if (ph == 0) { if (PHMASK & 1) { LCX; phase0(p, c2, smem); } }
    else if (ph == 1) { if (PHMASK & 2) { LCX; phase_adaln0(p, c2); } }
    else if (lp == 2 && (PHMASK & 4)) {
      LCX;
      h16* zrest = (h16*)(p.ws + OFF_ZREST);
      h16* zc = (h16*)(p.ws + OFF_REG2);
      GEMM_FN(p, c2, (const bf16_t*)(p.ws + OFF_H), (const bf16_t*)(p.ws + OFF_WT + (size_t)l * WT_SIZE + WT_IN), 2048, 130, 25, smem,
                 [&](int row, int col, f32x4 v, f32x4 u) {
                   h16* dst;
                   if (col < 2048) dst = zrest + (size_t)row * ZR + col;
                   else if (col < 5120) dst = zc + (size_t)row * ZC + (col - 2048);
                   else if (col < 6144) dst = zrest + (size_t)row * ZR + 2048 + (col - 5120);
                   else dst = zc + (size_t)row * ZC + 3072 + (col - 6144);
                   h16x8 o = {(h16)v[0], (h16)v[1], (h16)v[2], (h16)v[3], (h16)u[0], (h16)u[1], (h16)u[2], (h16)u[3]};
                   *(h16x8*)dst = o;
                 });
    } else if (lp == 3) { if (PHMASK & 8) { LCX; phase_prep(p, c2, l, smem); } }
    else if (lp == 4) { if (PHMASK & 16) { LCX; phase_scan(p, c2, l, smem); } }
    else if (lp == 5) { if (PHMASK & 32) { LCX; phase_merge(p, c2, l, smem); } }
    else if (lp == 6 && (PHMASK & 64)) {
      LCX;
      const float* mods = (const float*)(p.ws + OFF_MODS);
      float* prec = (float*)(p.ws + OFF_PREC);
      const float* xin = (l == 0) ? p.x : p.out;
      GEMM_FN(p, c2, (const bf16_t*)(p.ws + OFF_YM), (const bf16_t*)(p.ws + OFF_WT + (size_t)l * WT_SIZE + WT_OUT), 2048, l == 0 ? 130 : 128, 8, smem,
                 [&](int row, int col, f32x4 v, f32x4 u) {
                   const float* xr; const float* gr; float* dr;
                   if (row < NLAT) {
                     xr = xin + (size_t)row * D + col; gr = mods + (size_t)(l * 3 + (row >> 14)) * 6144 + 4096 + col; dr = p.out + (size_t)row * D + col;
                   } else {
                     xr = p.ctx + (size_t)(row - NLAT) * D + col; gr = mods + (size_t)(l * 3 + 2) * 6144 + 4096 + col; dr = prec + (size_t)(row - NLAT) * D + col;
                   }
                   const float4 x0 = *(const float4*)xr, x1 = *(const float4*)(xr + 4), g0 = *(const float4*)gr, g1 = *(const float4*)(gr + 4);
                   float4 r0, r1;
                   r0.x = ALPHA * x0.x + g0.x * v[0]; r0.y = ALPHA * x0.y + g0.y * v[1]; r0.z = ALPHA * x0.z + g0.z * v[2]; r0.w = ALPHA * x0.w + g0.w * v[3];
                   r1.x = ALPHA * x1.x + g1.x * u[0]; r1.y = ALPHA * x1.y + g1.y * u[1]; r1.z = ALPHA * x1.z + g1.z * u[2]; r1.w = ALPHA * x1.w + g1.w * u[3];
                   *(float4*)dr = r0; *(float4*)(dr + 4) = r1;
                 });
    } else if (lp == 7) { if (PHMASK & 128) { LCX; phase_finln(p, c2, l); } }
  }
}

constexpr int NPHASES = PH_NSTEPS;

extern "C" void kernel_launch(void* const* d_in, const int* in_sizes, int n_in, void* d_out, int out_size, void* d_ws, size_t ws_size,
                              hipStream_t stream) {
  static int grid_blocks = 0;
  if (grid_blocks == 0) {
    if (n_in != 32 || ws_size < WS_END) { fprintf(stderr, "kernel_launch: unexpected n_in %d / ws %zu (need %zu)\n", n_in, ws_size, (size_t)WS_END); grid_blocks = -1; return; }
    int dev = 0, cus = 0, per_cu = 0;
    hipGetDevice(&dev);
    hipDeviceGetAttribute(&cus, hipDeviceAttributeMultiprocessorCount, dev);
    if (hipFuncSetAttribute((const void*)mega_fwd, hipFuncAttributeMaxDynamicSharedMemorySize, LDS_BYTES) != hipSuccess) { fprintf(stderr, "hipFuncSetAttribute failed\n"); grid_blocks = -1; return; }
    if (hipOccupancyMaxActiveBlocksPerMultiprocessor(&per_cu, (const void*)mega_fwd, NTHREADS, LDS_BYTES) != hipSuccess || per_cu < 1) {
      fprintf(stderr, "occupancy query gave %d\n", per_cu); (void)hipGetLastError(); per_cu = 1;
    }
    grid_blocks = cus * per_cu;
  }
  if (grid_blocks < 0) return;
  Params p{};
  const float** pp = (const float**)&p;
  for (int i = 0; i < 32; ++i) pp[i] = (const float*)d_in[i];
  p.out = (float*)d_out;
  p.ws = (char*)d_ws;
  int ph0 = 0, ph1 = NPHASES;
  void* args[] = {&p, &ph0, &ph1};
  hipError_t e = hipLaunchCooperativeKernel((const void*)mega_fwd, dim3(grid_blocks), dim3(NTHREADS), args, LDS_BYTES, stream);
  if (e != hipSuccess) fprintf(stderr, "cooperative launch failed: %s (grid %d)\n", hipGetErrorString(e), grid_blocks);
}
```

```cpp
#include <hip/hip_runtime.h>
#include <hip/hip_cooperative_groups.h>
#include <cstdio>
namespace cg = cooperative_groups;

typedef unsigned short bf16_t;
typedef _Float16 h16;
using bf16x8 = __attribute__((ext_vector_type(8))) _Float16;
using f32x4 = __attribute__((ext_vector_type(4))) float;
using h16x4 = __attribute__((ext_vector_type(4))) _Float16;
using h16x8 = __attribute__((ext_vector_type(8))) _Float16;

#define DEV __device__ __forceinline__

constexpr int D = 2048, NLAT = 32768, MTOT = 33280, ZR = 3072, ZC = 3328;
constexpr int NTHREADS = 512;
constexpr int LDS_BYTES = 147456;
constexpr float ALPHA = 1.41421356237f;
constexpr float DECAY_SCALE = 0.606531f;

constexpr size_t al256(size_t x) { return (x + 255) & ~size_t(255); }
constexpr size_t ARR = (size_t)MTOT * 1024;
constexpr size_t OFF_MODS = 0;
constexpr size_t OFF_S5F = al256(OFF_MODS + 2 * 3 * 6144 * 4);
constexpr size_t OFF_PREC = al256(OFF_S5F + (size_t)2 * 32 * 65 * 2 * 64 * 8);
constexpr size_t OFF_WT = al256(OFF_PREC + (size_t)512 * 2048 * 4);
constexpr size_t WT_IN = 0, WT_OUT = 26214400, WT_W2 = 34603008, WT_A2 = 34865152, WT_POOL = 35127296, WT_GLU = 35258368, WT_SIZE = 35782656;
constexpr size_t OFF_ZREST = al256(OFF_WT + 2 * WT_SIZE);
constexpr size_t OFF_REG2 = al256(OFF_ZREST + (size_t)MTOT * ZR * 2);
constexpr size_t OFF_S5Y = OFF_REG2 + 2 * ARR * 2;
constexpr size_t OFF_SCAN = al256(OFF_REG2 + (size_t)MTOT * ZC * 2);
constexpr size_t OFF_H = OFF_SCAN;
constexpr size_t OFF_YM = OFF_SCAN + 6 * ARR * 2;
constexpr size_t WS_END = OFF_SCAN + 8 * ARR * 2;

#ifndef PH_SEQ
#define PH_SEQ 0xDCBA9876543210ull
#define PH_NSTEPS 14
#endif
struct Params {
  const float *x, *c, *ctx, *c_ctx, *w_ada, *b_ada, *w_in, *conv_rkv, *s5_lam_re, *s5_lam_im, *s5_log_step,
      *s5_b_re, *s5_b_im, *s5_c_re, *s5_c_im, *s5_d, *w_glu, *b_glu, *w_pool, *pool_scale,
      *rwkv_w0, *rwkv_w2, *rwkv_a0, *rwkv_a2, *rwkv_k_k, *rwkv_k_a, *rwkv_r_k, *gn_w, *gn_b,
      *w_out, *ln_g, *ln_b;
  float* out;
  char* ws;
};
struct Ctx { int tid, bid, nblk; };

DEV float rcp_f(float x) { return __builtin_amdgcn_rcpf(x); }
DEV float sigmoid_f(float x) { return rcp_f(1.f + __expf(-x)); }
DEV float silu_f(float x) { return x * rcp_f(1.f + __expf(-x)); }
DEV float tanh_f(float x) { float e = __expf(2.f * x); return 1.f - 2.f * rcp_f(e + 1.f); }
DEV float gelu_f(float y) { return 0.5f * y * (1.f + tanh_f(0.7978845608f * (y + 0.044715f * y * y * y))); }
using h16x2 = __attribute__((ext_vector_type(2))) _Float16;
DEV unsigned pack_bf2(float a, float b) { h16x2 v = {(h16)a, (h16)b}; return __builtin_bit_cast(unsigned, v); }
template <int CTRL> DEV float dpp_mov(float v) {
  return __int_as_float(__builtin_amdgcn_update_dpp(0, __float_as_int(v), CTRL, 0xf, 0xf, true));
}
DEV float allreduce16(float v) {
  v += dpp_mov<0xB1>(v);
  v += dpp_mov<0x4E>(v);
  v += dpp_mov<0x141>(v);
  v += dpp_mov<0x140>(v);
  return v;
}
DEV float wave_sum(float v) {
  v = allreduce16(v);
  return __builtin_amdgcn_readlane(__float_as_int(v), 0) == 0 && false ? 0.f :
         __int_as_float(__builtin_amdgcn_readlane(__float_as_int(v), 0)) + __int_as_float(__builtin_amdgcn_readlane(__float_as_int(v), 16)) +
         __int_as_float(__builtin_amdgcn_readlane(__float_as_int(v), 32)) + __int_as_float(__builtin_amdgcn_readlane(__float_as_int(v), 48));
}
DEV float allreduce8(float v) {
  v += dpp_mov<0xB1>(v);
  v += dpp_mov<0x4E>(v);
  v += dpp_mov<0x141>(v);
  return v;
}
DEV void lds_fence() { asm volatile("s_waitcnt lgkmcnt(0)" ::: "memory"); }

DEV void p0_mods_item(const Params& p, const Ctx& cx, int item, char* smem) {
  float* red = (float*)smem;
  float* mods = (float*)(p.ws + OFF_MODS);
  int l = item / 96, chunk = item % 96;
  int tid = cx.tid, kq = tid >> 6, col = tid & 63;
  int n = chunk * 64 + col;
  const float* W = p.w_ada + (size_t)l * 2048 * 6144;
  float a0 = 0, a1 = 0, a2 = 0;
#pragma unroll 8
  for (int k = kq; k < 2048; k += 8) {
    float w = W[(size_t)k * 6144 + n];
    a0 += silu_f(p.c[k]) * w;
    a1 += silu_f(p.c[2048 + k]) * w;
    a2 += silu_f(p.c_ctx[k]) * w;
  }
  red[(kq * 3 + 0) * 64 + col] = a0;
  red[(kq * 3 + 1) * 64 + col] = a1;
  red[(kq * 3 + 2) * 64 + col] = a2;
  __syncthreads();
  if (tid < 192) {
    int r = tid >> 6, cc = tid & 63;
    float s = 0;
#pragma unroll
    for (int q = 0; q < 8; ++q) s += red[(q * 3 + r) * 64 + cc];
    mods[(size_t)(l * 3 + r) * 6144 + chunk * 64 + cc] = s + p.b_ada[(size_t)l * 6144 + chunk * 64 + cc];
  }
}

DEV void p0_transpose_tile(const Params& p, const Ctx& cx, const float* __restrict__ src, bf16_t* __restrict__ dst, int K, int N, int tk, int tn, char* smem) {
  float* T = (float*)smem;
  int tid = cx.tid;
  int k0 = tk * 64, n0 = tn * 64;
  int kk = tid >> 4, n4 = tid & 15;
#pragma unroll
  for (int i = 0; i < 2; ++i) {
    int k = kk + 32 * i;
    float4 v = *(const float4*)(src + (size_t)(k0 + k) * N + n0 + n4 * 4);
    T[k * 65 + n4 * 4 + 0] = v.x; T[k * 65 + n4 * 4 + 1] = v.y; T[k * 65 + n4 * 4 + 2] = v.z; T[k * 65 + n4 * 4 + 3] = v.w;
  }
  __syncthreads();
  int n = tid >> 3, k8 = tid & 7;
  uint4 o;
  o.x = pack_bf2(T[(k8 * 8 + 0) * 65 + n], T[(k8 * 8 + 1) * 65 + n]);
  o.y = pack_bf2(T[(k8 * 8 + 2) * 65 + n], T[(k8 * 8 + 3) * 65 + n]);
  o.z = pack_bf2(T[(k8 * 8 + 4) * 65 + n], T[(k8 * 8 + 5) * 65 + n]);
  o.w = pack_bf2(T[(k8 * 8 + 6) * 65 + n], T[(k8 * 8 + 7) * 65 + n]);
  *(uint4*)(dst + (size_t)(n0 + n) * K + k0 + k8 * 8) = o;
}

DEV void phase0(const Params& p, const Ctx& cx0, char* smem) {
  const int NTR = 4368;
  const int total = 192 + 2 * NTR;
  for (int item = cx0.bid; item < total; item += cx0.nblk) {
    __syncthreads();
    Ctx cx = cx0; asm volatile("" : "+v"(cx.tid));
    if (item < 192) { p0_mods_item(p, cx, item, smem); continue; }
    int it = item - 192;
    int l = it / NTR, i = it % NTR;
    char* wt = p.ws + OFF_WT + (size_t)l * WT_SIZE;
    if (i < 3200) {
      p0_transpose_tile(p, cx, p.w_in + (size_t)l * 2048 * 6400, (bf16_t*)(wt + WT_IN), 2048, 6400, i / 100, i % 100, smem);
    } else if (i < 4224) {
      int j = i - 3200;
      p0_transpose_tile(p, cx, p.w_out + (size_t)l * 2048 * 2048, (bf16_t*)(wt + WT_OUT), 2048, 2048, j / 32, j % 32, smem);
    } else if (i < 4256) {
      int j = i - 4224, d = j / 16;
      p0_transpose_tile(p, cx, p.rwkv_w2 + (size_t)(l * 2 + d) * 64 * 1024, (bf16_t*)(wt + WT_W2) + (size_t)d * 1024 * 64, 64, 1024, 0, j % 16, smem);
    } else if (i < 4288) {
      int j = i - 4256, d = j / 16;
      p0_transpose_tile(p, cx, p.rwkv_a2 + (size_t)(l * 2 + d) * 64 * 1024, (bf16_t*)(wt + WT_A2) + (size_t)d * 1024 * 64, 64, 1024, 0, j % 16, smem);
    } else if (i < 4304) {
      int j = i - 4288, g = j / 4;
      p0_transpose_tile(p, cx, p.w_pool + (size_t)(l * 4 + g) * 128 * 128, (bf16_t*)(wt + WT_POOL) + (size_t)g * 128 * 128, 128, 128, (j % 4) / 2, j % 2, smem);
    } else {
      int j = i - 4304;
      p0_transpose_tile(p, cx, p.w_glu + (size_t)l * 512 * 512, (bf16_t*)(wt + WT_GLU), 512, 512, j / 8, j % 8, smem);
    }
  }
}

DEV void phase_adaln0(const Params& p, const Ctx& cx) {
  const float* mods = (const float*)(p.ws + OFF_MODS);
  bf16_t* hbuf = (bf16_t*)(p.ws + OFF_H);
  int lane = cx.tid & 63;
  int gw = cx.bid * 8 + (cx.tid >> 6), nw = cx.nblk * 8;
  for (int row = gw; row < MTOT; row += nw) {
    const float* src = row < NLAT ? p.x + (size_t)row * D : p.ctx + (size_t)(row - NLAT) * D;
    int mr = row < NLAT ? (row >> 14) : 2;
    const float* md = mods + (size_t)mr * 6144;
    float4 v[8];
    float s = 0;
#pragma unroll
    for (int i = 0; i < 8; ++i) { v[i] = *(const float4*)(src + i * 256 + lane * 4); s += v[i].x + v[i].y + v[i].z + v[i].w; }
    float mu = wave_sum(s) * (1.f / 2048.f);
    float q = 0;
#pragma unroll
    for (int i = 0; i < 8; ++i) { v[i].x -= mu; v[i].y -= mu; v[i].z -= mu; v[i].w -= mu; q += v[i].x * v[i].x + v[i].y * v[i].y + v[i].z * v[i].z + v[i].w * v[i].w; }
    float rstd = rsqrtf(wave_sum(q) * (1.f / 2048.f) + 1e-6f);
#pragma unroll
    for (int i = 0; i < 8; ++i) {
      int col = i * 256 + lane * 4;
      float4 sh = *(const float4*)(md + col), sc = *(const float4*)(md + 2048 + col);
      uint2 o;
      o.x = pack_bf2(v[i].x * rstd * (1.f + sc.x) + sh.x, v[i].y * rstd * (1.f + sc.y) + sh.y);
      o.y = pack_bf2(v[i].z * rstd * (1.f + sc.z) + sh.z, v[i].w * rstd * (1.f + sc.w) + sh.w);
      *(uint2*)(hbuf + (size_t)row * D + col) = o;
    }
  }
}

DEV void phase_finln(const Params& p, const Ctx& cx, int l) {
  const float* mods = (const float*)(p.ws + OFF_MODS);
  bf16_t* hbuf = (bf16_t*)(p.ws + OFF_H);
  float* prec = (float*)(p.ws + OFF_PREC);
  int lane = cx.tid & 63;
  int gw = cx.bid * 8 + (cx.tid >> 6), nw = cx.nblk * 8;
  const int nrows = (l == 0) ? MTOT : NLAT;
  for (int row = gw; row < nrows; row += nw) {
    float* src = row < NLAT ? p.out + (size_t)row * D : prec + (size_t)(row - NLAT) * D;
    float4 v[8];
    float s = 0;
#pragma unroll
    for (int i = 0; i < 8; ++i) { v[i] = *(const float4*)(src + i * 256 + lane * 4); s += v[i].x + v[i].y + v[i].z + v[i].w; }
    float mu = wave_sum(s) * (1.f / 2048.f);
    float q = 0;
#pragma unroll
    for (int i = 0; i < 8; ++i) { v[i].x -= mu; v[i].y -= mu; v[i].z -= mu; v[i].w -= mu; q += v[i].x * v[i].x + v[i].y * v[i].y + v[i].z * v[i].z + v[i].w * v[i].w; }
    float rstd = rsqrtf(wave_sum(q) * (1.f / 2048.f) + 1e-5f);
    float s2 = 0;
#pragma unroll
    for (int i = 0; i < 8; ++i) {
      int col = i * 256 + lane * 4;
      float4 g = *(const float4*)(p.ln_g + (size_t)l * D + col), b = *(const float4*)(p.ln_b + (size_t)l * D + col);
      v[i].x = v[i].x * rstd * g.x + b.x; v[i].y = v[i].y * rstd * g.y + b.y; v[i].z = v[i].z * rstd * g.z + b.z; v[i].w = v[i].w * rstd * g.w + b.w;
      if (row < NLAT) *(float4*)(src + col) = v[i];
      s2 += v[i].x + v[i].y + v[i].z + v[i].w;
    }
    if (l == 0) {
      int mr = row < NLAT ? (row >> 14) : 2;
      const float* md = mods + (size_t)(3 + mr) * 6144;
      float mu2 = wave_sum(s2) * (1.f / 2048.f);
      float q2 = 0;
#pragma unroll
      for (int i = 0; i < 8; ++i) { v[i].x -= mu2; v[i].y -= mu2; v[i].z -= mu2; v[i].w -= mu2; q2 += v[i].x * v[i].x + v[i].y * v[i].y + v[i].z * v[i].z + v[i].w * v[i].w; }
      float rstd2 = rsqrtf(wave_sum(q2) * (1.f / 2048.f) + 1e-6f);
#pragma unroll
      for (int i = 0; i < 8; ++i) {
        int col = i * 256 + lane * 4;
        float4 sh = *(const float4*)(md + col), sc = *(const float4*)(md + 2048 + col);
        uint2 o;
        o.x = pack_bf2(v[i].x * rstd2 * (1.f + sc.x) + sh.x, v[i].y * rstd2 * (1.f + sc.y) + sh.y);
        o.y = pack_bf2(v[i].z * rstd2 * (1.f + sc.z) + sh.z, v[i].w * rstd2 * (1.f + sc.w) + sh.w);
        *(uint2*)(hbuf + (size_t)row * D + col) = o;
      }
    }
  }
}

template <class Epi>
DEV void gemm_phase(const Params& p, const Ctx& cx, const bf16_t* __restrict__ A, const bf16_t* __restrict__ Bt, int K, int nM, int nN, char* smem, Epi epi) {
  const int tid = cx.tid, lane = tid & 63, wid = tid >> 6;
  const int wr = wid >> 2, wc = wid & 3, fr = lane & 15, fq = lane >> 4;
  const int nt = K / 64;
  const int ntiles = nM * nN;
  const int srow = tid >> 3, sc16 = tid & 7;
  const int nxcd = (cx.nblk & 7) == 0 ? 8 : 1;
  const int xcd = cx.bid % nxcd, xidx = cx.bid / nxcd, xper = cx.nblk / nxcd;
  const int t_lo = (int)(((long)ntiles * xcd) / nxcd), t_hi = (int)(((long)ntiles * (xcd + 1)) / nxcd);
  for (int tt = t_lo + xidx; tt < t_hi; tt += xper) {
    const int band = tt / (16 * nN);
    const int brows = min(16, nM - band * 16);
    const int rem = tt - band * 16 * nN;
    const int pn = rem / brows, pm = band * 16 + rem % brows;
    const int brow = pm * 256, bcol = pn * 256;
    const char* Ab = (const char*)(A + (size_t)brow * K);
    const char* Bb = (const char*)(Bt + (size_t)bcol * K);
    const unsigned voff = (unsigned)(srow * K + sc16 * 8) * 2u;
    const size_t rs = (size_t)64 * K * 2;
    f32x4 acc[8][4];
#pragma unroll
    for (int i = 0; i < 8; ++i)
#pragma unroll
      for (int j = 0; j < 4; ++j) acc[i][j] = f32x4{0.f, 0.f, 0.f, 0.f};
    uint4 ra0, ra1, ra2, ra3, rb0, rb1, rb2, rb3;
#define G_LD(ko) { const char* a_ = Ab + (size_t)(ko) * 2; const char* b_ = Bb + (size_t)(ko) * 2; \
                 ra0 = *(const uint4*)(a_ + voff); ra1 = *(const uint4*)(a_ + rs + voff); ra2 = *(const uint4*)(a_ + 2 * rs + voff); ra3 = *(const uint4*)(a_ + 3 * rs + voff); \
                 rb0 = *(const uint4*)(b_ + voff); rb1 = *(const uint4*)(b_ + rs + voff); rb2 = *(const uint4*)(b_ + 2 * rs + voff); rb3 = *(const uint4*)(b_ + 3 * rs + voff); }
#define G_ST(sp) { *(uint4*)(sp) = ra0; *(uint4*)((sp) + 64 * 144) = ra1; *(uint4*)((sp) + 128 * 144) = ra2; *(uint4*)((sp) + 192 * 144) = ra3; \
                 *(uint4*)((sp) + 36864) = rb0; *(uint4*)((sp) + 36864 + 64 * 144) = rb1; *(uint4*)((sp) + 36864 + 128 * 144) = rb2; *(uint4*)((sp) + 36864 + 192 * 144) = rb3; }
    char* const sbase = smem + srow * 144 + sc16 * 16;
    G_LD(0);
    G_ST(sbase);
    if (nt > 1) G_LD(64);
    for (int kt = 0; kt < nt; ++kt) {
      __syncthreads();
      if (kt + 1 < nt) { char* s1 = sbase + ((kt + 1) & 1) * 73728; G_ST(s1); }
      if (kt + 2 < nt) G_LD((kt + 2) * 64);
      const char* As = smem + (kt & 1) * 73728;
      const char* Bs = As + 36864;
#pragma unroll
      for (int kh = 0; kh < 2; ++kh) {
        bf16x8 bfr[4];
#pragma unroll
        for (int jn = 0; jn < 4; ++jn) bfr[jn] = *(const bf16x8*)(Bs + (wc * 64 + jn * 16 + fr) * 144 + kh * 64 + fq * 16);
#pragma unroll
        for (int i = 0; i < 8; ++i) {
          bf16x8 af = *(const bf16x8*)(As + (wr * 128 + i * 16 + fr) * 144 + kh * 64 + fq * 16);
#pragma unroll
          for (int jn = 0; jn < 4; ++jn) acc[i][jn] = __builtin_amdgcn_mfma_f32_16x16x32_f16(bfr[jn], af, acc[i][jn], 0, 0, 0);
        }
      }
    }
    __syncthreads();
#pragma unroll
    for (int i = 0; i < 8; ++i)
#pragma unroll
      for (int jn = 0; jn < 4; ++jn) epi(brow + wr * 128 + i * 16 + fr, bcol + wc * 64 + jn * 16 + fq * 4, acc[i][jn]);
  }
}

#define LAS3 __attribute__((address_space(3)))
DEV int g2_lds_byte(int r, int c) { const int st = (r >> 4) * 2 + (c >> 5), rr = r & 15, cc = c & 31, ob = rr * 64 + cc * 2; return st * 1024 + (ob ^ (((ob >> 9) & 1) << 5)); }
DEV void g2_stage_rc(int b, int& R, int& C) { const int st = b / 1024, sb = b % 1024, swz = sb ^ (((sb >> 9) & 1) << 5); R = (st >> 1) * 16 + swz / 64; C = (st & 1) * 32 + (swz % 64) / 2; }

template <class Epi>
DEV void gemm_phase2(const Params& p, const Ctx& cx, const bf16_t* __restrict__ A, const bf16_t* __restrict__ Bt, int K, int nM, int nN, char* smem, Epi epi) {
  constexpr int HTB = 128 * 64 * 2;
  LAS3 unsigned char* lds = (LAS3 unsigned char*)smem;
  const int tid = cx.tid, wid = __builtin_amdgcn_readfirstlane(tid >> 6), lane = tid & 63, wr = wid >> 2, wc = wid & 3, fr = lane & 15, fq = lane >> 4;
  const int nt = K / 64;
  const int ntiles = nM * nN;
  const int nxcd = (cx.nblk & 7) == 0 ? 8 : 1;
  const int xcd = cx.bid % nxcd, xidx = cx.bid / nxcd, xper = cx.nblk / nxcd;
  const int t_lo = (int)(((long)ntiles * xcd) / nxcd), t_hi = (int)(((long)ntiles * (xcd + 1)) / nxcd);
  auto unit_at = [&](int i, int& pm, int& pn) -> bool {
    const int tt = t_lo + xidx + i * xper;
    if (tt >= t_hi) return false;
    const int band = tt / (16 * nN);
    const int brows = min(16, nM - band * 16);
    const int rem = tt - band * 16 * nN;
    pn = rem / brows; pm = band * 16 + rem % brows;
    return true;
  };
  unsigned voffA[2], voffB[2];
#pragma unroll
  for (int i = 0; i < 2; ++i) {
    int R, C; g2_stage_rc(tid * 16 + i * 8192, R, C);
    const int rho = R & 31, Rb = (R & ~31) + 8 * ((rho & 15) >> 2) + 4 * (rho >> 4) + (rho & 3);
    voffA[i] = (unsigned)(R * K + C) * 2u; voffB[i] = (unsigned)(Rb * K + C) * 2u;
  }
  const size_t kstep = (size_t)(64 * 2);
  const size_t hstep = (size_t)128 * K * 2;
  const size_t tstep = 2 * hstep;
  const unsigned ldsw = (unsigned)wid * 1024u;
  const int aoff = g2_lds_byte(wr * 64 + fr, fq * 8), boff = g2_lds_byte(wc * 32 + fr, fq * 8);
#define G2_SA(b, h) (((b) * 2 + (h)) * HTB)
#define G2_SB(b, h) ((4 + (b) * 2 + (h)) * HTB)
#define G2_STAGE_(bufoff, gbase, vo_) do { _Pragma("unroll") for (int _i = 0; _i < 2; ++_i) \
    __builtin_amdgcn_global_load_lds((const unsigned*)((const char*)(gbase) + vo_[_i]), (LAS3 unsigned*)(lds + (bufoff) + ldsw + _i * 8192), 16, 0, 0); } while (0)
#define G2_STAGE(bufoff, gbase) G2_STAGE_(bufoff, gbase, voffA)
#define G2_STAGEB(bufoff, gbase) G2_STAGE_(bufoff, gbase, voffB)
#define G2_LDA(dst, b, h) do { _Pragma("unroll") for (int m = 0; m < 4; ++m) _Pragma("unroll") for (int k = 0; k < 2; ++k) dst[m][k] = *(const LAS3 bf16x8*)(lds + G2_SA(b, h) + aoff + m * 2048 + k * 1024); } while (0)
#define G2_LDB(dst, b, h) do { _Pragma("unroll") for (int n = 0; n < 2; ++n) _Pragma("unroll") for (int k = 0; k < 2; ++k) dst[n][k] = *(const LAS3 bf16x8*)(lds + G2_SB(b, h) + boff + n * 2048 + k * 1024); } while (0)
#define G2_MMA(ai, bj, At_, Bt_) do { __builtin_amdgcn_s_setprio(1); _Pragma("unroll") for (int m = 0; m < 4; ++m) _Pragma("unroll") for (int n = 0; n < 2; ++n) _Pragma("unroll") for (int k = 0; k < 2; ++k) \
    acc[ai][bj][m][n] = __builtin_amdgcn_mfma_f32_16x16x32_f16(Bt_[n][k], At_[m][k], acc[ai][bj][m][n], 0, 0, 0); __builtin_amdgcn_s_setprio(0); } while (0)
#define G2_WAIT_V(n) asm volatile("s_waitcnt vmcnt(" #n ")" ::: "memory")
#define G2_WAIT_L(n) asm volatile("s_waitcnt lgkmcnt(" #n ")" ::: "memory")
#define G2_BAR __builtin_amdgcn_s_barrier()
#define G2_SCHED __builtin_amdgcn_sched_barrier(0)
  int cpm, cpn, npm = 0, npn = 0, ui = 0;
  if (!unit_at(0, cpm, cpn)) return;
  f32x4 acc[2][2][4][2];
#pragma unroll
  for (int a = 0; a < 2; ++a)
#pragma unroll
    for (int b = 0; b < 2; ++b)
#pragma unroll
      for (int m = 0; m < 4; ++m)
#pragma unroll
        for (int n = 0; n < 2; ++n) acc[a][b][m][n] = f32x4{0.f, 0.f, 0.f, 0.f};
  bf16x8 At[4][2], B0[2][2], B1[2][2];
  const char* cA = (const char*)A + (size_t)cpm * tstep;
  const char* cB = (const char*)Bt + (size_t)cpn * tstep;
  G2_STAGEB(G2_SB(0, 0), cB); G2_STAGE(G2_SA(0, 0), cA); G2_STAGEB(G2_SB(0, 1), cB + hstep); G2_STAGE(G2_SA(0, 1), cA + hstep);
  if (wr == 1) G2_BAR;
  G2_WAIT_V(4); G2_BAR;
  G2_STAGEB(G2_SB(1, 0), cB + kstep); G2_STAGE(G2_SA(1, 0), cA + kstep); G2_STAGEB(G2_SB(1, 1), cB + hstep + kstep);
  G2_WAIT_V(6); G2_BAR;
  for (;;) {
    const bool has_next = unit_at(ui + 1, npm, npn);
    const char* nA = has_next ? (const char*)A + (size_t)npm * tstep : cA;
    const char* nB = has_next ? (const char*)Bt + (size_t)npn * tstep : cB;
    for (int t = 0; t < nt; t += 2) {
      const bool last = (t == nt - 2);
      const char* a1 = cA + (size_t)(t + 1) * kstep;
      const char* a2 = last ? nA : cA + (size_t)(t + 2) * kstep;
      const char* b2 = last ? nB : cB + (size_t)(t + 2) * kstep;
      const char* a3 = a2 + kstep;
      const char* b3 = b2 + kstep;
      G2_LDB(B0, 0, 0); G2_SCHED; G2_LDA(At, 0, 0); G2_STAGE(G2_SA(1, 1), a1 + hstep);
      G2_WAIT_L(8); G2_BAR; G2_WAIT_L(0); G2_MMA(0, 0, At, B0); G2_BAR; G2_SCHED;
      G2_LDB(B1, 0, 1); G2_STAGEB(G2_SB(0, 0), b2);
      G2_BAR; G2_WAIT_L(0); G2_MMA(0, 1, At, B1); G2_BAR;
      G2_LDA(At, 0, 1); G2_STAGE(G2_SA(0, 0), a2);
      G2_BAR; G2_WAIT_L(0); G2_MMA(1, 0, At, B0); G2_BAR; G2_SCHED;
      G2_STAGEB(G2_SB(0, 1), b2 + hstep);
      G2_WAIT_V(6); G2_BAR; G2_MMA(1, 1, At, B1); G2_BAR;
      G2_LDB(B0, 1, 0); G2_SCHED; G2_LDA(At, 1, 0); G2_STAGE(G2_SA(0, 1), a2 + hstep);
      G2_WAIT_L(8); G2_BAR; G2_WAIT_L(0); G2_MMA(0, 0, At, B0); G2_BAR; G2_SCHED;
      G2_LDB(B1, 1, 1); G2_STAGEB(G2_SB(1, 0), b3);
      G2_BAR; G2_WAIT_L(0); G2_MMA(0, 1, At, B1); G2_BAR;
      G2_LDA(At, 1, 1); G2_STAGE(G2_SA(1, 0), a3);
      G2_BAR; G2_WAIT_L(0); G2_MMA(1, 0, At, B0); G2_BAR; G2_SCHED;
      G2_STAGEB(G2_SB(1, 1), b3 + hstep);
      G2_WAIT_V(6); G2_BAR; G2_MMA(1, 1, At, B1); G2_BAR;
    }
    {
      const int row0 = cpm * 256 + wr * 64 + fr, col0 = cpn * 256 + wc * 32 + 8 * fq;
#pragma unroll
      for (int ai = 0; ai < 2; ++ai)
#pragma unroll
        for (int m = 0; m < 4; ++m)
#pragma unroll
          for (int bj = 0; bj < 2; ++bj) epi(row0 + ai * 128 + m * 16, col0 + bj * 128, acc[ai][bj][m][0], acc[ai][bj][m][1]);
    }
    if (!has_next) break;
#pragma unroll
    for (int a = 0; a < 2; ++a)
#pragma unroll
      for (int b = 0; b < 2; ++b)
#pragma unroll
        for (int m = 0; m < 4; ++m)
#pragma unroll
          for (int n = 0; n < 2; ++n) acc[a][b][m][n] = f32x4{0.f, 0.f, 0.f, 0.f};
    cpm = npm; cpn = npn; cA = nA; cB = nB; ++ui;
  }
  G2_WAIT_V(0);
  if (wr == 0) G2_BAR;
  G2_BAR;
#undef G2_SA
#undef G2_SB
#undef G2_STAGE
#undef G2_STAGEB
#undef G2_STAGE_
#undef G2_LDA
#undef G2_LDB
#undef G2_MMA
#undef G2_WAIT_V
#undef G2_WAIT_L
#undef G2_BAR
#undef G2_SCHED
}

template <int K, int NT, class Epi>
DEV void small_gemm(const Params& p, const Ctx& cx, const char* As, int astride, const bf16_t* __restrict__ Bt, int n0, Epi epi) {
  const int lane = cx.tid & 63, fr = lane & 15, fq = lane >> 4;
  f32x4 acc[4][NT];
#pragma unroll
  for (int i = 0; i < 4; ++i)
#pragma unroll
    for (int j = 0; j < NT; ++j) acc[i][j] = f32x4{0.f, 0.f, 0.f, 0.f};
#pragma unroll 2
  for (int k0 = 0; k0 < K; k0 += 32) {
    bf16x8 af[4];
#pragma unroll
    for (int i = 0; i < 4; ++i) af[i] = *(const bf16x8*)(As + (i * 16 + fr) * astride + (k0 + fq * 8) * 2);
#pragma unroll
    for (int jn = 0; jn < NT; ++jn) {
      bf16x8 bf = *(const bf16x8*)(Bt + (size_t)(n0 + jn * 16 + fr) * K + k0 + fq * 8);
#pragma unroll
      for (int i = 0; i < 4; ++i) acc[i][jn] = __builtin_amdgcn_mfma_f32_16x16x32_f16(bf, af[i], acc[i][jn], 0, 0, 0);
    }
  }
#pragma unroll
  for (int i = 0; i < 4; ++i)
#pragma unroll
    for (int jn = 0; jn < NT; ++jn) epi(i * 16 + fr, n0 + jn * 16 + fq * 4, acc[i][jn]);
}

struct S5P { float ar, ai, br, bi; };
DEV S5P s5_params(const Params& p, const Ctx& cx, int l, int d, int g, int lane) {
  int idx = ((l * 2 + d) * 32 + g) * 64 + lane;
  float lr = fminf(p.s5_lam_re[idx], -1e-4f), li = p.s5_lam_im[idx];
  float step = expf(p.s5_log_step[(l * 2 + d) * 32 + g]);
  float xr = lr * step, xi = li * step;
  float e = expf(xr), cs = cosf(xi), sn = sinf(xi);
  S5P r;
  r.ar = e * cs; r.ai = e * sn;
  float sh = sinf(0.5f * xi);
  float nr = expm1f(xr) * cs - 2.f * sh * sh, ni = e * sn;
  float inv = 1.f / (lr * lr + li * li);
  r.br = (nr * lr + ni * li) * inv;
  r.bi = (ni * lr - nr * li) * inv;
  return r;
}

DEV void s5_load_u(const h16* zrest, int rowbase, int g, char* ulds, int lane) {
#pragma unroll
  for (int i = 0; i < 8; ++i) {
    int e = i * 64 + lane;
    int r = e >> 1, hf = e & 1;
    uint4 v = *(const uint4*)(zrest + (size_t)(rowbase + r) * ZR + g * 16 + hf * 8);
    *(uint4*)(ulds + r * 32 + hf * 16) = v;
  }
  lds_fence();
}

DEV int s5_rowbase(int b, int c) { return c == 0 ? NLAT + b * 256 : b * 16384 + (c - 1) * 256; }

DEV void s5_pass1_unit(const Params& p, const Ctx& cx, int l, int unit, char* wl, int lane) {
  int c = unit % 65, bg = unit / 65, g = bg & 31, b = bg >> 5;
  const h16* zrest = (const h16*)(p.ws + OFF_ZREST);
  float2* F = (float2*)(p.ws + OFF_S5F);
  s5_load_u(zrest, s5_rowbase(b, c), g, wl, lane);
  float Br[16], Bi[16];
  {
    const float* pr = p.s5_b_re + ((size_t)(l * 32 + g) * 64 + lane) * 16;
    const float* pi = p.s5_b_im + ((size_t)(l * 32 + g) * 64 + lane) * 16;
#pragma unroll
    for (int i = 0; i < 16; i += 4) {
      float4 a = *(const float4*)(pr + i), bq = *(const float4*)(pi + i);
      Br[i] = a.x; Br[i + 1] = a.y; Br[i + 2] = a.z; Br[i + 3] = a.w;
      Bi[i] = bq.x; Bi[i + 1] = bq.y; Bi[i + 2] = bq.z; Bi[i + 3] = bq.w;
    }
  }
  S5P pf = s5_params(p, cx, l, 0, g, lane), pb = s5_params(p, cx, l, 1, g, lane);
  float xr = 0, xi = 0, yr = 0, yi = 0, pwr = 1.f, pwi = 0.f;
#pragma unroll 4
  for (int t = 0; t < 256; ++t) {
    h16x8 u0 = *(const h16x8*)(wl + t * 32), u1 = *(const h16x8*)(wl + t * 32 + 16);
    float br = 0, bi = 0;
#pragma unroll
    for (int i = 0; i < 8; ++i) { float u = (float)u0[i]; br = fmaf(u, Br[i], br); bi = fmaf(u, Bi[i], bi); }
#pragma unroll
    for (int i = 0; i < 8; ++i) { float u = (float)u1[i]; br = fmaf(u, Br[8 + i], br); bi = fmaf(u, Bi[8 + i], bi); }
    float vr = pf.br * br - pf.bi * bi, vi = pf.br * bi + pf.bi * br;
    float nxr = pf.ar * xr - pf.ai * xi + vr, nxi = pf.ar * xi + pf.ai * xr + vi;
    xr = nxr; xi = nxi;
    float wr_ = pb.br * br - pb.bi * bi, wi_ = pb.br * bi + pb.bi * br;
    yr += pwr * wr_ - pwi * wi_; yi += pwr * wi_ + pwi * wr_;
    float npr = pwr * pb.ar - pwi * pb.ai, npi = pwr * pb.ai + pwi * pb.ar;
    pwr = npr; pwi = npi;
  }
  size_t fi = (((size_t)(b * 32 + g) * 65 + c) * 2) * 64 + lane;
  F[fi] = make_float2(xr, xi);
  F[fi + 64] = make_float2(yr, yi);
}

DEV void s5_pass3_unit(const Params& p, const Ctx& cx, int l, int unit, char* wl, int lane) {
  int c = unit % 65, bg = unit / 65, g = bg & 31, b = bg >> 5;
  const int fr = lane & 15, fq = lane >> 4;
  const h16* zrest = (const h16*)(p.ws + OFF_ZREST);
  const float2* F = (const float2*)(p.ws + OFF_S5F);
  float* S5Y = (float*)(p.ws + OFF_S5Y);
  const int rowbase = s5_rowbase(b, c);
  char* ulds = wl;
  char* tile = wl + 8192;
  s5_load_u(zrest, rowbase, g, ulds, lane);
  float Br[16], Bi[16];
  {
    const float* pr = p.s5_b_re + ((size_t)(l * 32 + g) * 64 + lane) * 16;
    const float* pi = p.s5_b_im + ((size_t)(l * 32 + g) * 64 + lane) * 16;
#pragma unroll
    for (int i = 0; i < 16; i += 4) {
      float4 a = *(const float4*)(pr + i), bq = *(const float4*)(pi + i);
      Br[i] = a.x; Br[i + 1] = a.y; Br[i + 2] = a.z; Br[i + 3] = a.w;
      Bi[i] = bq.x; Bi[i + 1] = bq.y; Bi[i + 2] = bq.z; Bi[i + 3] = bq.w;
    }
  }
  const float dsk = p.s5_d[(size_t)l * 512 + g * 16 + fr];
  const size_t fbase = ((size_t)(b * 32 + g) * 65) * 2 * 64 + lane;
#pragma unroll 1
  for (int d = 0; d < 2; ++d) {
    S5P pp = s5_params(p, cx, l, d, g, lane);
    float qr = pp.ar, qi = pp.ai;
#pragma unroll
    for (int i = 0; i < 8; ++i) { float t = qr * qr - qi * qi; qi = 2.f * qr * qi; qr = t; }
    float xr = 0, xi = 0;
    if (d == 0) {
      for (int cc = 0; cc < c; ++cc) {
        float2 f = F[fbase + (size_t)(cc * 2 + 0) * 64];
        float t = qr * xr - qi * xi + f.x; xi = qr * xi + qi * xr + f.y; xr = t;
      }
    } else if (c > 0) {
      float2 f0 = F[fbase + (size_t)(0 * 2 + 1) * 64];
      xr = f0.x; xi = f0.y;
      for (int cc = 64; cc > c; --cc) {
        float2 f = F[fbase + (size_t)(cc * 2 + 1) * 64];
        float t = qr * xr - qi * xi + f.x; xi = qr * xi + qi * xr + f.y; xr = t;
      }
    }
    bf16x8 chi[4], clo[4];
    {
      const float* cr = p.s5_c_re + ((size_t)((l * 2 + d) * 32 + g) * 16 + fr) * 64;
      const float* ci = p.s5_c_im + ((size_t)((l * 2 + d) * 32 + g) * 16 + fr) * 64;
#pragma unroll
      for (int ks = 0; ks < 4; ++ks) {
        float4 a = *(const float4*)(cr + ks * 16 + fq * 4), bq = *(const float4*)(ci + ks * 16 + fq * 4);
        float vals[8] = {a.x, -bq.x, a.y, -bq.y, a.z, -bq.z, a.w, -bq.w};
#pragma unroll
        for (int j = 0; j < 8; ++j) {
          h16 hh = (h16)vals[j];
          chi[ks][j] = hh;
          clo[ks][j] = (h16)(vals[j] - (float)hh);
        }
      }
    }
#pragma unroll 1
    for (int sb = 0; sb < 16; ++sb) {
      const int sub = d == 0 ? sb : 15 - sb;
#pragma unroll 4
      for (int q = 0; q < 16; ++q) {
        const int tt = d == 0 ? q : 15 - q;
        const int t = sub * 16 + tt;
        h16x8 u0 = *(const h16x8*)(ulds + t * 32), u1 = *(const h16x8*)(ulds + t * 32 + 16);
        float br = 0, bi = 0;
#pragma unroll
        for (int i = 0; i < 8; ++i) { float u = (float)u0[i]; br = fmaf(u, Br[i], br); bi = fmaf(u, Bi[i], bi); }
#pragma unroll
        for (int i = 0; i < 8; ++i) { float u = (float)u1[i]; br = fmaf(u, Br[8 + i], br); bi = fmaf(u, Bi[8 + i], bi); }
        float vr = pp.br * br - pp.bi * bi, vi = pp.br * bi + pp.bi * br;
        float nxr = pp.ar * xr - pp.ai * xi + vr, nxi = pp.ar * xi + pp.ai * xr + vi;
        xr = nxr; xi = nxi;
        h16x2 hv2 = {(h16)xr, (h16)xi};
        float lr_ = xr - (float)hv2[0], li_ = xi - (float)hv2[1];
        *(unsigned*)(tile + tt * 272 + lane * 4) = __builtin_bit_cast(unsigned, hv2);
        *(unsigned*)(tile + 4352 + tt * 272 + lane * 4) = pack_bf2(lr_, li_);
      }
      lds_fence();
      f32x4 acc = f32x4{0.f, 0.f, 0.f, 0.f};
#pragma unroll
      for (int ks = 0; ks < 4; ++ks) {
        bf16x8 ah = *(const bf16x8*)(tile + fr * 272 + ks * 64 + fq * 16);
        bf16x8 alo = *(const bf16x8*)(tile + 4352 + fr * 272 + ks * 64 + fq * 16);
        acc = __builtin_amdgcn_mfma_f32_16x16x32_f16(ah, chi[ks], acc, 0, 0, 0);
        acc = __builtin_amdgcn_mfma_f32_16x16x32_f16(alo, chi[ks], acc, 0, 0, 0);
        acc = __builtin_amdgcn_mfma_f32_16x16x32_f16(ah, clo[ks], acc, 0, 0, 0);
      }
      lds_fence();
#pragma unroll
      for (int r = 0; r < 4; ++r) {
        int tl = sub * 16 + fq * 4 + r;
        float* yp = S5Y + (size_t)(rowbase + tl) * 512 + g * 16 + fr;
        if (d == 0) {
          float u = (float)*(const h16*)(ulds + tl * 32 + fr * 2);
          *yp = acc[r] + dsk * u;
        } else {
          *yp = gelu_f(*yp + acc[r]);
        }
      }
    }
  }
}

DEV void prep_item(const Params& p, const Ctx& cx, int l, int item, char* smem) {
  const int tile = item >> 2, q = item & 3;
  const int row0 = tile * 64;
  const int tid = cx.tid;
  const h16* zc = (const h16*)(p.ws + OFF_REG2);
  h16* SC = (h16*)(p.ws + OFF_SCAN);
  const char* wt = p.ws + OFF_WT + (size_t)l * WT_SIZE;
  {
    const int d = q >> 1, isA = q & 1;
    const int coff = isA ? 3200 + d * 64 : 3072 + d * 64;
    int tok = tid >> 3, c8 = tid & 7;
    h16x8 cv = *(const h16x8*)(zc + (size_t)(row0 + tok) * ZC + coff + c8 * 8);
    float f[8];
#pragma unroll
    for (int j = 0; j < 8; ++j) { f[j] = (float)cv[j]; if (!isA) f[j] = tanh_f(f[j]); }
    uint4 o;
    o.x = pack_bf2(f[0], f[1]); o.y = pack_bf2(f[2], f[3]); o.z = pack_bf2(f[4], f[5]); o.w = pack_bf2(f[6], f[7]);
    *(uint4*)(smem + tok * 144 + c8 * 16) = o;
    __syncthreads();
    const bf16_t* Bt = (const bf16_t*)(wt + (isA ? WT_A2 : WT_W2)) + (size_t)d * 1024 * 64;
    const float* biasw = p.rwkv_w0 + (size_t)(l * 2 + d) * 1024;
    const float* biasa = p.rwkv_a0 + (size_t)(l * 2 + d) * 1024;
    h16* dst = SC + (size_t)(isA ? 4 + d : 6 + d) * ARR;
#pragma unroll 1
    for (int hf = 0; hf < 2; ++hf) small_gemm<64, 4>(p, cx, smem, 144, Bt, (tid >> 6) * 128 + hf * 64, [&](int m, int n, f32x4 v) {
      float4 bbw = *(const float4*)(biasw + n), bba = *(const float4*)(biasa + n);
      float4 bb = isA ? bba : bbw;
      float r0 = sigmoid_f(v[0] + bb.x), r1 = sigmoid_f(v[1] + bb.y), r2 = sigmoid_f(v[2] + bb.z), r3 = sigmoid_f(v[3] + bb.w);
      if (!isA) { r0 = __expf(-DECAY_SCALE * r0); r1 = __expf(-DECAY_SCALE * r1); r2 = __expf(-DECAY_SCALE * r2); r3 = __expf(-DECAY_SCALE * r3); }
      h16x4 o4 = {(h16)r0, (h16)r1, (h16)r2, (h16)r3};
      *(h16x4*)(dst + (size_t)(row0 + m) * 1024 + n) = o4;
    });
  }
  {
    const float* cw = p.conv_rkv + (size_t)l * 3 * 3072;
    const int grp = tid & 7, hh = (tid >> 3) & 3;
    const int c0 = (4 * q + hh) * 64 + grp * 8;
    float cwt[3][3][8];
#pragma unroll
    for (int s = 0; s < 3; ++s)
#pragma unroll
      for (int tp = 0; tp < 3; ++tp)
#pragma unroll
        for (int j = 0; j < 8; j += 4) {
          float4 a = *(const float4*)(cw + tp * 3072 + s * 1024 + c0 + j);
          cwt[s][tp][j] = a.x; cwt[s][tp][j + 1] = a.y; cwt[s][tp][j + 2] = a.z; cwt[s][tp][j + 3] = a.w;
        }
    float kkw[8];
#pragma unroll
    for (int j = 0; j < 8; j += 4) {
      float4 kq = *(const float4*)(p.rwkv_k_k + (size_t)l * 1024 + c0 + j);
      kkw[j] = kq.x; kkw[j + 1] = kq.y; kkw[j + 2] = kq.z; kkw[j + 3] = kq.w;
    }
#pragma unroll 1
    for (int it = 0; it < 4; ++it) {
      const int tok = (tid >> 5) + it * 16;
      const int row = row0 + tok;
      bool hasp, hasn;
      if (row < NLAT) { hasp = (row & 16383) != 0; hasn = (row & 16383) != 16383; }
      else { hasp = (row & 255) != 0; hasn = (row & 255) != 255; }
      const size_t off = (size_t)row * 1024 + c0;
      const h16* zp = zc + (size_t)row * ZC + c0;
      const h16* zpp = hasp ? zp - ZC : zp;
      const h16* zpn = hasn ? zp + ZC : zp;
      h16x8 cur[3], prv[3], nxt[3];
#pragma unroll
      for (int s = 0; s < 3; ++s) { cur[s] = *(const h16x8*)(zp + s * 1024); prv[s] = *(const h16x8*)(zpp + s * 1024); nxt[s] = *(const h16x8*)(zpn + s * 1024); }
      const float fp = hasp ? 1.f : 0.f, fn = hasn ? 1.f : 0.f;
      float kv[8];
#pragma unroll
      for (int s = 0; s < 3; ++s) {
        h16x8 o;
#pragma unroll
        for (int j = 0; j < 8; ++j) {
          float ov = cwt[s][0][j] * (fp * (float)prv[s][j]) + cwt[s][1][j] * (float)cur[s][j] + cwt[s][2][j] * (fn * (float)nxt[s][j]);
          o[j] = (h16)ov;
          if (s == 1) kv[j] = ov;
        }
        *(h16x8*)(SC + (size_t)s * ARR + off) = o;
      }
      float kk[8], ss = 0;
#pragma unroll
      for (int j = 0; j < 8; ++j) { kk[j] = kv[j] * kkw[j]; ss += kk[j] * kk[j]; }
      ss = allreduce8(ss);
      float inv = rcp_f(fmaxf(sqrtf(ss), 1e-12f));
      h16x8 o;
#pragma unroll
      for (int j = 0; j < 8; ++j) o[j] = (h16)(kk[j] * inv);
      *(h16x8*)(SC + 3 * ARR + off) = o;
    }
  }
}

DEV void phase_prep(const Params& p, const Ctx& cx0, int l, char* smem) {
  const int NPREP = 520 * 4, NS5 = 520;
  const Ctx& cx_ = cx0;
  for (int item = cx_.bid; item < NPREP + NS5; item += cx_.nblk) {
    __syncthreads();
    Ctx cx = cx0; asm volatile("" : "+v"(cx.tid));
    const int lane = cx.tid & 63, wid = cx.tid >> 6;
#ifndef NO_PREPITEM
    if (item < NPREP) prep_item(p, cx, l, item, smem);
    else
#endif
#ifndef NO_S5P1
      s5_pass1_unit(p, cx, l, (item - NPREP) * 8 + wid, smem + wid * 8192, lane);
#else
    {}
#endif
  }
}

typedef unsigned u2v __attribute__((ext_vector_type(2)));
struct RG { u2v w, a, kk, k, r; h16 v; };

constexpr int RW_NSLOT = 8, RW_SLOTB = 3072;
constexpr int RW_FLAGS = RW_NSLOT * RW_SLOTB;
constexpr int RW_NG = 16640 / 4;
typedef float f4v __attribute__((ext_vector_type(4)));

#define RW_RLO(gq, rlo)                                                            \
  {                                                                                \
    const int gg = (gq) < RW_NG ? (gq) : RW_NG - 1;                                \
    const int q0_ = gg * 4;                                                        \
    const int isl = q0_ >= 256;                                                    \
    const int base_ = isl ? b * 16384 : NLAT + b * 256;                            \
    const int t0_ = isl ? q0_ - 256 : q0_;                                         \
    const int last_ = isl ? 16383 : 255;                                           \
    rlo = base_ + (d ? last_ - t0_ - 3 : t0_);                                     \
  }

DEV void rwkv_helper(const Params& p, const Ctx& cx, int l, int unit, int lane, char* ring) {
  const int d = unit & 1, h = (unit >> 1) & 15, b = unit >> 5;
  const int j = lane >> 4, s = lane & 15;
  const h16* SC = (const h16*)(p.ws + OFF_SCAN);
  const char* pR = (const char*)(SC + 0 * ARR + h * 64);
  const char* pK = (const char*)(SC + 1 * ARR + h * 64);
  const char* pV = (const char*)(SC + 2 * ARR + h * 64);
  const char* pKK = (const char*)(SC + 3 * ARR + h * 64);
  const char* pA = (const char*)(SC + (size_t)(4 + d) * ARR + h * 64);
  const char* pW = (const char*)(SC + (size_t)(6 + d) * ARR + h * 64);
  const int jm = d ? 3 - j : j;
  const unsigned vo0 = (unsigned)(jm * 2048 + s * 8);
  f4v ka4, om4;
  {
    float4 t = *(const float4*)(p.rwkv_k_a + (size_t)l * 1024 + h * 64 + 4 * s);
    ka4 = f4v{t.x, t.y, t.z, t.w};
    om4 = 1.f - ka4;
  }
  struct RGH { u2v w, a, kk, k, r, v; };
  RGH q0, q1, q2, q3, q4, q5, q6, q7;
  const unsigned wofs = (unsigned)(j * 128 + s * 8);
  const unsigned vwofs = (unsigned)(2560 + j * 128 + s * 8);
  LAS3 volatile int* pflag = (LAS3 volatile int*)(ring + RW_FLAGS);
  LAS3 volatile int* cflag = (LAS3 volatile int*)(ring + RW_FLAGS + 64);
  int cmin = 0;
#define CV4(uv) __builtin_convertvector(__builtin_bit_cast(h16x4, uv), f4v)
#define RH_LOAD(q, gq)                                                             \
  {                                                                                \
    int rlo; RW_RLO(gq, rlo);                                                      \
    unsigned vo = vo0; asm volatile("" : "+v"(vo));                                \
    const size_t off = (size_t)rlo * 2048;                                         \
    q.w = *(const u2v*)(pW + off + vo); q.a = *(const u2v*)(pA + off + vo);        \
    q.kk = *(const u2v*)(pKK + off + vo); q.k = *(const u2v*)(pK + off + vo);      \
    q.r = *(const u2v*)(pR + off + vo); q.v = *(const u2v*)(pV + off + vo);        \
  }
#define RH_STEP(q, gq)                                                             \
  {                                                                                \
    if ((gq) >= RW_NSLOT && cmin < (gq) - RW_NSLOT + 1) {                          \
      do {                                                                         \
        const int c0_ = cflag[0], c1_ = cflag[1], c2_ = cflag[2], c3_ = cflag[3];  \
        cmin = __builtin_amdgcn_readfirstlane(min(min(c0_, c1_), min(c2_, c3_)));  \
        if (cmin < (gq) - RW_NSLOT + 1) __builtin_amdgcn_s_sleep(1);               \
      } while (cmin < (gq) - RW_NSLOT + 1);                                        \
    }                                                                              \
    asm volatile("" ::: "memory");                                                 \
    char* sl = ring + ((gq) % RW_NSLOT) * RW_SLOTB;                                \
    const f4v a_ = CV4(q.a), kk_ = CV4(q.kk);                                      \
    const f4v kka_ = kk_ * a_, kd_ = CV4(q.k) * (a_ * ka4 + om4);                  \
    *(u2v*)(sl + 0 * 512 + wofs) = q.w;                                            \
    *(u2v*)(sl + 1 * 512 + wofs) = q.kk;                                           \
    *(u2v*)(sl + 2 * 512 + wofs) = __builtin_bit_cast(u2v, __builtin_convertvector(kka_, h16x4)); \
    *(u2v*)(sl + 3 * 512 + wofs) = __builtin_bit_cast(u2v, __builtin_convertvector(kd_, h16x4));  \
    *(u2v*)(sl + 4 * 512 + wofs) = q.r;                                            \
    *(u2v*)(sl + vwofs) = q.v;                                                     \
    asm volatile("s_waitcnt lgkmcnt(0)" ::: "memory");     \
    *pflag = (gq) + 1;                                                             \
  }
  RH_LOAD(q0, 0); RH_LOAD(q1, 1); RH_LOAD(q2, 2); RH_LOAD(q3, 3); RH_LOAD(q4, 4); RH_LOAD(q5, 5); RH_LOAD(q6, 6); RH_LOAD(q7, 7);
#pragma unroll 1
  for (int g = 0; g < RW_NG; g += 8) {
    RH_STEP(q0, g); RH_LOAD(q0, g + 8); __builtin_amdgcn_sched_barrier(0);
    RH_STEP(q1, g + 1); RH_LOAD(q1, g + 9); __builtin_amdgcn_sched_barrier(0);
    RH_STEP(q2, g + 2); RH_LOAD(q2, g + 10); __builtin_amdgcn_sched_barrier(0);
    RH_STEP(q3, g + 3); RH_LOAD(q3, g + 11); __builtin_amdgcn_sched_barrier(0);
    RH_STEP(q4, g + 4); RH_LOAD(q4, g + 12); __builtin_amdgcn_sched_barrier(0);
    RH_STEP(q5, g + 5); RH_LOAD(q5, g + 13); __builtin_amdgcn_sched_barrier(0);
    RH_STEP(q6, g + 6); RH_LOAD(q6, g + 14); __builtin_amdgcn_sched_barrier(0);
    RH_STEP(q7, g + 7); RH_LOAD(q7, g + 15); __builtin_amdgcn_sched_barrier(0);
  }
#undef RH_LOAD
#undef RH_STEP
#undef CV4
}

DEV void rwkv_consumer(const Params& p, const Ctx& cx, int l, int task, int lane, const char* ring, int widx) {
  const int unit = task >> 4, d = unit & 1, h = (unit >> 1) & 15, b = unit >> 5;
  const int j = lane >> 4, s = lane & 15;
  const int myrow = (task & 15) * 4 + j;
  char* pO = (char*)((h16*)(p.ws + OFF_REG2) + (size_t)d * ARR + h * 64);
  const int sm = d ? 3 - (s & 3) : (s & 3);
  const unsigned vov0 = (unsigned)(sm * 2048 + myrow * 2);
  const unsigned rofs = (unsigned)(s * 8);
  const unsigned vrofs = (unsigned)(2560 + myrow * 2);
  LAS3 volatile int* pflag = (LAS3 volatile int*)(ring + RW_FLAGS);
  LAS3 volatile int* cflag = (LAS3 volatile int*)(ring + RW_FLAGS + 64) + widx;
  float S0 = 0.f, S1 = 0.f, S2 = 0.f, S3 = 0.f;
  int pseen = 0, slotc = 0;
#pragma unroll 1
  for (int g = 0; g < RW_NG; ++g) {
    if (pseen <= g) {
      do {
        pseen = __builtin_amdgcn_readfirstlane(*pflag);
        if (pseen <= g) __builtin_amdgcn_s_sleep(1);
      } while (pseen <= g);
    }
    asm volatile("" ::: "memory");
    const char* sl = ring + slotc * RW_SLOTB;
    float dres[4];
#pragma unroll
    for (int u = 0; u < 4; ++u) {
      const u2v w_ = *(const u2v*)(sl + 0 * 512 + u * 128 + rofs);
      const u2v kk_ = *(const u2v*)(sl + 1 * 512 + u * 128 + rofs);
      const u2v kka_ = *(const u2v*)(sl + 2 * 512 + u * 128 + rofs);
      const u2v kd_ = *(const u2v*)(sl + 3 * 512 + u * 128 + rofs);
      const u2v r_ = *(const u2v*)(sl + 4 * 512 + u * 128 + rofs);
      const unsigned vj = *(const unsigned short*)(sl + u * 128 + vrofs);
      float pa, pb;
      asm("v_fma_mix_f32 %0, %2, %6, 0 op_sel:[0,0,0] op_sel_hi:[0,1,0]\n\t"
          "v_fma_mix_f32 %1, %4, %7, 0 op_sel:[0,0,0] op_sel_hi:[0,1,0]\n\t"
          "v_fma_mix_f32 %0, %3, %6, %0 op_sel:[0,1,0] op_sel_hi:[0,1,0]\n\t"
          "v_fma_mix_f32 %1, %5, %7, %1 op_sel:[0,1,0] op_sel_hi:[0,1,0]"
          : "=&v"(pa), "=&v"(pb) : "v"(S0), "v"(S1), "v"(S2), "v"(S3), "v"(kk_.x), "v"(kk_.y));
      const float d1 = allreduce16(pa + pb);
      float ea, eb, t0, t1, t2, t3;
      asm("v_fma_mix_f32 %6, %18, %12, 0 op_sel:[0,0,0] op_sel_hi:[1,1,0]\n\t"
          "v_fma_mix_f32 %7, %18, %12, 0 op_sel:[0,1,0] op_sel_hi:[1,1,0]\n\t"
          "v_fma_mix_f32 %8, %18, %13, 0 op_sel:[0,0,0] op_sel_hi:[1,1,0]\n\t"
          "v_fma_mix_f32 %9, %18, %13, 0 op_sel:[0,1,0] op_sel_hi:[1,1,0]\n\t"
          "v_fma_mix_f32 %0, %0, %10, %6 op_sel:[0,0,0] op_sel_hi:[0,1,0]\n\t"
          "v_fma_mix_f32 %1, %1, %10, %7 op_sel:[0,1,0] op_sel_hi:[0,1,0]\n\t"
          "v_fma_mix_f32 %2, %2, %11, %8 op_sel:[0,0,0] op_sel_hi:[0,1,0]\n\t"
          "v_fma_mix_f32 %3, %3, %11, %9 op_sel:[0,1,0] op_sel_hi:[0,1,0]\n\t"
          "v_fma_mix_f32 %0, -%19, %14, %0 op_sel:[0,0,0] op_sel_hi:[0,1,0]\n\t"
          "v_fma_mix_f32 %1, -%19, %14, %1 op_sel:[0,1,0] op_sel_hi:[0,1,0]\n\t"
          "v_fma_mix_f32 %2, -%19, %15, %2 op_sel:[0,0,0] op_sel_hi:[0,1,0]\n\t"
          "v_fma_mix_f32 %3, -%19, %15, %3 op_sel:[0,1,0] op_sel_hi:[0,1,0]\n\t"
          "v_fma_mix_f32 %4, %0, %16, 0 op_sel:[0,0,0] op_sel_hi:[0,1,0]\n\t"
          "v_fma_mix_f32 %5, %2, %17, 0 op_sel:[0,0,0] op_sel_hi:[0,1,0]\n\t"
          "v_fma_mix_f32 %4, %1, %16, %4 op_sel:[0,1,0] op_sel_hi:[0,1,0]\n\t"
          "v_fma_mix_f32 %5, %3, %17, %5 op_sel:[0,1,0] op_sel_hi:[0,1,0]"
          : "+v"(S0), "+v"(S1), "+v"(S2), "+v"(S3), "=&v"(ea), "=&v"(eb), "=&v"(t0), "=&v"(t1), "=&v"(t2), "=&v"(t3)
          : "v"(w_.x), "v"(w_.y), "v"(kd_.x), "v"(kd_.y), "v"(kka_.x), "v"(kka_.y), "v"(r_.x), "v"(r_.y), "v"(vj), "v"(d1));
      dres[u] = ea + eb;
    }
    asm volatile("s_waitcnt lgkmcnt(0)" ::: "memory");
    *cflag = g + 1;
    {
      int rlo; RW_RLO(g, rlo);
      unsigned vov = vov0; asm volatile("" : "+v"(vov));
      const bool p1_ = (s & 1) != 0, p2_ = (s & 2) != 0;
      const float a_ = (p1_ ? dres[1] : dres[0]) + dpp_mov<0xB1>(p1_ ? dres[0] : dres[1]);
      const float b_ = (p1_ ? dres[3] : dres[2]) + dpp_mov<0xB1>(p1_ ? dres[2] : dres[3]);
      float val = (p2_ ? b_ : a_) + dpp_mov<0x4E>(p2_ ? a_ : b_);
      val += dpp_mov<0x124>(val);
      val += dpp_mov<0x128>(val);
      *(h16*)(pO + (size_t)rlo * 2048 + vov) = (h16)val;
    }
    slotc = (slotc == RW_NSLOT - 1) ? 0 : slotc + 1;
  }
}
#undef RW_RLO

DEV void phase_scan(const Params& p, const Ctx& cx, int l, char* smem) {
  const int lane = cx.tid & 63, wid = __builtin_amdgcn_readfirstlane(cx.tid >> 6);
  for (int slot = cx.bid; slot < 256; slot += cx.nblk) {
    __syncthreads();
    if (wid == 4 && lane < 8) *(LAS3 volatile int*)(smem + RW_FLAGS + (lane == 0 ? 0 : 64 + (lane & 3) * 4)) = 0;
    __syncthreads();
    const int unit = slot & 63;
#ifndef NO_RWKV
    if (wid < 4) rwkv_consumer(p, cx, l, (unit << 4) | ((slot >> 6) << 2) | wid, lane, smem, wid);
    else if (wid == 4) rwkv_helper(p, cx, l, unit, lane, smem);
#endif
  }
  if (wid >= 5) {
    char* wl = smem + 32768 + (wid - 5) * 17408;
    for (int u = cx.bid * 3 + (wid - 5); u < 2 * 32 * 65; u += cx.nblk * 3) {
      if (l == 1 && (u % 65) == 0) continue;
#ifndef NO_S5P3
      s5_pass3_unit(p, cx, l, u, wl, lane);
#endif
    }
  }
}

DEV void pool_item(const Params& p, const Ctx& cx, int l, int item, char* smem) {
  const int tid = cx.tid;
  const h16* zrest = (const h16*)(p.ws + OFF_ZREST);
  bf16_t* ym = (bf16_t*)(p.ws + OFF_YM);
  const char* wt = p.ws + OFF_WT + (size_t)l * WT_SIZE;
  float* V = (float*)smem;
  char* At = smem + 43008;
  int g, rowout0, Lseq, p0, rlo, rhi, rstride, rowsrc0;
  if (item < 2048) {
    g = item & 3; int r = (item >> 2) & 255, b = item >> 10;
    int w = 2 << g;
    rlo = max(r - w / 2, 0); rhi = min(r + w / 2 - 1, 255);
    rowsrc0 = b * 16384; rstride = 64;
    rowout0 = b * 16384 + r * 64; Lseq = 64; p0 = 0;
  } else {
    int it = item - 2048;
    g = it & 3; int tq = (it >> 2) & 3, b = it >> 4;
    rlo = 0; rhi = 0; rowsrc0 = NLAT + b * 256; rstride = 0;
    rowout0 = NLAT + b * 256 + tq * 64; Lseq = 256; p0 = tq * 64;
  }
  const int w = 2 << g;
  const float invr = 1.f / (float)(rhi - rlo + 1);
  for (int unit = tid; unit < 80 * 16; unit += NTHREADS) {
    int lp = unit >> 4, ch8 = unit & 15;
    int pos = p0 - 8 + lp;
    float acc[8] = {0, 0, 0, 0, 0, 0, 0, 0};
    if (pos >= 0 && pos < Lseq) {
      const h16* bp = zrest + (size_t)(rowsrc0 + pos) * ZR + 1024 + g * 128 + ch8 * 8;
      const int nr = rhi - rlo + 1;
      for (int k0 = 0; k0 < nr; k0 += 4) {
        h16x8 v[4]; float wv[4];
#pragma unroll
        for (int i = 0; i < 4; ++i) {
          const int kk_ = min(k0 + i, nr - 1);
          wv[i] = (k0 + i < nr) ? 1.f : 0.f;
          v[i] = *(const h16x8*)(bp + (size_t)((rlo + kk_) * rstride) * ZR);
        }
#pragma unroll
        for (int i = 0; i < 4; ++i)
#pragma unroll
          for (int j = 0; j < 8; ++j) acc[j] += wv[i] * (float)v[i][j];
      }
    }
    float* vp = V + lp * 132 + ch8 * 8;
#pragma unroll
    for (int j = 0; j < 8; ++j) vp[j] = acc[j] * invr;
  }
  __syncthreads();
  for (int unit = tid; unit < 64 * 16; unit += NTHREADS) {
    int c = unit >> 4, ch8 = unit & 15;
    int pos = p0 + c;
    int lo = max(pos - w / 2, 0), hi = min(pos + w / 2 - 1, Lseq - 1);
    float acc[8] = {0, 0, 0, 0, 0, 0, 0, 0};
    for (int pp = lo; pp <= hi; ++pp) {
      const float* vp = V + (pp - p0 + 8) * 132 + ch8 * 8;
#pragma unroll
      for (int j = 0; j < 8; ++j) acc[j] += vp[j];
    }
    float invc = 1.f / (float)(hi - lo + 1);
    h16x8 uc = *(const h16x8*)(zrest + (size_t)(rowout0 + c) * ZR + 1024 + g * 128 + ch8 * 8);
    uint4 o;
    o.x = pack_bf2(acc[0] * invc - (float)uc[0], acc[1] * invc - (float)uc[1]);
    o.y = pack_bf2(acc[2] * invc - (float)uc[2], acc[3] * invc - (float)uc[3]);
    o.z = pack_bf2(acc[4] * invc - (float)uc[4], acc[5] * invc - (float)uc[5]);
    o.w = pack_bf2(acc[6] * invc - (float)uc[6], acc[7] * invc - (float)uc[7]);
    *(uint4*)(At + c * 272 + ch8 * 16) = o;
  }
  __syncthreads();
  const bf16_t* Bt = (const bf16_t*)(wt + WT_POOL) + (size_t)g * 128 * 128;
  const float* ps = p.pool_scale + (size_t)l * 512 + g * 128;
  small_gemm<128, 1>(p, cx, At, 272, Bt, (tid >> 6) * 16, [&](int m, int n, f32x4 v) {
    int row = rowout0 + m;
    float4 sc = *(const float4*)(ps + n);
    h16x4 gt = *(const h16x4*)(zrest + (size_t)row * ZR + 1536 + g * 128 + n);
    uint2 o;
    o.x = pack_bf2(v[0] * sc.x * silu_f((float)gt[0]), v[1] * sc.y * silu_f((float)gt[1]));
    o.y = pack_bf2(v[2] * sc.z * silu_f((float)gt[2]), v[3] * sc.w * silu_f((float)gt[3]));
    *(uint2*)(ym + (size_t)row * D + 512 + g * 128 + n) = o;
  });
}

DEV void glu_item(const Params& p, const Ctx& cx, int l, int tile, char* smem) {
  const int tid = cx.tid;
  const int row0 = tile * 64;
  const float* S5Y = (const float*)(p.ws + OFF_S5Y);
  const h16* zrest = (const h16*)(p.ws + OFF_ZREST);
  bf16_t* ym = (bf16_t*)(p.ws + OFF_YM);
  const char* wt = p.ws + OFF_WT + (size_t)l * WT_SIZE;
#pragma unroll
  for (int it = 0; it < 8; ++it) {
    int unit = tid + it * NTHREADS;
    int r = unit >> 6, c8 = unit & 63;
    const float* sp = S5Y + (size_t)(row0 + r) * 512 + c8 * 8;
    float4 a = *(const float4*)sp, bq = *(const float4*)(sp + 4);
    uint4 o;
    o.x = pack_bf2(a.x, a.y); o.y = pack_bf2(a.z, a.w); o.z = pack_bf2(bq.x, bq.y); o.w = pack_bf2(bq.z, bq.w);
    *(uint4*)(smem + r * 1040 + c8 * 16) = o;
  }
  __syncthreads();
  const bf16_t* Bt = (const bf16_t*)(wt + WT_GLU);
  const float* bg = p.b_glu + (size_t)l * 512;
  small_gemm<512, 4>(p, cx, smem, 1040, Bt, (tid >> 6) * 64, [&](int m, int n, f32x4 v) {
    int row = row0 + m;
    float4 y = *(const float4*)(S5Y + (size_t)row * 512 + n);
    float4 bb = *(const float4*)(bg + n);
    h16x4 gt = *(const h16x4*)(zrest + (size_t)row * ZR + 512 + n);
    uint2 o;
    o.x = pack_bf2(y.x * sigmoid_f(v[0] + bb.x) * silu_f((float)gt[0]), y.y * sigmoid_f(v[1] + bb.y) * silu_f((float)gt[1]));
    o.y = pack_bf2(y.z * sigmoid_f(v[2] + bb.z) * silu_f((float)gt[2]), y.w * sigmoid_f(v[3] + bb.w) * silu_f((float)gt[3]));
    *(uint2*)(ym + (size_t)row * D + n) = o;
  });
}

DEV void rwkvmerge_item(const Params& p, const Ctx& cx, int l, int tile) {
  const int tid = cx.tid;
  const int row0 = tile * 64;
  const h16* SC = (const h16*)(p.ws + OFF_SCAN);
  const h16* O = (const h16*)(p.ws + OFF_REG2);
  const h16* zrest = (const h16*)(p.ws + OFF_ZREST);
  bf16_t* ym = (bf16_t*)(p.ws + OFF_YM);
  const int grp = tid & 7, h = (tid >> 3) & 15;
  const int c0 = h * 64 + grp * 8;
  float pk[8], rk[8], gw[8], gb[8];
#pragma unroll
  for (int j = 0; j < 8; j += 4) {
    float4 t0 = *(const float4*)(p.rwkv_k_a + (size_t)l * 1024 + c0 + j), t1 = *(const float4*)(p.rwkv_r_k + (size_t)l * 1024 + c0 + j);
    float4 t2 = *(const float4*)(p.gn_w + (size_t)l * 1024 + c0 + j), t3 = *(const float4*)(p.gn_b + (size_t)l * 1024 + c0 + j);
    pk[j] = t0.x; pk[j + 1] = t0.y; pk[j + 2] = t0.z; pk[j + 3] = t0.w;
    rk[j] = t1.x; rk[j + 1] = t1.y; rk[j + 2] = t1.z; rk[j + 3] = t1.w;
    gw[j] = t2.x; gw[j + 1] = t2.y; gw[j + 2] = t2.z; gw[j + 3] = t2.w;
    gb[j] = t3.x; gb[j + 1] = t3.y; gb[j + 2] = t3.z; gb[j + 3] = t3.w;
  }
#pragma unroll 2
  for (int it = 0; it < 16; ++it) {
    const int tok = (tid >> 7) + it * 4;
    int row = row0 + tok;
    size_t off = (size_t)row * 1024 + c0;
    h16x8 of = *(const h16x8*)(O + off), ob = *(const h16x8*)(O + ARR + off);
    h16x8 r8 = *(const h16x8*)(SC + 0 * ARR + off), k8 = *(const h16x8*)(SC + 1 * ARR + off), v8 = *(const h16x8*)(SC + 2 * ARR + off);
    h16x8 af = *(const h16x8*)(SC + 4 * ARR + off), ab = *(const h16x8*)(SC + 5 * ARR + off);
    h16x8 gt = *(const h16x8*)(zrest + (size_t)row * ZR + 2048 + c0);
    float o[8], sm = 0;
#pragma unroll
    for (int j = 0; j < 8; ++j) { o[j] = (float)of[j] + (float)ob[j]; sm += o[j]; }
    sm = allreduce8(sm);
    float mu = sm * (1.f / 64.f), vq = 0;
#pragma unroll
    for (int j = 0; j < 8; ++j) { o[j] -= mu; vq += o[j] * o[j]; }
    vq = allreduce8(vq);
    float rstd = rsqrtf(vq * (1.f / 64.f) + 64e-5f);
    float part = 0;
#pragma unroll
    for (int j = 0; j < 8; ++j) {
      float ksum = (float)k8[j] * (2.f + ((float)af[j] + (float)ab[j] - 2.f) * pk[j]);
      part += (float)r8[j] * ksum * rk[j];
    }
    part = allreduce8(part);
    float res[8];
#pragma unroll
    for (int j = 0; j < 8; ++j) {
      float y = o[j] * rstd * gw[j] + gb[j] + part * (float)v8[j];
      res[j] = y * silu_f((float)gt[j]);
    }
    uint4 ov;
    ov.x = pack_bf2(res[0], res[1]); ov.y = pack_bf2(res[2], res[3]); ov.z = pack_bf2(res[4], res[5]); ov.w = pack_bf2(res[6], res[7]);
    *(uint4*)(ym + (size_t)row * D + 1024 + c0) = ov;
  }
}

DEV void phase_merge(const Params& p, const Ctx& cx0, int l, char* smem) {
  const int ntile = (l == 0) ? 520 : 512;
  const int npool = (l == 0) ? 2048 + 32 : 2048;
  const int total = npool + 2 * ntile;
  for (int item = cx0.bid; item < total; item += cx0.nblk) {
    __syncthreads();
    Ctx cx = cx0; asm volatile("" : "+v"(cx.tid));
    if (item < npool) pool_item(p, cx, l, item, smem);
    else if (item < npool + ntile) glu_item(p, cx, l, item - npool, smem);
    else rwkvmerge_item(p, cx, l, item - npool - ntile);
  }
}

#define LCX Ctx c2 = cx; asm volatile("" : "+v"(c2.tid))
#ifndef GEMM_FN
#define GEMM_FN gemm_phase2
#endif
__global__ void __launch_bounds__(NTHREADS) mega_fwd(Params p, int ph0, int ph1) {
  extern __shared__ __attribute__((aligned(16))) char smem[];
  cg::grid_group grid = cg::this_grid();
  const int wave_s = __builtin_amdgcn_readfirstlane((int)(threadIdx.x >> 6));
  for (int step = ph0; step < ph1; ++step) {
    if (step > ph0) grid.sync();
    const int ph = (int)((PH_SEQ >> (4 * step)) & 15ull);
    Ctx cx;
    {
      int t_, b_ = blockIdx.x, n_ = gridDim.x;
      asm volatile("v_mbcnt_lo_u32_b32 %0, -1, 0\n\tv_mbcnt_hi_u32_b32 %0, -1, %0\n\tv_lshl_add_u32 %0, %1, 6, %0" : "=&v"(t_) : "s"(wave_s));
      asm volatile("" : "+s"(b_), "+s"(n_));
      cx.tid = t_; cx.bid = b_; cx.nblk = n_;
    }
    const int l = ph >= 8 ? 1 : 0;
    const int lp = ph >= 8 ? ph - 6 : ph;
#ifndef PHMASK
#define PHMASK 0xff
#endif
    if (ph == 0) { if (PHMASK & 1) { LCX; phase0(p, c2, smem); } }
    else if (ph == 1) { if (PHMASK & 2) { LCX; phase_adaln0(p, c2); } }
    else if (lp == 2 && (PHMASK & 4)) {
      LCX;
      h16* zrest = (h16*)(p.ws + OFF_ZREST);
      h16* zc = (h16*)(p.ws + OFF_REG2);
      GEMM_FN(p, c2, (const bf16_t*)(p.ws + OFF_H), (const bf16_t*)(p.ws + OFF_WT + (size_t)l * WT_SIZE + WT_IN), 2048, 130, 25, smem,
                 [&](int row, int col, f32x4 v, f32x4 u) {
                   h16* dst;
                   if (col < 2048) dst = zrest + (size_t)row * ZR + col;
                   else if (col < 5120) dst = zc + (size_t)row * ZC + (col - 2048);
                   else if (col < 6144) dst = zrest + (size_t)row * ZR + 2048 + (col - 5120);
                   else dst = zc + (size_t)row * ZC + 3072 + (col - 6144);
                   h16x8 o = {(h16)v[0], (h16)v[1], (h16)v[2], (h16)v[3], (h16)u[0], (h16)u[1], (h16)u[2], (h16)u[3]};
                   *(h16x8*)dst = o;
                 });
    } else if (lp == 3) { if (PHMASK & 8) { LCX; phase_prep(p, c2, l, smem); } }
    else if (lp == 4) { if (PHMASK & 16) { LCX; phase_scan(p, c2, l, smem); } }
    else if (lp == 5) { if (PHMASK & 32) { LCX; phase_merge(p, c2, l, smem); } }
    else if (lp == 6 && (PHMASK & 64)) {
      LCX;
      const float* mods = (const float*)(p.ws + OFF_MODS);
      float* prec = (float*)(p.ws + OFF_PREC);
      const float* xin = (l == 0) ? p.x : p.out;
      GEMM_FN(p, c2, (const bf16_t*)(p.ws + OFF_YM), (const bf16_t*)(p.ws + OFF_WT + (size_t)l * WT_SIZE + WT_OUT), 2048, l == 0 ? 130 : 128, 8, smem,
                 [&](int row, int col, f32x4 v, f32x4 u) {
                   const float* xr; const float* gr; float* dr;
                   if (row < NLAT) {
                     xr = xin + (size_t)row * D + col; gr = mods + (size_t)(l * 3 + (row >> 14)) * 6144 + 4096 + col; dr = p.out + (size_t)row * D + col;
                   } else {
                     xr = p.ctx + (size_t)(row - NLAT) * D + col; gr = mods + (size_t)(l * 3 + 2) * 6144 + 4096 + col; dr = prec + (size_t)(row - NLAT) * D + col;
                   }
                   const float4 x0 = *(const float4*)xr, x1 = *(const float4*)(xr + 4), g0 = *(const float4*)gr, g1 = *(const float4*)(gr + 4);
                   float4 r0, r1;
                   r0.x = ALPHA * x0.x + g0.x * v[0]; r0.y = ALPHA * x0.y + g0.y * v[1]; r0.z = ALPHA * x0.z + g0.z * v[2]; r0.w = ALPHA * x0.w + g0.w * v[3];
                   r1.x = ALPHA * x1.x + g1.x * u[0]; r1.y = ALPHA * x1.y + g1.y * u[1]; r1.z = ALPHA * x1.z + g1.z * u[2]; r1.w = ALPHA * x1.w + g1.w * u[3];
                   *(float4*)dr = r0; *(float4*)(dr + 4) = r1;
                 });
    } else if (lp == 7) { if (PHMASK & 128) { LCX; phase_finln(p, c2, l); } }
  }
}

constexpr int NPHASES = PH_NSTEPS;

extern "C" void kernel_launch(void* const* d_in, const int* in_sizes, int n_in, void* d_out, int out_size, void* d_ws, size_t ws_size,
                              hipStream_t stream) {
  static int grid_blocks = 0;
  if (grid_blocks == 0) {
    if (n_in != 32 || ws_size < WS_END) { fprintf(stderr, "kernel_launch: unexpected n_in %d / ws %zu (need %zu)\n", n_in, ws_size, (size_t)WS_END); grid_blocks = -1; return; }
    int dev = 0, cus = 0, per_cu = 0;
    hipGetDevice(&dev);
    hipDeviceGetAttribute(&cus, hipDeviceAttributeMultiprocessorCount, dev);
    if (hipFuncSetAttribute((const void*)mega_fwd, hipFuncAttributeMaxDynamicSharedMemorySize, LDS_BYTES) != hipSuccess) { fprintf(stderr, "hipFuncSetAttribute failed\n"); grid_blocks = -1; return; }
    if (hipOccupancyMaxActiveBlocksPerMultiprocessor(&per_cu, (const void*)mega_fwd, NTHREADS, LDS_BYTES) != hipSuccess || per_cu < 1) {
      fprintf(stderr, "occupancy query gave %d\n", per_cu); (void)hipGetLastError(); per_cu = 1;
    }
    grid_blocks = cus * per_cu;
  }
  if (grid_blocks < 0) return;
  Params p{};
  const float** pp = (const float**)&p;
  for (int i = 0; i < 32; ++i) pp[i] = (const float*)d_in[i];
  p.out = (float*)d_out;
  p.ws = (char*)d_ws;
  int ph0 = 0, ph1 = NPHASES;
  void* args[] = {&p, &ph0, &ph1};
  hipError_t e = hipLaunchCooperativeKernel((const void*)mega_fwd, dim3(grid_blocks), dim3(NTHREADS), args, LDS_BYTES, stream);
  if (e != hipSuccess) fprintf(stderr, "cooperative launch failed: %s (grid %d)\n", hipGetErrorString(e), grid_blocks);
}
```

```cpp
#include <hip/hip_runtime.h>
#include <hip/hip_cooperative_groups.h>
#include <cstdio>
namespace cg = cooperative_groups;

typedef unsigned short bf16_t;
typedef _Float16 h16;
using bf16x8 = __attribute__((ext_vector_type(8))) _Float16;
using f32x4 = __attribute__((ext_vector_type(4))) float;
using h16x4 = __attribute__((ext_vector_type(4))) _Float16;
using h16x8 = __attribute__((ext_vector_type(8))) _Float16;

#define DEV __device__ __forceinline__

constexpr int D = 2048, NLAT = 32768, MTOT = 33280, ZR = 3072, ZC = 3328;
constexpr int NTHREADS = 512;
constexpr int LDS_BYTES = 147456;
constexpr float ALPHA = 1.41421356237f;
constexpr float DECAY_SCALE = 0.606531f;

constexpr size_t al256(size_t x) { return (x + 255) & ~size_t(255); }
constexpr size_t ARR = (size_t)MTOT * 1024;
constexpr size_t OFF_MODS = 0;
constexpr size_t OFF_S5F = al256(OFF_MODS + 2 * 3 * 6144 * 4);
constexpr size_t OFF_PREC = al256(OFF_S5F + (size_t)2 * 32 * 65 * 2 * 64 * 8);
constexpr size_t OFF_WT = al256(OFF_PREC + (size_t)512 * 2048 * 4);
constexpr size_t WT_IN = 0, WT_OUT = 26214400, WT_W2 = 34603008, WT_A2 = 34865152, WT_POOL = 35127296, WT_GLU = 35258368, WT_SIZE = 35782656;
constexpr size_t OFF_ZREST = al256(OFF_WT + 2 * WT_SIZE);
constexpr size_t OFF_REG2 = al256(OFF_ZREST + (size_t)MTOT * ZR * 2);
constexpr size_t OFF_S5Y = OFF_REG2 + 2 * ARR * 2;
constexpr size_t OFF_SCAN = al256(OFF_REG2 + (size_t)MTOT * ZC * 2);
constexpr size_t OFF_H = OFF_SCAN;
constexpr size_t OFF_YM = OFF_SCAN + 6 * ARR * 2;
constexpr size_t WS_END = OFF_SCAN + 8 * ARR * 2;

#ifndef PH_SEQ
#define PH_SEQ 0xDCBA9876543210ull
#define PH_NSTEPS 14
#endif
struct Params {
  const float *x, *c, *ctx, *c_ctx, *w_ada, *b_ada, *w_in, *conv_rkv, *s5_lam_re, *s5_lam_im, *s5_log_step,
      *s5_b_re, *s5_b_im, *s5_c_re, *s5_c_im, *s5_d, *w_glu, *b_glu, *w_pool, *pool_scale,
      *rwkv_w0, *rwkv_w2, *rwkv_a0, *rwkv_a2, *rwkv_k_k, *rwkv_k_a, *rwkv_r_k, *gn_w, *gn_b,
      *w_out, *ln_g, *ln_b;
  float* out;
  char* ws;
};
struct Ctx { int tid, bid, nblk; };

DEV float rcp_f(float x) { return __builtin_amdgcn_rcpf(x); }
DEV float sigmoid_f(float x) { return rcp_f(1.f + __expf(-x)); }
DEV float silu_f(float x) { return x * rcp_f(1.f + __expf(-x)); }
DEV float tanh_f(float x) { float e = __expf(2.f * x); return 1.f - 2.f * rcp_f(e + 1.f); }
DEV float gelu_f(float y) { return 0.5f * y * (1.f + tanh_f(0.7978845608f * (y + 0.044715f * y * y * y))); }
using h16x2 = __attribute__((ext_vector_type(2))) _Float16;
DEV unsigned pack_bf2(float a, float b) { h16x2 v = {(h16)a, (h16)b}; return __builtin_bit_cast(unsigned, v); }
template <int CTRL> DEV float dpp_mov(float v) {
  return __int_as_float(__builtin_amdgcn_update_dpp(0, __float_as_int(v), CTRL, 0xf, 0xf, true));
}
DEV float allreduce16(float v) {
  v += dpp_mov<0xB1>(v);
  v += dpp_mov<0x4E>(v);
  v += dpp_mov<0x141>(v);
  v += dpp_mov<0x140>(v);
  return v;
}
DEV float wave_sum(float v) {
  v = allreduce16(v);
  return __builtin_amdgcn_readlane(__float_as_int(v), 0) == 0 && false ? 0.f :
         __int_as_float(__builtin_amdgcn_readlane(__float_as_int(v), 0)) + __int_as_float(__builtin_amdgcn_readlane(__float_as_int(v), 16)) +
         __int_as_float(__builtin_amdgcn_readlane(__float_as_int(v), 32)) + __int_as_float(__builtin_amdgcn_readlane(__float_as_int(v), 48));
}
DEV float allreduce8(float v) {
  v += dpp_mov<0xB1>(v);
  v += dpp_mov<0x4E>(v);
  v += dpp_mov<0x141>(v);
  return v;
}
DEV void lds_fence() { asm volatile("s_waitcnt lgkmcnt(0)" ::: "memory"); }

DEV void p0_mods_item(const Params& p, const Ctx& cx, int item, char* smem) {
  float* red = (float*)smem;
  float* mods = (float*)(p.ws + OFF_MODS);
  int l = item / 96, chunk = item % 96;
  int tid = cx.tid, kq = tid >> 6, col = tid & 63;
  int n = chunk * 64 + col;
  const float* W = p.w_ada + (size_t)l * 2048 * 6144;
  float a0 = 0, a1 = 0, a2 = 0;
#pragma unroll 8
  for (int k = kq; k < 2048; k += 8) {
    float w = W[(size_t)k * 6144 + n];
    a0 += silu_f(p.c[k]) * w;
    a1 += silu_f(p.c[2048 + k]) * w;
    a2 += silu_f(p.c_ctx[k]) * w;
  }
  red[(kq * 3 + 0) * 64 + col] = a0;
  red[(kq * 3 + 1) * 64 + col] = a1;
  red[(kq * 3 + 2) * 64 + col] = a2;
  __syncthreads();
  if (tid < 192) {
    int r = tid >> 6, cc = tid & 63;
    float s = 0;
#pragma unroll
    for (int q = 0; q < 8; ++q) s += red[(q * 3 + r) * 64 + cc];
    mods[(size_t)(l * 3 + r) * 6144 + chunk * 64 + cc] = s + p.b_ada[(size_t)l * 6144 + chunk * 64 + cc];
  }
}

DEV void p0_transpose_tile(const Params& p, const Ctx& cx, const float* __restrict__ src, bf16_t* __restrict__ dst, int K, int N, int tk, int tn, char* smem) {
  float* T = (float*)smem;
  int tid = cx.tid;
  int k0 = tk * 64, n0 = tn * 64;
  int kk = tid >> 4, n4 = tid & 15;
#pragma unroll
  for (int i = 0; i < 2; ++i) {
    int k = kk + 32 * i;
    float4 v = *(const float4*)(src + (size_t)(k0 + k) * N + n0 + n4 * 4);
    T[k * 65 + n4 * 4 + 0] = v.x; T[k * 65 + n4 * 4 + 1] = v.y; T[k * 65 + n4 * 4 + 2] = v.z; T[k * 65 + n4 * 4 + 3] = v.w;
  }
  __syncthreads();
  int n = tid >> 3, k8 = tid & 7;
  uint4 o;
  o.x = pack_bf2(T[(k8 * 8 + 0) * 65 + n], T[(k8 * 8 + 1) * 65 + n]);
  o.y = pack_bf2(T[(k8 * 8 + 2) * 65 + n], T[(k8 * 8 + 3) * 65 + n]);
  o.z = pack_bf2(T[(k8 * 8 + 4) * 65 + n], T[(k8 * 8 + 5) * 65 + n]);
  o.w = pack_bf2(T[(k8 * 8 + 6) * 65 + n], T[(k8 * 8 + 7) * 65 + n]);
  *(uint4*)(dst + (size_t)(n0 + n) * K + k0 + k8 * 8) = o;
}

DEV void phase0(const Params& p, const Ctx& cx0, char* smem) {
  const int NTR = 4368;
  const int total = 192 + 2 * NTR;
  for (int item = cx0.bid; item < total; item += cx0.nblk) {
    __syncthreads();
    Ctx cx = cx0; asm volatile("" : "+v"(cx.tid));
    if (item < 192) { p0_mods_item(p, cx, item, smem); continue; }
    int it = item - 192;
    int l = it / NTR, i = it % NTR;
    char* wt = p.ws + OFF_WT + (size_t)l * WT_SIZE;
    if (i < 3200) {
      p0_transpose_tile(p, cx, p.w_in + (size_t)l * 2048 * 6400, (bf16_t*)(wt + WT_IN), 2048, 6400, i / 100, i % 100, smem);
    } else if (i < 4224) {
      int j = i - 3200;
      p0_transpose_tile(p, cx, p.w_out + (size_t)l * 2048 * 2048, (bf16_t*)(wt + WT_OUT), 2048, 2048, j / 32, j % 32, smem);
    } else if (i < 4256) {
      int j = i - 4224, d = j / 16;
      p0_transpose_tile(p, cx, p.rwkv_w2 + (size_t)(l * 2 + d) * 64 * 1024, (bf16_t*)(wt + WT_W2) + (size_t)d * 1024 * 64, 64, 1024, 0, j % 16, smem);
    } else if (i < 4288) {
      int j = i - 4256, d = j / 16;
      p0_transpose_tile(p, cx, p.rwkv_a2 + (size_t)(l * 2 + d) * 64 * 1024, (bf16_t*)(wt + WT_A2) + (size_t)d * 1024 * 64, 64, 1024, 0, j % 16, smem);
    } else if (i < 4304) {
      int j = i - 4288, g = j / 4;
      p0_transpose_tile(p, cx, p.w_pool + (size_t)(l * 4 + g) * 128 * 128, (bf16_t*)(wt + WT_POOL) + (size_t)g * 128 * 128, 128, 128, (j % 4) / 2, j % 2, smem);
    } else {
      int j = i - 4304;
      p0_transpose_tile(p, cx, p.w_glu + (size_t)l * 512 * 512, (bf16_t*)(wt + WT_GLU), 512, 512, j / 8, j % 8, smem);
    }
  }
}

DEV void phase_adaln0(const Params& p, const Ctx& cx) {
  const float* mods = (const float*)(p.ws + OFF_MODS);
  bf16_t* hbuf = (bf16_t*)(p.ws + OFF_H);
  int lane = cx.tid & 63;
  int gw = cx.bid * 8 + (cx.tid >> 6), nw = cx.nblk * 8;
  for (int row = gw; row < MTOT; row += nw) {
    const float* src = row < NLAT ? p.x + (size_t)row * D : p.ctx + (size_t)(row - NLAT) * D;
    int mr = row < NLAT ? (row >> 14) : 2;
    const float* md = mods + (size_t)mr * 6144;
    float4 v[8];
    float s = 0;
#pragma unroll
    for (int i = 0; i < 8; ++i) { v[i] = *(const float4*)(src + i * 256 + lane * 4); s += v[i].x + v[i].y + v[i].z + v[i].w; }
    float mu = wave_sum(s) * (1.f / 2048.f);
    float q = 0;
#pragma unroll
    for (int i = 0; i < 8; ++i) { v[i].x -= mu; v[i].y -= mu; v[i].z -= mu; v[i].w -= mu; q += v[i].x * v[i].x + v[i].y * v[i].y + v[i].z * v[i].z + v[i].w * v[i].w; }
    float rstd = rsqrtf(wave_sum(q) * (1.f / 2048.f) + 1e-6f);
#pragma unroll
    for (int i = 0; i < 8; ++i) {
      int col = i * 256 + lane * 4;
      float4 sh = *(const float4*)(md + col), sc = *(const float4*)(md + 2048 + col);
      uint2 o;
      o.x = pack_bf2(v[i].x * rstd * (1.f + sc.x) + sh.x, v[i].y * rstd * (1.f + sc.y) + sh.y);
      o.y = pack_bf2(v[i].z * rstd * (1.f + sc.z) + sh.z, v[i].w * rstd * (1.f + sc.w) + sh.w);
      *(uint2*)(hbuf + (size_t)row * D + col) = o;
    }
  }
}

DEV void phase_finln(const Params& p, const Ctx& cx, int l) {
  const float* mods = (const float*)(p.ws + OFF_MODS);
  bf16_t* hbuf = (bf16_t*)(p.ws + OFF_H);
  float* prec = (float*)(p.ws + OFF_PREC);
  int lane = cx.tid & 63;
  int gw = cx.bid * 8 + (cx.tid >> 6), nw = cx.nblk * 8;
  const int nrows = (l == 0) ? MTOT : NLAT;
  for (int row = gw; row < nrows; row += nw) {
    float* src = row < NLAT ? p.out + (size_t)row * D : prec + (size_t)(row - NLAT) * D;
    float4 v[8];
    float s = 0;
#pragma unroll
    for (int i = 0; i < 8; ++i) { v[i] = *(const float4*)(src + i * 256 + lane * 4); s += v[i].x + v[i].y + v[i].z + v[i].w; }
    float mu = wave_sum(s) * (1.f / 2048.f);
    float q = 0;
#pragma unroll
    for (int i = 0; i < 8; ++i) { v[i].x -= mu; v[i].y -= mu; v[i].z -= mu; v[i].w -= mu; q += v[i].x * v[i].x + v[i].y * v[i].y + v[i].z * v[i].z + v[i].w * v[i].w; }
    float rstd = rsqrtf(wave_sum(q) * (1.f / 2048.f) + 1e-5f);
    float s2 = 0;
#pragma unroll
    for (int i = 0; i < 8; ++i) {
      int col = i * 256 + lane * 4;
      float4 g = *(const float4*)(p.ln_g + (size_t)l * D + col), b = *(const float4*)(p.ln_b + (size_t)l * D + col);
      v[i].x = v[i].x * rstd * g.x + b.x; v[i].y = v[i].y * rstd * g.y + b.y; v[i].z = v[i].z * rstd * g.z + b.z; v[i].w = v[i].w * rstd * g.w + b.w;
      if (row < NLAT) *(float4*)(src + col) = v[i];
      s2 += v[i].x + v[i].y + v[i].z + v[i].w;
    }
    if (l == 0) {
      int mr = row < NLAT ? (row >> 14) : 2;
      const float* md = mods + (size_t)(3 + mr) * 6144;
      float mu2 = wave_sum(s2) * (1.f / 2048.f);
      float q2 = 0;
#pragma unroll
      for (int i = 0; i < 8; ++i) { v[i].x -= mu2; v[i].y -= mu2; v[i].z -= mu2; v[i].w -= mu2; q2 += v[i].x * v[i].x + v[i].y * v[i].y + v[i].z * v[i].z + v[i].w * v[i].w; }
      float rstd2 = rsqrtf(wave_sum(q2) * (1.f / 2048.f) + 1e-6f);
#pragma unroll
      for (int i = 0; i < 8; ++i) {
        int col = i * 256 + lane * 4;
        float4 sh = *(const float4*)(md + col), sc = *(const float4*)(md + 2048 + col);
        uint2 o;
        o.x = pack_bf2(v[i].x * rstd2 * (1.f + sc.x) + sh.x, v[i].y * rstd2 * (1.f + sc.y) + sh.y);
        o.y = pack_bf2(v[i].z * rstd2 * (1.f + sc.z) + sh.z, v[i].w * rstd2 * (1.f + sc.w) + sh.w);
        *(uint2*)(hbuf + (size_t)row * D + col) = o;
      }
    }
  }
}

template <class Epi>
DEV void gemm_phase(const Params& p, const Ctx& cx, const bf16_t* __restrict__ A, const bf16_t* __restrict__ Bt, int K, int nM, int nN, char* smem, Epi epi) {
  const int tid = cx.tid, lane = tid & 63, wid = tid >> 6;
  const int wr = wid >> 2, wc = wid & 3, fr = lane & 15, fq = lane >> 4;
  const int nt = K / 64;
  const int ntiles = nM * nN;
  const int srow = tid >> 3, sc16 = tid & 7;
  const int nxcd = (cx.nblk & 7) == 0 ? 8 : 1;
  const int xcd = cx.bid % nxcd, xidx = cx.bid / nxcd, xper = cx.nblk / nxcd;
  const int t_lo = (int)(((long)ntiles * xcd) / nxcd), t_hi = (int)(((long)ntiles * (xcd + 1)) / nxcd);
  for (int tt = t_lo + xidx; tt < t_hi; tt += xper) {
    const int band = tt / (16 * nN);
    const int brows = min(16, nM - band * 16);
    const int rem = tt - band * 16 * nN;
    const int pn = rem / brows, pm = band * 16 + rem % brows;
    const int brow = pm * 256, bcol = pn * 256;
    const char* Ab = (const char*)(A + (size_t)brow * K);
    const char* Bb = (const char*)(Bt + (size_t)bcol * K);
    const unsigned voff = (unsigned)(srow * K + sc16 * 8) * 2u;
    const size_t rs = (size_t)64 * K * 2;
    f32x4 acc[8][4];
#pragma unroll
    for (int i = 0; i < 8; ++i)
#pragma unroll
      for (int j = 0; j < 4; ++j) acc[i][j] = f32x4{0.f, 0.f, 0.f, 0.f};
    uint4 ra0, ra1, ra2, ra3, rb0, rb1, rb2, rb3;
#define G_LD(ko) { const char* a_ = Ab + (size_t)(ko) * 2; const char* b_ = Bb + (size_t)(ko) * 2; \
                 ra0 = *(const uint4*)(a_ + voff); ra1 = *(const uint4*)(a_ + rs + voff); ra2 = *(const uint4*)(a_ + 2 * rs + voff); ra3 = *(const uint4*)(a_ + 3 * rs + voff); \
                 rb0 = *(const uint4*)(b_ + voff); rb1 = *(const uint4*)(b_ + rs + voff); rb2 = *(const uint4*)(b_ + 2 * rs + voff); rb3 = *(const uint4*)(b_ + 3 * rs + voff); }
#define G_ST(sp) { *(uint4*)(sp) = ra0; *(uint4*)((sp) + 64 * 144) = ra1; *(uint4*)((sp) + 128 * 144) = ra2; *(uint4*)((sp) + 192 * 144) = ra3; \
                 *(uint4*)((sp) + 36864) = rb0; *(uint4*)((sp) + 36864 + 64 * 144) = rb1; *(uint4*)((sp) + 36864 + 128 * 144) = rb2; *(uint4*)((sp) + 36864 + 192 * 144) = rb3; }
    char* const sbase = smem + srow * 144 + sc16 * 16;
    G_LD(0);
    G_ST(sbase);
    if (nt > 1) G_LD(64);
    for (int kt = 0; kt < nt; ++kt) {
      __syncthreads();
      if (kt + 1 < nt) { char* s1 = sbase + ((kt + 1) & 1) * 73728; G_ST(s1); }
      if (kt + 2 < nt) G_LD((kt + 2) * 64);
      const char* As = smem + (kt & 1) * 73728;
      const char* Bs = As + 36864;
#pragma unroll
      for (int kh = 0; kh < 2; ++kh) {
        bf16x8 bfr[4];
#pragma unroll
        for (int jn = 0; jn < 4; ++jn) bfr[jn] = *(const bf16x8*)(Bs + (wc * 64 + jn * 16 + fr) * 144 + kh * 64 + fq * 16);
#pragma unroll
        for (int i = 0; i < 8; ++i) {
          bf16x8 af = *(const bf16x8*)(As + (wr * 128 + i * 16 + fr) * 144 + kh * 64 + fq * 16);
#pragma unroll
          for (int jn = 0; jn < 4; ++jn) acc[i][jn] = __builtin_amdgcn_mfma_f32_16x16x32_f16(bfr[jn], af, acc[i][jn], 0, 0, 0);
        }
      }
    }
    __syncthreads();
#pragma unroll
    for (int i = 0; i < 8; ++i)
#pragma unroll
      for (int jn = 0; jn < 4; ++jn) epi(brow + wr * 128 + i * 16 + fr, bcol + wc * 64 + jn * 16 + fq * 4, acc[i][jn]);
  }
}

#define LAS3 __attribute__((address_space(3)))
DEV int g2_lds_byte(int r, int c) { const int st = (r >> 4) * 2 + (c >> 5), rr = r & 15, cc = c & 31, ob = rr * 64 + cc * 2; return st * 1024 + (ob ^ (((ob >> 9) & 1) << 5)); }
DEV void g2_stage_rc(int b, int& R, int& C) { const int st = b / 1024, sb = b % 1024, swz = sb ^ (((sb >> 9) & 1) << 5); R = (st >> 1) * 16 + swz / 64; C = (st & 1) * 32 + (swz % 64) / 2; }

template <class Epi>
DEV void gemm_phase2(const Params& p, const Ctx& cx, const bf16_t* __restrict__ A, const bf16_t* __restrict__ Bt, int K, int nM, int nN, char* smem, Epi epi) {
  constexpr int HTB = 128 * 64 * 2;
  LAS3 unsigned char* lds = (LAS3 unsigned char*)smem;
  const int tid = cx.tid, wid = __builtin_amdgcn_readfirstlane(tid >> 6), lane = tid & 63, wr = wid >> 2, wc = wid & 3, fr = lane & 15, fq = lane >> 4;
  const int nt = K / 64;
  const int ntiles = nM * nN;
  const int nxcd = (cx.nblk & 7) == 0 ? 8 : 1;
  const int xcd = cx.bid % nxcd, xidx = cx.bid / nxcd, xper = cx.nblk / nxcd;
  const int t_lo = (int)(((long)ntiles * xcd) / nxcd), t_hi = (int)(((long)ntiles * (xcd + 1)) / nxcd);
  auto unit_at = [&](int i, int& pm, int& pn) -> bool {
    const int tt = t_lo + xidx + i * xper;
    if (tt >= t_hi) return false;
    const int band = tt / (16 * nN);
    const int brows = min(16, nM - band * 16);
    const int rem = tt - band * 16 * nN;
    pn = rem / brows; pm = band * 16 + rem % brows;
    return true;
  };
  unsigned voffA[2], voffB[2];
#pragma unroll
  for (int i = 0; i < 2; ++i) {
    int R, C; g2_stage_rc(tid * 16 + i * 8192, R, C);
    const int rho = R & 31, Rb = (R & ~31) + 8 * ((rho & 15) >> 2) + 4 * (rho >> 4) + (rho & 3);
    voffA[i] = (unsigned)(R * K + C) * 2u; voffB[i] = (unsigned)(Rb * K + C) * 2u;
  }
  const size_t kstep = (size_t)(64 * 2);
  const size_t hstep = (size_t)128 * K * 2;
  const size_t tstep = 2 * hstep;
  const unsigned ldsw = (unsigned)wid * 1024u;
  const int aoff = g2_lds_byte(wr * 64 + fr, fq * 8), boff = g2_lds_byte(wc * 32 + fr, fq * 8);
#define G2_SA(b, h) (((b) * 2 + (h)) * HTB)
#define G2_SB(b, h) ((4 + (b) * 2 + (h)) * HTB)
#define G2_STAGE_(bufoff, gbase, vo_) do { _Pragma("unroll") for (int _i = 0; _i < 2; ++_i) \
    __builtin_amdgcn_global_load_lds((const unsigned*)((const char*)(gbase) + vo_[_i]), (LAS3 unsigned*)(lds + (bufoff) + ldsw + _i * 8192), 16, 0, 0); } while (0)
#define G2_STAGE(bufoff, gbase) G2_STAGE_(bufoff, gbase, voffA)
#define G2_STAGEB(bufoff, gbase) G2_STAGE_(bufoff, gbase, voffB)
#define G2_LDA(dst, b, h) do { _Pragma("unroll") for (int m = 0; m < 4; ++m) _Pragma("unroll") for (int k = 0; k < 2; ++k) dst[m][k] = *(const LAS3 bf16x8*)(lds + G2_SA(b, h) + aoff + m * 2048 + k * 1024); } while (0)
#define G2_LDB(dst, b, h) do { _Pragma("unroll") for (int n = 0; n < 2; ++n) _Pragma("unroll") for (int k = 0; k < 2; ++k) dst[n][k] = *(const LAS3 bf16x8*)(lds + G2_SB(b, h) + boff + n * 2048 + k * 1024); } while (0)
#define G2_MMA(ai, bj, At_, Bt_) do { __builtin_amdgcn_s_setprio(1); _Pragma("unroll") for (int m = 0; m < 4; ++m) _Pragma("unroll") for (int n = 0; n < 2; ++n) _Pragma("unroll") for (int k = 0; k < 2; ++k) \
    acc[ai][bj][m][n] = __builtin_amdgcn_mfma_f32_16x16x32_f16(Bt_[n][k], At_[m][k], acc[ai][bj][m][n], 0, 0, 0); __builtin_amdgcn_s_setprio(0); } while (0)
#define G2_WAIT_V(n) asm volatile("s_waitcnt vmcnt(" #n ")" ::: "memory")
#define G2_WAIT_L(n) asm volatile("s_waitcnt lgkmcnt(" #n ")" ::: "memory")
#define G2_BAR __builtin_amdgcn_s_barrier()
#define G2_SCHED __builtin_amdgcn_sched_barrier(0)
  int cpm, cpn, npm = 0, npn = 0, ui = 0;
  if (!unit_at(0, cpm, cpn)) return;
  f32x4 acc[2][2][4][2];
#pragma unroll
  for (int a = 0; a < 2; ++a)
#pragma unroll
    for (int b = 0; b < 2; ++b)
#pragma unroll
      for (int m = 0; m < 4; ++m)
#pragma unroll
        for (int n = 0; n < 2; ++n) acc[a][b][m][n] = f32x4{0.f, 0.f, 0.f, 0.f};
  bf16x8 At[4][2], B0[2][2], B1[2][2];
  const char* cA = (const char*)A + (size_t)cpm * tstep;
  const char* cB = (const char*)Bt + (size_t)cpn * tstep;
  G2_STAGEB(G2_SB(0, 0), cB); G2_STAGE(G2_SA(0, 0), cA); G2_STAGEB(G2_SB(0, 1), cB + hstep); G2_STAGE(G2_SA(0, 1), cA + hstep);
  if (wr == 1) G2_BAR;
  G2_WAIT_V(4); G2_BAR;
  G2_STAGEB(G2_SB(1, 0), cB + kstep); G2_STAGE(G2_SA(1, 0), cA + kstep); G2_STAGEB(G2_SB(1, 1), cB + hstep + kstep);
  G2_WAIT_V(6); G2_BAR;
  for (;;) {
    const bool has_next = unit_at(ui + 1, npm, npn);
    const char* nA = has_next ? (const char*)A + (size_t)npm * tstep : cA;
    const char* nB = has_next ? (const char*)Bt + (size_t)npn * tstep : cB;
    for (int t = 0; t < nt; t += 2) {
      const bool last = (t == nt - 2);
      const char* a1 = cA + (size_t)(t + 1) * kstep;
      const char* a2 = last ? nA : cA + (size_t)(t + 2) * kstep;
      const char* b2 = last ? nB : cB + (size_t)(t + 2) * kstep;
      const char* a3 = a2 + kstep;
      const char* b3 = b2 + kstep;
      G2_LDB(B0, 0, 0); G2_SCHED; G2_LDA(At, 0, 0); G2_STAGE(G2_SA(1, 1), a1 + hstep);
      G2_WAIT_L(8); G2_BAR; G2_WAIT_L(0); G2_MMA(0, 0, At, B0); G2_BAR; G2_SCHED;
      G2_LDB(B1, 0, 1); G2_STAGEB(G2_SB(0, 0), b2);
      G2_BAR; G2_WAIT_L(0); G2_MMA(0, 1, At, B1); G2_BAR;
      G2_LDA(At, 0, 1); G2_STAGE(G2_SA(0, 0), a2);
      G2_BAR; G2_WAIT_L(0); G2_MMA(1, 0, At, B0); G2_BAR; G2_SCHED;
      G2_STAGEB(G2_SB(0, 1), b2 + hstep);
      G2_WAIT_V(6); G2_BAR; G2_MMA(1, 1, At, B1); G2_BAR;
      G2_LDB(B0, 1, 0); G2_SCHED; G2_LDA(At, 1, 0); G2_STAGE(G2_SA(0, 1), a2 + hstep);
      G2_WAIT_L(8); G2_BAR; G2_WAIT_L(0); G2_MMA(0, 0, At, B0); G2_BAR; G2_SCHED;
      G2_LDB(B1, 1, 1); G2_STAGEB(G2_SB(1, 0), b3);
      G2_BAR; G2_WAIT_L(0); G2_MMA(0, 1, At, B1); G2_BAR;
      G2_LDA(At, 1, 1); G2_STAGE(G2_SA(1, 0), a3);
      G2_BAR; G2_WAIT_L(0); G2_MMA(1, 0, At, B0); G2_BAR; G2_SCHED;
      G2_STAGEB(G2_SB(1, 1), b3 + hstep);
      G2_WAIT_V(6); G2_BAR; G2_MMA(1, 1, At, B1); G2_BAR;
    }
    {
      const int row0 = cpm * 256 + wr * 64 + fr, col0 = cpn * 256 + wc * 32 + 8 * fq;
#pragma unroll
      for (int ai = 0; ai < 2; ++ai)
#pragma unroll
        for (int m = 0; m < 4; ++m)
#pragma unroll
          for (int bj = 0; bj < 2; ++bj) epi(row0 + ai * 128 + m * 16, col0 + bj * 128, acc[ai][bj][m][0], acc[ai][bj][m][1]);
    }
    if (!has_next) break;
#pragma unroll
    for (int a = 0; a < 2; ++a)
#pragma unroll
      for (int b = 0; b < 2; ++b)
#pragma unroll
        for (int m = 0; m < 4; ++m)
#pragma unroll
          for (int n = 0; n < 2; ++n) acc[a][b][m][n] = f32x4{0.f, 0.f, 0.f, 0.f};
    cpm = npm; cpn = npn; cA = nA; cB = nB; ++ui;
  }
  G2_WAIT_V(0);
  if (wr == 0) G2_BAR;
  G2_BAR;
#undef G2_SA
#undef G2_SB
#undef G2_STAGE
#undef G2_STAGEB
#undef G2_STAGE_
#undef G2_LDA
#undef G2_LDB
#undef G2_MMA
#undef G2_WAIT_V
#undef G2_WAIT_L
#undef G2_BAR
#undef G2_SCHED
}

template <int K, int NT, class Epi>
DEV void small_gemm(const Params& p, const Ctx& cx, const char* As, int astride, const bf16_t* __restrict__ Bt, int n0, Epi epi) {
  const int lane = cx.tid & 63, fr = lane & 15, fq = lane >> 4;
  f32x4 acc[4][NT];
#pragma unroll
  for (int i = 0; i < 4; ++i)
#pragma unroll
    for (int j = 0; j < NT; ++j) acc[i][j] = f32x4{0.f, 0.f, 0.f, 0.f};
#pragma unroll 2
  for (int k0 = 0; k0 < K; k0 += 32) {
    bf16x8 af[4];
#pragma unroll
    for (int i = 0; i < 4; ++i) af[i] = *(const bf16x8*)(As + (i * 16 + fr) * astride + (k0 + fq * 8) * 2);
#pragma unroll
    for (int jn = 0; jn < NT; ++jn) {
      bf16x8 bf = *(const bf16x8*)(Bt + (size_t)(n0 + jn * 16 + fr) * K + k0 + fq * 8);
#pragma unroll
      for (int i = 0; i < 4; ++i) acc[i][jn] = __builtin_amdgcn_mfma_f32_16x16x32_f16(bf, af[i], acc[i][jn], 0, 0, 0);
    }
  }
#pragma unroll
  for (int i = 0; i < 4; ++i)
#pragma unroll
    for (int jn = 0; jn < NT; ++jn) epi(i * 16 + fr, n0 + jn * 16 + fq * 4, acc[i][jn]);
}

struct S5P { float ar, ai, br, bi; };
DEV S5P s5_params(const Params& p, const Ctx& cx, int l, int d, int g, int lane) {
  int idx = ((l * 2 + d) * 32 + g) * 64 + lane;
  float lr = fminf(p.s5_lam_re[idx], -1e-4f), li = p.s5_lam_im[idx];
  float step = expf(p.s5_log_step[(l * 2 + d) * 32 + g]);
  float xr = lr * step, xi = li * step;
  float e = expf(xr), cs = cosf(xi), sn = sinf(xi);
  S5P r;
  r.ar = e * cs; r.ai = e * sn;
  float sh = sinf(0.5f * xi);
  float nr = expm1f(xr) * cs - 2.f * sh * sh, ni = e * sn;
  float inv = 1.f / (lr * lr + li * li);
  r.br = (nr * lr + ni * li) * inv;
  r.bi = (ni * lr - nr * li) * inv;
  return r;
}

DEV void s5_load_u(const h16* zrest, int rowbase, int g, char* ulds, int lane) {
#pragma unroll
  for (int i = 0; i < 8; ++i) {
    int e = i * 64 + lane;
    int r = e >> 1, hf = e & 1;
    uint4 v = *(const uint4*)(zrest + (size_t)(rowbase + r) * ZR + g * 16 + hf * 8);
    *(uint4*)(ulds + r * 32 + hf * 16) = v;
  }
  lds_fence();
}

DEV int s5_rowbase(int b, int c) { return c == 0 ? NLAT + b * 256 : b * 16384 + (c - 1) * 256; }

DEV void s5_pass1_unit(const Params& p, const Ctx& cx, int l, int unit, char* wl, int lane) {
  int c = unit % 65, bg = unit / 65, g = bg & 31, b = bg >> 5;
  const h16* zrest = (const h16*)(p.ws + OFF_ZREST);
  float2* F = (float2*)(p.ws + OFF_S5F);
  s5_load_u(zrest, s5_rowbase(b, c), g, wl, lane);
  float Br[16], Bi[16];
  {
    const float* pr = p.s5_b_re + ((size_t)(l * 32 + g) * 64 + lane) * 16;
    const float* pi = p.s5_b_im + ((size_t)(l * 32 + g) * 64 + lane) * 16;
#pragma unroll
    for (int i = 0; i < 16; i += 4) {
      float4 a = *(const float4*)(pr + i), bq = *(const float4*)(pi + i);
      Br[i] = a.x; Br[i + 1] = a.y; Br[i + 2] = a.z; Br[i + 3] = a.w;
      Bi[i] = bq.x; Bi[i + 1] = bq.y; Bi[i + 2] = bq.z; Bi[i + 3] = bq.w;
    }
  }
  S5P pf = s5_params(p, cx, l, 0, g, lane), pb = s5_params(p, cx, l, 1, g, lane);
  float xr = 0, xi = 0, yr = 0, yi = 0, pwr = 1.f, pwi = 0.f;
#pragma unroll 4
  for (int t = 0; t < 256; ++t) {
    h16x8 u0 = *(const h16x8*)(wl + t * 32), u1 = *(const h16x8*)(wl + t * 32 + 16);
    float br = 0, bi = 0;
#pragma unroll
    for (int i = 0; i < 8; ++i) { float u = (float)u0[i]; br = fmaf(u, Br[i], br); bi = fmaf(u, Bi[i], bi); }
#pragma unroll
    for (int i = 0; i < 8; ++i) { float u = (float)u1[i]; br = fmaf(u, Br[8 + i], br); bi = fmaf(u, Bi[8 + i], bi); }
    float vr = pf.br * br - pf.bi * bi, vi = pf.br * bi + pf.bi * br;
    float nxr = pf.ar * xr - pf.ai * xi + vr, nxi = pf.ar * xi + pf.ai * xr + vi;
    xr = nxr; xi = nxi;
    float wr_ = pb.br * br - pb.bi * bi, wi_ = pb.br * bi + pb.bi * br;
    yr += pwr * wr_ - pwi * wi_; yi += pwr * wi_ + pwi * wr_;
    float npr = pwr * pb.ar - pwi * pb.ai, npi = pwr * pb.ai + pwi * pb.ar;
    pwr = npr; pwi = npi;
  }
  size_t fi = (((size_t)(b * 32 + g) * 65 + c) * 2) * 64 + lane;
  F[fi] = make_float2(xr, xi);
  F[fi + 64] = make_float2(yr, yi);
}

DEV void s5_pass3_unit(const Params& p, const Ctx& cx, int l, int unit, char* wl, int lane) {
  int c = unit % 65, bg = unit / 65, g = bg & 31, b = bg >> 5;
  const int fr = lane & 15, fq = lane >> 4;
  const h16* zrest = (const h16*)(p.ws + OFF_ZREST);
  const float2* F = (const float2*)(p.ws + OFF_S5F);
  float* S5Y = (float*)(p.ws + OFF_S5Y);
  const int rowbase = s5_rowbase(b, c);
  char* ulds = wl;
  char* tile = wl + 8192;
  s5_load_u(zrest, rowbase, g, ulds, lane);
  float Br[16], Bi[16];
  {
    const float* pr = p.s5_b_re + ((size_t)(l * 32 + g) * 64 + lane) * 16;
    const float* pi = p.s5_b_im + ((size_t)(l * 32 + g) * 64 + lane) * 16;
#pragma unroll
    for (int i = 0; i < 16; i += 4) {
      float4 a = *(const float4*)(pr + i), bq = *(const float4*)(pi + i);
      Br[i] = a.x; Br[i + 1] = a.y; Br[i + 2] = a.z; Br[i + 3] = a.w;
      Bi[i] = bq.x; Bi[i + 1] = bq.y; Bi[i + 2] = bq.z; Bi[i + 3] = bq.w;
    }
  }
  const float dsk = p.s5_d[(size_t)l * 512 + g * 16 + fr];
  const size_t fbase = ((size_t)(b * 32 + g) * 65) * 2 * 64 + lane;
#pragma unroll 1
  for (int d = 0; d < 2; ++d) {
    S5P pp = s5_params(p, cx, l, d, g, lane);
    float qr = pp.ar, qi = pp.ai;
#pragma unroll
    for (int i = 0; i < 8; ++i) { float t = qr * qr - qi * qi; qi = 2.f * qr * qi; qr = t; }
    float xr = 0, xi = 0;
    if (d == 0) {
      for (int cc = 0; cc < c; ++cc) {
        float2 f = F[fbase + (size_t)(cc * 2 + 0) * 64];
        float t = qr * xr - qi * xi + f.x; xi = qr * xi + qi * xr + f.y; xr = t;
      }
    } else if (c > 0) {
      float2 f0 = F[fbase + (size_t)(0 * 2 + 1) * 64];
      xr = f0.x; xi = f0.y;
      for (int cc = 64; cc > c; --cc) {
        float2 f = F[fbase + (size_t)(cc * 2 + 1) * 64];
        float t = qr * xr - qi * xi + f.x; xi = qr * xi + qi * xr + f.y; xr = t;
      }
    }
    bf16x8 chi[4], clo[4];
    {
      const float* cr = p.s5_c_re + ((size_t)((l * 2 + d) * 32 + g) * 16 + fr) * 64;
      const float* ci = p.s5_c_im + ((size_t)((l * 2 + d) * 32 + g) * 16 + fr) * 64;
#pragma unroll
      for (int ks = 0; ks < 4; ++ks) {
        float4 a = *(const float4*)(cr + ks * 16 + fq * 4), bq = *(const float4*)(ci + ks * 16 + fq * 4);
        float vals[8] = {a.x, -bq.x, a.y, -bq.y, a.z, -bq.z, a.w, -bq.w};
#pragma unroll
        for (int j = 0; j < 8; ++j) {
          h16 hh = (h16)vals[j];
          chi[ks][j] = hh;
          clo[ks][j] = (h16)(vals[j] - (float)hh);
        }
      }
    }
#pragma unroll 1
    for (int sb = 0; sb < 16; ++sb) {
      const int sub = d == 0 ? sb : 15 - sb;
#pragma unroll 4
      for (int q = 0; q < 16; ++q) {
        const int tt = d == 0 ? q : 15 - q;
        const int t = sub * 16 + tt;
        h16x8 u0 = *(const h16x8*)(ulds + t * 32), u1 = *(const h16x8*)(ulds + t * 32 + 16);
        float br = 0, bi = 0;
#pragma unroll
        for (int i = 0; i < 8; ++i) { float u = (float)u0[i]; br = fmaf(u, Br[i], br); bi = fmaf(u, Bi[i], bi); }
#pragma unroll
        for (int i = 0; i < 8; ++i) { float u = (float)u1[i]; br = fmaf(u, Br[8 + i], br); bi = fmaf(u, Bi[8 + i], bi); }
        float vr = pp.br * br - pp.bi * bi, vi = pp.br * bi + pp.bi * br;
        float nxr = pp.ar * xr - pp.ai * xi + vr, nxi = pp.ar * xi + pp.ai * xr + vi;
        xr = nxr; xi = nxi;
        h16x2 hv2 = {(h16)xr, (h16)xi};
        *(unsigned*)(tile + tt * 272 + lane * 4) = __builtin_bit_cast(unsigned, hv2);
      }
      lds_fence();
      f32x4 acc = f32x4{0.f, 0.f, 0.f, 0.f};
#pragma unroll
      for (int ks = 0; ks < 4; ++ks) {
        bf16x8 ah = *(const bf16x8*)(tile + fr * 272 + ks * 64 + fq * 16);
        acc = __builtin_amdgcn_mfma_f32_16x16x32_f16(ah, chi[ks], acc, 0, 0, 0);
        acc = __builtin_amdgcn_mfma_f32_16x16x32_f16(ah, clo[ks], acc, 0, 0, 0);
      }
      lds_fence();
#pragma unroll
      for (int r = 0; r < 4; ++r) {
        int tl = sub * 16 + fq * 4 + r;
        float* yp = S5Y + (size_t)(rowbase + tl) * 512 + g * 16 + fr;
        if (d == 0) {
          float u = (float)*(const h16*)(ulds + tl * 32 + fr * 2);
          *yp = acc[r] + dsk * u;
        } else {
          *yp = gelu_f(*yp + acc[r]);
        }
      }
    }
  }
}

DEV void prep_item(const Params& p, const Ctx& cx, int l, int item, char* smem) {
  const int tile = item >> 2, q = item & 3;
  const int row0 = tile * 64;
  const int tid = cx.tid;
  const h16* zc = (const h16*)(p.ws + OFF_REG2);
  h16* SC = (h16*)(p.ws + OFF_SCAN);
  const char* wt = p.ws + OFF_WT + (size_t)l * WT_SIZE;
  {
    const int d = q >> 1, isA = q & 1;
    const int coff = isA ? 3200 + d * 64 : 3072 + d * 64;
    int tok = tid >> 3, c8 = tid & 7;
    h16x8 cv = *(const h16x8*)(zc + (size_t)(row0 + tok) * ZC + coff + c8 * 8);
    float f[8];
#pragma unroll
    for (int j = 0; j < 8; ++j) { f[j] = (float)cv[j]; if (!isA) f[j] = tanh_f(f[j]); }
    uint4 o;
    o.x = pack_bf2(f[0], f[1]); o.y = pack_bf2(f[2], f[3]); o.z = pack_bf2(f[4], f[5]); o.w = pack_bf2(f[6], f[7]);
    *(uint4*)(smem + tok * 144 + c8 * 16) = o;
    __syncthreads();
    const bf16_t* Bt = (const bf16_t*)(wt + (isA ? WT_A2 : WT_W2)) + (size_t)d * 1024 * 64;
    const float* biasw = p.rwkv_w0 + (size_t)(l * 2 + d) * 1024;
    const float* biasa = p.rwkv_a0 + (size_t)(l * 2 + d) * 1024;
    h16* dst = SC + (size_t)(isA ? 4 + d : 6 + d) * ARR;
#pragma unroll 1
    for (int hf = 0; hf < 2; ++hf) small_gemm<64, 4>(p, cx, smem, 144, Bt, (tid >> 6) * 128 + hf * 64, [&](int m, int n, f32x4 v) {
      float4 bbw = *(const float4*)(biasw + n), bba = *(const float4*)(biasa + n);
      float4 bb = isA ? bba : bbw;
      float r0 = sigmoid_f(v[0] + bb.x), r1 = sigmoid_f(v[1] + bb.y), r2 = sigmoid_f(v[2] + bb.z), r3 = sigmoid_f(v[3] + bb.w);
      if (!isA) { r0 = __expf(-DECAY_SCALE * r0); r1 = __expf(-DECAY_SCALE * r1); r2 = __expf(-DECAY_SCALE * r2); r3 = __expf(-DECAY_SCALE * r3); }
      h16x4 o4 = {(h16)r0, (h16)r1, (h16)r2, (h16)r3};
      *(h16x4*)(dst + (size_t)(row0 + m) * 1024 + n) = o4;
    });
  }
  {
    const float* cw = p.conv_rkv + (size_t)l * 3 * 3072;
    const int grp = tid & 7, hh = (tid >> 3) & 3;
    const int c0 = (4 * q + hh) * 64 + grp * 8;
    float cwt[3][3][8];
#pragma unroll
    for (int s = 0; s < 3; ++s)
#pragma unroll
      for (int tp = 0; tp < 3; ++tp)
#pragma unroll
        for (int j = 0; j < 8; j += 4) {
          float4 a = *(const float4*)(cw + tp * 3072 + s * 1024 + c0 + j);
          cwt[s][tp][j] = a.x; cwt[s][tp][j + 1] = a.y; cwt[s][tp][j + 2] = a.z; cwt[s][tp][j + 3] = a.w;
        }
    float kkw[8];
#pragma unroll
    for (int j = 0; j < 8; j += 4) {
      float4 kq = *(const float4*)(p.rwkv_k_k + (size_t)l * 1024 + c0 + j);
      kkw[j] = kq.x; kkw[j + 1] = kq.y; kkw[j + 2] = kq.z; kkw[j + 3] = kq.w;
    }
#pragma unroll 1
    for (int it = 0; it < 4; ++it) {
      const int tok = (tid >> 5) + it * 16;
      const int row = row0 + tok;
      bool hasp, hasn;
      if (row < NLAT) { hasp = (row & 16383) != 0; hasn = (row & 16383) != 16383; }
      else { hasp = (row & 255) != 0; hasn = (row & 255) != 255; }
      const size_t off = (size_t)row * 1024 + c0;
      const h16* zp = zc + (size_t)row * ZC + c0;
      const h16* zpp = hasp ? zp - ZC : zp;
      const h16* zpn = hasn ? zp + ZC : zp;
      h16x8 cur[3], prv[3], nxt[3];
#pragma unroll
      for (int s = 0; s < 3; ++s) { cur[s] = *(const h16x8*)(zp + s * 1024); prv[s] = *(const h16x8*)(zpp + s * 1024); nxt[s] = *(const h16x8*)(zpn + s * 1024); }
      const float fp = hasp ? 1.f : 0.f, fn = hasn ? 1.f : 0.f;
      float kv[8];
#pragma unroll
      for (int s = 0; s < 3; ++s) {
        h16x8 o;
#pragma unroll
        for (int j = 0; j < 8; ++j) {
          float ov = cwt[s][0][j] * (fp * (float)prv[s][j]) + cwt[s][1][j] * (float)cur[s][j] + cwt[s][2][j] * (fn * (float)nxt[s][j]);
          o[j] = (h16)ov;
          if (s == 1) kv[j] = ov;
        }
        *(h16x8*)(SC + (size_t)s * ARR + off) = o;
      }
      float kk[8], ss = 0;
#pragma unroll
      for (int j = 0; j < 8; ++j) { kk[j] = kv[j] * kkw[j]; ss += kk[j] * kk[j]; }
      ss = allreduce8(ss);
      float inv = rcp_f(fmaxf(sqrtf(ss), 1e-12f));
      h16x8 o;
#pragma unroll
      for (int j = 0; j < 8; ++j) o[j] = (h16)(kk[j] * inv);
      *(h16x8*)(SC + 3 * ARR + off) = o;
    }
  }
}

DEV void phase_prep(const Params& p, const Ctx& cx0, int l, char* smem) {
  const int NPREP = 520 * 4, NS5 = 520;
  const Ctx& cx_ = cx0;
  for (int item = cx_.bid; item < NPREP + NS5; item += cx_.nblk) {
    __syncthreads();
    Ctx cx = cx0; asm volatile("" : "+v"(cx.tid));
    const int lane = cx.tid & 63, wid = cx.tid >> 6;
#ifndef NO_PREPITEM
    if (item < NPREP) prep_item(p, cx, l, item, smem);
    else
#endif
#ifndef NO_S5P1
      s5_pass1_unit(p, cx, l, (item - NPREP) * 8 + wid, smem + wid * 8192, lane);
#else
    {}
#endif
  }
}

typedef unsigned u2v __attribute__((ext_vector_type(2)));
struct RG { u2v w, a, kk, k, r; h16 v; };

constexpr int RW_NSLOT = 8, RW_SLOTB = 3072;
constexpr int RW_FLAGS = RW_NSLOT * RW_SLOTB;
constexpr int RW_NG = 16640 / 4;
typedef float f4v __attribute__((ext_vector_type(4)));

#define RW_RLO(gq, rlo)                                                            \
  {                                                                                \
    const int gg = (gq) < RW_NG ? (gq) : RW_NG - 1;                                \
    const int q0_ = gg * 4;                                                        \
    const int isl = q0_ >= 256;                                                    \
    const int base_ = isl ? b * 16384 : NLAT + b * 256;                            \
    const int t0_ = isl ? q0_ - 256 : q0_;                                         \
    const int last_ = isl ? 16383 : 255;                                           \
    rlo = base_ + (d ? last_ - t0_ - 3 : t0_);                                     \
  }

DEV void rwkv_helper(const Params& p, const Ctx& cx, int l, int unit, int lane, char* ring) {
  const int d = unit & 1, h = (unit >> 1) & 15, b = unit >> 5;
  const int j = lane >> 4, s = lane & 15;
  const h16* SC = (const h16*)(p.ws + OFF_SCAN);
  const char* pR = (const char*)(SC + 0 * ARR + h * 64);
  const char* pK = (const char*)(SC + 1 * ARR + h * 64);
  const char* pV = (const char*)(SC + 2 * ARR + h * 64);
  const char* pKK = (const char*)(SC + 3 * ARR + h * 64);
  const char* pA = (const char*)(SC + (size_t)(4 + d) * ARR + h * 64);
  const char* pW = (const char*)(SC + (size_t)(6 + d) * ARR + h * 64);
  const int jm = d ? 3 - j : j;
  const unsigned vo0 = (unsigned)(jm * 2048 + s * 8);
  f4v ka4, om4;
  {
    float4 t = *(const float4*)(p.rwkv_k_a + (size_t)l * 1024 + h * 64 + 4 * s);
    ka4 = f4v{t.x, t.y, t.z, t.w};
    om4 = 1.f - ka4;
  }
  struct RGH { u2v w, a, kk, k, r, v; };
  RGH q0, q1, q2, q3, q4, q5, q6, q7;
  const unsigned wofs = (unsigned)(j * 128 + s * 8);
  const unsigned vwofs = (unsigned)(2560 + j * 128 + s * 8);
  LAS3 volatile int* pflag = (LAS3 volatile int*)(ring + RW_FLAGS);
  LAS3 volatile int* cflag = (LAS3 volatile int*)(ring + RW_FLAGS + 64);
  int cmin = 0;
#define CV4(uv) __builtin_convertvector(__builtin_bit_cast(h16x4, uv), f4v)
#define RH_LOAD(q, gq)                                                             \
  {                                                                                \
    int rlo; RW_RLO(gq, rlo);                                                      \
    unsigned vo = vo0; asm volatile("" : "+v"(vo));                                \
    const size_t off = (size_t)rlo * 2048;                                         \
    q.w = *(const u2v*)(pW + off + vo); q.a = *(const u2v*)(pA + off + vo);        \
    q.kk = *(const u2v*)(pKK + off + vo); q.k = *(const u2v*)(pK + off + vo);      \
    q.r = *(const u2v*)(pR + off + vo); q.v = *(const u2v*)(pV + off + vo);        \
  }
#define RH_STEP(q, gq)                                                             \
  {                                                                                \
    if ((gq) >= RW_NSLOT && cmin < (gq) - RW_NSLOT + 1) {                          \
      do {                                                                         \
        const int c0_ = cflag[0], c1_ = cflag[1], c2_ = cflag[2], c3_ = cflag[3];  \
        cmin = __builtin_amdgcn_readfirstlane(min(min(c0_, c1_), min(c2_, c3_)));  \
        if (cmin < (gq) - RW_NSLOT + 1) __builtin_amdgcn_s_sleep(1);               \
      } while (cmin < (gq) - RW_NSLOT + 1);                                        \
    }                                                                              \
    asm volatile("" ::: "memory");                                                 \
    char* sl = ring + ((gq) % RW_NSLOT) * RW_SLOTB;                                \
    const f4v a_ = CV4(q.a), kk_ = CV4(q.kk);                                      \
    const f4v kka_ = kk_ * a_, kd_ = CV4(q.k) * (a_ * ka4 + om4);                  \
    *(u2v*)(sl + 0 * 512 + wofs) = q.w;                                            \
    *(u2v*)(sl + 1 * 512 + wofs) = q.kk;                                           \
    *(u2v*)(sl + 2 * 512 + wofs) = __builtin_bit_cast(u2v, __builtin_convertvector(kka_, h16x4)); \
    *(u2v*)(sl + 3 * 512 + wofs) = __builtin_bit_cast(u2v, __builtin_convertvector(kd_, h16x4));  \
    *(u2v*)(sl + 4 * 512 + wofs) = q.r;                                            \
    *(u2v*)(sl + vwofs) = q.v;                                                     \
    asm volatile("s_waitcnt lgkmcnt(0)" ::: "memory");     \
    *pflag = (gq) + 1;                                                             \
  }
  RH_LOAD(q0, 0); RH_LOAD(q1, 1); RH_LOAD(q2, 2); RH_LOAD(q3, 3); RH_LOAD(q4, 4); RH_LOAD(q5, 5); RH_LOAD(q6, 6); RH_LOAD(q7, 7);
#pragma unroll 1
  for (int g = 0; g < RW_NG; g += 8) {
    RH_STEP(q0, g); RH_LOAD(q0, g + 8); __builtin_amdgcn_sched_barrier(0);
    RH_STEP(q1, g + 1); RH_LOAD(q1, g + 9); __builtin_amdgcn_sched_barrier(0);
    RH_STEP(q2, g + 2); RH_LOAD(q2, g + 10); __builtin_amdgcn_sched_barrier(0);
    RH_STEP(q3, g + 3); RH_LOAD(q3, g + 11); __builtin_amdgcn_sched_barrier(0);
    RH_STEP(q4, g + 4); RH_LOAD(q4, g + 12); __builtin_amdgcn_sched_barrier(0);
    RH_STEP(q5, g + 5); RH_LOAD(q5, g + 13); __builtin_amdgcn_sched_barrier(0);
    RH_STEP(q6, g + 6); RH_LOAD(q6, g + 14); __builtin_amdgcn_sched_barrier(0);
    RH_STEP(q7, g + 7); RH_LOAD(q7, g + 15); __builtin_amdgcn_sched_barrier(0);
  }
#undef RH_LOAD
#undef RH_STEP
#undef CV4
}

DEV void rwkv_consumer(const Params& p, const Ctx& cx, int l, int task, int lane, const char* ring, int widx) {
  const int unit = task >> 4, d = unit & 1, h = (unit >> 1) & 15, b = unit >> 5;
  const int j = lane >> 4, s = lane & 15;
  const int myrow = (task & 15) * 4 + j;
  char* pO = (char*)((h16*)(p.ws + OFF_REG2) + (size_t)d * ARR + h * 64);
  const int sm = d ? 3 - (s & 3) : (s & 3);
  const unsigned vov0 = (unsigned)(sm * 2048 + myrow * 2);
  const unsigned rofs = (unsigned)(s * 8);
  const unsigned vrofs = (unsigned)(2560 + myrow * 2);
  LAS3 volatile int* pflag = (LAS3 volatile int*)(ring + RW_FLAGS);
  LAS3 volatile int* cflag = (LAS3 volatile int*)(ring + RW_FLAGS + 64) + widx;
  float S0 = 0.f, S1 = 0.f, S2 = 0.f, S3 = 0.f;
  int pseen = 0, slotc = 0;
#pragma unroll 1
  for (int g = 0; g < RW_NG; ++g) {
    if (pseen <= g) {
      do {
        pseen = __builtin_amdgcn_readfirstlane(*pflag);
        if (pseen <= g) __builtin_amdgcn_s_sleep(1);
      } while (pseen <= g);
    }
    asm volatile("" ::: "memory");
    const char* sl = ring + slotc * RW_SLOTB;
    float dres[4];
#pragma unroll
    for (int u = 0; u < 4; ++u) {
      const u2v w_ = *(const u2v*)(sl + 0 * 512 + u * 128 + rofs);
      const u2v kk_ = *(const u2v*)(sl + 1 * 512 + u * 128 + rofs);
      const u2v kka_ = *(const u2v*)(sl + 2 * 512 + u * 128 + rofs);
      const u2v kd_ = *(const u2v*)(sl + 3 * 512 + u * 128 + rofs);
      const u2v r_ = *(const u2v*)(sl + 4 * 512 + u * 128 + rofs);
      const unsigned vj = *(const unsigned short*)(sl + u * 128 + vrofs);
      float pa, pb;
      asm("v_fma_mix_f32 %0, %2, %6, 0 op_sel:[0,0,0] op_sel_hi:[0,1,0]\n\t"
          "v_fma_mix_f32 %1, %4, %7, 0 op_sel:[0,0,0] op_sel_hi:[0,1,0]\n\t"
          "v_fma_mix_f32 %0, %3, %6, %0 op_sel:[0,1,0] op_sel_hi:[0,1,0]\n\t"
          "v_fma_mix_f32 %1, %5, %7, %1 op_sel:[0,1,0] op_sel_hi:[0,1,0]"
          : "=&v"(pa), "=&v"(pb) : "v"(S0), "v"(S1), "v"(S2), "v"(S3), "v"(kk_.x), "v"(kk_.y));
      const float d1 = allreduce16(pa + pb);
      float ea, eb, t0, t1, t2, t3;
      asm("v_fma_mix_f32 %6, %18, %12, 0 op_sel:[0,0,0] op_sel_hi:[1,1,0]\n\t"
          "v_fma_mix_f32 %7, %18, %12, 0 op_sel:[0,1,0] op_sel_hi:[1,1,0]\n\t"
          "v_fma_mix_f32 %8, %18, %13, 0 op_sel:[0,0,0] op_sel_hi:[1,1,0]\n\t"
          "v_fma_mix_f32 %9, %18, %13, 0 op_sel:[0,1,0] op_sel_hi:[1,1,0]\n\t"
          "v_fma_mix_f32 %0, %0, %10, %6 op_sel:[0,0,0] op_sel_hi:[0,1,0]\n\t"
          "v_fma_mix_f32 %1, %1, %10, %7 op_sel:[0,1,0] op_sel_hi:[0,1,0]\n\t"
          "v_fma_mix_f32 %2, %2, %11, %8 op_sel:[0,0,0] op_sel_hi:[0,1,0]\n\t"
          "v_fma_mix_f32 %3, %3, %11, %9 op_sel:[0,1,0] op_sel_hi:[0,1,0]\n\t"
          "v_fma_mix_f32 %0, -%19, %14, %0 op_sel:[0,0,0] op_sel_hi:[0,1,0]\n\t"
          "v_fma_mix_f32 %1, -%19, %14, %1 op_sel:[0,1,0] op_sel_hi:[0,1,0]\n\t"
          "v_fma_mix_f32 %2, -%19, %15, %2 op_sel:[0,0,0] op_sel_hi:[0,1,0]\n\t"
          "v_fma_mix_f32 %3, -%19, %15, %3 op_sel:[0,1,0] op_sel_hi:[0,1,0]\n\t"
          "v_fma_mix_f32 %4, %0, %16, 0 op_sel:[0,0,0] op_sel_hi:[0,1,0]\n\t"
          "v_fma_mix_f32 %5, %2, %17, 0 op_sel:[0,0,0] op_sel_hi:[0,1,0]\n\t"
          "v_fma_mix_f32 %4, %1, %16, %4 op_sel:[0,1,0] op_sel_hi:[0,1,0]\n\t"
          "v_fma_mix_f32 %5, %3, %17, %5 op_sel:[0,1,0] op_sel_hi:[0,1,0]"
          : "+v"(S0), "+v"(S1), "+v"(S2), "+v"(S3), "=&v"(ea), "=&v"(eb), "=&v"(t0), "=&v"(t1), "=&v"(t2), "=&v"(t3)
          : "v"(w_.x), "v"(w_.y), "v"(kd_.x), "v"(kd_.y), "v"(kka_.x), "v"(kka_.y), "v"(r_.x), "v"(r_.y), "v"(vj), "v"(d1));
      dres[u] = ea + eb;
    }
    asm volatile("s_waitcnt lgkmcnt(0)" ::: "memory");
    *cflag = g + 1;
    {
      int rlo; RW_RLO(g, rlo);
      unsigned vov = vov0; asm volatile("" : "+v"(vov));
      const bool p1_ = (s & 1) != 0, p2_ = (s & 2) != 0;
      const float a_ = (p1_ ? dres[1] : dres[0]) + dpp_mov<0xB1>(p1_ ? dres[0] : dres[1]);
      const float b_ = (p1_ ? dres[3] : dres[2]) + dpp_mov<0xB1>(p1_ ? dres[2] : dres[3]);
      float val = (p2_ ? b_ : a_) + dpp_mov<0x4E>(p2_ ? a_ : b_);
      val += dpp_mov<0x124>(val);
      val += dpp_mov<0x128>(val);
      *(h16*)(pO + (size_t)rlo * 2048 + vov) = (h16)val;
    }
    slotc = (slotc == RW_NSLOT - 1) ? 0 : slotc + 1;
  }
}
#undef RW_RLO

DEV void phase_scan(const Params& p, const Ctx& cx, int l, char* smem) {
  const int lane = cx.tid & 63, wid = __builtin_amdgcn_readfirstlane(cx.tid >> 6);
  for (int slot = cx.bid; slot < 256; slot += cx.nblk) {
    __syncthreads();
    if (wid == 4 && lane < 8) *(LAS3 volatile int*)(smem + RW_FLAGS + (lane == 0 ? 0 : 64 + (lane & 3) * 4)) = 0;
    __syncthreads();
    const int unit = slot & 63;
#ifndef NO_RWKV
    if (wid < 4) rwkv_consumer(p, cx, l, (unit << 4) | ((slot >> 6) << 2) | wid, lane, smem, wid);
    else if (wid == 4) rwkv_helper(p, cx, l, unit, lane, smem);
#endif
  }
  if (wid >= 5) {
    char* wl = smem + 32768 + (wid - 5) * 17408;
    for (int u = cx.bid * 3 + (wid - 5); u < 2 * 32 * 65; u += cx.nblk * 3) {
      if (l == 1 && (u % 65) == 0) continue;
#ifndef NO_S5P3
      s5_pass3_unit(p, cx, l, u, wl, lane);
#endif
    }
  }
}

DEV void pool_item(const Params& p, const Ctx& cx, int l, int item, char* smem) {
  const int tid = cx.tid;
  const h16* zrest = (const h16*)(p.ws + OFF_ZREST);
  bf16_t* ym = (bf16_t*)(p.ws + OFF_YM);
  const char* wt = p.ws + OFF_WT + (size_t)l * WT_SIZE;
  float* V = (float*)smem;
  char* At = smem + 43008;
  int g, rowout0, Lseq, p0, rlo, rhi, rstride, rowsrc0;
  if (item < 2048) {
    g = item & 3; int r = (item >> 2) & 255, b = item >> 10;
    int w = 2 << g;
    rlo = max(r - w / 2, 0); rhi = min(r + w / 2 - 1, 255);
    rowsrc0 = b * 16384; rstride = 64;
    rowout0 = b * 16384 + r * 64; Lseq = 64; p0 = 0;
  } else {
    int it = item - 2048;
    g = it & 3; int tq = (it >> 2) & 3, b = it >> 4;
    rlo = 0; rhi = 0; rowsrc0 = NLAT + b * 256; rstride = 0;
    rowout0 = NLAT + b * 256 + tq * 64; Lseq = 256; p0 = tq * 64;
  }
  const int w = 2 << g;
  const float invr = 1.f / (float)(rhi - rlo + 1);
  for (int unit = tid; unit < 80 * 16; unit += NTHREADS) {
    int lp = unit >> 4, ch8 = unit & 15;
    int pos = p0 - 8 + lp;
    float acc[8] = {0, 0, 0, 0, 0, 0, 0, 0};
    if (pos >= 0 && pos < Lseq) {
      const h16* bp = zrest + (size_t)(rowsrc0 + pos) * ZR + 1024 + g * 128 + ch8 * 8;
      const int nr = rhi - rlo + 1;
      for (int k0 = 0; k0 < nr; k0 += 4) {
        h16x8 v[4]; float wv[4];
#pragma unroll
        for (int i = 0; i < 4; ++i) {
          const int kk_ = min(k0 + i, nr - 1);
          wv[i] = (k0 + i < nr) ? 1.f : 0.f;
          v[i] = *(const h16x8*)(bp + (size_t)((rlo + kk_) * rstride) * ZR);
        }
#pragma unroll
        for (int i = 0; i < 4; ++i)
#pragma unroll
          for (int j = 0; j < 8; ++j) acc[j] += wv[i] * (float)v[i][j];
      }
    }
    float* vp = V + lp * 132 + ch8 * 8;
#pragma unroll
    for (int j = 0; j < 8; ++j) vp[j] = acc[j] * invr;
  }
  __syncthreads();
  for (int unit = tid; unit < 64 * 16; unit += NTHREADS) {
    int c = unit >> 4, ch8 = unit & 15;
    int pos = p0 + c;
    int lo = max(pos - w / 2, 0), hi = min(pos + w / 2 - 1, Lseq - 1);
    float acc[8] = {0, 0, 0, 0, 0, 0, 0, 0};
    for (int pp = lo; pp <= hi; ++pp) {
      const float* vp = V + (pp - p0 + 8) * 132 + ch8 * 8;
#pragma unroll
      for (int j = 0; j < 8; ++j) acc[j] += vp[j];
    }
    float invc = 1.f / (float)(hi - lo + 1);
    h16x8 uc = *(const h16x8*)(zrest + (size_t)(rowout0 + c) * ZR + 1024 + g * 128 + ch8 * 8);
    uint4 o;
    o.x = pack_bf2(acc[0] * invc - (float)uc[0], acc[1] * invc - (float)uc[1]);
    o.y = pack_bf2(acc[2] * invc - (float)uc[2], acc[3] * invc - (float)uc[3]);
    o.z = pack_bf2(acc[4] * invc - (float)uc[4], acc[5] * invc - (float)uc[5]);
    o.w = pack_bf2(acc[6] * invc - (float)uc[6], acc[7] * invc - (float)uc[7]);
    *(uint4*)(At + c * 272 + ch8 * 16) = o;
  }
  __syncthreads();
  const bf16_t* Bt = (const bf16_t*)(wt + WT_POOL) + (size_t)g * 128 * 128;
  const float* ps = p.pool_scale + (size_t)l * 512 + g * 128;
  small_gemm<128, 1>(p, cx, At, 272, Bt, (tid >> 6) * 16, [&](int m, int n, f32x4 v) {
    int row = rowout0 + m;
    float4 sc = *(const float4*)(ps + n);
    h16x4 gt = *(const h16x4*)(zrest + (size_t)row * ZR + 1536 + g * 128 + n);
    uint2 o;
    o.x = pack_bf2(v[0] * sc.x * silu_f((float)gt[0]), v[1] * sc.y * silu_f((float)gt[1]));
    o.y = pack_bf2(v[2] * sc.z * silu_f((float)gt[2]), v[3] * sc.w * silu_f((float)gt[3]));
    *(uint2*)(ym + (size_t)row * D + 512 + g * 128 + n) = o;
  });
}

DEV void glu_item(const Params& p, const Ctx& cx, int l, int tile, char* smem) {
  const int tid = cx.tid;
  const int row0 = tile * 64;
  const float* S5Y = (const float*)(p.ws + OFF_S5Y);
  const h16* zrest = (const h16*)(p.ws + OFF_ZREST);
  bf16_t* ym = (bf16_t*)(p.ws + OFF_YM);
  const char* wt = p.ws + OFF_WT + (size_t)l * WT_SIZE;
#pragma unroll
  for (int it = 0; it < 8; ++it) {
    int unit = tid + it * NTHREADS;
    int r = unit >> 6, c8 = unit & 63;
    const float* sp = S5Y + (size_t)(row0 + r) * 512 + c8 * 8;
    float4 a = *(const float4*)sp, bq = *(const float4*)(sp + 4);
    uint4 o;
    o.x = pack_bf2(a.x, a.y); o.y = pack_bf2(a.z, a.w); o.z = pack_bf2(bq.x, bq.y); o.w = pack_bf2(bq.z, bq.w);
    *(uint4*)(smem + r * 1040 + c8 * 16) = o;
  }
  __syncthreads();
  const bf16_t* Bt = (const bf16_t*)(wt + WT_GLU);
  const float* bg = p.b_glu + (size_t)l * 512;
  small_gemm<512, 4>(p, cx, smem, 1040, Bt, (tid >> 6) * 64, [&](int m, int n, f32x4 v) {
    int row = row0 + m;
    float4 y = *(const float4*)(S5Y + (size_t)row * 512 + n);
    float4 bb = *(const float4*)(bg + n);
    h16x4 gt = *(const h16x4*)(zrest + (size_t)row * ZR + 512 + n);
    uint2 o;
    o.x = pack_bf2(y.x * sigmoid_f(v[0] + bb.x) * silu_f((float)gt[0]), y.y * sigmoid_f(v[1] + bb.y) * silu_f((float)gt[1]));
    o.y = pack_bf2(y.z * sigmoid_f(v[2] + bb.z) * silu_f((float)gt[2]), y.w * sigmoid_f(v[3] + bb.w) * silu_f((float)gt[3]));
    *(uint2*)(ym + (size_t)row * D + n) = o;
  });
}

DEV void rwkvmerge_item(const Params& p, const Ctx& cx, int l, int tile) {
  const int tid = cx.tid;
  const int row0 = tile * 64;
  const h16* SC = (const h16*)(p.ws + OFF_SCAN);
  const h16* O = (const h16*)(p.ws + OFF_REG2);
  const h16* zrest = (const h16*)(p.ws + OFF_ZREST);
  bf16_t* ym = (bf16_t*)(p.ws + OFF_YM);
  const int grp = tid & 7, h = (tid >> 3) & 15;
  const int c0 = h * 64 + grp * 8;
  float pk[8], rk[8], gw[8], gb[8];
#pragma unroll
  for (int j = 0; j < 8; j += 4) {
    float4 t0 = *(const float4*)(p.rwkv_k_a + (size_t)l * 1024 + c0 + j), t1 = *(const float4*)(p.rwkv_r_k + (size_t)l * 1024 + c0 + j);
    float4 t2 = *(const float4*)(p.gn_w + (size_t)l * 1024 + c0 + j), t3 = *(const float4*)(p.gn_b + (size_t)l * 1024 + c0 + j);
    pk[j] = t0.x; pk[j + 1] = t0.y; pk[j + 2] = t0.z; pk[j + 3] = t0.w;
    rk[j] = t1.x; rk[j + 1] = t1.y; rk[j + 2] = t1.z; rk[j + 3] = t1.w;
    gw[j] = t2.x; gw[j + 1] = t2.y; gw[j + 2] = t2.z; gw[j + 3] = t2.w;
    gb[j] = t3.x; gb[j + 1] = t3.y; gb[j + 2] = t3.z; gb[j + 3] = t3.w;
  }
#pragma unroll 2
  for (int it = 0; it < 16; ++it) {
    const int tok = (tid >> 7) + it * 4;
    int row = row0 + tok;
    size_t off = (size_t)row * 1024 + c0;
    h16x8 of = *(const h16x8*)(O + off), ob = *(const h16x8*)(O + ARR + off);
    h16x8 r8 = *(const h16x8*)(SC + 0 * ARR + off), k8 = *(const h16x8*)(SC + 1 * ARR + off), v8 = *(const h16x8*)(SC + 2 * ARR + off);
    h16x8 af = *(const h16x8*)(SC + 4 * ARR + off), ab = *(const h16x8*)(SC + 5 * ARR + off);
    h16x8 gt = *(const h16x8*)(zrest + (size_t)row * ZR + 2048 + c0);
    float o[8], sm = 0;
#pragma unroll
    for (int j = 0; j < 8; ++j) { o[j] = (float)of[j] + (float)ob[j]; sm += o[j]; }
    sm = allreduce8(sm);
    float mu = sm * (1.f / 64.f), vq = 0;
#pragma unroll
    for (int j = 0; j < 8; ++j) { o[j] -= mu; vq += o[j] * o[j]; }
    vq = allreduce8(vq);
    float rstd = rsqrtf(vq * (1.f / 64.f) + 64e-5f);
    float part = 0;
#pragma unroll
    for (int j = 0; j < 8; ++j) {
      float ksum = (float)k8[j] * (2.f + ((float)af[j] + (float)ab[j] - 2.f) * pk[j]);
      part += (float)r8[j] * ksum * rk[j];
    }
    part = allreduce8(part);
    float res[8];
#pragma unroll
    for (int j = 0; j < 8; ++j) {
      float y = o[j] * rstd * gw[j] + gb[j] + part * (float)v8[j];
      res[j] = y * silu_f((float)gt[j]);
    }
    uint4 ov;
    ov.x = pack_bf2(res[0], res[1]); ov.y = pack_bf2(res[2], res[3]); ov.z = pack_bf2(res[4], res[5]); ov.w = pack_bf2(res[6], res[7]);
    *(uint4*)(ym + (size_t)row * D + 1024 + c0) = ov;
  }
}

DEV void phase_merge(const Params& p, const Ctx& cx0, int l, char* smem) {
  const int ntile = (l == 0) ? 520 : 512;
  const int npool = (l == 0) ? 2048 + 32 : 2048;
  const int total = npool + 2 * ntile;
  for (int item = cx0.bid; item < total; item += cx0.nblk) {
    __syncthreads();
    Ctx cx = cx0; asm volatile("" : "+v"(cx.tid));
    if (item < npool) pool_item(p, cx, l, item, smem);
    else if (item < npool + ntile) glu_item(p, cx, l, item - npool, smem);
    else rwkvmerge_item(p, cx, l, item - npool - ntile);
  }
}

#define LCX Ctx c2 = cx; asm volatile("" : "+v"(c2.tid))
#ifndef GEMM_FN
#define GEMM_FN gemm_phase2
#endif
__global__ void __launch_bounds__(NTHREADS) mega_fwd(Params p, int ph0, int ph1) {
  extern __shared__ __attribute__((aligned(16))) char smem[];
  cg::grid_group grid = cg::this_grid();
  const int wave_s = __builtin_amdgcn_readfirstlane((int)(threadIdx.x >> 6));
  for (int step = ph0; step < ph1; ++step) {
    if (step > ph0) grid.sync();
    const int ph = (int)((PH_SEQ >> (4 * step)) & 15ull);
    Ctx cx;
    {
      int t_, b_ = blockIdx.x, n_ = gridDim.x;
      asm volatile("v_mbcnt_lo_u32_b32 %0, -1, 0\n\tv_mbcnt_hi_u32_b32 %0, -1, %0\n\tv_lshl_add_u32 %0, %1, 6, %0" : "=&v"(t_) : "s"(wave_s));
      asm volatile("" : "+s"(b_), "+s"(n_));
      cx.tid = t_; cx.bid = b_; cx.nblk = n_;
    }
    const int l = ph >= 8 ? 1 : 0;
    const int lp = ph >= 8 ? ph - 6 : ph;
#ifndef PHMASK
#define PHMASK 0xff
#endif
    if (ph == 0) { if (PHMASK & 1) { LCX; phase0(p, c2, smem); } }
    else if (ph == 1) { if (PHMASK & 2) { LCX; phase_adaln0(p, c2); } }
    else if (lp == 2 && (PHMASK & 4)) {
      LCX;
      h16* zrest = (h16*)(p.ws + OFF_ZREST);
      h16* zc = (h16*)(p.ws + OFF_REG2);
      GEMM_FN(p, c2, (const bf16_t*)(p.ws + OFF_H), (const bf16_t*)(p.ws + OFF_WT + (size_t)l * WT_SIZE + WT_IN), 2048, 130, 25, smem,
                 [&](int row, int col, f32x4 v, f32x4 u) {
                   h16* dst;
                   if (col < 2048) dst = zrest + (size_t)row * ZR + col;
                   else if (col < 5120) dst = zc + (size_t)row * ZC + (col - 2048);
                   else if (col < 6144) dst = zrest + (size_t)row * ZR + 2048 + (col - 5120);
                   else dst = zc + (size_t)row * ZC + 3072 + (col - 6144);
                   h16x8 o = {(h16)v[0], (h16)v[1], (h16)v[2], (h16)v[3], (h16)u[0], (h16)u[1], (h16)u[2], (h16)u[3]};
                   *(h16x8*)dst = o;
                 });
    } else if (lp == 3) { if (PHMASK & 8) { LCX; phase_prep(p, c2, l, smem); } }
    else if (lp == 4) { if (PHMASK & 16) { LCX; phase_scan(p, c2, l, smem); } }
    else if (lp == 5) { if (PHMASK & 32) { LCX; phase_merge(p, c2, l, smem); } }
    else if (lp == 6 && (PHMASK & 64)) {
      LCX;
      const float* mods = (const float*)(p.ws + OFF_MODS);
      float* prec = (float*)(p.ws + OFF_PREC);
      const float* xin = (l == 0) ? p.x : p.out;
      GEMM_FN(p, c2, (const bf16_t*)(p.ws + OFF_YM), (const bf16_t*)(p.ws + OFF_WT + (size_t)l * WT_SIZE + WT_OUT), 2048, l == 0 ? 130 : 128, 8, smem,
                 [&](int row, int col, f32x4 v, f32x4 u) {
                   const float* xr; const float* gr; float* dr;
                   if (row < NLAT) {
                     xr = xin + (size_t)row * D + col; gr = mods + (size_t)(l * 3 + (row >> 14)) * 6144 + 4096 + col; dr = p.out + (size_t)row * D + col;
                   } else {
                     xr = p.ctx + (size_t)(row - NLAT) * D + col; gr = mods + (size_t)(l * 3 + 2) * 6144 + 4096 + col; dr = prec + (size_t)(row - NLAT) * D + col;
                   }
                   const float4 x0 = *(const float4*)xr, x1 = *(const float4*)(xr + 4), g0 = *(const float4*)gr, g1 = *(const float4*)(gr + 4);
                   float4 r0, r1;
                   r0.x = ALPHA * x0.x + g0.x * v[0]; r0.y = ALPHA * x0.y + g0.y * v[1]; r0.z = ALPHA * x0.z + g0.z * v[2]; r0.w = ALPHA * x0.w + g0.w * v[3];
                   r1.x = ALPHA * x1.x + g1.x * u[0]; r1.y = ALPHA * x1.y + g1.y * u[1]; r1.z = ALPHA * x1.z + g1.z * u[2]; r1.w = ALPHA * x1.w + g1.w * u[3];
                   *(float4*)dr = r0; *(float4*)(dr + 4) = r1;
                 });
    } else if (lp == 7) { if (PHMASK & 128) { LCX; phase_finln(p, c2, l); } }
  }
}

constexpr int NPHASES = PH_NSTEPS;

extern "C" void kernel_launch(void* const* d_in, const int* in_sizes, int n_in, void* d_out, int out_size, void* d_ws, size_t ws_size,
                              hipStream_t stream) {
  static int grid_blocks = 0;
  if (grid_blocks == 0) {
    if (n_in != 32 || ws_size < WS_END) { fprintf(stderr, "kernel_launch: unexpected n_in %d / ws %zu (need %zu)\n", n_in, ws_size, (size_t)WS_END); grid_blocks = -1; return; }
    int dev = 0, cus = 0, per_cu = 0;
    hipGetDevice(&dev);
    hipDeviceGetAttribute(&cus, hipDeviceAttributeMultiprocessorCount, dev);
    if (hipFuncSetAttribute((const void*)mega_fwd, hipFuncAttributeMaxDynamicSharedMemorySize, LDS_BYTES) != hipSuccess) { fprintf(stderr, "hipFuncSetAttribute failed\n"); grid_blocks = -1; return; }
    if (hipOccupancyMaxActiveBlocksPerMultiprocessor(&per_cu, (const void*)mega_fwd, NTHREADS, LDS_BYTES) != hipSuccess || per_cu < 1) {
      fprintf(stderr, "occupancy query gave %d\n", per_cu); (void)hipGetLastError(); per_cu = 1;
    }
    grid_blocks = cus * per_cu;
  }
  if (grid_blocks < 0) return;
  Params p{};
  const float** pp = (const float**)&p;
  for (int i = 0; i < 32; ++i) pp[i] = (const float*)d_in[i];
  p.out = (float*)d_out;
  p.ws = (char*)d_ws;
  int ph0 = 0, ph1 = NPHASES;
  void* args[] = {&p, &ph0, &ph1};
  hipError_t e = hipLaunchCooperativeKernel((const void*)mega_fwd, dim3(grid_blocks), dim3(NTHREADS), args, LDS_BYTES, stream);
  if (e != hipSuccess) fprintf(stderr, "cooperative launch failed: %s (grid %d)\n", hipGetErrorString(e), grid_blocks);
}
```

```cpp
#include <hip/hip_runtime.h>
#include <hip/hip_cooperative_groups.h>
#include <cstdio>
namespace cg = cooperative_groups;

typedef unsigned short bf16_t;
typedef _Float16 h16;
using bf16x8 = __attribute__((ext_vector_type(8))) _Float16;
using f32x4 = __attribute__((ext_vector_type(4))) float;
using h16x4 = __attribute__((ext_vector_type(4))) _Float16;
using h16x8 = __attribute__((ext_vector_type(8))) _Float16;

#define DEV __device__ __forceinline__

constexpr int D = 2048, NLAT = 32768, MTOT = 33280, ZR = 3072, ZC = 3328;
constexpr int NTHREADS = 512;
constexpr int LDS_BYTES = 147456;
constexpr float ALPHA = 1.41421356237f;
constexpr float DECAY_SCALE = 0.606531f;

constexpr size_t al256(size_t x) { return (x + 255) & ~size_t(255); }
constexpr size_t ARR = (size_t)MTOT * 1024;
constexpr size_t OFF_MODS = 0;
constexpr size_t OFF_S5F = al256(OFF_MODS + 2 * 3 * 6144 * 4);
constexpr size_t OFF_PREC = al256(OFF_S5F + (size_t)2 * 32 * 65 * 2 * 64 * 8);
constexpr size_t OFF_WT = al256(OFF_PREC + (size_t)512 * 2048 * 4);
constexpr size_t WT_IN = 0, WT_OUT = 26214400, WT_W2 = 34603008, WT_A2 = 34865152, WT_POOL = 35127296, WT_GLU = 35258368, WT_SIZE = 35782656;
constexpr size_t OFF_ZREST = al256(OFF_WT + 2 * WT_SIZE);
constexpr size_t OFF_REG2 = al256(OFF_ZREST + (size_t)MTOT * ZR * 2);
constexpr size_t OFF_S5Y = OFF_REG2 + 2 * ARR * 2;
constexpr size_t OFF_SCAN = al256(OFF_REG2 + (size_t)MTOT * ZC * 2);
constexpr size_t OFF_H = OFF_SCAN;
constexpr size_t OFF_YM = OFF_SCAN + 6 * ARR * 2;
constexpr size_t WS_END = OFF_SCAN + 8 * ARR * 2;

#ifndef PH_SEQ
#define PH_SEQ 0xDCBA9876543210ull
#define PH_NSTEPS 14
#endif
struct Params {
  const float *x, *c, *ctx, *c_ctx, *w_ada, *b_ada, *w_in, *conv_rkv, *s5_lam_re, *s5_lam_im, *s5_log_step,
      *s5_b_re, *s5_b_im, *s5_c_re, *s5_c_im, *s5_d, *w_glu, *b_glu, *w_pool, *pool_scale,
      *rwkv_w0, *rwkv_w2, *rwkv_a0, *rwkv_a2, *rwkv_k_k, *rwkv_k_a, *rwkv_r_k, *gn_w, *gn_b,
      *w_out, *ln_g, *ln_b;
  float* out;
  char* ws;
};
struct Ctx { int tid, bid, nblk; };

DEV float rcp_f(float x) { return __builtin_amdgcn_rcpf(x); }
DEV float sigmoid_f(float x) { return rcp_f(1.f + __expf(-x)); }
DEV float silu_f(float x) { return x * rcp_f(1.f + __expf(-x)); }
DEV float tanh_f(float x) { float e = __expf(2.f * x); return 1.f - 2.f * rcp_f(e + 1.f); }
DEV float gelu_f(float y) { return 0.5f * y * (1.f + tanh_f(0.7978845608f * (y + 0.044715f * y * y * y))); }
using h16x2 = __attribute__((ext_vector_type(2))) _Float16;
DEV unsigned pack_bf2(float a, float b) { h16x2 v = {(h16)a, (h16)b}; return __builtin_bit_cast(unsigned, v); }
template <int CTRL> DEV float dpp_mov(float v) {
  return __int_as_float(__builtin_amdgcn_update_dpp(0, __float_as_int(v), CTRL, 0xf, 0xf, true));
}
DEV float allreduce16(float v) {
  v += dpp_mov<0xB1>(v);
  v += dpp_mov<0x4E>(v);
  v += dpp_mov<0x141>(v);
  v += dpp_mov<0x140>(v);
  return v;
}
DEV float wave_sum(float v) {
  v = allreduce16(v);
  return __builtin_amdgcn_readlane(__float_as_int(v), 0) == 0 && false ? 0.f :
         __int_as_float(__builtin_amdgcn_readlane(__float_as_int(v), 0)) + __int_as_float(__builtin_amdgcn_readlane(__float_as_int(v), 16)) +
         __int_as_float(__builtin_amdgcn_readlane(__float_as_int(v), 32)) + __int_as_float(__builtin_amdgcn_readlane(__float_as_int(v), 48));
}
DEV float allreduce8(float v) {
  v += dpp_mov<0xB1>(v);
  v += dpp_mov<0x4E>(v);
  v += dpp_mov<0x141>(v);
  return v;
}
DEV void lds_fence() { asm volatile("s_waitcnt lgkmcnt(0)" ::: "memory"); }

DEV void p0_mods_item(const Params& p, const Ctx& cx, int item, char* smem) {
  float* red = (float*)smem;
  float* mods = (float*)(p.ws + OFF_MODS);
  int l = item / 96, chunk = item % 96;
  int tid = cx.tid, kq = tid >> 6, col = tid & 63;
  int n = chunk * 64 + col;
  const float* W = p.w_ada + (size_t)l * 2048 * 6144;
  float a0 = 0, a1 = 0, a2 = 0;
#pragma unroll 8
  for (int k = kq; k < 2048; k += 8) {
    float w = W[(size_t)k * 6144 + n];
    a0 += silu_f(p.c[k]) * w;
    a1 += silu_f(p.c[2048 + k]) * w;
    a2 += silu_f(p.c_ctx[k]) * w;
  }
  red[(kq * 3 + 0) * 64 + col] = a0;
  red[(kq * 3 + 1) * 64 + col] = a1;
  red[(kq * 3 + 2) * 64 + col] = a2;
  __syncthreads();
  if (tid < 192) {
    int r = tid >> 6, cc = tid & 63;
    float s = 0;
#pragma unroll
    for (int q = 0; q < 8; ++q) s += red[(q * 3 + r) * 64 + cc];
    mods[(size_t)(l * 3 + r) * 6144 + chunk * 64 + cc] = s + p.b_ada[(size_t)l * 6144 + chunk * 64 + cc];
  }
}

DEV void p0_transpose_tile(const Params& p, const Ctx& cx, const float* __restrict__ src, bf16_t* __restrict__ dst, int K, int N, int tk, int tn, char* smem) {
  float* T = (float*)smem;
  int tid = cx.tid;
  int k0 = tk * 64, n0 = tn * 64;
  int kk = tid >> 4, n4 = tid & 15;
#pragma unroll
  for (int i = 0; i < 2; ++i) {
    int k = kk + 32 * i;
    float4 v = *(const float4*)(src + (size_t)(k0 + k) * N + n0 + n4 * 4);
    T[k * 65 + n4 * 4 + 0] = v.x; T[k * 65 + n4 * 4 + 1] = v.y; T[k * 65 + n4 * 4 + 2] = v.z; T[k * 65 + n4 * 4 + 3] = v.w;
  }
  __syncthreads();
  int n = tid >> 3, k8 = tid & 7;
  uint4 o;
  o.x = pack_bf2(T[(k8 * 8 + 0) * 65 + n], T[(k8 * 8 + 1) * 65 + n]);
  o.y = pack_bf2(T[(k8 * 8 + 2) * 65 + n], T[(k8 * 8 + 3) * 65 + n]);
  o.z = pack_bf2(T[(k8 * 8 + 4) * 65 + n], T[(k8 * 8 + 5) * 65 + n]);
  o.w = pack_bf2(T[(k8 * 8 + 6) * 65 + n], T[(k8 * 8 + 7) * 65 + n]);
  *(uint4*)(dst + (size_t)(n0 + n) * K + k0 + k8 * 8) = o;
}

DEV void phase0(const Params& p, const Ctx& cx0, char* smem) {
  const int NTR = 4368;
  const int total = 192 + 2 * NTR;
  for (int item = cx0.bid; item < total; item += cx0.nblk) {
    __syncthreads();
    Ctx cx = cx0; asm volatile("" : "+v"(cx.tid));
    if (item < 192) { p0_mods_item(p, cx, item, smem); continue; }
    int it = item - 192;
    int l = it / NTR, i = it % NTR;
    char* wt = p.ws + OFF_WT + (size_t)l * WT_SIZE;
    if (i < 3200) {
      p0_transpose_tile(p, cx, p.w_in + (size_t)l * 2048 * 6400, (bf16_t*)(wt + WT_IN), 2048, 6400, i / 100, i % 100, smem);
    } else if (i < 4224) {
      int j = i - 3200;
      p0_transpose_tile(p, cx, p.w_out + (size_t)l * 2048 * 2048, (bf16_t*)(wt + WT_OUT), 2048, 2048, j / 32, j % 32, smem);
    } else if (i < 4256) {
      int j = i - 4224, d = j / 16;
      p0_transpose_tile(p, cx, p.rwkv_w2 + (size_t)(l * 2 + d) * 64 * 1024, (bf16_t*)(wt + WT_W2) + (size_t)d * 1024 * 64, 64, 1024, 0, j % 16, smem);
    } else if (i < 4288) {
      int j = i - 4256, d = j / 16;
      p0_transpose_tile(p, cx, p.rwkv_a2 + (size_t)(l * 2 + d) * 64 * 1024, (bf16_t*)(wt + WT_A2) + (size_t)d * 1024 * 64, 64, 1024, 0, j % 16, smem);
    } else if (i < 4304) {
      int j = i - 4288, g = j / 4;
      p0_transpose_tile(p, cx, p.w_pool + (size_t)(l * 4 + g) * 128 * 128, (bf16_t*)(wt + WT_POOL) + (size_t)g * 128 * 128, 128, 128, (j % 4) / 2, j % 2, smem);
    } else {
      int j = i - 4304;
      p0_transpose_tile(p, cx, p.w_glu + (size_t)l * 512 * 512, (bf16_t*)(wt + WT_GLU), 512, 512, j / 8, j % 8, smem);
    }
  }
}

DEV void phase_adaln0(const Params& p, const Ctx& cx) {
  const float* mods = (const float*)(p.ws + OFF_MODS);
  bf16_t* hbuf = (bf16_t*)(p.ws + OFF_H);
  int lane = cx.tid & 63;
  int gw = cx.bid * 8 + (cx.tid >> 6), nw = cx.nblk * 8;
  for (int row = gw; row < MTOT; row += nw) {
    const float* src = row < NLAT ? p.x + (size_t)row * D : p.ctx + (size_t)(row - NLAT) * D;
    int mr = row < NLAT ? (row >> 14) : 2;
    const float* md = mods + (size_t)mr * 6144;
    float4 v[8];
    float s = 0;
#pragma unroll
    for (int i = 0; i < 8; ++i) { v[i] = *(const float4*)(src + i * 256 + lane * 4); s += v[i].x + v[i].y + v[i].z + v[i].w; }
    float mu = wave_sum(s) * (1.f / 2048.f);
    float q = 0;
#pragma unroll
    for (int i = 0; i < 8; ++i) { v[i].x -= mu; v[i].y -= mu; v[i].z -= mu; v[i].w -= mu; q += v[i].x * v[i].x + v[i].y * v[i].y + v[i].z * v[i].z + v[i].w * v[i].w; }
    float rstd = rsqrtf(wave_sum(q) * (1.f / 2048.f) + 1e-6f);
#pragma unroll
    for (int i = 0; i < 8; ++i) {
      int col = i * 256 + lane * 4;
      float4 sh = *(const float4*)(md + col), sc = *(const float4*)(md + 2048 + col);
      uint2 o;
      o.x = pack_bf2(v[i].x * rstd * (1.f + sc.x) + sh.x, v[i].y * rstd * (1.f + sc.y) + sh.y);
      o.y = pack_bf2(v[i].z * rstd * (1.f + sc.z) + sh.z, v[i].w * rstd * (1.f + sc.w) + sh.w);
      *(uint2*)(hbuf + (size_t)row * D + col) = o;
    }
  }
}

DEV void phase_finln(const Params& p, const Ctx& cx, int l) {
  const float* mods = (const float*)(p.ws + OFF_MODS);
  bf16_t* hbuf = (bf16_t*)(p.ws + OFF_H);
  float* prec = (float*)(p.ws + OFF_PREC);
  int lane = cx.tid & 63;
  int gw = cx.bid * 8 + (cx.tid >> 6), nw = cx.nblk * 8;
  const int nrows = (l == 0) ? MTOT : NLAT;
  for (int row = gw; row < nrows; row += nw) {
    float* src = row < NLAT ? p.out + (size_t)row * D : prec + (size_t)(row - NLAT) * D;
    float4 v[8];
    float s = 0;
#pragma unroll
    for (int i = 0; i < 8; ++i) { v[i] = *(const float4*)(src + i * 256 + lane * 4); s += v[i].x + v[i].y + v[i].z + v[i].w; }
    float mu = wave_sum(s) * (1.f / 2048.f);
    float q = 0;
#pragma unroll
    for (int i = 0; i < 8; ++i) { v[i].x -= mu; v[i].y -= mu; v[i].z -= mu; v[i].w -= mu; q += v[i].x * v[i].x + v[i].y * v[i].y + v[i].z * v[i].z + v[i].w * v[i].w; }
    float rstd = rsqrtf(wave_sum(q) * (1.f / 2048.f) + 1e-5f);
    float s2 = 0;
#pragma unroll
    for (int i = 0; i < 8; ++i) {
      int col = i * 256 + lane * 4;
      float4 g = *(const float4*)(p.ln_g + (size_t)l * D + col), b = *(const float4*)(p.ln_b + (size_t)l * D + col);
      v[i].x = v[i].x * rstd * g.x + b.x; v[i].y = v[i].y * rstd * g.y + b.y; v[i].z = v[i].z * rstd * g.z + b.z; v[i].w = v[i].w * rstd * g.w + b.w;
      if (row < NLAT) *(float4*)(src + col) = v[i];
      s2 += v[i].x + v[i].y + v[i].z + v[i].w;
    }
    if (l == 0) {
      int mr = row < NLAT ? (row >> 14) : 2;
      const float* md = mods + (size_t)(3 + mr) * 6144;
      float mu2 = wave_sum(s2) * (1.f / 2048.f);
      float q2 = 0;
#pragma unroll
      for (int i = 0; i < 8; ++i) { v[i].x -= mu2; v[i].y -= mu2; v[i].z -= mu2; v[i].w -= mu2; q2 += v[i].x * v[i].x + v[i].y * v[i].y + v[i].z * v[i].z + v[i].w * v[i].w; }
      float rstd2 = rsqrtf(wave_sum(q2) * (1.f / 2048.f) + 1e-6f);
#pragma unroll
      for (int i = 0; i < 8; ++i) {
        int col = i * 256 + lane * 4;
        float4 sh = *(const float4*)(md + col), sc = *(const float4*)(md + 2048 + col);
        uint2 o;
        o.x = pack_bf2(v[i].x * rstd2 * (1.f + sc.x) + sh.x, v[i].y * rstd2 * (1.f + sc.y) + sh.y);
        o.y = pack_bf2(v[i].z * rstd2 * (1.f + sc.z) + sh.z, v[i].w * rstd2 * (1.f + sc.w) + sh.w);
        *(uint2*)(hbuf + (size_t)row * D + col) = o;
      }
    }
  }
}

template <class Epi>
DEV void gemm_phase(const Params& p, const Ctx& cx, const bf16_t* __restrict__ A, const bf16_t* __restrict__ Bt, int K, int nM, int nN, char* smem, Epi epi) {
  const int tid = cx.tid, lane = tid & 63, wid = tid >> 6;
  const int wr = wid >> 2, wc = wid & 3, fr = lane & 15, fq = lane >> 4;
  const int nt = K / 64;
  const int ntiles = nM * nN;
  const int srow = tid >> 3, sc16 = tid & 7;
  const int nxcd = (cx.nblk & 7) == 0 ? 8 : 1;
  const int xcd = cx.bid % nxcd, xidx = cx.bid / nxcd, xper = cx.nblk / nxcd;
  const int t_lo = (int)(((long)ntiles * xcd) / nxcd), t_hi = (int)(((long)ntiles * (xcd + 1)) / nxcd);
  for (int tt = t_lo + xidx; tt < t_hi; tt += xper) {
    const int band = tt / (16 * nN);
    const int brows = min(16, nM - band * 16);
    const int rem = tt - band * 16 * nN;
    const int pn = rem / brows, pm = band * 16 + rem % brows;
    const int brow = pm * 256, bcol = pn * 256;
    const char* Ab = (const char*)(A + (size_t)brow * K);
    const char* Bb = (const char*)(Bt + (size_t)bcol * K);
    const unsigned voff = (unsigned)(srow * K + sc16 * 8) * 2u;
    const size_t rs = (size_t)64 * K * 2;
    f32x4 acc[8][4];
#pragma unroll
    for (int i = 0; i < 8; ++i)
#pragma unroll
      for (int j = 0; j < 4; ++j) acc[i][j] = f32x4{0.f, 0.f, 0.f, 0.f};
    uint4 ra0, ra1, ra2, ra3, rb0, rb1, rb2, rb3;
#define G_LD(ko) { const char* a_ = Ab + (size_t)(ko) * 2; const char* b_ = Bb + (size_t)(ko) * 2; \
                 ra0 = *(const uint4*)(a_ + voff); ra1 = *(const uint4*)(a_ + rs + voff); ra2 = *(const uint4*)(a_ + 2 * rs + voff); ra3 = *(const uint4*)(a_ + 3 * rs + voff); \
                 rb0 = *(const uint4*)(b_ + voff); rb1 = *(const uint4*)(b_ + rs + voff); rb2 = *(const uint4*)(b_ + 2 * rs + voff); rb3 = *(const uint4*)(b_ + 3 * rs + voff); }
#define G_ST(sp) { *(uint4*)(sp) = ra0; *(uint4*)((sp) + 64 * 144) = ra1; *(uint4*)((sp) + 128 * 144) = ra2; *(uint4*)((sp) + 192 * 144) = ra3; \
                 *(uint4*)((sp) + 36864) = rb0; *(uint4*)((sp) + 36864 + 64 * 144) = rb1; *(uint4*)((sp) + 36864 + 128 * 144) = rb2; *(uint4*)((sp) + 36864 + 192 * 144) = rb3; }
    char* const sbase = smem + srow * 144 + sc16 * 16;
    G_LD(0);
    G_ST(sbase);
    if (nt > 1) G_LD(64);
    for (int kt = 0; kt < nt; ++kt) {
      __syncthreads();
      if (kt + 1 < nt) { char* s1 = sbase + ((kt + 1) & 1) * 73728; G_ST(s1); }
      if (kt + 2 < nt) G_LD((kt + 2) * 64);
      const char* As = smem + (kt & 1) * 73728;
      const char* Bs = As + 36864;
#pragma unroll
      for (int kh = 0; kh < 2; ++kh) {
        bf16x8 bfr[4];
#pragma unroll
        for (int jn = 0; jn < 4; ++jn) bfr[jn] = *(const bf16x8*)(Bs + (wc * 64 + jn * 16 + fr) * 144 + kh * 64 + fq * 16);
#pragma unroll
        for (int i = 0; i < 8; ++i) {
          bf16x8 af = *(const bf16x8*)(As + (wr * 128 + i * 16 + fr) * 144 + kh * 64 + fq * 16);
#pragma unroll
          for (int jn = 0; jn < 4; ++jn) acc[i][jn] = __builtin_amdgcn_mfma_f32_16x16x32_f16(bfr[jn], af, acc[i][jn], 0, 0, 0);
        }
      }
    }
    __syncthreads();
#pragma unroll
    for (int i = 0; i < 8; ++i)
#pragma unroll
      for (int jn = 0; jn < 4; ++jn) epi(brow + wr * 128 + i * 16 + fr, bcol + wc * 64 + jn * 16 + fq * 4, acc[i][jn]);
  }
}

#define LAS3 __attribute__((address_space(3)))
DEV int g2_lds_byte(int r, int c) { const int st = (r >> 4) * 2 + (c >> 5), rr = r & 15, cc = c & 31, ob = rr * 64 + cc * 2; return st * 1024 + (ob ^ (((ob >> 9) & 1) << 5)); }
DEV void g2_stage_rc(int b, int& R, int& C) { const int st = b / 1024, sb = b % 1024, swz = sb ^ (((sb >> 9) & 1) << 5); R = (st >> 1) * 16 + swz / 64; C = (st & 1) * 32 + (swz % 64) / 2; }

template <class Epi>
DEV void gemm_phase2(const Params& p, const Ctx& cx, const bf16_t* __restrict__ A, const bf16_t* __restrict__ Bt, int K, int nM, int nN, char* smem, Epi epi) {
  constexpr int HTB = 128 * 64 * 2;
  LAS3 unsigned char* lds = (LAS3 unsigned char*)smem;
  const int tid = cx.tid, wid = __builtin_amdgcn_readfirstlane(tid >> 6), lane = tid & 63, wr = wid >> 2, wc = wid & 3, fr = lane & 15, fq = lane >> 4;
  const int nt = K / 64;
  const int ntiles = nM * nN;
  const int nxcd = (cx.nblk & 7) == 0 ? 8 : 1;
  const int xcd = cx.bid % nxcd, xidx = cx.bid / nxcd, xper = cx.nblk / nxcd;
  const int t_lo = (int)(((long)ntiles * xcd) / nxcd), t_hi = (int)(((long)ntiles * (xcd + 1)) / nxcd);
  auto unit_at = [&](int i, int& pm, int& pn) -> bool {
    const int tt = t_lo + xidx + i * xper;
    if (tt >= t_hi) return false;
    const int band = tt / (16 * nN);
    const int brows = min(16, nM - band * 16);
    const int rem = tt - band * 16 * nN;
    pn = rem / brows; pm = band * 16 + rem % brows;
    return true;
  };
  unsigned voffA[2], voffB[2];
#pragma unroll
  for (int i = 0; i < 2; ++i) {
    int R, C; g2_stage_rc(tid * 16 + i * 8192, R, C);
    const int rho = R & 31, Rb = (R & ~31) + 8 * ((rho & 15) >> 2) + 4 * (rho >> 4) + (rho & 3);
    voffA[i] = (unsigned)(R * K + C) * 2u; voffB[i] = (unsigned)(Rb * K + C) * 2u;
  }
  const size_t kstep = (size_t)(64 * 2);
  const size_t hstep = (size_t)128 * K * 2;
  const size_t tstep = 2 * hstep;
  const unsigned ldsw = (unsigned)wid * 1024u;
  const int aoff = g2_lds_byte(wr * 64 + fr, fq * 8), boff = g2_lds_byte(wc * 32 + fr, fq * 8);
#define G2_SA(b, h) (((b) * 2 + (h)) * HTB)
#define G2_SB(b, h) ((4 + (b) * 2 + (h)) * HTB)
#define G2_STAGE_(bufoff, gbase, vo_) do { _Pragma("unroll") for (int _i = 0; _i < 2; ++_i) \
    __builtin_amdgcn_global_load_lds((const unsigned*)((const char*)(gbase) + vo_[_i]), (LAS3 unsigned*)(lds + (bufoff) + ldsw + _i * 8192), 16, 0, 0); } while (0)
#define G2_STAGE(bufoff, gbase) G2_STAGE_(bufoff, gbase, voffA)
#define G2_STAGEB(bufoff, gbase) G2_STAGE_(bufoff, gbase, voffB)
#define G2_LDA(dst, b, h) do { _Pragma("unroll") for (int m = 0; m < 4; ++m) _Pragma("unroll") for (int k = 0; k < 2; ++k) dst[m][k] = *(const LAS3 bf16x8*)(lds + G2_SA(b, h) + aoff + m * 2048 + k * 1024); } while (0)
#define G2_LDB(dst, b, h) do { _Pragma("unroll") for (int n = 0; n < 2; ++n) _Pragma("unroll") for (int k = 0; k < 2; ++k) dst[n][k] = *(const LAS3 bf16x8*)(lds + G2_SB(b, h) + boff + n * 2048 + k * 1024); } while (0)
#define G2_MMA(ai, bj, At_, Bt_) do { __builtin_amdgcn_s_setprio(1); _Pragma("unroll") for (int m = 0; m < 4; ++m) _Pragma("unroll") for (int n = 0; n < 2; ++n) _Pragma("unroll") for (int k = 0; k < 2; ++k) \
    acc[ai][bj][m][n] = __builtin_amdgcn_mfma_f32_16x16x32_f16(Bt_[n][k], At_[m][k], acc[ai][bj][m][n], 0, 0, 0); __builtin_amdgcn_s_setprio(0); } while (0)
#define G2_WAIT_V(n) asm volatile("s_waitcnt vmcnt(" #n ")" ::: "memory")
#define G2_WAIT_L(n) asm volatile("s_waitcnt lgkmcnt(" #n ")" ::: "memory")
#define G2_BAR __builtin_amdgcn_s_barrier()
#define G2_SCHED __builtin_amdgcn_sched_barrier(0)
  int cpm, cpn, npm = 0, npn = 0, ui = 0;
  if (!unit_at(0, cpm, cpn)) return;
  f32x4 acc[2][2][4][2];
#pragma unroll
  for (int a = 0; a < 2; ++a)
#pragma unroll
    for (int b = 0; b < 2; ++b)
#pragma unroll
      for (int m = 0; m < 4; ++m)
#pragma unroll
        for (int n = 0; n < 2; ++n) acc[a][b][m][n] = f32x4{0.f, 0.f, 0.f, 0.f};
  bf16x8 At[4][2], B0[2][2], B1[2][2];
  const char* cA = (const char*)A + (size_t)cpm * tstep;
  const char* cB = (const char*)Bt + (size_t)cpn * tstep;
  G2_STAGEB(G2_SB(0, 0), cB); G2_STAGE(G2_SA(0, 0), cA); G2_STAGEB(G2_SB(0, 1), cB + hstep); G2_STAGE(G2_SA(0, 1), cA + hstep);
  if (wr == 1) G2_BAR;
  G2_WAIT_V(4); G2_BAR;
  G2_STAGEB(G2_SB(1, 0), cB + kstep); G2_STAGE(G2_SA(1, 0), cA + kstep); G2_STAGEB(G2_SB(1, 1), cB + hstep + kstep);
  G2_WAIT_V(6); G2_BAR;
  for (;;) {
    const bool has_next = unit_at(ui + 1, npm, npn);
    const char* nA = has_next ? (const char*)A + (size_t)npm * tstep : cA;
    const char* nB = has_next ? (const char*)Bt + (size_t)npn * tstep : cB;
    for (int t = 0; t < nt; t += 2) {
      const bool last = (t == nt - 2);
      const char* a1 = cA + (size_t)(t + 1) * kstep;
      const char* a2 = last ? nA : cA + (size_t)(t + 2) * kstep;
      const char* b2 = last ? nB : cB + (size_t)(t + 2) * kstep;
      const char* a3 = a2 + kstep;
      const char* b3 = b2 + kstep;
      G2_LDB(B0, 0, 0); G2_SCHED; G2_LDA(At, 0, 0); G2_STAGE(G2_SA(1, 1), a1 + hstep);
      G2_WAIT_L(8); G2_BAR; G2_WAIT_L(0); G2_MMA(0, 0, At, B0); G2_BAR; G2_SCHED;
      G2_LDB(B1, 0, 1); G2_STAGEB(G2_SB(0, 0), b2);
      G2_BAR; G2_WAIT_L(0); G2_MMA(0, 1, At, B1); G2_BAR;
      G2_LDA(At, 0, 1); G2_STAGE(G2_SA(0, 0), a2);
      G2_BAR; G2_WAIT_L(0); G2_MMA(1, 0, At, B0); G2_BAR; G2_SCHED;
      G2_STAGEB(G2_SB(0, 1), b2 + hstep);
      G2_WAIT_V(6); G2_BAR; G2_MMA(1, 1, At, B1); G2_BAR;
      G2_LDB(B0, 1, 0); G2_SCHED; G2_LDA(At, 1, 0); G2_STAGE(G2_SA(0, 1), a2 + hstep);
      G2_WAIT_L(8); G2_BAR; G2_WAIT_L(0); G2_MMA(0, 0, At, B0); G2_BAR; G2_SCHED;
      G2_LDB(B1, 1, 1); G2_STAGEB(G2_SB(1, 0), b3);
      G2_BAR; G2_WAIT_L(0); G2_MMA(0, 1, At, B1); G2_BAR;
      G2_LDA(At, 1, 1); G2_STAGE(G2_SA(1, 0), a3);
      G2_BAR; G2_WAIT_L(0); G2_MMA(1, 0, At, B0); G2_BAR; G2_SCHED;
      G2_STAGEB(G2_SB(1, 1), b3 + hstep);
      G2_WAIT_V(6); G2_BAR; G2_MMA(1, 1, At, B1); G2_BAR;
    }
    {
      const int row0 = cpm * 256 + wr * 64 + fr, col0 = cpn * 256 + wc * 32 + 8 * fq;
#pragma unroll
      for (int ai = 0; ai < 2; ++ai)
#pragma unroll
        for (int m = 0; m < 4; ++m)
#pragma unroll
          for (int bj = 0; bj < 2; ++bj) epi(row0 + ai * 128 + m * 16, col0 + bj * 128, acc[ai][bj][m][0], acc[ai][bj][m][1]);
    }
    if (!has_next) break;
#pragma unroll
    for (int a = 0; a < 2; ++a)
#pragma unroll
      for (int b = 0; b < 2; ++b)
#pragma unroll
        for (int m = 0; m < 4; ++m)
#pragma unroll
          for (int n = 0; n < 2; ++n) acc[a][b][m][n] = f32x4{0.f, 0.f, 0.f, 0.f};
    cpm = npm; cpn = npn; cA = nA; cB = nB; ++ui;
  }
  G2_WAIT_V(0);
  if (wr == 0) G2_BAR;
  G2_BAR;
#undef G2_SA
#undef G2_SB
#undef G2_STAGE
#undef G2_STAGEB
#undef G2_STAGE_
#undef G2_LDA
#undef G2_LDB
#undef G2_MMA
#undef G2_WAIT_V
#undef G2_WAIT_L
#undef G2_BAR
#undef G2_SCHED
}

template <int K, int NT, class Epi>
DEV void small_gemm(const Params& p, const Ctx& cx, const char* As, int astride, const bf16_t* __restrict__ Bt, int n0, Epi epi) {
  const int lane = cx.tid & 63, fr = lane & 15, fq = lane >> 4;
  f32x4 acc[4][NT];
#pragma unroll
  for (int i = 0; i < 4; ++i)
#pragma unroll
    for (int j = 0; j < NT; ++j) acc[i][j] = f32x4{0.f, 0.f, 0.f, 0.f};
#pragma unroll 2
  for (int k0 = 0; k0 < K; k0 += 32) {
    bf16x8 af[4];
#pragma unroll
    for (int i = 0; i < 4; ++i) af[i] = *(const bf16x8*)(As + (i * 16 + fr) * astride + (k0 + fq * 8) * 2);
#pragma unroll
    for (int jn = 0; jn < NT; ++jn) {
      bf16x8 bf = *(const bf16x8*)(Bt + (size_t)(n0 + jn * 16 + fr) * K + k0 + fq * 8);
#pragma unroll
      for (int i = 0; i < 4; ++i) acc[i][jn] = __builtin_amdgcn_mfma_f32_16x16x32_f16(bf, af[i], acc[i][jn], 0, 0, 0);
    }
  }
#pragma unroll
  for (int i = 0; i < 4; ++i)
#pragma unroll
    for (int jn = 0; jn < NT; ++jn) epi(i * 16 + fr, n0 + jn * 16 + fq * 4, acc[i][jn]);
}

struct S5P { float ar, ai, br, bi; };
DEV S5P s5_params(const Params& p, const Ctx& cx, int l, int d, int g, int lane) {
  int idx = ((l * 2 + d) * 32 + g) * 64 + lane;
  float lr = fminf(p.s5_lam_re[idx], -1e-4f), li = p.s5_lam_im[idx];
  float step = expf(p.s5_log_step[(l * 2 + d) * 32 + g]);
  float xr = lr * step, xi = li * step;
  float e = expf(xr), cs = cosf(xi), sn = sinf(xi);
  S5P r;
  r.ar = e * cs; r.ai = e * sn;
  float sh = sinf(0.5f * xi);
  float nr = expm1f(xr) * cs - 2.f * sh * sh, ni = e * sn;
  float inv = 1.f / (lr * lr + li * li);
  r.br = (nr * lr + ni * li) * inv;
  r.bi = (ni * lr - nr * li) * inv;
  return r;
}

DEV void s5_load_u(const h16* zrest, int rowbase, int g, char* ulds, int lane) {
#pragma unroll
  for (int i = 0; i < 8; ++i) {
    int e = i * 64 + lane;
    int r = e >> 1, hf = e & 1;
    uint4 v = *(const uint4*)(zrest + (size_t)(rowbase + r) * ZR + g * 16 + hf * 8);
    *(uint4*)(ulds + r * 32 + hf * 16) = v;
  }
  lds_fence();
}

DEV int s5_rowbase(int b, int c) { return c == 0 ? NLAT + b * 256 : b * 16384 + (c - 1) * 256; }

DEV void s5_pass1_unit(const Params& p, const Ctx& cx, int l, int unit, char* wl, int lane) {
  int c = unit % 65, bg = unit / 65, g = bg & 31, b = bg >> 5;
  const h16* zrest = (const h16*)(p.ws + OFF_ZREST);
  float2* F = (float2*)(p.ws + OFF_S5F);
  s5_load_u(zrest, s5_rowbase(b, c), g, wl, lane);
  float Br[16], Bi[16];
  {
    const float* pr = p.s5_b_re + ((size_t)(l * 32 + g) * 64 + lane) * 16;
    const float* pi = p.s5_b_im + ((size_t)(l * 32 + g) * 64 + lane) * 16;
#pragma unroll
    for (int i = 0; i < 16; i += 4) {
      float4 a = *(const float4*)(pr + i), bq = *(const float4*)(pi + i);
      Br[i] = a.x; Br[i + 1] = a.y; Br[i + 2] = a.z; Br[i + 3] = a.w;
      Bi[i] = bq.x; Bi[i + 1] = bq.y; Bi[i + 2] = bq.z; Bi[i + 3] = bq.w;
    }
  }
  S5P pf = s5_params(p, cx, l, 0, g, lane), pb = s5_params(p, cx, l, 1, g, lane);
  float xr = 0, xi = 0, yr = 0, yi = 0, pwr = 1.f, pwi = 0.f;
#pragma unroll 4
  for (int t = 0; t < 256; ++t) {
    h16x8 u0 = *(const h16x8*)(wl + t * 32), u1 = *(const h16x8*)(wl + t * 32 + 16);
    float br = 0, bi = 0;
#pragma unroll
    for (int i = 0; i < 8; ++i) { float u = (float)u0[i]; br = fmaf(u, Br[i], br); bi = fmaf(u, Bi[i], bi); }
#pragma unroll
    for (int i = 0; i < 8; ++i) { float u = (float)u1[i]; br = fmaf(u, Br[8 + i], br); bi = fmaf(u, Bi[8 + i], bi); }
    float vr = pf.br * br - pf.bi * bi, vi = pf.br * bi + pf.bi * br;
    float nxr = pf.ar * xr - pf.ai * xi + vr, nxi = pf.ar * xi + pf.ai * xr + vi;
    xr = nxr; xi = nxi;
    float wr_ = pb.br * br - pb.bi * bi, wi_ = pb.br * bi + pb.bi * br;
    yr += pwr * wr_ - pwi * wi_; yi += pwr * wi_ + pwi * wr_;
    float npr = pwr * pb.ar - pwi * pb.ai, npi = pwr * pb.ai + pwi * pb.ar;
    pwr = npr; pwi = npi;
  }
  size_t fi = (((size_t)(b * 32 + g) * 65 + c) * 2) * 64 + lane;
  F[fi] = make_float2(xr, xi);
  F[fi + 64] = make_float2(yr, yi);
}

DEV void s5_pass3_unit(const Params& p, const Ctx& cx, int l, int unit, char* wl, int lane) {
  int c = unit % 65, bg = unit / 65, g = bg & 31, b = bg >> 5;
  const int fr = lane & 15, fq = lane >> 4;
  const h16* zrest = (const h16*)(p.ws + OFF_ZREST);
  const float2* F = (const float2*)(p.ws + OFF_S5F);
  float* S5Y = (float*)(p.ws + OFF_S5Y);
  const int rowbase = s5_rowbase(b, c);
  char* ulds = wl;
  char* tile = wl + 8192;
  s5_load_u(zrest, rowbase, g, ulds, lane);
  float Br[16], Bi[16];
  {
    const float* pr = p.s5_b_re + ((size_t)(l * 32 + g) * 64 + lane) * 16;
    const float* pi = p.s5_b_im + ((size_t)(l * 32 + g) * 64 + lane) * 16;
#pragma unroll
    for (int i = 0; i < 16; i += 4) {
      float4 a = *(const float4*)(pr + i), bq = *(const float4*)(pi + i);
      Br[i] = a.x; Br[i + 1] = a.y; Br[i + 2] = a.z; Br[i + 3] = a.w;
      Bi[i] = bq.x; Bi[i + 1] = bq.y; Bi[i + 2] = bq.z; Bi[i + 3] = bq.w;
    }
  }
  const float dsk = p.s5_d[(size_t)l * 512 + g * 16 + fr];
  const size_t fbase = ((size_t)(b * 32 + g) * 65) * 2 * 64 + lane;
#pragma unroll 1
  for (int d = 0; d < 2; ++d) {
    S5P pp = s5_params(p, cx, l, d, g, lane);
    float qr = pp.ar, qi = pp.ai;
#pragma unroll
    for (int i = 0; i < 8; ++i) { float t = qr * qr - qi * qi; qi = 2.f * qr * qi; qr = t; }
    float xr = 0, xi = 0;
    if (d == 0) {
      for (int cc = 0; cc < c; ++cc) {
        float2 f = F[fbase + (size_t)(cc * 2 + 0) * 64];
        float t = qr * xr - qi * xi + f.x; xi = qr * xi + qi * xr + f.y; xr = t;
      }
    } else if (c > 0) {
      float2 f0 = F[fbase + (size_t)(0 * 2 + 1) * 64];
      xr = f0.x; xi = f0.y;
      for (int cc = 64; cc > c; --cc) {
        float2 f = F[fbase + (size_t)(cc * 2 + 1) * 64];
        float t = qr * xr - qi * xi + f.x; xi = qr * xi + qi * xr + f.y; xr = t;
      }
    }
    bf16x8 chi[4], clo[4];
    {
      const float* cr = p.s5_c_re + ((size_t)((l * 2 + d) * 32 + g) * 16 + fr) * 64;
      const float* ci = p.s5_c_im + ((size_t)((l * 2 + d) * 32 + g) * 16 + fr) * 64;
#pragma unroll
      for (int ks = 0; ks < 4; ++ks) {
        float4 a = *(const float4*)(cr + ks * 16 + fq * 4), bq = *(const float4*)(ci + ks * 16 + fq * 4);
        float vals[8] = {a.x, -bq.x, a.y, -bq.y, a.z, -bq.z, a.w, -bq.w};
#pragma unroll
        for (int j = 0; j < 8; ++j) {
          h16 hh = (h16)vals[j];
          chi[ks][j] = hh;
          clo[ks][j] = (h16)(vals[j] - (float)hh);
        }
      }
    }
#pragma unroll 1
    for (int sb = 0; sb < 16; ++sb) {
      const int sub = d == 0 ? sb : 15 - sb;
#pragma unroll 4
      for (int q = 0; q < 16; ++q) {
        const int tt = d == 0 ? q : 15 - q;
        const int t = sub * 16 + tt;
        h16x8 u0 = *(const h16x8*)(ulds + t * 32), u1 = *(const h16x8*)(ulds + t * 32 + 16);
        float br = 0, bi = 0;
#pragma unroll
        for (int i = 0; i < 8; ++i) { float u = (float)u0[i]; br = fmaf(u, Br[i], br); bi = fmaf(u, Bi[i], bi); }
#pragma unroll
        for (int i = 0; i < 8; ++i) { float u = (float)u1[i]; br = fmaf(u, Br[8 + i], br); bi = fmaf(u, Bi[8 + i], bi); }
        float vr = pp.br * br - pp.bi * bi, vi = pp.br * bi + pp.bi * br;
        float nxr = pp.ar * xr - pp.ai * xi + vr, nxi = pp.ar * xi + pp.ai * xr + vi;
        xr = nxr; xi = nxi;
        h16x2 hv2 = {(h16)xr, (h16)xi};
        *(unsigned*)(tile + tt * 272 + lane * 4) = __builtin_bit_cast(unsigned, hv2);
      }
      lds_fence();
      f32x4 acc = f32x4{0.f, 0.f, 0.f, 0.f};
#pragma unroll
      for (int ks = 0; ks < 4; ++ks) {
        bf16x8 ah = *(const bf16x8*)(tile + fr * 272 + ks * 64 + fq * 16);
        acc = __builtin_amdgcn_mfma_f32_16x16x32_f16(ah, chi[ks], acc, 0, 0, 0);
        acc = __builtin_amdgcn_mfma_f32_16x16x32_f16(ah, clo[ks], acc, 0, 0, 0);
      }
      lds_fence();
#pragma unroll
      for (int r = 0; r < 4; ++r) {
        int tl = sub * 16 + fq * 4 + r;
        float* yp = S5Y + (size_t)(rowbase + tl) * 512 + g * 16 + fr;
        if (d == 0) {
          float u = (float)*(const h16*)(ulds + tl * 32 + fr * 2);
          *yp = acc[r] + dsk * u;
        } else {
          *yp = gelu_f(*yp + acc[r]);
        }
      }
    }
  }
}

DEV void prep_item(const Params& p, const Ctx& cx, int l, int item, char* smem) {
  const int tile = item >> 2, q = item & 3;
  const int row0 = tile * 64;
  const int tid = cx.tid;
  const h16* zc = (const h16*)(p.ws + OFF_REG2);
  h16* SC = (h16*)(p.ws + OFF_SCAN);
  const char* wt = p.ws + OFF_WT + (size_t)l * WT_SIZE;
  {
    const int d = q >> 1, isA = q & 1;
    const int coff = isA ? 3200 + d * 64 : 3072 + d * 64;
    int tok = tid >> 3, c8 = tid & 7;
    h16x8 cv = *(const h16x8*)(zc + (size_t)(row0 + tok) * ZC + coff + c8 * 8);
    float f[8];
#pragma unroll
    for (int j = 0; j < 8; ++j) { f[j] = (float)cv[j]; if (!isA) f[j] = tanh_f(f[j]); }
    uint4 o;
    o.x = pack_bf2(f[0], f[1]); o.y = pack_bf2(f[2], f[3]); o.z = pack_bf2(f[4], f[5]); o.w = pack_bf2(f[6], f[7]);
    *(uint4*)(smem + tok * 144 + c8 * 16) = o;
    __syncthreads();
    const bf16_t* Bt = (const bf16_t*)(wt + (isA ? WT_A2 : WT_W2)) + (size_t)d * 1024 * 64;
    const float* biasw = p.rwkv_w0 + (size_t)(l * 2 + d) * 1024;
    const float* biasa = p.rwkv_a0 + (size_t)(l * 2 + d) * 1024;
    h16* dst = SC + (size_t)(isA ? 4 + d : 6 + d) * ARR;
#pragma unroll 1
    for (int hf = 0; hf < 2; ++hf) small_gemm<64, 4>(p, cx, smem, 144, Bt, (tid >> 6) * 128 + hf * 64, [&](int m, int n, f32x4 v) {
      float4 bbw = *(const float4*)(biasw + n), bba = *(const float4*)(biasa + n);
      float4 bb = isA ? bba : bbw;
      float r0 = sigmoid_f(v[0] + bb.x), r1 = sigmoid_f(v[1] + bb.y), r2 = sigmoid_f(v[2] + bb.z), r3 = sigmoid_f(v[3] + bb.w);
      if (!isA) { r0 = __expf(-DECAY_SCALE * r0); r1 = __expf(-DECAY_SCALE * r1); r2 = __expf(-DECAY_SCALE * r2); r3 = __expf(-DECAY_SCALE * r3); }
      h16x4 o4 = {(h16)r0, (h16)r1, (h16)r2, (h16)r3};
      *(h16x4*)(dst + (size_t)(row0 + m) * 1024 + n) = o4;
    });
  }
  {
    const float* cw = p.conv_rkv + (size_t)l * 3 * 3072;
    const int grp = tid & 7, hh = (tid >> 3) & 3;
    const int c0 = (4 * q + hh) * 64 + grp * 8;
    float cwt[3][3][8];
#pragma unroll
    for (int s = 0; s < 3; ++s)
#pragma unroll
      for (int tp = 0; tp < 3; ++tp)
#pragma unroll
        for (int j = 0; j < 8; j += 4) {
          float4 a = *(const float4*)(cw + tp * 3072 + s * 1024 + c0 + j);
          cwt[s][tp][j] = a.x; cwt[s][tp][j + 1] = a.y; cwt[s][tp][j + 2] = a.z; cwt[s][tp][j + 3] = a.w;
        }
    float kkw[8];
#pragma unroll
    for (int j = 0; j < 8; j += 4) {
      float4 kq = *(const float4*)(p.rwkv_k_k + (size_t)l * 1024 + c0 + j);
      kkw[j] = kq.x; kkw[j + 1] = kq.y; kkw[j + 2] = kq.z; kkw[j + 3] = kq.w;
    }
#pragma unroll 1
    for (int it = 0; it < 4; ++it) {
      const int tok = (tid >> 5) + it * 16;
      const int row = row0 + tok;
      bool hasp, hasn;
      if (row < NLAT) { hasp = (row & 16383) != 0; hasn = (row & 16383) != 16383; }
      else { hasp = (row & 255) != 0; hasn = (row & 255) != 255; }
      const size_t off = (size_t)row * 1024 + c0;
      const h16* zp = zc + (size_t)row * ZC + c0;
      const h16* zpp = hasp ? zp - ZC : zp;
      const h16* zpn = hasn ? zp + ZC : zp;
      h16x8 cur[3], prv[3], nxt[3];
#pragma unroll
      for (int s = 0; s < 3; ++s) { cur[s] = *(const h16x8*)(zp + s * 1024); prv[s] = *(const h16x8*)(zpp + s * 1024); nxt[s] = *(const h16x8*)(zpn + s * 1024); }
      const float fp = hasp ? 1.f : 0.f, fn = hasn ? 1.f : 0.f;
      float kv[8];
#pragma unroll
      for (int s = 0; s < 3; ++s) {
        h16x8 o;
#pragma unroll
        for (int j = 0; j < 8; ++j) {
          float ov = cwt[s][0][j] * (fp * (float)prv[s][j]) + cwt[s][1][j] * (float)cur[s][j] + cwt[s][2][j] * (fn * (float)nxt[s][j]);
          o[j] = (h16)ov;
          if (s == 1) kv[j] = ov;
        }
        *(h16x8*)(SC + (size_t)s * ARR + off) = o;
      }
      float kk[8], ss = 0;
#pragma unroll
      for (int j = 0; j < 8; ++j) { kk[j] = kv[j] * kkw[j]; ss += kk[j] * kk[j]; }
      ss = allreduce8(ss);
      float inv = rcp_f(fmaxf(sqrtf(ss), 1e-12f));
      h16x8 o;
#pragma unroll
      for (int j = 0; j < 8; ++j) o[j] = (h16)(kk[j] * inv);
      *(h16x8*)(SC + 3 * ARR + off) = o;
    }
  }
}

DEV void phase_prep(const Params& p, const Ctx& cx0, int l, char* smem) {
  const int NPREP = 520 * 4, NS5 = 520;
  const Ctx& cx_ = cx0;
  for (int item = cx_.bid; item < NPREP + NS5; item += cx_.nblk) {
    __syncthreads();
    Ctx cx = cx0; asm volatile("" : "+v"(cx.tid));
    const int lane = cx.tid & 63, wid = cx.tid >> 6;
#ifndef NO_PREPITEM
    if (item < NPREP) prep_item(p, cx, l, item, smem);
    else
#endif
#ifndef NO_S5P1
      s5_pass1_unit(p, cx, l, (item - NPREP) * 8 + wid, smem + wid * 8192, lane);
#else
    {}
#endif
  }
}

typedef unsigned u2v __attribute__((ext_vector_type(2)));
struct RG { u2v w, a, kk, k, r; h16 v; };

constexpr int RW_NSLOT = 8, RW_SLOTB = 3072;
constexpr int RW_FLAGS = RW_NSLOT * RW_SLOTB;
constexpr int RW_NG = 16640 / 4;
typedef float f4v __attribute__((ext_vector_type(4)));

#define RW_RLO(gq, rlo)                                                            \
  {                                                                                \
    const int gg = (gq) < RW_NG ? (gq) : RW_NG - 1;                                \
    const int q0_ = gg * 4;                                                        \
    const int isl = q0_ >= 256;                                                    \
    const int base_ = isl ? b * 16384 : NLAT + b * 256;                            \
    const int t0_ = isl ? q0_ - 256 : q0_;                                         \
    const int last_ = isl ? 16383 : 255;                                           \
    rlo = base_ + (d ? last_ - t0_ - 3 : t0_);                                     \
  }

DEV void rwkv_helper(const Params& p, const Ctx& cx, int l, int unit, int lane, char* ring) {
  const int d = unit & 1, h = (unit >> 1) & 15, b = unit >> 5;
  const int j = lane >> 4, s = lane & 15;
  const h16* SC = (const h16*)(p.ws + OFF_SCAN);
  const char* pR = (const char*)(SC + 0 * ARR + h * 64);
  const char* pK = (const char*)(SC + 1 * ARR + h * 64);
  const char* pV = (const char*)(SC + 2 * ARR + h * 64);
  const char* pKK = (const char*)(SC + 3 * ARR + h * 64);
  const char* pA = (const char*)(SC + (size_t)(4 + d) * ARR + h * 64);
  const char* pW = (const char*)(SC + (size_t)(6 + d) * ARR + h * 64);
  const int jm = d ? 3 - j : j;
  const unsigned vo0 = (unsigned)(jm * 2048 + s * 8);
  f4v ka4, om4;
  {
    float4 t = *(const float4*)(p.rwkv_k_a + (size_t)l * 1024 + h * 64 + 4 * s);
    ka4 = f4v{t.x, t.y, t.z, t.w};
    om4 = 1.f - ka4;
  }
  struct RGH { u2v w, a, kk, k, r, v; };
  RGH q0, q1, q2, q3, q4, q5, q6, q7;
  const unsigned wofs = (unsigned)(j * 128 + s * 8);
  const unsigned vwofs = (unsigned)(2560 + j * 128 + s * 8);
  LAS3 volatile int* pflag = (LAS3 volatile int*)(ring + RW_FLAGS);
  LAS3 volatile int* cflag = (LAS3 volatile int*)(ring + RW_FLAGS + 64);
  int cmin = 0;
#define CV4(uv) __builtin_convertvector(__builtin_bit_cast(h16x4, uv), f4v)
#define RH_LOAD(q, gq)                                                             \
  {                                                                                \
    int rlo; RW_RLO(gq, rlo);                                                      \
    unsigned vo = vo0; asm volatile("" : "+v"(vo));                                \
    const size_t off = (size_t)rlo * 2048;                                         \
    q.w = *(const u2v*)(pW + off + vo); q.a = *(const u2v*)(pA + off + vo);        \
    q.kk = *(const u2v*)(pKK + off + vo); q.k = *(const u2v*)(pK + off + vo);      \
    q.r = *(const u2v*)(pR + off + vo); q.v = *(const u2v*)(pV + off + vo);        \
  }
#define RH_STEP(q, gq)                                                             \
  {                                                                                \
    if ((gq) >= RW_NSLOT && cmin < (gq) - RW_NSLOT + 1) {                          \
      do {                                                                         \
        const int c0_ = cflag[0], c1_ = cflag[1], c2_ = cflag[2], c3_ = cflag[3];  \
        cmin = __builtin_amdgcn_readfirstlane(min(min(c0_, c1_), min(c2_, c3_)));  \
        if (cmin < (gq) - RW_NSLOT + 1) __builtin_amdgcn_s_sleep(1);               \
      } while (cmin < (gq) - RW_NSLOT + 1);                                        \
    }                                                                              \
    asm volatile("" ::: "memory");                                                 \
    char* sl = ring + ((gq) % RW_NSLOT) * RW_SLOTB;                                \
    const f4v a_ = CV4(q.a), kk_ = CV4(q.kk);                                      \
    const f4v kka_ = kk_ * a_, kd_ = CV4(q.k) * (a_ * ka4 + om4);                  \
    *(u2v*)(sl + 0 * 512 + wofs) = q.w;                                            \
    *(u2v*)(sl + 1 * 512 + wofs) = q.kk;                                           \
    *(u2v*)(sl + 2 * 512 + wofs) = __builtin_bit_cast(u2v, __builtin_convertvector(kka_, h16x4)); \
    *(u2v*)(sl + 3 * 512 + wofs) = __builtin_bit_cast(u2v, __builtin_convertvector(kd_, h16x4));  \
    *(u2v*)(sl + 4 * 512 + wofs) = q.r;                                            \
    *(u2v*)(sl + vwofs) = q.v;                                                     \
    asm volatile("s_waitcnt lgkmcnt(0)" ::: "memory");     \
    *pflag = (gq) + 1;                                                             \
  }
  RH_LOAD(q0, 0); RH_LOAD(q1, 1); RH_LOAD(q2, 2); RH_LOAD(q3, 3); RH_LOAD(q4, 4); RH_LOAD(q5, 5); RH_LOAD(q6, 6); RH_LOAD(q7, 7);
#pragma unroll 1
  for (int g = 0; g < RW_NG; g += 8) {
    RH_STEP(q0, g); RH_LOAD(q0, g + 8); __builtin_amdgcn_sched_barrier(0);
    RH_STEP(q1, g + 1); RH_LOAD(q1, g + 9); __builtin_amdgcn_sched_barrier(0);
    RH_STEP(q2, g + 2); RH_LOAD(q2, g + 10); __builtin_amdgcn_sched_barrier(0);
    RH_STEP(q3, g + 3); RH_LOAD(q3, g + 11); __builtin_amdgcn_sched_barrier(0);
    RH_STEP(q4, g + 4); RH_LOAD(q4, g + 12); __builtin_amdgcn_sched_barrier(0);
    RH_STEP(q5, g + 5); RH_LOAD(q5, g + 13); __builtin_amdgcn_sched_barrier(0);
    RH_STEP(q6, g + 6); RH_LOAD(q6, g + 14); __builtin_amdgcn_sched_barrier(0);
    RH_STEP(q7, g + 7); RH_LOAD(q7, g + 15); __builtin_amdgcn_sched_barrier(0);
  }
#undef RH_LOAD
#undef RH_STEP
#undef CV4
}

DEV void rwkv_consumer(const Params& p, const Ctx& cx, int l, int task, int lane, const char* ring, int widx) {
  const int unit = task >> 4, d = unit & 1, h = (unit >> 1) & 15, b = unit >> 5;
  const int j = lane >> 4, s = lane & 15;
  const int myrow = (task & 15) * 4 + j;
  char* pO = (char*)((h16*)(p.ws + OFF_REG2) + (size_t)d * ARR + h * 64);
  const int sm = d ? 3 - (s & 3) : (s & 3);
  const unsigned vov0 = (unsigned)(sm * 2048 + myrow * 2);
  const unsigned rofs = (unsigned)(s * 8);
  const unsigned vrofs = (unsigned)(2560 + myrow * 2);
  LAS3 volatile int* pflag = (LAS3 volatile int*)(ring + RW_FLAGS);
  LAS3 volatile int* cflag = (LAS3 volatile int*)(ring + RW_FLAGS + 64) + widx;
  float S0 = 0.f, S1 = 0.f, S2 = 0.f, S3 = 0.f;
  int pseen = 0;
  struct GD { u2v w[4], kk[4], kka[4], kd[4], r[4]; unsigned v[4]; };
  GD A, B;
#define RC_WAIT(gq) { if (pseen <= (gq)) { do { pseen = __builtin_amdgcn_readfirstlane(*pflag); if (pseen <= (gq)) __builtin_amdgcn_s_sleep(1); } while (pseen <= (gq)); } asm volatile("" ::: "memory"); }
#define RC_LOAD(G, gq)                                                             \
  {                                                                                \
    const char* sl = ring + ((gq) % RW_NSLOT) * RW_SLOTB;                          \
    _Pragma("unroll") for (int u = 0; u < 4; ++u) {                                \
      G.w[u] = *(const u2v*)(sl + 0 * 512 + u * 128 + rofs);                       \
      G.kk[u] = *(const u2v*)(sl + 1 * 512 + u * 128 + rofs);                      \
      G.kka[u] = *(const u2v*)(sl + 2 * 512 + u * 128 + rofs);                     \
      G.kd[u] = *(const u2v*)(sl + 3 * 512 + u * 128 + rofs);                      \
      G.r[u] = *(const u2v*)(sl + 4 * 512 + u * 128 + rofs);                       \
      G.v[u] = *(const unsigned short*)(sl + u * 128 + vrofs);                     \
    }                                                                              \
  }
#define RC_COMP(G, gq)                                                             \
  {                                                                                \
    float dres[4];                                                                 \
    _Pragma("unroll") for (int u = 0; u < 4; ++u) {                                \
      float pa, pb;                                                                \
      asm("v_fma_mix_f32 %0, %2, %6, 0 op_sel:[0,0,0] op_sel_hi:[0,1,0]\n\t"       \
          "v_fma_mix_f32 %1, %4, %7, 0 op_sel:[0,0,0] op_sel_hi:[0,1,0]\n\t"       \
          "v_fma_mix_f32 %0, %3, %6, %0 op_sel:[0,1,0] op_sel_hi:[0,1,0]\n\t"      \
          "v_fma_mix_f32 %1, %5, %7, %1 op_sel:[0,1,0] op_sel_hi:[0,1,0]"          \
          : "=&v"(pa), "=&v"(pb) : "v"(S0), "v"(S1), "v"(S2), "v"(S3), "v"(G.kk[u].x), "v"(G.kk[u].y)); \
      const float d1 = allreduce16(pa + pb);                                       \
      float ea, eb, t0, t1, t2, t3;                                                \
      asm("v_fma_mix_f32 %6, %18, %12, 0 op_sel:[0,0,0] op_sel_hi:[1,1,0]\n\t"     \
          "v_fma_mix_f32 %7, %18, %12, 0 op_sel:[0,1,0] op_sel_hi:[1,1,0]\n\t"     \
          "v_fma_mix_f32 %8, %18, %13, 0 op_sel:[0,0,0] op_sel_hi:[1,1,0]\n\t"     \
          "v_fma_mix_f32 %9, %18, %13, 0 op_sel:[0,1,0] op_sel_hi:[1,1,0]\n\t"     \
          "v_fma_mix_f32 %0, %0, %10, %6 op_sel:[0,0,0] op_sel_hi:[0,1,0]\n\t"     \
          "v_fma_mix_f32 %1, %1, %10, %7 op_sel:[0,1,0] op_sel_hi:[0,1,0]\n\t"     \
          "v_fma_mix_f32 %2, %2, %11, %8 op_sel:[0,0,0] op_sel_hi:[0,1,0]\n\t"     \
          "v_fma_mix_f32 %3, %3, %11, %9 op_sel:[0,1,0] op_sel_hi:[0,1,0]\n\t"     \
          "v_fma_mix_f32 %0, -%19, %14, %0 op_sel:[0,0,0] op_sel_hi:[0,1,0]\n\t"   \
          "v_fma_mix_f32 %1, -%19, %14, %1 op_sel:[0,1,0] op_sel_hi:[0,1,0]\n\t"   \
          "v_fma_mix_f32 %2, -%19, %15, %2 op_sel:[0,0,0] op_sel_hi:[0,1,0]\n\t"   \
          "v_fma_mix_f32 %3, -%19, %15, %3 op_sel:[0,1,0] op_sel_hi:[0,1,0]\n\t"   \
          "v_fma_mix_f32 %4, %0, %16, 0 op_sel:[0,0,0] op_sel_hi:[0,1,0]\n\t"      \
          "v_fma_mix_f32 %5, %2, %17, 0 op_sel:[0,0,0] op_sel_hi:[0,1,0]\n\t"      \
          "v_fma_mix_f32 %4, %1, %16, %4 op_sel:[0,1,0] op_sel_hi:[0,1,0]\n\t"     \
          "v_fma_mix_f32 %5, %3, %17, %5 op_sel:[0,1,0] op_sel_hi:[0,1,0]"         \
          : "+v"(S0), "+v"(S1), "+v"(S2), "+v"(S3), "=&v"(ea), "=&v"(eb), "=&v"(t0), "=&v"(t1), "=&v"(t2), "=&v"(t3) \
          : "v"(G.w[u].x), "v"(G.w[u].y), "v"(G.kd[u].x), "v"(G.kd[u].y), "v"(G.kka[u].x), "v"(G.kka[u].y),           \
            "v"(G.r[u].x), "v"(G.r[u].y), "v"(G.v[u]), "v"(d1));                   \
      dres[u] = ea + eb;     \
    }                                                                              \
    asm volatile("" ::: "memory");                                                 \
    *cflag = (gq) + 1;     \
    {                                                                              \
      int rlo; RW_RLO(gq, rlo);                                                    \
      unsigned vov = vov0; asm volatile("" : "+v"(vov));                           \
        \
      const bool p1_ = (s & 1) != 0, p2_ = (s & 2) != 0;                           \
      const float a_ = (p1_ ? dres[1] : dres[0]) + dpp_mov<0xB1>(p1_ ? dres[0] : dres[1]); \
      const float b_ = (p1_ ? dres[3] : dres[2]) + dpp_mov<0xB1>(p1_ ? dres[2] : dres[3]); \
      float val = (p2_ ? b_ : a_) + dpp_mov<0x4E>(p2_ ? a_ : b_);                  \
      val += dpp_mov<0x124>(val);                                                  \
      val += dpp_mov<0x128>(val);                                                  \
      *(h16*)(pO + (size_t)rlo * 2048 + vov) = (h16)val;                           \
    }                                                                              \
  }
  RC_WAIT(0); RC_LOAD(A, 0);
#pragma unroll 1
  for (int g = 0; g < RW_NG; g += 2) {
    RC_WAIT(g + 1); RC_LOAD(B, g + 1);
    RC_COMP(A, g);
    if (g + 2 < RW_NG) { RC_WAIT(g + 2); RC_LOAD(A, g + 2); }
    RC_COMP(B, g + 1);
  }
#undef RC_WAIT
#undef RC_LOAD
#undef RC_COMP
}
#undef RW_RLO

DEV void phase_scan(const Params& p, const Ctx& cx, int l, char* smem) {
  const int lane = cx.tid & 63, wid = __builtin_amdgcn_readfirstlane(cx.tid >> 6);
  for (int slot = cx.bid; slot < 256; slot += cx.nblk) {
    __syncthreads();
    if (wid == 4 && lane < 8) *(LAS3 volatile int*)(smem + RW_FLAGS + (lane == 0 ? 0 : 64 + (lane & 3) * 4)) = 0;
    __syncthreads();
    const int unit = slot & 63;
#ifndef NO_RWKV
    if (wid < 4) rwkv_consumer(p, cx, l, (unit << 4) | ((slot >> 6) << 2) | wid, lane, smem, wid);
    else if (wid == 4) rwkv_helper(p, cx, l, unit, lane, smem);
#endif
  }
  if (wid >= 5) {
    char* wl = smem + 32768 + (wid - 5) * 17408;
    for (int u = cx.bid * 3 + (wid - 5); u < 2 * 32 * 65; u += cx.nblk * 3) {
      if (l == 1 && (u % 65) == 0) continue;
#ifndef NO_S5P3
      s5_pass3_unit(p, cx, l, u, wl, lane);
#endif
    }
  }
}

DEV void pool_item(const Params& p, const Ctx& cx, int l, int item, char* smem) {
  const int tid = cx.tid;
  const h16* zrest = (const h16*)(p.ws + OFF_ZREST);
  bf16_t* ym = (bf16_t*)(p.ws + OFF_YM);
  const char* wt = p.ws + OFF_WT + (size_t)l * WT_SIZE;
  float* V = (float*)smem;
  char* At = smem + 43008;
  int g, rowout0, Lseq, p0, rlo, rhi, rstride, rowsrc0;
  if (item < 2048) {
    g = item & 3; int r = (item >> 2) & 255, b = item >> 10;
    int w = 2 << g;
    rlo = max(r - w / 2, 0); rhi = min(r + w / 2 - 1, 255);
    rowsrc0 = b * 16384; rstride = 64;
    rowout0 = b * 16384 + r * 64; Lseq = 64; p0 = 0;
  } else {
    int it = item - 2048;
    g = it & 3; int tq = (it >> 2) & 3, b = it >> 4;
    rlo = 0; rhi = 0; rowsrc0 = NLAT + b * 256; rstride = 0;
    rowout0 = NLAT + b * 256 + tq * 64; Lseq = 256; p0 = tq * 64;
  }
  const int w = 2 << g;
  const float invr = 1.f / (float)(rhi - rlo + 1);
  for (int unit = tid; unit < 80 * 16; unit += NTHREADS) {
    int lp = unit >> 4, ch8 = unit & 15;
    int pos = p0 - 8 + lp;
    float acc[8] = {0, 0, 0, 0, 0, 0, 0, 0};
    if (pos >= 0 && pos < Lseq) {
      const h16* bp = zrest + (size_t)(rowsrc0 + pos) * ZR + 1024 + g * 128 + ch8 * 8;
      const int nr = rhi - rlo + 1;
      for (int k0 = 0; k0 < nr; k0 += 4) {
        h16x8 v[4]; float wv[4];
#pragma unroll
        for (int i = 0; i < 4; ++i) {
          const int kk_ = min(k0 + i, nr - 1);
          wv[i] = (k0 + i < nr) ? 1.f : 0.f;
          v[i] = *(const h16x8*)(bp + (size_t)((rlo + kk_) * rstride) * ZR);
        }
#pragma unroll
        for (int i = 0; i < 4; ++i)
#pragma unroll
          for (int j = 0; j < 8; ++j) acc[j] += wv[i] * (float)v[i][j];
      }
    }
    float* vp = V + lp * 132 + ch8 * 8;
#pragma unroll
    for (int j = 0; j < 8; ++j) vp[j] = acc[j] * invr;
  }
  __syncthreads();
  for (int unit = tid; unit < 64 * 16; unit += NTHREADS) {
    int c = unit >> 4, ch8 = unit & 15;
    int pos = p0 + c;
    int lo = max(pos - w / 2, 0), hi = min(pos + w / 2 - 1, Lseq - 1);
    float acc[8] = {0, 0, 0, 0, 0, 0, 0, 0};
    for (int pp = lo; pp <= hi; ++pp) {
      const float* vp = V + (pp - p0 + 8) * 132 + ch8 * 8;
#pragma unroll
      for (int j = 0; j < 8; ++j) acc[j] += vp[j];
    }
    float invc = 1.f / (float)(hi - lo + 1);
    h16x8 uc = *(const h16x8*)(zrest + (size_t)(rowout0 + c) * ZR + 1024 + g * 128 + ch8 * 8);
    uint4 o;
    o.x = pack_bf2(acc[0] * invc - (float)uc[0], acc[1] * invc - (float)uc[1]);
    o.y = pack_bf2(acc[2] * invc - (float)uc[2], acc[3] * invc - (float)uc[3]);
    o.z = pack_bf2(acc[4] * invc - (float)uc[4], acc[5] * invc - (float)uc[5]);
    o.w = pack_bf2(acc[6] * invc - (float)uc[6], acc[7] * invc - (float)uc[7]);
    *(uint4*)(At + c * 272 + ch8 * 16) = o;
  }
  __syncthreads();
  const bf16_t* Bt = (const bf16_t*)(wt + WT_POOL) + (size_t)g * 128 * 128;
  const float* ps = p.pool_scale + (size_t)l * 512 + g * 128;
  small_gemm<128, 1>(p, cx, At, 272, Bt, (tid >> 6) * 16, [&](int m, int n, f32x4 v) {
    int row = rowout0 + m;
    float4 sc = *(const float4*)(ps + n);
    h16x4 gt = *(const h16x4*)(zrest + (size_t)row * ZR + 1536 + g * 128 + n);
    uint2 o;
    o.x = pack_bf2(v[0] * sc.x * silu_f((float)gt[0]), v[1] * sc.y * silu_f((float)gt[1]));
    o.y = pack_bf2(v[2] * sc.z * silu_f((float)gt[2]), v[3] * sc.w * silu_f((float)gt[3]));
    *(uint2*)(ym + (size_t)row * D + 512 + g * 128 + n) = o;
  });
}

DEV void glu_item(const Params& p, const Ctx& cx, int l, int tile, char* smem) {
  const int tid = cx.tid;
  const int row0 = tile * 64;
  const float* S5Y = (const float*)(p.ws + OFF_S5Y);
  const h16* zrest = (const h16*)(p.ws + OFF_ZREST);
  bf16_t* ym = (bf16_t*)(p.ws + OFF_YM);
  const char* wt = p.ws + OFF_WT + (size_t)l * WT_SIZE;
#pragma unroll
  for (int it = 0; it < 8; ++it) {
    int unit = tid + it * NTHREADS;
    int r = unit >> 6, c8 = unit & 63;
    const float* sp = S5Y + (size_t)(row0 + r) * 512 + c8 * 8;
    float4 a = *(const float4*)sp, bq = *(const float4*)(sp + 4);
    uint4 o;
    o.x = pack_bf2(a.x, a.y); o.y = pack_bf2(a.z, a.w); o.z = pack_bf2(bq.x, bq.y); o.w = pack_bf2(bq.z, bq.w);
    *(uint4*)(smem + r * 1040 + c8 * 16) = o;
  }
  __syncthreads();
  const bf16_t* Bt = (const bf16_t*)(wt + WT_GLU);
  const float* bg = p.b_glu + (size_t)l * 512;
  small_gemm<512, 4>(p, cx, smem, 1040, Bt, (tid >> 6) * 64, [&](int m, int n, f32x4 v) {
    int row = row0 + m;
    float4 y = *(const float4*)(S5Y + (size_t)row * 512 + n);
    float4 bb = *(const float4*)(bg + n);
    h16x4 gt = *(const h16x4*)(zrest + (size_t)row * ZR + 512 + n);
    uint2 o;
    o.x = pack_bf2(y.x * sigmoid_f(v[0] + bb.x) * silu_f((float)gt[0]), y.y * sigmoid_f(v[1] + bb.y) * silu_f((float)gt[1]));
    o.y = pack_bf2(y.z * sigmoid_f(v[2] + bb.z) * silu_f((float)gt[2]), y.w * sigmoid_f(v[3] + bb.w) * silu_f((float)gt[3]));
    *(uint2*)(ym + (size_t)row * D + n) = o;
  });
}

DEV void rwkvmerge_item(const Params& p, const Ctx& cx, int l, int tile) {
  const int tid = cx.tid;
  const int row0 = tile * 64;
  const h16* SC = (const h16*)(p.ws + OFF_SCAN);
  const h16* O = (const h16*)(p.ws + OFF_REG2);
  const h16* zrest = (const h16*)(p.ws + OFF_ZREST);
  bf16_t* ym = (bf16_t*)(p.ws + OFF_YM);
  const int grp = tid & 7, h = (tid >> 3) & 15;
  const int c0 = h * 64 + grp * 8;
  float pk[8], rk[8], gw[8], gb[8];
#pragma unroll
  for (int j = 0; j < 8; j += 4) {
    float4 t0 = *(const float4*)(p.rwkv_k_a + (size_t)l * 1024 + c0 + j), t1 = *(const float4*)(p.rwkv_r_k + (size_t)l * 1024 + c0 + j);
    float4 t2 = *(const float4*)(p.gn_w + (size_t)l * 1024 + c0 + j), t3 = *(const float4*)(p.gn_b + (size_t)l * 1024 + c0 + j);
    pk[j] = t0.x; pk[j + 1] = t0.y; pk[j + 2] = t0.z; pk[j + 3] = t0.w;
    rk[j] = t1.x; rk[j + 1] = t1.y; rk[j + 2] = t1.z; rk[j + 3] = t1.w;
    gw[j] = t2.x; gw[j + 1] = t2.y; gw[j + 2] = t2.z; gw[j + 3] = t2.w;
    gb[j] = t3.x; gb[j + 1] = t3.y; gb[j + 2] = t3.z; gb[j + 3] = t3.w;
  }
#pragma unroll 2
  for (int it = 0; it < 16; ++it) {
    const int tok = (tid >> 7) + it * 4;
    int row = row0 + tok;
    size_t off = (size_t)row * 1024 + c0;
    h16x8 of = *(const h16x8*)(O + off), ob = *(const h16x8*)(O + ARR + off);
    h16x8 r8 = *(const h16x8*)(SC + 0 * ARR + off), k8 = *(const h16x8*)(SC + 1 * ARR + off), v8 = *(const h16x8*)(SC + 2 * ARR + off);
    h16x8 af = *(const h16x8*)(SC + 4 * ARR + off), ab = *(const h16x8*)(SC + 5 * ARR + off);
    h16x8 gt = *(const h16x8*)(zrest + (size_t)row * ZR + 2048 + c0);
    float o[8], sm = 0;
#pragma unroll
    for (int j = 0; j < 8; ++j) { o[j] = (float)of[j] + (float)ob[j]; sm += o[j]; }
    sm = allreduce8(sm);
    float mu = sm * (1.f / 64.f), vq = 0;
#pragma unroll
    for (int j = 0; j < 8; ++j) { o[j] -= mu; vq += o[j] * o[j]; }
    vq = allreduce8(vq);
    float rstd = rsqrtf(vq * (1.f / 64.f) + 64e-5f);
    float part = 0;
#pragma unroll
    for (int j = 0; j < 8; ++j) {
      float ksum = (float)k8[j] * (2.f + ((float)af[j] + (float)ab[j] - 2.f) * pk[j]);
      part += (float)r8[j] * ksum * rk[j];
    }
    part = allreduce8(part);
    float res[8];
#pragma unroll
    for (int j = 0; j < 8; ++j) {
      float y = o[j] * rstd * gw[j] + gb[j] + part * (float)v8[j];
      res[j] = y * silu_f((float)gt[j]);
    }
    uint4 ov;
    ov.x = pack_bf2(res[0], res[1]); ov.y = pack_bf2(res[2], res[3]); ov.z = pack_bf2(res[4], res[5]); ov.w = pack_bf2(res[6], res[7]);
    *(uint4*)(ym + (size_t)row * D + 1024 + c0) = ov;
  }
}

DEV void phase_merge(const Params& p, const Ctx& cx0, int l, char* smem) {
  const int ntile = (l == 0) ? 520 : 512;
  const int npool = (l == 0) ? 2048 + 32 : 2048;
  const int total = npool + 2 * ntile;
  for (int item = cx0.bid; item < total; item += cx0.nblk) {
    __syncthreads();
    Ctx cx = cx0; asm volatile("" : "+v"(cx.tid));
    if (item < npool) pool_item(p, cx, l, item, smem);
    else if (item < npool + ntile) glu_item(p, cx, l, item - npool, smem);
    else rwkvmerge_item(p, cx, l, item - npool - ntile);
  }
}

#define LCX Ctx c2 = cx; asm volatile("" : "+v"(c2.tid))
#ifndef GEMM_FN
#define GEMM_FN gemm_phase2
#endif
__global__ void __launch_bounds__(NTHREADS) mega_fwd(Params p, int ph0, int ph1) {
  extern __shared__ __attribute__((aligned(16))) char smem[];
  cg::grid_group grid = cg::this_grid();
  const int wave_s = __builtin_amdgcn_readfirstlane((int)(threadIdx.x >> 6));
  for (int step = ph0; step < ph1; ++step) {
    if (step > ph0) grid.sync();
    const int ph = (int)((PH_SEQ >> (4 * step)) & 15ull);
    Ctx cx;
    {
      int t_, b_ = blockIdx.x, n_ = gridDim.x;
      asm volatile("v_mbcnt_lo_u32_b32 %0, -1, 0\n\tv_mbcnt_hi_u32_b32 %0, -1, %0\n\tv_lshl_add_u32 %0, %1, 6, %0" : "=&v"(t_) : "s"(wave_s));
      asm volatile("" : "+s"(b_), "+s"(n_));
      cx.tid = t_; cx.bid = b_; cx.nblk = n_;
    }
    const int l = ph >= 8 ? 1 : 0;
    const int lp = ph >= 8 ? ph - 6 : ph;
#ifndef PHMASK
#define PHMASK 0xff
#endif
    if (ph == 0) { if (PHMASK & 1) { LCX; phase0(p, c2, smem); } }
    else if (ph == 1) { if (PHMASK & 2) { LCX; phase_adaln0(p, c2); } }
    else if (lp == 2 && (PHMASK & 4)) {
      LCX;
      h16* zrest = (h16*)(p.ws + OFF_ZREST);
      h16* zc = (h16*)(p.ws + OFF_REG2);
      GEMM_FN(p, c2, (const bf16_t*)(p.ws + OFF_H), (const bf16_t*)(p.ws + OFF_WT + (size_t)l * WT_SIZE + WT_IN), 2048, 130, 25, smem,
                 [&](int row, int col, f32x4 v, f32x4 u) {
                   h16* dst;
                   if (col < 2048) dst = zrest + (size_t)row * ZR + col;
                   else if (col < 5120) dst = zc + (size_t)row * ZC + (col - 2048);
                   else if (col < 6144) dst = zrest + (size_t)row * ZR + 2048 + (col - 5120);
                   else dst = zc + (size_t)row * ZC + 3072 + (col - 6144);
                   h16x8 o = {(h16)v[0], (h16)v[1], (h16)v[2], (h16)v[3], (h16)u[0], (h16)u[1], (h16)u[2], (h16)u[3]};
                   *(h16x8*)dst = o;
                 });
    } else if (lp == 3) { if (PHMASK & 8) { LCX; phase_prep(p, c2, l, smem); } }
    else if (lp == 4) { if (PHMASK & 16) { LCX; phase_scan(p, c2, l, smem); } }
    else if (lp == 5) { if (PHMASK & 32) { LCX; phase_merge(p, c2, l, smem); } }
    else if (lp == 6 && (PHMASK & 64)) {
      LCX;
      const float* mods = (const float*)(p.ws + OFF_MODS);
      float* prec = (float*)(p.ws + OFF_PREC);
      const float* xin = (l == 0) ? p.x : p.out;
      GEMM_FN(p, c2, (const bf16_t*)(p.ws + OFF_YM), (const bf16_t*)(p.ws + OFF_WT + (size_t)l * WT_SIZE + WT_OUT), 2048, l == 0 ? 130 : 128, 8, smem,
                 [&](int row, int col, f32x4 v, f32x4 u) {
                   const float* xr; const float* gr; float* dr;
                   if (row < NLAT) {
                     xr = xin + (size_t)row * D + col; gr = mods + (size_t)(l * 3 + (row >> 14)) * 6144 + 4096 + col; dr = p.out + (size_t)row * D + col;
                   } else {
                     xr = p.ctx + (size_t)(row - NLAT) * D + col; gr = mods + (size_t)(l * 3 + 2) * 6144 + 4096 + col; dr = prec + (size_t)(row - NLAT) * D + col;
                   }
                   const float4 x0 = *(const float4*)xr, x1 = *(const float4*)(xr + 4), g0 = *(const float4*)gr, g1 = *(const float4*)(gr + 4);
                   float4 r0, r1;
                   r0.x = ALPHA * x0.x + g0.x * v[0]; r0.y = ALPHA * x0.y + g0.y * v[1]; r0.z = ALPHA * x0.z + g0.z * v[2]; r0.w = ALPHA * x0.w + g0.w * v[3];
                   r1.x = ALPHA * x1.x + g1.x * u[0]; r1.y = ALPHA * x1.y + g1.y * u[1]; r1.z = ALPHA * x1.z + g1.z * u[2]; r1.w = ALPHA * x1.w + g1.w * u[3];
                   *(float4*)dr = r0; *(float4*)(dr + 4) = r1;
                 });
    } else if (lp == 7) { if (PHMASK & 128) { LCX; phase_finln(p, c2, l); } }
  }
}

constexpr int NPHASES = PH_NSTEPS;

extern "C" void kernel_launch(void* const* d_in, const int* in_sizes, int n_in, void* d_out, int out_size, void* d_ws, size_t ws_size,
                              hipStream_t stream) {
  static int grid_blocks = 0;
  if (grid_blocks == 0) {
    if (n_in != 32 || ws_size < WS_END) { fprintf(stderr, "kernel_launch: unexpected n_in %d / ws %zu (need %zu)\n", n_in, ws_size, (size_t)WS_END); grid_blocks = -1; return; }
    int dev = 0, cus = 0, per_cu = 0;
    hipGetDevice(&dev);
    hipDeviceGetAttribute(&cus, hipDeviceAttributeMultiprocessorCount, dev);
    if (hipFuncSetAttribute((const void*)mega_fwd, hipFuncAttributeMaxDynamicSharedMemorySize, LDS_BYTES) != hipSuccess) { fprintf(stderr, "hipFuncSetAttribute failed\n"); grid_blocks = -1; return; }
    if (hipOccupancyMaxActiveBlocksPerMultiprocessor(&per_cu, (const void*)mega_fwd, NTHREADS, LDS_BYTES) != hipSuccess || per_cu < 1) {
      fprintf(stderr, "occupancy query gave %d\n", per_cu); (void)hipGetLastError(); per_cu = 1;
    }
    grid_blocks = cus * per_cu;
  }
  if (grid_blocks < 0) return;
  Params p{};
  const float** pp = (const float**)&p;
  for (int i = 0; i < 32; ++i) pp[i] = (const float*)d_in[i];
  p.out = (float*)d_out;
  p.ws = (char*)d_ws;
  int ph0 = 0, ph1 = NPHASES;
  void* args[] = {&p, &ph0, &ph1};
  hipError_t e = hipLaunchCooperativeKernel((const void*)mega_fwd, dim3(grid_blocks), dim3(NTHREADS), args, LDS_BYTES, stream);
  if (e != hipSuccess) fprintf(stderr, "cooperative launch failed: %s (grid %d)\n", hipGetErrorString(e), grid_blocks);
}
```

```cpp
#include <hip/hip_runtime.h>
#include <hip/hip_cooperative_groups.h>
#include <cstdio>
namespace cg = cooperative_groups;

typedef unsigned short bf16_t;
typedef _Float16 h16;
using bf16x8 = __attribute__((ext_vector_type(8))) _Float16;
using f32x4 = __attribute__((ext_vector_type(4))) float;
using h16x4 = __attribute__((ext_vector_type(4))) _Float16;
using h16x8 = __attribute__((ext_vector_type(8))) _Float16;

#define DEV __device__ __forceinline__

constexpr int D = 2048, NLAT = 32768, MTOT = 33280, ZR = 3072, ZC = 3328;
constexpr int NTHREADS = 512;
constexpr int LDS_BYTES = 147456;
constexpr float ALPHA = 1.41421356237f;
constexpr float DECAY_SCALE = 0.606531f;

constexpr size_t al256(size_t x) { return (x + 255) & ~size_t(255); }
constexpr size_t ARR = (size_t)MTOT * 1024;
constexpr size_t OFF_MODS = 0;
constexpr size_t OFF_S5F = al256(OFF_MODS + 2 * 3 * 6144 * 4);
constexpr size_t OFF_PREC = al256(OFF_S5F + (size_t)2 * 32 * 65 * 2 * 64 * 8);
constexpr size_t OFF_WT = al256(OFF_PREC + (size_t)512 * 2048 * 4);
constexpr size_t WT_IN = 0, WT_OUT = 26214400, WT_W2 = 34603008, WT_A2 = 34865152, WT_POOL = 35127296, WT_GLU = 35258368, WT_SIZE = 35782656;
constexpr size_t OFF_ZREST = al256(OFF_WT + 2 * WT_SIZE);
constexpr size_t OFF_REG2 = al256(OFF_ZREST + (size_t)MTOT * ZR * 2);
constexpr size_t OFF_S5Y = OFF_REG2 + 2 * ARR * 2;
constexpr size_t OFF_SCAN = al256(OFF_REG2 + (size_t)MTOT * ZC * 2);
constexpr size_t OFF_H = OFF_SCAN;
constexpr size_t OFF_YM = OFF_SCAN + 6 * ARR * 2;
constexpr size_t WS_END = OFF_SCAN + 8 * ARR * 2;

#ifndef PH_SEQ
#define PH_SEQ 0xDCBA9876543210ull
#define PH_NSTEPS 14
#endif
struct Params {
  const float *x, *c, *ctx, *c_ctx, *w_ada, *b_ada, *w_in, *conv_rkv, *s5_lam_re, *s5_lam_im, *s5_log_step,
      *s5_b_re, *s5_b_im, *s5_c_re, *s5_c_im, *s5_d, *w_glu, *b_glu, *w_pool, *pool_scale,
      *rwkv_w0, *rwkv_w2, *rwkv_a0, *rwkv_a2, *rwkv_k_k, *rwkv_k_a, *rwkv_r_k, *gn_w, *gn_b,
      *w_out, *ln_g, *ln_b;
  float* out;
  char* ws;
};
struct Ctx { int tid, bid, nblk; };

DEV float rcp_f(float x) { return __builtin_amdgcn_rcpf(x); }
DEV float sigmoid_f(float x) { return rcp_f(1.f + __expf(-x)); }
DEV float silu_f(float x) { return x * rcp_f(1.f + __expf(-x)); }
DEV float tanh_f(float x) { float e = __expf(2.f * x); return 1.f - 2.f * rcp_f(e + 1.f); }
DEV float gelu_f(float y) { return 0.5f * y * (1.f + tanh_f(0.7978845608f * (y + 0.044715f * y * y * y))); }
using h16x2 = __attribute__((ext_vector_type(2))) _Float16;
DEV unsigned pack_bf2(float a, float b) { h16x2 v = {(h16)a, (h16)b}; return __builtin_bit_cast(unsigned, v); }
template <int CTRL> DEV float dpp_mov(float v) {
  return __int_as_float(__builtin_amdgcn_update_dpp(0, __float_as_int(v), CTRL, 0xf, 0xf, true));
}
DEV float allreduce16(float v) {
  v += dpp_mov<0xB1>(v);
  v += dpp_mov<0x4E>(v);
  v += dpp_mov<0x141>(v);
  v += dpp_mov<0x140>(v);
  return v;
}
DEV float wave_sum(float v) {
  v = allreduce16(v);
  return __builtin_amdgcn_readlane(__float_as_int(v), 0) == 0 && false ? 0.f :
         __int_as_float(__builtin_amdgcn_readlane(__float_as_int(v), 0)) + __int_as_float(__builtin_amdgcn_readlane(__float_as_int(v), 16)) +
         __int_as_float(__builtin_amdgcn_readlane(__float_as_int(v), 32)) + __int_as_float(__builtin_amdgcn_readlane(__float_as_int(v), 48));
}
DEV float allreduce8(float v) {
  v += dpp_mov<0xB1>(v);
  v += dpp_mov<0x4E>(v);
  v += dpp_mov<0x141>(v);
  return v;
}
DEV void lds_fence() { asm volatile("s_waitcnt lgkmcnt(0)" ::: "memory"); }

DEV void p0_mods_item(const Params& p, const Ctx& cx, int item, char* smem) {
  float* red = (float*)smem;
  float* mods = (float*)(p.ws + OFF_MODS);
  int l = item / 96, chunk = item % 96;
  int tid = cx.tid, kq = tid >> 6, col = tid & 63;
  int n = chunk * 64 + col;
  const float* W = p.w_ada + (size_t)l * 2048 * 6144;
  float a0 = 0, a1 = 0, a2 = 0;
#pragma unroll 8
  for (int k = kq; k < 2048; k += 8) {
    float w = W[(size_t)k * 6144 + n];
    a0 += silu_f(p.c[k]) * w;
    a1 += silu_f(p.c[2048 + k]) * w;
    a2 += silu_f(p.c_ctx[k]) * w;
  }
  red[(kq * 3 + 0) * 64 + col] = a0;
  red[(kq * 3 + 1) * 64 + col] = a1;
  red[(kq * 3 + 2) * 64 + col] = a2;
  __syncthreads();
  if (tid < 192) {
    int r = tid >> 6, cc = tid & 63;
    float s = 0;
#pragma unroll
    for (int q = 0; q < 8; ++q) s += red[(q * 3 + r) * 64 + cc];
    mods[(size_t)(l * 3 + r) * 6144 + chunk * 64 + cc] = s + p.b_ada[(size_t)l * 6144 + chunk * 64 + cc];
  }
}

DEV void p0_transpose_tile(const Params& p, const Ctx& cx, const float* __restrict__ src, bf16_t* __restrict__ dst, int K, int N, int tk, int tn, char* smem) {
  float* T = (float*)smem;
  int tid = cx.tid;
  int k0 = tk * 64, n0 = tn * 64;
  int kk = tid >> 4, n4 = tid & 15;
#pragma unroll
  for (int i = 0; i < 2; ++i) {
    int k = kk + 32 * i;
    float4 v = *(const float4*)(src + (size_t)(k0 + k) * N + n0 + n4 * 4);
    T[k * 65 + n4 * 4 + 0] = v.x; T[k * 65 + n4 * 4 + 1] = v.y; T[k * 65 + n4 * 4 + 2] = v.z; T[k * 65 + n4 * 4 + 3] = v.w;
  }
  __syncthreads();
  int n = tid >> 3, k8 = tid & 7;
  uint4 o;
  o.x = pack_bf2(T[(k8 * 8 + 0) * 65 + n], T[(k8 * 8 + 1) * 65 + n]);
  o.y = pack_bf2(T[(k8 * 8 + 2) * 65 + n], T[(k8 * 8 + 3) * 65 + n]);
  o.z = pack_bf2(T[(k8 * 8 + 4) * 65 + n], T[(k8 * 8 + 5) * 65 + n]);
  o.w = pack_bf2(T[(k8 * 8 + 6) * 65 + n], T[(k8 * 8 + 7) * 65 + n]);
  *(uint4*)(dst + (size_t)(n0 + n) * K + k0 + k8 * 8) = o;
}

DEV void phase0(const Params& p, const Ctx& cx0, char* smem) {
  const int NTR = 4368;
  const int total = 192 + 2 * NTR;
  for (int item = cx0.bid; item < total; item += cx0.nblk) {
    __syncthreads();
    Ctx cx = cx0; asm volatile("" : "+v"(cx.tid));
    if (item < 192) { p0_mods_item(p, cx, item, smem); continue; }
    int it = item - 192;
    int l = it / NTR, i = it % NTR;
    char* wt = p.ws + OFF_WT + (size_t)l * WT_SIZE;
    if (i < 3200) {
      p0_transpose_tile(p, cx, p.w_in + (size_t)l * 2048 * 6400, (bf16_t*)(wt + WT_IN), 2048, 6400, i / 100, i % 100, smem);
    } else if (i < 4224) {
      int j = i - 3200;
      p0_transpose_tile(p, cx, p.w_out + (size_t)l * 2048 * 2048, (bf16_t*)(wt + WT_OUT), 2048, 2048, j / 32, j % 32, smem);
    } else if (i < 4256) {
      int j = i - 4224, d = j / 16;
      p0_transpose_tile(p, cx, p.rwkv_w2 + (size_t)(l * 2 + d) * 64 * 1024, (bf16_t*)(wt + WT_W2) + (size_t)d * 1024 * 64, 64, 1024, 0, j % 16, smem);
    } else if (i < 4288) {
      int j = i - 4256, d = j / 16;
      p0_transpose_tile(p, cx, p.rwkv_a2 + (size_t)(l * 2 + d) * 64 * 1024, (bf16_t*)(wt + WT_A2) + (size_t)d * 1024 * 64, 64, 1024, 0, j % 16, smem);
    } else if (i < 4304) {
      int j = i - 4288, g = j / 4;
      p0_transpose_tile(p, cx, p.w_pool + (size_t)(l * 4 + g) * 128 * 128, (bf16_t*)(wt + WT_POOL) + (size_t)g * 128 * 128, 128, 128, (j % 4) / 2, j % 2, smem);
    } else {
      int j = i - 4304;
      p0_transpose_tile(p, cx, p.w_glu + (size_t)l * 512 * 512, (bf16_t*)(wt + WT_GLU), 512, 512, j / 8, j % 8, smem);
    }
  }
}

DEV void phase_adaln0(const Params& p, const Ctx& cx) {
  const float* mods = (const float*)(p.ws + OFF_MODS);
  bf16_t* hbuf = (bf16_t*)(p.ws + OFF_H);
  int lane = cx.tid & 63;
  int gw = cx.bid * 8 + (cx.tid >> 6), nw = cx.nblk * 8;
  for (int row = gw; row < MTOT; row += nw) {
    const float* src = row < NLAT ? p.x + (size_t)row * D : p.ctx + (size_t)(row - NLAT) * D;
    int mr = row < NLAT ? (row >> 14) : 2;
    const float* md = mods + (size_t)mr * 6144;
    float4 v[8];
    float s = 0;
#pragma unroll
    for (int i = 0; i < 8; ++i) { v[i] = *(const float4*)(src + i * 256 + lane * 4); s += v[i].x + v[i].y + v[i].z + v[i].w; }
    float mu = wave_sum(s) * (1.f / 2048.f);
    float q = 0;
#pragma unroll
    for (int i = 0; i < 8; ++i) { v[i].x -= mu; v[i].y -= mu; v[i].z -= mu; v[i].w -= mu; q += v[i].x * v[i].x + v[i].y * v[i].y + v[i].z * v[i].z + v[i].w * v[i].w; }
    float rstd = rsqrtf(wave_sum(q) * (1.f / 2048.f) + 1e-6f);
#pragma unroll
    for (int i = 0; i < 8; ++i) {
      int col = i * 256 + lane * 4;
      float4 sh = *(const float4*)(md + col), sc = *(const float4*)(md + 2048 + col);
      uint2 o;
      o.x = pack_bf2(v[i].x * rstd * (1.f + sc.x) + sh.x, v[i].y * rstd * (1.f + sc.y) + sh.y);
      o.y = pack_bf2(v[i].z * rstd * (1.f + sc.z) + sh.z, v[i].w * rstd * (1.f + sc.w) + sh.w);
      *(uint2*)(hbuf + (size_t)row * D + col) = o;
    }
  }
}

DEV void phase_finln(const Params& p, const Ctx& cx, int l) {
  const float* mods = (const float*)(p.ws + OFF_MODS);
  bf16_t* hbuf = (bf16_t*)(p.ws + OFF_H);
  float* prec = (float*)(p.ws + OFF_PREC);
  int lane = cx.tid & 63;
  int gw = cx.bid * 8 + (cx.tid >> 6), nw = cx.nblk * 8;
  const int nrows = (l == 0) ? MTOT : NLAT;
  for (int row = gw; row < nrows; row += nw) {
    float* src = row < NLAT ? p.out + (size_t)row * D : prec + (size_t)(row - NLAT) * D;
    float4 v[8];
    float s = 0;
#pragma unroll
    for (int i = 0; i < 8; ++i) { v[i] = *(const float4*)(src + i * 256 + lane * 4); s += v[i].x + v[i].y + v[i].z + v[i].w; }
    float mu = wave_sum(s) * (1.f / 2048.f);
    float q = 0;
#pragma unroll
    for (int i = 0; i < 8; ++i) { v[i].x -= mu; v[i].y -= mu; v[i].z -= mu; v[i].w -= mu; q += v[i].x * v[i].x + v[i].y * v[i].y + v[i].z * v[i].z + v[i].w * v[i].w; }
    float rstd = rsqrtf(wave_sum(q) * (1.f / 2048.f) + 1e-5f);
    float s2 = 0;
#pragma unroll
    for (int i = 0; i < 8; ++i) {
      int col = i * 256 + lane * 4;
      float4 g = *(const float4*)(p.ln_g + (size_t)l * D + col), b = *(const float4*)(p.ln_b + (size_t)l * D + col);
      v[i].x = v[i].x * rstd * g.x + b.x; v[i].y = v[i].y * rstd * g.y + b.y; v[i].z = v[i].z * rstd * g.z + b.z; v[i].w = v[i].w * rstd * g.w + b.w;
      if (row < NLAT) *(float4*)(src + col) = v[i];
      s2 += v[i].x + v[i].y + v[i].z + v[i].w;
    }
    if (l == 0) {
      int mr = row < NLAT ? (row >> 14) : 2;
      const float* md = mods + (size_t)(3 + mr) * 6144;
      float mu2 = wave_sum(s2) * (1.f / 2048.f);
      float q2 = 0;
#pragma unroll
      for (int i = 0; i < 8; ++i) { v[i].x -= mu2; v[i].y -= mu2; v[i].z -= mu2; v[i].w -= mu2; q2 += v[i].x * v[i].x + v[i].y * v[i].y + v[i].z * v[i].z + v[i].w * v[i].w; }
      float rstd2 = rsqrtf(wave_sum(q2) * (1.f / 2048.f) + 1e-6f);
#pragma unroll
      for (int i = 0; i < 8; ++i) {
        int col = i * 256 + lane * 4;
        float4 sh = *(const float4*)(md + col), sc = *(const float4*)(md + 2048 + col);
        uint2 o;
        o.x = pack_bf2(v[i].x * rstd2 * (1.f + sc.x) + sh.x, v[i].y * rstd2 * (1.f + sc.y) + sh.y);
        o.y = pack_bf2(v[i].z * rstd2 * (1.f + sc.z) + sh.z, v[i].w * rstd2 * (1.f + sc.w) + sh.w);
        *(uint2*)(hbuf + (size_t)row * D + col) = o;
      }
    }
  }
}

template <class Epi>
DEV void gemm_phase(const Params& p, const Ctx& cx, const bf16_t* __restrict__ A, const bf16_t* __restrict__ Bt, int K, int nM, int nN, char* smem, Epi epi) {
  const int tid = cx.tid, lane = tid & 63, wid = tid >> 6;
  const int wr = wid >> 2, wc = wid & 3, fr = lane & 15, fq = lane >> 4;
  const int nt = K / 64;
  const int ntiles = nM * nN;
  const int srow = tid >> 3, sc16 = tid & 7;
  const int nxcd = (cx.nblk & 7) == 0 ? 8 : 1;
  const int xcd = cx.bid % nxcd, xidx = cx.bid / nxcd, xper = cx.nblk / nxcd;
  const int t_lo = (int)(((long)ntiles * xcd) / nxcd), t_hi = (int)(((long)ntiles * (xcd + 1)) / nxcd);
  for (int tt = t_lo + xidx; tt < t_hi; tt += xper) {
    const int band = tt / (16 * nN);
    const int brows = min(16, nM - band * 16);
    const int rem = tt - band * 16 * nN;
    const int pn = rem / brows, pm = band * 16 + rem % brows;
    const int brow = pm * 256, bcol = pn * 256;
    const char* Ab = (const char*)(A + (size_t)brow * K);
    const char* Bb = (const char*)(Bt + (size_t)bcol * K);
    const unsigned voff = (unsigned)(srow * K + sc16 * 8) * 2u;
    const size_t rs = (size_t)64 * K * 2;
    f32x4 acc[8][4];
#pragma unroll
    for (int i = 0; i < 8; ++i)
#pragma unroll
      for (int j = 0; j < 4; ++j) acc[i][j] = f32x4{0.f, 0.f, 0.f, 0.f};
    uint4 ra0, ra1, ra2, ra3, rb0, rb1, rb2, rb3;
#define G_LD(ko) { const char* a_ = Ab + (size_t)(ko) * 2; const char* b_ = Bb + (size_t)(ko) * 2; \
                 ra0 = *(const uint4*)(a_ + voff); ra1 = *(const uint4*)(a_ + rs + voff); ra2 = *(const uint4*)(a_ + 2 * rs + voff); ra3 = *(const uint4*)(a_ + 3 * rs + voff); \
                 rb0 = *(const uint4*)(b_ + voff); rb1 = *(const uint4*)(b_ + rs + voff); rb2 = *(const uint4*)(b_ + 2 * rs + voff); rb3 = *(const uint4*)(b_ + 3 * rs + voff); }
#define G_ST(sp) { *(uint4*)(sp) = ra0; *(uint4*)((sp) + 64 * 144) = ra1; *(uint4*)((sp) + 128 * 144) = ra2; *(uint4*)((sp) + 192 * 144) = ra3; \
                 *(uint4*)((sp) + 36864) = rb0; *(uint4*)((sp) + 36864 + 64 * 144) = rb1; *(uint4*)((sp) + 36864 + 128 * 144) = rb2; *(uint4*)((sp) + 36864 + 192 * 144) = rb3; }
    char* const sbase = smem + srow * 144 + sc16 * 16;
    G_LD(0);
    G_ST(sbase);
    if (nt > 1) G_LD(64);
    for (int kt = 0; kt < nt; ++kt) {
      __syncthreads();
      if (kt + 1 < nt) { char* s1 = sbase + ((kt + 1) & 1) * 73728; G_ST(s1); }
      if (kt + 2 < nt) G_LD((kt + 2) * 64);
      const char* As = smem + (kt & 1) * 73728;
      const char* Bs = As + 36864;
#pragma unroll
      for (int kh = 0; kh < 2; ++kh) {
        bf16x8 bfr[4];
#pragma unroll
        for (int jn = 0; jn < 4; ++jn) bfr[jn] = *(const bf16x8*)(Bs + (wc * 64 + jn * 16 + fr) * 144 + kh * 64 + fq * 16);
#pragma unroll
        for (int i = 0; i < 8; ++i) {
          bf16x8 af = *(const bf16x8*)(As + (wr * 128 + i * 16 + fr) * 144 + kh * 64 + fq * 16);
#pragma unroll
          for (int jn = 0; jn < 4; ++jn) acc[i][jn] = __builtin_amdgcn_mfma_f32_16x16x32_f16(bfr[jn], af, acc[i][jn], 0, 0, 0);
        }
      }
    }
    __syncthreads();
#pragma unroll
    for (int i = 0; i < 8; ++i)
#pragma unroll
      for (int jn = 0; jn < 4; ++jn) epi(brow + wr * 128 + i * 16 + fr, bcol + wc * 64 + jn * 16 + fq * 4, acc[i][jn]);
  }
}

#define LAS3 __attribute__((address_space(3)))
DEV int g2_lds_byte(int r, int c) { const int st = (r >> 4) * 2 + (c >> 5), rr = r & 15, cc = c & 31, ob = rr * 64 + cc * 2; return st * 1024 + (ob ^ (((ob >> 9) & 1) << 5)); }
DEV void g2_stage_rc(int b, int& R, int& C) { const int st = b / 1024, sb = b % 1024, swz = sb ^ (((sb >> 9) & 1) << 5); R = (st >> 1) * 16 + swz / 64; C = (st & 1) * 32 + (swz % 64) / 2; }

template <class Epi>
DEV void gemm_phase2(const Params& p, const Ctx& cx, const bf16_t* __restrict__ A, const bf16_t* __restrict__ Bt, int K, int nM, int nN, char* smem, Epi epi) {
  constexpr int HTB = 128 * 64 * 2;
  LAS3 unsigned char* lds = (LAS3 unsigned char*)smem;
  const int tid = cx.tid, wid = __builtin_amdgcn_readfirstlane(tid >> 6), lane = tid & 63, wr = wid >> 2, wc = wid & 3, fr = lane & 15, fq = lane >> 4;
  const int nt = K / 64;
  const int ntiles = nM * nN;
  const int nxcd = (cx.nblk & 7) == 0 ? 8 : 1;
  const int xcd = cx.bid % nxcd, xidx = cx.bid / nxcd, xper = cx.nblk / nxcd;
  const int t_lo = (int)(((long)ntiles * xcd) / nxcd), t_hi = (int)(((long)ntiles * (xcd + 1)) / nxcd);
  auto unit_at = [&](int i, int& pm, int& pn) -> bool {
    const int tt = t_lo + xidx + i * xper;
    if (tt >= t_hi) return false;
    const int band = tt / (16 * nN);
    const int brows = min(16, nM - band * 16);
    const int rem = tt - band * 16 * nN;
    pn = rem / brows; pm = band * 16 + rem % brows;
    return true;
  };
  unsigned voffA[2], voffB[2];
#pragma unroll
  for (int i = 0; i < 2; ++i) {
    int R, C; g2_stage_rc(tid * 16 + i * 8192, R, C);
    const int rho = R & 31, Rb = (R & ~31) + 8 * ((rho & 15) >> 2) + 4 * (rho >> 4) + (rho & 3);
    voffA[i] = (unsigned)(R * K + C) * 2u; voffB[i] = (unsigned)(Rb * K + C) * 2u;
  }
  const size_t kstep = (size_t)(64 * 2);
  const size_t hstep = (size_t)128 * K * 2;
  const size_t tstep = 2 * hstep;
  const unsigned ldsw = (unsigned)wid * 1024u;
  const int aoff = g2_lds_byte(wr * 64 + fr, fq * 8), boff = g2_lds_byte(wc * 32 + fr, fq * 8);
#define G2_SA(b, h) (((b) * 2 + (h)) * HTB)
#define G2_SB(b, h) ((4 + (b) * 2 + (h)) * HTB)
#define G2_STAGE_(bufoff, gbase, vo_) do { _Pragma("unroll") for (int _i = 0; _i < 2; ++_i) \
    __builtin_amdgcn_global_load_lds((const unsigned*)((const char*)(gbase) + vo_[_i]), (LAS3 unsigned*)(lds + (bufoff) + ldsw + _i * 8192), 16, 0, 0); } while (0)
#define G2_STAGE(bufoff, gbase) G2_STAGE_(bufoff, gbase, voffA)
#define G2_STAGEB(bufoff, gbase) G2_STAGE_(bufoff, gbase, voffB)
#define G2_LDA(dst, b, h) do { _Pragma("unroll") for (int m = 0; m < 4; ++m) _Pragma("unroll") for (int k = 0; k < 2; ++k) dst[m][k] = *(const LAS3 bf16x8*)(lds + G2_SA(b, h) + aoff + m * 2048 + k * 1024); } while (0)
#define G2_LDB(dst, b, h) do { _Pragma("unroll") for (int n = 0; n < 2; ++n) _Pragma("unroll") for (int k = 0; k < 2; ++k) dst[n][k] = *(const LAS3 bf16x8*)(lds + G2_SB(b, h) + boff + n * 2048 + k * 1024); } while (0)
#define G2_MMA(ai, bj, At_, Bt_) do { __builtin_amdgcn_s_setprio(1); _Pragma("unroll") for (int m = 0; m < 4; ++m) _Pragma("unroll") for (int n = 0; n < 2; ++n) _Pragma("unroll") for (int k = 0; k < 2; ++k) \
    acc[ai][bj][m][n] = __builtin_amdgcn_mfma_f32_16x16x32_f16(Bt_[n][k], At_[m][k], acc[ai][bj][m][n], 0, 0, 0); __builtin_amdgcn_s_setprio(0); } while (0)
#define G2_WAIT_V(n) asm volatile("s_waitcnt vmcnt(" #n ")" ::: "memory")
#define G2_WAIT_L(n) asm volatile("s_waitcnt lgkmcnt(" #n ")" ::: "memory")
#define G2_BAR __builtin_amdgcn_s_barrier()
#define G2_SCHED __builtin_amdgcn_sched_barrier(0)
  int cpm, cpn, npm = 0, npn = 0, ui = 0;
  if (!unit_at(0, cpm, cpn)) return;
  f32x4 acc[2][2][4][2];
#pragma unroll
  for (int a = 0; a < 2; ++a)
#pragma unroll
    for (int b = 0; b < 2; ++b)
#pragma unroll
      for (int m = 0; m < 4; ++m)
#pragma unroll
        for (int n = 0; n < 2; ++n) acc[a][b][m][n] = f32x4{0.f, 0.f, 0.f, 0.f};
  bf16x8 At[4][2], B0[2][2], B1[2][2];
  const char* cA = (const char*)A + (size_t)cpm * tstep;
  const char* cB = (const char*)Bt + (size_t)cpn * tstep;
  G2_STAGEB(G2_SB(0, 0), cB); G2_STAGE(G2_SA(0, 0), cA); G2_STAGEB(G2_SB(0, 1), cB + hstep); G2_STAGE(G2_SA(0, 1), cA + hstep);
  if (wr == 1) G2_BAR;
  G2_WAIT_V(4); G2_BAR;
  G2_STAGEB(G2_SB(1, 0), cB + kstep); G2_STAGE(G2_SA(1, 0), cA + kstep); G2_STAGEB(G2_SB(1, 1), cB + hstep + kstep);
  G2_WAIT_V(6); G2_BAR;
  for (;;) {
    const bool has_next = unit_at(ui + 1, npm, npn);
    const char* nA = has_next ? (const char*)A + (size_t)npm * tstep : cA;
    const char* nB = has_next ? (const char*)Bt + (size_t)npn * tstep : cB;
    for (int t = 0; t < nt; t += 2) {
      const bool last = (t == nt - 2);
      const char* a1 = cA + (size_t)(t + 1) * kstep;
      const char* a2 = last ? nA : cA + (size_t)(t + 2) * kstep;
      const char* b2 = last ? nB : cB + (size_t)(t + 2) * kstep;
      const char* a3 = a2 + kstep;
      const char* b3 = b2 + kstep;
      G2_LDB(B0, 0, 0); G2_SCHED; G2_LDA(At, 0, 0); G2_STAGE(G2_SA(1, 1), a1 + hstep);
      G2_WAIT_L(8); G2_BAR; G2_WAIT_L(0); G2_MMA(0, 0, At, B0); G2_BAR; G2_SCHED;
      G2_LDB(B1, 0, 1); G2_STAGEB(G2_SB(0, 0), b2);
      G2_BAR; G2_WAIT_L(0); G2_MMA(0, 1, At, B1); G2_BAR;
      G2_LDA(At, 0, 1); G2_STAGE(G2_SA(0, 0), a2);
      G2_BAR; G2_WAIT_L(0); G2_MMA(1, 0, At, B0); G2_BAR; G2_SCHED;
      G2_STAGEB(G2_SB(0, 1), b2 + hstep);
      G2_WAIT_V(6); G2_BAR; G2_MMA(1, 1, At, B1); G2_BAR;
      G2_LDB(B0, 1, 0); G2_SCHED; G2_LDA(At, 1, 0); G2_STAGE(G2_SA(0, 1), a2 + hstep);
      G2_WAIT_L(8); G2_BAR; G2_WAIT_L(0); G2_MMA(0, 0, At, B0); G2_BAR; G2_SCHED;
      G2_LDB(B1, 1, 1); G2_STAGEB(G2_SB(1, 0), b3);
      G2_BAR; G2_WAIT_L(0); G2_MMA(0, 1, At, B1); G2_BAR;
      G2_LDA(At, 1, 1); G2_STAGE(G2_SA(1, 0), a3);
      G2_BAR; G2_WAIT_L(0); G2_MMA(1, 0, At, B0); G2_BAR; G2_SCHED;
      G2_STAGEB(G2_SB(1, 1), b3 + hstep);
      G2_WAIT_V(6); G2_BAR; G2_MMA(1, 1, At, B1); G2_BAR;
    }
    {
      const int row0 = cpm * 256 + wr * 64 + fr, col0 = cpn * 256 + wc * 32 + 8 * fq;
#pragma unroll
      for (int ai = 0; ai < 2; ++ai)
#pragma unroll
        for (int m = 0; m < 4; ++m)
#pragma unroll
          for (int bj = 0; bj < 2; ++bj) epi(row0 + ai * 128 + m * 16, col0 + bj * 128, acc[ai][bj][m][0], acc[ai][bj][m][1]);
    }
    if (!has_next) break;
#pragma unroll
    for (int a = 0; a < 2; ++a)
#pragma unroll
      for (int b = 0; b < 2; ++b)
#pragma unroll
        for (int m = 0; m < 4; ++m)
#pragma unroll
          for (int n = 0; n < 2; ++n) acc[a][b][m][n] = f32x4{0.f, 0.f, 0.f, 0.f};
    cpm = npm; cpn = npn; cA = nA; cB = nB; ++ui;
  }
  G2_WAIT_V(0);
  if (wr == 0) G2_BAR;
  G2_BAR;
#undef G2_SA
#undef G2_SB
#undef G2_STAGE
#undef G2_STAGEB
#undef G2_STAGE_
#undef G2_LDA
#undef G2_LDB
#undef G2_MMA
#undef G2_WAIT_V
#undef G2_WAIT_L
#undef G2_BAR
#undef G2_SCHED
}

template <int K, int NT, class Epi>
DEV void small_gemm(const Params& p, const Ctx& cx, const char* As, int astride, const bf16_t* __restrict__ Bt, int n0, Epi epi) {
  const int lane = cx.tid & 63, fr = lane & 15, fq = lane >> 4;
  f32x4 acc[4][NT];
#pragma unroll
  for (int i = 0; i < 4; ++i)
#pragma unroll
    for (int j = 0; j < NT; ++j) acc[i][j] = f32x4{0.f, 0.f, 0.f, 0.f};
#pragma unroll 2
  for (int k0 = 0; k0 < K; k0 += 32) {
    bf16x8 af[4];
#pragma unroll
    for (int i = 0; i < 4; ++i) af[i] = *(const bf16x8*)(As + (i * 16 + fr) * astride + (k0 + fq * 8) * 2);
#pragma unroll
    for (int jn = 0; jn < NT; ++jn) {
      bf16x8 bf = *(const bf16x8*)(Bt + (size_t)(n0 + jn * 16 + fr) * K + k0 + fq * 8);
#pragma unroll
      for (int i = 0; i < 4; ++i) acc[i][jn] = __builtin_amdgcn_mfma_f32_16x16x32_f16(bf, af[i], acc[i][jn], 0, 0, 0);
    }
  }
#pragma unroll
  for (int i = 0; i < 4; ++i)
#pragma unroll
    for (int jn = 0; jn < NT; ++jn) epi(i * 16 + fr, n0 + jn * 16 + fq * 4, acc[i][jn]);
}

struct S5P { float ar, ai, br, bi; };
DEV S5P s5_params(const Params& p, const Ctx& cx, int l, int d, int g, int lane) {
  int idx = ((l * 2 + d) * 32 + g) * 64 + lane;
  float lr = fminf(p.s5_lam_re[idx], -1e-4f), li = p.s5_lam_im[idx];
  float step = expf(p.s5_log_step[(l * 2 + d) * 32 + g]);
  float xr = lr * step, xi = li * step;
  float e = expf(xr), cs = cosf(xi), sn = sinf(xi);
  S5P r;
  r.ar = e * cs; r.ai = e * sn;
  float sh = sinf(0.5f * xi);
  float nr = expm1f(xr) * cs - 2.f * sh * sh, ni = e * sn;
  float inv = 1.f / (lr * lr + li * li);
  r.br = (nr * lr + ni * li) * inv;
  r.bi = (ni * lr - nr * li) * inv;
  return r;
}

DEV void s5_load_u(const h16* zrest, int rowbase, int g, char* ulds, int lane) {
#pragma unroll
  for (int i = 0; i < 8; ++i) {
    int e = i * 64 + lane;
    int r = e >> 1, hf = e & 1;
    uint4 v = *(const uint4*)(zrest + (size_t)(rowbase + r) * ZR + g * 16 + hf * 8);
    *(uint4*)(ulds + r * 32 + hf * 16) = v;
  }
  lds_fence();
}

DEV int s5_rowbase(int b, int c) { return c == 0 ? NLAT + b * 256 : b * 16384 + (c - 1) * 256; }

DEV void s5_pass1_unit(const Params& p, const Ctx& cx, int l, int unit, char* wl, int lane) {
  int c = unit % 65, bg = unit / 65, g = bg & 31, b = bg >> 5;
  const h16* zrest = (const h16*)(p.ws + OFF_ZREST);
  float2* F = (float2*)(p.ws + OFF_S5F);
  s5_load_u(zrest, s5_rowbase(b, c), g, wl, lane);
  float Br[16], Bi[16];
  {
    const float* pr = p.s5_b_re + ((size_t)(l * 32 + g) * 64 + lane) * 16;
    const float* pi = p.s5_b_im + ((size_t)(l * 32 + g) * 64 + lane) * 16;
#pragma unroll
    for (int i = 0; i < 16; i += 4) {
      float4 a = *(const float4*)(pr + i), bq = *(const float4*)(pi + i);
      Br[i] = a.x; Br[i + 1] = a.y; Br[i + 2] = a.z; Br[i + 3] = a.w;
      Bi[i] = bq.x; Bi[i + 1] = bq.y; Bi[i + 2] = bq.z; Bi[i + 3] = bq.w;
    }
  }
  S5P pf = s5_params(p, cx, l, 0, g, lane), pb = s5_params(p, cx, l, 1, g, lane);
  float xr = 0, xi = 0, yr = 0, yi = 0, pwr = 1.f, pwi = 0.f;
#pragma unroll 4
  for (int t = 0; t < 256; ++t) {
    h16x8 u0 = *(const h16x8*)(wl + t * 32), u1 = *(const h16x8*)(wl + t * 32 + 16);
    float br = 0, bi = 0;
#pragma unroll
    for (int i = 0; i < 8; ++i) { float u = (float)u0[i]; br = fmaf(u, Br[i], br); bi = fmaf(u, Bi[i], bi); }
#pragma unroll
    for (int i = 0; i < 8; ++i) { float u = (float)u1[i]; br = fmaf(u, Br[8 + i], br); bi = fmaf(u, Bi[8 + i], bi); }
    float vr = pf.br * br - pf.bi * bi, vi = pf.br * bi + pf.bi * br;
    float nxr = pf.ar * xr - pf.ai * xi + vr, nxi = pf.ar * xi + pf.ai * xr + vi;
    xr = nxr; xi = nxi;
    float wr_ = pb.br * br - pb.bi * bi, wi_ = pb.br * bi + pb.bi * br;
    yr += pwr * wr_ - pwi * wi_; yi += pwr * wi_ + pwi * wr_;
    float npr = pwr * pb.ar - pwi * pb.ai, npi = pwr * pb.ai + pwi * pb.ar;
    pwr = npr; pwi = npi;
  }
  size_t fi = (((size_t)(b * 32 + g) * 65 + c) * 2) * 64 + lane;
  F[fi] = make_float2(xr, xi);
  F[fi + 64] = make_float2(yr, yi);
}

DEV void s5_pass3_unit(const Params& p, const Ctx& cx, int l, int unit, char* wl, int lane) {
  int c = unit % 65, bg = unit / 65, g = bg & 31, b = bg >> 5;
  const int fr = lane & 15, fq = lane >> 4;
  const h16* zrest = (const h16*)(p.ws + OFF_ZREST);
  const float2* F = (const float2*)(p.ws + OFF_S5F);
  float* S5Y = (float*)(p.ws + OFF_S5Y);
  const int rowbase = s5_rowbase(b, c);
  char* ulds = wl;
  char* tile = wl + 8192;
  s5_load_u(zrest, rowbase, g, ulds, lane);
  float Br[16], Bi[16];
  {
    const float* pr = p.s5_b_re + ((size_t)(l * 32 + g) * 64 + lane) * 16;
    const float* pi = p.s5_b_im + ((size_t)(l * 32 + g) * 64 + lane) * 16;
#pragma unroll
    for (int i = 0; i < 16; i += 4) {
      float4 a = *(const float4*)(pr + i), bq = *(const float4*)(pi + i);
      Br[i] = a.x; Br[i + 1] = a.y; Br[i + 2] = a.z; Br[i + 3] = a.w;
      Bi[i] = bq.x; Bi[i + 1] = bq.y; Bi[i + 2] = bq.z; Bi[i + 3] = bq.w;
    }
  }
  const float dsk = p.s5_d[(size_t)l * 512 + g * 16 + fr];
  const size_t fbase = ((size_t)(b * 32 + g) * 65) * 2 * 64 + lane;
#pragma unroll 1
  for (int d = 0; d < 2; ++d) {
    S5P pp = s5_params(p, cx, l, d, g, lane);
    float qr = pp.ar, qi = pp.ai;
#pragma unroll
    for (int i = 0; i < 8; ++i) { float t = qr * qr - qi * qi; qi = 2.f * qr * qi; qr = t; }
    float xr = 0, xi = 0;
    if (d == 0) {
      for (int cc = 0; cc < c; ++cc) {
        float2 f = F[fbase + (size_t)(cc * 2 + 0) * 64];
        float t = qr * xr - qi * xi + f.x; xi = qr * xi + qi * xr + f.y; xr = t;
      }
    } else if (c > 0) {
      float2 f0 = F[fbase + (size_t)(0 * 2 + 1) * 64];
      xr = f0.x; xi = f0.y;
      for (int cc = 64; cc > c; --cc) {
        float2 f = F[fbase + (size_t)(cc * 2 + 1) * 64];
        float t = qr * xr - qi * xi + f.x; xi = qr * xi + qi * xr + f.y; xr = t;
      }
    }
    bf16x8 chi[4], clo[4];
    {
      const float* cr = p.s5_c_re + ((size_t)((l * 2 + d) * 32 + g) * 16 + fr) * 64;
      const float* ci = p.s5_c_im + ((size_t)((l * 2 + d) * 32 + g) * 16 + fr) * 64;
#pragma unroll
      for (int ks = 0; ks < 4; ++ks) {
        float4 a = *(const float4*)(cr + ks * 16 + fq * 4), bq = *(const float4*)(ci + ks * 16 + fq * 4);
        float vals[8] = {a.x, -bq.x, a.y, -bq.y, a.z, -bq.z, a.w, -bq.w};
#pragma unroll
        for (int j = 0; j < 8; ++j) {
          h16 hh = (h16)vals[j];
          chi[ks][j] = hh;
          clo[ks][j] = (h16)(vals[j] - (float)hh);
        }
      }
    }
#pragma unroll 1
    for (int sb = 0; sb < 16; ++sb) {
      const int sub = d == 0 ? sb : 15 - sb;
#pragma unroll 4
      for (int q = 0; q < 16; ++q) {
        const int tt = d == 0 ? q : 15 - q;
        const int t = sub * 16 + tt;
        h16x8 u0 = *(const h16x8*)(ulds + t * 32), u1 = *(const h16x8*)(ulds + t * 32 + 16);
        float br = 0, bi = 0;
#pragma unroll
        for (int i = 0; i < 8; ++i) { float u = (float)u0[i]; br = fmaf(u, Br[i], br); bi = fmaf(u, Bi[i], bi); }
#pragma unroll
        for (int i = 0; i < 8; ++i) { float u = (float)u1[i]; br = fmaf(u, Br[8 + i], br); bi = fmaf(u, Bi[8 + i], bi); }
        float vr = pp.br * br - pp.bi * bi, vi = pp.br * bi + pp.bi * br;
        float nxr = pp.ar * xr - pp.ai * xi + vr, nxi = pp.ar * xi + pp.ai * xr + vi;
        xr = nxr; xi = nxi;
        h16x2 hv2 = {(h16)xr, (h16)xi};
        *(unsigned*)(tile + tt * 272 + lane * 4) = __builtin_bit_cast(unsigned, hv2);
      }
      lds_fence();
      f32x4 acc = f32x4{0.f, 0.f, 0.f, 0.f};
#pragma unroll
      for (int ks = 0; ks < 4; ++ks) {
        bf16x8 ah = *(const bf16x8*)(tile + fr * 272 + ks * 64 + fq * 16);
        acc = __builtin_amdgcn_mfma_f32_16x16x32_f16(ah, chi[ks], acc, 0, 0, 0);
        acc = __builtin_amdgcn_mfma_f32_16x16x32_f16(ah, clo[ks], acc, 0, 0, 0);
      }
      lds_fence();
#pragma unroll
      for (int r = 0; r < 4; ++r) {
        int tl = sub * 16 + fq * 4 + r;
        float* yp = S5Y + (size_t)(rowbase + tl) * 512 + g * 16 + fr;
        if (d == 0) {
          float u = (float)*(const h16*)(ulds + tl * 32 + fr * 2);
          *yp = acc[r] + dsk * u;
        } else {
          *yp = gelu_f(*yp + acc[r]);
        }
      }
    }
  }
}

DEV void prep_item(const Params& p, const Ctx& cx, int l, int item, char* smem) {
  const int tile = item >> 2, q = item & 3;
  const int row0 = tile * 64;
  const int tid = cx.tid;
  const h16* zc = (const h16*)(p.ws + OFF_REG2);
  h16* SC = (h16*)(p.ws + OFF_SCAN);
  const char* wt = p.ws + OFF_WT + (size_t)l * WT_SIZE;
  {
    const int d = q >> 1, isA = q & 1;
    const int coff = isA ? 3200 + d * 64 : 3072 + d * 64;
    int tok = tid >> 3, c8 = tid & 7;
    h16x8 cv = *(const h16x8*)(zc + (size_t)(row0 + tok) * ZC + coff + c8 * 8);
    float f[8];
#pragma unroll
    for (int j = 0; j < 8; ++j) { f[j] = (float)cv[j]; if (!isA) f[j] = tanh_f(f[j]); }
    uint4 o;
    o.x = pack_bf2(f[0], f[1]); o.y = pack_bf2(f[2], f[3]); o.z = pack_bf2(f[4], f[5]); o.w = pack_bf2(f[6], f[7]);
    *(uint4*)(smem + tok * 144 + c8 * 16) = o;
    __syncthreads();
    const bf16_t* Bt = (const bf16_t*)(wt + (isA ? WT_A2 : WT_W2)) + (size_t)d * 1024 * 64;
    const float* biasw = p.rwkv_w0 + (size_t)(l * 2 + d) * 1024;
    const float* biasa = p.rwkv_a0 + (size_t)(l * 2 + d) * 1024;
    h16* dst = SC + (size_t)(isA ? 4 + d : 6 + d) * ARR;
#pragma unroll 1
    for (int hf = 0; hf < 2; ++hf) small_gemm<64, 4>(p, cx, smem, 144, Bt, (tid >> 6) * 128 + hf * 64, [&](int m, int n, f32x4 v) {
      float4 bbw = *(const float4*)(biasw + n), bba = *(const float4*)(biasa + n);
      float4 bb = isA ? bba : bbw;
      float r0 = sigmoid_f(v[0] + bb.x), r1 = sigmoid_f(v[1] + bb.y), r2 = sigmoid_f(v[2] + bb.z), r3 = sigmoid_f(v[3] + bb.w);
      if (!isA) { r0 = __expf(-DECAY_SCALE * r0); r1 = __expf(-DECAY_SCALE * r1); r2 = __expf(-DECAY_SCALE * r2); r3 = __expf(-DECAY_SCALE * r3); }
      h16x4 o4 = {(h16)r0, (h16)r1, (h16)r2, (h16)r3};
      *(h16x4*)(dst + (size_t)(row0 + m) * 1024 + n) = o4;
    });
  }
  {
    const float* cw = p.conv_rkv + (size_t)l * 3 * 3072;
    const int grp = tid & 7, hh = (tid >> 3) & 3;
    const int c0 = (4 * q + hh) * 64 + grp * 8;
    float cwt[3][3][8];
#pragma unroll
    for (int s = 0; s < 3; ++s)
#pragma unroll
      for (int tp = 0; tp < 3; ++tp)
#pragma unroll
        for (int j = 0; j < 8; j += 4) {
          float4 a = *(const float4*)(cw + tp * 3072 + s * 1024 + c0 + j);
          cwt[s][tp][j] = a.x; cwt[s][tp][j + 1] = a.y; cwt[s][tp][j + 2] = a.z; cwt[s][tp][j + 3] = a.w;
        }
    float kkw[8];
#pragma unroll
    for (int j = 0; j < 8; j += 4) {
      float4 kq = *(const float4*)(p.rwkv_k_k + (size_t)l * 1024 + c0 + j);
      kkw[j] = kq.x; kkw[j + 1] = kq.y; kkw[j + 2] = kq.z; kkw[j + 3] = kq.w;
    }
#pragma unroll 1
    for (int it = 0; it < 4; ++it) {
      const int tok = (tid >> 5) + it * 16;
      const int row = row0 + tok;
      bool hasp, hasn;
      if (row < NLAT) { hasp = (row & 16383) != 0; hasn = (row & 16383) != 16383; }
      else { hasp = (row & 255) != 0; hasn = (row & 255) != 255; }
      const size_t off = (size_t)row * 1024 + c0;
      const h16* zp = zc + (size_t)row * ZC + c0;
      const h16* zpp = hasp ? zp - ZC : zp;
      const h16* zpn = hasn ? zp + ZC : zp;
      h16x8 cur[3], prv[3], nxt[3];
#pragma unroll
      for (int s = 0; s < 3; ++s) { cur[s] = *(const h16x8*)(zp + s * 1024); prv[s] = *(const h16x8*)(zpp + s * 1024); nxt[s] = *(const h16x8*)(zpn + s * 1024); }
      const float fp = hasp ? 1.f : 0.f, fn = hasn ? 1.f : 0.f;
      float kv[8];
#pragma unroll
      for (int s = 0; s < 3; ++s) {
        h16x8 o;
#pragma unroll
        for (int j = 0; j < 8; ++j) {
          float ov = cwt[s][0][j] * (fp * (float)prv[s][j]) + cwt[s][1][j] * (float)cur[s][j] + cwt[s][2][j] * (fn * (float)nxt[s][j]);
          o[j] = (h16)ov;
          if (s == 1) kv[j] = ov;
        }
        *(h16x8*)(SC + (size_t)s * ARR + off) = o;
      }
      float kk[8], ss = 0;
#pragma unroll
      for (int j = 0; j < 8; ++j) { kk[j] = kv[j] * kkw[j]; ss += kk[j] * kk[j]; }
      ss = allreduce8(ss);
      float inv = rcp_f(fmaxf(sqrtf(ss), 1e-12f));
      h16x8 o;
#pragma unroll
      for (int j = 0; j < 8; ++j) o[j] = (h16)(kk[j] * inv);
      *(h16x8*)(SC + 3 * ARR + off) = o;
    }
  }
}

DEV void phase_prep(const Params& p, const Ctx& cx0, int l, char* smem) {
  const int NPREP = 520 * 4, NS5 = 520;
  const Ctx& cx_ = cx0;
  for (int item = cx_.bid; item < NPREP + NS5; item += cx_.nblk) {
    __syncthreads();
    Ctx cx = cx0; asm volatile("" : "+v"(cx.tid));
    const int lane = cx.tid & 63, wid = cx.tid >> 6;
#ifndef NO_PREPITEM
    if (item < NPREP) prep_item(p, cx, l, item, smem);
    else
#endif
#ifndef NO_S5P1
      s5_pass1_unit(p, cx, l, (item - NPREP) * 8 + wid, smem + wid * 8192, lane);
#else
    {}
#endif
  }
}

typedef unsigned u2v __attribute__((ext_vector_type(2)));
struct RG { u2v w, a, kk, k, r; h16 v; };

constexpr int RW_NSLOT = 8, RW_SLOTB = 3072;
constexpr int RW_FLAGS = RW_NSLOT * RW_SLOTB;
constexpr int RW_NG = 16640 / 4;
typedef float f4v __attribute__((ext_vector_type(4)));

#define RW_RLO(gq, rlo)                                                            \
  {                                                                                \
    const int gg = (gq) < RW_NG ? (gq) : RW_NG - 1;                                \
    const int q0_ = gg * 4;                                                        \
    const int isl = q0_ >= 256;                                                    \
    const int base_ = isl ? b * 16384 : NLAT + b * 256;                            \
    const int t0_ = isl ? q0_ - 256 : q0_;                                         \
    const int last_ = isl ? 16383 : 255;                                           \
    rlo = base_ + (d ? last_ - t0_ - 3 : t0_);                                     \
  }

DEV void rwkv_helper(const Params& p, const Ctx& cx, int l, int unit, int lane, char* ring) {
  const int d = unit & 1, h = (unit >> 1) & 15, b = unit >> 5;
  const int j = lane >> 4, s = lane & 15;
  const h16* SC = (const h16*)(p.ws + OFF_SCAN);
  const char* pR = (const char*)(SC + 0 * ARR + h * 64);
  const char* pK = (const char*)(SC + 1 * ARR + h * 64);
  const char* pV = (const char*)(SC + 2 * ARR + h * 64);
  const char* pKK = (const char*)(SC + 3 * ARR + h * 64);
  const char* pA = (const char*)(SC + (size_t)(4 + d) * ARR + h * 64);
  const char* pW = (const char*)(SC + (size_t)(6 + d) * ARR + h * 64);
  const int jm = d ? 3 - j : j;
  const unsigned vo0 = (unsigned)(jm * 2048 + s * 8);
  f4v ka4, om4;
  {
    float4 t = *(const float4*)(p.rwkv_k_a + (size_t)l * 1024 + h * 64 + 4 * s);
    ka4 = f4v{t.x, t.y, t.z, t.w};
    om4 = 1.f - ka4;
  }
  struct RGH { u2v w, a, kk, k, r, v; };
  RGH q0, q1, q2, q3, q4, q5, q6, q7;
  const unsigned wofs = (unsigned)(j * 128 + s * 8);
  const unsigned vwofs = (unsigned)(2560 + j * 128 + s * 8);
  LAS3 volatile int* pflag = (LAS3 volatile int*)(ring + RW_FLAGS);
  LAS3 volatile int* cflag = (LAS3 volatile int*)(ring + RW_FLAGS + 64);
  int cmin = 0;
#define CV4(uv) __builtin_convertvector(__builtin_bit_cast(h16x4, uv), f4v)
#define RH_LOAD(q, gq)                                                             \
  {                                                                                \
    int rlo; RW_RLO(gq, rlo);                                                      \
    unsigned vo = vo0; asm volatile("" : "+v"(vo));                                \
    const size_t off = (size_t)rlo * 2048;                                         \
    q.w = *(const u2v*)(pW + off + vo); q.a = *(const u2v*)(pA + off + vo);        \
    q.kk = *(const u2v*)(pKK + off + vo); q.k = *(const u2v*)(pK + off + vo);      \
    q.r = *(const u2v*)(pR + off + vo); q.v = *(const u2v*)(pV + off + vo);        \
  }
#define RH_STEP(q, gq)                                                             \
  {                                                                                \
    if ((gq) >= RW_NSLOT && cmin < (gq) - RW_NSLOT + 1) {                          \
      do {                                                                         \
        const int c0_ = cflag[0], c1_ = cflag[1], c2_ = cflag[2], c3_ = cflag[3];  \
        cmin = __builtin_amdgcn_readfirstlane(min(min(c0_, c1_), min(c2_, c3_)));  \
        if (cmin < (gq) - RW_NSLOT + 1) __builtin_amdgcn_s_sleep(1);               \
      } while (cmin < (gq) - RW_NSLOT + 1);                                        \
    }                                                                              \
    asm volatile("" ::: "memory");                                                 \
    char* sl = ring + ((gq) % RW_NSLOT) * RW_SLOTB;                                \
    const f4v a_ = CV4(q.a), kk_ = CV4(q.kk);                                      \
    const f4v kka_ = kk_ * a_, kd_ = CV4(q.k) * (a_ * ka4 + om4);                  \
    *(u2v*)(sl + 0 * 512 + wofs) = q.w;                                            \
    *(u2v*)(sl + 1 * 512 + wofs) = q.kk;                                           \
    *(u2v*)(sl + 2 * 512 + wofs) = __builtin_bit_cast(u2v, __builtin_convertvector(kka_, h16x4)); \
    *(u2v*)(sl + 3 * 512 + wofs) = __builtin_bit_cast(u2v, __builtin_convertvector(kd_, h16x4));  \
    *(u2v*)(sl + 4 * 512 + wofs) = q.r;                                            \
    *(u2v*)(sl + vwofs) = q.v;                                                     \
    asm volatile("s_waitcnt lgkmcnt(0)" ::: "memory");     \
    *pflag = (gq) + 1;                                                             \
  }
  RH_LOAD(q0, 0); RH_LOAD(q1, 1); RH_LOAD(q2, 2); RH_LOAD(q3, 3); RH_LOAD(q4, 4); RH_LOAD(q5, 5); RH_LOAD(q6, 6); RH_LOAD(q7, 7);
#pragma unroll 1
  for (int g = 0; g < RW_NG; g += 8) {
    RH_STEP(q0, g); RH_LOAD(q0, g + 8); __builtin_amdgcn_sched_barrier(0);
    RH_STEP(q1, g + 1); RH_LOAD(q1, g + 9); __builtin_amdgcn_sched_barrier(0);
    RH_STEP(q2, g + 2); RH_LOAD(q2, g + 10); __builtin_amdgcn_sched_barrier(0);
    RH_STEP(q3, g + 3); RH_LOAD(q3, g + 11); __builtin_amdgcn_sched_barrier(0);
    RH_STEP(q4, g + 4); RH_LOAD(q4, g + 12); __builtin_amdgcn_sched_barrier(0);
    RH_STEP(q5, g + 5); RH_LOAD(q5, g + 13); __builtin_amdgcn_sched_barrier(0);
    RH_STEP(q6, g + 6); RH_LOAD(q6, g + 14); __builtin_amdgcn_sched_barrier(0);
    RH_STEP(q7, g + 7); RH_LOAD(q7, g + 15); __builtin_amdgcn_sched_barrier(0);
  }
#undef RH_LOAD
#undef RH_STEP
#undef CV4
}

DEV void rwkv_consumer(const Params& p, const Ctx& cx, int l, int task, int lane, const char* ring, int widx) {
  const int unit = task >> 4, d = unit & 1, h = (unit >> 1) & 15, b = unit >> 5;
  const int j = lane >> 4, s = lane & 15;
  const int myrow = (task & 15) * 4 + j;
  char* pO = (char*)((h16*)(p.ws + OFF_REG2) + (size_t)d * ARR + h * 64);
  const int sm = d ? 3 - (s & 3) : (s & 3);
  const unsigned vov0 = (unsigned)(sm * 2048 + myrow * 2);
  const unsigned rofs = (unsigned)(s * 8);
  const unsigned vrofs = (unsigned)(2560 + myrow * 2);
  LAS3 volatile int* pflag = (LAS3 volatile int*)(ring + RW_FLAGS);
  LAS3 volatile int* cflag = (LAS3 volatile int*)(ring + RW_FLAGS + 64) + widx;
  float S0 = 0.f, S1 = 0.f, S2 = 0.f, S3 = 0.f;
  int pseen = 0;
  struct GD { u2v w[4], kk[4], kka[4], kd[4], r[4]; unsigned v[4]; };
  GD A, B;
#define RC_WAIT(gq) { if (pseen <= (gq)) { do { pseen = __builtin_amdgcn_readfirstlane(*pflag); if (pseen <= (gq)) __builtin_amdgcn_s_sleep(1); } while (pseen <= (gq)); } asm volatile("" ::: "memory"); }
#define RC_LOAD(G, gq)                                                             \
  {                                                                                \
    const char* sl = ring + ((gq) % RW_NSLOT) * RW_SLOTB;                          \
    _Pragma("unroll") for (int u = 0; u < 4; ++u) {                                \
      G.w[u] = *(const u2v*)(sl + 0 * 512 + u * 128 + rofs);                       \
      G.kk[u] = *(const u2v*)(sl + 1 * 512 + u * 128 + rofs);                      \
      G.kka[u] = *(const u2v*)(sl + 2 * 512 + u * 128 + rofs);                     \
      G.kd[u] = *(const u2v*)(sl + 3 * 512 + u * 128 + rofs);                      \
      G.r[u] = *(const u2v*)(sl + 4 * 512 + u * 128 + rofs);                       \
      G.v[u] = *(const unsigned short*)(sl + u * 128 + vrofs);                     \
    }                                                                              \
  }
#define RC_COMP(G, gq)                                                             \
  {                                                                                \
    float dres[4];                                                                 \
    _Pragma("unroll") for (int u = 0; u < 4; ++u) {                                \
        \
        \
      float ea, eb, x_, y_, t0, t1, t2, t3;                                        \
      asm("v_fma_mix_f32 %6, %0, %12, 0 op_sel:[0,0,0] op_sel_hi:[0,1,0]\n\t"      \
          "v_fma_mix_f32 %7, %2, %13, 0 op_sel:[0,0,0] op_sel_hi:[0,1,0]\n\t"      \
          "v_fma_mix_f32 %6, %1, %12, %6 op_sel:[0,1,0] op_sel_hi:[0,1,0]\n\t"     \
          "v_fma_mix_f32 %7, %3, %13, %7 op_sel:[0,1,0] op_sel_hi:[0,1,0]\n\t"     \
          "v_fma_mix_f32 %8, %22, %16, 0 op_sel:[0,0,0] op_sel_hi:[1,1,0]\n\t"     \
          "v_add_f32 %6, %6, %7\n\t"                                               \
          "v_fma_mix_f32 %9, %22, %16, 0 op_sel:[0,1,0] op_sel_hi:[1,1,0]\n\t"     \
          "v_fma_mix_f32 %10, %22, %17, 0 op_sel:[0,0,0] op_sel_hi:[1,1,0]\n\t"    \
          "v_add_f32_dpp %6, %6, %6 quad_perm:[1,0,3,2] row_mask:0xf bank_mask:0xf bound_ctrl:1\n\t" \
          "v_fma_mix_f32 %11, %22, %17, 0 op_sel:[0,1,0] op_sel_hi:[1,1,0]\n\t"    \
          "v_fma_mix_f32 %0, %0, %14, %8 op_sel:[0,0,0] op_sel_hi:[0,1,0]\n\t"     \
          "v_add_f32_dpp %6, %6, %6 quad_perm:[2,3,0,1] row_mask:0xf bank_mask:0xf bound_ctrl:1\n\t" \
          "v_fma_mix_f32 %1, %1, %14, %9 op_sel:[0,1,0] op_sel_hi:[0,1,0]\n\t"     \
          "v_fma_mix_f32 %2, %2, %15, %10 op_sel:[0,0,0] op_sel_hi:[0,1,0]\n\t"    \
          "v_add_f32_dpp %6, %6, %6 row_half_mirror row_mask:0xf bank_mask:0xf bound_ctrl:1\n\t" \
          "v_fma_mix_f32 %3, %3, %15, %11 op_sel:[0,1,0] op_sel_hi:[0,1,0]\n\t"    \
          "s_nop 0\n\t"                                                            \
          "v_add_f32_dpp %6, %6, %6 row_mirror row_mask:0xf bank_mask:0xf bound_ctrl:1\n\t" \
          "v_fma_mix_f32 %0, -%6, %18, %0 op_sel:[0,0,0] op_sel_hi:[0,1,0]\n\t"    \
          "v_fma_mix_f32 %1, -%6, %18, %1 op_sel:[0,1,0] op_sel_hi:[0,1,0]\n\t"    \
          "v_fma_mix_f32 %2, -%6, %19, %2 op_sel:[0,0,0] op_sel_hi:[0,1,0]\n\t"    \
          "v_fma_mix_f32 %3, -%6, %19, %3 op_sel:[0,1,0] op_sel_hi:[0,1,0]\n\t"    \
          "v_fma_mix_f32 %4, %0, %20, 0 op_sel:[0,0,0] op_sel_hi:[0,1,0]\n\t"      \
          "v_fma_mix_f32 %5, %2, %21, 0 op_sel:[0,0,0] op_sel_hi:[0,1,0]\n\t"      \
          "v_fma_mix_f32 %4, %1, %20, %4 op_sel:[0,1,0] op_sel_hi:[0,1,0]\n\t"     \
          "v_fma_mix_f32 %5, %3, %21, %5 op_sel:[0,1,0] op_sel_hi:[0,1,0]"         \
          : "+v"(S0), "+v"(S1), "+v"(S2), "+v"(S3), "=&v"(ea), "=&v"(eb), "=&v"(x_), "=&v"(y_),                     \
            "=&v"(t0), "=&v"(t1), "=&v"(t2), "=&v"(t3)                                                              \
          : "v"(G.kk[u].x), "v"(G.kk[u].y), "v"(G.w[u].x), "v"(G.w[u].y), "v"(G.kd[u].x), "v"(G.kd[u].y),           \
            "v"(G.kka[u].x), "v"(G.kka[u].y), "v"(G.r[u].x), "v"(G.r[u].y), "v"(G.v[u]));                           \
      dres[u] = ea + eb;     \
    }                                                                              \
    asm volatile("" ::: "memory");                                                 \
    *cflag = (gq) + 1;     \
    {                                                                              \
      int rlo; RW_RLO(gq, rlo);                                                    \
      unsigned vov = vov0; asm volatile("" : "+v"(vov));                           \
        \
      const bool p1_ = (s & 1) != 0, p2_ = (s & 2) != 0;                           \
      const float a_ = (p1_ ? dres[1] : dres[0]) + dpp_mov<0xB1>(p1_ ? dres[0] : dres[1]); \
      const float b_ = (p1_ ? dres[3] : dres[2]) + dpp_mov<0xB1>(p1_ ? dres[2] : dres[3]); \
      float val = (p2_ ? b_ : a_) + dpp_mov<0x4E>(p2_ ? a_ : b_);                  \
      val += dpp_mov<0x124>(val);                                                  \
      val += dpp_mov<0x128>(val);                                                  \
      *(h16*)(pO + (size_t)rlo * 2048 + vov) = (h16)val;                           \
    }                                                                              \
  }
  RC_WAIT(0); RC_LOAD(A, 0);
#pragma unroll 1
  for (int g = 0; g < RW_NG; g += 2) {
    RC_WAIT(g + 1); RC_LOAD(B, g + 1);
    RC_COMP(A, g);
    if (g + 2 < RW_NG) { RC_WAIT(g + 2); RC_LOAD(A, g + 2); }
    RC_COMP(B, g + 1);
  }
#undef RC_WAIT
#undef RC_LOAD
#undef RC_COMP
}
#undef RW_RLO

DEV void phase_scan(const Params& p, const Ctx& cx, int l, char* smem) {
  const int lane = cx.tid & 63, wid = __builtin_amdgcn_readfirstlane(cx.tid >> 6);
  for (int slot = cx.bid; slot < 256; slot += cx.nblk) {
    __syncthreads();
    if (wid == 4 && lane < 8) *(LAS3 volatile int*)(smem + RW_FLAGS + (lane == 0 ? 0 : 64 + (lane & 3) * 4)) = 0;
    __syncthreads();
    const int unit = slot & 63;
#ifndef NO_RWKV
    if (wid < 4) { __builtin_amdgcn_s_setprio(3); rwkv_consumer(p, cx, l, (unit << 4) | ((slot >> 6) << 2) | wid, lane, smem, wid); __builtin_amdgcn_s_setprio(0); }
    else if (wid == 4) { __builtin_amdgcn_s_setprio(2); rwkv_helper(p, cx, l, unit, lane, smem); __builtin_amdgcn_s_setprio(0); }
#endif
  }
  if (wid >= 5) {
    char* wl = smem + 32768 + (wid - 5) * 17408;
    for (int u = cx.bid * 3 + (wid - 5); u < 2 * 32 * 65; u += cx.nblk * 3) {
      if (l == 1 && (u % 65) == 0) continue;
#ifndef NO_S5P3
      s5_pass3_unit(p, cx, l, u, wl, lane);
#endif
    }
  }
}

DEV void pool_item(const Params& p, const Ctx& cx, int l, int item, char* smem) {
  const int tid = cx.tid;
  const h16* zrest = (const h16*)(p.ws + OFF_ZREST);
  bf16_t* ym = (bf16_t*)(p.ws + OFF_YM);
  const char* wt = p.ws + OFF_WT + (size_t)l * WT_SIZE;
  float* V = (float*)smem;
  char* At = smem + 43008;
  int g, rowout0, Lseq, p0, rlo, rhi, rstride, rowsrc0;
  if (item < 2048) {
    g = item & 3; int r = (item >> 2) & 255, b = item >> 10;
    int w = 2 << g;
    rlo = max(r - w / 2, 0); rhi = min(r + w / 2 - 1, 255);
    rowsrc0 = b * 16384; rstride = 64;
    rowout0 = b * 16384 + r * 64; Lseq = 64; p0 = 0;
  } else {
    int it = item - 2048;
    g = it & 3; int tq = (it >> 2) & 3, b = it >> 4;
    rlo = 0; rhi = 0; rowsrc0 = NLAT + b * 256; rstride = 0;
    rowout0 = NLAT + b * 256 + tq * 64; Lseq = 256; p0 = tq * 64;
  }
  const int w = 2 << g;
  const float invr = 1.f / (float)(rhi - rlo + 1);
  for (int unit = tid; unit < 80 * 16; unit += NTHREADS) {
    int lp = unit >> 4, ch8 = unit & 15;
    int pos = p0 - 8 + lp;
    float acc[8] = {0, 0, 0, 0, 0, 0, 0, 0};
    if (pos >= 0 && pos < Lseq) {
      const h16* bp = zrest + (size_t)(rowsrc0 + pos) * ZR + 1024 + g * 128 + ch8 * 8;
      const int nr = rhi - rlo + 1;
      for (int k0 = 0; k0 < nr; k0 += 4) {
        h16x8 v[4]; float wv[4];
#pragma unroll
        for (int i = 0; i < 4; ++i) {
          const int kk_ = min(k0 + i, nr - 1);
          wv[i] = (k0 + i < nr) ? 1.f : 0.f;
          v[i] = *(const h16x8*)(bp + (size_t)((rlo + kk_) * rstride) * ZR);
        }
#pragma unroll
        for (int i = 0; i < 4; ++i)
#pragma unroll
          for (int j = 0; j < 8; ++j) acc[j] += wv[i] * (float)v[i][j];
      }
    }
    float* vp = V + lp * 132 + ch8 * 8;
#pragma unroll
    for (int j = 0; j < 8; ++j) vp[j] = acc[j] * invr;
  }
  __syncthreads();
  for (int unit = tid; unit < 64 * 16; unit += NTHREADS) {
    int c = unit >> 4, ch8 = unit & 15;
    int pos = p0 + c;
    int lo = max(pos - w / 2, 0), hi = min(pos + w / 2 - 1, Lseq - 1);
    float acc[8] = {0, 0, 0, 0, 0, 0, 0, 0};
    for (int pp = lo; pp <= hi; ++pp) {
      const float* vp = V + (pp - p0 + 8) * 132 + ch8 * 8;
#pragma unroll
      for (int j = 0; j < 8; ++j) acc[j] += vp[j];
    }
    float invc = 1.f / (float)(hi - lo + 1);
    h16x8 uc = *(const h16x8*)(zrest + (size_t)(rowout0 + c) * ZR + 1024 + g * 128 + ch8 * 8);
    uint4 o;
    o.x = pack_bf2(acc[0] * invc - (float)uc[0], acc[1] * invc - (float)uc[1]);
    o.y = pack_bf2(acc[2] * invc - (float)uc[2], acc[3] * invc - (float)uc[3]);
    o.z = pack_bf2(acc[4] * invc - (float)uc[4], acc[5] * invc - (float)uc[5]);
    o.w = pack_bf2(acc[6] * invc - (float)uc[6], acc[7] * invc - (float)uc[7]);
    *(uint4*)(At + c * 272 + ch8 * 16) = o;
  }
  __syncthreads();
  const bf16_t* Bt = (const bf16_t*)(wt + WT_POOL) + (size_t)g * 128 * 128;
  const float* ps = p.pool_scale + (size_t)l * 512 + g * 128;
  small_gemm<128, 1>(p, cx, At, 272, Bt, (tid >> 6) * 16, [&](int m, int n, f32x4 v) {
    int row = rowout0 + m;
    float4 sc = *(const float4*)(ps + n);
    h16x4 gt = *(const h16x4*)(zrest + (size_t)row * ZR + 1536 + g * 128 + n);
    uint2 o;
    o.x = pack_bf2(v[0] * sc.x * silu_f((float)gt[0]), v[1] * sc.y * silu_f((float)gt[1]));
    o.y = pack_bf2(v[2] * sc.z * silu_f((float)gt[2]), v[3] * sc.w * silu_f((float)gt[3]));
    *(uint2*)(ym + (size_t)row * D + 512 + g * 128 + n) = o;
  });
}

DEV void glu_item(const Params& p, const Ctx& cx, int l, int tile, char* smem) {
  const int tid = cx.tid;
  const int row0 = tile * 64;
  const float* S5Y = (const float*)(p.ws + OFF_S5Y);
  const h16* zrest = (const h16*)(p.ws + OFF_ZREST);
  bf16_t* ym = (bf16_t*)(p.ws + OFF_YM);
  const char* wt = p.ws + OFF_WT + (size_t)l * WT_SIZE;
#pragma unroll
  for (int it = 0; it < 8; ++it) {
    int unit = tid + it * NTHREADS;
    int r = unit >> 6, c8 = unit & 63;
    const float* sp = S5Y + (size_t)(row0 + r) * 512 + c8 * 8;
    float4 a = *(const float4*)sp, bq = *(const float4*)(sp + 4);
    uint4 o;
    o.x = pack_bf2(a.x, a.y); o.y = pack_bf2(a.z, a.w); o.z = pack_bf2(bq.x, bq.y); o.w = pack_bf2(bq.z, bq.w);
    *(uint4*)(smem + r * 1040 + c8 * 16) = o;
  }
  __syncthreads();
  const bf16_t* Bt = (const bf16_t*)(wt + WT_GLU);
  const float* bg = p.b_glu + (size_t)l * 512;
  small_gemm<512, 4>(p, cx, smem, 1040, Bt, (tid >> 6) * 64, [&](int m, int n, f32x4 v) {
    int row = row0 + m;
    float4 y = *(const float4*)(S5Y + (size_t)row * 512 + n);
    float4 bb = *(const float4*)(bg + n);
    h16x4 gt = *(const h16x4*)(zrest + (size_t)row * ZR + 512 + n);
    uint2 o;
    o.x = pack_bf2(y.x * sigmoid_f(v[0] + bb.x) * silu_f((float)gt[0]), y.y * sigmoid_f(v[1] + bb.y) * silu_f((float)gt[1]));
    o.y = pack_bf2(y.z * sigmoid_f(v[2] + bb.z) * silu_f((float)gt[2]), y.w * sigmoid_f(v[3] + bb.w) * silu_f((float)gt[3]));
    *(uint2*)(ym + (size_t)row * D + n) = o;
  });
}

DEV void rwkvmerge_item(const Params& p, const Ctx& cx, int l, int tile) {
  const int tid = cx.tid;
  const int row0 = tile * 64;
  const h16* SC = (const h16*)(p.ws + OFF_SCAN);
  const h16* O = (const h16*)(p.ws + OFF_REG2);
  const h16* zrest = (const h16*)(p.ws + OFF_ZREST);
  bf16_t* ym = (bf16_t*)(p.ws + OFF_YM);
  const int grp = tid & 7, h = (tid >> 3) & 15;
  const int c0 = h * 64 + grp * 8;
  float pk[8], rk[8], gw[8], gb[8];
#pragma unroll
  for (int j = 0; j < 8; j += 4) {
    float4 t0 = *(const float4*)(p.rwkv_k_a + (size_t)l * 1024 + c0 + j), t1 = *(const float4*)(p.rwkv_r_k + (size_t)l * 1024 + c0 + j);
    float4 t2 = *(const float4*)(p.gn_w + (size_t)l * 1024 + c0 + j), t3 = *(const float4*)(p.gn_b + (size_t)l * 1024 + c0 + j);
    pk[j] = t0.x; pk[j + 1] = t0.y; pk[j + 2] = t0.z; pk[j + 3] = t0.w;
    rk[j] = t1.x; rk[j + 1] = t1.y; rk[j + 2] = t1.z; rk[j + 3] = t1.w;
    gw[j] = t2.x; gw[j + 1] = t2.y; gw[j + 2] = t2.z; gw[j + 3] = t2.w;
    gb[j] = t3.x; gb[j + 1] = t3.y; gb[j + 2] = t3.z; gb[j + 3] = t3.w;
  }
#pragma unroll 2
  for (int it = 0; it < 16; ++it) {
    const int tok = (tid >> 7) + it * 4;
    int row = row0 + tok;
    size_t off = (size_t)row * 1024 + c0;
    h16x8 of = *(const h16x8*)(O + off), ob = *(const h16x8*)(O + ARR + off);
    h16x8 r8 = *(const h16x8*)(SC + 0 * ARR + off), k8 = *(const h16x8*)(SC + 1 * ARR + off), v8 = *(const h16x8*)(SC + 2 * ARR + off);
    h16x8 af = *(const h16x8*)(SC + 4 * ARR + off), ab = *(const h16x8*)(SC + 5 * ARR + off);
    h16x8 gt = *(const h16x8*)(zrest + (size_t)row * ZR + 2048 + c0);
    float o[8], sm = 0;
#pragma unroll
    for (int j = 0; j < 8; ++j) { o[j] = (float)of[j] + (float)ob[j]; sm += o[j]; }
    sm = allreduce8(sm);
    float mu = sm * (1.f / 64.f), vq = 0;
#pragma unroll
    for (int j = 0; j < 8; ++j) { o[j] -= mu; vq += o[j] * o[j]; }
    vq = allreduce8(vq);
    float rstd = rsqrtf(vq * (1.f / 64.f) + 64e-5f);
    float part = 0;
#pragma unroll
    for (int j = 0; j < 8; ++j) {
      float ksum = (float)k8[j] * (2.f + ((float)af[j] + (float)ab[j] - 2.f) * pk[j]);
      part += (float)r8[j] * ksum * rk[j];
    }
    part = allreduce8(part);
    float res[8];
#pragma unroll
    for (int j = 0; j < 8; ++j) {
      float y = o[j] * rstd * gw[j] + gb[j] + part * (float)v8[j];
      res[j] = y * silu_f((float)gt[j]);
    }
    uint4 ov;
    ov.x = pack_bf2(res[0], res[1]); ov.y = pack_bf2(res[2], res[3]); ov.z = pack_bf2(res[4], res[5]); ov.w = pack_bf2(res[6], res[7]);
    *(uint4*)(ym + (size_t)row * D + 1024 + c0) = ov;
  }
}

DEV void phase_merge(const Params& p, const Ctx& cx0, int l, char* smem) {
  const int ntile = (l == 0) ? 520 : 512;
  const int npool = (l == 0) ? 2048 + 32 : 2048;
  const int total = npool + 2 * ntile;
  for (int item = cx0.bid; item < total; item += cx0.nblk) {
    __syncthreads();
    Ctx cx = cx0; asm volatile("" : "+v"(cx.tid));
    if (item < npool) pool_item(p, cx, l, item, smem);
    else if (item < npool + ntile) glu_item(p, cx, l, item - npool, smem);
    else rwkvmerge_item(p, cx, l, item - npool - ntile);
  }
}

#define LCX Ctx c2 = cx; asm volatile("" : "+v"(c2.tid))
#ifndef GEMM_FN
#define GEMM_FN gemm_phase2
#endif
__global__ void __launch_bounds__(NTHREADS) mega_fwd(Params p, int ph0, int ph1) {
  extern __shared__ __attribute__((aligned(16))) char smem[];
  cg::grid_group grid = cg::this_grid();
  const int wave_s = __builtin_amdgcn_readfirstlane((int)(threadIdx.x >> 6));
  for (int step = ph0; step < ph1; ++step) {
    if (step > ph0) grid.sync();
    const int ph = (int)((PH_SEQ >> (4 * step)) & 15ull);
    Ctx cx;
    {
      int t_, b_ = blockIdx.x, n_ = gridDim.x;
      asm volatile("v_mbcnt_lo_u32_b32 %0, -1, 0\n\tv_mbcnt_hi_u32_b32 %0, -1, %0\n\tv_lshl_add_u32 %0, %1, 6, %0" : "=&v"(t_) : "s"(wave_s));
      asm volatile("" : "+s"(b_), "+s"(n_));
      cx.tid = t_; cx.bid = b_; cx.nblk = n_;
    }
    const int l = ph >= 8 ? 1 : 0;
    const int lp = ph >= 8 ? ph - 6 : ph;
#ifndef PHMASK
#define PHMASK 0xff
#endif
    if (ph == 0) { if (PHMASK & 1) { LCX; phase0(p, c2, smem); } }
    else if (ph == 1) { if (PHMASK & 2) { LCX; phase_adaln0(p, c2); } }
    else if (lp == 2 && (PHMASK & 4)) {
      LCX;
      h16* zrest = (h16*)(p.ws + OFF_ZREST);
      h16* zc = (h16*)(p.ws + OFF_REG2);
      GEMM_FN(p, c2, (const bf16_t*)(p.ws + OFF_H), (const bf16_t*)(p.ws + OFF_WT + (size_t)l * WT_SIZE + WT_IN), 2048, 130, 25, smem,
                 [&](int row, int col, f32x4 v, f32x4 u) {
                   h16* dst;
                   if (col < 2048) dst = zrest + (size_t)row * ZR + col;
                   else if (col < 5120) dst = zc + (size_t)row * ZC + (col - 2048);
                   else if (col < 6144) dst = zrest + (size_t)row * ZR + 2048 + (col - 5120);
                   else dst = zc + (size_t)row * ZC + 3072 + (col - 6144);
                   h16x8 o = {(h16)v[0], (h16)v[1], (h16)v[2], (h16)v[3], (h16)u[0], (h16)u[1], (h16)u[2], (h16)u[3]};
                   *(h16x8*)dst = o;
                 });
    } else if (lp == 3) { if (PHMASK & 8) { LCX; phase_prep(p, c2, l, smem); } }
    else if (lp == 4) { if (PHMASK & 16) { LCX; phase_scan(p, c2, l, smem); } }
    else if (lp == 5) { if (PHMASK & 32) { LCX; phase_merge(p, c2, l, smem); } }
    else if (lp == 6 && (PHMASK & 64)) {
      LCX;
      const float* mods = (const float*)(p.ws + OFF_MODS);
      float* prec = (float*)(p.ws + OFF_PREC);
      const float* xin = (l == 0) ? p.x : p.out;
      GEMM_FN(p, c2, (const bf16_t*)(p.ws + OFF_YM), (const bf16_t*)(p.ws + OFF_WT + (size_t)l * WT_SIZE + WT_OUT), 2048, l == 0 ? 130 : 128, 8, smem,
                 [&](int row, int col, f32x4 v, f32x4 u) {
                   const float* xr; const float* gr; float* dr;
                   if (row < NLAT) {
                     xr = xin + (size_t)row * D + col; gr = mods + (size_t)(l * 3 + (row >> 14)) * 6144 + 4096 + col; dr = p.out + (size_t)row * D + col;
                   } else {
                     xr = p.ctx + (size_t)(row - NLAT) * D + col; gr = mods + (size_t)(l * 3 + 2) * 6144 + 4096 + col; dr = prec + (size_t)(row - NLAT) * D + col;
                   }
                   const float4 x0 = *(const float4*)xr, x1 = *(const float4*)(xr + 4), g0 = *(const float4*)gr, g1 = *(const float4*)(gr + 4);
                   float4 r0, r1;
                   r0.x = ALPHA * x0.x + g0.x * v[0]; r0.y = ALPHA * x0.y + g0.y * v[1]; r0.z = ALPHA * x0.z + g0.z * v[2]; r0.w = ALPHA * x0.w + g0.w * v[3];
                   r1.x = ALPHA * x1.x + g1.x * u[0]; r1.y = ALPHA * x1.y + g1.y * u[1]; r1.z = ALPHA * x1.z + g1.z * u[2]; r1.w = ALPHA * x1.w + g1.w * u[3];
                   *(float4*)dr = r0; *(float4*)(dr + 4) = r1;
                 });
    } else if (lp == 7) { if (PHMASK & 128) { LCX; phase_finln(p, c2, l); } }
  }
}

constexpr int NPHASES = PH_NSTEPS;

extern "C" void kernel_launch(void* const* d_in, const int* in_sizes, int n_in, void* d_out, int out_size, void* d_ws, size_t ws_size,
                              hipStream_t stream) {
  static int grid_blocks = 0;
  if (grid_blocks == 0) {
    if (n_in != 32 || ws_size < WS_END) { fprintf(stderr, "kernel_launch: unexpected n_in %d / ws %zu (need %zu)\n", n_in, ws_size, (size_t)WS_END); grid_blocks = -1; return; }
    int dev = 0, cus = 0, per_cu = 0;
    hipGetDevice(&dev);
    hipDeviceGetAttribute(&cus, hipDeviceAttributeMultiprocessorCount, dev);
    if (hipFuncSetAttribute((const void*)mega_fwd, hipFuncAttributeMaxDynamicSharedMemorySize, LDS_BYTES) != hipSuccess) { fprintf(stderr, "hipFuncSetAttribute failed\n"); grid_blocks = -1; return; }
    if (hipOccupancyMaxActiveBlocksPerMultiprocessor(&per_cu, (const void*)mega_fwd, NTHREADS, LDS_BYTES) != hipSuccess || per_cu < 1) {
      fprintf(stderr, "occupancy query gave %d\n", per_cu); (void)hipGetLastError(); per_cu = 1;
    }
    grid_blocks = cus * per_cu;
  }
  if (grid_blocks < 0) return;
  Params p{};
  const float** pp = (const float**)&p;
  for (int i = 0; i < 32; ++i) pp[i] = (const float*)d_in[i];
  p.out = (float*)d_out;
  p.ws = (char*)d_ws;
  int ph0 = 0, ph1 = NPHASES;
  void* args[] = {&p, &ph0, &ph1};
  hipError_t e = hipLaunchCooperativeKernel((const void*)mega_fwd, dim3(grid_blocks), dim3(NTHREADS), args, LDS_BYTES, stream);
  if (e != hipSuccess) fprintf(stderr, "cooperative launch failed: %s (grid %d)\n", hipGetErrorString(e), grid_blocks);
}
```

```cpp
#include <hip/hip_runtime.h>
#include <hip/hip_cooperative_groups.h>
#include <cstdio>
namespace cg = cooperative_groups;

typedef unsigned short bf16_t;
typedef _Float16 h16;
using bf16x8 = __attribute__((ext_vector_type(8))) _Float16;
using f32x4 = __attribute__((ext_vector_type(4))) float;
using h16x4 = __attribute__((ext_vector_type(4))) _Float16;
using h16x8 = __attribute__((ext_vector_type(8))) _Float16;

#define DEV __device__ __forceinline__

constexpr int D = 2048, NLAT = 32768, MTOT = 33280, ZR = 3072, ZC = 3328;
constexpr int NTHREADS = 512;
constexpr int LDS_BYTES = 147456;
constexpr float ALPHA = 1.41421356237f;
constexpr float DECAY_SCALE = 0.606531f;

constexpr size_t al256(size_t x) { return (x + 255) & ~size_t(255); }
constexpr size_t ARR = (size_t)MTOT * 1024;
constexpr size_t OFF_MODS = 0;
constexpr size_t OFF_S5F = al256(OFF_MODS + 2 * 3 * 6144 * 4);
constexpr size_t OFF_PREC = al256(OFF_S5F + (size_t)2 * 32 * 65 * 2 * 64 * 8);
constexpr size_t OFF_WT = al256(OFF_PREC + (size_t)512 * 2048 * 4);
constexpr size_t WT_IN = 0, WT_OUT = 26214400, WT_W2 = 34603008, WT_A2 = 34865152, WT_POOL = 35127296, WT_GLU = 35258368, WT_SIZE = 35782656;
constexpr size_t OFF_ZREST = al256(OFF_WT + 2 * WT_SIZE);
constexpr size_t OFF_REG2 = al256(OFF_ZREST + (size_t)MTOT * ZR * 2);
constexpr size_t OFF_S5Y = OFF_REG2 + 2 * ARR * 2;
constexpr size_t OFF_SCAN = al256(OFF_REG2 + (size_t)MTOT * ZC * 2);
constexpr size_t OFF_H = OFF_SCAN;
constexpr size_t OFF_YM = OFF_SCAN + 6 * ARR * 2;
constexpr size_t WS_END = OFF_SCAN + 8 * ARR * 2;

#ifndef PH_SEQ
#define PH_SEQ 0xDCBA9876543210ull
#define PH_NSTEPS 14
#endif
struct Params {
  const float *x, *c, *ctx, *c_ctx, *w_ada, *b_ada, *w_in, *conv_rkv, *s5_lam_re, *s5_lam_im, *s5_log_step,
      *s5_b_re, *s5_b_im, *s5_c_re, *s5_c_im, *s5_d, *w_glu, *b_glu, *w_pool, *pool_scale,
      *rwkv_w0, *rwkv_w2, *rwkv_a0, *rwkv_a2, *rwkv_k_k, *rwkv_k_a, *rwkv_r_k, *gn_w, *gn_b,
      *w_out, *ln_g, *ln_b;
  float* out;
  char* ws;
};
struct Ctx { int tid, bid, nblk; };

DEV float rcp_f(float x) { return __builtin_amdgcn_rcpf(x); }
DEV float sigmoid_f(float x) { return rcp_f(1.f + __expf(-x)); }
DEV float silu_f(float x) { return x * rcp_f(1.f + __expf(-x)); }
DEV float tanh_f(float x) { float e = __expf(2.f * x); return 1.f - 2.f * rcp_f(e + 1.f); }
DEV float gelu_f(float y) { return 0.5f * y * (1.f + tanh_f(0.7978845608f * (y + 0.044715f * y * y * y))); }
using h16x2 = __attribute__((ext_vector_type(2))) _Float16;
DEV unsigned pack_bf2(float a, float b) { h16x2 v = {(h16)a, (h16)b}; return __builtin_bit_cast(unsigned, v); }
template <int CTRL> DEV float dpp_mov(float v) {
  return __int_as_float(__builtin_amdgcn_update_dpp(0, __float_as_int(v), CTRL, 0xf, 0xf, true));
}
DEV float allreduce16(float v) {
  v += dpp_mov<0xB1>(v);
  v += dpp_mov<0x4E>(v);
  v += dpp_mov<0x141>(v);
  v += dpp_mov<0x140>(v);
  return v;
}
DEV float wave_sum(float v) {
  v = allreduce16(v);
  return __builtin_amdgcn_readlane(__float_as_int(v), 0) == 0 && false ? 0.f :
         __int_as_float(__builtin_amdgcn_readlane(__float_as_int(v), 0)) + __int_as_float(__builtin_amdgcn_readlane(__float_as_int(v), 16)) +
         __int_as_float(__builtin_amdgcn_readlane(__float_as_int(v), 32)) + __int_as_float(__builtin_amdgcn_readlane(__float_as_int(v), 48));
}
DEV float allreduce8(float v) {
  v += dpp_mov<0xB1>(v);
  v += dpp_mov<0x4E>(v);
  v += dpp_mov<0x141>(v);
  return v;
}
DEV void lds_fence() { asm volatile("s_waitcnt lgkmcnt(0)" ::: "memory"); }

DEV void p0_mods_item(const Params& p, const Ctx& cx, int item, char* smem) {
  float* red = (float*)smem;
  float* mods = (float*)(p.ws + OFF_MODS);
  int l = item / 96, chunk = item % 96;
  int tid = cx.tid, kq = tid >> 6, col = tid & 63;
  int n = chunk * 64 + col;
  const float* W = p.w_ada + (size_t)l * 2048 * 6144;
  float a0 = 0, a1 = 0, a2 = 0;
#pragma unroll 8
  for (int k = kq; k < 2048; k += 8) {
    float w = W[(size_t)k * 6144 + n];
    a0 += silu_f(p.c[k]) * w;
    a1 += silu_f(p.c[2048 + k]) * w;
    a2 += silu_f(p.c_ctx[k]) * w;
  }
  red[(kq * 3 + 0) * 64 + col] = a0;
  red[(kq * 3 + 1) * 64 + col] = a1;
  red[(kq * 3 + 2) * 64 + col] = a2;
  __syncthreads();
  if (tid < 192) {
    int r = tid >> 6, cc = tid & 63;
    float s = 0;
#pragma unroll
    for (int q = 0; q < 8; ++q) s += red[(q * 3 + r) * 64 + cc];
    mods[(size_t)(l * 3 + r) * 6144 + chunk * 64 + cc] = s + p.b_ada[(size_t)l * 6144 + chunk * 64 + cc];
  }
}

DEV void p0_transpose_tile(const Params& p, const Ctx& cx, const float* __restrict__ src, bf16_t* __restrict__ dst, int K, int N, int tk, int tn, char* smem) {
  float* T = (float*)smem;
  int tid = cx.tid;
  int k0 = tk * 64, n0 = tn * 64;
  int kk = tid >> 4, n4 = tid & 15;
#pragma unroll
  for (int i = 0; i < 2; ++i) {
    int k = kk + 32 * i;
    float4 v = *(const float4*)(src + (size_t)(k0 + k) * N + n0 + n4 * 4);
    T[k * 65 + n4 * 4 + 0] = v.x; T[k * 65 + n4 * 4 + 1] = v.y; T[k * 65 + n4 * 4 + 2] = v.z; T[k * 65 + n4 * 4 + 3] = v.w;
  }
  __syncthreads();
  int n = tid >> 3, k8 = tid & 7;
  uint4 o;
  o.x = pack_bf2(T[(k8 * 8 + 0) * 65 + n], T[(k8 * 8 + 1) * 65 + n]);
  o.y = pack_bf2(T[(k8 * 8 + 2) * 65 + n], T[(k8 * 8 + 3) * 65 + n]);
  o.z = pack_bf2(T[(k8 * 8 + 4) * 65 + n], T[(k8 * 8 + 5) * 65 + n]);
  o.w = pack_bf2(T[(k8 * 8 + 6) * 65 + n], T[(k8 * 8 + 7) * 65 + n]);
  *(uint4*)(dst + (size_t)(n0 + n) * K + k0 + k8 * 8) = o;
}

DEV void phase0(const Params& p, const Ctx& cx0, char* smem) {
  const int NTR = 4368;
  const int total = 192 + 2 * NTR;
  for (int item = cx0.bid; item < total; item += cx0.nblk) {
    __syncthreads();
    Ctx cx = cx0; asm volatile("" : "+v"(cx.tid));
    if (item < 192) { p0_mods_item(p, cx, item, smem); continue; }
    int it = item - 192;
    int l = it / NTR, i = it % NTR;
    char* wt = p.ws + OFF_WT + (size_t)l * WT_SIZE;
    if (i < 3200) {
      p0_transpose_tile(p, cx, p.w_in + (size_t)l * 2048 * 6400, (bf16_t*)(wt + WT_IN), 2048, 6400, i / 100, i % 100, smem);
    } else if (i < 4224) {
      int j = i - 3200;
      p0_transpose_tile(p, cx, p.w_out + (size_t)l * 2048 * 2048, (bf16_t*)(wt + WT_OUT), 2048, 2048, j / 32, j % 32, smem);
    } else if (i < 4256) {
      int j = i - 4224, d = j / 16;
      p0_transpose_tile(p, cx, p.rwkv_w2 + (size_t)(l * 2 + d) * 64 * 1024, (bf16_t*)(wt + WT_W2) + (size_t)d * 1024 * 64, 64, 1024, 0, j % 16, smem);
    } else if (i < 4288) {
      int j = i - 4256, d = j / 16;
      p0_transpose_tile(p, cx, p.rwkv_a2 + (size_t)(l * 2 + d) * 64 * 1024, (bf16_t*)(wt + WT_A2) + (size_t)d * 1024 * 64, 64, 1024, 0, j % 16, smem);
    } else if (i < 4304) {
      int j = i - 4288, g = j / 4;
      p0_transpose_tile(p, cx, p.w_pool + (size_t)(l * 4 + g) * 128 * 128, (bf16_t*)(wt + WT_POOL) + (size_t)g * 128 * 128, 128, 128, (j % 4) / 2, j % 2, smem);
    } else {
      int j = i - 4304;
      p0_transpose_tile(p, cx, p.w_glu + (size_t)l * 512 * 512, (bf16_t*)(wt + WT_GLU), 512, 512, j / 8, j % 8, smem);
    }
  }
}

DEV void phase_adaln0(const Params& p, const Ctx& cx) {
  const float* mods = (const float*)(p.ws + OFF_MODS);
  bf16_t* hbuf = (bf16_t*)(p.ws + OFF_H);
  int lane = cx.tid & 63;
  int gw = cx.bid * 8 + (cx.tid >> 6), nw = cx.nblk * 8;
  for (int row = gw; row < MTOT; row += nw) {
    const float* src = row < NLAT ? p.x + (size_t)row * D : p.ctx + (size_t)(row - NLAT) * D;
    int mr = row < NLAT ? (row >> 14) : 2;
    const float* md = mods + (size_t)mr * 6144;
    float4 v[8];
    float s = 0;
#pragma unroll
    for (int i = 0; i < 8; ++i) { v[i] = *(const float4*)(src + i * 256 + lane * 4); s += v[i].x + v[i].y + v[i].z + v[i].w; }
    float mu = wave_sum(s) * (1.f / 2048.f);
    float q = 0;
#pragma unroll
    for (int i = 0; i < 8; ++i) { v[i].x -= mu; v[i].y -= mu; v[i].z -= mu; v[i].w -= mu; q += v[i].x * v[i].x + v[i].y * v[i].y + v[i].z * v[i].z + v[i].w * v[i].w; }
    float rstd = rsqrtf(wave_sum(q) * (1.f / 2048.f) + 1e-6f);
#pragma unroll
    for (int i = 0; i < 8; ++i) {
      int col = i * 256 + lane * 4;
      float4 sh = *(const float4*)(md + col), sc = *(const float4*)(md + 2048 + col);
      uint2 o;
      o.x = pack_bf2(v[i].x * rstd * (1.f + sc.x) + sh.x, v[i].y * rstd * (1.f + sc.y) + sh.y);
      o.y = pack_bf2(v[i].z * rstd * (1.f + sc.z) + sh.z, v[i].w * rstd * (1.f + sc.w) + sh.w);
      *(uint2*)(hbuf + (size_t)row * D + col) = o;
    }
  }
}

DEV void phase_finln(const Params& p, const Ctx& cx, int l) {
  const float* mods = (const float*)(p.ws + OFF_MODS);
  bf16_t* hbuf = (bf16_t*)(p.ws + OFF_H);
  float* prec = (float*)(p.ws + OFF_PREC);
  int lane = cx.tid & 63;
  int gw = cx.bid * 8 + (cx.tid >> 6), nw = cx.nblk * 8;
  const int nrows = (l == 0) ? MTOT : NLAT;
  for (int row = gw; row < nrows; row += nw) {
    float* src = row < NLAT ? p.out + (size_t)row * D : prec + (size_t)(row - NLAT) * D;
    float4 v[8];
    float s = 0;
#pragma unroll
    for (int i = 0; i < 8; ++i) { v[i] = *(const float4*)(src + i * 256 + lane * 4); s += v[i].x + v[i].y + v[i].z + v[i].w; }
    float mu = wave_sum(s) * (1.f / 2048.f);
    float q = 0;
#pragma unroll
    for (int i = 0; i < 8; ++i) { v[i].x -= mu; v[i].y -= mu; v[i].z -= mu; v[i].w -= mu; q += v[i].x * v[i].x + v[i].y * v[i].y + v[i].z * v[i].z + v[i].w * v[i].w; }
    float rstd = rsqrtf(wave_sum(q) * (1.f / 2048.f) + 1e-5f);
    float s2 = 0;
#pragma unroll
    for (int i = 0; i < 8; ++i) {
      int col = i * 256 + lane * 4;
      float4 g = *(const float4*)(p.ln_g + (size_t)l * D + col), b = *(const float4*)(p.ln_b + (size_t)l * D + col);
      v[i].x = v[i].x * rstd * g.x + b.x; v[i].y = v[i].y * rstd * g.y + b.y; v[i].z = v[i].z * rstd * g.z + b.z; v[i].w = v[i].w * rstd * g.w + b.w;
      if (row < NLAT) *(float4*)(src + col) = v[i];
      s2 += v[i].x + v[i].y + v[i].z + v[i].w;
    }
    if (l == 0) {
      int mr = row < NLAT ? (row >> 14) : 2;
      const float* md = mods + (size_t)(3 + mr) * 6144;
      float mu2 = wave_sum(s2) * (1.f / 2048.f);
      float q2 = 0;
#pragma unroll
      for (int i = 0; i < 8; ++i) { v[i].x -= mu2; v[i].y -= mu2; v[i].z -= mu2; v[i].w -= mu2; q2 += v[i].x * v[i].x + v[i].y * v[i].y + v[i].z * v[i].z + v[i].w * v[i].w; }
      float rstd2 = rsqrtf(wave_sum(q2) * (1.f / 2048.f) + 1e-6f);
#pragma unroll
      for (int i = 0; i < 8; ++i) {
        int col = i * 256 + lane * 4;
        float4 sh = *(const float4*)(md + col), sc = *(const float4*)(md + 2048 + col);
        uint2 o;
        o.x = pack_bf2(v[i].x * rstd2 * (1.f + sc.x) + sh.x, v[i].y * rstd2 * (1.f + sc.y) + sh.y);
        o.y = pack_bf2(v[i].z * rstd2 * (1.f + sc.z) + sh.z, v[i].w * rstd2 * (1.f + sc.w) + sh.w);
        *(uint2*)(hbuf + (size_t)row * D + col) = o;
      }
    }
  }
}

template <class Epi>
DEV void gemm_phase(const Params& p, const Ctx& cx, const bf16_t* __restrict__ A, const bf16_t* __restrict__ Bt, int K, int nM, int nN, char* smem, Epi epi) {
  const int tid = cx.tid, lane = tid & 63, wid = tid >> 6;
  const int wr = wid >> 2, wc = wid & 3, fr = lane & 15, fq = lane >> 4;
  const int nt = K / 64;
  const int ntiles = nM * nN;
  const int srow = tid >> 3, sc16 = tid & 7;
  const int nxcd = (cx.nblk & 7) == 0 ? 8 : 1;
  const int xcd = cx.bid % nxcd, xidx = cx.bid / nxcd, xper = cx.nblk / nxcd;
  const int t_lo = (int)(((long)ntiles * xcd) / nxcd), t_hi = (int)(((long)ntiles * (xcd + 1)) / nxcd);
  for (int tt = t_lo + xidx; tt < t_hi; tt += xper) {
    const int band = tt / (16 * nN);
    const int brows = min(16, nM - band * 16);
    const int rem = tt - band * 16 * nN;
    const int pn = rem / brows, pm = band * 16 + rem % brows;
    const int brow = pm * 256, bcol = pn * 256;
    const char* Ab = (const char*)(A + (size_t)brow * K);
    const char* Bb = (const char*)(Bt + (size_t)bcol * K);
    const unsigned voff = (unsigned)(srow * K + sc16 * 8) * 2u;
    const size_t rs = (size_t)64 * K * 2;
    f32x4 acc[8][4];
#pragma unroll
    for (int i = 0; i < 8; ++i)
#pragma unroll
      for (int j = 0; j < 4; ++j) acc[i][j] = f32x4{0.f, 0.f, 0.f, 0.f};
    uint4 ra0, ra1, ra2, ra3, rb0, rb1, rb2, rb3;
#define G_LD(ko) { const char* a_ = Ab + (size_t)(ko) * 2; const char* b_ = Bb + (size_t)(ko) * 2; \
                 ra0 = *(const uint4*)(a_ + voff); ra1 = *(const uint4*)(a_ + rs + voff); ra2 = *(const uint4*)(a_ + 2 * rs + voff); ra3 = *(const uint4*)(a_ + 3 * rs + voff); \
                 rb0 = *(const uint4*)(b_ + voff); rb1 = *(const uint4*)(b_ + rs + voff); rb2 = *(const uint4*)(b_ + 2 * rs + voff); rb3 = *(const uint4*)(b_ + 3 * rs + voff); }
#define G_ST(sp) { *(uint4*)(sp) = ra0; *(uint4*)((sp) + 64 * 144) = ra1; *(uint4*)((sp) + 128 * 144) = ra2; *(uint4*)((sp) + 192 * 144) = ra3; \
                 *(uint4*)((sp) + 36864) = rb0; *(uint4*)((sp) + 36864 + 64 * 144) = rb1; *(uint4*)((sp) + 36864 + 128 * 144) = rb2; *(uint4*)((sp) + 36864 + 192 * 144) = rb3; }
    char* const sbase = smem + srow * 144 + sc16 * 16;
    G_LD(0);
    G_ST(sbase);
    if (nt > 1) G_LD(64);
    for (int kt = 0; kt < nt; ++kt) {
      __syncthreads();
      if (kt + 1 < nt) { char* s1 = sbase + ((kt + 1) & 1) * 73728; G_ST(s1); }
      if (kt + 2 < nt) G_LD((kt + 2) * 64);
      const char* As = smem + (kt & 1) * 73728;
      const char* Bs = As + 36864;
#pragma unroll
      for (int kh = 0; kh < 2; ++kh) {
        bf16x8 bfr[4];
#pragma unroll
        for (int jn = 0; jn < 4; ++jn) bfr[jn] = *(const bf16x8*)(Bs + (wc * 64 + jn * 16 + fr) * 144 + kh * 64 + fq * 16);
#pragma unroll
        for (int i = 0; i < 8; ++i) {
          bf16x8 af = *(const bf16x8*)(As + (wr * 128 + i * 16 + fr) * 144 + kh * 64 + fq * 16);
#pragma unroll
          for (int jn = 0; jn < 4; ++jn) acc[i][jn] = __builtin_amdgcn_mfma_f32_16x16x32_f16(bfr[jn], af, acc[i][jn], 0, 0, 0);
        }
      }
    }
    __syncthreads();
#pragma unroll
    for (int i = 0; i < 8; ++i)
#pragma unroll
      for (int jn = 0; jn < 4; ++jn) epi(brow + wr * 128 + i * 16 + fr, bcol + wc * 64 + jn * 16 + fq * 4, acc[i][jn]);
  }
}

#define LAS3 __attribute__((address_space(3)))
DEV int g2_lds_byte(int r, int c) { const int st = (r >> 4) * 2 + (c >> 5), rr = r & 15, cc = c & 31, ob = rr * 64 + cc * 2; return st * 1024 + (ob ^ (((ob >> 9) & 1) << 5)); }
DEV void g2_stage_rc(int b, int& R, int& C) { const int st = b / 1024, sb = b % 1024, swz = sb ^ (((sb >> 9) & 1) << 5); R = (st >> 1) * 16 + swz / 64; C = (st & 1) * 32 + (swz % 64) / 2; }

template <class Epi>
DEV void gemm_phase2(const Params& p, const Ctx& cx, const bf16_t* __restrict__ A, const bf16_t* __restrict__ Bt, int K, int nM, int nN, char* smem, Epi epi) {
  constexpr int HTB = 128 * 64 * 2;
  LAS3 unsigned char* lds = (LAS3 unsigned char*)smem;
  const int tid = cx.tid, wid = __builtin_amdgcn_readfirstlane(tid >> 6), lane = tid & 63, wr = wid >> 2, wc = wid & 3, fr = lane & 15, fq = lane >> 4;
  const int nt = K / 64;
  const int ntiles = nM * nN;
  const int nxcd = (cx.nblk & 7) == 0 ? 8 : 1;
  const int xcd = cx.bid % nxcd, xidx = cx.bid / nxcd, xper = cx.nblk / nxcd;
  const int t_lo = (int)(((long)ntiles * xcd) / nxcd), t_hi = (int)(((long)ntiles * (xcd + 1)) / nxcd);
  auto unit_at = [&](int i, int& pm, int& pn) -> bool {
    const int tt = t_lo + xidx + i * xper;
    if (tt >= t_hi) return false;
    const int band = tt / (8 * nN);
    const int brows = min(8, nM - band * 8);
    const int rem = tt - band * 8 * nN;
    pn = rem / brows; pm = band * 8 + rem % brows;
    return true;
  };
  unsigned voffA[2], voffB[2];
#pragma unroll
  for (int i = 0; i < 2; ++i) {
    int R, C; g2_stage_rc(tid * 16 + i * 8192, R, C);
    const int rho = R & 31, Rb = (R & ~31) + 8 * ((rho & 15) >> 2) + 4 * (rho >> 4) + (rho & 3);
    voffA[i] = (unsigned)(R * K + C) * 2u; voffB[i] = (unsigned)(Rb * K + C) * 2u;
  }
  const size_t kstep = (size_t)(64 * 2);
  const size_t hstep = (size_t)128 * K * 2;
  const size_t tstep = 2 * hstep;
  const unsigned ldsw = (unsigned)wid * 1024u;
  const int aoff = g2_lds_byte(wr * 64 + fr, fq * 8), boff = g2_lds_byte(wc * 32 + fr, fq * 8);
#define G2_SA(b, h) (((b) * 2 + (h)) * HTB)
#define G2_SB(b, h) ((4 + (b) * 2 + (h)) * HTB)
#define G2_STAGE_(bufoff, gbase, vo_) do { _Pragma("unroll") for (int _i = 0; _i < 2; ++_i) \
    __builtin_amdgcn_global_load_lds((const unsigned*)((const char*)(gbase) + vo_[_i]), (LAS3 unsigned*)(lds + (bufoff) + ldsw + _i * 8192), 16, 0, 0); } while (0)
#define G2_STAGE(bufoff, gbase) G2_STAGE_(bufoff, gbase, voffA)
#define G2_STAGEB(bufoff, gbase) G2_STAGE_(bufoff, gbase, voffB)
#define G2_LDA(dst, b, h) do { _Pragma("unroll") for (int m = 0; m < 4; ++m) _Pragma("unroll") for (int k = 0; k < 2; ++k) dst[m][k] = *(const LAS3 bf16x8*)(lds + G2_SA(b, h) + aoff + m * 2048 + k * 1024); } while (0)
#define G2_LDB(dst, b, h) do { _Pragma("unroll") for (int n = 0; n < 2; ++n) _Pragma("unroll") for (int k = 0; k < 2; ++k) dst[n][k] = *(const LAS3 bf16x8*)(lds + G2_SB(b, h) + boff + n * 2048 + k * 1024); } while (0)
#define G2_MMA(ai, bj, At_, Bt_) do { __builtin_amdgcn_s_setprio(1); _Pragma("unroll") for (int m = 0; m < 4; ++m) _Pragma("unroll") for (int n = 0; n < 2; ++n) _Pragma("unroll") for (int k = 0; k < 2; ++k) \
    acc[ai][bj][m][n] = __builtin_amdgcn_mfma_f32_16x16x32_f16(Bt_[n][k], At_[m][k], acc[ai][bj][m][n], 0, 0, 0); __builtin_amdgcn_s_setprio(0); } while (0)
#define G2_WAIT_V(n) asm volatile("s_waitcnt vmcnt(" #n ")" ::: "memory")
#define G2_WAIT_L(n) asm volatile("s_waitcnt lgkmcnt(" #n ")" ::: "memory")
#define G2_BAR __builtin_amdgcn_s_barrier()
#define G2_SCHED __builtin_amdgcn_sched_barrier(0)
  int cpm, cpn, npm = 0, npn = 0, ui = 0;
  if (!unit_at(0, cpm, cpn)) return;
  f32x4 acc[2][2][4][2];
#pragma unroll
  for (int a = 0; a < 2; ++a)
#pragma unroll
    for (int b = 0; b < 2; ++b)
#pragma unroll
      for (int m = 0; m < 4; ++m)
#pragma unroll
        for (int n = 0; n < 2; ++n) acc[a][b][m][n] = f32x4{0.f, 0.f, 0.f, 0.f};
  bf16x8 At[4][2], B0[2][2], B1[2][2];
  const char* cA = (const char*)A + (size_t)cpm * tstep;
  const char* cB = (const char*)Bt + (size_t)cpn * tstep;
  G2_STAGEB(G2_SB(0, 0), cB); G2_STAGE(G2_SA(0, 0), cA); G2_STAGEB(G2_SB(0, 1), cB + hstep); G2_STAGE(G2_SA(0, 1), cA + hstep);
  if (wr == 1) G2_BAR;
  G2_WAIT_V(4); G2_BAR;
  G2_STAGEB(G2_SB(1, 0), cB + kstep); G2_STAGE(G2_SA(1, 0), cA + kstep); G2_STAGEB(G2_SB(1, 1), cB + hstep + kstep);
  G2_WAIT_V(6); G2_BAR;
  for (;;) {
    const bool has_next = unit_at(ui + 1, npm, npn);
    const char* nA = has_next ? (const char*)A + (size_t)npm * tstep : cA;
    const char* nB = has_next ? (const char*)Bt + (size_t)npn * tstep : cB;
    for (int t = 0; t < nt; t += 2) {
      const bool last = (t == nt - 2);
      const char* a1 = cA + (size_t)(t + 1) * kstep;
      const char* a2 = last ? nA : cA + (size_t)(t + 2) * kstep;
      const char* b2 = last ? nB : cB + (size_t)(t + 2) * kstep;
      const char* a3 = a2 + kstep;
      const char* b3 = b2 + kstep;
      G2_LDB(B0, 0, 0); G2_SCHED; G2_LDA(At, 0, 0); G2_STAGE(G2_SA(1, 1), a1 + hstep);
      G2_WAIT_L(8); G2_BAR; G2_WAIT_L(0); G2_MMA(0, 0, At, B0); G2_BAR; G2_SCHED;
      G2_LDB(B1, 0, 1); G2_STAGEB(G2_SB(0, 0), b2);
      G2_BAR; G2_WAIT_L(0); G2_MMA(0, 1, At, B1); G2_BAR;
      G2_LDA(At, 0, 1); G2_STAGE(G2_SA(0, 0), a2);
      G2_BAR; G2_WAIT_L(0); G2_MMA(1, 0, At, B0); G2_BAR; G2_SCHED;
      G2_STAGEB(G2_SB(0, 1), b2 + hstep);
      G2_WAIT_V(6); G2_BAR; G2_MMA(1, 1, At, B1); G2_BAR;
      G2_LDB(B0, 1, 0); G2_SCHED; G2_LDA(At, 1, 0); G2_STAGE(G2_SA(0, 1), a2 + hstep);
      G2_WAIT_L(8); G2_BAR; G2_WAIT_L(0); G2_MMA(0, 0, At, B0); G2_BAR; G2_SCHED;
      G2_LDB(B1, 1, 1); G2_STAGEB(G2_SB(1, 0), b3);
      G2_BAR; G2_WAIT_L(0); G2_MMA(0, 1, At, B1); G2_BAR;
      G2_LDA(At, 1, 1); G2_STAGE(G2_SA(1, 0), a3);
      G2_BAR; G2_WAIT_L(0); G2_MMA(1, 0, At, B0); G2_BAR; G2_SCHED;
      G2_STAGEB(G2_SB(1, 1), b3 + hstep);
      G2_WAIT_V(6); G2_BAR; G2_MMA(1, 1, At, B1); G2_BAR;
    }
    {
      const int row0 = cpm * 256 + wr * 64 + fr, col0 = cpn * 256 + wc * 32 + 8 * fq;
#pragma unroll
      for (int ai = 0; ai < 2; ++ai)
#pragma unroll
        for (int m = 0; m < 4; ++m)
#pragma unroll
          for (int bj = 0; bj < 2; ++bj) epi(row0 + ai * 128 + m * 16, col0 + bj * 128, acc[ai][bj][m][0], acc[ai][bj][m][1]);
    }
    if (!has_next) break;
#pragma unroll
    for (int a = 0; a < 2; ++a)
#pragma unroll
      for (int b = 0; b < 2; ++b)
#pragma unroll
        for (int m = 0; m < 4; ++m)
#pragma unroll
          for (int n = 0; n < 2; ++n) acc[a][b][m][n] = f32x4{0.f, 0.f, 0.f, 0.f};
    cpm = npm; cpn = npn; cA = nA; cB = nB; ++ui;
  }
  G2_WAIT_V(0);
  if (wr == 0) G2_BAR;
  G2_BAR;
#undef G2_SA
#undef G2_SB
#undef G2_STAGE
#undef G2_STAGEB
#undef G2_STAGE_
#undef G2_LDA
#undef G2_LDB
#undef G2_MMA
#undef G2_WAIT_V
#undef G2_WAIT_L
#undef G2_BAR
#undef G2_SCHED
}

template <int K, int NT, class Epi>
DEV void small_gemm(const Params& p, const Ctx& cx, const char* As, int astride, const bf16_t* __restrict__ Bt, int n0, Epi epi) {
  const int lane = cx.tid & 63, fr = lane & 15, fq = lane >> 4;
  f32x4 acc[4][NT];
#pragma unroll
  for (int i = 0; i < 4; ++i)
#pragma unroll
    for (int j = 0; j < NT; ++j) acc[i][j] = f32x4{0.f, 0.f, 0.f, 0.f};
#pragma unroll 2
  for (int k0 = 0; k0 < K; k0 += 32) {
    bf16x8 af[4];
#pragma unroll
    for (int i = 0; i < 4; ++i) af[i] = *(const bf16x8*)(As + (i * 16 + fr) * astride + (k0 + fq * 8) * 2);
#pragma unroll
    for (int jn = 0; jn < NT; ++jn) {
      bf16x8 bf = *(const bf16x8*)(Bt + (size_t)(n0 + jn * 16 + fr) * K + k0 + fq * 8);
#pragma unroll
      for (int i = 0; i < 4; ++i) acc[i][jn] = __builtin_amdgcn_mfma_f32_16x16x32_f16(bf, af[i], acc[i][jn], 0, 0, 0);
    }
  }
#pragma unroll
  for (int i = 0; i < 4; ++i)
#pragma unroll
    for (int jn = 0; jn < NT; ++jn) epi(i * 16 + fr, n0 + jn * 16 + fq * 4, acc[i][jn]);
}

struct S5P { float ar, ai, br, bi; };
DEV S5P s5_params(const Params& p, const Ctx& cx, int l, int d, int g, int lane) {
  int idx = ((l * 2 + d) * 32 + g) * 64 + lane;
  float lr = fminf(p.s5_lam_re[idx], -1e-4f), li = p.s5_lam_im[idx];
  float step = expf(p.s5_log_step[(l * 2 + d) * 32 + g]);
  float xr = lr * step, xi = li * step;
  float e = expf(xr), cs = cosf(xi), sn = sinf(xi);
  S5P r;
  r.ar = e * cs; r.ai = e * sn;
  float sh = sinf(0.5f * xi);
  float nr = expm1f(xr) * cs - 2.f * sh * sh, ni = e * sn;
  float inv = 1.f / (lr * lr + li * li);
  r.br = (nr * lr + ni * li) * inv;
  r.bi = (ni * lr - nr * li) * inv;
  return r;
}

DEV void s5_load_u(const h16* zrest, int rowbase, int g, char* ulds, int lane) {
#pragma unroll
  for (int i = 0; i < 8; ++i) {
    int e = i * 64 + lane;
    int r = e >> 1, hf = e & 1;
    uint4 v = *(const uint4*)(zrest + (size_t)(rowbase + r) * ZR + g * 16 + hf * 8);
    *(uint4*)(ulds + r * 32 + hf * 16) = v;
  }
  lds_fence();
}

DEV int s5_rowbase(int b, int c) { return c == 0 ? NLAT + b * 256 : b * 16384 + (c - 1) * 256; }

DEV void s5_pass1_unit(const Params& p, const Ctx& cx, int l, int unit, char* wl, int lane) {
  int c = unit % 65, bg = unit / 65, g = bg & 31, b = bg >> 5;
  const h16* zrest = (const h16*)(p.ws + OFF_ZREST);
  float2* F = (float2*)(p.ws + OFF_S5F);
  s5_load_u(zrest, s5_rowbase(b, c), g, wl, lane);
  float Br[16], Bi[16];
  {
    const float* pr = p.s5_b_re + ((size_t)(l * 32 + g) * 64 + lane) * 16;
    const float* pi = p.s5_b_im + ((size_t)(l * 32 + g) * 64 + lane) * 16;
#pragma unroll
    for (int i = 0; i < 16; i += 4) {
      float4 a = *(const float4*)(pr + i), bq = *(const float4*)(pi + i);
      Br[i] = a.x; Br[i + 1] = a.y; Br[i + 2] = a.z; Br[i + 3] = a.w;
      Bi[i] = bq.x; Bi[i + 1] = bq.y; Bi[i + 2] = bq.z; Bi[i + 3] = bq.w;
    }
  }
  S5P pf = s5_params(p, cx, l, 0, g, lane), pb = s5_params(p, cx, l, 1, g, lane);
  float xr = 0, xi = 0, yr = 0, yi = 0, pwr = 1.f, pwi = 0.f;
#pragma unroll 4
  for (int t = 0; t < 256; ++t) {
    h16x8 u0 = *(const h16x8*)(wl + t * 32), u1 = *(const h16x8*)(wl + t * 32 + 16);
    float br = 0, bi = 0;
#pragma unroll
    for (int i = 0; i < 8; ++i) { float u = (float)u0[i]; br = fmaf(u, Br[i], br); bi = fmaf(u, Bi[i], bi); }
#pragma unroll
    for (int i = 0; i < 8; ++i) { float u = (float)u1[i]; br = fmaf(u, Br[8 + i], br); bi = fmaf(u, Bi[8 + i], bi); }
    float vr = pf.br * br - pf.bi * bi, vi = pf.br * bi + pf.bi * br;
    float nxr = pf.ar * xr - pf.ai * xi + vr, nxi = pf.ar * xi + pf.ai * xr + vi;
    xr = nxr; xi = nxi;
    float wr_ = pb.br * br - pb.bi * bi, wi_ = pb.br * bi + pb.bi * br;
    yr += pwr * wr_ - pwi * wi_; yi += pwr * wi_ + pwi * wr_;
    float npr = pwr * pb.ar - pwi * pb.ai, npi = pwr * pb.ai + pwi * pb.ar;
    pwr = npr; pwi = npi;
  }
  size_t fi = (((size_t)(b * 32 + g) * 65 + c) * 2) * 64 + lane;
  F[fi] = make_float2(xr, xi);
  F[fi + 64] = make_float2(yr, yi);
}

DEV void s5_pass3_unit(const Params& p, const Ctx& cx, int l, int unit, char* wl, int lane) {
  int c = unit % 65, bg = unit / 65, g = bg & 31, b = bg >> 5;
  const int fr = lane & 15, fq = lane >> 4;
  const h16* zrest = (const h16*)(p.ws + OFF_ZREST);
  const float2* F = (const float2*)(p.ws + OFF_S5F);
  float* S5Y = (float*)(p.ws + OFF_S5Y);
  const int rowbase = s5_rowbase(b, c);
  char* ulds = wl;
  char* tile = wl + 8192;
  s5_load_u(zrest, rowbase, g, ulds, lane);
  float Br[16], Bi[16];
  {
    const float* pr = p.s5_b_re + ((size_t)(l * 32 + g) * 64 + lane) * 16;
    const float* pi = p.s5_b_im + ((size_t)(l * 32 + g) * 64 + lane) * 16;
#pragma unroll
    for (int i = 0; i < 16; i += 4) {
      float4 a = *(const float4*)(pr + i), bq = *(const float4*)(pi + i);
      Br[i] = a.x; Br[i + 1] = a.y; Br[i + 2] = a.z; Br[i + 3] = a.w;
      Bi[i] = bq.x; Bi[i + 1] = bq.y; Bi[i + 2] = bq.z; Bi[i + 3] = bq.w;
    }
  }
  const float dsk = p.s5_d[(size_t)l * 512 + g * 16 + fr];
  const size_t fbase = ((size_t)(b * 32 + g) * 65) * 2 * 64 + lane;
#pragma unroll 1
  for (int d = 0; d < 2; ++d) {
    S5P pp = s5_params(p, cx, l, d, g, lane);
    float qr = pp.ar, qi = pp.ai;
#pragma unroll
    for (int i = 0; i < 8; ++i) { float t = qr * qr - qi * qi; qi = 2.f * qr * qi; qr = t; }
    float xr = 0, xi = 0;
    if (d == 0) {
      for (int cc = 0; cc < c; ++cc) {
        float2 f = F[fbase + (size_t)(cc * 2 + 0) * 64];
        float t = qr * xr - qi * xi + f.x; xi = qr * xi + qi * xr + f.y; xr = t;
      }
    } else if (c > 0) {
      float2 f0 = F[fbase + (size_t)(0 * 2 + 1) * 64];
      xr = f0.x; xi = f0.y;
      for (int cc = 64; cc > c; --cc) {
        float2 f = F[fbase + (size_t)(cc * 2 + 1) * 64];
        float t = qr * xr - qi * xi + f.x; xi = qr * xi + qi * xr + f.y; xr = t;
      }
    }
    bf16x8 chi[4], clo[4];
    {
      const float* cr = p.s5_c_re + ((size_t)((l * 2 + d) * 32 + g) * 16 + fr) * 64;
      const float* ci = p.s5_c_im + ((size_t)((l * 2 + d) * 32 + g) * 16 + fr) * 64;
#pragma unroll
      for (int ks = 0; ks < 4; ++ks) {
        float4 a = *(const float4*)(cr + ks * 16 + fq * 4), bq = *(const float4*)(ci + ks * 16 + fq * 4);
        float vals[8] = {a.x, -bq.x, a.y, -bq.y, a.z, -bq.z, a.w, -bq.w};
#pragma unroll
        for (int j = 0; j < 8; ++j) {
          h16 hh = (h16)vals[j];
          chi[ks][j] = hh;
          clo[ks][j] = (h16)(vals[j] - (float)hh);
        }
      }
    }
#pragma unroll 1
    for (int sb = 0; sb < 16; ++sb) {
      const int sub = d == 0 ? sb : 15 - sb;
#pragma unroll 4
      for (int q = 0; q < 16; ++q) {
        const int tt = d == 0 ? q : 15 - q;
        const int t = sub * 16 + tt;
        h16x8 u0 = *(const h16x8*)(ulds + t * 32), u1 = *(const h16x8*)(ulds + t * 32 + 16);
        float br = 0, bi = 0;
#pragma unroll
        for (int i = 0; i < 8; ++i) { float u = (float)u0[i]; br = fmaf(u, Br[i], br); bi = fmaf(u, Bi[i], bi); }
#pragma unroll
        for (int i = 0; i < 8; ++i) { float u = (float)u1[i]; br = fmaf(u, Br[8 + i], br); bi = fmaf(u, Bi[8 + i], bi); }
        float vr = pp.br * br - pp.bi * bi, vi = pp.br * bi + pp.bi * br;
        float nxr = pp.ar * xr - pp.ai * xi + vr, nxi = pp.ar * xi + pp.ai * xr + vi;
        xr = nxr; xi = nxi;
        h16x2 hv2 = {(h16)xr, (h16)xi};
        *(unsigned*)(tile + tt * 272 + lane * 4) = __builtin_bit_cast(unsigned, hv2);
      }
      lds_fence();
      f32x4 acc = f32x4{0.f, 0.f, 0.f, 0.f};
#pragma unroll
      for (int ks = 0; ks < 4; ++ks) {
        bf16x8 ah = *(const bf16x8*)(tile + fr * 272 + ks * 64 + fq * 16);
        acc = __builtin_amdgcn_mfma_f32_16x16x32_f16(ah, chi[ks], acc, 0, 0, 0);
        acc = __builtin_amdgcn_mfma_f32_16x16x32_f16(ah, clo[ks], acc, 0, 0, 0);
      }
      lds_fence();
#pragma unroll
      for (int r = 0; r < 4; ++r) {
        int tl = sub * 16 + fq * 4 + r;
        float* yp = S5Y + (size_t)(rowbase + tl) * 512 + g * 16 + fr;
        if (d == 0) {
          float u = (float)*(const h16*)(ulds + tl * 32 + fr * 2);
          *yp = acc[r] + dsk * u;
        } else {
          *yp = gelu_f(*yp + acc[r]);
        }
      }
    }
  }
}

DEV void prep_item(const Params& p, const Ctx& cx, int l, int item, char* smem) {
  const int tile = item >> 2, q = item & 3;
  const int row0 = tile * 64;
  const int tid = cx.tid;
  const h16* zc = (const h16*)(p.ws + OFF_REG2);
  h16* SC = (h16*)(p.ws + OFF_SCAN);
  const char* wt = p.ws + OFF_WT + (size_t)l * WT_SIZE;
  {
    const int d = q >> 1, isA = q & 1;
    const int coff = isA ? 3200 + d * 64 : 3072 + d * 64;
    int tok = tid >> 3, c8 = tid & 7;
    h16x8 cv = *(const h16x8*)(zc + (size_t)(row0 + tok) * ZC + coff + c8 * 8);
    float f[8];
#pragma unroll
    for (int j = 0; j < 8; ++j) { f[j] = (float)cv[j]; if (!isA) f[j] = tanh_f(f[j]); }
    uint4 o;
    o.x = pack_bf2(f[0], f[1]); o.y = pack_bf2(f[2], f[3]); o.z = pack_bf2(f[4], f[5]); o.w = pack_bf2(f[6], f[7]);
    *(uint4*)(smem + tok * 144 + c8 * 16) = o;
    __syncthreads();
    const bf16_t* Bt = (const bf16_t*)(wt + (isA ? WT_A2 : WT_W2)) + (size_t)d * 1024 * 64;
    const float* biasw = p.rwkv_w0 + (size_t)(l * 2 + d) * 1024;
    const float* biasa = p.rwkv_a0 + (size_t)(l * 2 + d) * 1024;
    h16* dst = SC + (size_t)(isA ? 4 + d : 6 + d) * ARR;
#pragma unroll 1
    for (int hf = 0; hf < 2; ++hf) small_gemm<64, 4>(p, cx, smem, 144, Bt, (tid >> 6) * 128 + hf * 64, [&](int m, int n, f32x4 v) {
      float4 bbw = *(const float4*)(biasw + n), bba = *(const float4*)(biasa + n);
      float4 bb = isA ? bba : bbw;
      float r0 = sigmoid_f(v[0] + bb.x), r1 = sigmoid_f(v[1] + bb.y), r2 = sigmoid_f(v[2] + bb.z), r3 = sigmoid_f(v[3] + bb.w);
      if (!isA) { r0 = __expf(-DECAY_SCALE * r0); r1 = __expf(-DECAY_SCALE * r1); r2 = __expf(-DECAY_SCALE * r2); r3 = __expf(-DECAY_SCALE * r3); }
      h16x4 o4 = {(h16)r0, (h16)r1, (h16)r2, (h16)r3};
      *(h16x4*)(dst + (size_t)(row0 + m) * 1024 + n) = o4;
    });
  }
  {
    const float* cw = p.conv_rkv + (size_t)l * 3 * 3072;
    const int grp = tid & 7, hh = (tid >> 3) & 3;
    const int c0 = (4 * q + hh) * 64 + grp * 8;
    float cwt[3][3][8];
#pragma unroll
    for (int s = 0; s < 3; ++s)
#pragma unroll
      for (int tp = 0; tp < 3; ++tp)
#pragma unroll
        for (int j = 0; j < 8; j += 4) {
          float4 a = *(const float4*)(cw + tp * 3072 + s * 1024 + c0 + j);
          cwt[s][tp][j] = a.x; cwt[s][tp][j + 1] = a.y; cwt[s][tp][j + 2] = a.z; cwt[s][tp][j + 3] = a.w;
        }
    float kkw[8];
#pragma unroll
    for (int j = 0; j < 8; j += 4) {
      float4 kq = *(const float4*)(p.rwkv_k_k + (size_t)l * 1024 + c0 + j);
      kkw[j] = kq.x; kkw[j + 1] = kq.y; kkw[j + 2] = kq.z; kkw[j + 3] = kq.w;
    }
#pragma unroll 1
    for (int it = 0; it < 4; ++it) {
      const int tok = (tid >> 5) + it * 16;
      const int row = row0 + tok;
      bool hasp, hasn;
      if (row < NLAT) { hasp = (row & 16383) != 0; hasn = (row & 16383) != 16383; }
      else { hasp = (row & 255) != 0; hasn = (row & 255) != 255; }
      const size_t off = (size_t)row * 1024 + c0;
      const h16* zp = zc + (size_t)row * ZC + c0;
      const h16* zpp = hasp ? zp - ZC : zp;
      const h16* zpn = hasn ? zp + ZC : zp;
      h16x8 cur[3], prv[3], nxt[3];
#pragma unroll
      for (int s = 0; s < 3; ++s) { cur[s] = *(const h16x8*)(zp + s * 1024); prv[s] = *(const h16x8*)(zpp + s * 1024); nxt[s] = *(const h16x8*)(zpn + s * 1024); }
      const float fp = hasp ? 1.f : 0.f, fn = hasn ? 1.f : 0.f;
      float kv[8];
#pragma unroll
      for (int s = 0; s < 3; ++s) {
        h16x8 o;
#pragma unroll
        for (int j = 0; j < 8; ++j) {
          float ov = cwt[s][0][j] * (fp * (float)prv[s][j]) + cwt[s][1][j] * (float)cur[s][j] + cwt[s][2][j] * (fn * (float)nxt[s][j]);
          o[j] = (h16)ov;
          if (s == 1) kv[j] = ov;
        }
        *(h16x8*)(SC + (size_t)s * ARR + off) = o;
      }
      float kk[8], ss = 0;
#pragma unroll
      for (int j = 0; j < 8; ++j) { kk[j] = kv[j] * kkw[j]; ss += kk[j] * kk[j]; }
      ss = allreduce8(ss);
      float inv = rcp_f(fmaxf(sqrtf(ss), 1e-12f));
      h16x8 o;
#pragma unroll
      for (int j = 0; j < 8; ++j) o[j] = (h16)(kk[j] * inv);
      *(h16x8*)(SC + 3 * ARR + off) = o;
    }
  }
}

DEV void phase_prep(const Params& p, const Ctx& cx0, int l, char* smem) {
  const int NPREP = 520 * 4, NS5 = 520;
  const Ctx& cx_ = cx0;
  for (int item = cx_.bid; item < NPREP + NS5; item += cx_.nblk) {
    __syncthreads();
    Ctx cx = cx0; asm volatile("" : "+v"(cx.tid));
    const int lane = cx.tid & 63, wid = cx.tid >> 6;
#ifndef NO_PREPITEM
    if (item < NPREP) prep_item(p, cx, l, item, smem);
    else
#endif
#ifndef NO_S5P1
      s5_pass1_unit(p, cx, l, (item - NPREP) * 8 + wid, smem + wid * 8192, lane);
#else
    {}
#endif
  }
}

typedef unsigned u2v __attribute__((ext_vector_type(2)));
struct RG { u2v w, a, kk, k, r; h16 v; };

constexpr int RW_NSLOT = 8, RW_SLOTB = 3072;
constexpr int RW_FLAGS = RW_NSLOT * RW_SLOTB;
constexpr int RW_NG = 16640 / 4;
typedef float f4v __attribute__((ext_vector_type(4)));

#define RW_RLO(gq, rlo)                                                            \
  {                                                                                \
    const int gg = (gq) < RW_NG ? (gq) : RW_NG - 1;                                \
    const int q0_ = gg * 4;                                                        \
    const int isl = q0_ >= 256;                                                    \
    const int base_ = isl ? b * 16384 : NLAT + b * 256;                            \
    const int t0_ = isl ? q0_ - 256 : q0_;                                         \
    const int last_ = isl ? 16383 : 255;                                           \
    rlo = base_ + (d ? last_ - t0_ - 3 : t0_);                                     \
  }

DEV void rwkv_helper(const Params& p, const Ctx& cx, int l, int unit, int lane, char* ring) {
  const int d = unit & 1, h = (unit >> 1) & 15, b = unit >> 5;
  const int j = lane >> 4, s = lane & 15;
  const h16* SC = (const h16*)(p.ws + OFF_SCAN);
  const char* pR = (const char*)(SC + 0 * ARR + h * 64);
  const char* pK = (const char*)(SC + 1 * ARR + h * 64);
  const char* pV = (const char*)(SC + 2 * ARR + h * 64);
  const char* pKK = (const char*)(SC + 3 * ARR + h * 64);
  const char* pA = (const char*)(SC + (size_t)(4 + d) * ARR + h * 64);
  const char* pW = (const char*)(SC + (size_t)(6 + d) * ARR + h * 64);
  const int jm = d ? 3 - j : j;
  const unsigned vo0 = (unsigned)(jm * 2048 + s * 8);
  f4v ka4, om4;
  {
    float4 t = *(const float4*)(p.rwkv_k_a + (size_t)l * 1024 + h * 64 + 4 * s);
    ka4 = f4v{t.x, t.y, t.z, t.w};
    om4 = 1.f - ka4;
  }
  struct RGH { u2v w, a, kk, k, r, v; };
  RGH q0, q1, q2, q3, q4, q5, q6, q7;
  const unsigned wofs = (unsigned)(j * 128 + s * 8);
  const unsigned vwofs = (unsigned)(2560 + j * 128 + s * 8);
  LAS3 volatile int* pflag = (LAS3 volatile int*)(ring + RW_FLAGS);
  LAS3 volatile int* cflag = (LAS3 volatile int*)(ring + RW_FLAGS + 64);
  int cmin = 0;
#define CV4(uv) __builtin_convertvector(__builtin_bit_cast(h16x4, uv), f4v)
#define RH_LOAD(q, gq)                                                             \
  {                                                                                \
    int rlo; RW_RLO(gq, rlo);                                                      \
    unsigned vo = vo0; asm volatile("" : "+v"(vo));                                \
    const size_t off = (size_t)rlo * 2048;                                         \
    q.w = *(const u2v*)(pW + off + vo); q.a = *(const u2v*)(pA + off + vo);        \
    q.kk = *(const u2v*)(pKK + off + vo); q.k = *(const u2v*)(pK + off + vo);      \
    q.r = *(const u2v*)(pR + off + vo); q.v = *(const u2v*)(pV + off + vo);        \
  }
#define RH_STEP(q, gq)                                                             \
  {                                                                                \
    if ((gq) >= RW_NSLOT && cmin < (gq) - RW_NSLOT + 1) {                          \
      do {                                                                         \
        const int c0_ = cflag[0], c1_ = cflag[1], c2_ = cflag[2], c3_ = cflag[3];  \
        cmin = __builtin_amdgcn_readfirstlane(min(min(c0_, c1_), min(c2_, c3_)));  \
        if (cmin < (gq) - RW_NSLOT + 1) __builtin_amdgcn_s_sleep(1);               \
      } while (cmin < (gq) - RW_NSLOT + 1);                                        \
    }                                                                              \
    asm volatile("" ::: "memory");                                                 \
    char* sl = ring + ((gq) % RW_NSLOT) * RW_SLOTB;                                \
    const f4v a_ = CV4(q.a), kk_ = CV4(q.kk);                                      \
    const f4v kka_ = kk_ * a_, kd_ = CV4(q.k) * (a_ * ka4 + om4);                  \
    *(u2v*)(sl + 0 * 512 + wofs) = q.w;                                            \
    *(u2v*)(sl + 1 * 512 + wofs) = q.kk;                                           \
    *(u2v*)(sl + 2 * 512 + wofs) = __builtin_bit_cast(u2v, __builtin_convertvector(kka_, h16x4)); \
    *(u2v*)(sl + 3 * 512 + wofs) = __builtin_bit_cast(u2v, __builtin_convertvector(kd_, h16x4));  \
    *(u2v*)(sl + 4 * 512 + wofs) = q.r;                                            \
    *(u2v*)(sl + vwofs) = q.v;                                                     \
    asm volatile("s_waitcnt lgkmcnt(0)" ::: "memory");     \
    *pflag = (gq) + 1;                                                             \
  }
  RH_LOAD(q0, 0); RH_LOAD(q1, 1); RH_LOAD(q2, 2); RH_LOAD(q3, 3); RH_LOAD(q4, 4); RH_LOAD(q5, 5); RH_LOAD(q6, 6); RH_LOAD(q7, 7);
#pragma unroll 1
  for (int g = 0; g < RW_NG; g += 8) {
    RH_STEP(q0, g); RH_LOAD(q0, g + 8); __builtin_amdgcn_sched_barrier(0);
    RH_STEP(q1, g + 1); RH_LOAD(q1, g + 9); __builtin_amdgcn_sched_barrier(0);
    RH_STEP(q2, g + 2); RH_LOAD(q2, g + 10); __builtin_amdgcn_sched_barrier(0);
    RH_STEP(q3, g + 3); RH_LOAD(q3, g + 11); __builtin_amdgcn_sched_barrier(0);
    RH_STEP(q4, g + 4); RH_LOAD(q4, g + 12); __builtin_amdgcn_sched_barrier(0);
    RH_STEP(q5, g + 5); RH_LOAD(q5, g + 13); __builtin_amdgcn_sched_barrier(0);
    RH_STEP(q6, g + 6); RH_LOAD(q6, g + 14); __builtin_amdgcn_sched_barrier(0);
    RH_STEP(q7, g + 7); RH_LOAD(q7, g + 15); __builtin_amdgcn_sched_barrier(0);
  }
#undef RH_LOAD
#undef RH_STEP
#undef CV4
}

DEV void rwkv_consumer(const Params& p, const Ctx& cx, int l, int task, int lane, const char* ring, int widx) {
  const int unit = task >> 4, d = unit & 1, h = (unit >> 1) & 15, b = unit >> 5;
  const int j = lane >> 4, s = lane & 15;
  const int myrow = (task & 15) * 4 + j;
  char* pO = (char*)((h16*)(p.ws + OFF_REG2) + (size_t)d * ARR + h * 64);
  const int sm = d ? 3 - (s & 3) : (s & 3);
  const unsigned vov0 = (unsigned)(sm * 2048 + myrow * 2);
  const unsigned rofs = (unsigned)(s * 8);
  const unsigned vrofs = (unsigned)(2560 + myrow * 2);
  LAS3 volatile int* pflag = (LAS3 volatile int*)(ring + RW_FLAGS);
  LAS3 volatile int* cflag = (LAS3 volatile int*)(ring + RW_FLAGS + 64) + widx;
  float S0 = 0.f, S1 = 0.f, S2 = 0.f, S3 = 0.f;
  int pseen = 0;
  struct GD { u2v w[4], kk[4], kka[4], kd[4], r[4]; unsigned v[4]; };
  GD A, B;
#define RC_WAIT(gq) { if (pseen <= (gq)) { do { pseen = __builtin_amdgcn_readfirstlane(*pflag); if (pseen <= (gq)) __builtin_amdgcn_s_sleep(1); } while (pseen <= (gq)); } asm volatile("" ::: "memory"); }
#define RC_LOAD(G, gq)                                                             \
  {                                                                                \
    const char* sl = ring + ((gq) % RW_NSLOT) * RW_SLOTB;                          \
    _Pragma("unroll") for (int u = 0; u < 4; ++u) {                                \
      G.w[u] = *(const u2v*)(sl + 0 * 512 + u * 128 + rofs);                       \
      G.kk[u] = *(const u2v*)(sl + 1 * 512 + u * 128 + rofs);                      \
      G.kka[u] = *(const u2v*)(sl + 2 * 512 + u * 128 + rofs);                     \
      G.kd[u] = *(const u2v*)(sl + 3 * 512 + u * 128 + rofs);                      \
      G.r[u] = *(const u2v*)(sl + 4 * 512 + u * 128 + rofs);                       \
      G.v[u] = *(const unsigned short*)(sl + u * 128 + vrofs);                     \
    }                                                                              \
  }
#define RC_COMP(G, gq)                                                             \
  {                                                                                \
    float dres[4];                                                                 \
    _Pragma("unroll") for (int u = 0; u < 4; ++u) {                                \
        \
        \
      float ea, eb, x_, y_, t0, t1, t2, t3;                                        \
      asm("v_fma_mix_f32 %6, %0, %12, 0 op_sel:[0,0,0] op_sel_hi:[0,1,0]\n\t"      \
          "v_fma_mix_f32 %7, %2, %13, 0 op_sel:[0,0,0] op_sel_hi:[0,1,0]\n\t"      \
          "v_fma_mix_f32 %6, %1, %12, %6 op_sel:[0,1,0] op_sel_hi:[0,1,0]\n\t"     \
          "v_fma_mix_f32 %7, %3, %13, %7 op_sel:[0,1,0] op_sel_hi:[0,1,0]\n\t"     \
          "v_fma_mix_f32 %8, %22, %16, 0 op_sel:[0,0,0] op_sel_hi:[1,1,0]\n\t"     \
          "v_add_f32 %6, %6, %7\n\t"                                               \
          "v_fma_mix_f32 %9, %22, %16, 0 op_sel:[0,1,0] op_sel_hi:[1,1,0]\n\t"     \
          "v_fma_mix_f32 %10, %22, %17, 0 op_sel:[0,0,0] op_sel_hi:[1,1,0]\n\t"    \
          "v_add_f32_dpp %6, %6, %6 quad_perm:[1,0,3,2] row_mask:0xf bank_mask:0xf bound_ctrl:1\n\t" \
          "v_fma_mix_f32 %11, %22, %17, 0 op_sel:[0,1,0] op_sel_hi:[1,1,0]\n\t"    \
          "v_fma_mix_f32 %0, %0, %14, %8 op_sel:[0,0,0] op_sel_hi:[0,1,0]\n\t"     \
          "v_add_f32_dpp %6, %6, %6 quad_perm:[2,3,0,1] row_mask:0xf bank_mask:0xf bound_ctrl:1\n\t" \
          "v_fma_mix_f32 %1, %1, %14, %9 op_sel:[0,1,0] op_sel_hi:[0,1,0]\n\t"     \
          "v_fma_mix_f32 %2, %2, %15, %10 op_sel:[0,0,0] op_sel_hi:[0,1,0]\n\t"    \
          "v_add_f32_dpp %6, %6, %6 row_half_mirror row_mask:0xf bank_mask:0xf bound_ctrl:1\n\t" \
          "v_fma_mix_f32 %3, %3, %15, %11 op_sel:[0,1,0] op_sel_hi:[0,1,0]\n\t"    \
          "s_nop 0\n\t"                                                            \
          "v_add_f32_dpp %6, %6, %6 row_mirror row_mask:0xf bank_mask:0xf bound_ctrl:1\n\t" \
          "v_fma_mix_f32 %0, -%6, %18, %0 op_sel:[0,0,0] op_sel_hi:[0,1,0]\n\t"    \
          "v_fma_mix_f32 %1, -%6, %18, %1 op_sel:[0,1,0] op_sel_hi:[0,1,0]\n\t"    \
          "v_fma_mix_f32 %2, -%6, %19, %2 op_sel:[0,0,0] op_sel_hi:[0,1,0]\n\t"    \
          "v_fma_mix_f32 %3, -%6, %19, %3 op_sel:[0,1,0] op_sel_hi:[0,1,0]\n\t"    \
          "v_fma_mix_f32 %4, %0, %20, 0 op_sel:[0,0,0] op_sel_hi:[0,1,0]\n\t"      \
          "v_fma_mix_f32 %5, %2, %21, 0 op_sel:[0,0,0] op_sel_hi:[0,1,0]\n\t"      \
          "v_fma_mix_f32 %4, %1, %20, %4 op_sel:[0,1,0] op_sel_hi:[0,1,0]\n\t"     \
          "v_fma_mix_f32 %5, %3, %21, %5 op_sel:[0,1,0] op_sel_hi:[0,1,0]"         \
          : "+v"(S0), "+v"(S1), "+v"(S2), "+v"(S3), "=&v"(ea), "=&v"(eb), "=&v"(x_), "=&v"(y_),                     \
            "=&v"(t0), "=&v"(t1), "=&v"(t2), "=&v"(t3)                                                              \
          : "v"(G.kk[u].x), "v"(G.kk[u].y), "v"(G.w[u].x), "v"(G.w[u].y), "v"(G.kd[u].x), "v"(G.kd[u].y),           \
            "v"(G.kka[u].x), "v"(G.kka[u].y), "v"(G.r[u].x), "v"(G.r[u].y), "v"(G.v[u]));                           \
      dres[u] = ea + eb;     \
    }                                                                              \
    asm volatile("" ::: "memory");                                                 \
    *cflag = (gq) + 1;     \
    {                                                                              \
      int rlo; RW_RLO(gq, rlo);                                                    \
      unsigned vov = vov0; asm volatile("" : "+v"(vov));                           \
        \
      const bool p1_ = (s & 1) != 0, p2_ = (s & 2) != 0;                           \
      const float a_ = (p1_ ? dres[1] : dres[0]) + dpp_mov<0xB1>(p1_ ? dres[0] : dres[1]); \
      const float b_ = (p1_ ? dres[3] : dres[2]) + dpp_mov<0xB1>(p1_ ? dres[2] : dres[3]); \
      float val = (p2_ ? b_ : a_) + dpp_mov<0x4E>(p2_ ? a_ : b_);                  \
      val += dpp_mov<0x124>(val);                                                  \
      val += dpp_mov<0x128>(val);                                                  \
      *(h16*)(pO + (size_t)rlo * 2048 + vov) = (h16)val;                           \
    }                                                                              \
  }
  RC_WAIT(0); RC_LOAD(A, 0);
#pragma unroll 1
  for (int g = 0; g < RW_NG; g += 2) {
    RC_WAIT(g + 1); RC_LOAD(B, g + 1);
    RC_COMP(A, g);
    if (g + 2 < RW_NG) { RC_WAIT(g + 2); RC_LOAD(A, g + 2); }
    RC_COMP(B, g + 1);
  }
#undef RC_WAIT
#undef RC_LOAD
#undef RC_COMP
}
#undef RW_RLO

DEV void phase_scan(const Params& p, const Ctx& cx, int l, char* smem) {
  const int lane = cx.tid & 63, wid = __builtin_amdgcn_readfirstlane(cx.tid >> 6);
  for (int slot = cx.bid; slot < 256; slot += cx.nblk) {
    __syncthreads();
    if (wid == 4 && lane < 8) *(LAS3 volatile int*)(smem + RW_FLAGS + (lane == 0 ? 0 : 64 + (lane & 3) * 4)) = 0;
    __syncthreads();
    const int unit = slot & 63;
#ifndef NO_RWKV
    if (wid < 4) { __builtin_amdgcn_s_setprio(3); rwkv_consumer(p, cx, l, (unit << 4) | ((slot >> 6) << 2) | wid, lane, smem, wid); __builtin_amdgcn_s_setprio(0); }
    else if (wid == 4) { __builtin_amdgcn_s_setprio(2); rwkv_helper(p, cx, l, unit, lane, smem); __builtin_amdgcn_s_setprio(0); }
#endif
  }
  if (wid >= 5) {
    char* wl = smem + 32768 + (wid - 5) * 17408;
    for (int u = cx.bid * 3 + (wid - 5); u < 2 * 32 * 65; u += cx.nblk * 3) {
      if (l == 1 && (u % 65) == 0) continue;
#ifndef NO_S5P3
      s5_pass3_unit(p, cx, l, u, wl, lane);
#endif
    }
  }
}

DEV void pool_item(const Params& p, const Ctx& cx, int l, int item, char* smem) {
  const int tid = cx.tid;
  const h16* zrest = (const h16*)(p.ws + OFF_ZREST);
  bf16_t* ym = (bf16_t*)(p.ws + OFF_YM);
  const char* wt = p.ws + OFF_WT + (size_t)l * WT_SIZE;
  float* V = (float*)smem;
  char* At = smem + 43008;
  int g, rowout0, Lseq, p0, rlo, rhi, rstride, rowsrc0;
  if (item < 2048) {
    g = item & 3; int r = (item >> 2) & 255, b = item >> 10;
    int w = 2 << g;
    rlo = max(r - w / 2, 0); rhi = min(r + w / 2 - 1, 255);
    rowsrc0 = b * 16384; rstride = 64;
    rowout0 = b * 16384 + r * 64; Lseq = 64; p0 = 0;
  } else {
    int it = item - 2048;
    g = it & 3; int tq = (it >> 2) & 3, b = it >> 4;
    rlo = 0; rhi = 0; rowsrc0 = NLAT + b * 256; rstride = 0;
    rowout0 = NLAT + b * 256 + tq * 64; Lseq = 256; p0 = tq * 64;
  }
  const int w = 2 << g;
  const float invr = 1.f / (float)(rhi - rlo + 1);
  for (int unit = tid; unit < 80 * 16; unit += NTHREADS) {
    int lp = unit >> 4, ch8 = unit & 15;
    int pos = p0 - 8 + lp;
    float acc[8] = {0, 0, 0, 0, 0, 0, 0, 0};
    if (pos >= 0 && pos < Lseq) {
      const h16* bp = zrest + (size_t)(rowsrc0 + pos) * ZR + 1024 + g * 128 + ch8 * 8;
      const int nr = rhi - rlo + 1;
      for (int k0 = 0; k0 < nr; k0 += 4) {
        h16x8 v[4]; float wv[4];
#pragma unroll
        for (int i = 0; i < 4; ++i) {
          const int kk_ = min(k0 + i, nr - 1);
          wv[i] = (k0 + i < nr) ? 1.f : 0.f;
          v[i] = *(const h16x8*)(bp + (size_t)((rlo + kk_) * rstride) * ZR);
        }
#pragma unroll
        for (int i = 0; i < 4; ++i)
#pragma unroll
          for (int j = 0; j < 8; ++j) acc[j] += wv[i] * (float)v[i][j];
      }
    }
    float* vp = V + lp * 132 + ch8 * 8;
#pragma unroll
    for (int j = 0; j < 8; ++j) vp[j] = acc[j] * invr;
  }
  __syncthreads();
  for (int unit = tid; unit < 64 * 16; unit += NTHREADS) {
    int c = unit >> 4, ch8 = unit & 15;
    int pos = p0 + c;
    int lo = max(pos - w / 2, 0), hi = min(pos + w / 2 - 1, Lseq - 1);
    float acc[8] = {0, 0, 0, 0, 0, 0, 0, 0};
    for (int pp = lo; pp <= hi; ++pp) {
      const float* vp = V + (pp - p0 + 8) * 132 + ch8 * 8;
#pragma unroll
      for (int j = 0; j < 8; ++j) acc[j] += vp[j];
    }
    float invc = 1.f / (float)(hi - lo + 1);
    h16x8 uc = *(const h16x8*)(zrest + (size_t)(rowout0 + c) * ZR + 1024 + g * 128 + ch8 * 8);
    uint4 o;
    o.x = pack_bf2(acc[0] * invc - (float)uc[0], acc[1] * invc - (float)uc[1]);
    o.y = pack_bf2(acc[2] * invc - (float)uc[2], acc[3] * invc - (float)uc[3]);
    o.z = pack_bf2(acc[4] * invc - (float)uc[4], acc[5] * invc - (float)uc[5]);
    o.w = pack_bf2(acc[6] * invc - (float)uc[6], acc[7] * invc - (float)uc[7]);
    *(uint4*)(At + c * 272 + ch8 * 16) = o;
  }
  __syncthreads();
  const bf16_t* Bt = (const bf16_t*)(wt + WT_POOL) + (size_t)g * 128 * 128;
  const float* ps = p.pool_scale + (size_t)l * 512 + g * 128;
  small_gemm<128, 1>(p, cx, At, 272, Bt, (tid >> 6) * 16, [&](int m, int n, f32x4 v) {
    int row = rowout0 + m;
    float4 sc = *(const float4*)(ps + n);
    h16x4 gt = *(const h16x4*)(zrest + (size_t)row * ZR + 1536 + g * 128 + n);
    uint2 o;
    o.x = pack_bf2(v[0] * sc.x * silu_f((float)gt[0]), v[1] * sc.y * silu_f((float)gt[1]));
    o.y = pack_bf2(v[2] * sc.z * silu_f((float)gt[2]), v[3] * sc.w * silu_f((float)gt[3]));
    *(uint2*)(ym + (size_t)row * D + 512 + g * 128 + n) = o;
  });
}

DEV void glu_item(const Params& p, const Ctx& cx, int l, int tile, char* smem) {
  const int tid = cx.tid;
  const int row0 = tile * 64;
  const float* S5Y = (const float*)(p.ws + OFF_S5Y);
  const h16* zrest = (const h16*)(p.ws + OFF_ZREST);
  bf16_t* ym = (bf16_t*)(p.ws + OFF_YM);
  const char* wt = p.ws + OFF_WT + (size_t)l * WT_SIZE;
#pragma unroll
  for (int it = 0; it < 8; ++it) {
    int unit = tid + it * NTHREADS;
    int r = unit >> 6, c8 = unit & 63;
    const float* sp = S5Y + (size_t)(row0 + r) * 512 + c8 * 8;
    float4 a = *(const float4*)sp, bq = *(const float4*)(sp + 4);
    uint4 o;
    o.x = pack_bf2(a.x, a.y); o.y = pack_bf2(a.z, a.w); o.z = pack_bf2(bq.x, bq.y); o.w = pack_bf2(bq.z, bq.w);
    *(uint4*)(smem + r * 1040 + c8 * 16) = o;
  }
  __syncthreads();
  const bf16_t* Bt = (const bf16_t*)(wt + WT_GLU);
  const float* bg = p.b_glu + (size_t)l * 512;
  small_gemm<512, 4>(p, cx, smem, 1040, Bt, (tid >> 6) * 64, [&](int m, int n, f32x4 v) {
    int row = row0 + m;
    float4 y = *(const float4*)(S5Y + (size_t)row * 512 + n);
    float4 bb = *(const float4*)(bg + n);
    h16x4 gt = *(const h16x4*)(zrest + (size_t)row * ZR + 512 + n);
    uint2 o;
    o.x = pack_bf2(y.x * sigmoid_f(v[0] + bb.x) * silu_f((float)gt[0]), y.y * sigmoid_f(v[1] + bb.y) * silu_f((float)gt[1]));
    o.y = pack_bf2(y.z * sigmoid_f(v[2] + bb.z) * silu_f((float)gt[2]), y.w * sigmoid_f(v[3] + bb.w) * silu_f((float)gt[3]));
    *(uint2*)(ym + (size_t)row * D + n) = o;
  });
}

DEV void rwkvmerge_item(const Params& p, const Ctx& cx, int l, int tile) {
  const int tid = cx.tid;
  const int row0 = tile * 64;
  const h16* SC = (const h16*)(p.ws + OFF_SCAN);
  const h16* O = (const h16*)(p.ws + OFF_REG2);
  const h16* zrest = (const h16*)(p.ws + OFF_ZREST);
  bf16_t* ym = (bf16_t*)(p.ws + OFF_YM);
  const int grp = tid & 7, h = (tid >> 3) & 15;
  const int c0 = h * 64 + grp * 8;
  float pk[8], rk[8], gw[8], gb[8];
#pragma unroll
  for (int j = 0; j < 8; j += 4) {
    float4 t0 = *(const float4*)(p.rwkv_k_a + (size_t)l * 1024 + c0 + j), t1 = *(const float4*)(p.rwkv_r_k + (size_t)l * 1024 + c0 + j);
    float4 t2 = *(const float4*)(p.gn_w + (size_t)l * 1024 + c0 + j), t3 = *(const float4*)(p.gn_b + (size_t)l * 1024 + c0 + j);
    pk[j] = t0.x; pk[j + 1] = t0.y; pk[j + 2] = t0.z; pk[j + 3] = t0.w;
    rk[j] = t1.x; rk[j + 1] = t1.y; rk[j + 2] = t1.z; rk[j + 3] = t1.w;
    gw[j] = t2.x; gw[j + 1] = t2.y; gw[j + 2] = t2.z; gw[j + 3] = t2.w;
    gb[j] = t3.x; gb[j + 1] = t3.y; gb[j + 2] = t3.z; gb[j + 3] = t3.w;
  }
#pragma unroll 2
  for (int it = 0; it < 16; ++it) {
    const int tok = (tid >> 7) + it * 4;
    int row = row0 + tok;
    size_t off = (size_t)row * 1024 + c0;
    h16x8 of = *(const h16x8*)(O + off), ob = *(const h16x8*)(O + ARR + off);
    h16x8 r8 = *(const h16x8*)(SC + 0 * ARR + off), k8 = *(const h16x8*)(SC + 1 * ARR + off), v8 = *(const h16x8*)(SC + 2 * ARR + off);
    h16x8 af = *(const h16x8*)(SC + 4 * ARR + off), ab = *(const h16x8*)(SC + 5 * ARR + off);
    h16x8 gt = *(const h16x8*)(zrest + (size_t)row * ZR + 2048 + c0);
    float o[8], sm = 0;
#pragma unroll
    for (int j = 0; j < 8; ++j) { o[j] = (float)of[j] + (float)ob[j]; sm += o[j]; }
    sm = allreduce8(sm);
    float mu = sm * (1.f / 64.f), vq = 0;
#pragma unroll
    for (int j = 0; j < 8; ++j) { o[j] -= mu; vq += o[j] * o[j]; }
    vq = allreduce8(vq);
    float rstd = rsqrtf(vq * (1.f / 64.f) + 64e-5f);
    float part = 0;
#pragma unroll
    for (int j = 0; j < 8; ++j) {
      float ksum = (float)k8[j] * (2.f + ((float)af[j] + (float)ab[j] - 2.f) * pk[j]);
      part += (float)r8[j] * ksum * rk[j];
    }
    part = allreduce8(part);
    float res[8];
#pragma unroll
    for (int j = 0; j < 8; ++j) {
      float y = o[j] * rstd * gw[j] + gb[j] + part * (float)v8[j];
      res[j] = y * silu_f((float)gt[j]);
    }
    uint4 ov;
    ov.x = pack_bf2(res[0], res[1]); ov.y = pack_bf2(res[2], res[3]); ov.z = pack_bf2(res[4], res[5]); ov.w = pack_bf2(res[6], res[7]);
    *(uint4*)(ym + (size_t)row * D + 1024 + c0) = ov;
  }
}

DEV void phase_merge(const Params& p, const Ctx& cx0, int l, char* smem) {
  const int ntile = (l == 0) ? 520 : 512;
  const int npool = (l == 0) ? 2048 + 32 : 2048;
  const int total = npool + 2 * ntile;
  for (int item = cx0.bid; item < total; item += cx0.nblk) {
    __syncthreads();
    Ctx cx = cx0; asm volatile("" : "+v"(cx.tid));
    if (item < npool) pool_item(p, cx, l, item, smem);
    else if (item < npool + ntile) glu_item(p, cx, l, item - npool, smem);
    else rwkvmerge_item(p, cx, l, item - npool - ntile);
  }
}

#define LCX Ctx c2 = cx; asm volatile("" : "+v"(c2.tid))
#ifndef GEMM_FN
#define GEMM_FN gemm_phase2
#endif
__global__ void __launch_bounds__(NTHREADS) mega_fwd(Params p, int ph0, int ph1) {
  extern __shared__ __attribute__((aligned(16))) char smem[];
  cg::grid_group grid = cg::this_grid();
  const int wave_s = __builtin_amdgcn_readfirstlane((int)(threadIdx.x >> 6));
  for (int step = ph0; step < ph1; ++step) {
    if (step > ph0) grid.sync();
    const int ph = (int)((PH_SEQ >> (4 * step)) & 15ull);
    Ctx cx;
    {
      int t_, b_ = blockIdx.x, n_ = gridDim.x;
      asm volatile("v_mbcnt_lo_u32_b32 %0, -1, 0\n\tv_mbcnt_hi_u32_b32 %0, -1, %0\n\tv_lshl_add_u32 %0, %1, 6, %0" : "=&v"(t_) : "s"(wave_s));
      asm volatile("" : "+s"(b_), "+s"(n_));
      cx.tid = t_; cx.bid = b_; cx.nblk = n_;
    }
    const int l = ph >= 8 ? 1 : 0;
    const int lp = ph >= 8 ? ph - 6 : ph;
#ifndef PHMASK
#define PHMASK 0xff
#endif
    if (ph == 0) { if (PHMASK & 1) { LCX; phase0(p, c2, smem); } }
    else if (ph == 1) { if (PHMASK & 2) { LCX; phase_adaln0(p, c2); } }
    else if (lp == 2 && (PHMASK & 4)) {
      LCX;
      h16* zrest = (h16*)(p.ws + OFF_ZREST);
      h16* zc = (h16*)(p.ws + OFF_REG2);
      GEMM_FN(p, c2, (const bf16_t*)(p.ws + OFF_H), (const bf16_t*)(p.ws + OFF_WT + (size_t)l * WT_SIZE + WT_IN), 2048, 130, 25, smem,
                 [&](int row, int col, f32x4 v, f32x4 u) {
                   h16* dst;
                   if (col < 2048) dst = zrest + (size_t)row * ZR + col;
                   else if (col < 5120) dst = zc + (size_t)row * ZC + (col - 2048);
                   else if (col < 6144) dst = zrest + (size_t)row * ZR + 2048 + (col - 5120);
                   else dst = zc + (size_t)row * ZC + 3072 + (col - 6144);
                   h16x8 o = {(h16)v[0], (h16)v[1], (h16)v[2], (h16)v[3], (h16)u[0], (h16)u[1], (h16)u[2], (h16)u[3]};
                   *(h16x8*)dst = o;
                 });
    } else if (lp == 3) { if (PHMASK & 8) { LCX; phase_prep(p, c2, l, smem); } }
    else if (lp == 4) { if (PHMASK & 16) { LCX; phase_scan(p, c2, l, smem); } }
    else if (lp == 5) { if (PHMASK & 32) { LCX; phase_merge(p, c2, l, smem); } }
    else if (lp == 6 && (PHMASK & 64)) {
      LCX;
      const float* mods = (const float*)(p.ws + OFF_MODS);
      float* prec = (float*)(p.ws + OFF_PREC);
      const float* xin = (l == 0) ? p.x : p.out;
      GEMM_FN(p, c2, (const bf16_t*)(p.ws + OFF_YM), (const bf16_t*)(p.ws + OFF_WT + (size_t)l * WT_SIZE + WT_OUT), 2048, l == 0 ? 130 : 128, 8, smem,
                 [&](int row, int col, f32x4 v, f32x4 u) {
                   const float* xr; const float* gr; float* dr;
                   if (row < NLAT) {
                     xr = xin + (size_t)row * D + col; gr = mods + (size_t)(l * 3 + (row >> 14)) * 6144 + 4096 + col; dr = p.out + (size_t)row * D + col;
                   } else {
                     xr = p.ctx + (size_t)(row - NLAT) * D + col; gr = mods + (size_t)(l * 3 + 2) * 6144 + 4096 + col; dr = prec + (size_t)(row - NLAT) * D + col;
                   }
                   const float4 x0 = *(const float4*)xr, x1 = *(const float4*)(xr + 4), g0 = *(const float4*)gr, g1 = *(const float4*)(gr + 4);
                   float4 r0, r1;
                   r0.x = ALPHA * x0.x + g0.x * v[0]; r0.y = ALPHA * x0.y + g0.y * v[1]; r0.z = ALPHA * x0.z + g0.z * v[2]; r0.w = ALPHA * x0.w + g0.w * v[3];
                   r1.x = ALPHA * x1.x + g1.x * u[0]; r1.y = ALPHA * x1.y + g1.y * u[1]; r1.z = ALPHA * x1.z + g1.z * u[2]; r1.w = ALPHA * x1.w + g1.w * u[3];
                   *(float4*)dr = r0; *(float4*)(dr + 4) = r1;
                 });
    } else if (lp == 7) { if (PHMASK & 128) { LCX; phase_finln(p, c2, l); } }
  }
}

constexpr int NPHASES = PH_NSTEPS;

extern "C" void kernel_launch(void* const* d_in, const int* in_sizes, int n_in, void* d_out, int out_size, void* d_ws, size_t ws_size,
                              hipStream_t stream) {
  static int grid_blocks = 0;
  if (grid_blocks == 0) {
    if (n_in != 32 || ws_size < WS_END) { fprintf(stderr, "kernel_launch: unexpected n_in %d / ws %zu (need %zu)\n", n_in, ws_size, (size_t)WS_END); grid_blocks = -1; return; }
    int dev = 0, cus = 0, per_cu = 0;
    hipGetDevice(&dev);
    hipDeviceGetAttribute(&cus, hipDeviceAttributeMultiprocessorCount, dev);
    if (hipFuncSetAttribute((const void*)mega_fwd, hipFuncAttributeMaxDynamicSharedMemorySize, LDS_BYTES) != hipSuccess) { fprintf(stderr, "hipFuncSetAttribute failed\n"); grid_blocks = -1; return; }
    if (hipOccupancyMaxActiveBlocksPerMultiprocessor(&per_cu, (const void*)mega_fwd, NTHREADS, LDS_BYTES) != hipSuccess || per_cu < 1) {
      fprintf(stderr, "occupancy query gave %d\n", per_cu); (void)hipGetLastError(); per_cu = 1;
    }
    grid_blocks = cus * per_cu;
  }
  if (grid_blocks < 0) return;
  Params p{};
  const float** pp = (const float**)&p;
  for (int i = 0; i < 32; ++i) pp[i] = (const float*)d_in[i];
  p.out = (float*)d_out;
  p.ws = (char*)d_ws;
  int ph0 = 0, ph1 = NPHASES;
  void* args[] = {&p, &ph0, &ph1};
  hipError_t e = hipLaunchCooperativeKernel((const void*)mega_fwd, dim3(grid_blocks), dim3(NTHREADS), args, LDS_BYTES, stream);
  if (e != hipSuccess) fprintf(stderr, "cooperative launch failed: %s (grid %d)\n", hipGetErrorString(e), grid_blocks);
}
```

```cpp
#include <hip/hip_runtime.h>
#include <hip/hip_cooperative_groups.h>
#include <cstdio>
namespace cg = cooperative_groups;

typedef unsigned short bf16_t;
typedef _Float16 h16;
using bf16x8 = __attribute__((ext_vector_type(8))) _Float16;
using f32x4 = __attribute__((ext_vector_type(4))) float;
using h16x4 = __attribute__((ext_vector_type(4))) _Float16;
using h16x8 = __attribute__((ext_vector_type(8))) _Float16;

#define DEV __device__ __forceinline__

constexpr int D = 2048, NLAT = 32768, MTOT = 33280, ZR = 3072, ZC = 3328;
constexpr int NTHREADS = 512;
constexpr int LDS_BYTES = 147456;
constexpr float ALPHA = 1.41421356237f;
constexpr float DECAY_SCALE = 0.606531f;

constexpr size_t al256(size_t x) { return (x + 255) & ~size_t(255); }
constexpr size_t ARR = (size_t)MTOT * 1024;
constexpr size_t OFF_MODS = 0;
constexpr size_t OFF_S5F = al256(OFF_MODS + 2 * 3 * 6144 * 4);
constexpr size_t OFF_PREC = al256(OFF_S5F + (size_t)2 * 32 * 65 * 2 * 64 * 8);
constexpr size_t OFF_WT = al256(OFF_PREC + (size_t)512 * 2048 * 4);
constexpr size_t WT_IN = 0, WT_OUT = 26214400, WT_W2 = 34603008, WT_A2 = 34865152, WT_POOL = 35127296, WT_GLU = 35258368, WT_SIZE = 35782656;
constexpr size_t OFF_ZREST = al256(OFF_WT + 2 * WT_SIZE);
constexpr size_t OFF_REG2 = al256(OFF_ZREST + (size_t)MTOT * ZR * 2);
constexpr size_t OFF_S5Y = OFF_REG2 + 2 * ARR * 2;
constexpr size_t OFF_SCAN = al256(OFF_REG2 + (size_t)MTOT * ZC * 2);
constexpr size_t OFF_H = OFF_SCAN;
constexpr size_t OFF_YM = OFF_SCAN + 6 * ARR * 2;
constexpr size_t WS_END = OFF_SCAN + 8 * ARR * 2;

#ifndef PH_SEQ
#define PH_SEQ 0xDCBA9876543210ull
#define PH_NSTEPS 14
#endif
struct Params {
  const float *x, *c, *ctx, *c_ctx, *w_ada, *b_ada, *w_in, *conv_rkv, *s5_lam_re, *s5_lam_im, *s5_log_step,
      *s5_b_re, *s5_b_im, *s5_c_re, *s5_c_im, *s5_d, *w_glu, *b_glu, *w_pool, *pool_scale,
      *rwkv_w0, *rwkv_w2, *rwkv_a0, *rwkv_a2, *rwkv_k_k, *rwkv_k_a, *rwkv_r_k, *gn_w, *gn_b,
      *w_out, *ln_g, *ln_b;
  float* out;
  char* ws;
};
struct Ctx { int tid, bid, nblk; };

DEV float rcp_f(float x) { return __builtin_amdgcn_rcpf(x); }
DEV float sigmoid_f(float x) { return rcp_f(1.f + __expf(-x)); }
DEV float silu_f(float x) { return x * rcp_f(1.f + __expf(-x)); }
DEV float tanh_f(float x) { float e = __expf(2.f * x); return 1.f - 2.f * rcp_f(e + 1.f); }
DEV float gelu_f(float y) { return 0.5f * y * (1.f + tanh_f(0.7978845608f * (y + 0.044715f * y * y * y))); }
using h16x2 = __attribute__((ext_vector_type(2))) _Float16;
DEV unsigned pack_bf2(float a, float b) { h16x2 v = {(h16)a, (h16)b}; return __builtin_bit_cast(unsigned, v); }
template <int CTRL> DEV float dpp_mov(float v) {
  return __int_as_float(__builtin_amdgcn_update_dpp(0, __float_as_int(v), CTRL, 0xf, 0xf, true));
}
DEV float allreduce16(float v) {
  v += dpp_mov<0xB1>(v);
  v += dpp_mov<0x4E>(v);
  v += dpp_mov<0x141>(v);
  v += dpp_mov<0x140>(v);
  return v;
}
DEV float wave_sum(float v) {
  v = allreduce16(v);
  return __builtin_amdgcn_readlane(__float_as_int(v), 0) == 0 && false ? 0.f :
         __int_as_float(__builtin_amdgcn_readlane(__float_as_int(v), 0)) + __int_as_float(__builtin_amdgcn_readlane(__float_as_int(v), 16)) +
         __int_as_float(__builtin_amdgcn_readlane(__float_as_int(v), 32)) + __int_as_float(__builtin_amdgcn_readlane(__float_as_int(v), 48));
}
DEV float allreduce8(float v) {
  v += dpp_mov<0xB1>(v);
  v += dpp_mov<0x4E>(v);
  v += dpp_mov<0x141>(v);
  return v;
}
DEV void lds_fence() { asm volatile("s_waitcnt lgkmcnt(0)" ::: "memory"); }

DEV void p0_mods_item(const Params& p, const Ctx& cx, int item, char* smem) {
  float* red = (float*)smem;
  float* mods = (float*)(p.ws + OFF_MODS);
  int l = item / 96, chunk = item % 96;
  int tid = cx.tid, kq = tid >> 6, col = tid & 63;
  int n = chunk * 64 + col;
  const float* W = p.w_ada + (size_t)l * 2048 * 6144;
  float a0 = 0, a1 = 0, a2 = 0;
#pragma unroll 8
  for (int k = kq; k < 2048; k += 8) {
    float w = W[(size_t)k * 6144 + n];
    a0 += silu_f(p.c[k]) * w;
    a1 += silu_f(p.c[2048 + k]) * w;
    a2 += silu_f(p.c_ctx[k]) * w;
  }
  red[(kq * 3 + 0) * 64 + col] = a0;
  red[(kq * 3 + 1) * 64 + col] = a1;
  red[(kq * 3 + 2) * 64 + col] = a2;
  __syncthreads();
  if (tid < 192) {
    int r = tid >> 6, cc = tid & 63;
    float s = 0;
#pragma unroll
    for (int q = 0; q < 8; ++q) s += red[(q * 3 + r) * 64 + cc];
    mods[(size_t)(l * 3 + r) * 6144 + chunk * 64 + cc] = s + p.b_ada[(size_t)l * 6144 + chunk * 64 + cc];
  }
}

DEV void p0_transpose_tile(const Params& p, const Ctx& cx, const float* __restrict__ src, bf16_t* __restrict__ dst, int K, int N, int tk, int tn, char* smem) {
  float* T = (float*)smem;
  int tid = cx.tid;
  int k0 = tk * 64, n0 = tn * 64;
  int kk = tid >> 4, n4 = tid & 15;
#pragma unroll
  for (int i = 0; i < 2; ++i) {
    int k = kk + 32 * i;
    float4 v = *(const float4*)(src + (size_t)(k0 + k) * N + n0 + n4 * 4);
    T[k * 65 + n4 * 4 + 0] = v.x; T[k * 65 + n4 * 4 + 1] = v.y; T[k * 65 + n4 * 4 + 2] = v.z; T[k * 65 + n4 * 4 + 3] = v.w;
  }
  __syncthreads();
  int n = tid >> 3, k8 = tid & 7;
  uint4 o;
  o.x = pack_bf2(T[(k8 * 8 + 0) * 65 + n], T[(k8 * 8 + 1) * 65 + n]);
  o.y = pack_bf2(T[(k8 * 8 + 2) * 65 + n], T[(k8 * 8 + 3) * 65 + n]);
  o.z = pack_bf2(T[(k8 * 8 + 4) * 65 + n], T[(k8 * 8 + 5) * 65 + n]);
  o.w = pack_bf2(T[(k8 * 8 + 6) * 65 + n], T[(k8 * 8 + 7) * 65 + n]);
  *(uint4*)(dst + (size_t)(n0 + n) * K + k0 + k8 * 8) = o;
}

DEV void phase0(const Params& p, const Ctx& cx0, char* smem) {
  const int NTR = 4368;
  const int total = 192 + 2 * NTR;
  for (int item = cx0.bid; item < total; item += cx0.nblk) {
    __syncthreads();
    Ctx cx = cx0; asm volatile("" : "+v"(cx.tid));
    if (item < 192) { p0_mods_item(p, cx, item, smem); continue; }
    int it = item - 192;
    int l = it / NTR, i = it % NTR;
    char* wt = p.ws + OFF_WT + (size_t)l * WT_SIZE;
    if (i < 3200) {
      p0_transpose_tile(p, cx, p.w_in + (size_t)l * 2048 * 6400, (bf16_t*)(wt + WT_IN), 2048, 6400, i / 100, i % 100, smem);
    } else if (i < 4224) {
      int j = i - 3200;
      p0_transpose_tile(p, cx, p.w_out + (size_t)l * 2048 * 2048, (bf16_t*)(wt + WT_OUT), 2048, 2048, j / 32, j % 32, smem);
    } else if (i < 4256) {
      int j = i - 4224, d = j / 16;
      p0_transpose_tile(p, cx, p.rwkv_w2 + (size_t)(l * 2 + d) * 64 * 1024, (bf16_t*)(wt + WT_W2) + (size_t)d * 1024 * 64, 64, 1024, 0, j % 16, smem);
    } else if (i < 4288) {
      int j = i - 4256, d = j / 16;
      p0_transpose_tile(p, cx, p.rwkv_a2 + (size_t)(l * 2 + d) * 64 * 1024, (bf16_t*)(wt + WT_A2) + (size_t)d * 1024 * 64, 64, 1024, 0, j % 16, smem);
    } else if (i < 4304) {
      int j = i - 4288, g = j / 4;
      p0_transpose_tile(p, cx, p.w_pool + (size_t)(l * 4 + g) * 128 * 128, (bf16_t*)(wt + WT_POOL) + (size_t)g * 128 * 128, 128, 128, (j % 4) / 2, j % 2, smem);
    } else {
      int j = i - 4304;
      p0_transpose_tile(p, cx, p.w_glu + (size_t)l * 512 * 512, (bf16_t*)(wt + WT_GLU), 512, 512, j / 8, j % 8, smem);
    }
  }
}

DEV void phase_adaln0(const Params& p, const Ctx& cx) {
  const float* mods = (const float*)(p.ws + OFF_MODS);
  bf16_t* hbuf = (bf16_t*)(p.ws + OFF_H);
  int lane = cx.tid & 63;
  int gw = cx.bid * 8 + (cx.tid >> 6), nw = cx.nblk * 8;
  for (int row = gw; row < MTOT; row += nw) {
    const float* src = row < NLAT ? p.x + (size_t)row * D : p.ctx + (size_t)(row - NLAT) * D;
    int mr = row < NLAT ? (row >> 14) : 2;
    const float* md = mods + (size_t)mr * 6144;
    float4 v[8];
    float s = 0;
#pragma unroll
    for (int i = 0; i < 8; ++i) { v[i] = *(const float4*)(src + i * 256 + lane * 4); s += v[i].x + v[i].y + v[i].z + v[i].w; }
    float mu = wave_sum(s) * (1.f / 2048.f);
    float q = 0;
#pragma unroll
    for (int i = 0; i < 8; ++i) { v[i].x -= mu; v[i].y -= mu; v[i].z -= mu; v[i].w -= mu; q += v[i].x * v[i].x + v[i].y * v[i].y + v[i].z * v[i].z + v[i].w * v[i].w; }
    float rstd = rsqrtf(wave_sum(q) * (1.f / 2048.f) + 1e-6f);
#pragma unroll
    for (int i = 0; i < 8; ++i) {
      int col = i * 256 + lane * 4;
      float4 sh = *(const float4*)(md + col), sc = *(const float4*)(md + 2048 + col);
      uint2 o;
      o.x = pack_bf2(v[i].x * rstd * (1.f + sc.x) + sh.x, v[i].y * rstd * (1.f + sc.y) + sh.y);
      o.y = pack_bf2(v[i].z * rstd * (1.f + sc.z) + sh.z, v[i].w * rstd * (1.f + sc.w) + sh.w);
      *(uint2*)(hbuf + (size_t)row * D + col) = o;
    }
  }
}

DEV void phase_finln(const Params& p, const Ctx& cx, int l) {
  const float* mods = (const float*)(p.ws + OFF_MODS);
  bf16_t* hbuf = (bf16_t*)(p.ws + OFF_H);
  float* prec = (float*)(p.ws + OFF_PREC);
  int lane = cx.tid & 63;
  int gw = cx.bid * 8 + (cx.tid >> 6), nw = cx.nblk * 8;
  const int nrows = (l == 0) ? MTOT : NLAT;
  for (int row = gw; row < nrows; row += nw) {
    float* src = row < NLAT ? p.out + (size_t)row * D : prec + (size_t)(row - NLAT) * D;
    float4 v[8];
    float s = 0;
#pragma unroll
    for (int i = 0; i < 8; ++i) { v[i] = *(const float4*)(src + i * 256 + lane * 4); s += v[i].x + v[i].y + v[i].z + v[i].w; }
    float mu = wave_sum(s) * (1.f / 2048.f);
    float q = 0;
#pragma unroll
    for (int i = 0; i < 8; ++i) { v[i].x -= mu; v[i].y -= mu; v[i].z -= mu; v[i].w -= mu; q += v[i].x * v[i].x + v[i].y * v[i].y + v[i].z * v[i].z + v[i].w * v[i].w; }
    float rstd = rsqrtf(wave_sum(q) * (1.f / 2048.f) + 1e-5f);
    float s2 = 0;
#pragma unroll
    for (int i = 0; i < 8; ++i) {
      int col = i * 256 + lane * 4;
      float4 g = *(const float4*)(p.ln_g + (size_t)l * D + col), b = *(const float4*)(p.ln_b + (size_t)l * D + col);
      v[i].x = v[i].x * rstd * g.x + b.x; v[i].y = v[i].y * rstd * g.y + b.y; v[i].z = v[i].z * rstd * g.z + b.z; v[i].w = v[i].w * rstd * g.w + b.w;
      if (row < NLAT) *(float4*)(src + col) = v[i];
      s2 += v[i].x + v[i].y + v[i].z + v[i].w;
    }
    if (l == 0) {
      int mr = row < NLAT ? (row >> 14) : 2;
      const float* md = mods + (size_t)(3 + mr) * 6144;
      float mu2 = wave_sum(s2) * (1.f / 2048.f);
      float q2 = 0;
#pragma unroll
      for (int i = 0; i < 8; ++i) { v[i].x -= mu2; v[i].y -= mu2; v[i].z -= mu2; v[i].w -= mu2; q2 += v[i].x * v[i].x + v[i].y * v[i].y + v[i].z * v[i].z + v[i].w * v[i].w; }
      float rstd2 = rsqrtf(wave_sum(q2) * (1.f / 2048.f) + 1e-6f);
#pragma unroll
      for (int i = 0; i < 8; ++i) {
        int col = i * 256 + lane * 4;
        float4 sh = *(const float4*)(md + col), sc = *(const float4*)(md + 2048 + col);
        uint2 o;
        o.x = pack_bf2(v[i].x * rstd2 * (1.f + sc.x) + sh.x, v[i].y * rstd2 * (1.f + sc.y) + sh.y);
        o.y = pack_bf2(v[i].z * rstd2 * (1.f + sc.z) + sh.z, v[i].w * rstd2 * (1.f + sc.w) + sh.w);
        *(uint2*)(hbuf + (size_t)row * D + col) = o;
      }
    }
  }
}

template <class Epi>
DEV void gemm_phase(const Params& p, const Ctx& cx, const bf16_t* __restrict__ A, const bf16_t* __restrict__ Bt, int K, int nM, int nN, char* smem, Epi epi) {
  const int tid = cx.tid, lane = tid & 63, wid = tid >> 6;
  const int wr = wid >> 2, wc = wid & 3, fr = lane & 15, fq = lane >> 4;
  const int nt = K / 64;
  const int ntiles = nM * nN;
  const int srow = tid >> 3, sc16 = tid & 7;
  const int nxcd = (cx.nblk & 7) == 0 ? 8 : 1;
  const int xcd = cx.bid % nxcd, xidx = cx.bid / nxcd, xper = cx.nblk / nxcd;
  const int t_lo = (int)(((long)ntiles * xcd) / nxcd), t_hi = (int)(((long)ntiles * (xcd + 1)) / nxcd);
  for (int tt = t_lo + xidx; tt < t_hi; tt += xper) {
    const int band = tt / (16 * nN);
    const int brows = min(16, nM - band * 16);
    const int rem = tt - band * 16 * nN;
    const int pn = rem / brows, pm = band * 16 + rem % brows;
    const int brow = pm * 256, bcol = pn * 256;
    const char* Ab = (const char*)(A + (size_t)brow * K);
    const char* Bb = (const char*)(Bt + (size_t)bcol * K);
    const unsigned voff = (unsigned)(srow * K + sc16 * 8) * 2u;
    const size_t rs = (size_t)64 * K * 2;
    f32x4 acc[8][4];
#pragma unroll
    for (int i = 0; i < 8; ++i)
#pragma unroll
      for (int j = 0; j < 4; ++j) acc[i][j] = f32x4{0.f, 0.f, 0.f, 0.f};
    uint4 ra0, ra1, ra2, ra3, rb0, rb1, rb2, rb3;
#define G_LD(ko) { const char* a_ = Ab + (size_t)(ko) * 2; const char* b_ = Bb + (size_t)(ko) * 2; \
                 ra0 = *(const uint4*)(a_ + voff); ra1 = *(const uint4*)(a_ + rs + voff); ra2 = *(const uint4*)(a_ + 2 * rs + voff); ra3 = *(const uint4*)(a_ + 3 * rs + voff); \
                 rb0 = *(const uint4*)(b_ + voff); rb1 = *(const uint4*)(b_ + rs + voff); rb2 = *(const uint4*)(b_ + 2 * rs + voff); rb3 = *(const uint4*)(b_ + 3 * rs + voff); }
#define G_ST(sp) { *(uint4*)(sp) = ra0; *(uint4*)((sp) + 64 * 144) = ra1; *(uint4*)((sp) + 128 * 144) = ra2; *(uint4*)((sp) + 192 * 144) = ra3; \
                 *(uint4*)((sp) + 36864) = rb0; *(uint4*)((sp) + 36864 + 64 * 144) = rb1; *(uint4*)((sp) + 36864 + 128 * 144) = rb2; *(uint4*)((sp) + 36864 + 192 * 144) = rb3; }
    char* const sbase = smem + srow * 144 + sc16 * 16;
    G_LD(0);
    G_ST(sbase);
    if (nt > 1) G_LD(64);
    for (int kt = 0; kt < nt; ++kt) {
      __syncthreads();
      if (kt + 1 < nt) { char* s1 = sbase + ((kt + 1) & 1) * 73728; G_ST(s1); }
      if (kt + 2 < nt) G_LD((kt + 2) * 64);
      const char* As = smem + (kt & 1) * 73728;
      const char* Bs = As + 36864;
#pragma unroll
      for (int kh = 0; kh < 2; ++kh) {
        bf16x8 bfr[4];
#pragma unroll
        for (int jn = 0; jn < 4; ++jn) bfr[jn] = *(const bf16x8*)(Bs + (wc * 64 + jn * 16 + fr) * 144 + kh * 64 + fq * 16);
#pragma unroll
        for (int i = 0; i < 8; ++i) {
          bf16x8 af = *(const bf16x8*)(As + (wr * 128 + i * 16 + fr) * 144 + kh * 64 + fq * 16);
#pragma unroll
          for (int jn = 0; jn < 4; ++jn) acc[i][jn] = __builtin_amdgcn_mfma_f32_16x16x32_f16(bfr[jn], af, acc[i][jn], 0, 0, 0);
        }
      }
    }
    __syncthreads();
#pragma unroll
    for (int i = 0; i < 8; ++i)
#pragma unroll
      for (int jn = 0; jn < 4; ++jn) epi(brow + wr * 128 + i * 16 + fr, bcol + wc * 64 + jn * 16 + fq * 4, acc[i][jn]);
  }
}

#define LAS3 __attribute__((address_space(3)))
DEV int g2_lds_byte(int r, int c) { const int st = (r >> 4) * 2 + (c >> 5), rr = r & 15, cc = c & 31, ob = rr * 64 + cc * 2; return st * 1024 + (ob ^ (((ob >> 9) & 1) << 5)); }
DEV void g2_stage_rc(int b, int& R, int& C) { const int st = b / 1024, sb = b % 1024, swz = sb ^ (((sb >> 9) & 1) << 5); R = (st >> 1) * 16 + swz / 64; C = (st & 1) * 32 + (swz % 64) / 2; }

template <class Epi>
DEV void gemm_phase2(const Params& p, const Ctx& cx, const bf16_t* __restrict__ A, const bf16_t* __restrict__ Bt, int K, int nM, int nN, char* smem, Epi epi) {
  constexpr int HTB = 128 * 64 * 2;
  LAS3 unsigned char* lds = (LAS3 unsigned char*)smem;
  const int tid = cx.tid, wid = __builtin_amdgcn_readfirstlane(tid >> 6), lane = tid & 63, wr = wid >> 2, wc = wid & 3, fr = lane & 15, fq = lane >> 4;
  const int nt = K / 64;
  const int ntiles = nM * nN;
  const int nxcd = (cx.nblk & 7) == 0 ? 8 : 1;
  const int xcd = cx.bid % nxcd, xidx = cx.bid / nxcd, xper = cx.nblk / nxcd;
  const int t_lo = (int)(((long)ntiles * xcd) / nxcd), t_hi = (int)(((long)ntiles * (xcd + 1)) / nxcd);
  auto unit_at = [&](int i, int& pm, int& pn) -> bool {
    const int tt = t_lo + xidx + i * xper;
    if (tt >= t_hi) return false;
    const int band = tt / (8 * nN);
    const int brows = min(8, nM - band * 8);
    const int rem = tt - band * 8 * nN;
    pn = rem / brows; pm = band * 8 + rem % brows;
    return true;
  };
  unsigned voffA[2], voffB[2];
#pragma unroll
  for (int i = 0; i < 2; ++i) {
    int R, C; g2_stage_rc(tid * 16 + i * 8192, R, C);
    const int rho = R & 31, Rb = (R & ~31) + 8 * ((rho & 15) >> 2) + 4 * (rho >> 4) + (rho & 3);
    voffA[i] = (unsigned)(R * K + C) * 2u; voffB[i] = (unsigned)(Rb * K + C) * 2u;
  }
  const size_t kstep = (size_t)(64 * 2);
  const size_t hstep = (size_t)128 * K * 2;
  const size_t tstep = 2 * hstep;
  const unsigned ldsw = (unsigned)wid * 1024u;
  const int aoff = g2_lds_byte(wr * 64 + fr, fq * 8), boff = g2_lds_byte(wc * 32 + fr, fq * 8);
#define G2_SA(b, h) (((b) * 2 + (h)) * HTB)
#define G2_SB(b, h) ((4 + (b) * 2 + (h)) * HTB)
#define G2_STAGE_(bufoff, gbase, vo_) do { _Pragma("unroll") for (int _i = 0; _i < 2; ++_i) \
    __builtin_amdgcn_global_load_lds((const unsigned*)((const char*)(gbase) + vo_[_i]), (LAS3 unsigned*)(lds + (bufoff) + ldsw + _i * 8192), 16, 0, 0); } while (0)
#define G2_STAGE(bufoff, gbase) G2_STAGE_(bufoff, gbase, voffA)
#define G2_STAGEB(bufoff, gbase) G2_STAGE_(bufoff, gbase, voffB)
#define G2_LDA(dst, b, h) do { _Pragma("unroll") for (int m = 0; m < 4; ++m) _Pragma("unroll") for (int k = 0; k < 2; ++k) dst[m][k] = *(const LAS3 bf16x8*)(lds + G2_SA(b, h) + aoff + m * 2048 + k * 1024); } while (0)
#define G2_LDB(dst, b, h) do { _Pragma("unroll") for (int n = 0; n < 2; ++n) _Pragma("unroll") for (int k = 0; k < 2; ++k) dst[n][k] = *(const LAS3 bf16x8*)(lds + G2_SB(b, h) + boff + n * 2048 + k * 1024); } while (0)
#define G2_MMA(ai, bj, At_, Bt_) do { __builtin_amdgcn_s_setprio(1); _Pragma("unroll") for (int m = 0; m < 4; ++m) _Pragma("unroll") for (int n = 0; n < 2; ++n) _Pragma("unroll") for (int k = 0; k < 2; ++k) \
    acc[ai][bj][m][n] = __builtin_amdgcn_mfma_f32_16x16x32_f16(Bt_[n][k], At_[m][k], acc[ai][bj][m][n], 0, 0, 0); __builtin_amdgcn_s_setprio(0); } while (0)
#define G2_WAIT_V(n) asm volatile("s_waitcnt vmcnt(" #n ")" ::: "memory")
#define G2_WAIT_L(n) asm volatile("s_waitcnt lgkmcnt(" #n ")" ::: "memory")
#define G2_BAR __builtin_amdgcn_s_barrier()
#define G2_SCHED __builtin_amdgcn_sched_barrier(0)
  int cpm, cpn, npm = 0, npn = 0, ui = 0;
  if (!unit_at(0, cpm, cpn)) return;
  f32x4 acc[2][2][4][2];
#pragma unroll
  for (int a = 0; a < 2; ++a)
#pragma unroll
    for (int b = 0; b < 2; ++b)
#pragma unroll
      for (int m = 0; m < 4; ++m)
#pragma unroll
        for (int n = 0; n < 2; ++n) acc[a][b][m][n] = f32x4{0.f, 0.f, 0.f, 0.f};
  bf16x8 At[4][2], B0[2][2], B1[2][2];
  const char* cA = (const char*)A + (size_t)cpm * tstep;
  const char* cB = (const char*)Bt + (size_t)cpn * tstep;
  G2_STAGEB(G2_SB(0, 0), cB); G2_STAGE(G2_SA(0, 0), cA); G2_STAGEB(G2_SB(0, 1), cB + hstep); G2_STAGE(G2_SA(0, 1), cA + hstep);
  if (wr == 1) G2_BAR;
  G2_WAIT_V(4); G2_BAR;
  G2_STAGEB(G2_SB(1, 0), cB + kstep); G2_STAGE(G2_SA(1, 0), cA + kstep); G2_STAGEB(G2_SB(1, 1), cB + hstep + kstep);
  G2_WAIT_V(6); G2_BAR;
  for (;;) {
    const bool has_next = unit_at(ui + 1, npm, npn);
    const char* nA = has_next ? (const char*)A + (size_t)npm * tstep : cA;
    const char* nB = has_next ? (const char*)Bt + (size_t)npn * tstep : cB;
    for (int t = 0; t < nt; t += 2) {
      const bool last = (t == nt - 2);
      const char* a1 = cA + (size_t)(t + 1) * kstep;
      const char* a2 = last ? nA : cA + (size_t)(t + 2) * kstep;
      const char* b2 = last ? nB : cB + (size_t)(t + 2) * kstep;
      const char* a3 = a2 + kstep;
      const char* b3 = b2 + kstep;
      G2_LDB(B0, 0, 0); G2_SCHED; G2_LDA(At, 0, 0); G2_STAGE(G2_SA(1, 1), a1 + hstep);
      G2_WAIT_L(8); G2_BAR; G2_WAIT_L(0); G2_MMA(0, 0, At, B0); G2_BAR; G2_SCHED;
      G2_LDB(B1, 0, 1); G2_STAGEB(G2_SB(0, 0), b2);
      G2_BAR; G2_WAIT_L(0); G2_MMA(0, 1, At, B1); G2_BAR;
      G2_LDA(At, 0, 1); G2_STAGE(G2_SA(0, 0), a2);
      G2_BAR; G2_WAIT_L(0); G2_MMA(1, 0, At, B0); G2_BAR; G2_SCHED;
      G2_STAGEB(G2_SB(0, 1), b2 + hstep);
      G2_WAIT_V(6); G2_BAR; G2_MMA(1, 1, At, B1); G2_BAR;
      G2_LDB(B0, 1, 0); G2_SCHED; G2_LDA(At, 1, 0); G2_STAGE(G2_SA(0, 1), a2 + hstep);
      G2_WAIT_L(8); G2_BAR; G2_WAIT_L(0); G2_MMA(0, 0, At, B0); G2_BAR; G2_SCHED;
      G2_LDB(B1, 1, 1); G2_STAGEB(G2_SB(1, 0), b3);
      G2_BAR; G2_WAIT_L(0); G2_MMA(0, 1, At, B1); G2_BAR;
      G2_LDA(At, 1, 1); G2_STAGE(G2_SA(1, 0), a3);
      G2_BAR; G2_WAIT_L(0); G2_MMA(1, 0, At, B0); G2_BAR; G2_SCHED;
      G2_STAGEB(G2_SB(1, 1), b3 + hstep);
      G2_WAIT_V(6); G2_BAR; G2_MMA(1, 1, At, B1); G2_BAR;
    }
    {
      const int row0 = cpm * 256 + wr * 64 + fr, col0 = cpn * 256 + wc * 32 + 8 * fq;
#pragma unroll
      for (int ai = 0; ai < 2; ++ai)
#pragma unroll
        for (int m = 0; m < 4; ++m)
#pragma unroll
          for (int bj = 0; bj < 2; ++bj) epi(row0 + ai * 128 + m * 16, col0 + bj * 128, acc[ai][bj][m][0], acc[ai][bj][m][1]);
    }
    if (!has_next) break;
#pragma unroll
    for (int a = 0; a < 2; ++a)
#pragma unroll
      for (int b = 0; b < 2; ++b)
#pragma unroll
        for (int m = 0; m < 4; ++m)
#pragma unroll
          for (int n = 0; n < 2; ++n) acc[a][b][m][n] = f32x4{0.f, 0.f, 0.f, 0.f};
    cpm = npm; cpn = npn; cA = nA; cB = nB; ++ui;
  }
  G2_WAIT_V(0);
  if (wr == 0) G2_BAR;
  G2_BAR;
#undef G2_SA
#undef G2_SB
#undef G2_STAGE
#undef G2_STAGEB
#undef G2_STAGE_
#undef G2_LDA
#undef G2_LDB
#undef G2_MMA
#undef G2_WAIT_V
#undef G2_WAIT_L
#undef G2_BAR
#undef G2_SCHED
}

template <int K, int NT, class Epi>
DEV void small_gemm(const Params& p, const Ctx& cx, const char* As, int astride, const bf16_t* __restrict__ Bt, int n0, Epi epi) {
  const int lane = cx.tid & 63, fr = lane & 15, fq = lane >> 4;
  f32x4 acc[4][NT];
#pragma unroll
  for (int i = 0; i < 4; ++i)
#pragma unroll
    for (int j = 0; j < NT; ++j) acc[i][j] = f32x4{0.f, 0.f, 0.f, 0.f};
#pragma unroll 2
  for (int k0 = 0; k0 < K; k0 += 32) {
    bf16x8 af[4];
#pragma unroll
    for (int i = 0; i < 4; ++i) af[i] = *(const bf16x8*)(As + (i * 16 + fr) * astride + (k0 + fq * 8) * 2);
#pragma unroll
    for (int jn = 0; jn < NT; ++jn) {
      bf16x8 bf = *(const bf16x8*)(Bt + (size_t)(n0 + jn * 16 + fr) * K + k0 + fq * 8);
#pragma unroll
      for (int i = 0; i < 4; ++i) acc[i][jn] = __builtin_amdgcn_mfma_f32_16x16x32_f16(bf, af[i], acc[i][jn], 0, 0, 0);
    }
  }
#pragma unroll
  for (int i = 0; i < 4; ++i)
#pragma unroll
    for (int jn = 0; jn < NT; ++jn) epi(i * 16 + fr, n0 + jn * 16 + fq * 4, acc[i][jn]);
}

struct S5P { float ar, ai, br, bi; };
DEV S5P s5_params(const Params& p, const Ctx& cx, int l, int d, int g, int lane) {
  int idx = ((l * 2 + d) * 32 + g) * 64 + lane;
  float lr = fminf(p.s5_lam_re[idx], -1e-4f), li = p.s5_lam_im[idx];
  float step = expf(p.s5_log_step[(l * 2 + d) * 32 + g]);
  float xr = lr * step, xi = li * step;
  float e = expf(xr), cs = cosf(xi), sn = sinf(xi);
  S5P r;
  r.ar = e * cs; r.ai = e * sn;
  float sh = sinf(0.5f * xi);
  float nr = expm1f(xr) * cs - 2.f * sh * sh, ni = e * sn;
  float inv = 1.f / (lr * lr + li * li);
  r.br = (nr * lr + ni * li) * inv;
  r.bi = (ni * lr - nr * li) * inv;
  return r;
}

DEV void s5_load_u(const h16* zrest, int rowbase, int g, char* ulds, int lane) {
#pragma unroll
  for (int i = 0; i < 8; ++i) {
    int e = i * 64 + lane;
    int r = e >> 1, hf = e & 1;
    uint4 v = *(const uint4*)(zrest + (size_t)(rowbase + r) * ZR + g * 16 + hf * 8);
    *(uint4*)(ulds + r * 32 + hf * 16) = v;
  }
  lds_fence();
}

DEV int s5_rowbase(int b, int c) { return c == 0 ? NLAT + b * 256 : b * 16384 + (c - 1) * 256; }

DEV void s5_pass1_unit(const Params& p, const Ctx& cx, int l, int unit, char* wl, int lane) {
  int c = unit % 65, bg = unit / 65, g = bg & 31, b = bg >> 5;
  const h16* zrest = (const h16*)(p.ws + OFF_ZREST);
  float2* F = (float2*)(p.ws + OFF_S5F);
  s5_load_u(zrest, s5_rowbase(b, c), g, wl, lane);
  float Br[16], Bi[16];
  {
    const float* pr = p.s5_b_re + ((size_t)(l * 32 + g) * 64 + lane) * 16;
    const float* pi = p.s5_b_im + ((size_t)(l * 32 + g) * 64 + lane) * 16;
#pragma unroll
    for (int i = 0; i < 16; i += 4) {
      float4 a = *(const float4*)(pr + i), bq = *(const float4*)(pi + i);
      Br[i] = a.x; Br[i + 1] = a.y; Br[i + 2] = a.z; Br[i + 3] = a.w;
      Bi[i] = bq.x; Bi[i + 1] = bq.y; Bi[i + 2] = bq.z; Bi[i + 3] = bq.w;
    }
  }
  S5P pf = s5_params(p, cx, l, 0, g, lane), pb = s5_params(p, cx, l, 1, g, lane);
  float xr = 0, xi = 0, yr = 0, yi = 0, pwr = 1.f, pwi = 0.f;
#pragma unroll 4
  for (int t = 0; t < 256; ++t) {
    h16x8 u0 = *(const h16x8*)(wl + t * 32), u1 = *(const h16x8*)(wl + t * 32 + 16);
    float br = 0, bi = 0;
#pragma unroll
    for (int i = 0; i < 8; ++i) { float u = (float)u0[i]; br = fmaf(u, Br[i], br); bi = fmaf(u, Bi[i], bi); }
#pragma unroll
    for (int i = 0; i < 8; ++i) { float u = (float)u1[i]; br = fmaf(u, Br[8 + i], br); bi = fmaf(u, Bi[8 + i], bi); }
    float nxr = pf.ar * xr - pf.ai * xi + br, nxi = pf.ar * xi + pf.ai * xr + bi;
    xr = nxr; xi = nxi;
    yr += pwr * br - pwi * bi; yi += pwr * bi + pwi * br;
    float npr = pwr * pb.ar - pwi * pb.ai, npi = pwr * pb.ai + pwi * pb.ar;
    pwr = npr; pwi = npi;
  }
  size_t fi = (((size_t)(b * 32 + g) * 65 + c) * 2) * 64 + lane;
  F[fi] = make_float2(pf.br * xr - pf.bi * xi, pf.br * xi + pf.bi * xr);
  F[fi + 64] = make_float2(pb.br * yr - pb.bi * yi, pb.br * yi + pb.bi * yr);
}

DEV void s5_pass3_unit(const Params& p, const Ctx& cx, int l, int unit, char* wl, int lane) {
  int c = unit % 65, bg = unit / 65, g = bg & 31, b = bg >> 5;
  const int fr = lane & 15, fq = lane >> 4;
  const h16* zrest = (const h16*)(p.ws + OFF_ZREST);
  const float2* F = (const float2*)(p.ws + OFF_S5F);
  float* S5Y = (float*)(p.ws + OFF_S5Y);
  const int rowbase = s5_rowbase(b, c);
  char* ulds = wl;
  char* tile = wl + 8192;
  s5_load_u(zrest, rowbase, g, ulds, lane);
  float Br[16], Bi[16];
  {
    const float* pr = p.s5_b_re + ((size_t)(l * 32 + g) * 64 + lane) * 16;
    const float* pi = p.s5_b_im + ((size_t)(l * 32 + g) * 64 + lane) * 16;
#pragma unroll
    for (int i = 0; i < 16; i += 4) {
      float4 a = *(const float4*)(pr + i), bq = *(const float4*)(pi + i);
      Br[i] = a.x; Br[i + 1] = a.y; Br[i + 2] = a.z; Br[i + 3] = a.w;
      Bi[i] = bq.x; Bi[i + 1] = bq.y; Bi[i + 2] = bq.z; Bi[i + 3] = bq.w;
    }
  }
  const float dsk = p.s5_d[(size_t)l * 512 + g * 16 + fr];
  const size_t fbase = ((size_t)(b * 32 + g) * 65) * 2 * 64 + lane;
#pragma unroll 1
  for (int d = 0; d < 2; ++d) {
    S5P pp = s5_params(p, cx, l, d, g, lane);
    float qr = pp.ar, qi = pp.ai;
#pragma unroll
    for (int i = 0; i < 8; ++i) { float t = qr * qr - qi * qi; qi = 2.f * qr * qi; qr = t; }
    float xr = 0, xi = 0;
    if (d == 0) {
      for (int cc = 0; cc < c; ++cc) {
        float2 f = F[fbase + (size_t)(cc * 2 + 0) * 64];
        float t = qr * xr - qi * xi + f.x; xi = qr * xi + qi * xr + f.y; xr = t;
      }
    } else if (c > 0) {
      float2 f0 = F[fbase + (size_t)(0 * 2 + 1) * 64];
      xr = f0.x; xi = f0.y;
      for (int cc = 64; cc > c; --cc) {
        float2 f = F[fbase + (size_t)(cc * 2 + 1) * 64];
        float t = qr * xr - qi * xi + f.x; xi = qr * xi + qi * xr + f.y; xr = t;
      }
    }
    bf16x8 chi[4], clo[4];
    {
      const float* cr = p.s5_c_re + ((size_t)((l * 2 + d) * 32 + g) * 16 + fr) * 64;
      const float* ci = p.s5_c_im + ((size_t)((l * 2 + d) * 32 + g) * 16 + fr) * 64;
#pragma unroll
      for (int ks = 0; ks < 4; ++ks) {
        float4 a = *(const float4*)(cr + ks * 16 + fq * 4), bq = *(const float4*)(ci + ks * 16 + fq * 4);
        float vals[8] = {a.x, -bq.x, a.y, -bq.y, a.z, -bq.z, a.w, -bq.w};
#pragma unroll
        for (int j = 0; j < 8; ++j) {
          h16 hh = (h16)vals[j];
          chi[ks][j] = hh;
          clo[ks][j] = (h16)(vals[j] - (float)hh);
        }
      }
    }
#pragma unroll 1
    for (int sb = 0; sb < 16; ++sb) {
      const int sub = d == 0 ? sb : 15 - sb;
#pragma unroll 4
      for (int q = 0; q < 16; ++q) {
        const int tt = d == 0 ? q : 15 - q;
        const int t = sub * 16 + tt;
        h16x8 u0 = *(const h16x8*)(ulds + t * 32), u1 = *(const h16x8*)(ulds + t * 32 + 16);
        float br = 0, bi = 0;
#pragma unroll
        for (int i = 0; i < 8; ++i) { float u = (float)u0[i]; br = fmaf(u, Br[i], br); bi = fmaf(u, Bi[i], bi); }
#pragma unroll
        for (int i = 0; i < 8; ++i) { float u = (float)u1[i]; br = fmaf(u, Br[8 + i], br); bi = fmaf(u, Bi[8 + i], bi); }
        float vr = pp.br * br - pp.bi * bi, vi = pp.br * bi + pp.bi * br;
        float nxr = pp.ar * xr - pp.ai * xi + vr, nxi = pp.ar * xi + pp.ai * xr + vi;
        xr = nxr; xi = nxi;
        h16x2 hv2 = {(h16)xr, (h16)xi};
        *(unsigned*)(tile + tt * 272 + lane * 4) = __builtin_bit_cast(unsigned, hv2);
      }
      lds_fence();
      f32x4 acc = f32x4{0.f, 0.f, 0.f, 0.f};
#pragma unroll
      for (int ks = 0; ks < 4; ++ks) {
        bf16x8 ah = *(const bf16x8*)(tile + fr * 272 + ks * 64 + fq * 16);
        acc = __builtin_amdgcn_mfma_f32_16x16x32_f16(ah, chi[ks], acc, 0, 0, 0);
        acc = __builtin_amdgcn_mfma_f32_16x16x32_f16(ah, clo[ks], acc, 0, 0, 0);
      }
      lds_fence();
#pragma unroll
      for (int r = 0; r < 4; ++r) {
        int tl = sub * 16 + fq * 4 + r;
        float* yp = S5Y + (size_t)(rowbase + tl) * 512 + g * 16 + fr;
        if (d == 0) {
          float u = (float)*(const h16*)(ulds + tl * 32 + fr * 2);
          *yp = acc[r] + dsk * u;
        } else {
          *yp = gelu_f(*yp + acc[r]);
        }
      }
    }
  }
}

DEV void prep_item(const Params& p, const Ctx& cx, int l, int item, char* smem) {
  const int tile = item >> 2, q = item & 3;
  const int row0 = tile * 64;
  const int tid = cx.tid;
  const h16* zc = (const h16*)(p.ws + OFF_REG2);
  h16* SC = (h16*)(p.ws + OFF_SCAN);
  const char* wt = p.ws + OFF_WT + (size_t)l * WT_SIZE;
  {
    const int d = q >> 1, isA = q & 1;
    const int coff = isA ? 3200 + d * 64 : 3072 + d * 64;
    int tok = tid >> 3, c8 = tid & 7;
    h16x8 cv = *(const h16x8*)(zc + (size_t)(row0 + tok) * ZC + coff + c8 * 8);
    float f[8];
#pragma unroll
    for (int j = 0; j < 8; ++j) { f[j] = (float)cv[j]; if (!isA) f[j] = tanh_f(f[j]); }
    uint4 o;
    o.x = pack_bf2(f[0], f[1]); o.y = pack_bf2(f[2], f[3]); o.z = pack_bf2(f[4], f[5]); o.w = pack_bf2(f[6], f[7]);
    *(uint4*)(smem + tok * 144 + c8 * 16) = o;
    __syncthreads();
    const bf16_t* Bt = (const bf16_t*)(wt + (isA ? WT_A2 : WT_W2)) + (size_t)d * 1024 * 64;
    const float* biasw = p.rwkv_w0 + (size_t)(l * 2 + d) * 1024;
    const float* biasa = p.rwkv_a0 + (size_t)(l * 2 + d) * 1024;
    h16* dst = SC + (size_t)(isA ? 4 + d : 6 + d) * ARR;
#pragma unroll 1
    for (int hf = 0; hf < 2; ++hf) small_gemm<64, 4>(p, cx, smem, 144, Bt, (tid >> 6) * 128 + hf * 64, [&](int m, int n, f32x4 v) {
      float4 bbw = *(const float4*)(biasw + n), bba = *(const float4*)(biasa + n);
      float4 bb = isA ? bba : bbw;
      float r0 = sigmoid_f(v[0] + bb.x), r1 = sigmoid_f(v[1] + bb.y), r2 = sigmoid_f(v[2] + bb.z), r3 = sigmoid_f(v[3] + bb.w);
      if (!isA) { r0 = __expf(-DECAY_SCALE * r0); r1 = __expf(-DECAY_SCALE * r1); r2 = __expf(-DECAY_SCALE * r2); r3 = __expf(-DECAY_SCALE * r3); }
      h16x4 o4 = {(h16)r0, (h16)r1, (h16)r2, (h16)r3};
      *(h16x4*)(dst + (size_t)(row0 + m) * 1024 + n) = o4;
    });
  }
  {
    const float* cw = p.conv_rkv + (size_t)l * 3 * 3072;
    const int grp = tid & 7, hh = (tid >> 3) & 3;
    const int c0 = (4 * q + hh) * 64 + grp * 8;
    float cwt[3][3][8];
#pragma unroll
    for (int s = 0; s < 3; ++s)
#pragma unroll
      for (int tp = 0; tp < 3; ++tp)
#pragma unroll
        for (int j = 0; j < 8; j += 4) {
          float4 a = *(const float4*)(cw + tp * 3072 + s * 1024 + c0 + j);
          cwt[s][tp][j] = a.x; cwt[s][tp][j + 1] = a.y; cwt[s][tp][j + 2] = a.z; cwt[s][tp][j + 3] = a.w;
        }
    float kkw[8];
#pragma unroll
    for (int j = 0; j < 8; j += 4) {
      float4 kq = *(const float4*)(p.rwkv_k_k + (size_t)l * 1024 + c0 + j);
      kkw[j] = kq.x; kkw[j + 1] = kq.y; kkw[j + 2] = kq.z; kkw[j + 3] = kq.w;
    }
#pragma unroll 1
    for (int it = 0; it < 4; ++it) {
      const int tok = (tid >> 5) + it * 16;
      const int row = row0 + tok;
      bool hasp, hasn;
      if (row < NLAT) { hasp = (row & 16383) != 0; hasn = (row & 16383) != 16383; }
      else { hasp = (row & 255) != 0; hasn = (row & 255) != 255; }
      const size_t off = (size_t)row * 1024 + c0;
      const h16* zp = zc + (size_t)row * ZC + c0;
      const h16* zpp = hasp ? zp - ZC : zp;
      const h16* zpn = hasn ? zp + ZC : zp;
      h16x8 cur[3], prv[3], nxt[3];
#pragma unroll
      for (int s = 0; s < 3; ++s) { cur[s] = *(const h16x8*)(zp + s * 1024); prv[s] = *(const h16x8*)(zpp + s * 1024); nxt[s] = *(const h16x8*)(zpn + s * 1024); }
      const float fp = hasp ? 1.f : 0.f, fn = hasn ? 1.f : 0.f;
      float kv[8];
#pragma unroll
      for (int s = 0; s < 3; ++s) {
        h16x8 o;
#pragma unroll
        for (int j = 0; j < 8; ++j) {
          float ov = cwt[s][0][j] * (fp * (float)prv[s][j]) + cwt[s][1][j] * (float)cur[s][j] + cwt[s][2][j] * (fn * (float)nxt[s][j]);
          o[j] = (h16)ov;
          if (s == 1) kv[j] = ov;
        }
        *(h16x8*)(SC + (size_t)s * ARR + off) = o;
      }
      float kk[8], ss = 0;
#pragma unroll
      for (int j = 0; j < 8; ++j) { kk[j] = kv[j] * kkw[j]; ss += kk[j] * kk[j]; }
      ss = allreduce8(ss);
      float inv = rcp_f(fmaxf(sqrtf(ss), 1e-12f));
      h16x8 o;
#pragma unroll
      for (int j = 0; j < 8; ++j) o[j] = (h16)(kk[j] * inv);
      *(h16x8*)(SC + 3 * ARR + off) = o;
    }
  }
}

DEV void phase_prep(const Params& p, const Ctx& cx0, int l, char* smem) {
  const int NPREP = 520 * 4, NS5 = 520;
  const Ctx& cx_ = cx0;
  for (int item = cx_.bid; item < NPREP + NS5; item += cx_.nblk) {
    __syncthreads();
    Ctx cx = cx0; asm volatile("" : "+v"(cx.tid));
    const int lane = cx.tid & 63, wid = cx.tid >> 6;
#ifndef NO_PREPITEM
    if (item < NPREP) prep_item(p, cx, l, item, smem);
    else
#endif
#ifndef NO_S5P1
      s5_pass1_unit(p, cx, l, (item - NPREP) * 8 + wid, smem + wid * 8192, lane);
#else
    {}
#endif
  }
}

typedef unsigned u2v __attribute__((ext_vector_type(2)));
struct RG { u2v w, a, kk, k, r; h16 v; };

constexpr int RW_NSLOT = 8, RW_SLOTB = 3072;
constexpr int RW_FLAGS = RW_NSLOT * RW_SLOTB;
constexpr int RW_NG = 16640 / 4;
typedef float f4v __attribute__((ext_vector_type(4)));

#define RW_RLO(gq, rlo)                                                            \
  {                                                                                \
    const int gg = (gq) < RW_NG ? (gq) : RW_NG - 1;                                \
    const int q0_ = gg * 4;                                                        \
    const int isl = q0_ >= 256;                                                    \
    const int base_ = isl ? b * 16384 : NLAT + b * 256;                            \
    const int t0_ = isl ? q0_ - 256 : q0_;                                         \
    const int last_ = isl ? 16383 : 255;                                           \
    rlo = base_ + (d ? last_ - t0_ - 3 : t0_);                                     \
  }

DEV void rwkv_helper(const Params& p, const Ctx& cx, int l, int unit, int lane, char* ring) {
  const int d = unit & 1, h = (unit >> 1) & 15, b = unit >> 5;
  const int j = lane >> 4, s = lane & 15;
  const h16* SC = (const h16*)(p.ws + OFF_SCAN);
  const char* pR = (const char*)(SC + 0 * ARR + h * 64);
  const char* pK = (const char*)(SC + 1 * ARR + h * 64);
  const char* pV = (const char*)(SC + 2 * ARR + h * 64);
  const char* pKK = (const char*)(SC + 3 * ARR + h * 64);
  const char* pA = (const char*)(SC + (size_t)(4 + d) * ARR + h * 64);
  const char* pW = (const char*)(SC + (size_t)(6 + d) * ARR + h * 64);
  const int jm = d ? 3 - j : j;
  const unsigned vo0 = (unsigned)(jm * 2048 + s * 8);
  f4v ka4, om4;
  {
    float4 t = *(const float4*)(p.rwkv_k_a + (size_t)l * 1024 + h * 64 + 4 * s);
    ka4 = f4v{t.x, t.y, t.z, t.w};
    om4 = 1.f - ka4;
  }
  struct RGH { u2v w, a, kk, k, r, v; };
  RGH q0, q1, q2, q3, q4, q5, q6, q7;
  const unsigned wofs = (unsigned)(j * 128 + s * 8);
  const unsigned vwofs = (unsigned)(2560 + j * 128 + s * 8);
  LAS3 volatile int* pflag = (LAS3 volatile int*)(ring + RW_FLAGS);
  LAS3 volatile int* cflag = (LAS3 volatile int*)(ring + RW_FLAGS + 64);
  int cmin = 0;
#define CV4(uv) __builtin_convertvector(__builtin_bit_cast(h16x4, uv), f4v)
#define RH_LOAD(q, gq)                                                             \
  {                                                                                \
    int rlo; RW_RLO(gq, rlo);                                                      \
    unsigned vo = vo0; asm volatile("" : "+v"(vo));                                \
    const size_t off = (size_t)rlo * 2048;                                         \
    q.w = *(const u2v*)(pW + off + vo); q.a = *(const u2v*)(pA + off + vo);        \
    q.kk = *(const u2v*)(pKK + off + vo); q.k = *(const u2v*)(pK + off + vo);      \
    q.r = *(const u2v*)(pR + off + vo); q.v = *(const u2v*)(pV + off + vo);        \
  }
#define RH_STEP(q, gq)                                                             \
  {                                                                                \
    if ((gq) >= RW_NSLOT && cmin < (gq) - RW_NSLOT + 1) {                          \
      do {                                                                         \
        const int c0_ = cflag[0], c1_ = cflag[1], c2_ = cflag[2], c3_ = cflag[3];  \
        cmin = __builtin_amdgcn_readfirstlane(min(min(c0_, c1_), min(c2_, c3_)));  \
        if (cmin < (gq) - RW_NSLOT + 1) __builtin_amdgcn_s_sleep(1);               \
      } while (cmin < (gq) - RW_NSLOT + 1);                                        \
    }                                                                              \
    asm volatile("" ::: "memory");                                                 \
    char* sl = ring + ((gq) % RW_NSLOT) * RW_SLOTB;                                \
    const f4v a_ = CV4(q.a), kk_ = CV4(q.kk);                                      \
    const f4v kka_ = kk_ * a_, kd_ = CV4(q.k) * (a_ * ka4 + om4);                  \
    *(u2v*)(sl + 0 * 512 + wofs) = q.w;                                            \
    *(u2v*)(sl + 1 * 512 + wofs) = q.kk;                                           \
    *(u2v*)(sl + 2 * 512 + wofs) = __builtin_bit_cast(u2v, __builtin_convertvector(kka_, h16x4)); \
    *(u2v*)(sl + 3 * 512 + wofs) = __builtin_bit_cast(u2v, __builtin_convertvector(kd_, h16x4));  \
    *(u2v*)(sl + 4 * 512 + wofs) = q.r;                                            \
    *(u2v*)(sl + vwofs) = q.v;                                                     \
    asm volatile("s_waitcnt lgkmcnt(0)" ::: "memory");     \
    *pflag = (gq) + 1;                                                             \
  }
  RH_LOAD(q0, 0); RH_LOAD(q1, 1); RH_LOAD(q2, 2); RH_LOAD(q3, 3); RH_LOAD(q4, 4); RH_LOAD(q5, 5); RH_LOAD(q6, 6); RH_LOAD(q7, 7);
#pragma unroll 1
  for (int g = 0; g < RW_NG; g += 8) {
    RH_STEP(q0, g); RH_LOAD(q0, g + 8); __builtin_amdgcn_sched_barrier(0);
    RH_STEP(q1, g + 1); RH_LOAD(q1, g + 9); __builtin_amdgcn_sched_barrier(0);
    RH_STEP(q2, g + 2); RH_LOAD(q2, g + 10); __builtin_amdgcn_sched_barrier(0);
    RH_STEP(q3, g + 3); RH_LOAD(q3, g + 11); __builtin_amdgcn_sched_barrier(0);
    RH_STEP(q4, g + 4); RH_LOAD(q4, g + 12); __builtin_amdgcn_sched_barrier(0);
    RH_STEP(q5, g + 5); RH_LOAD(q5, g + 13); __builtin_amdgcn_sched_barrier(0);
    RH_STEP(q6, g + 6); RH_LOAD(q6, g + 14); __builtin_amdgcn_sched_barrier(0);
    RH_STEP(q7, g + 7); RH_LOAD(q7, g + 15); __builtin_amdgcn_sched_barrier(0);
  }
#undef RH_LOAD
#undef RH_STEP
#undef CV4
}

DEV void rwkv_consumer(const Params& p, const Ctx& cx, int l, int task, int lane, const char* ring, int widx) {
  const int unit = task >> 4, d = unit & 1, h = (unit >> 1) & 15, b = unit >> 5;
  const int j = lane >> 4, s = lane & 15;
  const int myrow = (task & 15) * 4 + j;
  char* pO = (char*)((h16*)(p.ws + OFF_REG2) + (size_t)d * ARR + h * 64);
  const int sm = d ? 3 - (s & 3) : (s & 3);
  const unsigned vov0 = (unsigned)(sm * 2048 + myrow * 2);
  const unsigned rofs = (unsigned)(s * 8);
  const unsigned vrofs = (unsigned)(2560 + myrow * 2);
  LAS3 volatile int* pflag = (LAS3 volatile int*)(ring + RW_FLAGS);
  LAS3 volatile int* cflag = (LAS3 volatile int*)(ring + RW_FLAGS + 64) + widx;
  float S0 = 0.f, S1 = 0.f, S2 = 0.f, S3 = 0.f;
  int pseen = 0;
  struct GD { u2v w[4], kk[4], kka[4], kd[4], r[4]; unsigned v[4]; };
  GD A, B;
#define RC_WAIT(gq) { if (pseen <= (gq)) { do { pseen = __builtin_amdgcn_readfirstlane(*pflag); if (pseen <= (gq)) __builtin_amdgcn_s_sleep(1); } while (pseen <= (gq)); } asm volatile("" ::: "memory"); }
#define RC_LOAD(G, gq)                                                             \
  {                                                                                \
    const char* sl = ring + ((gq) % RW_NSLOT) * RW_SLOTB;                          \
    _Pragma("unroll") for (int u = 0; u < 4; ++u) {                                \
      G.w[u] = *(const u2v*)(sl + 0 * 512 + u * 128 + rofs);                       \
      G.kk[u] = *(const u2v*)(sl + 1 * 512 + u * 128 + rofs);                      \
      G.kka[u] = *(const u2v*)(sl + 2 * 512 + u * 128 + rofs);                     \
      G.kd[u] = *(const u2v*)(sl + 3 * 512 + u * 128 + rofs);                      \
      G.r[u] = *(const u2v*)(sl + 4 * 512 + u * 128 + rofs);                       \
      G.v[u] = *(const unsigned short*)(sl + u * 128 + vrofs);                     \
    }                                                                              \
  }
#define RC_COMP(G, gq)                                                             \
  {                                                                                \
    float dres[4];                                                                 \
    _Pragma("unroll") for (int u = 0; u < 4; ++u) {                                \
        \
        \
      float ea, eb, x_, y_, t0, t1, t2, t3;                                        \
      asm("v_fma_mix_f32 %6, %0, %12, 0 op_sel:[0,0,0] op_sel_hi:[0,1,0]\n\t"      \
          "v_fma_mix_f32 %7, %2, %13, 0 op_sel:[0,0,0] op_sel_hi:[0,1,0]\n\t"      \
          "v_fma_mix_f32 %6, %1, %12, %6 op_sel:[0,1,0] op_sel_hi:[0,1,0]\n\t"     \
          "v_fma_mix_f32 %7, %3, %13, %7 op_sel:[0,1,0] op_sel_hi:[0,1,0]\n\t"     \
          "v_fma_mix_f32 %8, %22, %16, 0 op_sel:[0,0,0] op_sel_hi:[1,1,0]\n\t"     \
          "v_add_f32 %6, %6, %7\n\t"                                               \
          "v_fma_mix_f32 %9, %22, %16, 0 op_sel:[0,1,0] op_sel_hi:[1,1,0]\n\t"     \
          "v_fma_mix_f32 %10, %22, %17, 0 op_sel:[0,0,0] op_sel_hi:[1,1,0]\n\t"    \
          "v_add_f32_dpp %6, %6, %6 quad_perm:[1,0,3,2] row_mask:0xf bank_mask:0xf bound_ctrl:1\n\t" \
          "v_fma_mix_f32 %11, %22, %17, 0 op_sel:[0,1,0] op_sel_hi:[1,1,0]\n\t"    \
          "v_fma_mix_f32 %0, %0, %14, %8 op_sel:[0,0,0] op_sel_hi:[0,1,0]\n\t"     \
          "v_add_f32_dpp %6, %6, %6 quad_perm:[2,3,0,1] row_mask:0xf bank_mask:0xf bound_ctrl:1\n\t" \
          "v_fma_mix_f32 %1, %1, %14, %9 op_sel:[0,1,0] op_sel_hi:[0,1,0]\n\t"     \
          "v_fma_mix_f32 %2, %2, %15, %10 op_sel:[0,0,0] op_sel_hi:[0,1,0]\n\t"    \
          "v_add_f32_dpp %6, %6, %6 row_half_mirror row_mask:0xf bank_mask:0xf bound_ctrl:1\n\t" \
          "v_fma_mix_f32 %3, %3, %15, %11 op_sel:[0,1,0] op_sel_hi:[0,1,0]\n\t"    \
          "s_nop 0\n\t"                                                            \
          "v_add_f32_dpp %6, %6, %6 row_mirror row_mask:0xf bank_mask:0xf bound_ctrl:1\n\t" \
          "v_fma_mix_f32 %0, -%6, %18, %0 op_sel:[0,0,0] op_sel_hi:[0,1,0]\n\t"    \
          "v_fma_mix_f32 %1, -%6, %18, %1 op_sel:[0,1,0] op_sel_hi:[0,1,0]\n\t"    \
          "v_fma_mix_f32 %2, -%6, %19, %2 op_sel:[0,0,0] op_sel_hi:[0,1,0]\n\t"    \
          "v_fma_mix_f32 %3, -%6, %19, %3 op_sel:[0,1,0] op_sel_hi:[0,1,0]\n\t"    \
          "v_fma_mix_f32 %4, %0, %20, 0 op_sel:[0,0,0] op_sel_hi:[0,1,0]\n\t"      \
          "v_fma_mix_f32 %5, %2, %21, 0 op_sel:[0,0,0] op_sel_hi:[0,1,0]\n\t"      \
          "v_fma_mix_f32 %4, %1, %20, %4 op_sel:[0,1,0] op_sel_hi:[0,1,0]\n\t"     \
          "v_fma_mix_f32 %5, %3, %21, %5 op_sel:[0,1,0] op_sel_hi:[0,1,0]"         \
          : "+v"(S0), "+v"(S1), "+v"(S2), "+v"(S3), "=&v"(ea), "=&v"(eb), "=&v"(x_), "=&v"(y_),                     \
            "=&v"(t0), "=&v"(t1), "=&v"(t2), "=&v"(t3)                                                              \
          : "v"(G.kk[u].x), "v"(G.kk[u].y), "v"(G.w[u].x), "v"(G.w[u].y), "v"(G.kd[u].x), "v"(G.kd[u].y),           \
            "v"(G.kka[u].x), "v"(G.kka[u].y), "v"(G.r[u].x), "v"(G.r[u].y), "v"(G.v[u]));                           \
      dres[u] = ea + eb;     \
    }                                                                              \
    asm volatile("" ::: "memory");                                                 \
    *cflag = (gq) + 1;     \
    {                                                                              \
      int rlo; RW_RLO(gq, rlo);                                                    \
      unsigned vov = vov0; asm volatile("" : "+v"(vov));                           \
        \
      const bool p1_ = (s & 1) != 0, p2_ = (s & 2) != 0;                           \
      const float a_ = (p1_ ? dres[1] : dres[0]) + dpp_mov<0xB1>(p1_ ? dres[0] : dres[1]); \
      const float b_ = (p1_ ? dres[3] : dres[2]) + dpp_mov<0xB1>(p1_ ? dres[2] : dres[3]); \
      float val = (p2_ ? b_ : a_) + dpp_mov<0x4E>(p2_ ? a_ : b_);                  \
      val += dpp_mov<0x124>(val);                                                  \
      val += dpp_mov<0x128>(val);                                                  \
      *(h16*)(pO + (size_t)rlo * 2048 + vov) = (h16)val;                           \
    }                                                                              \
  }
  RC_WAIT(0); RC_LOAD(A, 0);
#pragma unroll 1
  for (int g = 0; g < RW_NG; g += 2) {
    RC_WAIT(g + 1); RC_LOAD(B, g + 1);
    RC_COMP(A, g);
    if (g + 2 < RW_NG) { RC_WAIT(g + 2); RC_LOAD(A, g + 2); }
    RC_COMP(B, g + 1);
  }
#undef RC_WAIT
#undef RC_LOAD
#undef RC_COMP
}
#undef RW_RLO

DEV void phase_scan(const Params& p, const Ctx& cx, int l, char* smem) {
  const int lane = cx.tid & 63, wid = __builtin_amdgcn_readfirstlane(cx.tid >> 6);
  for (int slot = cx.bid; slot < 256; slot += cx.nblk) {
    __syncthreads();
    if (wid == 4 && lane < 8) *(LAS3 volatile int*)(smem + RW_FLAGS + (lane == 0 ? 0 : 64 + (lane & 3) * 4)) = 0;
    __syncthreads();
    const int unit = slot & 63;
#ifndef NO_RWKV
    if (wid < 4) { __builtin_amdgcn_s_setprio(3); rwkv_consumer(p, cx, l, (unit << 4) | ((slot >> 6) << 2) | wid, lane, smem, wid); __builtin_amdgcn_s_setprio(0); }
    else if (wid == 4) { __builtin_amdgcn_s_setprio(2); rwkv_helper(p, cx, l, unit, lane, smem); __builtin_amdgcn_s_setprio(0); }
#endif
  }
  if (wid >= 5) {
    char* wl = smem + 32768 + (wid - 5) * 17408;
    for (int u = cx.bid * 3 + (wid - 5); u < 2 * 32 * 65; u += cx.nblk * 3) {
      if (l == 1 && (u % 65) == 0) continue;
#ifndef NO_S5P3
      s5_pass3_unit(p, cx, l, u, wl, lane);
#endif
    }
  }
}

DEV void pool_item(const Params& p, const Ctx& cx, int l, int item, char* smem) {
  const int tid = cx.tid;
  const h16* zrest = (const h16*)(p.ws + OFF_ZREST);
  bf16_t* ym = (bf16_t*)(p.ws + OFF_YM);
  const char* wt = p.ws + OFF_WT + (size_t)l * WT_SIZE;
  float* V = (float*)smem;
  char* At = smem + 43008;
  int g, rowout0, Lseq, p0, rlo, rhi, rstride, rowsrc0;
  if (item < 2048) {
    g = item & 3; int r = (item >> 2) & 255, b = item >> 10;
    int w = 2 << g;
    rlo = max(r - w / 2, 0); rhi = min(r + w / 2 - 1, 255);
    rowsrc0 = b * 16384; rstride = 64;
    rowout0 = b * 16384 + r * 64; Lseq = 64; p0 = 0;
  } else {
    int it = item - 2048;
    g = it & 3; int tq = (it >> 2) & 3, b = it >> 4;
    rlo = 0; rhi = 0; rowsrc0 = NLAT + b * 256; rstride = 0;
    rowout0 = NLAT + b * 256 + tq * 64; Lseq = 256; p0 = tq * 64;
  }
  const int w = 2 << g;
  const float invr = 1.f / (float)(rhi - rlo + 1);
  for (int unit = tid; unit < 80 * 16; unit += NTHREADS) {
    int lp = unit >> 4, ch8 = unit & 15;
    int pos = p0 - 8 + lp;
    float acc[8] = {0, 0, 0, 0, 0, 0, 0, 0};
    if (pos >= 0 && pos < Lseq) {
      const h16* bp = zrest + (size_t)(rowsrc0 + pos) * ZR + 1024 + g * 128 + ch8 * 8;
      const int nr = rhi - rlo + 1;
      for (int k0 = 0; k0 < nr; k0 += 4) {
        h16x8 v[4]; float wv[4];
#pragma unroll
        for (int i = 0; i < 4; ++i) {
          const int kk_ = min(k0 + i, nr - 1);
          wv[i] = (k0 + i < nr) ? 1.f : 0.f;
          v[i] = *(const h16x8*)(bp + (size_t)((rlo + kk_) * rstride) * ZR);
        }
#pragma unroll
        for (int i = 0; i < 4; ++i)
#pragma unroll
          for (int j = 0; j < 8; ++j) acc[j] += wv[i] * (float)v[i][j];
      }
    }
    float* vp = V + lp * 132 + ch8 * 8;
#pragma unroll
    for (int j = 0; j < 8; ++j) vp[j] = acc[j] * invr;
  }
  __syncthreads();
  for (int unit = tid; unit < 64 * 16; unit += NTHREADS) {
    int c = unit >> 4, ch8 = unit & 15;
    int pos = p0 + c;
    int lo = max(pos - w / 2, 0), hi = min(pos + w / 2 - 1, Lseq - 1);
    float acc[8] = {0, 0, 0, 0, 0, 0, 0, 0};
    for (int pp = lo; pp <= hi; ++pp) {
      const float* vp = V + (pp - p0 + 8) * 132 + ch8 * 8;
#pragma unroll
      for (int j = 0; j < 8; ++j) acc[j] += vp[j];
    }
    float invc = 1.f / (float)(hi - lo + 1);
    h16x8 uc = *(const h16x8*)(zrest + (size_t)(rowout0 + c) * ZR + 1024 + g * 128 + ch8 * 8);
    uint4 o;
    o.x = pack_bf2(acc[0] * invc - (float)uc[0], acc[1] * invc - (float)uc[1]);
    o.y = pack_bf2(acc[2] * invc - (float)uc[2], acc[3] * invc - (float)uc[3]);
    o.z = pack_bf2(acc[4] * invc - (float)uc[4], acc[5] * invc - (float)uc[5]);
    o.w = pack_bf2(acc[6] * invc - (float)uc[6], acc[7] * invc - (float)uc[7]);
    *(uint4*)(At + c * 272 + ch8 * 16) = o;
  }
  __syncthreads();
  const bf16_t* Bt = (const bf16_t*)(wt + WT_POOL) + (size_t)g * 128 * 128;
  const float* ps = p.pool_scale + (size_t)l * 512 + g * 128;
  small_gemm<128, 1>(p, cx, At, 272, Bt, (tid >> 6) * 16, [&](int m, int n, f32x4 v) {
    int row = rowout0 + m;
    float4 sc = *(const float4*)(ps + n);
    h16x4 gt = *(const h16x4*)(zrest + (size_t)row * ZR + 1536 + g * 128 + n);
    uint2 o;
    o.x = pack_bf2(v[0] * sc.x * silu_f((float)gt[0]), v[1] * sc.y * silu_f((float)gt[1]));
    o.y = pack_bf2(v[2] * sc.z * silu_f((float)gt[2]), v[3] * sc.w * silu_f((float)gt[3]));
    *(uint2*)(ym + (size_t)row * D + 512 + g * 128 + n) = o;
  });
}

DEV void glu_item(const Params& p, const Ctx& cx, int l, int tile, char* smem) {
  const int tid = cx.tid;
  const int row0 = tile * 64;
  const float* S5Y = (const float*)(p.ws + OFF_S5Y);
  const h16* zrest = (const h16*)(p.ws + OFF_ZREST);
  bf16_t* ym = (bf16_t*)(p.ws + OFF_YM);
  const char* wt = p.ws + OFF_WT + (size_t)l * WT_SIZE;
#pragma unroll
  for (int it = 0; it < 8; ++it) {
    int unit = tid + it * NTHREADS;
    int r = unit >> 6, c8 = unit & 63;
    const float* sp = S5Y + (size_t)(row0 + r) * 512 + c8 * 8;
    float4 a = *(const float4*)sp, bq = *(const float4*)(sp + 4);
    uint4 o;
    o.x = pack_bf2(a.x, a.y); o.y = pack_bf2(a.z, a.w); o.z = pack_bf2(bq.x, bq.y); o.w = pack_bf2(bq.z, bq.w);
    *(uint4*)(smem + r * 1040 + c8 * 16) = o;
  }
  __syncthreads();
  const bf16_t* Bt = (const bf16_t*)(wt + WT_GLU);
  const float* bg = p.b_glu + (size_t)l * 512;
  small_gemm<512, 4>(p, cx, smem, 1040, Bt, (tid >> 6) * 64, [&](int m, int n, f32x4 v) {
    int row = row0 + m;
    float4 y = *(const float4*)(S5Y + (size_t)row * 512 + n);
    float4 bb = *(const float4*)(bg + n);
    h16x4 gt = *(const h16x4*)(zrest + (size_t)row * ZR + 512 + n);
    uint2 o;
    o.x = pack_bf2(y.x * sigmoid_f(v[0] + bb.x) * silu_f((float)gt[0]), y.y * sigmoid_f(v[1] + bb.y) * silu_f((float)gt[1]));
    o.y = pack_bf2(y.z * sigmoid_f(v[2] + bb.z) * silu_f((float)gt[2]), y.w * sigmoid_f(v[3] + bb.w) * silu_f((float)gt[3]));
    *(uint2*)(ym + (size_t)row * D + n) = o;
  });
}

DEV void rwkvmerge_item(const Params& p, const Ctx& cx, int l, int tile) {
  const int tid = cx.tid;
  const int row0 = tile * 64;
  const h16* SC = (const h16*)(p.ws + OFF_SCAN);
  const h16* O = (const h16*)(p.ws + OFF_REG2);
  const h16* zrest = (const h16*)(p.ws + OFF_ZREST);
  bf16_t* ym = (bf16_t*)(p.ws + OFF_YM);
  const int grp = tid & 7, h = (tid >> 3) & 15;
  const int c0 = h * 64 + grp * 8;
  float pk[8], rk[8], gw[8], gb[8];
#pragma unroll
  for (int j = 0; j < 8; j += 4) {
    float4 t0 = *(const float4*)(p.rwkv_k_a + (size_t)l * 1024 + c0 + j), t1 = *(const float4*)(p.rwkv_r_k + (size_t)l * 1024 + c0 + j);
    float4 t2 = *(const float4*)(p.gn_w + (size_t)l * 1024 + c0 + j), t3 = *(const float4*)(p.gn_b + (size_t)l * 1024 + c0 + j);
    pk[j] = t0.x; pk[j + 1] = t0.y; pk[j + 2] = t0.z; pk[j + 3] = t0.w;
    rk[j] = t1.x; rk[j + 1] = t1.y; rk[j + 2] = t1.z; rk[j + 3] = t1.w;
    gw[j] = t2.x; gw[j + 1] = t2.y; gw[j + 2] = t2.z; gw[j + 3] = t2.w;
    gb[j] = t3.x; gb[j + 1] = t3.y; gb[j + 2] = t3.z; gb[j + 3] = t3.w;
  }
#pragma unroll 2
  for (int it = 0; it < 16; ++it) {
    const int tok = (tid >> 7) + it * 4;
    int row = row0 + tok;
    size_t off = (size_t)row * 1024 + c0;
    h16x8 of = *(const h16x8*)(O + off), ob = *(const h16x8*)(O + ARR + off);
    h16x8 r8 = *(const h16x8*)(SC + 0 * ARR + off), k8 = *(const h16x8*)(SC + 1 * ARR + off), v8 = *(const h16x8*)(SC + 2 * ARR + off);
    h16x8 af = *(const h16x8*)(SC + 4 * ARR + off), ab = *(const h16x8*)(SC + 5 * ARR + off);
    h16x8 gt = *(const h16x8*)(zrest + (size_t)row * ZR + 2048 + c0);
    float o[8], sm = 0;
#pragma unroll
    for (int j = 0; j < 8; ++j) { o[j] = (float)of[j] + (float)ob[j]; sm += o[j]; }
    sm = allreduce8(sm);
    float mu = sm * (1.f / 64.f), vq = 0;
#pragma unroll
    for (int j = 0; j < 8; ++j) { o[j] -= mu; vq += o[j] * o[j]; }
    vq = allreduce8(vq);
    float rstd = rsqrtf(vq * (1.f / 64.f) + 64e-5f);
    float part = 0;
#pragma unroll
    for (int j = 0; j < 8; ++j) {
      float ksum = (float)k8[j] * (2.f + ((float)af[j] + (float)ab[j] - 2.f) * pk[j]);
      part += (float)r8[j] * ksum * rk[j];
    }
    part = allreduce8(part);
    float res[8];
#pragma unroll
    for (int j = 0; j < 8; ++j) {
      float y = o[j] * rstd * gw[j] + gb[j] + part * (float)v8[j];
      res[j] = y * silu_f((float)gt[j]);
    }
    uint4 ov;
    ov.x = pack_bf2(res[0], res[1]); ov.y = pack_bf2(res[2], res[3]); ov.z = pack_bf2(res[4], res[5]); ov.w = pack_bf2(res[6], res[7]);
    *(uint4*)(ym + (size_t)row * D + 1024 + c0) = ov;
  }
}

DEV void phase_merge(const Params& p, const Ctx& cx0, int l, char* smem) {
  const int ntile = (l == 0) ? 520 : 512;
  const int npool = (l == 0) ? 2048 + 32 : 2048;
  const int total = npool + 2 * ntile;
  for (int item = cx0.bid; item < total; item += cx0.nblk) {
    __syncthreads();
    Ctx cx = cx0; asm volatile("" : "+v"(cx.tid));
    if (item < npool) pool_item(p, cx, l, item, smem);
    else if (item < npool + ntile) glu_item(p, cx, l, item - npool, smem);
    else rwkvmerge_item(p, cx, l, item - npool - ntile);
  }
}

#define LCX Ctx c2 = cx; asm volatile("" : "+v"(c2.tid))
#ifndef GEMM_FN
#define GEMM_FN gemm_phase2
#endif
__global__ void __launch_bounds__(NTHREADS) mega_fwd(Params p, int ph0, int ph1) {
  extern __shared__ __attribute__((aligned(16))) char smem[];
  cg::grid_group grid = cg::this_grid();
  const int wave_s = __builtin_amdgcn_readfirstlane((int)(threadIdx.x >> 6));
  for (int step = ph0; step < ph1; ++step) {
    if (step > ph0) grid.sync();
    const int ph = (int)((PH_SEQ >> (4 * step)) & 15ull);
    Ctx cx;
    {
      int t_, b_ = blockIdx.x, n_ = gridDim.x;
      asm volatile("v_mbcnt_lo_u32_b32 %0, -1, 0\n\tv_mbcnt_hi_u32_b32 %0, -1, %0\n\tv_lshl_add_u32 %0, %1, 6, %0" : "=&v"(t_) : "s"(wave_s));
      asm volatile("" : "+s"(b_), "+s"(n_));
      cx.tid = t_; cx.bid = b_; cx.nblk = n_;
    }
    const int l = ph >= 8 ? 1 : 0;
    const int lp = ph >= 8 ? ph - 6 : ph;
#ifndef PHMASK
#define PHMASK 0xff
#endif
    if (ph == 0) { if (PHMASK & 1) { LCX; phase0(p, c2, smem); } }
    else if (ph == 1) { if (PHMASK & 2) { LCX; phase_adaln0(p, c2); } }
    else if (lp == 2 && (PHMASK & 4)) {
      LCX;
      h16* zrest = (h16*)(p.ws + OFF_ZREST);
      h16* zc = (h16*)(p.ws + OFF_REG2);
      GEMM_FN(p, c2, (const bf16_t*)(p.ws + OFF_H), (const bf16_t*)(p.ws + OFF_WT + (size_t)l * WT_SIZE + WT_IN), 2048, 130, 25, smem,
                 [&](int row, int col, f32x4 v, f32x4 u) {
                   h16* dst;
                   if (col < 2048) dst = zrest + (size_t)row * ZR + col;
                   else if (col < 5120) dst = zc + (size_t)row * ZC + (col - 2048);
                   else if (col < 6144) dst = zrest + (size_t)row * ZR + 2048 + (col - 5120);
                   else dst = zc + (size_t)row * ZC + 3072 + (col - 6144);
                   h16x8 o = {(h16)v[0], (h16)v[1], (h16)v[2], (h16)v[3], (h16)u[0], (h16)u[1], (h16)u[2], (h16)u[3]};
                   *(h16x8*)dst = o;
                 });
    } else if (lp == 3) { if (PHMASK & 8) { LCX; phase_prep(p, c2, l, smem); } }
    else if (lp == 4) { if (PHMASK & 16) { LCX; phase_scan(p, c2, l, smem); } }
    else if (lp == 5) { if (PHMASK & 32) { LCX; phase_merge(p, c2, l, smem); } }
    else if (lp == 6 && (PHMASK & 64)) {
      LCX;
      const float* mods = (const float*)(p.ws + OFF_MODS);
      float* prec = (float*)(p.ws + OFF_PREC);
      const float* xin = (l == 0) ? p.x : p.out;
      GEMM_FN(p, c2, (const bf16_t*)(p.ws + OFF_YM), (const bf16_t*)(p.ws + OFF_WT + (size_t)l * WT_SIZE + WT_OUT), 2048, l == 0 ? 130 : 128, 8, smem,
                 [&](int row, int col, f32x4 v, f32x4 u) {
                   const float* xr; const float* gr; float* dr;
                   if (row < NLAT) {
                     xr = xin + (size_t)row * D + col; gr = mods + (size_t)(l * 3 + (row >> 14)) * 6144 + 4096 + col; dr = p.out + (size_t)row * D + col;
                   } else {
                     xr = p.ctx + (size_t)(row - NLAT) * D + col; gr = mods + (size_t)(l * 3 + 2) * 6144 + 4096 + col; dr = prec + (size_t)(row - NLAT) * D + col;
                   }
                   const float4 x0 = *(const float4*)xr, x1 = *(const float4*)(xr + 4), g0 = *(const float4*)gr, g1 = *(const float4*)(gr + 4);
                   float4 r0, r1;
                   r0.x = ALPHA * x0.x + g0.x * v[0]; r0.y = ALPHA * x0.y + g0.y * v[1]; r0.z = ALPHA * x0.z + g0.z * v[2]; r0.w = ALPHA * x0.w + g0.w * v[3];
                   r1.x = ALPHA * x1.x + g1.x * u[0]; r1.y = ALPHA * x1.y + g1.y * u[1]; r1.z = ALPHA * x1.z + g1.z * u[2]; r1.w = ALPHA * x1.w + g1.w * u[3];
                   *(float4*)dr = r0; *(float4*)(dr + 4) = r1;
                 });
    } else if (lp == 7) { if (PHMASK & 128) { LCX; phase_finln(p, c2, l); } }
  }
}

constexpr int NPHASES = PH_NSTEPS;

extern "C" void kernel_launch(void* const* d_in, const int* in_sizes, int n_in, void* d_out, int out_size, void* d_ws, size_t ws_size,
                              hipStream_t stream) {
  static int grid_blocks = 0;
  if (grid_blocks == 0) {
    if (n_in != 32 || ws_size < WS_END) { fprintf(stderr, "kernel_launch: unexpected n_in %d / ws %zu (need %zu)\n", n_in, ws_size, (size_t)WS_END); grid_blocks = -1; return; }
    int dev = 0, cus = 0, per_cu = 0;
    hipGetDevice(&dev);
    hipDeviceGetAttribute(&cus, hipDeviceAttributeMultiprocessorCount, dev);
    if (hipFuncSetAttribute((const void*)mega_fwd, hipFuncAttributeMaxDynamicSharedMemorySize, LDS_BYTES) != hipSuccess) { fprintf(stderr, "hipFuncSetAttribute failed\n"); grid_blocks = -1; return; }
    if (hipOccupancyMaxActiveBlocksPerMultiprocessor(&per_cu, (const void*)mega_fwd, NTHREADS, LDS_BYTES) != hipSuccess || per_cu < 1) {
      fprintf(stderr, "occupancy query gave %d\n", per_cu); (void)hipGetLastError(); per_cu = 1;
    }
    grid_blocks = cus * per_cu;
  }
  if (grid_blocks < 0) return;
  Params p{};
  const float** pp = (const float**)&p;
  for (int i = 0; i < 32; ++i) pp[i] = (const float*)d_in[i];
  p.out = (float*)d_out;
  p.ws = (char*)d_ws;
  int ph0 = 0, ph1 = NPHASES;
  void* args[] = {&p, &ph0, &ph1};
  hipError_t e = hipLaunchCooperativeKernel((const void*)mega_fwd, dim3(grid_blocks), dim3(NTHREADS), args, LDS_BYTES, stream);
  if (e != hipSuccess) fprintf(stderr, "cooperative launch failed: %s (grid %d)\n", hipGetErrorString(e), grid_blocks);
}
```

```cpp
#include <hip/hip_runtime.h>
#include <hip/hip_cooperative_groups.h>
#include <cstdio>
namespace cg = cooperative_groups;

typedef unsigned short bf16_t;
typedef _Float16 h16;
using bf16x8 = __attribute__((ext_vector_type(8))) _Float16;
using f32x4 = __attribute__((ext_vector_type(4))) float;
using h16x4 = __attribute__((ext_vector_type(4))) _Float16;
using h16x8 = __attribute__((ext_vector_type(8))) _Float16;

#define DEV __device__ __forceinline__

constexpr int D = 2048, NLAT = 32768, MTOT = 33280, ZR = 3072, ZC = 3328;
constexpr int NTHREADS = 512;
constexpr int LDS_BYTES = 147456;
constexpr float ALPHA = 1.41421356237f;
constexpr float DECAY_SCALE = 0.606531f;

constexpr size_t al256(size_t x) { return (x + 255) & ~size_t(255); }
constexpr size_t ARR = (size_t)MTOT * 1024;
constexpr size_t OFF_MODS = 0;
constexpr size_t OFF_S5F = al256(OFF_MODS + 2 * 3 * 6144 * 4);
constexpr size_t OFF_PREC = al256(OFF_S5F + (size_t)2 * 32 * 65 * 2 * 64 * 8);
constexpr size_t OFF_WT = al256(OFF_PREC + (size_t)512 * 2048 * 4);
constexpr size_t WT_IN = 0, WT_OUT = 26214400, WT_W2 = 34603008, WT_A2 = 34865152, WT_POOL = 35127296, WT_GLU = 35258368, WT_SIZE = 35782656;
constexpr size_t OFF_ZREST = al256(OFF_WT + 2 * WT_SIZE);
constexpr size_t OFF_REG2 = al256(OFF_ZREST + (size_t)MTOT * ZR * 2);
constexpr size_t OFF_S5Y = OFF_REG2 + 2 * ARR * 2;
constexpr size_t OFF_SCAN = al256(OFF_REG2 + (size_t)MTOT * ZC * 2);
constexpr size_t OFF_H = OFF_SCAN;
constexpr size_t OFF_YM = OFF_SCAN + 6 * ARR * 2;
constexpr size_t WS_END = OFF_SCAN + 8 * ARR * 2;

#ifndef PH_SEQ
#define PH_SEQ 0xDCBA9876543210ull
#define PH_NSTEPS 14
#endif
struct Params {
  const float *x, *c, *ctx, *c_ctx, *w_ada, *b_ada, *w_in, *conv_rkv, *s5_lam_re, *s5_lam_im, *s5_log_step,
      *s5_b_re, *s5_b_im, *s5_c_re, *s5_c_im, *s5_d, *w_glu, *b_glu, *w_pool, *pool_scale,
      *rwkv_w0, *rwkv_w2, *rwkv_a0, *rwkv_a2, *rwkv_k_k, *rwkv_k_a, *rwkv_r_k, *gn_w, *gn_b,
      *w_out, *ln_g, *ln_b;
  float* out;
  char* ws;
};
struct Ctx { int tid, bid, nblk; };

DEV float rcp_f(float x) { return __builtin_amdgcn_rcpf(x); }
DEV float sigmoid_f(float x) { return rcp_f(1.f + __expf(-x)); }
DEV float silu_f(float x) { return x * rcp_f(1.f + __expf(-x)); }
DEV float tanh_f(float x) { float e = __expf(2.f * x); return 1.f - 2.f * rcp_f(e + 1.f); }
DEV float gelu_f(float y) { return 0.5f * y * (1.f + tanh_f(0.7978845608f * (y + 0.044715f * y * y * y))); }
using h16x2 = __attribute__((ext_vector_type(2))) _Float16;
DEV unsigned pack_bf2(float a, float b) { h16x2 v = {(h16)a, (h16)b}; return __builtin_bit_cast(unsigned, v); }
template <int CTRL> DEV float dpp_mov(float v) {
  return __int_as_float(__builtin_amdgcn_update_dpp(0, __float_as_int(v), CTRL, 0xf, 0xf, true));
}
DEV float allreduce16(float v) {
  v += dpp_mov<0xB1>(v);
  v += dpp_mov<0x4E>(v);
  v += dpp_mov<0x141>(v);
  v += dpp_mov<0x140>(v);
  return v;
}
DEV float wave_sum(float v) {
  v = allreduce16(v);
  return __builtin_amdgcn_readlane(__float_as_int(v), 0) == 0 && false ? 0.f :
         __int_as_float(__builtin_amdgcn_readlane(__float_as_int(v), 0)) + __int_as_float(__builtin_amdgcn_readlane(__float_as_int(v), 16)) +
         __int_as_float(__builtin_amdgcn_readlane(__float_as_int(v), 32)) + __int_as_float(__builtin_amdgcn_readlane(__float_as_int(v), 48));
}
DEV float allreduce8(float v) {
  v += dpp_mov<0xB1>(v);
  v += dpp_mov<0x4E>(v);
  v += dpp_mov<0x141>(v);
  return v;
}
DEV void lds_fence() { asm volatile("s_waitcnt lgkmcnt(0)" ::: "memory"); }

DEV void p0_mods_item(const Params& p, const Ctx& cx, int item, char* smem) {
  float* red = (float*)smem;
  float* mods = (float*)(p.ws + OFF_MODS);
  int l = item / 96, chunk = item % 96;
  int tid = cx.tid, kq = tid >> 6, col = tid & 63;
  int n = chunk * 64 + col;
  const float* W = p.w_ada + (size_t)l * 2048 * 6144;
  float a0 = 0, a1 = 0, a2 = 0;
#pragma unroll 8
  for (int k = kq; k < 2048; k += 8) {
    float w = W[(size_t)k * 6144 + n];
    a0 += silu_f(p.c[k]) * w;
    a1 += silu_f(p.c[2048 + k]) * w;
    a2 += silu_f(p.c_ctx[k]) * w;
  }
  red[(kq * 3 + 0) * 64 + col] = a0;
  red[(kq * 3 + 1) * 64 + col] = a1;
  red[(kq * 3 + 2) * 64 + col] = a2;
  __syncthreads();
  if (tid < 192) {
    int r = tid >> 6, cc = tid & 63;
    float s = 0;
#pragma unroll
    for (int q = 0; q < 8; ++q) s += red[(q * 3 + r) * 64 + cc];
    mods[(size_t)(l * 3 + r) * 6144 + chunk * 64 + cc] = s + p.b_ada[(size_t)l * 6144 + chunk * 64 + cc];
  }
}

DEV void p0_transpose_tile(const Params& p, const Ctx& cx, const float* __restrict__ src, bf16_t* __restrict__ dst, int K, int N, int tk, int tn, char* smem) {
  float* T = (float*)smem;
  int tid = cx.tid;
  int k0 = tk * 64, n0 = tn * 64;
  int kk = tid >> 4, n4 = tid & 15;
#pragma unroll
  for (int i = 0; i < 2; ++i) {
    int k = kk + 32 * i;
    float4 v = *(const float4*)(src + (size_t)(k0 + k) * N + n0 + n4 * 4);
    T[k * 65 + n4 * 4 + 0] = v.x; T[k * 65 + n4 * 4 + 1] = v.y; T[k * 65 + n4 * 4 + 2] = v.z; T[k * 65 + n4 * 4 + 3] = v.w;
  }
  __syncthreads();
  int n = tid >> 3, k8 = tid & 7;
  uint4 o;
  o.x = pack_bf2(T[(k8 * 8 + 0) * 65 + n], T[(k8 * 8 + 1) * 65 + n]);
  o.y = pack_bf2(T[(k8 * 8 + 2) * 65 + n], T[(k8 * 8 + 3) * 65 + n]);
  o.z = pack_bf2(T[(k8 * 8 + 4) * 65 + n], T[(k8 * 8 + 5) * 65 + n]);
  o.w = pack_bf2(T[(k8 * 8 + 6) * 65 + n], T[(k8 * 8 + 7) * 65 + n]);
  *(uint4*)(dst + (size_t)(n0 + n) * K + k0 + k8 * 8) = o;
}

DEV void phase0(const Params& p, const Ctx& cx0, char* smem) {
  const int NTR = 4368;
  const int total = 192 + 2 * NTR;
  for (int item = cx0.bid; item < total; item += cx0.nblk) {
    __syncthreads();
    Ctx cx = cx0; asm volatile("" : "+v"(cx.tid));
    if (item < 192) { p0_mods_item(p, cx, item, smem); continue; }
    int it = item - 192;
    int l = it / NTR, i = it % NTR;
    char* wt = p.ws + OFF_WT + (size_t)l * WT_SIZE;
    if (i < 3200) {
      p0_transpose_tile(p, cx, p.w_in + (size_t)l * 2048 * 6400, (bf16_t*)(wt + WT_IN), 2048, 6400, i / 100, i % 100, smem);
    } else if (i < 4224) {
      int j = i - 3200;
      p0_transpose_tile(p, cx, p.w_out + (size_t)l * 2048 * 2048, (bf16_t*)(wt + WT_OUT), 2048, 2048, j / 32, j % 32, smem);
    } else if (i < 4256) {
      int j = i - 4224, d = j / 16;
      p0_transpose_tile(p, cx, p.rwkv_w2 + (size_t)(l * 2 + d) * 64 * 1024, (bf16_t*)(wt + WT_W2) + (size_t)d * 1024 * 64, 64, 1024, 0, j % 16, smem);
    } else if (i < 4288) {
      int j = i - 4256, d = j / 16;
      p0_transpose_tile(p, cx, p.rwkv_a2 + (size_t)(l * 2 + d) * 64 * 1024, (bf16_t*)(wt + WT_A2) + (size_t)d * 1024 * 64, 64, 1024, 0, j % 16, smem);
    } else if (i < 4304) {
      int j = i - 4288, g = j / 4;
      p0_transpose_tile(p, cx, p.w_pool + (size_t)(l * 4 + g) * 128 * 128, (bf16_t*)(wt + WT_POOL) + (size_t)g * 128 * 128, 128, 128, (j % 4) / 2, j % 2, smem);
    } else {
      int j = i - 4304;
      p0_transpose_tile(p, cx, p.w_glu + (size_t)l * 512 * 512, (bf16_t*)(wt + WT_GLU), 512, 512, j / 8, j % 8, smem);
    }
  }
}

DEV void phase_adaln0(const Params& p, const Ctx& cx) {
  const float* mods = (const float*)(p.ws + OFF_MODS);
  bf16_t* hbuf = (bf16_t*)(p.ws + OFF_H);
  int lane = cx.tid & 63;
  int gw = cx.bid * 8 + (cx.tid >> 6), nw = cx.nblk * 8;
  for (int row = gw; row < MTOT; row += nw) {
    const float* src = row < NLAT ? p.x + (size_t)row * D : p.ctx + (size_t)(row - NLAT) * D;
    int mr = row < NLAT ? (row >> 14) : 2;
    const float* md = mods + (size_t)mr * 6144;
    float4 v[8];
    float s = 0;
#pragma unroll
    for (int i = 0; i < 8; ++i) { v[i] = *(const float4*)(src + i * 256 + lane * 4); s += v[i].x + v[i].y + v[i].z + v[i].w; }
    float mu = wave_sum(s) * (1.f / 2048.f);
    float q = 0;
#pragma unroll
    for (int i = 0; i < 8; ++i) { v[i].x -= mu; v[i].y -= mu; v[i].z -= mu; v[i].w -= mu; q += v[i].x * v[i].x + v[i].y * v[i].y + v[i].z * v[i].z + v[i].w * v[i].w; }
    float rstd = rsqrtf(wave_sum(q) * (1.f / 2048.f) + 1e-6f);
#pragma unroll
    for (int i = 0; i < 8; ++i) {
      int col = i * 256 + lane * 4;
      float4 sh = *(const float4*)(md + col), sc = *(const float4*)(md + 2048 + col);
      uint2 o;
      o.x = pack_bf2(v[i].x * rstd * (1.f + sc.x) + sh.x, v[i].y * rstd * (1.f + sc.y) + sh.y);
      o.y = pack_bf2(v[i].z * rstd * (1.f + sc.z) + sh.z, v[i].w * rstd * (1.f + sc.w) + sh.w);
      *(uint2*)(hbuf + (size_t)row * D + col) = o;
    }
  }
}

DEV void phase_finln(const Params& p, const Ctx& cx, int l) {
  const float* mods = (const float*)(p.ws + OFF_MODS);
  bf16_t* hbuf = (bf16_t*)(p.ws + OFF_H);
  float* prec = (float*)(p.ws + OFF_PREC);
  int lane = cx.tid & 63;
  int gw = cx.bid * 8 + (cx.tid >> 6), nw = cx.nblk * 8;
  const int nrows = (l == 0) ? MTOT : NLAT;
  for (int row = gw; row < nrows; row += nw) {
    float* src = row < NLAT ? p.out + (size_t)row * D : prec + (size_t)(row - NLAT) * D;
    float4 v[8];
    float s = 0;
#pragma unroll
    for (int i = 0; i < 8; ++i) { v[i] = *(const float4*)(src + i * 256 + lane * 4); s += v[i].x + v[i].y + v[i].z + v[i].w; }
    float mu = wave_sum(s) * (1.f / 2048.f);
    float q = 0;
#pragma unroll
    for (int i = 0; i < 8; ++i) { v[i].x -= mu; v[i].y -= mu; v[i].z -= mu; v[i].w -= mu; q += v[i].x * v[i].x + v[i].y * v[i].y + v[i].z * v[i].z + v[i].w * v[i].w; }
    float rstd = rsqrtf(wave_sum(q) * (1.f / 2048.f) + 1e-5f);
    float s2 = 0;
#pragma unroll
    for (int i = 0; i < 8; ++i) {
      int col = i * 256 + lane * 4;
      float4 g = *(const float4*)(p.ln_g + (size_t)l * D + col), b = *(const float4*)(p.ln_b + (size_t)l * D + col);
      v[i].x = v[i].x * rstd * g.x + b.x; v[i].y = v[i].y * rstd * g.y + b.y; v[i].z = v[i].z * rstd * g.z + b.z; v[i].w = v[i].w * rstd * g.w + b.w;
      if (row < NLAT) *(float4*)(src + col) = v[i];
      s2 += v[i].x + v[i].y + v[i].z + v[i].w;
    }
    if (l == 0) {
      int mr = row < NLAT ? (row >> 14) : 2;
      const float* md = mods + (size_t)(3 + mr) * 6144;
      float mu2 = wave_sum(s2) * (1.f / 2048.f);
      float q2 = 0;
#pragma unroll
      for (int i = 0; i < 8; ++i) { v[i].x -= mu2; v[i].y -= mu2; v[i].z -= mu2; v[i].w -= mu2; q2 += v[i].x * v[i].x + v[i].y * v[i].y + v[i].z * v[i].z + v[i].w * v[i].w; }
      float rstd2 = rsqrtf(wave_sum(q2) * (1.f / 2048.f) + 1e-6f);
#pragma unroll
      for (int i = 0; i < 8; ++i) {
        int col = i * 256 + lane * 4;
        float4 sh = *(const float4*)(md + col), sc = *(const float4*)(md + 2048 + col);
        uint2 o;
        o.x = pack_bf2(v[i].x * rstd2 * (1.f + sc.x) + sh.x, v[i].y * rstd2 * (1.f + sc.y) + sh.y);
        o.y = pack_bf2(v[i].z * rstd2 * (1.f + sc.z) + sh.z, v[i].w * rstd2 * (1.f + sc.w) + sh.w);
        *(uint2*)(hbuf + (size_t)row * D + col) = o;
      }
    }
  }
}

template <class Epi>
DEV void gemm_phase(const Params& p, const Ctx& cx, const bf16_t* __restrict__ A, const bf16_t* __restrict__ Bt, int K, int nM, int nN, char* smem, Epi epi) {
  const int tid = cx.tid, lane = tid & 63, wid = tid >> 6;
  const int wr = wid >> 2, wc = wid & 3, fr = lane & 15, fq = lane >> 4;
  const int nt = K / 64;
  const int ntiles = nM * nN;
  const int srow = tid >> 3, sc16 = tid & 7;
  const int nxcd = (cx.nblk & 7) == 0 ? 8 : 1;
  const int xcd = cx.bid % nxcd, xidx = cx.bid / nxcd, xper = cx.nblk / nxcd;
  const int t_lo = (int)(((long)ntiles * xcd) / nxcd), t_hi = (int)(((long)ntiles * (xcd + 1)) / nxcd);
  for (int tt = t_lo + xidx; tt < t_hi; tt += xper) {
    const int band = tt / (16 * nN);
    const int brows = min(16, nM - band * 16);
    const int rem = tt - band * 16 * nN;
    const int pn = rem / brows, pm = band * 16 + rem % brows;
    const int brow = pm * 256, bcol = pn * 256;
    const char* Ab = (const char*)(A + (size_t)brow * K);
    const char* Bb = (const char*)(Bt + (size_t)bcol * K);
    const unsigned voff = (unsigned)(srow * K + sc16 * 8) * 2u;
    const size_t rs = (size_t)64 * K * 2;
    f32x4 acc[8][4];
#pragma unroll
    for (int i = 0; i < 8; ++i)
#pragma unroll
      for (int j = 0; j < 4; ++j) acc[i][j] = f32x4{0.f, 0.f, 0.f, 0.f};
    uint4 ra0, ra1, ra2, ra3, rb0, rb1, rb2, rb3;
#define G_LD(ko) { const char* a_ = Ab + (size_t)(ko) * 2; const char* b_ = Bb + (size_t)(ko) * 2; \
                 ra0 = *(const uint4*)(a_ + voff); ra1 = *(const uint4*)(a_ + rs + voff); ra2 = *(const uint4*)(a_ + 2 * rs + voff); ra3 = *(const uint4*)(a_ + 3 * rs + voff); \
                 rb0 = *(const uint4*)(b_ + voff); rb1 = *(const uint4*)(b_ + rs + voff); rb2 = *(const uint4*)(b_ + 2 * rs + voff); rb3 = *(const uint4*)(b_ + 3 * rs + voff); }
#define G_ST(sp) { *(uint4*)(sp) = ra0; *(uint4*)((sp) + 64 * 144) = ra1; *(uint4*)((sp) + 128 * 144) = ra2; *(uint4*)((sp) + 192 * 144) = ra3; \
                 *(uint4*)((sp) + 36864) = rb0; *(uint4*)((sp) + 36864 + 64 * 144) = rb1; *(uint4*)((sp) + 36864 + 128 * 144) = rb2; *(uint4*)((sp) + 36864 + 192 * 144) = rb3; }
    char* const sbase = smem + srow * 144 + sc16 * 16;
    G_LD(0);
    G_ST(sbase);
    if (nt > 1) G_LD(64);
    for (int kt = 0; kt < nt; ++kt) {
      __syncthreads();
      if (kt + 1 < nt) { char* s1 = sbase + ((kt + 1) & 1) * 73728; G_ST(s1); }
      if (kt + 2 < nt) G_LD((kt + 2) * 64);
      const char* As = smem + (kt & 1) * 73728;
      const char* Bs = As + 36864;
#pragma unroll
      for (int kh = 0; kh < 2; ++kh) {
        bf16x8 bfr[4];
#pragma unroll
        for (int jn = 0; jn < 4; ++jn) bfr[jn] = *(const bf16x8*)(Bs + (wc * 64 + jn * 16 + fr) * 144 + kh * 64 + fq * 16);
#pragma unroll
        for (int i = 0; i < 8; ++i) {
          bf16x8 af = *(const bf16x8*)(As + (wr * 128 + i * 16 + fr) * 144 + kh * 64 + fq * 16);
#pragma unroll
          for (int jn = 0; jn < 4; ++jn) acc[i][jn] = __builtin_amdgcn_mfma_f32_16x16x32_f16(bfr[jn], af, acc[i][jn], 0, 0, 0);
        }
      }
    }
    __syncthreads();
#pragma unroll
    for (int i = 0; i < 8; ++i)
#pragma unroll
      for (int jn = 0; jn < 4; ++jn) epi(brow + wr * 128 + i * 16 + fr, bcol + wc * 64 + jn * 16 + fq * 4, acc[i][jn]);
  }
}

#define LAS3 __attribute__((address_space(3)))
DEV int g2_lds_byte(int r, int c) { const int st = (r >> 4) * 2 + (c >> 5), rr = r & 15, cc = c & 31, ob = rr * 64 + cc * 2; return st * 1024 + (ob ^ (((ob >> 9) & 1) << 5)); }
DEV void g2_stage_rc(int b, int& R, int& C) { const int st = b / 1024, sb = b % 1024, swz = sb ^ (((sb >> 9) & 1) << 5); R = (st >> 1) * 16 + swz / 64; C = (st & 1) * 32 + (swz % 64) / 2; }

template <class Epi>
DEV void gemm_phase2(const Params& p, const Ctx& cx, const bf16_t* __restrict__ A, const bf16_t* __restrict__ Bt, int K, int nM, int nN, char* smem, Epi epi) {
  constexpr int HTB = 128 * 64 * 2;
  LAS3 unsigned char* lds = (LAS3 unsigned char*)smem;
  const int tid = cx.tid, wid = __builtin_amdgcn_readfirstlane(tid >> 6), lane = tid & 63, wr = wid >> 2, wc = wid & 3, fr = lane & 15, fq = lane >> 4;
  const int nt = K / 64;
  const int ntiles = nM * nN;
  const int nxcd = (cx.nblk & 7) == 0 ? 8 : 1;
  const int xcd = cx.bid % nxcd, xidx = cx.bid / nxcd, xper = cx.nblk / nxcd;
  const int t_lo = (int)(((long)ntiles * xcd) / nxcd), t_hi = (int)(((long)ntiles * (xcd + 1)) / nxcd);
  auto unit_at = [&](int i, int& pm, int& pn) -> bool {
    const int tt = t_lo + xidx + i * xper;
    if (tt >= t_hi) return false;
    const int band = tt / (8 * nN);
    const int brows = min(8, nM - band * 8);
    const int rem = tt - band * 8 * nN;
    pn = rem / brows; pm = band * 8 + rem % brows;
    return true;
  };
  unsigned voffA[2], voffB[2];
#pragma unroll
  for (int i = 0; i < 2; ++i) {
    int R, C; g2_stage_rc(tid * 16 + i * 8192, R, C);
    const int rho = R & 31, Rb = (R & ~31) + 8 * ((rho & 15) >> 2) + 4 * (rho >> 4) + (rho & 3);
    voffA[i] = (unsigned)(R * K + C) * 2u; voffB[i] = (unsigned)(Rb * K + C) * 2u;
  }
  const size_t kstep = (size_t)(64 * 2);
  const size_t hstep = (size_t)128 * K * 2;
  const size_t tstep = 2 * hstep;
  const unsigned ldsw = (unsigned)wid * 1024u;
  const int aoff = g2_lds_byte(wr * 64 + fr, fq * 8), boff = g2_lds_byte(wc * 32 + fr, fq * 8);
#define G2_SA(b, h) (((b) * 2 + (h)) * HTB)
#define G2_SB(b, h) ((4 + (b) * 2 + (h)) * HTB)
#define G2_STAGE_(bufoff, gbase, vo_) do { _Pragma("unroll") for (int _i = 0; _i < 2; ++_i) \
    __builtin_amdgcn_global_load_lds((const unsigned*)((const char*)(gbase) + vo_[_i]), (LAS3 unsigned*)(lds + (bufoff) + ldsw + _i * 8192), 16, 0, 0); } while (0)
#define G2_STAGE(bufoff, gbase) G2_STAGE_(bufoff, gbase, voffA)
#define G2_STAGEB(bufoff, gbase) G2_STAGE_(bufoff, gbase, voffB)
#define G2_LDA(dst, b, h) do { _Pragma("unroll") for (int m = 0; m < 4; ++m) _Pragma("unroll") for (int k = 0; k < 2; ++k) dst[m][k] = *(const LAS3 bf16x8*)(lds + G2_SA(b, h) + aoff + m * 2048 + k * 1024); } while (0)
#define G2_LDB(dst, b, h) do { _Pragma("unroll") for (int n = 0; n < 2; ++n) _Pragma("unroll") for (int k = 0; k < 2; ++k) dst[n][k] = *(const LAS3 bf16x8*)(lds + G2_SB(b, h) + boff + n * 2048 + k * 1024); } while (0)
#define G2_MMA(ai, bj, At_, Bt_) do { __builtin_amdgcn_s_setprio(1); _Pragma("unroll") for (int m = 0; m < 4; ++m) _Pragma("unroll") for (int n = 0; n < 2; ++n) _Pragma("unroll") for (int k = 0; k < 2; ++k) \
    acc[ai][bj][m][n] = __builtin_amdgcn_mfma_f32_16x16x32_f16(Bt_[n][k], At_[m][k], acc[ai][bj][m][n], 0, 0, 0); __builtin_amdgcn_s_setprio(0); } while (0)
#define G2_WAIT_V(n) asm volatile("s_waitcnt vmcnt(" #n ")" ::: "memory")
#define G2_WAIT_L(n) asm volatile("s_waitcnt lgkmcnt(" #n ")" ::: "memory")
#define G2_BAR __builtin_amdgcn_s_barrier()
#define G2_SCHED __builtin_amdgcn_sched_barrier(0)
  int cpm, cpn, npm = 0, npn = 0, ui = 0;
  if (!unit_at(0, cpm, cpn)) return;
  f32x4 acc[2][2][4][2];
#pragma unroll
  for (int a = 0; a < 2; ++a)
#pragma unroll
    for (int b = 0; b < 2; ++b)
#pragma unroll
      for (int m = 0; m < 4; ++m)
#pragma unroll
        for (int n = 0; n < 2; ++n) acc[a][b][m][n] = f32x4{0.f, 0.f, 0.f, 0.f};
  bf16x8 At[4][2], B0[2][2], B1[2][2];
  const char* cA = (const char*)A + (size_t)cpm * tstep;
  const char* cB = (const char*)Bt + (size_t)cpn * tstep;
  G2_STAGEB(G2_SB(0, 0), cB); G2_STAGE(G2_SA(0, 0), cA); G2_STAGEB(G2_SB(0, 1), cB + hstep); G2_STAGE(G2_SA(0, 1), cA + hstep);
  if (wr == 1) G2_BAR;
  G2_WAIT_V(4); G2_BAR;
  G2_STAGEB(G2_SB(1, 0), cB + kstep); G2_STAGE(G2_SA(1, 0), cA + kstep); G2_STAGEB(G2_SB(1, 1), cB + hstep + kstep);
  G2_WAIT_V(6); G2_BAR;
  for (;;) {
    const bool has_next = unit_at(ui + 1, npm, npn);
    const char* nA = has_next ? (const char*)A + (size_t)npm * tstep : cA;
    const char* nB = has_next ? (const char*)Bt + (size_t)npn * tstep : cB;
    for (int t = 0; t < nt; t += 2) {
      const bool last = (t == nt - 2);
      const char* a1 = cA + (size_t)(t + 1) * kstep;
      const char* a2 = last ? nA : cA + (size_t)(t + 2) * kstep;
      const char* b2 = last ? nB : cB + (size_t)(t + 2) * kstep;
      const char* a3 = a2 + kstep;
      const char* b3 = b2 + kstep;
      G2_LDB(B0, 0, 0); G2_SCHED; G2_LDA(At, 0, 0); G2_STAGE(G2_SA(1, 1), a1 + hstep);
      G2_WAIT_L(8); G2_BAR; G2_WAIT_L(0); G2_MMA(0, 0, At, B0); G2_BAR; G2_SCHED;
      G2_LDB(B1, 0, 1); G2_STAGEB(G2_SB(0, 0), b2);
      G2_BAR; G2_WAIT_L(0); G2_MMA(0, 1, At, B1); G2_BAR;
      G2_LDA(At, 0, 1); G2_STAGE(G2_SA(0, 0), a2);
      G2_BAR; G2_WAIT_L(0); G2_MMA(1, 0, At, B0); G2_BAR; G2_SCHED;
      G2_STAGEB(G2_SB(0, 1), b2 + hstep);
      G2_WAIT_V(6); G2_BAR; G2_MMA(1, 1, At, B1); G2_BAR;
      G2_LDB(B0, 1, 0); G2_SCHED; G2_LDA(At, 1, 0); G2_STAGE(G2_SA(0, 1), a2 + hstep);
      G2_WAIT_L(8); G2_BAR; G2_WAIT_L(0); G2_MMA(0, 0, At, B0); G2_BAR; G2_SCHED;
      G2_LDB(B1, 1, 1); G2_STAGEB(G2_SB(1, 0), b3);
      G2_BAR; G2_WAIT_L(0); G2_MMA(0, 1, At, B1); G2_BAR;
      G2_LDA(At, 1, 1); G2_STAGE(G2_SA(1, 0), a3);
      G2_BAR; G2_WAIT_L(0); G2_MMA(1, 0, At, B0); G2_BAR; G2_SCHED;
      G2_STAGEB(G2_SB(1, 1), b3 + hstep);
      G2_WAIT_V(6); G2_BAR; G2_MMA(1, 1, At, B1); G2_BAR;
    }
    {
      const int row0 = cpm * 256 + wr * 64 + fr, col0 = cpn * 256 + wc * 32 + 8 * fq;
#pragma unroll
      for (int ai = 0; ai < 2; ++ai)
#pragma unroll
        for (int m = 0; m < 4; ++m)
#pragma unroll
          for (int bj = 0; bj < 2; ++bj) epi(row0 + ai * 128 + m * 16, col0 + bj * 128, acc[ai][bj][m][0], acc[ai][bj][m][1]);
    }
    if (!has_next) break;
#pragma unroll
    for (int a = 0; a < 2; ++a)
#pragma unroll
      for (int b = 0; b < 2; ++b)
#pragma unroll
        for (int m = 0; m < 4; ++m)
#pragma unroll
          for (int n = 0; n < 2; ++n) acc[a][b][m][n] = f32x4{0.f, 0.f, 0.f, 0.f};
    cpm = npm; cpn = npn; cA = nA; cB = nB; ++ui;
  }
  G2_WAIT_V(0);
  if (wr == 0) G2_BAR;
  G2_BAR;
#undef G2_SA
#undef G2_SB
#undef G2_STAGE
#undef G2_STAGEB
#undef G2_STAGE_
#undef G2_LDA
#undef G2_LDB
#undef G2_MMA
#undef G2_WAIT_V
#undef G2_WAIT_L
#undef G2_BAR
#undef G2_SCHED
}

template <int K, int NT, class Epi>
DEV void small_gemm(const Params& p, const Ctx& cx, const char* As, int astride, const bf16_t* __restrict__ Bt, int n0, Epi epi) {
  const int lane = cx.tid & 63, fr = lane & 15, fq = lane >> 4;
  f32x4 acc[4][NT];
#pragma unroll
  for (int i = 0; i < 4; ++i)
#pragma unroll
    for (int j = 0; j < NT; ++j) acc[i][j] = f32x4{0.f, 0.f, 0.f, 0.f};
#pragma unroll 2
  for (int k0 = 0; k0 < K; k0 += 32) {
    bf16x8 af[4];
#pragma unroll
    for (int i = 0; i < 4; ++i) af[i] = *(const bf16x8*)(As + (i * 16 + fr) * astride + (k0 + fq * 8) * 2);
#pragma unroll
    for (int jn = 0; jn < NT; ++jn) {
      bf16x8 bf = *(const bf16x8*)(Bt + (size_t)(n0 + jn * 16 + fr) * K + k0 + fq * 8);
#pragma unroll
      for (int i = 0; i < 4; ++i) acc[i][jn] = __builtin_amdgcn_mfma_f32_16x16x32_f16(bf, af[i], acc[i][jn], 0, 0, 0);
    }
  }
#pragma unroll
  for (int i = 0; i < 4; ++i)
#pragma unroll
    for (int jn = 0; jn < NT; ++jn) epi(i * 16 + fr, n0 + jn * 16 + fq * 4, acc[i][jn]);
}

struct S5P { float ar, ai, br, bi; };
DEV S5P s5_params(const Params& p, const Ctx& cx, int l, int d, int g, int lane) {
  int idx = ((l * 2 + d) * 32 + g) * 64 + lane;
  float lr = fminf(p.s5_lam_re[idx], -1e-4f), li = p.s5_lam_im[idx];
  float step = expf(p.s5_log_step[(l * 2 + d) * 32 + g]);
  float xr = lr * step, xi = li * step;
  float e = expf(xr), cs = cosf(xi), sn = sinf(xi);
  S5P r;
  r.ar = e * cs; r.ai = e * sn;
  float sh = sinf(0.5f * xi);
  float nr = expm1f(xr) * cs - 2.f * sh * sh, ni = e * sn;
  float inv = 1.f / (lr * lr + li * li);
  r.br = (nr * lr + ni * li) * inv;
  r.bi = (ni * lr - nr * li) * inv;
  return r;
}

DEV void s5_load_u(const h16* zrest, int rowbase, int g, char* ulds, int lane) {
#pragma unroll
  for (int i = 0; i < 8; ++i) {
    int e = i * 64 + lane;
    int r = e >> 1, hf = e & 1;
    uint4 v = *(const uint4*)(zrest + (size_t)(rowbase + r) * ZR + g * 16 + hf * 8);
    *(uint4*)(ulds + r * 32 + hf * 16) = v;
  }
  lds_fence();
}

DEV int s5_rowbase(int b, int c) { return c == 0 ? NLAT + b * 256 : b * 16384 + (c - 1) * 256; }

DEV void s5_pass1_unit(const Params& p, const Ctx& cx, int l, int unit, char* wl, int lane) {
  int c = unit % 65, bg = unit / 65, g = bg & 31, b = bg >> 5;
  const h16* zrest = (const h16*)(p.ws + OFF_ZREST);
  float2* F = (float2*)(p.ws + OFF_S5F);
  s5_load_u(zrest, s5_rowbase(b, c), g, wl, lane);
  float Br[16], Bi[16];
  {
    const float* pr = p.s5_b_re + ((size_t)(l * 32 + g) * 64 + lane) * 16;
    const float* pi = p.s5_b_im + ((size_t)(l * 32 + g) * 64 + lane) * 16;
#pragma unroll
    for (int i = 0; i < 16; i += 4) {
      float4 a = *(const float4*)(pr + i), bq = *(const float4*)(pi + i);
      Br[i] = a.x; Br[i + 1] = a.y; Br[i + 2] = a.z; Br[i + 3] = a.w;
      Bi[i] = bq.x; Bi[i + 1] = bq.y; Bi[i + 2] = bq.z; Bi[i + 3] = bq.w;
    }
  }
  S5P pf = s5_params(p, cx, l, 0, g, lane), pb = s5_params(p, cx, l, 1, g, lane);
  float xr = 0, xi = 0, yr = 0, yi = 0, pwr = 1.f, pwi = 0.f;
#pragma unroll 4
  for (int t = 0; t < 256; ++t) {
    h16x8 u0 = *(const h16x8*)(wl + t * 32), u1 = *(const h16x8*)(wl + t * 32 + 16);
    float br = 0, bi = 0;
#pragma unroll
    for (int i = 0; i < 8; ++i) { float u = (float)u0[i]; br = fmaf(u, Br[i], br); bi = fmaf(u, Bi[i], bi); }
#pragma unroll
    for (int i = 0; i < 8; ++i) { float u = (float)u1[i]; br = fmaf(u, Br[8 + i], br); bi = fmaf(u, Bi[8 + i], bi); }
    float nxr = pf.ar * xr - pf.ai * xi + br, nxi = pf.ar * xi + pf.ai * xr + bi;
    xr = nxr; xi = nxi;
    yr += pwr * br - pwi * bi; yi += pwr * bi + pwi * br;
    float npr = pwr * pb.ar - pwi * pb.ai, npi = pwr * pb.ai + pwi * pb.ar;
    pwr = npr; pwi = npi;
  }
  size_t fi = (((size_t)(b * 32 + g) * 65 + c) * 2) * 64 + lane;
  F[fi] = make_float2(pf.br * xr - pf.bi * xi, pf.br * xi + pf.bi * xr);
  F[fi + 64] = make_float2(pb.br * yr - pb.bi * yi, pb.br * yi + pb.bi * yr);
}

DEV void s5_pass3_unit(const Params& p, const Ctx& cx, int l, int unit, char* wl, int lane) {
  int c = unit % 65, bg = unit / 65, g = bg & 31, b = bg >> 5;
  const int fr = lane & 15, fq = lane >> 4;
  const h16* zrest = (const h16*)(p.ws + OFF_ZREST);
  const float2* F = (const float2*)(p.ws + OFF_S5F);
  float* S5Y = (float*)(p.ws + OFF_S5Y);
  const int rowbase = s5_rowbase(b, c);
  char* ulds = wl;
  char* tile = wl + 8192;
  s5_load_u(zrest, rowbase, g, ulds, lane);
  float Br[16], Bi[16];
  {
    const float* pr = p.s5_b_re + ((size_t)(l * 32 + g) * 64 + lane) * 16;
    const float* pi = p.s5_b_im + ((size_t)(l * 32 + g) * 64 + lane) * 16;
#pragma unroll
    for (int i = 0; i < 16; i += 4) {
      float4 a = *(const float4*)(pr + i), bq = *(const float4*)(pi + i);
      Br[i] = a.x; Br[i + 1] = a.y; Br[i + 2] = a.z; Br[i + 3] = a.w;
      Bi[i] = bq.x; Bi[i + 1] = bq.y; Bi[i + 2] = bq.z; Bi[i + 3] = bq.w;
    }
  }
  const float dsk = p.s5_d[(size_t)l * 512 + g * 16 + fr];
  const size_t fbase = ((size_t)(b * 32 + g) * 65) * 2 * 64 + lane;
#pragma unroll 1
  for (int d = 0; d < 2; ++d) {
    S5P pp = s5_params(p, cx, l, d, g, lane);
    float qr = pp.ar, qi = pp.ai;
#pragma unroll
    for (int i = 0; i < 8; ++i) { float t = qr * qr - qi * qi; qi = 2.f * qr * qi; qr = t; }
    float xr = 0, xi = 0;
    if (d == 0) {
      for (int cc = 0; cc < c; ++cc) {
        float2 f = F[fbase + (size_t)(cc * 2 + 0) * 64];
        float t = qr * xr - qi * xi + f.x; xi = qr * xi + qi * xr + f.y; xr = t;
      }
    } else if (c > 0) {
      float2 f0 = F[fbase + (size_t)(0 * 2 + 1) * 64];
      xr = f0.x; xi = f0.y;
      for (int cc = 64; cc > c; --cc) {
        float2 f = F[fbase + (size_t)(cc * 2 + 1) * 64];
        float t = qr * xr - qi * xi + f.x; xi = qr * xi + qi * xr + f.y; xr = t;
      }
    }
    bf16x8 chi[4], clo[4];
    {
      const float* cr = p.s5_c_re + ((size_t)((l * 2 + d) * 32 + g) * 16 + fr) * 64;
      const float* ci = p.s5_c_im + ((size_t)((l * 2 + d) * 32 + g) * 16 + fr) * 64;
#pragma unroll
      for (int ks = 0; ks < 4; ++ks) {
        float4 a = *(const float4*)(cr + ks * 16 + fq * 4), bq = *(const float4*)(ci + ks * 16 + fq * 4);
        float vals[8] = {a.x, -bq.x, a.y, -bq.y, a.z, -bq.z, a.w, -bq.w};
#pragma unroll
        for (int j = 0; j < 8; ++j) {
          h16 hh = (h16)vals[j];
          chi[ks][j] = hh;
          clo[ks][j] = (h16)(vals[j] - (float)hh);
        }
      }
    }
#pragma unroll 1
    for (int sb = 0; sb < 16; ++sb) {
      const int sub = d == 0 ? sb : 15 - sb;
#pragma unroll 4
      for (int q = 0; q < 16; ++q) {
        const int tt = d == 0 ? q : 15 - q;
        const int t = sub * 16 + tt;
        h16x8 u0 = *(const h16x8*)(ulds + t * 32), u1 = *(const h16x8*)(ulds + t * 32 + 16);
        float br = 0, bi = 0;
#pragma unroll
        for (int i = 0; i < 8; ++i) { float u = (float)u0[i]; br = fmaf(u, Br[i], br); bi = fmaf(u, Bi[i], bi); }
#pragma unroll
        for (int i = 0; i < 8; ++i) { float u = (float)u1[i]; br = fmaf(u, Br[8 + i], br); bi = fmaf(u, Bi[8 + i], bi); }
        float vr = pp.br * br - pp.bi * bi, vi = pp.br * bi + pp.bi * br;
        float nxr = pp.ar * xr - pp.ai * xi + vr, nxi = pp.ar * xi + pp.ai * xr + vi;
        xr = nxr; xi = nxi;
        h16x2 hv2 = {(h16)xr, (h16)xi};
        *(unsigned*)(tile + tt * 272 + lane * 4) = __builtin_bit_cast(unsigned, hv2);
      }
      lds_fence();
      f32x4 acc = f32x4{0.f, 0.f, 0.f, 0.f};
#pragma unroll
      for (int ks = 0; ks < 4; ++ks) {
        bf16x8 ah = *(const bf16x8*)(tile + fr * 272 + ks * 64 + fq * 16);
        acc = __builtin_amdgcn_mfma_f32_16x16x32_f16(ah, chi[ks], acc, 0, 0, 0);
        acc = __builtin_amdgcn_mfma_f32_16x16x32_f16(ah, clo[ks], acc, 0, 0, 0);
      }
      lds_fence();
#pragma unroll
      for (int r = 0; r < 4; ++r) {
        int tl = sub * 16 + fq * 4 + r;
        float* yp = S5Y + (size_t)(rowbase + tl) * 512 + g * 16 + fr;
        if (d == 0) {
          float u = (float)*(const h16*)(ulds + tl * 32 + fr * 2);
          *yp = acc[r] + dsk * u;
        } else {
          *yp = gelu_f(*yp + acc[r]);
        }
      }
    }
  }
}

DEV void prep_item(const Params& p, const Ctx& cx, int l, int item, char* smem) {
  const int tile = item >> 2, q = item & 3;
  const int row0 = tile * 64;
  const int tid = cx.tid;
  const h16* zc = (const h16*)(p.ws + OFF_REG2);
  h16* SC = (h16*)(p.ws + OFF_SCAN);
  const char* wt = p.ws + OFF_WT + (size_t)l * WT_SIZE;
  {
    const int d = q >> 1, isA = q & 1;
    const int coff = isA ? 3200 + d * 64 : 3072 + d * 64;
    int tok = tid >> 3, c8 = tid & 7;
    h16x8 cv = *(const h16x8*)(zc + (size_t)(row0 + tok) * ZC + coff + c8 * 8);
    float f[8];
#pragma unroll
    for (int j = 0; j < 8; ++j) { f[j] = (float)cv[j]; if (!isA) f[j] = tanh_f(f[j]); }
    uint4 o;
    o.x = pack_bf2(f[0], f[1]); o.y = pack_bf2(f[2], f[3]); o.z = pack_bf2(f[4], f[5]); o.w = pack_bf2(f[6], f[7]);
    *(uint4*)(smem + tok * 144 + c8 * 16) = o;
    __syncthreads();
    const bf16_t* Bt = (const bf16_t*)(wt + (isA ? WT_A2 : WT_W2)) + (size_t)d * 1024 * 64;
    const float* biasw = p.rwkv_w0 + (size_t)(l * 2 + d) * 1024;
    const float* biasa = p.rwkv_a0 + (size_t)(l * 2 + d) * 1024;
    h16* dst = SC + (size_t)(isA ? 4 + d : 6 + d) * ARR;
#pragma unroll 1
    for (int hf = 0; hf < 2; ++hf) small_gemm<64, 4>(p, cx, smem, 144, Bt, (tid >> 6) * 128 + hf * 64, [&](int m, int n, f32x4 v) {
      float4 bbw = *(const float4*)(biasw + n), bba = *(const float4*)(biasa + n);
      float4 bb = isA ? bba : bbw;
      float r0 = sigmoid_f(v[0] + bb.x), r1 = sigmoid_f(v[1] + bb.y), r2 = sigmoid_f(v[2] + bb.z), r3 = sigmoid_f(v[3] + bb.w);
      if (!isA) { r0 = __expf(-DECAY_SCALE * r0); r1 = __expf(-DECAY_SCALE * r1); r2 = __expf(-DECAY_SCALE * r2); r3 = __expf(-DECAY_SCALE * r3); }
      h16x4 o4 = {(h16)r0, (h16)r1, (h16)r2, (h16)r3};
      *(h16x4*)(dst + (size_t)(row0 + m) * 1024 + n) = o4;
    });
  }
  {
    const float* cw = p.conv_rkv + (size_t)l * 3 * 3072;
    const int grp = tid & 7, hh = (tid >> 3) & 3;
    const int c0 = (4 * q + hh) * 64 + grp * 8;
    float cwt[3][3][8];
#pragma unroll
    for (int s = 0; s < 3; ++s)
#pragma unroll
      for (int tp = 0; tp < 3; ++tp)
#pragma unroll
        for (int j = 0; j < 8; j += 4) {
          float4 a = *(const float4*)(cw + tp * 3072 + s * 1024 + c0 + j);
          cwt[s][tp][j] = a.x; cwt[s][tp][j + 1] = a.y; cwt[s][tp][j + 2] = a.z; cwt[s][tp][j + 3] = a.w;
        }
    float kkw[8];
#pragma unroll
    for (int j = 0; j < 8; j += 4) {
      float4 kq = *(const float4*)(p.rwkv_k_k + (size_t)l * 1024 + c0 + j);
      kkw[j] = kq.x; kkw[j + 1] = kq.y; kkw[j + 2] = kq.z; kkw[j + 3] = kq.w;
    }
#pragma unroll 1
    for (int it = 0; it < 4; ++it) {
      const int tok = (tid >> 5) + it * 16;
      const int row = row0 + tok;
      bool hasp, hasn;
      if (row < NLAT) { hasp = (row & 16383) != 0; hasn = (row & 16383) != 16383; }
      else { hasp = (row & 255) != 0; hasn = (row & 255) != 255; }
      const size_t off = (size_t)row * 1024 + c0;
      const h16* zp = zc + (size_t)row * ZC + c0;
      const h16* zpp = hasp ? zp - ZC : zp;
      const h16* zpn = hasn ? zp + ZC : zp;
      h16x8 cur[3], prv[3], nxt[3];
#pragma unroll
      for (int s = 0; s < 3; ++s) { cur[s] = *(const h16x8*)(zp + s * 1024); prv[s] = *(const h16x8*)(zpp + s * 1024); nxt[s] = *(const h16x8*)(zpn + s * 1024); }
      const float fp = hasp ? 1.f : 0.f, fn = hasn ? 1.f : 0.f;
      float kv[8];
#pragma unroll
      for (int s = 0; s < 3; ++s) {
        h16x8 o;
#pragma unroll
        for (int j = 0; j < 8; ++j) {
          float ov = cwt[s][0][j] * (fp * (float)prv[s][j]) + cwt[s][1][j] * (float)cur[s][j] + cwt[s][2][j] * (fn * (float)nxt[s][j]);
          o[j] = (h16)ov;
          if (s == 1) kv[j] = ov;
        }
        *(h16x8*)(SC + (size_t)s * ARR + off) = o;
      }
      float kk[8], ss = 0;
#pragma unroll
      for (int j = 0; j < 8; ++j) { kk[j] = kv[j] * kkw[j]; ss += kk[j] * kk[j]; }
      ss = allreduce8(ss);
      float inv = rcp_f(fmaxf(sqrtf(ss), 1e-12f));
      h16x8 o;
#pragma unroll
      for (int j = 0; j < 8; ++j) o[j] = (h16)(kk[j] * inv);
      *(h16x8*)(SC + 3 * ARR + off) = o;
    }
  }
}

DEV void phase_prep(const Params& p, const Ctx& cx0, int l, char* smem) {
  const int NPREP = 520 * 4, NS5 = 520;
  const Ctx& cx_ = cx0;
  for (int item = cx_.bid; item < NPREP + NS5; item += cx_.nblk) {
    __syncthreads();
    Ctx cx = cx0; asm volatile("" : "+v"(cx.tid));
    const int lane = cx.tid & 63, wid = cx.tid >> 6;
#ifndef NO_PREPITEM
    if (item < NPREP) prep_item(p, cx, l, item, smem);
    else
#endif
#ifndef NO_S5P1
      s5_pass1_unit(p, cx, l, (item - NPREP) * 8 + wid, smem + wid * 8192, lane);
#else
    {}
#endif
  }
}

typedef unsigned u2v __attribute__((ext_vector_type(2)));
struct RG { u2v w, a, kk, k, r; h16 v; };

constexpr int RW_NSLOT = 8, RW_SLOTB = 3072;
constexpr int RW_FLAGS = RW_NSLOT * RW_SLOTB;
constexpr int RW_NG = 16640 / 4;
typedef float f4v __attribute__((ext_vector_type(4)));

#define RW_RLO(gq, rlo)                                                            \
  {                                                                                \
    const int gg = (gq) < RW_NG ? (gq) : RW_NG - 1;                                \
    const int q0_ = gg * 4;                                                        \
    const int isl = q0_ >= 256;                                                    \
    const int base_ = isl ? b * 16384 : NLAT + b * 256;                            \
    const int t0_ = isl ? q0_ - 256 : q0_;                                         \
    const int last_ = isl ? 16383 : 255;                                           \
    rlo = base_ + (d ? last_ - t0_ - 3 : t0_);                                     \
  }

DEV void rwkv_helper(const Params& p, const Ctx& cx, int l, int unit, int lane, char* ring) {
  const int d = unit & 1, h = (unit >> 1) & 15, b = unit >> 5;
  const int j = lane >> 4, s = lane & 15;
  const h16* SC = (const h16*)(p.ws + OFF_SCAN);
  const char* pR = (const char*)(SC + 0 * ARR + h * 64);
  const char* pK = (const char*)(SC + 1 * ARR + h * 64);
  const char* pV = (const char*)(SC + 2 * ARR + h * 64);
  const char* pKK = (const char*)(SC + 3 * ARR + h * 64);
  const char* pA = (const char*)(SC + (size_t)(4 + d) * ARR + h * 64);
  const char* pW = (const char*)(SC + (size_t)(6 + d) * ARR + h * 64);
  const int jm = d ? 3 - j : j;
  const unsigned vo0 = (unsigned)(jm * 2048 + s * 8);
  f4v ka4, om4;
  {
    float4 t = *(const float4*)(p.rwkv_k_a + (size_t)l * 1024 + h * 64 + 4 * s);
    ka4 = f4v{t.x, t.y, t.z, t.w};
    om4 = 1.f - ka4;
  }
  struct RGH { u2v w, a, kk, k, r, v; };
  RGH q0, q1, q2, q3, q4, q5, q6, q7;
  const unsigned wofs = (unsigned)(j * 128 + s * 8);
  const unsigned vwofs = (unsigned)(2560 + j * 128 + s * 8);
  LAS3 volatile int* pflag = (LAS3 volatile int*)(ring + RW_FLAGS);
  LAS3 volatile int* cflag = (LAS3 volatile int*)(ring + RW_FLAGS + 64);
  int cmin = 0;
#define CV4(uv) __builtin_convertvector(__builtin_bit_cast(h16x4, uv), f4v)
#define RH_LOAD(q, gq)                                                             \
  {                                                                                \
    int rlo; RW_RLO(gq, rlo);                                                      \
    unsigned vo = vo0; asm volatile("" : "+v"(vo));                                \
    const size_t off = (size_t)rlo * 2048;                                         \
    q.w = *(const u2v*)(pW + off + vo); q.a = *(const u2v*)(pA + off + vo);        \
    q.kk = *(const u2v*)(pKK + off + vo); q.k = *(const u2v*)(pK + off + vo);      \
    q.r = *(const u2v*)(pR + off + vo); q.v = *(const u2v*)(pV + off + vo);        \
  }
#define RH_STEP(q, gq)                                                             \
  {                                                                                \
    if ((gq) >= RW_NSLOT && cmin < (gq) - RW_NSLOT + 1) {                          \
      do {                                                                         \
        const int c0_ = cflag[0], c1_ = cflag[1], c2_ = cflag[2], c3_ = cflag[3];  \
        cmin = __builtin_amdgcn_readfirstlane(min(min(c0_, c1_), min(c2_, c3_)));  \
        if (cmin < (gq) - RW_NSLOT + 1) __builtin_amdgcn_s_sleep(1);               \
      } while (cmin < (gq) - RW_NSLOT + 1);                                        \
    }                                                                              \
    asm volatile("" ::: "memory");                                                 \
    char* sl = ring + ((gq) % RW_NSLOT) * RW_SLOTB;                                \
    const f4v a_ = CV4(q.a), kk_ = CV4(q.kk);                                      \
    const f4v kka_ = kk_ * a_, kd_ = CV4(q.k) * (a_ * ka4 + om4);                  \
    *(u2v*)(sl + 0 * 512 + wofs) = q.w;                                            \
    *(u2v*)(sl + 1 * 512 + wofs) = q.kk;                                           \
    *(u2v*)(sl + 2 * 512 + wofs) = __builtin_bit_cast(u2v, __builtin_convertvector(kka_, h16x4)); \
    *(u2v*)(sl + 3 * 512 + wofs) = __builtin_bit_cast(u2v, __builtin_convertvector(kd_, h16x4));  \
    *(u2v*)(sl + 4 * 512 + wofs) = q.r;                                            \
    *(u2v*)(sl + vwofs) = q.v;                                                     \
    asm volatile("s_waitcnt lgkmcnt(0)" ::: "memory");     \
    *pflag = (gq) + 1;                                                             \
  }
  RH_LOAD(q0, 0); RH_LOAD(q1, 1); RH_LOAD(q2, 2); RH_LOAD(q3, 3); RH_LOAD(q4, 4); RH_LOAD(q5, 5); RH_LOAD(q6, 6); RH_LOAD(q7, 7);
#pragma unroll 1
  for (int g = 0; g < RW_NG; g += 8) {
    RH_STEP(q0, g); RH_LOAD(q0, g + 8); __builtin_amdgcn_sched_barrier(0);
    RH_STEP(q1, g + 1); RH_LOAD(q1, g + 9); __builtin_amdgcn_sched_barrier(0);
    RH_STEP(q2, g + 2); RH_LOAD(q2, g + 10); __builtin_amdgcn_sched_barrier(0);
    RH_STEP(q3, g + 3); RH_LOAD(q3, g + 11); __builtin_amdgcn_sched_barrier(0);
    RH_STEP(q4, g + 4); RH_LOAD(q4, g + 12); __builtin_amdgcn_sched_barrier(0);
    RH_STEP(q5, g + 5); RH_LOAD(q5, g + 13); __builtin_amdgcn_sched_barrier(0);
    RH_STEP(q6, g + 6); RH_LOAD(q6, g + 14); __builtin_amdgcn_sched_barrier(0);
    RH_STEP(q7, g + 7); RH_LOAD(q7, g + 15); __builtin_amdgcn_sched_barrier(0);
  }
#undef RH_LOAD
#undef RH_STEP
#undef CV4
}

DEV void rwkv_consumer(const Params& p, const Ctx& cx, int l, int task, int lane, const char* ring, int widx) {
  const int unit = task >> 4, d = unit & 1, h = (unit >> 1) & 15, b = unit >> 5;
  const int j = lane >> 4, s = lane & 15;
  const int myrow = (task & 15) * 4 + j;
  char* pO = (char*)((h16*)(p.ws + OFF_REG2) + (size_t)d * ARR + h * 64);
  const int sm = d ? 3 - (s & 3) : (s & 3);
  const unsigned vov0 = (unsigned)(sm * 2048 + myrow * 2);
  const unsigned rofs = (unsigned)(s * 8);
  const unsigned vrofs = (unsigned)(2560 + myrow * 2);
  LAS3 volatile int* pflag = (LAS3 volatile int*)(ring + RW_FLAGS);
  LAS3 volatile int* cflag = (LAS3 volatile int*)(ring + RW_FLAGS + 64) + widx;
  float S0 = 0.f, S1 = 0.f, S2 = 0.f, S3 = 0.f;
  int pseen = 0;
  struct GD { u2v w[4], kk[4], kka[4], kd[4], r[4]; unsigned v[4]; };
  GD A, B;
#define RC_WAIT(gq) { if (pseen <= (gq)) { do { pseen = __builtin_amdgcn_readfirstlane(*pflag); if (pseen <= (gq)) __builtin_amdgcn_s_sleep(1); } while (pseen <= (gq)); } asm volatile("" ::: "memory"); }
#define RC_LOAD(G, gq)                                                             \
  {                                                                                \
    const char* sl = ring + ((gq) % RW_NSLOT) * RW_SLOTB;                          \
    _Pragma("unroll") for (int u = 0; u < 4; ++u) {                                \
      G.w[u] = *(const u2v*)(sl + 0 * 512 + u * 128 + rofs);                       \
      G.kk[u] = *(const u2v*)(sl + 1 * 512 + u * 128 + rofs);                      \
      G.kka[u] = *(const u2v*)(sl + 2 * 512 + u * 128 + rofs);                     \
      G.kd[u] = *(const u2v*)(sl + 3 * 512 + u * 128 + rofs);                      \
      G.r[u] = *(const u2v*)(sl + 4 * 512 + u * 128 + rofs);                       \
      G.v[u] = *(const unsigned short*)(sl + u * 128 + vrofs);                     \
    }                                                                              \
  }
#define RC_COMP(G, gq)                                                             \
  {                                                                                \
    float dres[4];                                                                 \
    _Pragma("unroll") for (int u = 0; u < 4; ++u) {                                \
        \
        \
      float ea, eb, x_, y_, t0, t1, t2, t3;                                        \
      asm("v_fma_mix_f32 %6, %0, %12, 0 op_sel:[0,0,0] op_sel_hi:[0,1,0]\n\t"      \
          "v_fma_mix_f32 %7, %2, %13, 0 op_sel:[0,0,0] op_sel_hi:[0,1,0]\n\t"      \
          "v_fma_mix_f32 %6, %1, %12, %6 op_sel:[0,1,0] op_sel_hi:[0,1,0]\n\t"     \
          "v_fma_mix_f32 %7, %3, %13, %7 op_sel:[0,1,0] op_sel_hi:[0,1,0]\n\t"     \
          "v_fma_mix_f32 %8, %22, %16, 0 op_sel:[0,0,0] op_sel_hi:[1,1,0]\n\t"     \
          "v_add_f32 %6, %6, %7\n\t"                                               \
          "v_fma_mix_f32 %9, %22, %16, 0 op_sel:[0,1,0] op_sel_hi:[1,1,0]\n\t"     \
          "v_fma_mix_f32 %10, %22, %17, 0 op_sel:[0,0,0] op_sel_hi:[1,1,0]\n\t"    \
          "v_add_f32_dpp %6, %6, %6 quad_perm:[1,0,3,2] row_mask:0xf bank_mask:0xf bound_ctrl:1\n\t" \
          "v_fma_mix_f32 %11, %22, %17, 0 op_sel:[0,1,0] op_sel_hi:[1,1,0]\n\t"    \
          "v_fma_mix_f32 %0, %0, %14, %8 op_sel:[0,0,0] op_sel_hi:[0,1,0]\n\t"     \
          "v_add_f32_dpp %6, %6, %6 quad_perm:[2,3,0,1] row_mask:0xf bank_mask:0xf bound_ctrl:1\n\t" \
          "v_fma_mix_f32 %1, %1, %14, %9 op_sel:[0,1,0] op_sel_hi:[0,1,0]\n\t"     \
          "v_fma_mix_f32 %2, %2, %15, %10 op_sel:[0,0,0] op_sel_hi:[0,1,0]\n\t"    \
          "v_add_f32_dpp %6, %6, %6 row_half_mirror row_mask:0xf bank_mask:0xf bound_ctrl:1\n\t" \
          "v_fma_mix_f32 %3, %3, %15, %11 op_sel:[0,1,0] op_sel_hi:[0,1,0]\n\t"    \
          "s_nop 0\n\t"                                                            \
          "v_add_f32_dpp %6, %6, %6 row_mirror row_mask:0xf bank_mask:0xf bound_ctrl:1\n\t" \
          "v_fma_mix_f32 %0, -%6, %18, %0 op_sel:[0,0,0] op_sel_hi:[0,1,0]\n\t"    \
          "v_fma_mix_f32 %1, -%6, %18, %1 op_sel:[0,1,0] op_sel_hi:[0,1,0]\n\t"    \
          "v_fma_mix_f32 %2, -%6, %19, %2 op_sel:[0,0,0] op_sel_hi:[0,1,0]\n\t"    \
          "v_fma_mix_f32 %3, -%6, %19, %3 op_sel:[0,1,0] op_sel_hi:[0,1,0]\n\t"    \
          "v_fma_mix_f32 %4, %0, %20, 0 op_sel:[0,0,0] op_sel_hi:[0,1,0]\n\t"      \
          "v_fma_mix_f32 %5, %2, %21, 0 op_sel:[0,0,0] op_sel_hi:[0,1,0]\n\t"      \
          "v_fma_mix_f32 %4, %1, %20, %4 op_sel:[0,1,0] op_sel_hi:[0,1,0]\n\t"     \
          "v_fma_mix_f32 %5, %3, %21, %5 op_sel:[0,1,0] op_sel_hi:[0,1,0]"         \
          : "+v"(S0), "+v"(S1), "+v"(S2), "+v"(S3), "=&v"(ea), "=&v"(eb), "=&v"(x_), "=&v"(y_),                     \
            "=&v"(t0), "=&v"(t1), "=&v"(t2), "=&v"(t3)                                                              \
          : "v"(G.kk[u].x), "v"(G.kk[u].y), "v"(G.w[u].x), "v"(G.w[u].y), "v"(G.kd[u].x), "v"(G.kd[u].y),           \
            "v"(G.kka[u].x), "v"(G.kka[u].y), "v"(G.r[u].x), "v"(G.r[u].y), "v"(G.v[u]));                           \
      dres[u] = ea + eb;     \
    }                                                                              \
    asm volatile("" ::: "memory");                                                 \
    *cflag = (gq) + 1;     \
    {                                                                              \
      int rlo; RW_RLO(gq, rlo);                                                    \
      unsigned vov = vov0; asm volatile("" : "+v"(vov));                           \
        \
      const bool p1_ = (s & 1) != 0, p2_ = (s & 2) != 0;                           \
      const float a_ = (p1_ ? dres[1] : dres[0]) + dpp_mov<0xB1>(p1_ ? dres[0] : dres[1]); \
      const float b_ = (p1_ ? dres[3] : dres[2]) + dpp_mov<0xB1>(p1_ ? dres[2] : dres[3]); \
      float val = (p2_ ? b_ : a_) + dpp_mov<0x4E>(p2_ ? a_ : b_);                  \
      val += dpp_mov<0x124>(val);                                                  \
      val += dpp_mov<0x128>(val);                                                  \
      *(h16*)(pO + (size_t)rlo * 2048 + vov) = (h16)val;                           \
    }                                                                              \
  }
  RC_WAIT(0); RC_LOAD(A, 0);
#pragma unroll 1
  for (int g = 0; g < RW_NG; g += 2) {
    RC_WAIT(g + 1); RC_LOAD(B, g + 1);
    RC_COMP(A, g);
    if (g + 2 < RW_NG) { RC_WAIT(g + 2); RC_LOAD(A, g + 2); }
    RC_COMP(B, g + 1);
  }
#undef RC_WAIT
#undef RC_LOAD
#undef RC_COMP
}
#undef RW_RLO

DEV void phase_scan(const Params& p, const Ctx& cx, int l, char* smem) {
  const int lane = cx.tid & 63, wid = __builtin_amdgcn_readfirstlane(cx.tid >> 6);
  for (int slot = cx.bid; slot < 256; slot += cx.nblk) {
    __syncthreads();
    if (wid == 4 && lane < 8) *(LAS3 volatile int*)(smem + RW_FLAGS + (lane == 0 ? 0 : 64 + (lane & 3) * 4)) = 0;
    __syncthreads();
    const int unit = slot & 63;
#ifndef NO_RWKV
    if (wid < 4) { __builtin_amdgcn_s_setprio(3); rwkv_consumer(p, cx, l, (unit << 4) | ((slot >> 6) << 2) | wid, lane, smem, wid); __builtin_amdgcn_s_setprio(0); }
    else if (wid == 4) { __builtin_amdgcn_s_setprio(2); rwkv_helper(p, cx, l, unit, lane, smem); __builtin_amdgcn_s_setprio(0); }
#endif
  }
  if (wid >= 5) {
    char* wl = smem + 32768 + (wid - 5) * 17408;
    for (int u = cx.bid * 3 + (wid - 5); u < 2 * 32 * 65; u += cx.nblk * 3) {
      if (l == 1 && (u % 65) == 0) continue;
#ifndef NO_S5P3
      s5_pass3_unit(p, cx, l, u, wl, lane);
#endif
    }
  }
}

DEV void pool_item(const Params& p, const Ctx& cx, int l, int item, char* smem) {
  const int tid = cx.tid;
  const h16* zrest = (const h16*)(p.ws + OFF_ZREST);
  bf16_t* ym = (bf16_t*)(p.ws + OFF_YM);
  const char* wt = p.ws + OFF_WT + (size_t)l * WT_SIZE;
  float* V = (float*)smem;
  char* At = smem + 43008;
  int g, rowout0, Lseq, p0, rlo, rhi, rstride, rowsrc0;
  if (item < 2048) {
    g = item & 3; int r = (item >> 2) & 255, b = item >> 10;
    int w = 2 << g;
    rlo = max(r - w / 2, 0); rhi = min(r + w / 2 - 1, 255);
    rowsrc0 = b * 16384; rstride = 64;
    rowout0 = b * 16384 + r * 64; Lseq = 64; p0 = 0;
  } else {
    int it = item - 2048;
    g = it & 3; int tq = (it >> 2) & 3, b = it >> 4;
    rlo = 0; rhi = 0; rowsrc0 = NLAT + b * 256; rstride = 0;
    rowout0 = NLAT + b * 256 + tq * 64; Lseq = 256; p0 = tq * 64;
  }
  const int w = 2 << g;
  const float invr = 1.f / (float)(rhi - rlo + 1);
  for (int unit = tid; unit < 80 * 16; unit += NTHREADS) {
    int lp = unit >> 4, ch8 = unit & 15;
    int pos = p0 - 8 + lp;
    float acc[8] = {0, 0, 0, 0, 0, 0, 0, 0};
    if (pos >= 0 && pos < Lseq) {
      const h16* bp = zrest + (size_t)(rowsrc0 + pos) * ZR + 1024 + g * 128 + ch8 * 8;
      const int nr = rhi - rlo + 1;
      for (int k0 = 0; k0 < nr; k0 += 4) {
        h16x8 v[4]; float wv[4];
#pragma unroll
        for (int i = 0; i < 4; ++i) {
          const int kk_ = min(k0 + i, nr - 1);
          wv[i] = (k0 + i < nr) ? 1.f : 0.f;
          v[i] = *(const h16x8*)(bp + (size_t)((rlo + kk_) * rstride) * ZR);
        }
#pragma unroll
        for (int i = 0; i < 4; ++i)
#pragma unroll
          for (int j = 0; j < 8; ++j) acc[j] += wv[i] * (float)v[i][j];
      }
    }
    float* vp = V + lp * 132 + ch8 * 8;
#pragma unroll
    for (int j = 0; j < 8; ++j) vp[j] = acc[j] * invr;
  }
  __syncthreads();
  for (int unit = tid; unit < 64 * 16; unit += NTHREADS) {
    int c = unit >> 4, ch8 = unit & 15;
    int pos = p0 + c;
    int lo = max(pos - w / 2, 0), hi = min(pos + w / 2 - 1, Lseq - 1);
    float acc[8] = {0, 0, 0, 0, 0, 0, 0, 0};
    for (int pp = lo; pp <= hi; ++pp) {
      const float* vp = V + (pp - p0 + 8) * 132 + ch8 * 8;
#pragma unroll
      for (int j = 0; j < 8; ++j) acc[j] += vp[j];
    }
    float invc = 1.f / (float)(hi - lo + 1);
    h16x8 uc = *(const h16x8*)(zrest + (size_t)(rowout0 + c) * ZR + 1024 + g * 128 + ch8 * 8);
    uint4 o;
    o.x = pack_bf2(acc[0] * invc - (float)uc[0], acc[1] * invc - (float)uc[1]);
    o.y = pack_bf2(acc[2] * invc - (float)uc[2], acc[3] * invc - (float)uc[3]);
    o.z = pack_bf2(acc[4] * invc - (float)uc[4], acc[5] * invc - (float)uc[5]);
    o.w = pack_bf2(acc[6] * invc - (float)uc[6], acc[7] * invc - (float)uc[7]);
    *(uint4*)(At + c * 272 + ch8 * 16) = o;
  }
  __syncthreads();
  const bf16_t* Bt = (const bf16_t*)(wt + WT_POOL) + (size_t)g * 128 * 128;
  const float* ps = p.pool_scale + (size_t)l * 512 + g * 128;
  small_gemm<128, 1>(p, cx, At, 272, Bt, (tid >> 6) * 16, [&](int m, int n, f32x4 v) {
    int row = rowout0 + m;
    float4 sc = *(const float4*)(ps + n);
    h16x4 gt = *(const h16x4*)(zrest + (size_t)row * ZR + 1536 + g * 128 + n);
    uint2 o;
    o.x = pack_bf2(v[0] * sc.x * silu_f((float)gt[0]), v[1] * sc.y * silu_f((float)gt[1]));
    o.y = pack_bf2(v[2] * sc.z * silu_f((float)gt[2]), v[3] * sc.w * silu_f((float)gt[3]));
    *(uint2*)(ym + (size_t)row * D + 512 + g * 128 + n) = o;
  });
}

DEV void glu_item(const Params& p, const Ctx& cx, int l, int tile, char* smem) {
  const int tid = cx.tid;
  const int row0 = tile * 64;
  const float* S5Y = (const float*)(p.ws + OFF_S5Y);
  const h16* zrest = (const h16*)(p.ws + OFF_ZREST);
  bf16_t* ym = (bf16_t*)(p.ws + OFF_YM);
  const char* wt = p.ws + OFF_WT + (size_t)l * WT_SIZE;
#pragma unroll
  for (int it = 0; it < 8; ++it) {
    int unit = tid + it * NTHREADS;
    int r = unit >> 6, c8 = unit & 63;
    const float* sp = S5Y + (size_t)(row0 + r) * 512 + c8 * 8;
    float4 a = *(const float4*)sp, bq = *(const float4*)(sp + 4);
    uint4 o;
    o.x = pack_bf2(a.x, a.y); o.y = pack_bf2(a.z, a.w); o.z = pack_bf2(bq.x, bq.y); o.w = pack_bf2(bq.z, bq.w);
    *(uint4*)(smem + r * 1040 + c8 * 16) = o;
  }
  __syncthreads();
  const bf16_t* Bt = (const bf16_t*)(wt + WT_GLU);
  const float* bg = p.b_glu + (size_t)l * 512;
  small_gemm<512, 4>(p, cx, smem, 1040, Bt, (tid >> 6) * 64, [&](int m, int n, f32x4 v) {
    int row = row0 + m;
    float4 y = *(const float4*)(S5Y + (size_t)row * 512 + n);
    float4 bb = *(const float4*)(bg + n);
    h16x4 gt = *(const h16x4*)(zrest + (size_t)row * ZR + 512 + n);
    uint2 o;
    o.x = pack_bf2(y.x * sigmoid_f(v[0] + bb.x) * silu_f((float)gt[0]), y.y * sigmoid_f(v[1] + bb.y) * silu_f((float)gt[1]));
    o.y = pack_bf2(y.z * sigmoid_f(v[2] + bb.z) * silu_f((float)gt[2]), y.w * sigmoid_f(v[3] + bb.w) * silu_f((float)gt[3]));
    *(uint2*)(ym + (size_t)row * D + n) = o;
  });
}

DEV void rwkvmerge_item(const Params& p, const Ctx& cx, int l, int tile) {
  const int tid = cx.tid;
  const int row0 = tile * 64;
  const h16* SC = (const h16*)(p.ws + OFF_SCAN);
  const h16* O = (const h16*)(p.ws + OFF_REG2);
  const h16* zrest = (const h16*)(p.ws + OFF_ZREST);
  bf16_t* ym = (bf16_t*)(p.ws + OFF_YM);
  const int grp = tid & 7, h = (tid >> 3) & 15;
  const int c0 = h * 64 + grp * 8;
  float pk[8], rk[8], gw[8], gb[8];
#pragma unroll
  for (int j = 0; j < 8; j += 4) {
    float4 t0 = *(const float4*)(p.rwkv_k_a + (size_t)l * 1024 + c0 + j), t1 = *(const float4*)(p.rwkv_r_k + (size_t)l * 1024 + c0 + j);
    float4 t2 = *(const float4*)(p.gn_w + (size_t)l * 1024 + c0 + j), t3 = *(const float4*)(p.gn_b + (size_t)l * 1024 + c0 + j);
    pk[j] = t0.x; pk[j + 1] = t0.y; pk[j + 2] = t0.z; pk[j + 3] = t0.w;
    rk[j] = t1.x; rk[j + 1] = t1.y; rk[j + 2] = t1.z; rk[j + 3] = t1.w;
    gw[j] = t2.x; gw[j + 1] = t2.y; gw[j + 2] = t2.z; gw[j + 3] = t2.w;
    gb[j] = t3.x; gb[j + 1] = t3.y; gb[j + 2] = t3.z; gb[j + 3] = t3.w;
  }
#pragma unroll 2
  for (int it = 0; it < 16; ++it) {
    const int tok = (tid >> 7) + it * 4;
    int row = row0 + tok;
    size_t off = (size_t)row * 1024 + c0;
    h16x8 of = *(const h16x8*)(O + off), ob = *(const h16x8*)(O + ARR + off);
    h16x8 r8 = *(const h16x8*)(SC + 0 * ARR + off), k8 = *(const h16x8*)(SC + 1 * ARR + off), v8 = *(const h16x8*)(SC + 2 * ARR + off);
    h16x8 af = *(const h16x8*)(SC + 4 * ARR + off), ab = *(const h16x8*)(SC + 5 * ARR + off);
    h16x8 gt = *(const h16x8*)(zrest + (size_t)row * ZR + 2048 + c0);
    float o[8], sm = 0;
#pragma unroll
    for (int j = 0; j < 8; ++j) { o[j] = (float)of[j] + (float)ob[j]; sm += o[j]; }
    sm = allreduce8(sm);
    float mu = sm * (1.f / 64.f), vq = 0;
#pragma unroll
    for (int j = 0; j < 8; ++j) { o[j] -= mu; vq += o[j] * o[j]; }
    vq = allreduce8(vq);
    float rstd = rsqrtf(vq * (1.f / 64.f) + 64e-5f);
    float part = 0;
#pragma unroll
    for (int j = 0; j < 8; ++j) {
      float ksum = (float)k8[j] * (2.f + ((float)af[j] + (float)ab[j] - 2.f) * pk[j]);
      part += (float)r8[j] * ksum * rk[j];
    }
    part = allreduce8(part);
    float res[8];
#pragma unroll
    for (int j = 0; j < 8; ++j) {
      float y = o[j] * rstd * gw[j] + gb[j] + part * (float)v8[j];
      res[j] = y * silu_f((float)gt[j]);
    }
    uint4 ov;
    ov.x = pack_bf2(res[0], res[1]); ov.y = pack_bf2(res[2], res[3]); ov.z = pack_bf2(res[4], res[5]); ov.w = pack_bf2(res[6], res[7]);
    *(uint4*)(ym + (size_t)row * D + 1024 + c0) = ov;
  }
}

DEV void phase_merge(const Params& p, const Ctx& cx0, int l, char* smem) {
  const int ntile = (l == 0) ? 520 : 512;
  const int npool = (l == 0) ? 2048 + 32 : 2048;
  const int total = npool + 2 * ntile;
  for (int item = cx0.bid; item < total; item += cx0.nblk) {
    __syncthreads();
    Ctx cx = cx0; asm volatile("" : "+v"(cx.tid));
    const int grp6 = item / 6, pos6 = item - grp6 * 6;
    if (pos6 < 4) pool_item(p, cx, l, grp6 * 4 + pos6, smem);
    else if (pos6 == 4) glu_item(p, cx, l, grp6, smem);
    else rwkvmerge_item(p, cx, l, grp6);
  }
}

#define LCX Ctx c2 = cx; asm volatile("" : "+v"(c2.tid))
#ifndef GEMM_FN
#define GEMM_FN gemm_phase2
#endif
__global__ void __launch_bounds__(NTHREADS) mega_fwd(Params p, int ph0, int ph1) {
  extern __shared__ __attribute__((aligned(16))) char smem[];
  cg::grid_group grid = cg::this_grid();
  const int wave_s = __builtin_amdgcn_readfirstlane((int)(threadIdx.x >> 6));
  for (int step = ph0; step < ph1; ++step) {
    if (step > ph0) grid.sync();
    const int ph = (int)((PH_SEQ >> (4 * step)) & 15ull);
    Ctx cx;
    {
      int t_, b_ = blockIdx.x, n_ = gridDim.x;
      asm volatile("v_mbcnt_lo_u32_b32 %0, -1, 0\n\tv_mbcnt_hi_u32_b32 %0, -1, %0\n\tv_lshl_add_u32 %0, %1, 6, %0" : "=&v"(t_) : "s"(wave_s));
      asm volatile("" : "+s"(b_), "+s"(n_));
      cx.tid = t_; cx.bid = b_; cx.nblk = n_;
    }
    const int l = ph >= 8 ? 1 : 0;
    const int lp = ph >= 8 ? ph - 6 : ph;
#ifndef PHMASK
#define PHMASK 0xff
#endif
    if (ph == 0) { if (PHMASK & 1) { LCX; phase0(p, c2, smem); } }
    else if (ph == 1) { if (PHMASK & 2) { LCX; phase_adaln0(p, c2); } }
    else if (lp == 2 && (PHMASK & 4)) {
      LCX;
      h16* zrest = (h16*)(p.ws + OFF_ZREST);
      h16* zc = (h16*)(p.ws + OFF_REG2);
      GEMM_FN(p, c2, (const bf16_t*)(p.ws + OFF_H), (const bf16_t*)(p.ws + OFF_WT + (size_t)l * WT_SIZE + WT_IN), 2048, 130, 25, smem,
                 [&](int row, int col, f32x4 v, f32x4 u) {
                   h16* dst;
                   if (col < 2048) dst = zrest + (size_t)row * ZR + col;
                   else if (col < 5120) dst = zc + (size_t)row * ZC + (col - 2048);
                   else if (col < 6144) dst = zrest + (size_t)row * ZR + 2048 + (col - 5120);
                   else dst = zc + (size_t)row * ZC + 3072 + (col - 6144);
                   h16x8 o = {(h16)v[0], (h16)v[1], (h16)v[2], (h16)v[3], (h16)u[0], (h16)u[1], (h16)u[2], (h16)u[3]};
                   *(h16x8*)dst = o;
                 });
    } else if (lp == 3) { if (PHMASK & 8) { LCX; phase_prep(p, c2, l, smem); } }
    else if (lp == 4) { if (PHMASK & 16) { LCX; phase_scan(p, c2, l, smem); } }
    else if (lp == 5) { if (PHMASK & 32) { LCX; phase_merge(p, c2, l, smem); } }
    else if (lp == 6 && (PHMASK & 64)) {
      LCX;
      const float* mods = (const float*)(p.ws + OFF_MODS);
      float* prec = (float*)(p.ws + OFF_PREC);
      const float* xin = (l == 0) ? p.x : p.out;
      GEMM_FN(p, c2, (const bf16_t*)(p.ws + OFF_YM), (const bf16_t*)(p.ws + OFF_WT + (size_t)l * WT_SIZE + WT_OUT), 2048, l == 0 ? 130 : 128, 8, smem,
                 [&](int row, int col, f32x4 v, f32x4 u) {
                   const float* xr; const float* gr; float* dr;
                   if (row < NLAT) {
                     xr = xin + (size_t)row * D + col; gr = mods + (size_t)(l * 3 + (row >> 14)) * 6144 + 4096 + col; dr = p.out + (size_t)row * D + col;
                   } else {
                     xr = p.ctx + (size_t)(row - NLAT) * D + col; gr = mods + (size_t)(l * 3 + 2) * 6144 + 4096 + col; dr = prec + (size_t)(row - NLAT) * D + col;
                   }
                   const float4 x0 = *(const float4*)xr, x1 = *(const float4*)(xr + 4), g0 = *(const float4*)gr, g1 = *(const float4*)(gr + 4);
                   float4 r0, r1;
                   r0.x = ALPHA * x0.x + g0.x * v[0]; r0.y = ALPHA * x0.y + g0.y * v[1]; r0.z = ALPHA * x0.z + g0.z * v[2]; r0.w = ALPHA * x0.w + g0.w * v[3];
                   r1.x = ALPHA * x1.x + g1.x * u[0]; r1.y = ALPHA * x1.y + g1.y * u[1]; r1.z = ALPHA * x1.z + g1.z * u[2]; r1.w = ALPHA * x1.w + g1.w * u[3];
                   *(float4*)dr = r0; *(float4*)(dr + 4) = r1;
                 });
    } else if (lp == 7) { if (PHMASK & 128) { LCX; phase_finln(p, c2, l); } }
  }
}

constexpr int NPHASES = PH_NSTEPS;

extern "C" void kernel_launch(void* const* d_in, const int* in_sizes, int n_in, void* d_out, int out_size, void* d_ws, size_t ws_size,
                              hipStream_t stream) {
  static int grid_blocks = 0;
  if (grid_blocks == 0) {
    if (n_in != 32 || ws_size < WS_END) { fprintf(stderr, "kernel_launch: unexpected n_in %d / ws %zu (need %zu)\n", n_in, ws_size, (size_t)WS_END); grid_blocks = -1; return; }
    int dev = 0, cus = 0, per_cu = 0;
    hipGetDevice(&dev);
    hipDeviceGetAttribute(&cus, hipDeviceAttributeMultiprocessorCount, dev);
    if (hipFuncSetAttribute((const void*)mega_fwd, hipFuncAttributeMaxDynamicSharedMemorySize, LDS_BYTES) != hipSuccess) { fprintf(stderr, "hipFuncSetAttribute failed\n"); grid_blocks = -1; return; }
    if (hipOccupancyMaxActiveBlocksPerMultiprocessor(&per_cu, (const void*)mega_fwd, NTHREADS, LDS_BYTES) != hipSuccess || per_cu < 1) {
      fprintf(stderr, "occupancy query gave %d\n", per_cu); (void)hipGetLastError(); per_cu = 1;
    }
    grid_blocks = cus * per_cu;
  }
  if (grid_blocks < 0) return;
  Params p{};
  const float** pp = (const float**)&p;
  for (int i = 0; i < 32; ++i) pp[i] = (const float*)d_in[i];
  p.out = (float*)d_out;
  p.ws = (char*)d_ws;
  int ph0 = 0, ph1 = NPHASES;
  void* args[] = {&p, &ph0, &ph1};
  hipError_t e = hipLaunchCooperativeKernel((const void*)mega_fwd, dim3(grid_blocks), dim3(NTHREADS), args, LDS_BYTES, stream);
  if (e != hipSuccess) fprintf(stderr, "cooperative launch failed: %s (grid %d)\n", hipGetErrorString(e), grid_blocks);
}
```

```cpp
#include <hip/hip_runtime.h>
#include <hip/hip_cooperative_groups.h>
#include <cstdio>
namespace cg = cooperative_groups;

typedef unsigned short bf16_t;
typedef _Float16 h16;
using bf16x8 = __attribute__((ext_vector_type(8))) _Float16;
using f32x4 = __attribute__((ext_vector_type(4))) float;
using h16x4 = __attribute__((ext_vector_type(4))) _Float16;
using h16x8 = __attribute__((ext_vector_type(8))) _Float16;

#define DEV __device__ __forceinline__

constexpr int D = 2048, NLAT = 32768, MTOT = 33280, ZR = 3072, ZC = 3328;
constexpr int NTHREADS = 512;
constexpr int LDS_BYTES = 147456;
constexpr float ALPHA = 1.41421356237f;
constexpr float DECAY_SCALE = 0.606531f;

constexpr size_t al256(size_t x) { return (x + 255) & ~size_t(255); }
constexpr size_t ARR = (size_t)MTOT * 1024;
constexpr size_t OFF_MODS = 0;
constexpr size_t OFF_S5F = al256(OFF_MODS + 2 * 3 * 6144 * 4);
constexpr size_t OFF_PREC = al256(OFF_S5F + (size_t)2 * 32 * 65 * 2 * 64 * 8);
constexpr size_t OFF_WT = al256(OFF_PREC + (size_t)512 * 2048 * 4);
constexpr size_t WT_IN = 0, WT_OUT = 26214400, WT_W2 = 34603008, WT_A2 = 34865152, WT_POOL = 35127296, WT_GLU = 35258368, WT_SIZE = 35782656;
constexpr size_t OFF_ZREST = al256(OFF_WT + 2 * WT_SIZE);
constexpr size_t OFF_REG2 = al256(OFF_ZREST + (size_t)MTOT * ZR * 2);
constexpr size_t OFF_S5Y = OFF_REG2 + 2 * ARR * 2;
constexpr size_t OFF_SCAN = al256(OFF_REG2 + (size_t)MTOT * ZC * 2);
constexpr size_t OFF_H = OFF_SCAN;
constexpr size_t OFF_YM = OFF_SCAN + 6 * ARR * 2;
constexpr size_t WS_END = OFF_SCAN + 8 * ARR * 2;

#ifndef PH_SEQ
#define PH_SEQ 0xDCBA9876543210ull
#define PH_NSTEPS 14
#endif
struct Params {
  const float *x, *c, *ctx, *c_ctx, *w_ada, *b_ada, *w_in, *conv_rkv, *s5_lam_re, *s5_lam_im, *s5_log_step,
      *s5_b_re, *s5_b_im, *s5_c_re, *s5_c_im, *s5_d, *w_glu, *b_glu, *w_pool, *pool_scale,
      *rwkv_w0, *rwkv_w2, *rwkv_a0, *rwkv_a2, *rwkv_k_k, *rwkv_k_a, *rwkv_r_k, *gn_w, *gn_b,
      *w_out, *ln_g, *ln_b;
  float* out;
  char* ws;
};
struct Ctx { int tid, bid, nblk; };

DEV float rcp_f(float x) { return __builtin_amdgcn_rcpf(x); }
DEV float sigmoid_f(float x) { return rcp_f(1.f + __expf(-x)); }
DEV float silu_f(float x) { return x * rcp_f(1.f + __expf(-x)); }
DEV float tanh_f(float x) { float e = __expf(2.f * x); return 1.f - 2.f * rcp_f(e + 1.f); }
DEV float gelu_f(float y) { return 0.5f * y * (1.f + tanh_f(0.7978845608f * (y + 0.044715f * y * y * y))); }
using h16x2 = __attribute__((ext_vector_type(2))) _Float16;
DEV unsigned pack_bf2(float a, float b) { h16x2 v = {(h16)a, (h16)b}; return __builtin_bit_cast(unsigned, v); }
template <int CTRL> DEV float dpp_mov(float v) {
  return __int_as_float(__builtin_amdgcn_update_dpp(0, __float_as_int(v), CTRL, 0xf, 0xf, true));
}
DEV float allreduce16(float v) {
  v += dpp_mov<0xB1>(v);
  v += dpp_mov<0x4E>(v);
  v += dpp_mov<0x141>(v);
  v += dpp_mov<0x140>(v);
  return v;
}
DEV float wave_sum(float v) {
  v = allreduce16(v);
  return __builtin_amdgcn_readlane(__float_as_int(v), 0) == 0 && false ? 0.f :
         __int_as_float(__builtin_amdgcn_readlane(__float_as_int(v), 0)) + __int_as_float(__builtin_amdgcn_readlane(__float_as_int(v), 16)) +
         __int_as_float(__builtin_amdgcn_readlane(__float_as_int(v), 32)) + __int_as_float(__builtin_amdgcn_readlane(__float_as_int(v), 48));
}
DEV float allreduce8(float v) {
  v += dpp_mov<0xB1>(v);
  v += dpp_mov<0x4E>(v);
  v += dpp_mov<0x141>(v);
  return v;
}
DEV void lds_fence() { asm volatile("s_waitcnt lgkmcnt(0)" ::: "memory"); }

DEV void p0_mods_item(const Params& p, const Ctx& cx, int item, char* smem) {
  float* red = (float*)smem;
  float* mods = (float*)(p.ws + OFF_MODS);
  int l = item / 96, chunk = item % 96;
  int tid = cx.tid, kq = tid >> 6, col = tid & 63;
  int n = chunk * 64 + col;
  const float* W = p.w_ada + (size_t)l * 2048 * 6144;
  float a0 = 0, a1 = 0, a2 = 0;
#pragma unroll 8
  for (int k = kq; k < 2048; k += 8) {
    float w = W[(size_t)k * 6144 + n];
    a0 += silu_f(p.c[k]) * w;
    a1 += silu_f(p.c[2048 + k]) * w;
    a2 += silu_f(p.c_ctx[k]) * w;
  }
  red[(kq * 3 + 0) * 64 + col] = a0;
  red[(kq * 3 + 1) * 64 + col] = a1;
  red[(kq * 3 + 2) * 64 + col] = a2;
  __syncthreads();
  if (tid < 192) {
    int r = tid >> 6, cc = tid & 63;
    float s = 0;
#pragma unroll
    for (int q = 0; q < 8; ++q) s += red[(q * 3 + r) * 64 + cc];
    mods[(size_t)(l * 3 + r) * 6144 + chunk * 64 + cc] = s + p.b_ada[(size_t)l * 6144 + chunk * 64 + cc];
  }
}

DEV void p0_transpose_tile(const Params& p, const Ctx& cx, const float* __restrict__ src, bf16_t* __restrict__ dst, int K, int N, int tk, int tn, char* smem) {
  float* T = (float*)smem;
  int tid = cx.tid;
  int k0 = tk * 64, n0 = tn * 64;
  int kk = tid >> 4, n4 = tid & 15;
#pragma unroll
  for (int i = 0; i < 2; ++i) {
    int k = kk + 32 * i;
    float4 v = *(const float4*)(src + (size_t)(k0 + k) * N + n0 + n4 * 4);
    T[k * 65 + n4 * 4 + 0] = v.x; T[k * 65 + n4 * 4 + 1] = v.y; T[k * 65 + n4 * 4 + 2] = v.z; T[k * 65 + n4 * 4 + 3] = v.w;
  }
  __syncthreads();
  int n = tid >> 3, k8 = tid & 7;
  uint4 o;
  o.x = pack_bf2(T[(k8 * 8 + 0) * 65 + n], T[(k8 * 8 + 1) * 65 + n]);
  o.y = pack_bf2(T[(k8 * 8 + 2) * 65 + n], T[(k8 * 8 + 3) * 65 + n]);
  o.z = pack_bf2(T[(k8 * 8 + 4) * 65 + n], T[(k8 * 8 + 5) * 65 + n]);
  o.w = pack_bf2(T[(k8 * 8 + 6) * 65 + n], T[(k8 * 8 + 7) * 65 + n]);
  *(uint4*)(dst + (size_t)(n0 + n) * K + k0 + k8 * 8) = o;
}

DEV void phase0(const Params& p, const Ctx& cx0, char* smem) {
  const int NTR = 4368;
  const int total = 192 + 2 * NTR;
  for (int item = cx0.bid; item < total; item += cx0.nblk) {
    __syncthreads();
    Ctx cx = cx0; asm volatile("" : "+v"(cx.tid));
    if (item < 192) { p0_mods_item(p, cx, item, smem); continue; }
    int it = item - 192;
    int l = it / NTR, i = it % NTR;
    char* wt = p.ws + OFF_WT + (size_t)l * WT_SIZE;
    if (i < 3200) {
      p0_transpose_tile(p, cx, p.w_in + (size_t)l * 2048 * 6400, (bf16_t*)(wt + WT_IN), 2048, 6400, i / 100, i % 100, smem);
    } else if (i < 4224) {
      int j = i - 3200;
      p0_transpose_tile(p, cx, p.w_out + (size_t)l * 2048 * 2048, (bf16_t*)(wt + WT_OUT), 2048, 2048, j / 32, j % 32, smem);
    } else if (i < 4256) {
      int j = i - 4224, d = j / 16;
      p0_transpose_tile(p, cx, p.rwkv_w2 + (size_t)(l * 2 + d) * 64 * 1024, (bf16_t*)(wt + WT_W2) + (size_t)d * 1024 * 64, 64, 1024, 0, j % 16, smem);
    } else if (i < 4288) {
      int j = i - 4256, d = j / 16;
      p0_transpose_tile(p, cx, p.rwkv_a2 + (size_t)(l * 2 + d) * 64 * 1024, (bf16_t*)(wt + WT_A2) + (size_t)d * 1024 * 64, 64, 1024, 0, j % 16, smem);
    } else if (i < 4304) {
      int j = i - 4288, g = j / 4;
      p0_transpose_tile(p, cx, p.w_pool + (size_t)(l * 4 + g) * 128 * 128, (bf16_t*)(wt + WT_POOL) + (size_t)g * 128 * 128, 128, 128, (j % 4) / 2, j % 2, smem);
    } else {
      int j = i - 4304;
      p0_transpose_tile(p, cx, p.w_glu + (size_t)l * 512 * 512, (bf16_t*)(wt + WT_GLU), 512, 512, j / 8, j % 8, smem);
    }
  }
}

DEV void phase_adaln0(const Params& p, const Ctx& cx) {
  const float* mods = (const float*)(p.ws + OFF_MODS);
  bf16_t* hbuf = (bf16_t*)(p.ws + OFF_H);
  int lane = cx.tid & 63;
  int gw = cx.bid * 8 + (cx.tid >> 6), nw = cx.nblk * 8;
  for (int row = gw; row < MTOT; row += nw) {
    const float* src = row < NLAT ? p.x + (size_t)row * D : p.ctx + (size_t)(row - NLAT) * D;
    int mr = row < NLAT ? (row >> 14) : 2;
    const float* md = mods + (size_t)mr * 6144;
    float4 v[8];
    float s = 0;
#pragma unroll
    for (int i = 0; i < 8; ++i) { v[i] = *(const float4*)(src + i * 256 + lane * 4); s += v[i].x + v[i].y + v[i].z + v[i].w; }
    float mu = wave_sum(s) * (1.f / 2048.f);
    float q = 0;
#pragma unroll
    for (int i = 0; i < 8; ++i) { v[i].x -= mu; v[i].y -= mu; v[i].z -= mu; v[i].w -= mu; q += v[i].x * v[i].x + v[i].y * v[i].y + v[i].z * v[i].z + v[i].w * v[i].w; }
    float rstd = rsqrtf(wave_sum(q) * (1.f / 2048.f) + 1e-6f);
#pragma unroll
    for (int i = 0; i < 8; ++i) {
      int col = i * 256 + lane * 4;
      float4 sh = *(const float4*)(md + col), sc = *(const float4*)(md + 2048 + col);
      uint2 o;
      o.x = pack_bf2(v[i].x * rstd * (1.f + sc.x) + sh.x, v[i].y * rstd * (1.f + sc.y) + sh.y);
      o.y = pack_bf2(v[i].z * rstd * (1.f + sc.z) + sh.z, v[i].w * rstd * (1.f + sc.w) + sh.w);
      *(uint2*)(hbuf + (size_t)row * D + col) = o;
    }
  }
}

DEV void phase_finln(const Params& p, const Ctx& cx, int l) {
  const float* mods = (const float*)(p.ws + OFF_MODS);
  bf16_t* hbuf = (bf16_t*)(p.ws + OFF_H);
  float* prec = (float*)(p.ws + OFF_PREC);
  int lane = cx.tid & 63;
  int gw = cx.bid * 8 + (cx.tid >> 6), nw = cx.nblk * 8;
  const int nrows = (l == 0) ? MTOT : NLAT;
  for (int row = gw; row < nrows; row += nw) {
    float* src = row < NLAT ? p.out + (size_t)row * D : prec + (size_t)(row - NLAT) * D;
    float4 v[8];
    float s = 0;
#pragma unroll
    for (int i = 0; i < 8; ++i) { v[i] = *(const float4*)(src + i * 256 + lane * 4); s += v[i].x + v[i].y + v[i].z + v[i].w; }
    float mu = wave_sum(s) * (1.f / 2048.f);
    float q = 0;
#pragma unroll
    for (int i = 0; i < 8; ++i) { v[i].x -= mu; v[i].y -= mu; v[i].z -= mu; v[i].w -= mu; q += v[i].x * v[i].x + v[i].y * v[i].y + v[i].z * v[i].z + v[i].w * v[i].w; }
    float rstd = rsqrtf(wave_sum(q) * (1.f / 2048.f) + 1e-5f);
    float s2 = 0;
#pragma unroll
    for (int i = 0; i < 8; ++i) {
      int col = i * 256 + lane * 4;
      float4 g = *(const float4*)(p.ln_g + (size_t)l * D + col), b = *(const float4*)(p.ln_b + (size_t)l * D + col);
      v[i].x = v[i].x * rstd * g.x + b.x; v[i].y = v[i].y * rstd * g.y + b.y; v[i].z = v[i].z * rstd * g.z + b.z; v[i].w = v[i].w * rstd * g.w + b.w;
      if (row < NLAT) *(float4*)(src + col) = v[i];
      s2 += v[i].x + v[i].y + v[i].z + v[i].w;
    }
    if (l == 0) {
      int mr = row < NLAT ? (row >> 14) : 2;
      const float* md = mods + (size_t)(3 + mr) * 6144;
      float mu2 = wave_sum(s2) * (1.f / 2048.f);
      float q2 = 0;
#pragma unroll
      for (int i = 0; i < 8; ++i) { v[i].x -= mu2; v[i].y -= mu2; v[i].z -= mu2; v[i].w -= mu2; q2 += v[i].x * v[i].x + v[i].y * v[i].y + v[i].z * v[i].z + v[i].w * v[i].w; }
      float rstd2 = rsqrtf(wave_sum(q2) * (1.f / 2048.f) + 1e-6f);
#pragma unroll
      for (int i = 0; i < 8; ++i) {
        int col = i * 256 + lane * 4;
        float4 sh = *(const float4*)(md + col), sc = *(const float4*)(md + 2048 + col);
        uint2 o;
        o.x = pack_bf2(v[i].x * rstd2 * (1.f + sc.x) + sh.x, v[i].y * rstd2 * (1.f + sc.y) + sh.y);
        o.y = pack_bf2(v[i].z * rstd2 * (1.f + sc.z) + sh.z, v[i].w * rstd2 * (1.f + sc.w) + sh.w);
        *(uint2*)(hbuf + (size_t)row * D + col) = o;
      }
    }
  }
}

template <class Epi>
DEV void gemm_phase(const Params& p, const Ctx& cx, const bf16_t* __restrict__ A, const bf16_t* __restrict__ Bt, int K, int nM, int nN, char* smem, Epi epi) {
  const int tid = cx.tid, lane = tid & 63, wid = tid >> 6;
  const int wr = wid >> 2, wc = wid & 3, fr = lane & 15, fq = lane >> 4;
  const int nt = K / 64;
  const int ntiles = nM * nN;
  const int srow = tid >> 3, sc16 = tid & 7;
  const int nxcd = (cx.nblk & 7) == 0 ? 8 : 1;
  const int xcd = cx.bid % nxcd, xidx = cx.bid / nxcd, xper = cx.nblk / nxcd;
  const int t_lo = (int)(((long)ntiles * xcd) / nxcd), t_hi = (int)(((long)ntiles * (xcd + 1)) / nxcd);
  for (int tt = t_lo + xidx; tt < t_hi; tt += xper) {
    const int band = tt / (16 * nN);
    const int brows = min(16, nM - band * 16);
    const int rem = tt - band * 16 * nN;
    const int pn = rem / brows, pm = band * 16 + rem % brows;
    const int brow = pm * 256, bcol = pn * 256;
    const char* Ab = (const char*)(A + (size_t)brow * K);
    const char* Bb = (const char*)(Bt + (size_t)bcol * K);
    const unsigned voff = (unsigned)(srow * K + sc16 * 8) * 2u;
    const size_t rs = (size_t)64 * K * 2;
    f32x4 acc[8][4];
#pragma unroll
    for (int i = 0; i < 8; ++i)
#pragma unroll
      for (int j = 0; j < 4; ++j) acc[i][j] = f32x4{0.f, 0.f, 0.f, 0.f};
    uint4 ra0, ra1, ra2, ra3, rb0, rb1, rb2, rb3;
#define G_LD(ko) { const char* a_ = Ab + (size_t)(ko) * 2; const char* b_ = Bb + (size_t)(ko) * 2; \
                 ra0 = *(const uint4*)(a_ + voff); ra1 = *(const uint4*)(a_ + rs + voff); ra2 = *(const uint4*)(a_ + 2 * rs + voff); ra3 = *(const uint4*)(a_ + 3 * rs + voff); \
                 rb0 = *(const uint4*)(b_ + voff); rb1 = *(const uint4*)(b_ + rs + voff); rb2 = *(const uint4*)(b_ + 2 * rs + voff); rb3 = *(const uint4*)(b_ + 3 * rs + voff); }
#define G_ST(sp) { *(uint4*)(sp) = ra0; *(uint4*)((sp) + 64 * 144) = ra1; *(uint4*)((sp) + 128 * 144) = ra2; *(uint4*)((sp) + 192 * 144) = ra3; \
                 *(uint4*)((sp) + 36864) = rb0; *(uint4*)((sp) + 36864 + 64 * 144) = rb1; *(uint4*)((sp) + 36864 + 128 * 144) = rb2; *(uint4*)((sp) + 36864 + 192 * 144) = rb3; }
    char* const sbase = smem + srow * 144 + sc16 * 16;
    G_LD(0);
    G_ST(sbase);
    if (nt > 1) G_LD(64);
    for (int kt = 0; kt < nt; ++kt) {
      __syncthreads();
      if (kt + 1 < nt) { char* s1 = sbase + ((kt + 1) & 1) * 73728; G_ST(s1); }
      if (kt + 2 < nt) G_LD((kt + 2) * 64);
      const char* As = smem + (kt & 1) * 73728;
      const char* Bs = As + 36864;
#pragma unroll
      for (int kh = 0; kh < 2; ++kh) {
        bf16x8 bfr[4];
#pragma unroll
        for (int jn = 0; jn < 4; ++jn) bfr[jn] = *(const bf16x8*)(Bs + (wc * 64 + jn * 16 + fr) * 144 + kh * 64 + fq * 16);
#pragma unroll
        for (int i = 0; i < 8; ++i) {
          bf16x8 af = *(const bf16x8*)(As + (wr * 128 + i * 16 + fr) * 144 + kh * 64 + fq * 16);
#pragma unroll
          for (int jn = 0; jn < 4; ++jn) acc[i][jn] = __builtin_amdgcn_mfma_f32_16x16x32_f16(bfr[jn], af, acc[i][jn], 0, 0, 0);
        }
      }
    }
    __syncthreads();
#pragma unroll
    for (int i = 0; i < 8; ++i)
#pragma unroll
      for (int jn = 0; jn < 4; ++jn) epi(brow + wr * 128 + i * 16 + fr, bcol + wc * 64 + jn * 16 + fq * 4, acc[i][jn]);
  }
}

#define LAS3 __attribute__((address_space(3)))
DEV int g2_lds_byte(int r, int c) { const int st = (r >> 4) * 2 + (c >> 5), rr = r & 15, cc = c & 31, ob = rr * 64 + cc * 2; return st * 1024 + (ob ^ (((ob >> 9) & 1) << 5)); }
DEV void g2_stage_rc(int b, int& R, int& C) { const int st = b / 1024, sb = b % 1024, swz = sb ^ (((sb >> 9) & 1) << 5); R = (st >> 1) * 16 + swz / 64; C = (st & 1) * 32 + (swz % 64) / 2; }

template <class Epi>
DEV void gemm_phase2(const Params& p, const Ctx& cx, const bf16_t* __restrict__ A, const bf16_t* __restrict__ Bt, int K, int nM, int nN, char* smem, Epi epi) {
  constexpr int HTB = 128 * 64 * 2;
  LAS3 unsigned char* lds = (LAS3 unsigned char*)smem;
  const int tid = cx.tid, wid = __builtin_amdgcn_readfirstlane(tid >> 6), lane = tid & 63, wr = wid >> 2, wc = wid & 3, fr = lane & 15, fq = lane >> 4;
  const int nt = K / 64;
  const int ntiles = nM * nN;
  const int nxcd = (cx.nblk & 7) == 0 ? 8 : 1;
  const int xcd = cx.bid % nxcd, xidx = cx.bid / nxcd, xper = cx.nblk / nxcd;
  const int t_lo = (int)(((long)ntiles * xcd) / nxcd), t_hi = (int)(((long)ntiles * (xcd + 1)) / nxcd);
  auto unit_at = [&](int i, int& pm, int& pn) -> bool {
    const int tt = t_lo + xidx + i * xper;
    if (tt >= t_hi) return false;
    const int band = tt / (8 * nN);
    const int brows = min(8, nM - band * 8);
    const int rem = tt - band * 8 * nN;
    pn = rem / brows; pm = band * 8 + rem % brows;
    return true;
  };
  unsigned voffA[2], voffB[2];
#pragma unroll
  for (int i = 0; i < 2; ++i) {
    int R, C; g2_stage_rc(tid * 16 + i * 8192, R, C);
    const int rho = R & 31, Rb = (R & ~31) + 8 * ((rho & 15) >> 2) + 4 * (rho >> 4) + (rho & 3);
    voffA[i] = (unsigned)(R * K + C) * 2u; voffB[i] = (unsigned)(Rb * K + C) * 2u;
  }
  const size_t kstep = (size_t)(64 * 2);
  const size_t hstep = (size_t)128 * K * 2;
  const size_t tstep = 2 * hstep;
  const unsigned ldsw = (unsigned)wid * 1024u;
  const int aoff = g2_lds_byte(wr * 64 + fr, fq * 8), boff = g2_lds_byte(wc * 32 + fr, fq * 8);
#define G2_SA(b, h) (((b) * 2 + (h)) * HTB)
#define G2_SB(b, h) ((4 + (b) * 2 + (h)) * HTB)
#define G2_STAGE_(bufoff, gbase, vo_) do { _Pragma("unroll") for (int _i = 0; _i < 2; ++_i) \
    __builtin_amdgcn_global_load_lds((const unsigned*)((const char*)(gbase) + vo_[_i]), (LAS3 unsigned*)(lds + (bufoff) + ldsw + _i * 8192), 16, 0, 0); } while (0)
#define G2_STAGE(bufoff, gbase) G2_STAGE_(bufoff, gbase, voffA)
#define G2_STAGEB(bufoff, gbase) G2_STAGE_(bufoff, gbase, voffB)
#define G2_LDA(dst, b, h) do { _Pragma("unroll") for (int m = 0; m < 4; ++m) _Pragma("unroll") for (int k = 0; k < 2; ++k) dst[m][k] = *(const LAS3 bf16x8*)(lds + G2_SA(b, h) + aoff + m * 2048 + k * 1024); } while (0)
#define G2_LDB(dst, b, h) do { _Pragma("unroll") for (int n = 0; n < 2; ++n) _Pragma("unroll") for (int k = 0; k < 2; ++k) dst[n][k] = *(const LAS3 bf16x8*)(lds + G2_SB(b, h) + boff + n * 2048 + k * 1024); } while (0)
#define G2_MMA(ai, bj, At_, Bt_) do { __builtin_amdgcn_s_setprio(1); _Pragma("unroll") for (int m = 0; m < 4; ++m) _Pragma("unroll") for (int n = 0; n < 2; ++n) _Pragma("unroll") for (int k = 0; k < 2; ++k) \
    acc[ai][bj][m][n] = __builtin_amdgcn_mfma_f32_16x16x32_f16(Bt_[n][k], At_[m][k], acc[ai][bj][m][n], 0, 0, 0); __builtin_amdgcn_s_setprio(0); } while (0)
#define G2_WAIT_V(n) asm volatile("s_waitcnt vmcnt(" #n ")" ::: "memory")
#define G2_WAIT_L(n) asm volatile("s_waitcnt lgkmcnt(" #n ")" ::: "memory")
#define G2_BAR __builtin_amdgcn_s_barrier()
#define G2_SCHED __builtin_amdgcn_sched_barrier(0)
  int cpm, cpn, npm = 0, npn = 0, ui = 0;
  if (!unit_at(0, cpm, cpn)) return;
  f32x4 acc[2][2][4][2];
#pragma unroll
  for (int a = 0; a < 2; ++a)
#pragma unroll
    for (int b = 0; b < 2; ++b)
#pragma unroll
      for (int m = 0; m < 4; ++m)
#pragma unroll
        for (int n = 0; n < 2; ++n) acc[a][b][m][n] = f32x4{0.f, 0.f, 0.f, 0.f};
  bf16x8 At[4][2], B0[2][2], B1[2][2];
  const char* cA = (const char*)A + (size_t)cpm * tstep;
  const char* cB = (const char*)Bt + (size_t)cpn * tstep;
  G2_STAGEB(G2_SB(0, 0), cB); G2_STAGE(G2_SA(0, 0), cA); G2_STAGEB(G2_SB(0, 1), cB + hstep); G2_STAGE(G2_SA(0, 1), cA + hstep);
  if (wr == 1) G2_BAR;
  G2_WAIT_V(4); G2_BAR;
  G2_STAGEB(G2_SB(1, 0), cB + kstep); G2_STAGE(G2_SA(1, 0), cA + kstep); G2_STAGEB(G2_SB(1, 1), cB + hstep + kstep);
  G2_WAIT_V(6); G2_BAR;
  for (;;) {
    const bool has_next = unit_at(ui + 1, npm, npn);
    const char* nA = has_next ? (const char*)A + (size_t)npm * tstep : cA;
    const char* nB = has_next ? (const char*)Bt + (size_t)npn * tstep : cB;
    for (int t = 0; t < nt; t += 2) {
      const bool last = (t == nt - 2);
      const char* a1 = cA + (size_t)(t + 1) * kstep;
      const char* a2 = last ? nA : cA + (size_t)(t + 2) * kstep;
      const char* b2 = last ? nB : cB + (size_t)(t + 2) * kstep;
      const char* a3 = a2 + kstep;
      const char* b3 = b2 + kstep;
      G2_LDB(B0, 0, 0); G2_SCHED; G2_LDA(At, 0, 0); G2_STAGE(G2_SA(1, 1), a1 + hstep);
      G2_WAIT_L(8); G2_BAR; G2_WAIT_L(0); G2_MMA(0, 0, At, B0); G2_BAR; G2_SCHED;
      G2_LDB(B1, 0, 1); G2_STAGEB(G2_SB(0, 0), b2);
      G2_BAR; G2_WAIT_L(0); G2_MMA(0, 1, At, B1); G2_BAR;
      G2_LDA(At, 0, 1); G2_STAGE(G2_SA(0, 0), a2);
      G2_BAR; G2_WAIT_L(0); G2_MMA(1, 0, At, B0); G2_BAR; G2_SCHED;
      G2_STAGEB(G2_SB(0, 1), b2 + hstep);
      G2_WAIT_V(6); G2_BAR; G2_MMA(1, 1, At, B1); G2_BAR;
      G2_LDB(B0, 1, 0); G2_SCHED; G2_LDA(At, 1, 0); G2_STAGE(G2_SA(0, 1), a2 + hstep);
      G2_WAIT_L(8); G2_BAR; G2_WAIT_L(0); G2_MMA(0, 0, At, B0); G2_BAR; G2_SCHED;
      G2_LDB(B1, 1, 1); G2_STAGEB(G2_SB(1, 0), b3);
      G2_BAR; G2_WAIT_L(0); G2_MMA(0, 1, At, B1); G2_BAR;
      G2_LDA(At, 1, 1); G2_STAGE(G2_SA(1, 0), a3);
      G2_BAR; G2_WAIT_L(0); G2_MMA(1, 0, At, B0); G2_BAR; G2_SCHED;
      G2_STAGEB(G2_SB(1, 1), b3 + hstep);
      G2_WAIT_V(6); G2_BAR; G2_MMA(1, 1, At, B1); G2_BAR;
    }
    {
      const int row0 = cpm * 256 + wr * 64 + fr, col0 = cpn * 256 + wc * 32 + 8 * fq;
#pragma unroll
      for (int ai = 0; ai < 2; ++ai)
#pragma unroll
        for (int m = 0; m < 4; ++m)
#pragma unroll
          for (int bj = 0; bj < 2; ++bj) epi(row0 + ai * 128 + m * 16, col0 + bj * 128, acc[ai][bj][m][0], acc[ai][bj][m][1]);
    }
    if (!has_next) break;
#pragma unroll
    for (int a = 0; a < 2; ++a)
#pragma unroll
      for (int b = 0; b < 2; ++b)
#pragma unroll
        for (int m = 0; m < 4; ++m)
#pragma unroll
          for (int n = 0; n < 2; ++n) acc[a][b][m][n] = f32x4{0.f, 0.f, 0.f, 0.f};
    cpm = npm; cpn = npn; cA = nA; cB = nB; ++ui;
  }
  G2_WAIT_V(0);
  if (wr == 0) G2_BAR;
  G2_BAR;
#undef G2_SA
#undef G2_SB
#undef G2_STAGE
#undef G2_STAGEB
#undef G2_STAGE_
#undef G2_LDA
#undef G2_LDB
#undef G2_MMA
#undef G2_WAIT_V
#undef G2_WAIT_L
#undef G2_BAR
#undef G2_SCHED
}

template <int K, int NT, class Epi>
DEV void small_gemm(const Params& p, const Ctx& cx, const char* As, int astride, const bf16_t* __restrict__ Bt, int n0, Epi epi) {
  const int lane = cx.tid & 63, fr = lane & 15, fq = lane >> 4;
  f32x4 acc[4][NT];
#pragma unroll
  for (int i = 0; i < 4; ++i)
#pragma unroll
    for (int j = 0; j < NT; ++j) acc[i][j] = f32x4{0.f, 0.f, 0.f, 0.f};
#pragma unroll 2
  for (int k0 = 0; k0 < K; k0 += 32) {
    bf16x8 af[4];
#pragma unroll
    for (int i = 0; i < 4; ++i) af[i] = *(const bf16x8*)(As + (i * 16 + fr) * astride + (k0 + fq * 8) * 2);
#pragma unroll
    for (int jn = 0; jn < NT; ++jn) {
      bf16x8 bf = *(const bf16x8*)(Bt + (size_t)(n0 + jn * 16 + fr) * K + k0 + fq * 8);
#pragma unroll
      for (int i = 0; i < 4; ++i) acc[i][jn] = __builtin_amdgcn_mfma_f32_16x16x32_f16(bf, af[i], acc[i][jn], 0, 0, 0);
    }
  }
#pragma unroll
  for (int i = 0; i < 4; ++i)
#pragma unroll
    for (int jn = 0; jn < NT; ++jn) epi(i * 16 + fr, n0 + jn * 16 + fq * 4, acc[i][jn]);
}

struct S5P { float ar, ai, br, bi; };
DEV S5P s5_params(const Params& p, const Ctx& cx, int l, int d, int g, int lane) {
  int idx = ((l * 2 + d) * 32 + g) * 64 + lane;
  float lr = fminf(p.s5_lam_re[idx], -1e-4f), li = p.s5_lam_im[idx];
  float step = expf(p.s5_log_step[(l * 2 + d) * 32 + g]);
  float xr = lr * step, xi = li * step;
  float e = expf(xr), cs = cosf(xi), sn = sinf(xi);
  S5P r;
  r.ar = e * cs; r.ai = e * sn;
  float sh = sinf(0.5f * xi);
  float nr = expm1f(xr) * cs - 2.f * sh * sh, ni = e * sn;
  float inv = 1.f / (lr * lr + li * li);
  r.br = (nr * lr + ni * li) * inv;
  r.bi = (ni * lr - nr * li) * inv;
  return r;
}

DEV void s5_load_u(const h16* zrest, int rowbase, int g, char* ulds, int lane) {
#pragma unroll
  for (int i = 0; i < 8; ++i) {
    int e = i * 64 + lane;
    int r = e >> 1, hf = e & 1;
    uint4 v = *(const uint4*)(zrest + (size_t)(rowbase + r) * ZR + g * 16 + hf * 8);
    *(uint4*)(ulds + r * 32 + hf * 16) = v;
  }
  lds_fence();
}

DEV int s5_rowbase(int b, int c) { return c == 0 ? NLAT + b * 256 : b * 16384 + (c - 1) * 256; }

DEV void s5_pass1_unit(const Params& p, const Ctx& cx, int l, int unit, char* wl, int lane) {
  int c = unit % 65, bg = unit / 65, g = bg & 31, b = bg >> 5;
  const h16* zrest = (const h16*)(p.ws + OFF_ZREST);
  float2* F = (float2*)(p.ws + OFF_S5F);
  s5_load_u(zrest, s5_rowbase(b, c), g, wl, lane);
  float Br[16], Bi[16];
  {
    const float* pr = p.s5_b_re + ((size_t)(l * 32 + g) * 64 + lane) * 16;
    const float* pi = p.s5_b_im + ((size_t)(l * 32 + g) * 64 + lane) * 16;
#pragma unroll
    for (int i = 0; i < 16; i += 4) {
      float4 a = *(const float4*)(pr + i), bq = *(const float4*)(pi + i);
      Br[i] = a.x; Br[i + 1] = a.y; Br[i + 2] = a.z; Br[i + 3] = a.w;
      Bi[i] = bq.x; Bi[i + 1] = bq.y; Bi[i + 2] = bq.z; Bi[i + 3] = bq.w;
    }
  }
  S5P pf = s5_params(p, cx, l, 0, g, lane), pb = s5_params(p, cx, l, 1, g, lane);
  float xr = 0, xi = 0, yr = 0, yi = 0, pwr = 1.f, pwi = 0.f;
#pragma unroll 4
  for (int t = 0; t < 256; ++t) {
    h16x8 u0 = *(const h16x8*)(wl + t * 32), u1 = *(const h16x8*)(wl + t * 32 + 16);
    float br = 0, bi = 0;
#pragma unroll
    for (int i = 0; i < 8; ++i) { float u = (float)u0[i]; br = fmaf(u, Br[i], br); bi = fmaf(u, Bi[i], bi); }
#pragma unroll
    for (int i = 0; i < 8; ++i) { float u = (float)u1[i]; br = fmaf(u, Br[8 + i], br); bi = fmaf(u, Bi[8 + i], bi); }
    float nxr = pf.ar * xr - pf.ai * xi + br, nxi = pf.ar * xi + pf.ai * xr + bi;
    xr = nxr; xi = nxi;
    yr += pwr * br - pwi * bi; yi += pwr * bi + pwi * br;
    float npr = pwr * pb.ar - pwi * pb.ai, npi = pwr * pb.ai + pwi * pb.ar;
    pwr = npr; pwi = npi;
  }
  size_t fi = (((size_t)(b * 32 + g) * 65 + c) * 2) * 64 + lane;
  F[fi] = make_float2(pf.br * xr - pf.bi * xi, pf.br * xi + pf.bi * xr);
  F[fi + 64] = make_float2(pb.br * yr - pb.bi * yi, pb.br * yi + pb.bi * yr);
}

DEV void s5_pass3_unit(const Params& p, const Ctx& cx, int l, int unit, char* wl, int lane) {
  int c = unit % 65, bg = unit / 65, g = bg & 31, b = bg >> 5;
  const int fr = lane & 15, fq = lane >> 4;
  const h16* zrest = (const h16*)(p.ws + OFF_ZREST);
  const float2* F = (const float2*)(p.ws + OFF_S5F);
  float* S5Y = (float*)(p.ws + OFF_S5Y);
  const int rowbase = s5_rowbase(b, c);
  char* ulds = wl;
  char* tile = wl + 8192;
  s5_load_u(zrest, rowbase, g, ulds, lane);
  float Br[16], Bi[16];
  {
    const float* pr = p.s5_b_re + ((size_t)(l * 32 + g) * 64 + lane) * 16;
    const float* pi = p.s5_b_im + ((size_t)(l * 32 + g) * 64 + lane) * 16;
#pragma unroll
    for (int i = 0; i < 16; i += 4) {
      float4 a = *(const float4*)(pr + i), bq = *(const float4*)(pi + i);
      Br[i] = a.x; Br[i + 1] = a.y; Br[i + 2] = a.z; Br[i + 3] = a.w;
      Bi[i] = bq.x; Bi[i + 1] = bq.y; Bi[i + 2] = bq.z; Bi[i + 3] = bq.w;
    }
  }
  const float dsk = p.s5_d[(size_t)l * 512 + g * 16 + fr];
  const size_t fbase = ((size_t)(b * 32 + g) * 65) * 2 * 64 + lane;
#pragma unroll 1
  for (int d = 0; d < 2; ++d) {
    S5P pp = s5_params(p, cx, l, d, g, lane);
    float qr = pp.ar, qi = pp.ai;
#pragma unroll
    for (int i = 0; i < 8; ++i) { float t = qr * qr - qi * qi; qi = 2.f * qr * qi; qr = t; }
    float xr = 0, xi = 0;
    if (d == 0) {
      for (int cc = 0; cc < c; ++cc) {
        float2 f = F[fbase + (size_t)(cc * 2 + 0) * 64];
        float t = qr * xr - qi * xi + f.x; xi = qr * xi + qi * xr + f.y; xr = t;
      }
    } else if (c > 0) {
      float2 f0 = F[fbase + (size_t)(0 * 2 + 1) * 64];
      xr = f0.x; xi = f0.y;
      for (int cc = 64; cc > c; --cc) {
        float2 f = F[fbase + (size_t)(cc * 2 + 1) * 64];
        float t = qr * xr - qi * xi + f.x; xi = qr * xi + qi * xr + f.y; xr = t;
      }
    }
    bf16x8 chi[4], clo[4];
    {
      const float* cr = p.s5_c_re + ((size_t)((l * 2 + d) * 32 + g) * 16 + fr) * 64;
      const float* ci = p.s5_c_im + ((size_t)((l * 2 + d) * 32 + g) * 16 + fr) * 64;
#pragma unroll
      for (int ks = 0; ks < 4; ++ks) {
        float4 a = *(const float4*)(cr + ks * 16 + fq * 4), bq = *(const float4*)(ci + ks * 16 + fq * 4);
        float vals[8] = {a.x, -bq.x, a.y, -bq.y, a.z, -bq.z, a.w, -bq.w};
#pragma unroll
        for (int j = 0; j < 8; ++j) {
          h16 hh = (h16)vals[j];
          chi[ks][j] = hh;
          clo[ks][j] = (h16)(vals[j] - (float)hh);
        }
      }
    }
#pragma unroll 1
    for (int sb = 0; sb < 16; ++sb) {
      const int sub = d == 0 ? sb : 15 - sb;
#pragma unroll 4
      for (int q = 0; q < 16; ++q) {
        const int tt = d == 0 ? q : 15 - q;
        const int t = sub * 16 + tt;
        h16x8 u0 = *(const h16x8*)(ulds + t * 32), u1 = *(const h16x8*)(ulds + t * 32 + 16);
        float br = 0, bi = 0;
#pragma unroll
        for (int i = 0; i < 8; ++i) { float u = (float)u0[i]; br = fmaf(u, Br[i], br); bi = fmaf(u, Bi[i], bi); }
#pragma unroll
        for (int i = 0; i < 8; ++i) { float u = (float)u1[i]; br = fmaf(u, Br[8 + i], br); bi = fmaf(u, Bi[8 + i], bi); }
        float vr = pp.br * br - pp.bi * bi, vi = pp.br * bi + pp.bi * br;
        float nxr = pp.ar * xr - pp.ai * xi + vr, nxi = pp.ar * xi + pp.ai * xr + vi;
        xr = nxr; xi = nxi;
        h16x2 hv2 = {(h16)xr, (h16)xi};
        *(unsigned*)(tile + tt * 272 + lane * 4) = __builtin_bit_cast(unsigned, hv2);
      }
      lds_fence();
      f32x4 acc = f32x4{0.f, 0.f, 0.f, 0.f};
#pragma unroll
      for (int ks = 0; ks < 4; ++ks) {
        bf16x8 ah = *(const bf16x8*)(tile + fr * 272 + ks * 64 + fq * 16);
        acc = __builtin_amdgcn_mfma_f32_16x16x32_f16(ah, chi[ks], acc, 0, 0, 0);
        acc = __builtin_amdgcn_mfma_f32_16x16x32_f16(ah, clo[ks], acc, 0, 0, 0);
      }
      lds_fence();
#pragma unroll
      for (int r = 0; r < 4; ++r) {
        int tl = sub * 16 + fq * 4 + r;
        float* yp = S5Y + (size_t)(rowbase + tl) * 512 + g * 16 + fr;
        if (d == 0) {
          float u = (float)*(const h16*)(ulds + tl * 32 + fr * 2);
          *yp = acc[r] + dsk * u;
        } else {
          *yp = gelu_f(*yp + acc[r]);
        }
      }
    }
  }
}

DEV void prep_item(const Params& p, const Ctx& cx, int l, int item, char* smem) {
  const int tile = item >> 2, q = item & 3;
  const int row0 = tile * 64;
  const int tid = cx.tid;
  const h16* zc = (const h16*)(p.ws + OFF_REG2);
  h16* SC = (h16*)(p.ws + OFF_SCAN);
  const char* wt = p.ws + OFF_WT + (size_t)l * WT_SIZE;
  {
    const int d = q >> 1, isA = q & 1;
    const int coff = isA ? 3200 + d * 64 : 3072 + d * 64;
    int tok = tid >> 3, c8 = tid & 7;
    h16x8 cv = *(const h16x8*)(zc + (size_t)(row0 + tok) * ZC + coff + c8 * 8);
    float f[8];
#pragma unroll
    for (int j = 0; j < 8; ++j) { f[j] = (float)cv[j]; if (!isA) f[j] = tanh_f(f[j]); }
    uint4 o;
    o.x = pack_bf2(f[0], f[1]); o.y = pack_bf2(f[2], f[3]); o.z = pack_bf2(f[4], f[5]); o.w = pack_bf2(f[6], f[7]);
    *(uint4*)(smem + tok * 144 + c8 * 16) = o;
    __syncthreads();
    const bf16_t* Bt = (const bf16_t*)(wt + (isA ? WT_A2 : WT_W2)) + (size_t)d * 1024 * 64;
    const float* biasw = p.rwkv_w0 + (size_t)(l * 2 + d) * 1024;
    const float* biasa = p.rwkv_a0 + (size_t)(l * 2 + d) * 1024;
    h16* dst = SC + (size_t)(isA ? 4 + d : 6 + d) * ARR;
#pragma unroll 1
    for (int hf = 0; hf < 2; ++hf) small_gemm<64, 4>(p, cx, smem, 144, Bt, (tid >> 6) * 128 + hf * 64, [&](int m, int n, f32x4 v) {
      float4 bbw = *(const float4*)(biasw + n), bba = *(const float4*)(biasa + n);
      float4 bb = isA ? bba : bbw;
      float r0 = sigmoid_f(v[0] + bb.x), r1 = sigmoid_f(v[1] + bb.y), r2 = sigmoid_f(v[2] + bb.z), r3 = sigmoid_f(v[3] + bb.w);
      if (!isA) { r0 = __expf(-DECAY_SCALE * r0); r1 = __expf(-DECAY_SCALE * r1); r2 = __expf(-DECAY_SCALE * r2); r3 = __expf(-DECAY_SCALE * r3); }
      h16x4 o4 = {(h16)r0, (h16)r1, (h16)r2, (h16)r3};
      *(h16x4*)(dst + (size_t)(row0 + m) * 1024 + n) = o4;
    });
  }
  {
    const float* cw = p.conv_rkv + (size_t)l * 3 * 3072;
    const int grp = tid & 7, hh = (tid >> 3) & 3;
    const int c0 = (4 * q + hh) * 64 + grp * 8;
    float cwt[3][3][8];
#pragma unroll
    for (int s = 0; s < 3; ++s)
#pragma unroll
      for (int tp = 0; tp < 3; ++tp)
#pragma unroll
        for (int j = 0; j < 8; j += 4) {
          float4 a = *(const float4*)(cw + tp * 3072 + s * 1024 + c0 + j);
          cwt[s][tp][j] = a.x; cwt[s][tp][j + 1] = a.y; cwt[s][tp][j + 2] = a.z; cwt[s][tp][j + 3] = a.w;
        }
    float kkw[8];
#pragma unroll
    for (int j = 0; j < 8; j += 4) {
      float4 kq = *(const float4*)(p.rwkv_k_k + (size_t)l * 1024 + c0 + j);
      kkw[j] = kq.x; kkw[j + 1] = kq.y; kkw[j + 2] = kq.z; kkw[j + 3] = kq.w;
    }
#pragma unroll 1
    for (int it = 0; it < 4; ++it) {
      const int tok = (tid >> 5) + it * 16;
      const int row = row0 + tok;
      bool hasp, hasn;
      if (row < NLAT) { hasp = (row & 16383) != 0; hasn = (row & 16383) != 16383; }
      else { hasp = (row & 255) != 0; hasn = (row & 255) != 255; }
      const size_t off = (size_t)row * 1024 + c0;
      const h16* zp = zc + (size_t)row * ZC + c0;
      const h16* zpp = hasp ? zp - ZC : zp;
      const h16* zpn = hasn ? zp + ZC : zp;
      h16x8 cur[3], prv[3], nxt[3];
#pragma unroll
      for (int s = 0; s < 3; ++s) { cur[s] = *(const h16x8*)(zp + s * 1024); prv[s] = *(const h16x8*)(zpp + s * 1024); nxt[s] = *(const h16x8*)(zpn + s * 1024); }
      const float fp = hasp ? 1.f : 0.f, fn = hasn ? 1.f : 0.f;
      float kv[8];
#pragma unroll
      for (int s = 0; s < 3; ++s) {
        h16x8 o;
#pragma unroll
        for (int j = 0; j < 8; ++j) {
          float ov = cwt[s][0][j] * (fp * (float)prv[s][j]) + cwt[s][1][j] * (float)cur[s][j] + cwt[s][2][j] * (fn * (float)nxt[s][j]);
          o[j] = (h16)ov;
          if (s == 1) kv[j] = ov;
        }
        *(h16x8*)(SC + (size_t)s * ARR + off) = o;
      }
      float kk[8], ss = 0;
#pragma unroll
      for (int j = 0; j < 8; ++j) { kk[j] = kv[j] * kkw[j]; ss += kk[j] * kk[j]; }
      ss = allreduce8(ss);
      float inv = rcp_f(fmaxf(sqrtf(ss), 1e-12f));
      h16x8 o;
#pragma unroll
      for (int j = 0; j < 8; ++j) o[j] = (h16)(kk[j] * inv);
      *(h16x8*)(SC + 3 * ARR + off) = o;
    }
  }
}

DEV void phase_prep(const Params& p, const Ctx& cx0, int l, char* smem) {
  const int NPREP = 520 * 4, NS5 = 520;
  const Ctx& cx_ = cx0;
  for (int item = cx_.bid; item < NPREP + NS5; item += cx_.nblk) {
    __syncthreads();
    Ctx cx = cx0; asm volatile("" : "+v"(cx.tid));
    const int lane = cx.tid & 63, wid = cx.tid >> 6;
#ifndef NO_PREPITEM
    if (item < NPREP) prep_item(p, cx, l, item, smem);
    else
#endif
#ifndef NO_S5P1
      s5_pass1_unit(p, cx, l, (item - NPREP) * 8 + wid, smem + wid * 8192, lane);
#else
    {}
#endif
  }
}

typedef unsigned u2v __attribute__((ext_vector_type(2)));
struct RG { u2v w, a, kk, k, r; h16 v; };

constexpr int RW_NSLOT = 8, RW_SLOTB = 3072;
constexpr int RW_FLAGS = RW_NSLOT * RW_SLOTB;
constexpr int RW_NG = 16640 / 4;
typedef float f4v __attribute__((ext_vector_type(4)));

#define RW_RLO(gq, rlo)                                                            \
  {                                                                                \
    const int gg = (gq) < RW_NG ? (gq) : RW_NG - 1;                                \
    const int q0_ = gg * 4;                                                        \
    const int isl = q0_ >= 256;                                                    \
    const int base_ = isl ? b * 16384 : NLAT + b * 256;                            \
    const int t0_ = isl ? q0_ - 256 : q0_;                                         \
    const int last_ = isl ? 16383 : 255;                                           \
    rlo = base_ + (d ? last_ - t0_ - 3 : t0_);                                     \
  }

DEV void rwkv_helper(const Params& p, const Ctx& cx, int l, int unit, int lane, char* ring) {
  const int d = unit & 1, h = (unit >> 1) & 15, b = unit >> 5;
  const int j = lane >> 4, s = lane & 15;
  const h16* SC = (const h16*)(p.ws + OFF_SCAN);
  const char* pR = (const char*)(SC + 0 * ARR + h * 64);
  const char* pK = (const char*)(SC + 1 * ARR + h * 64);
  const char* pV = (const char*)(SC + 2 * ARR + h * 64);
  const char* pKK = (const char*)(SC + 3 * ARR + h * 64);
  const char* pA = (const char*)(SC + (size_t)(4 + d) * ARR + h * 64);
  const char* pW = (const char*)(SC + (size_t)(6 + d) * ARR + h * 64);
  const int jm = d ? 3 - j : j;
  const unsigned vo0 = (unsigned)(jm * 2048 + s * 8);
  f4v ka4, om4;
  {
    float4 t = *(const float4*)(p.rwkv_k_a + (size_t)l * 1024 + h * 64 + 4 * s);
    ka4 = f4v{t.x, t.y, t.z, t.w};
    om4 = 1.f - ka4;
  }
  struct RGH { u2v w, a, kk, k, r, v; };
  RGH q0, q1, q2, q3, q4, q5, q6, q7;
  const unsigned wofs = (unsigned)(j * 128 + s * 8);
  const unsigned vwofs = (unsigned)(2560 + j * 128 + s * 8);
  LAS3 volatile int* pflag = (LAS3 volatile int*)(ring + RW_FLAGS);
  LAS3 volatile int* cflag = (LAS3 volatile int*)(ring + RW_FLAGS + 64);
  int cmin = 0;
#define CV4(uv) __builtin_convertvector(__builtin_bit_cast(h16x4, uv), f4v)
#define RH_LOAD(q, gq)                                                             \
  {                                                                                \
    int rlo; RW_RLO(gq, rlo);                                                      \
    unsigned vo = vo0; asm volatile("" : "+v"(vo));                                \
    const size_t off = (size_t)rlo * 2048;                                         \
    q.w = *(const u2v*)(pW + off + vo); q.a = *(const u2v*)(pA + off + vo);        \
    q.kk = *(const u2v*)(pKK + off + vo); q.k = *(const u2v*)(pK + off + vo);      \
    q.r = *(const u2v*)(pR + off + vo); q.v = *(const u2v*)(pV + off + vo);        \
  }
#define RH_STEP(q, gq)                                                             \
  {                                                                                \
    if ((gq) >= RW_NSLOT && cmin < (gq) - RW_NSLOT + 1) {                          \
      do {                                                                         \
        const int c0_ = cflag[0], c1_ = cflag[1], c2_ = cflag[2], c3_ = cflag[3];  \
        cmin = __builtin_amdgcn_readfirstlane(min(min(c0_, c1_), min(c2_, c3_)));  \
        if (cmin < (gq) - RW_NSLOT + 1) __builtin_amdgcn_s_sleep(1);               \
      } while (cmin < (gq) - RW_NSLOT + 1);                                        \
    }                                                                              \
    asm volatile("" ::: "memory");                                                 \
    char* sl = ring + ((gq) % RW_NSLOT) * RW_SLOTB;                                \
    const f4v a_ = CV4(q.a), kk_ = CV4(q.kk);                                      \
    const f4v kka_ = kk_ * a_, kd_ = CV4(q.k) * (a_ * ka4 + om4);                  \
    *(u2v*)(sl + 0 * 512 + wofs) = q.w;                                            \
    *(u2v*)(sl + 1 * 512 + wofs) = q.kk;                                           \
    *(u2v*)(sl + 2 * 512 + wofs) = __builtin_bit_cast(u2v, __builtin_convertvector(kka_, h16x4)); \
    *(u2v*)(sl + 3 * 512 + wofs) = __builtin_bit_cast(u2v, __builtin_convertvector(kd_, h16x4));  \
    *(u2v*)(sl + 4 * 512 + wofs) = q.r;                                            \
    *(u2v*)(sl + vwofs) = q.v;                                                     \
    asm volatile("s_waitcnt lgkmcnt(0)" ::: "memory");     \
    *pflag = (gq) + 1;                                                             \
  }
  RH_LOAD(q0, 0); RH_LOAD(q1, 1); RH_LOAD(q2, 2); RH_LOAD(q3, 3); RH_LOAD(q4, 4); RH_LOAD(q5, 5); RH_LOAD(q6, 6); RH_LOAD(q7, 7);
#pragma unroll 1
  for (int g = 0; g < RW_NG; g += 8) {
    RH_STEP(q0, g); RH_LOAD(q0, g + 8); __builtin_amdgcn_sched_barrier(0);
    RH_STEP(q1, g + 1); RH_LOAD(q1, g + 9); __builtin_amdgcn_sched_barrier(0);
    RH_STEP(q2, g + 2); RH_LOAD(q2, g + 10); __builtin_amdgcn_sched_barrier(0);
    RH_STEP(q3, g + 3); RH_LOAD(q3, g + 11); __builtin_amdgcn_sched_barrier(0);
    RH_STEP(q4, g + 4); RH_LOAD(q4, g + 12); __builtin_amdgcn_sched_barrier(0);
    RH_STEP(q5, g + 5); RH_LOAD(q5, g + 13); __builtin_amdgcn_sched_barrier(0);
    RH_STEP(q6, g + 6); RH_LOAD(q6, g + 14); __builtin_amdgcn_sched_barrier(0);
    RH_STEP(q7, g + 7); RH_LOAD(q7, g + 15); __builtin_amdgcn_sched_barrier(0);
  }
#undef RH_LOAD
#undef RH_STEP
#undef CV4
}

DEV void rwkv_consumer(const Params& p, const Ctx& cx, int l, int task, int lane, const char* ring, int widx) {
  const int unit = task >> 4, d = unit & 1, h = (unit >> 1) & 15, b = unit >> 5;
  const int j = lane >> 4, s = lane & 15;
  const int myrow = (task & 15) * 4 + j;
  char* pO = (char*)((h16*)(p.ws + OFF_REG2) + (size_t)d * ARR + h * 64);
  const int sm = d ? 3 - (s & 3) : (s & 3);
  const unsigned vov0 = (unsigned)(sm * 2048 + myrow * 2);
  const unsigned rofs = (unsigned)(s * 8);
  const unsigned vrofs = (unsigned)(2560 + myrow * 2);
  LAS3 volatile int* pflag = (LAS3 volatile int*)(ring + RW_FLAGS);
  LAS3 volatile int* cflag = (LAS3 volatile int*)(ring + RW_FLAGS + 64) + widx;
  float S0 = 0.f, S1 = 0.f, S2 = 0.f, S3 = 0.f;
  int pseen = 0;
  struct GD { u2v w[4], kk[4], kka[4], kd[4], r[4]; unsigned v[4]; };
  GD A, B;
#define RC_WAIT(gq) { if (pseen <= (gq)) { do { pseen = __builtin_amdgcn_readfirstlane(*pflag); if (pseen <= (gq)) __builtin_amdgcn_s_sleep(1); } while (pseen <= (gq)); } asm volatile("" ::: "memory"); }
#define RC_LOAD(G, gq)                                                             \
  {                                                                                \
    const char* sl = ring + ((gq) % RW_NSLOT) * RW_SLOTB;                          \
    _Pragma("unroll") for (int u = 0; u < 4; ++u) {                                \
      G.w[u] = *(const u2v*)(sl + 0 * 512 + u * 128 + rofs);                       \
      G.kk[u] = *(const u2v*)(sl + 1 * 512 + u * 128 + rofs);                      \
      G.kka[u] = *(const u2v*)(sl + 2 * 512 + u * 128 + rofs);                     \
      G.kd[u] = *(const u2v*)(sl + 3 * 512 + u * 128 + rofs);                      \
      G.r[u] = *(const u2v*)(sl + 4 * 512 + u * 128 + rofs);                       \
      G.v[u] = *(const unsigned short*)(sl + u * 128 + vrofs);                     \
    }                                                                              \
  }
#define RC_COMP(G, gq)                                                             \
  {                                                                                \
    float dres[4];                                                                 \
    _Pragma("unroll") for (int u = 0; u < 4; ++u) {                                \
        \
        \
      float ea, eb, x_, y_, t0, t1, t2, t3;                                        \
      asm("v_fma_mix_f32 %6, %0, %12, 0 op_sel:[0,0,0] op_sel_hi:[0,1,0]\n\t"      \
          "v_fma_mix_f32 %7, %2, %13, 0 op_sel:[0,0,0] op_sel_hi:[0,1,0]\n\t"      \
          "v_fma_mix_f32 %6, %1, %12, %6 op_sel:[0,1,0] op_sel_hi:[0,1,0]\n\t"     \
          "v_fma_mix_f32 %7, %3, %13, %7 op_sel:[0,1,0] op_sel_hi:[0,1,0]\n\t"     \
          "v_fma_mix_f32 %8, %22, %16, 0 op_sel:[0,0,0] op_sel_hi:[1,1,0]\n\t"     \
          "v_add_f32 %6, %6, %7\n\t"                                               \
          "v_fma_mix_f32 %9, %22, %16, 0 op_sel:[0,1,0] op_sel_hi:[1,1,0]\n\t"     \
          "v_fma_mix_f32 %10, %22, %17, 0 op_sel:[0,0,0] op_sel_hi:[1,1,0]\n\t"    \
          "v_add_f32_dpp %6, %6, %6 quad_perm:[1,0,3,2] row_mask:0xf bank_mask:0xf bound_ctrl:1\n\t" \
          "v_fma_mix_f32 %11, %22, %17, 0 op_sel:[0,1,0] op_sel_hi:[1,1,0]\n\t"    \
          "v_fma_mix_f32 %0, %0, %14, %8 op_sel:[0,0,0] op_sel_hi:[0,1,0]\n\t"     \
          "v_add_f32_dpp %6, %6, %6 quad_perm:[2,3,0,1] row_mask:0xf bank_mask:0xf bound_ctrl:1\n\t" \
          "v_fma_mix_f32 %1, %1, %14, %9 op_sel:[0,1,0] op_sel_hi:[0,1,0]\n\t"     \
          "v_fma_mix_f32 %2, %2, %15, %10 op_sel:[0,0,0] op_sel_hi:[0,1,0]\n\t"    \
          "v_add_f32_dpp %6, %6, %6 row_half_mirror row_mask:0xf bank_mask:0xf bound_ctrl:1\n\t" \
          "v_fma_mix_f32 %3, %3, %15, %11 op_sel:[0,1,0] op_sel_hi:[0,1,0]\n\t"    \
          "s_nop 0\n\t"                                                            \
          "v_add_f32_dpp %6, %6, %6 row_mirror row_mask:0xf bank_mask:0xf bound_ctrl:1\n\t" \
          "v_fma_mix_f32 %0, -%6, %18, %0 op_sel:[0,0,0] op_sel_hi:[0,1,0]\n\t"    \
          "v_fma_mix_f32 %1, -%6, %18, %1 op_sel:[0,1,0] op_sel_hi:[0,1,0]\n\t"    \
          "v_fma_mix_f32 %2, -%6, %19, %2 op_sel:[0,0,0] op_sel_hi:[0,1,0]\n\t"    \
          "v_fma_mix_f32 %3, -%6, %19, %3 op_sel:[0,1,0] op_sel_hi:[0,1,0]\n\t"    \
          "v_fma_mix_f32 %4, %0, %20, 0 op_sel:[0,0,0] op_sel_hi:[0,1,0]\n\t"      \
          "v_fma_mix_f32 %5, %2, %21, 0 op_sel:[0,0,0] op_sel_hi:[0,1,0]\n\t"      \
          "v_fma_mix_f32 %4, %1, %20, %4 op_sel:[0,1,0] op_sel_hi:[0,1,0]\n\t"     \
          "v_fma_mix_f32 %5, %3, %21, %5 op_sel:[0,1,0] op_sel_hi:[0,1,0]"         \
          : "+v"(S0), "+v"(S1), "+v"(S2), "+v"(S3), "=&v"(ea), "=&v"(eb), "=&v"(x_), "=&v"(y_),                     \
            "=&v"(t0), "=&v"(t1), "=&v"(t2), "=&v"(t3)                                                              \
          : "v"(G.kk[u].x), "v"(G.kk[u].y), "v"(G.w[u].x), "v"(G.w[u].y), "v"(G.kd[u].x), "v"(G.kd[u].y),           \
            "v"(G.kka[u].x), "v"(G.kka[u].y), "v"(G.r[u].x), "v"(G.r[u].y), "v"(G.v[u]));                           \
      dres[u] = ea + eb;     \
    }                                                                              \
    asm volatile("" ::: "memory");                                                 \
    *cflag = (gq) + 1;     \
    {                                                                              \
      int rlo; RW_RLO(gq, rlo);                                                    \
      unsigned vov = vov0; asm volatile("" : "+v"(vov));                           \
        \
      const bool p1_ = (s & 1) != 0, p2_ = (s & 2) != 0;                           \
      const float a_ = (p1_ ? dres[1] : dres[0]) + dpp_mov<0xB1>(p1_ ? dres[0] : dres[1]); \
      const float b_ = (p1_ ? dres[3] : dres[2]) + dpp_mov<0xB1>(p1_ ? dres[2] : dres[3]); \
      float val = (p2_ ? b_ : a_) + dpp_mov<0x4E>(p2_ ? a_ : b_);                  \
      val += dpp_mov<0x124>(val);                                                  \
      val += dpp_mov<0x128>(val);                                                  \
      *(h16*)(pO + (size_t)rlo * 2048 + vov) = (h16)val;                           \
    }                                                                              \
  }
  RC_WAIT(0); RC_LOAD(A, 0);
#pragma unroll 1
  for (int g = 0; g < RW_NG; g += 2) {
    RC_WAIT(g + 1); RC_LOAD(B, g + 1);
    RC_COMP(A, g);
    if (g + 2 < RW_NG) { RC_WAIT(g + 2); RC_LOAD(A, g + 2); }
    RC_COMP(B, g + 1);
  }
#undef RC_WAIT
#undef RC_LOAD
#undef RC_COMP
}
#undef RW_RLO

DEV void phase_scan(const Params& p, const Ctx& cx, int l, char* smem) {
  const int lane = cx.tid & 63, wid = __builtin_amdgcn_readfirstlane(cx.tid >> 6);
  for (int slot = cx.bid; slot < 256; slot += cx.nblk) {
    __syncthreads();
    if (wid == 4 && lane < 8) *(LAS3 volatile int*)(smem + RW_FLAGS + (lane == 0 ? 0 : 64 + (lane & 3) * 4)) = 0;
    __syncthreads();
    const int unit = slot & 63;
#ifndef NO_RWKV
    if (wid < 4) { __builtin_amdgcn_s_setprio(3); rwkv_consumer(p, cx, l, (unit << 4) | ((slot >> 6) << 2) | wid, lane, smem, wid); __builtin_amdgcn_s_setprio(0); }
    else if (wid == 4) { __builtin_amdgcn_s_setprio(1); rwkv_helper(p, cx, l, unit, lane, smem); __builtin_amdgcn_s_setprio(0); }
#endif
  }
  if (wid >= 5) {
    char* wl = smem + 32768 + (wid - 5) * 17408;
    for (int u = cx.bid * 3 + (wid - 5); u < 2 * 32 * 65; u += cx.nblk * 3) {
      if (l == 1 && (u % 65) == 0) continue;
#ifndef NO_S5P3
      s5_pass3_unit(p, cx, l, u, wl, lane);
#endif
    }
  }
}

DEV void pool_item(const Params& p, const Ctx& cx, int l, int item, char* smem) {
  const int tid = cx.tid;
  const h16* zrest = (const h16*)(p.ws + OFF_ZREST);
  bf16_t* ym = (bf16_t*)(p.ws + OFF_YM);
  const char* wt = p.ws + OFF_WT + (size_t)l * WT_SIZE;
  float* V = (float*)smem;
  char* At = smem + 43008;
  int g, rowout0, Lseq, p0, rlo, rhi, rstride, rowsrc0;
  if (item < 2048) {
    g = item & 3; int r = (item >> 2) & 255, b = item >> 10;
    int w = 2 << g;
    rlo = max(r - w / 2, 0); rhi = min(r + w / 2 - 1, 255);
    rowsrc0 = b * 16384; rstride = 64;
    rowout0 = b * 16384 + r * 64; Lseq = 64; p0 = 0;
  } else {
    int it = item - 2048;
    g = it & 3; int tq = (it >> 2) & 3, b = it >> 4;
    rlo = 0; rhi = 0; rowsrc0 = NLAT + b * 256; rstride = 0;
    rowout0 = NLAT + b * 256 + tq * 64; Lseq = 256; p0 = tq * 64;
  }
  const int w = 2 << g;
  const float invr = 1.f / (float)(rhi - rlo + 1);
  for (int unit = tid; unit < 80 * 16; unit += NTHREADS) {
    int lp = unit >> 4, ch8 = unit & 15;
    int pos = p0 - 8 + lp;
    float acc[8] = {0, 0, 0, 0, 0, 0, 0, 0};
    if (pos >= 0 && pos < Lseq) {
      const h16* bp = zrest + (size_t)(rowsrc0 + pos) * ZR + 1024 + g * 128 + ch8 * 8;
      const int nr = rhi - rlo + 1;
      for (int k0 = 0; k0 < nr; k0 += 4) {
        h16x8 v[4]; float wv[4];
#pragma unroll
        for (int i = 0; i < 4; ++i) {
          const int kk_ = min(k0 + i, nr - 1);
          wv[i] = (k0 + i < nr) ? 1.f : 0.f;
          v[i] = *(const h16x8*)(bp + (size_t)((rlo + kk_) * rstride) * ZR);
        }
#pragma unroll
        for (int i = 0; i < 4; ++i)
#pragma unroll
          for (int j = 0; j < 8; ++j) acc[j] += wv[i] * (float)v[i][j];
      }
    }
    float* vp = V + lp * 132 + ch8 * 8;
#pragma unroll
    for (int j = 0; j < 8; ++j) vp[j] = acc[j] * invr;
  }
  __syncthreads();
  for (int unit = tid; unit < 64 * 16; unit += NTHREADS) {
    int c = unit >> 4, ch8 = unit & 15;
    int pos = p0 + c;
    int lo = max(pos - w / 2, 0), hi = min(pos + w / 2 - 1, Lseq - 1);
    float acc[8] = {0, 0, 0, 0, 0, 0, 0, 0};
    for (int pp = lo; pp <= hi; ++pp) {
      const float* vp = V + (pp - p0 + 8) * 132 + ch8 * 8;
#pragma unroll
      for (int j = 0; j < 8; ++j) acc[j] += vp[j];
    }
    float invc = 1.f / (float)(hi - lo + 1);
    h16x8 uc = *(const h16x8*)(zrest + (size_t)(rowout0 + c) * ZR + 1024 + g * 128 + ch8 * 8);
    uint4 o;
    o.x = pack_bf2(acc[0] * invc - (float)uc[0], acc[1] * invc - (float)uc[1]);
    o.y = pack_bf2(acc[2] * invc - (float)uc[2], acc[3] * invc - (float)uc[3]);
    o.z = pack_bf2(acc[4] * invc - (float)uc[4], acc[5] * invc - (float)uc[5]);
    o.w = pack_bf2(acc[6] * invc - (float)uc[6], acc[7] * invc - (float)uc[7]);
    *(uint4*)(At + c * 272 + ch8 * 16) = o;
  }
  __syncthreads();
  const bf16_t* Bt = (const bf16_t*)(wt + WT_POOL) + (size_t)g * 128 * 128;
  const float* ps = p.pool_scale + (size_t)l * 512 + g * 128;
  small_gemm<128, 1>(p, cx, At, 272, Bt, (tid >> 6) * 16, [&](int m, int n, f32x4 v) {
    int row = rowout0 + m;
    float4 sc = *(const float4*)(ps + n);
    h16x4 gt = *(const h16x4*)(zrest + (size_t)row * ZR + 1536 + g * 128 + n);
    uint2 o;
    o.x = pack_bf2(v[0] * sc.x * silu_f((float)gt[0]), v[1] * sc.y * silu_f((float)gt[1]));
    o.y = pack_bf2(v[2] * sc.z * silu_f((float)gt[2]), v[3] * sc.w * silu_f((float)gt[3]));
    *(uint2*)(ym + (size_t)row * D + 512 + g * 128 + n) = o;
  });
}

DEV void glu_item(const Params& p, const Ctx& cx, int l, int tile, char* smem) {
  const int tid = cx.tid;
  const int row0 = tile * 64;
  const float* S5Y = (const float*)(p.ws + OFF_S5Y);
  const h16* zrest = (const h16*)(p.ws + OFF_ZREST);
  bf16_t* ym = (bf16_t*)(p.ws + OFF_YM);
  const char* wt = p.ws + OFF_WT + (size_t)l * WT_SIZE;
#pragma unroll
  for (int it = 0; it < 8; ++it) {
    int unit = tid + it * NTHREADS;
    int r = unit >> 6, c8 = unit & 63;
    const float* sp = S5Y + (size_t)(row0 + r) * 512 + c8 * 8;
    float4 a = *(const float4*)sp, bq = *(const float4*)(sp + 4);
    uint4 o;
    o.x = pack_bf2(a.x, a.y); o.y = pack_bf2(a.z, a.w); o.z = pack_bf2(bq.x, bq.y); o.w = pack_bf2(bq.z, bq.w);
    *(uint4*)(smem + r * 1040 + c8 * 16) = o;
  }
  __syncthreads();
  const bf16_t* Bt = (const bf16_t*)(wt + WT_GLU);
  const float* bg = p.b_glu + (size_t)l * 512;
  small_gemm<512, 4>(p, cx, smem, 1040, Bt, (tid >> 6) * 64, [&](int m, int n, f32x4 v) {
    int row = row0 + m;
    float4 y = *(const float4*)(S5Y + (size_t)row * 512 + n);
    float4 bb = *(const float4*)(bg + n);
    h16x4 gt = *(const h16x4*)(zrest + (size_t)row * ZR + 512 + n);
    uint2 o;
    o.x = pack_bf2(y.x * sigmoid_f(v[0] + bb.x) * silu_f((float)gt[0]), y.y * sigmoid_f(v[1] + bb.y) * silu_f((float)gt[1]));
    o.y = pack_bf2(y.z * sigmoid_f(v[2] + bb.z) * silu_f((float)gt[2]), y.w * sigmoid_f(v[3] + bb.w) * silu_f((float)gt[3]));
    *(uint2*)(ym + (size_t)row * D + n) = o;
  });
}

DEV void rwkvmerge_item(const Params& p, const Ctx& cx, int l, int tile) {
  const int tid = cx.tid;
  const int row0 = tile * 64;
  const h16* SC = (const h16*)(p.ws + OFF_SCAN);
  const h16* O = (const h16*)(p.ws + OFF_REG2);
  const h16* zrest = (const h16*)(p.ws + OFF_ZREST);
  bf16_t* ym = (bf16_t*)(p.ws + OFF_YM);
  const int grp = tid & 7, h = (tid >> 3) & 15;
  const int c0 = h * 64 + grp * 8;
  float pk[8], rk[8], gw[8], gb[8];
#pragma unroll
  for (int j = 0; j < 8; j += 4) {
    float4 t0 = *(const float4*)(p.rwkv_k_a + (size_t)l * 1024 + c0 + j), t1 = *(const float4*)(p.rwkv_r_k + (size_t)l * 1024 + c0 + j);
    float4 t2 = *(const float4*)(p.gn_w + (size_t)l * 1024 + c0 + j), t3 = *(const float4*)(p.gn_b + (size_t)l * 1024 + c0 + j);
    pk[j] = t0.x; pk[j + 1] = t0.y; pk[j + 2] = t0.z; pk[j + 3] = t0.w;
    rk[j] = t1.x; rk[j + 1] = t1.y; rk[j + 2] = t1.z; rk[j + 3] = t1.w;
    gw[j] = t2.x; gw[j + 1] = t2.y; gw[j + 2] = t2.z; gw[j + 3] = t2.w;
    gb[j] = t3.x; gb[j + 1] = t3.y; gb[j + 2] = t3.z; gb[j + 3] = t3.w;
  }
#pragma unroll 2
  for (int it = 0; it < 16; ++it) {
    const int tok = (tid >> 7) + it * 4;
    int row = row0 + tok;
    size_t off = (size_t)row * 1024 + c0;
    h16x8 of = *(const h16x8*)(O + off), ob = *(const h16x8*)(O + ARR + off);
    h16x8 r8 = *(const h16x8*)(SC + 0 * ARR + off), k8 = *(const h16x8*)(SC + 1 * ARR + off), v8 = *(const h16x8*)(SC + 2 * ARR + off);
    h16x8 af = *(const h16x8*)(SC + 4 * ARR + off), ab = *(const h16x8*)(SC + 5 * ARR + off);
    h16x8 gt = *(const h16x8*)(zrest + (size_t)row * ZR + 2048 + c0);
    float o[8], sm = 0;
#pragma unroll
    for (int j = 0; j < 8; ++j) { o[j] = (float)of[j] + (float)ob[j]; sm += o[j]; }
    sm = allreduce8(sm);
    float mu = sm * (1.f / 64.f), vq = 0;
#pragma unroll
    for (int j = 0; j < 8; ++j) { o[j] -= mu; vq += o[j] * o[j]; }
    vq = allreduce8(vq);
    float rstd = rsqrtf(vq * (1.f / 64.f) + 64e-5f);
    float part = 0;
#pragma unroll
    for (int j = 0; j < 8; ++j) {
      float ksum = (float)k8[j] * (2.f + ((float)af[j] + (float)ab[j] - 2.f) * pk[j]);
      part += (float)r8[j] * ksum * rk[j];
    }
    part = allreduce8(part);
    float res[8];
#pragma unroll
    for (int j = 0; j < 8; ++j) {
      float y = o[j] * rstd * gw[j] + gb[j] + part * (float)v8[j];
      res[j] = y * silu_f((float)gt[j]);
    }
    uint4 ov;
    ov.x = pack_bf2(res[0], res[1]); ov.y = pack_bf2(res[2], res[3]); ov.z = pack_bf2(res[4], res[5]); ov.w = pack_bf2(res[6], res[7]);
    *(uint4*)(ym + (size_t)row * D + 1024 + c0) = ov;
  }
}

DEV void phase_merge(const Params& p, const Ctx& cx0, int l, char* smem) {
  const int ntile = (l == 0) ? 520 : 512;
  const int npool = (l == 0) ? 2048 + 32 : 2048;
  const int total = npool + 2 * ntile;
  for (int item = cx0.bid; item < total; item += cx0.nblk) {
    __syncthreads();
    Ctx cx = cx0; asm volatile("" : "+v"(cx.tid));
    const int grp6 = item / 6, pos6 = item - grp6 * 6;
    if (pos6 < 4) pool_item(p, cx, l, grp6 * 4 + pos6, smem);
    else if (pos6 == 4) glu_item(p, cx, l, grp6, smem);
    else rwkvmerge_item(p, cx, l, grp6);
  }
}

#define LCX Ctx c2 = cx; asm volatile("" : "+v"(c2.tid))
#ifndef GEMM_FN
#define GEMM_FN gemm_phase2
#endif
__global__ void __launch_bounds__(NTHREADS) mega_fwd(Params p, int ph0, int ph1) {
  extern __shared__ __attribute__((aligned(16))) char smem[];
  cg::grid_group grid = cg::this_grid();
  const int wave_s = __builtin_amdgcn_readfirstlane((int)(threadIdx.x >> 6));
  for (int step = ph0; step < ph1; ++step) {
    if (step > ph0) grid.sync();
    const int ph = (int)((PH_SEQ >> (4 * step)) & 15ull);
    Ctx cx;
    {
      int t_, b_ = blockIdx.x, n_ = gridDim.x;
      asm volatile("v_mbcnt_lo_u32_b32 %0, -1, 0\n\tv_mbcnt_hi_u32_b32 %0, -1, %0\n\tv_lshl_add_u32 %0, %1, 6, %0" : "=&v"(t_) : "s"(wave_s));
      asm volatile("" : "+s"(b_), "+s"(n_));
      cx.tid = t_; cx.bid = b_; cx.nblk = n_;
    }
    const int l = ph >= 8 ? 1 : 0;
    const int lp = ph >= 8 ? ph - 6 : ph;
#ifndef PHMASK
#define PHMASK 0xff
#endif
    if (ph == 0) { if (PHMASK & 1) { LCX; phase0(p, c2, smem); } }
    else if (ph == 1) { if (PHMASK & 2) { LCX; phase_adaln0(p, c2); } }
    else if (lp == 2 && (PHMASK & 4)) {
      LCX;
      h16* zrest = (h16*)(p.ws + OFF_ZREST);
      h16* zc = (h16*)(p.ws + OFF_REG2);
      GEMM_FN(p, c2, (const bf16_t*)(p.ws + OFF_H), (const bf16_t*)(p.ws + OFF_WT + (size_t)l * WT_SIZE + WT_IN), 2048, 130, 25, smem,
                 [&](int row, int col, f32x4 v, f32x4 u) {
                   h16* dst;
                   if (col < 2048) dst = zrest + (size_t)row * ZR + col;
                   else if (col < 5120) dst = zc + (size_t)row * ZC + (col - 2048);
                   else if (col < 6144) dst = zrest + (size_t)row * ZR + 2048 + (col - 5120);
                   else dst = zc + (size_t)row * ZC + 3072 + (col - 6144);
                   h16x8 o = {(h16)v[0], (h16)v[1], (h16)v[2], (h16)v[3], (h16)u[0], (h16)u[1], (h16)u[2], (h16)u[3]};
                   *(h16x8*)dst = o;
                 });
    } else if (lp == 3) { if (PHMASK & 8) { LCX; phase_prep(p, c2, l, smem); } }
    else if (lp == 4) { if (PHMASK & 16) { LCX; phase_scan(p, c2, l, smem); } }
    else if (lp == 5) { if (PHMASK & 32) { LCX; phase_merge(p, c2, l, smem); } }
    else if (lp == 6 && (PHMASK & 64)) {
      LCX;
      const float* mods = (const float*)(p.ws + OFF_MODS);
      float* prec = (float*)(p.ws + OFF_PREC);
      const float* xin = (l == 0) ? p.x : p.out;
      GEMM_FN(p, c2, (const bf16_t*)(p.ws + OFF_YM), (const bf16_t*)(p.ws + OFF_WT + (size_t)l * WT_SIZE + WT_OUT), 2048, l == 0 ? 130 : 128, 8, smem,
                 [&](int row, int col, f32x4 v, f32x4 u) {
                   const float* xr; const float* gr; float* dr;
                   if (row < NLAT) {
                     xr = xin + (size_t)row * D + col; gr = mods + (size_t)(l * 3 + (row >> 14)) * 6144 + 4096 + col; dr = p.out + (size_t)row * D + col;
                   } else {
                     xr = p.ctx + (size_t)(row - NLAT) * D + col; gr = mods + (size_t)(l * 3 + 2) * 6144 + 4096 + col; dr = prec + (size_t)(row - NLAT) * D + col;
                   }
                   const float4 x0 = *(const float4*)xr, x1 = *(const float4*)(xr + 4), g0 = *(const float4*)gr, g1 = *(const float4*)(gr + 4);
                   float4 r0, r1;
                   r0.x = ALPHA * x0.x + g0.x * v[0]; r0.y = ALPHA * x0.y + g0.y * v[1]; r0.z = ALPHA * x0.z + g0.z * v[2]; r0.w = ALPHA * x0.w + g0.w * v[3];
                   r1.x = ALPHA * x1.x + g1.x * u[0]; r1.y = ALPHA * x1.y + g1.y * u[1]; r1.z = ALPHA * x1.z + g1.z * u[2]; r1.w = ALPHA * x1.w + g1.w * u[3];
                   *(float4*)dr = r0; *(float4*)(dr + 4) = r1;
                 });
    } else if (lp == 7) { if (PHMASK & 128) { LCX; phase_finln(p, c2, l); } }
  }
}

constexpr int NPHASES = PH_NSTEPS;

extern "C" void kernel_launch(void* const* d_in, const int* in_sizes, int n_in, void* d_out, int out_size, void* d_ws, size_t ws_size,
                              hipStream_t stream) {
  static int grid_blocks = 0;
  if (grid_blocks == 0) {
    if (n_in != 32 || ws_size < WS_END) { fprintf(stderr, "kernel_launch: unexpected n_in %d / ws %zu (need %zu)\n", n_in, ws_size, (size_t)WS_END); grid_blocks = -1; return; }
    int dev = 0, cus = 0, per_cu = 0;
    hipGetDevice(&dev);
    hipDeviceGetAttribute(&cus, hipDeviceAttributeMultiprocessorCount, dev);
    if (hipFuncSetAttribute((const void*)mega_fwd, hipFuncAttributeMaxDynamicSharedMemorySize, LDS_BYTES) != hipSuccess) { fprintf(stderr, "hipFuncSetAttribute failed\n"); grid_blocks = -1; return; }
    if (hipOccupancyMaxActiveBlocksPerMultiprocessor(&per_cu, (const void*)mega_fwd, NTHREADS, LDS_BYTES) != hipSuccess || per_cu < 1) {
      fprintf(stderr, "occupancy query gave %d\n", per_cu); (void)hipGetLastError(); per_cu = 1;
    }
    grid_blocks = cus * per_cu;
  }
  if (grid_blocks < 0) return;
  Params p{};
  const float** pp = (const float**)&p;
  for (int i = 0; i < 32; ++i) pp[i] = (const float*)d_in[i];
  p.out = (float*)d_out;
  p.ws = (char*)d_ws;
  int ph0 = 0, ph1 = NPHASES;
  void* args[] = {&p, &ph0, &ph1};
  hipError_t e = hipLaunchCooperativeKernel((const void*)mega_fwd, dim3(grid_blocks), dim3(NTHREADS), args, LDS_BYTES, stream);
  if (e != hipSuccess) fprintf(stderr, "cooperative launch failed: %s (grid %d)\n", hipGetErrorString(e), grid_blocks);
}
```

```cpp
#include <hip/hip_runtime.h>
#include <hip/hip_cooperative_groups.h>
#include <cstdio>
namespace cg = cooperative_groups;

typedef unsigned short bf16_t;
typedef _Float16 h16;
using bf16x8 = __attribute__((ext_vector_type(8))) _Float16;
using f32x4 = __attribute__((ext_vector_type(4))) float;
using h16x4 = __attribute__((ext_vector_type(4))) _Float16;
using h16x8 = __attribute__((ext_vector_type(8))) _Float16;

#define DEV __device__ __forceinline__

constexpr int D = 2048, NLAT = 32768, MTOT = 33280, ZR = 3072, ZC = 3328;
constexpr int NTHREADS = 512;
constexpr int LDS_BYTES = 147456;
constexpr float ALPHA = 1.41421356237f;
constexpr float DECAY_SCALE = 0.606531f;

constexpr size_t al256(size_t x) { return (x + 255) & ~size_t(255); }
constexpr size_t ARR = (size_t)MTOT * 1024;
constexpr size_t OFF_MODS = 0;
constexpr size_t OFF_S5F = al256(OFF_MODS + 2 * 3 * 6144 * 4);
constexpr size_t OFF_PREC = al256(OFF_S5F + (size_t)2 * 32 * 65 * 2 * 64 * 8);
constexpr size_t OFF_WT = al256(OFF_PREC + (size_t)512 * 2048 * 4);
constexpr size_t WT_IN = 0, WT_OUT = 26214400, WT_W2 = 34603008, WT_A2 = 34865152, WT_POOL = 35127296, WT_GLU = 35258368, WT_SIZE = 35782656;
constexpr size_t OFF_ZREST = al256(OFF_WT + 2 * WT_SIZE);
constexpr size_t OFF_REG2 = al256(OFF_ZREST + (size_t)MTOT * ZR * 2);
constexpr size_t OFF_S5Y = OFF_REG2 + 2 * ARR * 2;
constexpr size_t OFF_SCAN = al256(OFF_REG2 + (size_t)MTOT * ZC * 2);
constexpr size_t OFF_H = OFF_SCAN;
constexpr size_t OFF_YM = OFF_SCAN + 6 * ARR * 2;
constexpr size_t OFF_BAR = al256(OFF_SCAN + 8 * ARR * 2);
constexpr size_t WS_END = OFF_BAR + 16384;

#ifndef PH_SEQ
#define PH_SEQ 0xDCBA9876543210ull
#define PH_NSTEPS 14
#endif
struct Params {
  const float *x, *c, *ctx, *c_ctx, *w_ada, *b_ada, *w_in, *conv_rkv, *s5_lam_re, *s5_lam_im, *s5_log_step,
      *s5_b_re, *s5_b_im, *s5_c_re, *s5_c_im, *s5_d, *w_glu, *b_glu, *w_pool, *pool_scale,
      *rwkv_w0, *rwkv_w2, *rwkv_a0, *rwkv_a2, *rwkv_k_k, *rwkv_k_a, *rwkv_r_k, *gn_w, *gn_b,
      *w_out, *ln_g, *ln_b;
  float* out;
  char* ws;
};
struct Ctx { int tid, bid, nblk; };

DEV float rcp_f(float x) { return __builtin_amdgcn_rcpf(x); }
DEV float sigmoid_f(float x) { return rcp_f(1.f + __expf(-x)); }
DEV float silu_f(float x) { return x * rcp_f(1.f + __expf(-x)); }
DEV float tanh_f(float x) { float e = __expf(2.f * x); return 1.f - 2.f * rcp_f(e + 1.f); }
DEV float gelu_f(float y) { return 0.5f * y * (1.f + tanh_f(0.7978845608f * (y + 0.044715f * y * y * y))); }
using h16x2 = __attribute__((ext_vector_type(2))) _Float16;
DEV unsigned pack_bf2(float a, float b) { h16x2 v = {(h16)a, (h16)b}; return __builtin_bit_cast(unsigned, v); }
template <int CTRL> DEV float dpp_mov(float v) {
  return __int_as_float(__builtin_amdgcn_update_dpp(0, __float_as_int(v), CTRL, 0xf, 0xf, true));
}
DEV float allreduce16(float v) {
  v += dpp_mov<0xB1>(v);
  v += dpp_mov<0x4E>(v);
  v += dpp_mov<0x141>(v);
  v += dpp_mov<0x140>(v);
  return v;
}
DEV float wave_sum(float v) {
  v = allreduce16(v);
  return __builtin_amdgcn_readlane(__float_as_int(v), 0) == 0 && false ? 0.f :
         __int_as_float(__builtin_amdgcn_readlane(__float_as_int(v), 0)) + __int_as_float(__builtin_amdgcn_readlane(__float_as_int(v), 16)) +
         __int_as_float(__builtin_amdgcn_readlane(__float_as_int(v), 32)) + __int_as_float(__builtin_amdgcn_readlane(__float_as_int(v), 48));
}
DEV float allreduce8(float v) {
  v += dpp_mov<0xB1>(v);
  v += dpp_mov<0x4E>(v);
  v += dpp_mov<0x141>(v);
  return v;
}
DEV void lds_fence() { asm volatile("s_waitcnt lgkmcnt(0)" ::: "memory"); }

DEV void p0_mods_item(const Params& p, const Ctx& cx, int item, char* smem) {
  float* red = (float*)smem;
  float* mods = (float*)(p.ws + OFF_MODS);
  int l = item / 96, chunk = item % 96;
  int tid = cx.tid, kq = tid >> 6, col = tid & 63;
  int n = chunk * 64 + col;
  const float* W = p.w_ada + (size_t)l * 2048 * 6144;
  float a0 = 0, a1 = 0, a2 = 0;
#pragma unroll 8
  for (int k = kq; k < 2048; k += 8) {
    float w = W[(size_t)k * 6144 + n];
    a0 += silu_f(p.c[k]) * w;
    a1 += silu_f(p.c[2048 + k]) * w;
    a2 += silu_f(p.c_ctx[k]) * w;
  }
  red[(kq * 3 + 0) * 64 + col] = a0;
  red[(kq * 3 + 1) * 64 + col] = a1;
  red[(kq * 3 + 2) * 64 + col] = a2;
  __syncthreads();
  if (tid < 192) {
    int r = tid >> 6, cc = tid & 63;
    float s = 0;
#pragma unroll
    for (int q = 0; q < 8; ++q) s += red[(q * 3 + r) * 64 + cc];
    mods[(size_t)(l * 3 + r) * 6144 + chunk * 64 + cc] = s + p.b_ada[(size_t)l * 6144 + chunk * 64 + cc];
  }
}

DEV void p0_transpose_tile(const Params& p, const Ctx& cx, const float* __restrict__ src, bf16_t* __restrict__ dst, int K, int N, int tk, int tn, char* smem) {
  float* T = (float*)smem;
  int tid = cx.tid;
  int k0 = tk * 64, n0 = tn * 64;
  int kk = tid >> 4, n4 = tid & 15;
#pragma unroll
  for (int i = 0; i < 2; ++i) {
    int k = kk + 32 * i;
    float4 v = *(const float4*)(src + (size_t)(k0 + k) * N + n0 + n4 * 4);
    T[k * 65 + n4 * 4 + 0] = v.x; T[k * 65 + n4 * 4 + 1] = v.y; T[k * 65 + n4 * 4 + 2] = v.z; T[k * 65 + n4 * 4 + 3] = v.w;
  }
  __syncthreads();
  int n = tid >> 3, k8 = tid & 7;
  uint4 o;
  o.x = pack_bf2(T[(k8 * 8 + 0) * 65 + n], T[(k8 * 8 + 1) * 65 + n]);
  o.y = pack_bf2(T[(k8 * 8 + 2) * 65 + n], T[(k8 * 8 + 3) * 65 + n]);
  o.z = pack_bf2(T[(k8 * 8 + 4) * 65 + n], T[(k8 * 8 + 5) * 65 + n]);
  o.w = pack_bf2(T[(k8 * 8 + 6) * 65 + n], T[(k8 * 8 + 7) * 65 + n]);
  *(uint4*)(dst + (size_t)(n0 + n) * K + k0 + k8 * 8) = o;
}

DEV void phase0(const Params& p, const Ctx& cx0, char* smem) {
  const int NTR = 4368;
  const int total = 192 + 2 * NTR;
  for (int item = cx0.bid; item < total; item += cx0.nblk) {
    __syncthreads();
    Ctx cx = cx0; asm volatile("" : "+v"(cx.tid));
    if (item < 192) { p0_mods_item(p, cx, item, smem); continue; }
    int it = item - 192;
    int l = it / NTR, i = it % NTR;
    char* wt = p.ws + OFF_WT + (size_t)l * WT_SIZE;
    if (i < 3200) {
      p0_transpose_tile(p, cx, p.w_in + (size_t)l * 2048 * 6400, (bf16_t*)(wt + WT_IN), 2048, 6400, i / 100, i % 100, smem);
    } else if (i < 4224) {
      int j = i - 3200;
      p0_transpose_tile(p, cx, p.w_out + (size_t)l * 2048 * 2048, (bf16_t*)(wt + WT_OUT), 2048, 2048, j / 32, j % 32, smem);
    } else if (i < 4256) {
      int j = i - 4224, d = j / 16;
      p0_transpose_tile(p, cx, p.rwkv_w2 + (size_t)(l * 2 + d) * 64 * 1024, (bf16_t*)(wt + WT_W2) + (size_t)d * 1024 * 64, 64, 1024, 0, j % 16, smem);
    } else if (i < 4288) {
      int j = i - 4256, d = j / 16;
      p0_transpose_tile(p, cx, p.rwkv_a2 + (size_t)(l * 2 + d) * 64 * 1024, (bf16_t*)(wt + WT_A2) + (size_t)d * 1024 * 64, 64, 1024, 0, j % 16, smem);
    } else if (i < 4304) {
      int j = i - 4288, g = j / 4;
      p0_transpose_tile(p, cx, p.w_pool + (size_t)(l * 4 + g) * 128 * 128, (bf16_t*)(wt + WT_POOL) + (size_t)g * 128 * 128, 128, 128, (j % 4) / 2, j % 2, smem);
    } else {
      int j = i - 4304;
      p0_transpose_tile(p, cx, p.w_glu + (size_t)l * 512 * 512, (bf16_t*)(wt + WT_GLU), 512, 512, j / 8, j % 8, smem);
    }
  }
}

DEV void phase_adaln0(const Params& p, const Ctx& cx) {
  const float* mods = (const float*)(p.ws + OFF_MODS);
  bf16_t* hbuf = (bf16_t*)(p.ws + OFF_H);
  int lane = cx.tid & 63;
  int gw = cx.bid * 8 + (cx.tid >> 6), nw = cx.nblk * 8;
  for (int row = gw; row < MTOT; row += nw) {
    const float* src = row < NLAT ? p.x + (size_t)row * D : p.ctx + (size_t)(row - NLAT) * D;
    int mr = row < NLAT ? (row >> 14) : 2;
    const float* md = mods + (size_t)mr * 6144;
    float4 v[8];
    float s = 0;
#pragma unroll
    for (int i = 0; i < 8; ++i) { v[i] = *(const float4*)(src + i * 256 + lane * 4); s += v[i].x + v[i].y + v[i].z + v[i].w; }
    float mu = wave_sum(s) * (1.f / 2048.f);
    float q = 0;
#pragma unroll
    for (int i = 0; i < 8; ++i) { v[i].x -= mu; v[i].y -= mu; v[i].z -= mu; v[i].w -= mu; q += v[i].x * v[i].x + v[i].y * v[i].y + v[i].z * v[i].z + v[i].w * v[i].w; }
    float rstd = rsqrtf(wave_sum(q) * (1.f / 2048.f) + 1e-6f);
#pragma unroll
    for (int i = 0; i < 8; ++i) {
      int col = i * 256 + lane * 4;
      float4 sh = *(const float4*)(md + col), sc = *(const float4*)(md + 2048 + col);
      uint2 o;
      o.x = pack_bf2(v[i].x * rstd * (1.f + sc.x) + sh.x, v[i].y * rstd * (1.f + sc.y) + sh.y);
      o.y = pack_bf2(v[i].z * rstd * (1.f + sc.z) + sh.z, v[i].w * rstd * (1.f + sc.w) + sh.w);
      *(uint2*)(hbuf + (size_t)row * D + col) = o;
    }
  }
}

DEV void phase_finln(const Params& p, const Ctx& cx, int l) {
  const float* mods = (const float*)(p.ws + OFF_MODS);
  bf16_t* hbuf = (bf16_t*)(p.ws + OFF_H);
  float* prec = (float*)(p.ws + OFF_PREC);
  int lane = cx.tid & 63;
  int gw = cx.bid * 8 + (cx.tid >> 6), nw = cx.nblk * 8;
  const int nrows = (l == 0) ? MTOT : NLAT;
  for (int row = gw; row < nrows; row += nw) {
    float* src = row < NLAT ? p.out + (size_t)row * D : prec + (size_t)(row - NLAT) * D;
    float4 v[8];
    float s = 0;
#pragma unroll
    for (int i = 0; i < 8; ++i) { v[i] = *(const float4*)(src + i * 256 + lane * 4); s += v[i].x + v[i].y + v[i].z + v[i].w; }
    float mu = wave_sum(s) * (1.f / 2048.f);
    float q = 0;
#pragma unroll
    for (int i = 0; i < 8; ++i) { v[i].x -= mu; v[i].y -= mu; v[i].z -= mu; v[i].w -= mu; q += v[i].x * v[i].x + v[i].y * v[i].y + v[i].z * v[i].z + v[i].w * v[i].w; }
    float rstd = rsqrtf(wave_sum(q) * (1.f / 2048.f) + 1e-5f);
    float s2 = 0;
#pragma unroll
    for (int i = 0; i < 8; ++i) {
      int col = i * 256 + lane * 4;
      float4 g = *(const float4*)(p.ln_g + (size_t)l * D + col), b = *(const float4*)(p.ln_b + (size_t)l * D + col);
      v[i].x = v[i].x * rstd * g.x + b.x; v[i].y = v[i].y * rstd * g.y + b.y; v[i].z = v[i].z * rstd * g.z + b.z; v[i].w = v[i].w * rstd * g.w + b.w;
      if (row < NLAT) *(float4*)(src + col) = v[i];
      s2 += v[i].x + v[i].y + v[i].z + v[i].w;
    }
    if (l == 0) {
      int mr = row < NLAT ? (row >> 14) : 2;
      const float* md = mods + (size_t)(3 + mr) * 6144;
      float mu2 = wave_sum(s2) * (1.f / 2048.f);
      float q2 = 0;
#pragma unroll
      for (int i = 0; i < 8; ++i) { v[i].x -= mu2; v[i].y -= mu2; v[i].z -= mu2; v[i].w -= mu2; q2 += v[i].x * v[i].x + v[i].y * v[i].y + v[i].z * v[i].z + v[i].w * v[i].w; }
      float rstd2 = rsqrtf(wave_sum(q2) * (1.f / 2048.f) + 1e-6f);
#pragma unroll
      for (int i = 0; i < 8; ++i) {
        int col = i * 256 + lane * 4;
        float4 sh = *(const float4*)(md + col), sc = *(const float4*)(md + 2048 + col);
        uint2 o;
        o.x = pack_bf2(v[i].x * rstd2 * (1.f + sc.x) + sh.x, v[i].y * rstd2 * (1.f + sc.y) + sh.y);
        o.y = pack_bf2(v[i].z * rstd2 * (1.f + sc.z) + sh.z, v[i].w * rstd2 * (1.f + sc.w) + sh.w);
        *(uint2*)(hbuf + (size_t)row * D + col) = o;
      }
    }
  }
}

template <class Epi>
DEV void gemm_phase(const Params& p, const Ctx& cx, const bf16_t* __restrict__ A, const bf16_t* __restrict__ Bt, int K, int nM, int nN, char* smem, Epi epi) {
  const int tid = cx.tid, lane = tid & 63, wid = tid >> 6;
  const int wr = wid >> 2, wc = wid & 3, fr = lane & 15, fq = lane >> 4;
  const int nt = K / 64;
  const int ntiles = nM * nN;
  const int srow = tid >> 3, sc16 = tid & 7;
  const int nxcd = (cx.nblk & 7) == 0 ? 8 : 1;
  const int xcd = cx.bid % nxcd, xidx = cx.bid / nxcd, xper = cx.nblk / nxcd;
  const int t_lo = (int)(((long)ntiles * xcd) / nxcd), t_hi = (int)(((long)ntiles * (xcd + 1)) / nxcd);
  for (int tt = t_lo + xidx; tt < t_hi; tt += xper) {
    const int band = tt / (16 * nN);
    const int brows = min(16, nM - band * 16);
    const int rem = tt - band * 16 * nN;
    const int pn = rem / brows, pm = band * 16 + rem % brows;
    const int brow = pm * 256, bcol = pn * 256;
    const char* Ab = (const char*)(A + (size_t)brow * K);
    const char* Bb = (const char*)(Bt + (size_t)bcol * K);
    const unsigned voff = (unsigned)(srow * K + sc16 * 8) * 2u;
    const size_t rs = (size_t)64 * K * 2;
    f32x4 acc[8][4];
#pragma unroll
    for (int i = 0; i < 8; ++i)
#pragma unroll
      for (int j = 0; j < 4; ++j) acc[i][j] = f32x4{0.f, 0.f, 0.f, 0.f};
    uint4 ra0, ra1, ra2, ra3, rb0, rb1, rb2, rb3;
#define G_LD(ko) { const char* a_ = Ab + (size_t)(ko) * 2; const char* b_ = Bb + (size_t)(ko) * 2; \
                 ra0 = *(const uint4*)(a_ + voff); ra1 = *(const uint4*)(a_ + rs + voff); ra2 = *(const uint4*)(a_ + 2 * rs + voff); ra3 = *(const uint4*)(a_ + 3 * rs + voff); \
                 rb0 = *(const uint4*)(b_ + voff); rb1 = *(const uint4*)(b_ + rs + voff); rb2 = *(const uint4*)(b_ + 2 * rs + voff); rb3 = *(const uint4*)(b_ + 3 * rs + voff); }
#define G_ST(sp) { *(uint4*)(sp) = ra0; *(uint4*)((sp) + 64 * 144) = ra1; *(uint4*)((sp) + 128 * 144) = ra2; *(uint4*)((sp) + 192 * 144) = ra3; \
                 *(uint4*)((sp) + 36864) = rb0; *(uint4*)((sp) + 36864 + 64 * 144) = rb1; *(uint4*)((sp) + 36864 + 128 * 144) = rb2; *(uint4*)((sp) + 36864 + 192 * 144) = rb3; }
    char* const sbase = smem + srow * 144 + sc16 * 16;
    G_LD(0);
    G_ST(sbase);
    if (nt > 1) G_LD(64);
    for (int kt = 0; kt < nt; ++kt) {
      __syncthreads();
      if (kt + 1 < nt) { char* s1 = sbase + ((kt + 1) & 1) * 73728; G_ST(s1); }
      if (kt + 2 < nt) G_LD((kt + 2) * 64);
      const char* As = smem + (kt & 1) * 73728;
      const char* Bs = As + 36864;
#pragma unroll
      for (int kh = 0; kh < 2; ++kh) {
        bf16x8 bfr[4];
#pragma unroll
        for (int jn = 0; jn < 4; ++jn) bfr[jn] = *(const bf16x8*)(Bs + (wc * 64 + jn * 16 + fr) * 144 + kh * 64 + fq * 16);
#pragma unroll
        for (int i = 0; i < 8; ++i) {
          bf16x8 af = *(const bf16x8*)(As + (wr * 128 + i * 16 + fr) * 144 + kh * 64 + fq * 16);
#pragma unroll
          for (int jn = 0; jn < 4; ++jn) acc[i][jn] = __builtin_amdgcn_mfma_f32_16x16x32_f16(bfr[jn], af, acc[i][jn], 0, 0, 0);
        }
      }
    }
    __syncthreads();
#pragma unroll
    for (int i = 0; i < 8; ++i)
#pragma unroll
      for (int jn = 0; jn < 4; ++jn) epi(brow + wr * 128 + i * 16 + fr, bcol + wc * 64 + jn * 16 + fq * 4, acc[i][jn]);
  }
}

#define LAS3 __attribute__((address_space(3)))
DEV int g2_lds_byte(int r, int c) { const int st = (r >> 4) * 2 + (c >> 5), rr = r & 15, cc = c & 31, ob = rr * 64 + cc * 2; return st * 1024 + (ob ^ (((ob >> 9) & 1) << 5)); }
DEV void g2_stage_rc(int b, int& R, int& C) { const int st = b / 1024, sb = b % 1024, swz = sb ^ (((sb >> 9) & 1) << 5); R = (st >> 1) * 16 + swz / 64; C = (st & 1) * 32 + (swz % 64) / 2; }

template <class Epi>
DEV void gemm_phase2(const Params& p, const Ctx& cx, const bf16_t* __restrict__ A, const bf16_t* __restrict__ Bt, int K, int nM, int nN, char* smem, Epi epi) {
  constexpr int HTB = 128 * 64 * 2;
  LAS3 unsigned char* lds = (LAS3 unsigned char*)smem;
  const int tid = cx.tid, wid = __builtin_amdgcn_readfirstlane(tid >> 6), lane = tid & 63, wr = wid >> 2, wc = wid & 3, fr = lane & 15, fq = lane >> 4;
  const int nt = K / 64;
  const int ntiles = nM * nN;
  const int nxcd = (cx.nblk & 7) == 0 ? 8 : 1;
  const int xcd = cx.bid % nxcd, xidx = cx.bid / nxcd, xper = cx.nblk / nxcd;
  const int t_lo = (int)(((long)ntiles * xcd) / nxcd), t_hi = (int)(((long)ntiles * (xcd + 1)) / nxcd);
  auto unit_at = [&](int i, int& pm, int& pn) -> bool {
    const int tt = t_lo + xidx + i * xper;
    if (tt >= t_hi) return false;
    const int band = tt / (8 * nN);
    const int brows = min(8, nM - band * 8);
    const int rem = tt - band * 8 * nN;
    pn = rem / brows; pm = band * 8 + rem % brows;
    return true;
  };
  unsigned voffA[2], voffB[2];
#pragma unroll
  for (int i = 0; i < 2; ++i) {
    int R, C; g2_stage_rc(tid * 16 + i * 8192, R, C);
    const int rho = R & 31, Rb = (R & ~31) + 8 * ((rho & 15) >> 2) + 4 * (rho >> 4) + (rho & 3);
    voffA[i] = (unsigned)(R * K + C) * 2u; voffB[i] = (unsigned)(Rb * K + C) * 2u;
  }
  const size_t kstep = (size_t)(64 * 2);
  const size_t hstep = (size_t)128 * K * 2;
  const size_t tstep = 2 * hstep;
  const unsigned ldsw = (unsigned)wid * 1024u;
  const int aoff = g2_lds_byte(wr * 64 + fr, fq * 8), boff = g2_lds_byte(wc * 32 + fr, fq * 8);
#define G2_SA(b, h) (((b) * 2 + (h)) * HTB)
#define G2_SB(b, h) ((4 + (b) * 2 + (h)) * HTB)
#define G2_STAGE_(bufoff, gbase, vo_) do { _Pragma("unroll") for (int _i = 0; _i < 2; ++_i) \
    __builtin_amdgcn_global_load_lds((const unsigned*)((const char*)(gbase) + vo_[_i]), (LAS3 unsigned*)(lds + (bufoff) + ldsw + _i * 8192), 16, 0, 0); } while (0)
#define G2_STAGE(bufoff, gbase) G2_STAGE_(bufoff, gbase, voffA)
#define G2_STAGEB(bufoff, gbase) G2_STAGE_(bufoff, gbase, voffB)
#define G2_LDA(dst, b, h) do { _Pragma("unroll") for (int m = 0; m < 4; ++m) _Pragma("unroll") for (int k = 0; k < 2; ++k) dst[m][k] = *(const LAS3 bf16x8*)(lds + G2_SA(b, h) + aoff + m * 2048 + k * 1024); } while (0)
#define G2_LDB(dst, b, h) do { _Pragma("unroll") for (int n = 0; n < 2; ++n) _Pragma("unroll") for (int k = 0; k < 2; ++k) dst[n][k] = *(const LAS3 bf16x8*)(lds + G2_SB(b, h) + boff + n * 2048 + k * 1024); } while (0)
#define G2_MMA(ai, bj, At_, Bt_) do { __builtin_amdgcn_s_setprio(1); _Pragma("unroll") for (int m = 0; m < 4; ++m) _Pragma("unroll") for (int n = 0; n < 2; ++n) _Pragma("unroll") for (int k = 0; k < 2; ++k) \
    acc[ai][bj][m][n] = __builtin_amdgcn_mfma_f32_16x16x32_f16(Bt_[n][k], At_[m][k], acc[ai][bj][m][n], 0, 0, 0); __builtin_amdgcn_s_setprio(0); } while (0)
#define G2_WAIT_V(n) asm volatile("s_waitcnt vmcnt(" #n ")" ::: "memory")
#define G2_WAIT_L(n) asm volatile("s_waitcnt lgkmcnt(" #n ")" ::: "memory")
#define G2_BAR __builtin_amdgcn_s_barrier()
#define G2_SCHED __builtin_amdgcn_sched_barrier(0)
  int cpm, cpn, npm = 0, npn = 0, ui = 0;
  if (!unit_at(0, cpm, cpn)) return;
  f32x4 acc[2][2][4][2];
#pragma unroll
  for (int a = 0; a < 2; ++a)
#pragma unroll
    for (int b = 0; b < 2; ++b)
#pragma unroll
      for (int m = 0; m < 4; ++m)
#pragma unroll
        for (int n = 0; n < 2; ++n) acc[a][b][m][n] = f32x4{0.f, 0.f, 0.f, 0.f};
  bf16x8 At[4][2], B0[2][2], B1[2][2];
  const char* cA = (const char*)A + (size_t)cpm * tstep;
  const char* cB = (const char*)Bt + (size_t)cpn * tstep;
  G2_STAGEB(G2_SB(0, 0), cB); G2_STAGE(G2_SA(0, 0), cA); G2_STAGEB(G2_SB(0, 1), cB + hstep); G2_STAGE(G2_SA(0, 1), cA + hstep);
  if (wr == 1) G2_BAR;
  G2_WAIT_V(4); G2_BAR;
  G2_STAGEB(G2_SB(1, 0), cB + kstep); G2_STAGE(G2_SA(1, 0), cA + kstep); G2_STAGEB(G2_SB(1, 1), cB + hstep + kstep);
  G2_WAIT_V(6); G2_BAR;
  for (;;) {
    const bool has_next = unit_at(ui + 1, npm, npn);
    const char* nA = has_next ? (const char*)A + (size_t)npm * tstep : cA;
    const char* nB = has_next ? (const char*)Bt + (size_t)npn * tstep : cB;
    for (int t = 0; t < nt; t += 2) {
      const bool last = (t == nt - 2);
      const char* a1 = cA + (size_t)(t + 1) * kstep;
      const char* a2 = last ? nA : cA + (size_t)(t + 2) * kstep;
      const char* b2 = last ? nB : cB + (size_t)(t + 2) * kstep;
      const char* a3 = a2 + kstep;
      const char* b3 = b2 + kstep;
      G2_LDB(B0, 0, 0); G2_SCHED; G2_LDA(At, 0, 0); G2_STAGE(G2_SA(1, 1), a1 + hstep);
      G2_WAIT_L(8); G2_BAR; G2_WAIT_L(0); G2_MMA(0, 0, At, B0); G2_BAR; G2_SCHED;
      G2_LDB(B1, 0, 1); G2_STAGEB(G2_SB(0, 0), b2);
      G2_BAR; G2_WAIT_L(0); G2_MMA(0, 1, At, B1); G2_BAR;
      G2_LDA(At, 0, 1); G2_STAGE(G2_SA(0, 0), a2);
      G2_BAR; G2_WAIT_L(0); G2_MMA(1, 0, At, B0); G2_BAR; G2_SCHED;
      G2_STAGEB(G2_SB(0, 1), b2 + hstep);
      G2_WAIT_V(6); G2_BAR; G2_MMA(1, 1, At, B1); G2_BAR;
      G2_LDB(B0, 1, 0); G2_SCHED; G2_LDA(At, 1, 0); G2_STAGE(G2_SA(0, 1), a2 + hstep);
      G2_WAIT_L(8); G2_BAR; G2_WAIT_L(0); G2_MMA(0, 0, At, B0); G2_BAR; G2_SCHED;
      G2_LDB(B1, 1, 1); G2_STAGEB(G2_SB(1, 0), b3);
      G2_BAR; G2_WAIT_L(0); G2_MMA(0, 1, At, B1); G2_BAR;
      G2_LDA(At, 1, 1); G2_STAGE(G2_SA(1, 0), a3);
      G2_BAR; G2_WAIT_L(0); G2_MMA(1, 0, At, B0); G2_BAR; G2_SCHED;
      G2_STAGEB(G2_SB(1, 1), b3 + hstep);
      G2_WAIT_V(6); G2_BAR; G2_MMA(1, 1, At, B1); G2_BAR;
    }
    {
      const int row0 = cpm * 256 + wr * 64 + fr, col0 = cpn * 256 + wc * 32 + 8 * fq;
#pragma unroll
      for (int ai = 0; ai < 2; ++ai)
#pragma unroll
        for (int m = 0; m < 4; ++m)
#pragma unroll
          for (int bj = 0; bj < 2; ++bj) epi(row0 + ai * 128 + m * 16, col0 + bj * 128, acc[ai][bj][m][0], acc[ai][bj][m][1]);
    }
    if (!has_next) break;
#pragma unroll
    for (int a = 0; a < 2; ++a)
#pragma unroll
      for (int b = 0; b < 2; ++b)
#pragma unroll
        for (int m = 0; m < 4; ++m)
#pragma unroll
          for (int n = 0; n < 2; ++n) acc[a][b][m][n] = f32x4{0.f, 0.f, 0.f, 0.f};
    cpm = npm; cpn = npn; cA = nA; cB = nB; ++ui;
  }
  G2_WAIT_V(0);
  if (wr == 0) G2_BAR;
  G2_BAR;
#undef G2_SA
#undef G2_SB
#undef G2_STAGE
#undef G2_STAGEB
#undef G2_STAGE_
#undef G2_LDA
#undef G2_LDB
#undef G2_MMA
#undef G2_WAIT_V
#undef G2_WAIT_L
#undef G2_BAR
#undef G2_SCHED
}

template <int K, int NT, class Epi>
DEV void small_gemm(const Params& p, const Ctx& cx, const char* As, int astride, const bf16_t* __restrict__ Bt, int n0, Epi epi) {
  const int lane = cx.tid & 63, fr = lane & 15, fq = lane >> 4;
  f32x4 acc[4][NT];
#pragma unroll
  for (int i = 0; i < 4; ++i)
#pragma unroll
    for (int j = 0; j < NT; ++j) acc[i][j] = f32x4{0.f, 0.f, 0.f, 0.f};
#pragma unroll 2
  for (int k0 = 0; k0 < K; k0 += 32) {
    bf16x8 af[4];
#pragma unroll
    for (int i = 0; i < 4; ++i) af[i] = *(const bf16x8*)(As + (i * 16 + fr) * astride + (k0 + fq * 8) * 2);
#pragma unroll
    for (int jn = 0; jn < NT; ++jn) {
      bf16x8 bf = *(const bf16x8*)(Bt + (size_t)(n0 + jn * 16 + fr) * K + k0 + fq * 8);
#pragma unroll
      for (int i = 0; i < 4; ++i) acc[i][jn] = __builtin_amdgcn_mfma_f32_16x16x32_f16(bf, af[i], acc[i][jn], 0, 0, 0);
    }
  }
#pragma unroll
  for (int i = 0; i < 4; ++i)
#pragma unroll
    for (int jn = 0; jn < NT; ++jn) epi(i * 16 + fr, n0 + jn * 16 + fq * 4, acc[i][jn]);
}

struct S5P { float ar, ai, br, bi; };
DEV S5P s5_params(const Params& p, const Ctx& cx, int l, int d, int g, int lane) {
  int idx = ((l * 2 + d) * 32 + g) * 64 + lane;
  float lr = fminf(p.s5_lam_re[idx], -1e-4f), li = p.s5_lam_im[idx];
  float step = expf(p.s5_log_step[(l * 2 + d) * 32 + g]);
  float xr = lr * step, xi = li * step;
  float e = expf(xr), cs = cosf(xi), sn = sinf(xi);
  S5P r;
  r.ar = e * cs; r.ai = e * sn;
  float sh = sinf(0.5f * xi);
  float nr = expm1f(xr) * cs - 2.f * sh * sh, ni = e * sn;
  float inv = 1.f / (lr * lr + li * li);
  r.br = (nr * lr + ni * li) * inv;
  r.bi = (ni * lr - nr * li) * inv;
  return r;
}

DEV void s5_load_u(const h16* zrest, int rowbase, int g, char* ulds, int lane) {
#pragma unroll
  for (int i = 0; i < 8; ++i) {
    int e = i * 64 + lane;
    int r = e >> 1, hf = e & 1;
    uint4 v = *(const uint4*)(zrest + (size_t)(rowbase + r) * ZR + g * 16 + hf * 8);
    *(uint4*)(ulds + r * 32 + hf * 16) = v;
  }
  lds_fence();
}

DEV int s5_rowbase(int b, int c) { return c == 0 ? NLAT + b * 256 : b * 16384 + (c - 1) * 256; }

DEV void s5_pass1_unit(const Params& p, const Ctx& cx, int l, int unit, char* wl, int lane) {
  int c = unit % 65, bg = unit / 65, g = bg & 31, b = bg >> 5;
  const h16* zrest = (const h16*)(p.ws + OFF_ZREST);
  float2* F = (float2*)(p.ws + OFF_S5F);
  s5_load_u(zrest, s5_rowbase(b, c), g, wl, lane);
  float Br[16], Bi[16];
  {
    const float* pr = p.s5_b_re + ((size_t)(l * 32 + g) * 64 + lane) * 16;
    const float* pi = p.s5_b_im + ((size_t)(l * 32 + g) * 64 + lane) * 16;
#pragma unroll
    for (int i = 0; i < 16; i += 4) {
      float4 a = *(const float4*)(pr + i), bq = *(const float4*)(pi + i);
      Br[i] = a.x; Br[i + 1] = a.y; Br[i + 2] = a.z; Br[i + 3] = a.w;
      Bi[i] = bq.x; Bi[i + 1] = bq.y; Bi[i + 2] = bq.z; Bi[i + 3] = bq.w;
    }
  }
  S5P pf = s5_params(p, cx, l, 0, g, lane), pb = s5_params(p, cx, l, 1, g, lane);
  float xr = 0, xi = 0, yr = 0, yi = 0, pwr = 1.f, pwi = 0.f;
#pragma unroll 4
  for (int t = 0; t < 256; ++t) {
    h16x8 u0 = *(const h16x8*)(wl + t * 32), u1 = *(const h16x8*)(wl + t * 32 + 16);
    float br = 0, bi = 0;
#pragma unroll
    for (int i = 0; i < 8; ++i) { float u = (float)u0[i]; br = fmaf(u, Br[i], br); bi = fmaf(u, Bi[i], bi); }
#pragma unroll
    for (int i = 0; i < 8; ++i) { float u = (float)u1[i]; br = fmaf(u, Br[8 + i], br); bi = fmaf(u, Bi[8 + i], bi); }
    float nxr = pf.ar * xr - pf.ai * xi + br, nxi = pf.ar * xi + pf.ai * xr + bi;
    xr = nxr; xi = nxi;
    yr += pwr * br - pwi * bi; yi += pwr * bi + pwi * br;
    float npr = pwr * pb.ar - pwi * pb.ai, npi = pwr * pb.ai + pwi * pb.ar;
    pwr = npr; pwi = npi;
  }
  size_t fi = (((size_t)(b * 32 + g) * 65 + c) * 2) * 64 + lane;
  F[fi] = make_float2(pf.br * xr - pf.bi * xi, pf.br * xi + pf.bi * xr);
  F[fi + 64] = make_float2(pb.br * yr - pb.bi * yi, pb.br * yi + pb.bi * yr);
}

DEV void s5_pass3_unit(const Params& p, const Ctx& cx, int l, int unit, char* wl, int lane) {
  int c = unit % 65, bg = unit / 65, g = bg & 31, b = bg >> 5;
  const int fr = lane & 15, fq = lane >> 4;
  const h16* zrest = (const h16*)(p.ws + OFF_ZREST);
  const float2* F = (const float2*)(p.ws + OFF_S5F);
  float* S5Y = (float*)(p.ws + OFF_S5Y);
  const int rowbase = s5_rowbase(b, c);
  char* ulds = wl;
  char* tile = wl + 8192;
  s5_load_u(zrest, rowbase, g, ulds, lane);
  float Br[16], Bi[16];
  {
    const float* pr = p.s5_b_re + ((size_t)(l * 32 + g) * 64 + lane) * 16;
    const float* pi = p.s5_b_im + ((size_t)(l * 32 + g) * 64 + lane) * 16;
#pragma unroll
    for (int i = 0; i < 16; i += 4) {
      float4 a = *(const float4*)(pr + i), bq = *(const float4*)(pi + i);
      Br[i] = a.x; Br[i + 1] = a.y; Br[i + 2] = a.z; Br[i + 3] = a.w;
      Bi[i] = bq.x; Bi[i + 1] = bq.y; Bi[i + 2] = bq.z; Bi[i + 3] = bq.w;
    }
  }
  const float dsk = p.s5_d[(size_t)l * 512 + g * 16 + fr];
  const size_t fbase = ((size_t)(b * 32 + g) * 65) * 2 * 64 + lane;
#pragma unroll 1
  for (int d = 0; d < 2; ++d) {
    S5P pp = s5_params(p, cx, l, d, g, lane);
    float qr = pp.ar, qi = pp.ai;
#pragma unroll
    for (int i = 0; i < 8; ++i) { float t = qr * qr - qi * qi; qi = 2.f * qr * qi; qr = t; }
    float xr = 0, xi = 0;
    if (d == 0) {
      for (int cc = 0; cc < c; ++cc) {
        float2 f = F[fbase + (size_t)(cc * 2 + 0) * 64];
        float t = qr * xr - qi * xi + f.x; xi = qr * xi + qi * xr + f.y; xr = t;
      }
    } else if (c > 0) {
      float2 f0 = F[fbase + (size_t)(0 * 2 + 1) * 64];
      xr = f0.x; xi = f0.y;
      for (int cc = 64; cc > c; --cc) {
        float2 f = F[fbase + (size_t)(cc * 2 + 1) * 64];
        float t = qr * xr - qi * xi + f.x; xi = qr * xi + qi * xr + f.y; xr = t;
      }
    }
    bf16x8 chi[4], clo[4];
    {
      const float* cr = p.s5_c_re + ((size_t)((l * 2 + d) * 32 + g) * 16 + fr) * 64;
      const float* ci = p.s5_c_im + ((size_t)((l * 2 + d) * 32 + g) * 16 + fr) * 64;
#pragma unroll
      for (int ks = 0; ks < 4; ++ks) {
        float4 a = *(const float4*)(cr + ks * 16 + fq * 4), bq = *(const float4*)(ci + ks * 16 + fq * 4);
        float vals[8] = {a.x, -bq.x, a.y, -bq.y, a.z, -bq.z, a.w, -bq.w};
#pragma unroll
        for (int j = 0; j < 8; ++j) {
          h16 hh = (h16)vals[j];
          chi[ks][j] = hh;
          clo[ks][j] = (h16)(vals[j] - (float)hh);
        }
      }
    }
#pragma unroll 1
    for (int sb = 0; sb < 16; ++sb) {
      const int sub = d == 0 ? sb : 15 - sb;
#pragma unroll 4
      for (int q = 0; q < 16; ++q) {
        const int tt = d == 0 ? q : 15 - q;
        const int t = sub * 16 + tt;
        h16x8 u0 = *(const h16x8*)(ulds + t * 32), u1 = *(const h16x8*)(ulds + t * 32 + 16);
        float br = 0, bi = 0;
#pragma unroll
        for (int i = 0; i < 8; ++i) { float u = (float)u0[i]; br = fmaf(u, Br[i], br); bi = fmaf(u, Bi[i], bi); }
#pragma unroll
        for (int i = 0; i < 8; ++i) { float u = (float)u1[i]; br = fmaf(u, Br[8 + i], br); bi = fmaf(u, Bi[8 + i], bi); }
        float vr = pp.br * br - pp.bi * bi, vi = pp.br * bi + pp.bi * br;
        float nxr = pp.ar * xr - pp.ai * xi + vr, nxi = pp.ar * xi + pp.ai * xr + vi;
        xr = nxr; xi = nxi;
        h16x2 hv2 = {(h16)xr, (h16)xi};
        *(unsigned*)(tile + tt * 272 + lane * 4) = __builtin_bit_cast(unsigned, hv2);
      }
      lds_fence();
      f32x4 acc = f32x4{0.f, 0.f, 0.f, 0.f};
#pragma unroll
      for (int ks = 0; ks < 4; ++ks) {
        bf16x8 ah = *(const bf16x8*)(tile + fr * 272 + ks * 64 + fq * 16);
        acc = __builtin_amdgcn_mfma_f32_16x16x32_f16(ah, chi[ks], acc, 0, 0, 0);
        acc = __builtin_amdgcn_mfma_f32_16x16x32_f16(ah, clo[ks], acc, 0, 0, 0);
      }
      lds_fence();
#pragma unroll
      for (int r = 0; r < 4; ++r) {
        int tl = sub * 16 + fq * 4 + r;
        float* yp = S5Y + (size_t)(rowbase + tl) * 512 + g * 16 + fr;
        if (d == 0) {
          float u = (float)*(const h16*)(ulds + tl * 32 + fr * 2);
          *yp = acc[r] + dsk * u;
        } else {
          *yp = gelu_f(*yp + acc[r]);
        }
      }
    }
  }
}

DEV void prep_item(const Params& p, const Ctx& cx, int l, int item, char* smem) {
  const int tile = item >> 2, q = item & 3;
  const int row0 = tile * 64;
  const int tid = cx.tid;
  const h16* zc = (const h16*)(p.ws + OFF_REG2);
  h16* SC = (h16*)(p.ws + OFF_SCAN);
  const char* wt = p.ws + OFF_WT + (size_t)l * WT_SIZE;
  {
    const int d = q >> 1, isA = q & 1;
    const int coff = isA ? 3200 + d * 64 : 3072 + d * 64;
    int tok = tid >> 3, c8 = tid & 7;
    h16x8 cv = *(const h16x8*)(zc + (size_t)(row0 + tok) * ZC + coff + c8 * 8);
    float f[8];
#pragma unroll
    for (int j = 0; j < 8; ++j) { f[j] = (float)cv[j]; if (!isA) f[j] = tanh_f(f[j]); }
    uint4 o;
    o.x = pack_bf2(f[0], f[1]); o.y = pack_bf2(f[2], f[3]); o.z = pack_bf2(f[4], f[5]); o.w = pack_bf2(f[6], f[7]);
    *(uint4*)(smem + tok * 144 + c8 * 16) = o;
    __syncthreads();
    const bf16_t* Bt = (const bf16_t*)(wt + (isA ? WT_A2 : WT_W2)) + (size_t)d * 1024 * 64;
    const float* biasw = p.rwkv_w0 + (size_t)(l * 2 + d) * 1024;
    const float* biasa = p.rwkv_a0 + (size_t)(l * 2 + d) * 1024;
    h16* dst = SC + (size_t)(isA ? 4 + d : 6 + d) * ARR;
#pragma unroll 1
    for (int hf = 0; hf < 2; ++hf) small_gemm<64, 4>(p, cx, smem, 144, Bt, (tid >> 6) * 128 + hf * 64, [&](int m, int n, f32x4 v) {
      float4 bbw = *(const float4*)(biasw + n), bba = *(const float4*)(biasa + n);
      float4 bb = isA ? bba : bbw;
      float r0 = sigmoid_f(v[0] + bb.x), r1 = sigmoid_f(v[1] + bb.y), r2 = sigmoid_f(v[2] + bb.z), r3 = sigmoid_f(v[3] + bb.w);
      if (!isA) { r0 = __expf(-DECAY_SCALE * r0); r1 = __expf(-DECAY_SCALE * r1); r2 = __expf(-DECAY_SCALE * r2); r3 = __expf(-DECAY_SCALE * r3); }
      h16x4 o4 = {(h16)r0, (h16)r1, (h16)r2, (h16)r3};
      *(h16x4*)(dst + (size_t)(row0 + m) * 1024 + n) = o4;
    });
  }
  {
    const float* cw = p.conv_rkv + (size_t)l * 3 * 3072;
    const int grp = tid & 7, hh = (tid >> 3) & 3;
    const int c0 = (4 * q + hh) * 64 + grp * 8;
    float cwt[3][3][8];
#pragma unroll
    for (int s = 0; s < 3; ++s)
#pragma unroll
      for (int tp = 0; tp < 3; ++tp)
#pragma unroll
        for (int j = 0; j < 8; j += 4) {
          float4 a = *(const float4*)(cw + tp * 3072 + s * 1024 + c0 + j);
          cwt[s][tp][j] = a.x; cwt[s][tp][j + 1] = a.y; cwt[s][tp][j + 2] = a.z; cwt[s][tp][j + 3] = a.w;
        }
    float kkw[8];
#pragma unroll
    for (int j = 0; j < 8; j += 4) {
      float4 kq = *(const float4*)(p.rwkv_k_k + (size_t)l * 1024 + c0 + j);
      kkw[j] = kq.x; kkw[j + 1] = kq.y; kkw[j + 2] = kq.z; kkw[j + 3] = kq.w;
    }
#pragma unroll 1
    for (int it = 0; it < 4; ++it) {
      const int tok = (tid >> 5) + it * 16;
      const int row = row0 + tok;
      bool hasp, hasn;
      if (row < NLAT) { hasp = (row & 16383) != 0; hasn = (row & 16383) != 16383; }
      else { hasp = (row & 255) != 0; hasn = (row & 255) != 255; }
      const size_t off = (size_t)row * 1024 + c0;
      const h16* zp = zc + (size_t)row * ZC + c0;
      const h16* zpp = hasp ? zp - ZC : zp;
      const h16* zpn = hasn ? zp + ZC : zp;
      h16x8 cur[3], prv[3], nxt[3];
#pragma unroll
      for (int s = 0; s < 3; ++s) { cur[s] = *(const h16x8*)(zp + s * 1024); prv[s] = *(const h16x8*)(zpp + s * 1024); nxt[s] = *(const h16x8*)(zpn + s * 1024); }
      const float fp = hasp ? 1.f : 0.f, fn = hasn ? 1.f : 0.f;
      float kv[8];
#pragma unroll
      for (int s = 0; s < 3; ++s) {
        h16x8 o;
#pragma unroll
        for (int j = 0; j < 8; ++j) {
          float ov = cwt[s][0][j] * (fp * (float)prv[s][j]) + cwt[s][1][j] * (float)cur[s][j] + cwt[s][2][j] * (fn * (float)nxt[s][j]);
          o[j] = (h16)ov;
          if (s == 1) kv[j] = ov;
        }
        *(h16x8*)(SC + (size_t)s * ARR + off) = o;
      }
      float kk[8], ss = 0;
#pragma unroll
      for (int j = 0; j < 8; ++j) { kk[j] = kv[j] * kkw[j]; ss += kk[j] * kk[j]; }
      ss = allreduce8(ss);
      float inv = rcp_f(fmaxf(sqrtf(ss), 1e-12f));
      h16x8 o;
#pragma unroll
      for (int j = 0; j < 8; ++j) o[j] = (h16)(kk[j] * inv);
      *(h16x8*)(SC + 3 * ARR + off) = o;
    }
  }
}

DEV void phase_prep(const Params& p, const Ctx& cx0, int l, char* smem) {
  const int NPREP = 520 * 4, NS5 = 520;
  const Ctx& cx_ = cx0;
  for (int item = cx_.bid; item < NPREP + NS5; item += cx_.nblk) {
    __syncthreads();
    Ctx cx = cx0; asm volatile("" : "+v"(cx.tid));
    const int lane = cx.tid & 63, wid = cx.tid >> 6;
#ifndef NO_PREPITEM
    if (item < NPREP) prep_item(p, cx, l, item, smem);
    else
#endif
#ifndef NO_S5P1
      s5_pass1_unit(p, cx, l, (item - NPREP) * 8 + wid, smem + wid * 8192, lane);
#else
    {}
#endif
  }
}

typedef unsigned u2v __attribute__((ext_vector_type(2)));
struct RG { u2v w, a, kk, k, r; h16 v; };

constexpr int RW_NSLOT = 8, RW_SLOTB = 3072;
constexpr int RW_FLAGS = RW_NSLOT * RW_SLOTB;
constexpr int RW_NG = 16640 / 4;
typedef float f4v __attribute__((ext_vector_type(4)));

#define RW_RLO(gq, rlo)                                                            \
  {                                                                                \
    const int gg = (gq) < RW_NG ? (gq) : RW_NG - 1;                                \
    const int q0_ = gg * 4;                                                        \
    const int isl = q0_ >= 256;                                                    \
    const int base_ = isl ? b * 16384 : NLAT + b * 256;                            \
    const int t0_ = isl ? q0_ - 256 : q0_;                                         \
    const int last_ = isl ? 16383 : 255;                                           \
    rlo = base_ + (d ? last_ - t0_ - 3 : t0_);                                     \
  }

DEV void rwkv_helper(const Params& p, const Ctx& cx, int l, int unit, int lane, char* ring) {
  const int d = unit & 1, h = (unit >> 1) & 15, b = unit >> 5;
  const int j = lane >> 4, s = lane & 15;
  const h16* SC = (const h16*)(p.ws + OFF_SCAN);
  const char* pR = (const char*)(SC + 0 * ARR + h * 64);
  const char* pK = (const char*)(SC + 1 * ARR + h * 64);
  const char* pV = (const char*)(SC + 2 * ARR + h * 64);
  const char* pKK = (const char*)(SC + 3 * ARR + h * 64);
  const char* pA = (const char*)(SC + (size_t)(4 + d) * ARR + h * 64);
  const char* pW = (const char*)(SC + (size_t)(6 + d) * ARR + h * 64);
  const int jm = d ? 3 - j : j;
  const unsigned vo0 = (unsigned)(jm * 2048 + s * 8);
  f4v ka4, om4;
  {
    float4 t = *(const float4*)(p.rwkv_k_a + (size_t)l * 1024 + h * 64 + 4 * s);
    ka4 = f4v{t.x, t.y, t.z, t.w};
    om4 = 1.f - ka4;
  }
  struct RGH { u2v w, a, kk, k, r, v; };
  RGH q0, q1, q2, q3, q4, q5, q6, q7;
  const unsigned wofs = (unsigned)(j * 128 + s * 8);
  const unsigned vwofs = (unsigned)(2560 + j * 128 + s * 8);
  LAS3 volatile int* pflag = (LAS3 volatile int*)(ring + RW_FLAGS);
  LAS3 volatile int* cflag = (LAS3 volatile int*)(ring + RW_FLAGS + 64);
  int cmin = 0;
#define CV4(uv) __builtin_convertvector(__builtin_bit_cast(h16x4, uv), f4v)
#define RH_LOAD(q, gq)                                                             \
  {                                                                                \
    int rlo; RW_RLO(gq, rlo);                                                      \
    unsigned vo = vo0; asm volatile("" : "+v"(vo));                                \
    const size_t off = (size_t)rlo * 2048;                                         \
    q.w = *(const u2v*)(pW + off + vo); q.a = *(const u2v*)(pA + off + vo);        \
    q.kk = *(const u2v*)(pKK + off + vo); q.k = *(const u2v*)(pK + off + vo);      \
    q.r = *(const u2v*)(pR + off + vo); q.v = *(const u2v*)(pV + off + vo);        \
  }
#define RH_STEP(q, gq)                                                             \
  {                                                                                \
    if ((gq) >= RW_NSLOT && cmin < (gq) - RW_NSLOT + 1) {                          \
      do {                                                                         \
        const int c0_ = cflag[0], c1_ = cflag[1], c2_ = cflag[2], c3_ = cflag[3];  \
        cmin = __builtin_amdgcn_readfirstlane(min(min(c0_, c1_), min(c2_, c3_)));  \
        if (cmin < (gq) - RW_NSLOT + 1) __builtin_amdgcn_s_sleep(1);               \
      } while (cmin < (gq) - RW_NSLOT + 1);                                        \
    }                                                                              \
    asm volatile("" ::: "memory");                                                 \
    char* sl = ring + ((gq) % RW_NSLOT) * RW_SLOTB;                                \
    const f4v a_ = CV4(q.a), kk_ = CV4(q.kk);                                      \
    const f4v kka_ = kk_ * a_, kd_ = CV4(q.k) * (a_ * ka4 + om4);                  \
    *(u2v*)(sl + 0 * 512 + wofs) = q.w;                                            \
    *(u2v*)(sl + 1 * 512 + wofs) = q.kk;                                           \
    *(u2v*)(sl + 2 * 512 + wofs) = __builtin_bit_cast(u2v, __builtin_convertvector(kka_, h16x4)); \
    *(u2v*)(sl + 3 * 512 + wofs) = __builtin_bit_cast(u2v, __builtin_convertvector(kd_, h16x4));  \
    *(u2v*)(sl + 4 * 512 + wofs) = q.r;                                            \
    *(u2v*)(sl + vwofs) = q.v;                                                     \
    asm volatile("s_waitcnt lgkmcnt(0)" ::: "memory");     \
    *pflag = (gq) + 1;                                                             \
  }
  RH_LOAD(q0, 0); RH_LOAD(q1, 1); RH_LOAD(q2, 2); RH_LOAD(q3, 3); RH_LOAD(q4, 4); RH_LOAD(q5, 5); RH_LOAD(q6, 6); RH_LOAD(q7, 7);
#pragma unroll 1
  for (int g = 0; g < RW_NG; g += 8) {
    RH_STEP(q0, g); RH_LOAD(q0, g + 8); __builtin_amdgcn_sched_barrier(0);
    RH_STEP(q1, g + 1); RH_LOAD(q1, g + 9); __builtin_amdgcn_sched_barrier(0);
    RH_STEP(q2, g + 2); RH_LOAD(q2, g + 10); __builtin_amdgcn_sched_barrier(0);
    RH_STEP(q3, g + 3); RH_LOAD(q3, g + 11); __builtin_amdgcn_sched_barrier(0);
    RH_STEP(q4, g + 4); RH_LOAD(q4, g + 12); __builtin_amdgcn_sched_barrier(0);
    RH_STEP(q5, g + 5); RH_LOAD(q5, g + 13); __builtin_amdgcn_sched_barrier(0);
    RH_STEP(q6, g + 6); RH_LOAD(q6, g + 14); __builtin_amdgcn_sched_barrier(0);
    RH_STEP(q7, g + 7); RH_LOAD(q7, g + 15); __builtin_amdgcn_sched_barrier(0);
  }
#undef RH_LOAD
#undef RH_STEP
#undef CV4
}

DEV void rwkv_consumer(const Params& p, const Ctx& cx, int l, int task, int lane, const char* ring, int widx) {
  const int unit = task >> 4, d = unit & 1, h = (unit >> 1) & 15, b = unit >> 5;
  const int j = lane >> 4, s = lane & 15;
  const int myrow = (task & 15) * 4 + j;
  char* pO = (char*)((h16*)(p.ws + OFF_REG2) + (size_t)d * ARR + h * 64);
  const int sm = d ? 3 - (s & 3) : (s & 3);
  const unsigned vov0 = (unsigned)(sm * 2048 + myrow * 2);
  const unsigned rofs = (unsigned)(s * 8);
  const unsigned vrofs = (unsigned)(2560 + myrow * 2);
  LAS3 volatile int* pflag = (LAS3 volatile int*)(ring + RW_FLAGS);
  LAS3 volatile int* cflag = (LAS3 volatile int*)(ring + RW_FLAGS + 64) + widx;
  float S0 = 0.f, S1 = 0.f, S2 = 0.f, S3 = 0.f;
  int pseen = 0;
  struct GD { u2v w[4], kk[4], kka[4], kd[4], r[4]; unsigned v[4]; };
  GD A, B;
#define RC_WAIT(gq) { if (pseen <= (gq)) { do { pseen = __builtin_amdgcn_readfirstlane(*pflag); if (pseen <= (gq)) __builtin_amdgcn_s_sleep(1); } while (pseen <= (gq)); } asm volatile("" ::: "memory"); }
#define RC_LOAD(G, gq)                                                             \
  {                                                                                \
    const char* sl = ring + ((gq) % RW_NSLOT) * RW_SLOTB;                          \
    _Pragma("unroll") for (int u = 0; u < 4; ++u) {                                \
      G.w[u] = *(const u2v*)(sl + 0 * 512 + u * 128 + rofs);                       \
      G.kk[u] = *(const u2v*)(sl + 1 * 512 + u * 128 + rofs);                      \
      G.kka[u] = *(const u2v*)(sl + 2 * 512 + u * 128 + rofs);                     \
      G.kd[u] = *(const u2v*)(sl + 3 * 512 + u * 128 + rofs);                      \
      G.r[u] = *(const u2v*)(sl + 4 * 512 + u * 128 + rofs);                       \
      G.v[u] = *(const unsigned short*)(sl + u * 128 + vrofs);                     \
    }                                                                              \
  }
#define RC_COMP(G, gq)                                                             \
  {                                                                                \
    float dres[4];                                                                 \
    _Pragma("unroll") for (int u = 0; u < 4; ++u) {                                \
        \
        \
      float ea, eb, x_, y_, t0, t1, t2, t3;                                        \
      asm("v_fma_mix_f32 %6, %0, %12, 0 op_sel:[0,0,0] op_sel_hi:[0,1,0]\n\t"      \
          "v_fma_mix_f32 %7, %2, %13, 0 op_sel:[0,0,0] op_sel_hi:[0,1,0]\n\t"      \
          "v_fma_mix_f32 %6, %1, %12, %6 op_sel:[0,1,0] op_sel_hi:[0,1,0]\n\t"     \
          "v_fma_mix_f32 %7, %3, %13, %7 op_sel:[0,1,0] op_sel_hi:[0,1,0]\n\t"     \
          "v_fma_mix_f32 %8, %22, %16, 0 op_sel:[0,0,0] op_sel_hi:[1,1,0]\n\t"     \
          "v_add_f32 %6, %6, %7\n\t"                                               \
          "v_fma_mix_f32 %9, %22, %16, 0 op_sel:[0,1,0] op_sel_hi:[1,1,0]\n\t"     \
          "v_fma_mix_f32 %10, %22, %17, 0 op_sel:[0,0,0] op_sel_hi:[1,1,0]\n\t"    \
          "v_add_f32_dpp %6, %6, %6 quad_perm:[1,0,3,2] row_mask:0xf bank_mask:0xf bound_ctrl:1\n\t" \
          "v_fma_mix_f32 %11, %22, %17, 0 op_sel:[0,1,0] op_sel_hi:[1,1,0]\n\t"    \
          "v_fma_mix_f32 %0, %0, %14, %8 op_sel:[0,0,0] op_sel_hi:[0,1,0]\n\t"     \
          "v_add_f32_dpp %6, %6, %6 quad_perm:[2,3,0,1] row_mask:0xf bank_mask:0xf bound_ctrl:1\n\t" \
          "v_fma_mix_f32 %1, %1, %14, %9 op_sel:[0,1,0] op_sel_hi:[0,1,0]\n\t"     \
          "v_fma_mix_f32 %2, %2, %15, %10 op_sel:[0,0,0] op_sel_hi:[0,1,0]\n\t"    \
          "v_add_f32_dpp %6, %6, %6 row_half_mirror row_mask:0xf bank_mask:0xf bound_ctrl:1\n\t" \
          "v_fma_mix_f32 %3, %3, %15, %11 op_sel:[0,1,0] op_sel_hi:[0,1,0]\n\t"    \
          "s_nop 0\n\t"                                                            \
          "v_add_f32_dpp %6, %6, %6 row_mirror row_mask:0xf bank_mask:0xf bound_ctrl:1\n\t" \
          "v_fma_mix_f32 %0, -%6, %18, %0 op_sel:[0,0,0] op_sel_hi:[0,1,0]\n\t"    \
          "v_fma_mix_f32 %1, -%6, %18, %1 op_sel:[0,1,0] op_sel_hi:[0,1,0]\n\t"    \
          "v_fma_mix_f32 %2, -%6, %19, %2 op_sel:[0,0,0] op_sel_hi:[0,1,0]\n\t"    \
          "v_fma_mix_f32 %3, -%6, %19, %3 op_sel:[0,1,0] op_sel_hi:[0,1,0]\n\t"    \
          "v_fma_mix_f32 %4, %0, %20, 0 op_sel:[0,0,0] op_sel_hi:[0,1,0]\n\t"      \
          "v_fma_mix_f32 %5, %2, %21, 0 op_sel:[0,0,0] op_sel_hi:[0,1,0]\n\t"      \
          "v_fma_mix_f32 %4, %1, %20, %4 op_sel:[0,1,0] op_sel_hi:[0,1,0]\n\t"     \
          "v_fma_mix_f32 %5, %3, %21, %5 op_sel:[0,1,0] op_sel_hi:[0,1,0]"         \
          : "+v"(S0), "+v"(S1), "+v"(S2), "+v"(S3), "=&v"(ea), "=&v"(eb), "=&v"(x_), "=&v"(y_),                     \
            "=&v"(t0), "=&v"(t1), "=&v"(t2), "=&v"(t3)                                                              \
          : "v"(G.kk[u].x), "v"(G.kk[u].y), "v"(G.w[u].x), "v"(G.w[u].y), "v"(G.kd[u].x), "v"(G.kd[u].y),           \
            "v"(G.kka[u].x), "v"(G.kka[u].y), "v"(G.r[u].x), "v"(G.r[u].y), "v"(G.v[u]));                           \
      dres[u] = ea + eb;     \
    }                                                                              \
    asm volatile("" ::: "memory");                                                 \
    *cflag = (gq) + 1;     \
    {                                                                              \
      int rlo; RW_RLO(gq, rlo);                                                    \
      unsigned vov = vov0; asm volatile("" : "+v"(vov));                           \
        \
      const bool p1_ = (s & 1) != 0, p2_ = (s & 2) != 0;                           \
      const float a_ = (p1_ ? dres[1] : dres[0]) + dpp_mov<0xB1>(p1_ ? dres[0] : dres[1]); \
      const float b_ = (p1_ ? dres[3] : dres[2]) + dpp_mov<0xB1>(p1_ ? dres[2] : dres[3]); \
      float val = (p2_ ? b_ : a_) + dpp_mov<0x4E>(p2_ ? a_ : b_);                  \
      val += dpp_mov<0x124>(val);                                                  \
      val += dpp_mov<0x128>(val);                                                  \
      *(h16*)(pO + (size_t)rlo * 2048 + vov) = (h16)val;                           \
    }                                                                              \
  }
  RC_WAIT(0); RC_LOAD(A, 0);
#pragma unroll 1
  for (int g = 0; g < RW_NG; g += 2) {
    RC_WAIT(g + 1); RC_LOAD(B, g + 1);
    RC_COMP(A, g);
    if (g + 2 < RW_NG) { RC_WAIT(g + 2); RC_LOAD(A, g + 2); }
    RC_COMP(B, g + 1);
  }
#undef RC_WAIT
#undef RC_LOAD
#undef RC_COMP
}
#undef RW_RLO

DEV void phase_scan(const Params& p, const Ctx& cx, int l, char* smem) {
  const int lane = cx.tid & 63, wid = __builtin_amdgcn_readfirstlane(cx.tid >> 6);
  for (int slot = cx.bid; slot < 256; slot += cx.nblk) {
    __syncthreads();
    if (wid == 4 && lane < 8) *(LAS3 volatile int*)(smem + RW_FLAGS + (lane == 0 ? 0 : 64 + (lane & 3) * 4)) = 0;
    __syncthreads();
    const int unit = slot & 63;
#ifndef NO_RWKV
    if (wid < 4) { __builtin_amdgcn_s_setprio(3); rwkv_consumer(p, cx, l, (unit << 4) | ((slot >> 6) << 2) | wid, lane, smem, wid); __builtin_amdgcn_s_setprio(0); }
    else if (wid == 4) { __builtin_amdgcn_s_setprio(1); rwkv_helper(p, cx, l, unit, lane, smem); __builtin_amdgcn_s_setprio(0); }
#endif
  }
  if (wid >= 5) {
    char* wl = smem + 32768 + (wid - 5) * 17408;
    for (int u = cx.bid * 3 + (wid - 5); u < 2 * 32 * 65; u += cx.nblk * 3) {
      if (l == 1 && (u % 65) == 0) continue;
#ifndef NO_S5P3
      s5_pass3_unit(p, cx, l, u, wl, lane);
#endif
    }
  }
}

DEV void pool_item(const Params& p, const Ctx& cx, int l, int item, char* smem) {
  const int tid = cx.tid;
  const h16* zrest = (const h16*)(p.ws + OFF_ZREST);
  bf16_t* ym = (bf16_t*)(p.ws + OFF_YM);
  const char* wt = p.ws + OFF_WT + (size_t)l * WT_SIZE;
  float* V = (float*)smem;
  char* At = smem + 43008;
  int g, rowout0, Lseq, p0, rlo, rhi, rstride, rowsrc0;
  if (item < 2048) {
    g = item & 3; int r = (item >> 2) & 255, b = item >> 10;
    int w = 2 << g;
    rlo = max(r - w / 2, 0); rhi = min(r + w / 2 - 1, 255);
    rowsrc0 = b * 16384; rstride = 64;
    rowout0 = b * 16384 + r * 64; Lseq = 64; p0 = 0;
  } else {
    int it = item - 2048;
    g = it & 3; int tq = (it >> 2) & 3, b = it >> 4;
    rlo = 0; rhi = 0; rowsrc0 = NLAT + b * 256; rstride = 0;
    rowout0 = NLAT + b * 256 + tq * 64; Lseq = 256; p0 = tq * 64;
  }
  const int w = 2 << g;
  const float invr = 1.f / (float)(rhi - rlo + 1);
  for (int unit = tid; unit < 80 * 16; unit += NTHREADS) {
    int lp = unit >> 4, ch8 = unit & 15;
    int pos = p0 - 8 + lp;
    float acc[8] = {0, 0, 0, 0, 0, 0, 0, 0};
    if (pos >= 0 && pos < Lseq) {
      const h16* bp = zrest + (size_t)(rowsrc0 + pos) * ZR + 1024 + g * 128 + ch8 * 8;
      const int nr = rhi - rlo + 1;
      for (int k0 = 0; k0 < nr; k0 += 4) {
        h16x8 v[4]; float wv[4];
#pragma unroll
        for (int i = 0; i < 4; ++i) {
          const int kk_ = min(k0 + i, nr - 1);
          wv[i] = (k0 + i < nr) ? 1.f : 0.f;
          v[i] = *(const h16x8*)(bp + (size_t)((rlo + kk_) * rstride) * ZR);
        }
#pragma unroll
        for (int i = 0; i < 4; ++i)
#pragma unroll
          for (int j = 0; j < 8; ++j) acc[j] += wv[i] * (float)v[i][j];
      }
    }
    float* vp = V + lp * 132 + ch8 * 8;
#pragma unroll
    for (int j = 0; j < 8; ++j) vp[j] = acc[j] * invr;
  }
  __syncthreads();
  for (int unit = tid; unit < 64 * 16; unit += NTHREADS) {
    int c = unit >> 4, ch8 = unit & 15;
    int pos = p0 + c;
    int lo = max(pos - w / 2, 0), hi = min(pos + w / 2 - 1, Lseq - 1);
    float acc[8] = {0, 0, 0, 0, 0, 0, 0, 0};
    for (int pp = lo; pp <= hi; ++pp) {
      const float* vp = V + (pp - p0 + 8) * 132 + ch8 * 8;
#pragma unroll
      for (int j = 0; j < 8; ++j) acc[j] += vp[j];
    }
    float invc = 1.f / (float)(hi - lo + 1);
    h16x8 uc = *(const h16x8*)(zrest + (size_t)(rowout0 + c) * ZR + 1024 + g * 128 + ch8 * 8);
    uint4 o;
    o.x = pack_bf2(acc[0] * invc - (float)uc[0], acc[1] * invc - (float)uc[1]);
    o.y = pack_bf2(acc[2] * invc - (float)uc[2], acc[3] * invc - (float)uc[3]);
    o.z = pack_bf2(acc[4] * invc - (float)uc[4], acc[5] * invc - (float)uc[5]);
    o.w = pack_bf2(acc[6] * invc - (float)uc[6], acc[7] * invc - (float)uc[7]);
    *(uint4*)(At + c * 272 + ch8 * 16) = o;
  }
  __syncthreads();
  const bf16_t* Bt = (const bf16_t*)(wt + WT_POOL) + (size_t)g * 128 * 128;
  const float* ps = p.pool_scale + (size_t)l * 512 + g * 128;
  small_gemm<128, 1>(p, cx, At, 272, Bt, (tid >> 6) * 16, [&](int m, int n, f32x4 v) {
    int row = rowout0 + m;
    float4 sc = *(const float4*)(ps + n);
    h16x4 gt = *(const h16x4*)(zrest + (size_t)row * ZR + 1536 + g * 128 + n);
    uint2 o;
    o.x = pack_bf2(v[0] * sc.x * silu_f((float)gt[0]), v[1] * sc.y * silu_f((float)gt[1]));
    o.y = pack_bf2(v[2] * sc.z * silu_f((float)gt[2]), v[3] * sc.w * silu_f((float)gt[3]));
    *(uint2*)(ym + (size_t)row * D + 512 + g * 128 + n) = o;
  });
}

DEV void glu_item(const Params& p, const Ctx& cx, int l, int tile, char* smem) {
  const int tid = cx.tid;
  const int row0 = tile * 64;
  const float* S5Y = (const float*)(p.ws + OFF_S5Y);
  const h16* zrest = (const h16*)(p.ws + OFF_ZREST);
  bf16_t* ym = (bf16_t*)(p.ws + OFF_YM);
  const char* wt = p.ws + OFF_WT + (size_t)l * WT_SIZE;
#pragma unroll
  for (int it = 0; it < 8; ++it) {
    int unit = tid + it * NTHREADS;
    int r = unit >> 6, c8 = unit & 63;
    const float* sp = S5Y + (size_t)(row0 + r) * 512 + c8 * 8;
    float4 a = *(const float4*)sp, bq = *(const float4*)(sp + 4);
    uint4 o;
    o.x = pack_bf2(a.x, a.y); o.y = pack_bf2(a.z, a.w); o.z = pack_bf2(bq.x, bq.y); o.w = pack_bf2(bq.z, bq.w);
    *(uint4*)(smem + r * 1040 + c8 * 16) = o;
  }
  __syncthreads();
  const bf16_t* Bt = (const bf16_t*)(wt + WT_GLU);
  const float* bg = p.b_glu + (size_t)l * 512;
  small_gemm<512, 4>(p, cx, smem, 1040, Bt, (tid >> 6) * 64, [&](int m, int n, f32x4 v) {
    int row = row0 + m;
    float4 y = *(const float4*)(S5Y + (size_t)row * 512 + n);
    float4 bb = *(const float4*)(bg + n);
    h16x4 gt = *(const h16x4*)(zrest + (size_t)row * ZR + 512 + n);
    uint2 o;
    o.x = pack_bf2(y.x * sigmoid_f(v[0] + bb.x) * silu_f((float)gt[0]), y.y * sigmoid_f(v[1] + bb.y) * silu_f((float)gt[1]));
    o.y = pack_bf2(y.z * sigmoid_f(v[2] + bb.z) * silu_f((float)gt[2]), y.w * sigmoid_f(v[3] + bb.w) * silu_f((float)gt[3]));
    *(uint2*)(ym + (size_t)row * D + n) = o;
  });
}

DEV void rwkvmerge_item(const Params& p, const Ctx& cx, int l, int tile) {
  const int tid = cx.tid;
  const int row0 = tile * 64;
  const h16* SC = (const h16*)(p.ws + OFF_SCAN);
  const h16* O = (const h16*)(p.ws + OFF_REG2);
  const h16* zrest = (const h16*)(p.ws + OFF_ZREST);
  bf16_t* ym = (bf16_t*)(p.ws + OFF_YM);
  const int grp = tid & 7, h = (tid >> 3) & 15;
  const int c0 = h * 64 + grp * 8;
  float pk[8], rk[8], gw[8], gb[8];
#pragma unroll
  for (int j = 0; j < 8; j += 4) {
    float4 t0 = *(const float4*)(p.rwkv_k_a + (size_t)l * 1024 + c0 + j), t1 = *(const float4*)(p.rwkv_r_k + (size_t)l * 1024 + c0 + j);
    float4 t2 = *(const float4*)(p.gn_w + (size_t)l * 1024 + c0 + j), t3 = *(const float4*)(p.gn_b + (size_t)l * 1024 + c0 + j);
    pk[j] = t0.x; pk[j + 1] = t0.y; pk[j + 2] = t0.z; pk[j + 3] = t0.w;
    rk[j] = t1.x; rk[j + 1] = t1.y; rk[j + 2] = t1.z; rk[j + 3] = t1.w;
    gw[j] = t2.x; gw[j + 1] = t2.y; gw[j + 2] = t2.z; gw[j + 3] = t2.w;
    gb[j] = t3.x; gb[j + 1] = t3.y; gb[j + 2] = t3.z; gb[j + 3] = t3.w;
  }
#pragma unroll 2
  for (int it = 0; it < 16; ++it) {
    const int tok = (tid >> 7) + it * 4;
    int row = row0 + tok;
    size_t off = (size_t)row * 1024 + c0;
    h16x8 of = *(const h16x8*)(O + off), ob = *(const h16x8*)(O + ARR + off);
    h16x8 r8 = *(const h16x8*)(SC + 0 * ARR + off), k8 = *(const h16x8*)(SC + 1 * ARR + off), v8 = *(const h16x8*)(SC + 2 * ARR + off);
    h16x8 af = *(const h16x8*)(SC + 4 * ARR + off), ab = *(const h16x8*)(SC + 5 * ARR + off);
    h16x8 gt = *(const h16x8*)(zrest + (size_t)row * ZR + 2048 + c0);
    float o[8], sm = 0;
#pragma unroll
    for (int j = 0; j < 8; ++j) { o[j] = (float)of[j] + (float)ob[j]; sm += o[j]; }
    sm = allreduce8(sm);
    float mu = sm * (1.f / 64.f), vq = 0;
#pragma unroll
    for (int j = 0; j < 8; ++j) { o[j] -= mu; vq += o[j] * o[j]; }
    vq = allreduce8(vq);
    float rstd = rsqrtf(vq * (1.f / 64.f) + 64e-5f);
    float part = 0;
#pragma unroll
    for (int j = 0; j < 8; ++j) {
      float ksum = (float)k8[j] * (2.f + ((float)af[j] + (float)ab[j] - 2.f) * pk[j]);
      part += (float)r8[j] * ksum * rk[j];
    }
    part = allreduce8(part);
    float res[8];
#pragma unroll
    for (int j = 0; j < 8; ++j) {
      float y = o[j] * rstd * gw[j] + gb[j] + part * (float)v8[j];
      res[j] = y * silu_f((float)gt[j]);
    }
    uint4 ov;
    ov.x = pack_bf2(res[0], res[1]); ov.y = pack_bf2(res[2], res[3]); ov.z = pack_bf2(res[4], res[5]); ov.w = pack_bf2(res[6], res[7]);
    *(uint4*)(ym + (size_t)row * D + 1024 + c0) = ov;
  }
}

DEV void phase_merge(const Params& p, const Ctx& cx0, int l, char* smem) {
  const int ntile = (l == 0) ? 520 : 512;
  const int npool = (l == 0) ? 2048 + 32 : 2048;
  const int total = npool + 2 * ntile;
  for (int item = cx0.bid; item < total; item += cx0.nblk) {
    __syncthreads();
    Ctx cx = cx0; asm volatile("" : "+v"(cx.tid));
    const int grp6 = item / 6, pos6 = item - grp6 * 6;
    if (pos6 < 4) pool_item(p, cx, l, grp6 * 4 + pos6, smem);
    else if (pos6 == 4) glu_item(p, cx, l, grp6, smem);
    else rwkvmerge_item(p, cx, l, grp6);
  }
}

#define XB_TMO      128
#define XB_XCNT(j)  (256  + 64 * (j))
#define XB_XSUB(j)  (1280 + 64 * (j))
#define XB_XGEN(j)  (2304 + 64 * (j))
#define XB_TOP      3328
#define XB_TOPGEN   3392
#define XCD_BAR_WORDS 3456
#define XB_SPIN_CAP (1u << 18)
DEV unsigned xb_ld(unsigned* p) { return __hip_atomic_load(p, __ATOMIC_RELAXED, __HIP_MEMORY_SCOPE_AGENT); }
DEV unsigned xb_add(unsigned* p, unsigned v) { return __hip_atomic_fetch_add(p, v, __ATOMIC_RELAXED, __HIP_MEMORY_SCOPE_AGENT); }
DEV unsigned xb_xcc_id() { return (unsigned)__builtin_amdgcn_s_getreg((3 << 11) | 20) & 0xFu; }
#define XB_SPIN(cond, bar) do { unsigned _sp = 0; while (cond) { __builtin_amdgcn_s_sleep(1); \
    if ((++_sp & 255u) == 0u) { if (xb_ld(&(bar)[XB_TMO])) break; if (_sp > XB_SPIN_CAP) { atomicAdd(&(bar)[XB_TMO], 1u); break; } } } } while (0)
struct XcdBarrier { unsigned* bar; unsigned x; volatile LAS3 unsigned* st; };
DEV XcdBarrier xcd_barrier_post(unsigned* bar, volatile LAS3 unsigned* st) {
  XcdBarrier b; b.bar = bar; b.x = xb_xcc_id(); b.st = st;
  if (threadIdx.x == 0) (void)xb_add(&bar[XB_XCNT(b.x)], 1u);
  return b;
}
DEV void xcd_barrier_complete(unsigned* bar, unsigned x, unsigned& nloc, unsigned& nx) {
  const unsigned G = gridDim.x * gridDim.y * gridDim.z;
  unsigned sum, cnt, mine, sp = 0u;
  for (;;) {
    sum = 0u; cnt = 0u; mine = 0u;
#pragma unroll
    for (unsigned j = 0; j < 16; ++j) { const unsigned c = xb_ld(&bar[XB_XCNT(j)]); sum += c; cnt += (c > 0u) ? 1u : 0u; mine = (j == x) ? c : mine; }
    if (sum == G) break;
    __builtin_amdgcn_s_sleep(1);
    if ((++sp & 255u) == 0u) { if (xb_ld(&bar[XB_TMO])) break; if (sp > XB_SPIN_CAP) { atomicAdd(&bar[XB_TMO], 1u); break; } }
  }
  nloc = mine > 0u ? mine : 1u; nx = cnt > 0u ? cnt : 1u;
}
DEV void xcd_barrier(const XcdBarrier& b) {
  asm volatile("s_waitcnt vmcnt(0)" ::: "memory");
  __syncthreads();
  if (threadIdx.x == 0) {
    unsigned* bar = b.bar;
    __builtin_amdgcn_s_waitcnt(0);
    unsigned nloc = b.st[0], nx = b.st[1];
    if (nloc == 0u) { xcd_barrier_complete(bar, b.x, nloc, nx); b.st[0] = nloc; b.st[1] = nx; }
    const unsigned old = xb_add(&bar[XB_XSUB(b.x)], 1u);
    const unsigned gen = old / nloc;
    if (old + 1u == (gen + 1u) * nloc) {
      __builtin_amdgcn_fence(__ATOMIC_RELEASE, "agent");
      asm volatile("s_waitcnt vmcnt(0)" ::: "memory");
      const unsigned og = xb_add(&bar[XB_TOP], 1u);
      const unsigned tg = og / nx;
      if (og + 1u == (tg + 1u) * nx) xb_add(&bar[XB_TOPGEN], 1u);
      else XB_SPIN(xb_ld(&bar[XB_TOPGEN]) == tg, bar);
      __builtin_amdgcn_fence(__ATOMIC_ACQUIRE, "agent");
      xb_add(&bar[XB_XGEN(b.x)], 1u);
      asm volatile("s_waitcnt vmcnt(0)" ::: "memory");
    } else {
      XB_SPIN(xb_ld(&bar[XB_XGEN(b.x)]) == gen, bar);
      __builtin_amdgcn_fence(__ATOMIC_ACQUIRE, "agent");
      asm volatile("s_waitcnt vmcnt(0)" ::: "memory");
    }
  }
  __syncthreads();
}

#define LCX Ctx c2 = cx; asm volatile("" : "+v"(c2.tid))
#ifndef GEMM_FN
#define GEMM_FN gemm_phase2
#endif
__global__ void __launch_bounds__(NTHREADS) mega_fwd(Params p, int ph0, int ph1) {
  extern __shared__ __attribute__((aligned(16))) char smem[];
  cg::grid_group grid = cg::this_grid();
  __shared__ uint4 xb_words;
  if (threadIdx.x == 0) xb_words = make_uint4(0u, 0u, 0u, 0u);
  __syncthreads();
  const XcdBarrier xb = xcd_barrier_post((unsigned*)(p.ws + OFF_BAR), (volatile LAS3 unsigned*)&xb_words);
  const int wave_s = __builtin_amdgcn_readfirstlane((int)(threadIdx.x >> 6));
  for (int step = ph0; step < ph1; ++step) {
    if (step == ph0 + 1) grid.sync(); else if (step > ph0) xcd_barrier(xb);
    const int ph = (int)((PH_SEQ >> (4 * step)) & 15ull);
    Ctx cx;
    {
      int t_, b_ = blockIdx.x, n_ = gridDim.x;
      asm volatile("v_mbcnt_lo_u32_b32 %0, -1, 0\n\tv_mbcnt_hi_u32_b32 %0, -1, %0\n\tv_lshl_add_u32 %0, %1, 6, %0" : "=&v"(t_) : "s"(wave_s));
      asm volatile("" : "+s"(b_), "+s"(n_));
      cx.tid = t_; cx.bid = b_; cx.nblk = n_;
    }
    const int l = ph >= 8 ? 1 : 0;
    const int lp = ph >= 8 ? ph - 6 : ph;
#ifndef PHMASK
#define PHMASK 0xff
#endif
    if (ph == 0) { if (PHMASK & 1) { LCX; phase0(p, c2, smem); } }
    else if (ph == 1) { if (PHMASK & 2) { LCX; phase_adaln0(p, c2); } }
    else if (lp == 2 && (PHMASK & 4)) {
      LCX;
      h16* zrest = (h16*)(p.ws + OFF_ZREST);
      h16* zc = (h16*)(p.ws + OFF_REG2);
      GEMM_FN(p, c2, (const bf16_t*)(p.ws + OFF_H), (const bf16_t*)(p.ws + OFF_WT + (size_t)l * WT_SIZE + WT_IN), 2048, 130, 25, smem,
                 [&](int row, int col, f32x4 v, f32x4 u) {
                   h16* dst;
                   if (col < 2048) dst = zrest + (size_t)row * ZR + col;
                   else if (col < 5120) dst = zc + (size_t)row * ZC + (col - 2048);
                   else if (col < 6144) dst = zrest + (size_t)row * ZR + 2048 + (col - 5120);
                   else dst = zc + (size_t)row * ZC + 3072 + (col - 6144);
                   h16x8 o = {(h16)v[0], (h16)v[1], (h16)v[2], (h16)v[3], (h16)u[0], (h16)u[1], (h16)u[2], (h16)u[3]};
                   *(h16x8*)dst = o;
                 });
    } else if (lp == 3) { if (PHMASK & 8) { LCX; phase_prep(p, c2, l, smem); } }
    else if (lp == 4) { if (PHMASK & 16) { LCX; phase_scan(p, c2, l, smem); } }
    else if (lp == 5) { if (PHMASK & 32) { LCX; phase_merge(p, c2, l, smem); } }
    else if (lp == 6 && (PHMASK & 64)) {
      LCX;
      const float* mods = (const float*)(p.ws + OFF_MODS);
      float* prec = (float*)(p.ws + OFF_PREC);
      const float* xin = (l == 0) ? p.x : p.out;
      GEMM_FN(p, c2, (const bf16_t*)(p.ws + OFF_YM), (const bf16_t*)(p.ws + OFF_WT + (size_t)l * WT_SIZE + WT_OUT), 2048, l == 0 ? 130 : 128, 8, smem,
                 [&](int row, int col, f32x4 v, f32x4 u) {
                   const float* xr; const float* gr; float* dr;
                   if (row < NLAT) {
                     xr = xin + (size_t)row * D + col; gr = mods + (size_t)(l * 3 + (row >> 14)) * 6144 + 4096 + col; dr = p.out + (size_t)row * D + col;
                   } else {
                     xr = p.ctx + (size_t)(row - NLAT) * D + col; gr = mods + (size_t)(l * 3 + 2) * 6144 + 4096 + col; dr = prec + (size_t)(row - NLAT) * D + col;
                   }
                   const float4 x0 = *(const float4*)xr, x1 = *(const float4*)(xr + 4), g0 = *(const float4*)gr, g1 = *(const float4*)(gr + 4);
                   float4 r0, r1;
                   r0.x = ALPHA * x0.x + g0.x * v[0]; r0.y = ALPHA * x0.y + g0.y * v[1]; r0.z = ALPHA * x0.z + g0.z * v[2]; r0.w = ALPHA * x0.w + g0.w * v[3];
                   r1.x = ALPHA * x1.x + g1.x * u[0]; r1.y = ALPHA * x1.y + g1.y * u[1]; r1.z = ALPHA * x1.z + g1.z * u[2]; r1.w = ALPHA * x1.w + g1.w * u[3];
                   *(float4*)dr = r0; *(float4*)(dr + 4) = r1;
                 });
    } else if (lp == 7) { if (PHMASK & 128) { LCX; phase_finln(p, c2, l); } }
  }
}

constexpr int NPHASES = PH_NSTEPS;

extern "C" void kernel_launch(void* const* d_in, const int* in_sizes, int n_in, void* d_out, int out_size, void* d_ws, size_t ws_size,
                              hipStream_t stream) {
  static int grid_blocks = 0;
  if (grid_blocks == 0) {
    if (n_in != 32 || ws_size < WS_END) { fprintf(stderr, "kernel_launch: unexpected n_in %d / ws %zu (need %zu)\n", n_in, ws_size, (size_t)WS_END); grid_blocks = -1; return; }
    int dev = 0, cus = 0, per_cu = 0;
    hipGetDevice(&dev);
    hipDeviceGetAttribute(&cus, hipDeviceAttributeMultiprocessorCount, dev);
    if (hipFuncSetAttribute((const void*)mega_fwd, hipFuncAttributeMaxDynamicSharedMemorySize, LDS_BYTES) != hipSuccess) { fprintf(stderr, "hipFuncSetAttribute failed\n"); grid_blocks = -1; return; }
    if (hipOccupancyMaxActiveBlocksPerMultiprocessor(&per_cu, (const void*)mega_fwd, NTHREADS, LDS_BYTES) != hipSuccess || per_cu < 1) {
      fprintf(stderr, "occupancy query gave %d\n", per_cu); (void)hipGetLastError(); per_cu = 1;
    }
    grid_blocks = cus * per_cu;
  }
  if (grid_blocks < 0) return;
  Params p{};
  const float** pp = (const float**)&p;
  for (int i = 0; i < 32; ++i) pp[i] = (const float*)d_in[i];
  p.out = (float*)d_out;
  p.ws = (char*)d_ws;
  if (hipMemsetAsync((char*)d_ws + OFF_BAR, 0, XCD_BAR_WORDS * sizeof(unsigned), stream) != hipSuccess) { fprintf(stderr, "barrier memset failed\n"); return; }
  int ph0 = 0, ph1 = NPHASES;
  void* args[] = {&p, &ph0, &ph1};
  hipError_t e = hipLaunchCooperativeKernel((const void*)mega_fwd, dim3(grid_blocks), dim3(NTHREADS), args, LDS_BYTES, stream);
  if (e != hipSuccess) fprintf(stderr, "cooperative launch failed: %s (grid %d)\n", hipGetErrorString(e), grid_blocks);
}
```

```cpp
#include <hip/hip_runtime.h>
#include <hip/hip_cooperative_groups.h>
#include <cstdio>
namespace cg = cooperative_groups;

typedef unsigned short bf16_t;
typedef _Float16 h16;
using bf16x8 = __attribute__((ext_vector_type(8))) _Float16;
using f32x4 = __attribute__((ext_vector_type(4))) float;
using h16x4 = __attribute__((ext_vector_type(4))) _Float16;
using h16x8 = __attribute__((ext_vector_type(8))) _Float16;

#define DEV __device__ __forceinline__

constexpr int D = 2048, NLAT = 32768, MTOT = 33280, ZR = 3072, ZC = 3328;
constexpr int NTHREADS = 512;
constexpr int LDS_BYTES = 147456;
constexpr float ALPHA = 1.41421356237f;
constexpr float DECAY_SCALE = 0.606531f;

constexpr size_t al256(size_t x) { return (x + 255) & ~size_t(255); }
constexpr size_t ARR = (size_t)MTOT * 1024;
constexpr size_t OFF_MODS = 0;
constexpr size_t OFF_S5F = al256(OFF_MODS + 2 * 3 * 6144 * 4);
constexpr size_t OFF_PREC = al256(OFF_S5F + (size_t)2 * 32 * 65 * 2 * 64 * 8);
constexpr size_t OFF_WT = al256(OFF_PREC + (size_t)512 * 2048 * 4);
constexpr size_t WT_IN = 0, WT_OUT = 26214400, WT_W2 = 34603008, WT_A2 = 34865152, WT_POOL = 35127296, WT_GLU = 35258368, WT_SIZE = 35782656;
constexpr size_t OFF_ZREST = al256(OFF_WT + 2 * WT_SIZE);
constexpr size_t OFF_REG2 = al256(OFF_ZREST + (size_t)MTOT * ZR * 2);
constexpr size_t OFF_S5Y = OFF_REG2 + 2 * ARR * 2;
constexpr size_t OFF_SCAN = al256(OFF_REG2 + (size_t)MTOT * ZC * 2);
constexpr size_t OFF_H = OFF_SCAN;
constexpr size_t OFF_YM = OFF_SCAN + 6 * ARR * 2;
constexpr size_t OFF_BAR = al256(OFF_SCAN + 8 * ARR * 2);
constexpr size_t WS_END = OFF_BAR + 16384;

#ifndef PH_SEQ
#define PH_SEQ 0xDCBA9876543210ull
#define PH_NSTEPS 14
#endif
struct Params {
  const float *x, *c, *ctx, *c_ctx, *w_ada, *b_ada, *w_in, *conv_rkv, *s5_lam_re, *s5_lam_im, *s5_log_step,
      *s5_b_re, *s5_b_im, *s5_c_re, *s5_c_im, *s5_d, *w_glu, *b_glu, *w_pool, *pool_scale,
      *rwkv_w0, *rwkv_w2, *rwkv_a0, *rwkv_a2, *rwkv_k_k, *rwkv_k_a, *rwkv_r_k, *gn_w, *gn_b,
      *w_out, *ln_g, *ln_b;
  float* out;
  char* ws;
};
struct Ctx { int tid, bid, nblk; };

DEV float rcp_f(float x) { return __builtin_amdgcn_rcpf(x); }
DEV float sigmoid_f(float x) { return rcp_f(1.f + __expf(-x)); }
DEV float silu_f(float x) { return x * rcp_f(1.f + __expf(-x)); }
DEV float tanh_f(float x) { float e = __expf(2.f * x); return 1.f - 2.f * rcp_f(e + 1.f); }
DEV float gelu_f(float y) { return 0.5f * y * (1.f + tanh_f(0.7978845608f * (y + 0.044715f * y * y * y))); }
using h16x2 = __attribute__((ext_vector_type(2))) _Float16;
DEV unsigned pack_bf2(float a, float b) { h16x2 v = {(h16)a, (h16)b}; return __builtin_bit_cast(unsigned, v); }
template <int CTRL> DEV float dpp_mov(float v) {
  return __int_as_float(__builtin_amdgcn_update_dpp(0, __float_as_int(v), CTRL, 0xf, 0xf, true));
}
DEV float allreduce16(float v) {
  v += dpp_mov<0xB1>(v);
  v += dpp_mov<0x4E>(v);
  v += dpp_mov<0x141>(v);
  v += dpp_mov<0x140>(v);
  return v;
}
DEV float wave_sum(float v) {
  v = allreduce16(v);
  return __builtin_amdgcn_readlane(__float_as_int(v), 0) == 0 && false ? 0.f :
         __int_as_float(__builtin_amdgcn_readlane(__float_as_int(v), 0)) + __int_as_float(__builtin_amdgcn_readlane(__float_as_int(v), 16)) +
         __int_as_float(__builtin_amdgcn_readlane(__float_as_int(v), 32)) + __int_as_float(__builtin_amdgcn_readlane(__float_as_int(v), 48));
}
DEV float allreduce8(float v) {
  v += dpp_mov<0xB1>(v);
  v += dpp_mov<0x4E>(v);
  v += dpp_mov<0x141>(v);
  return v;
}
DEV void lds_fence() { asm volatile("s_waitcnt lgkmcnt(0)" ::: "memory"); }

DEV void p0_mods_item(const Params& p, const Ctx& cx, int item, char* smem) {
  float* red = (float*)smem;
  float* mods = (float*)(p.ws + OFF_MODS);
  int l = item / 96, chunk = item % 96;
  int tid = cx.tid, kq = tid >> 6, col = tid & 63;
  int n = chunk * 64 + col;
  const float* W = p.w_ada + (size_t)l * 2048 * 6144;
  float a0 = 0, a1 = 0, a2 = 0;
#pragma unroll 8
  for (int k = kq; k < 2048; k += 8) {
    float w = W[(size_t)k * 6144 + n];
    a0 += silu_f(p.c[k]) * w;
    a1 += silu_f(p.c[2048 + k]) * w;
    a2 += silu_f(p.c_ctx[k]) * w;
  }
  red[(kq * 3 + 0) * 64 + col] = a0;
  red[(kq * 3 + 1) * 64 + col] = a1;
  red[(kq * 3 + 2) * 64 + col] = a2;
  __syncthreads();
  if (tid < 192) {
    int r = tid >> 6, cc = tid & 63;
    float s = 0;
#pragma unroll
    for (int q = 0; q < 8; ++q) s += red[(q * 3 + r) * 64 + cc];
    mods[(size_t)(l * 3 + r) * 6144 + chunk * 64 + cc] = s + p.b_ada[(size_t)l * 6144 + chunk * 64 + cc];
  }
}

DEV void p0_transpose_tile(const Params& p, const Ctx& cx, const float* __restrict__ src, bf16_t* __restrict__ dst, int K, int N, int tk, int tn, char* smem) {
  float* T = (float*)smem;
  int tid = cx.tid;
  int k0 = tk * 64, n0 = tn * 64;
  int kk = tid >> 4, n4 = tid & 15;
#pragma unroll
  for (int i = 0; i < 2; ++i) {
    int k = kk + 32 * i;
    float4 v = *(const float4*)(src + (size_t)(k0 + k) * N + n0 + n4 * 4);
    T[k * 65 + n4 * 4 + 0] = v.x; T[k * 65 + n4 * 4 + 1] = v.y; T[k * 65 + n4 * 4 + 2] = v.z; T[k * 65 + n4 * 4 + 3] = v.w;
  }
  __syncthreads();
  int n = tid >> 3, k8 = tid & 7;
  uint4 o;
  o.x = pack_bf2(T[(k8 * 8 + 0) * 65 + n], T[(k8 * 8 + 1) * 65 + n]);
  o.y = pack_bf2(T[(k8 * 8 + 2) * 65 + n], T[(k8 * 8 + 3) * 65 + n]);
  o.z = pack_bf2(T[(k8 * 8 + 4) * 65 + n], T[(k8 * 8 + 5) * 65 + n]);
  o.w = pack_bf2(T[(k8 * 8 + 6) * 65 + n], T[(k8 * 8 + 7) * 65 + n]);
  *(uint4*)(dst + (size_t)(n0 + n) * K + k0 + k8 * 8) = o;
}

DEV void phase0(const Params& p, const Ctx& cx0, char* smem) {
  const int NTR = 4368;
  const int total = 192 + 2 * NTR;
  for (int item = cx0.bid; item < total; item += cx0.nblk) {
    __syncthreads();
    Ctx cx = cx0; asm volatile("" : "+v"(cx.tid));
    if (item < 192) { p0_mods_item(p, cx, item, smem); continue; }
    int it = item - 192;
    int l = it / NTR, i = it % NTR;
    char* wt = p.ws + OFF_WT + (size_t)l * WT_SIZE;
    if (i < 3200) {
      p0_transpose_tile(p, cx, p.w_in + (size_t)l * 2048 * 6400, (bf16_t*)(wt + WT_IN), 2048, 6400, i / 100, i % 100, smem);
    } else if (i < 4224) {
      int j = i - 3200;
      p0_transpose_tile(p, cx, p.w_out + (size_t)l * 2048 * 2048, (bf16_t*)(wt + WT_OUT), 2048, 2048, j / 32, j % 32, smem);
    } else if (i < 4256) {
      int j = i - 4224, d = j / 16;
      p0_transpose_tile(p, cx, p.rwkv_w2 + (size_t)(l * 2 + d) * 64 * 1024, (bf16_t*)(wt + WT_W2) + (size_t)d * 1024 * 64, 64, 1024, 0, j % 16, smem);
    } else if (i < 4288) {
      int j = i - 4256, d = j / 16;
      p0_transpose_tile(p, cx, p.rwkv_a2 + (size_t)(l * 2 + d) * 64 * 1024, (bf16_t*)(wt + WT_A2) + (size_t)d * 1024 * 64, 64, 1024, 0, j % 16, smem);
    } else if (i < 4304) {
      int j = i - 4288, g = j / 4;
      p0_transpose_tile(p, cx, p.w_pool + (size_t)(l * 4 + g) * 128 * 128, (bf16_t*)(wt + WT_POOL) + (size_t)g * 128 * 128, 128, 128, (j % 4) / 2, j % 2, smem);
    } else {
      int j = i - 4304;
      p0_transpose_tile(p, cx, p.w_glu + (size_t)l * 512 * 512, (bf16_t*)(wt + WT_GLU), 512, 512, j / 8, j % 8, smem);
    }
  }
}

DEV void phase_adaln0(const Params& p, const Ctx& cx) {
  const float* mods = (const float*)(p.ws + OFF_MODS);
  bf16_t* hbuf = (bf16_t*)(p.ws + OFF_H);
  int lane = cx.tid & 63;
  int gw = cx.bid * 8 + (cx.tid >> 6), nw = cx.nblk * 8;
  for (int row = gw; row < MTOT; row += nw) {
    const float* src = row < NLAT ? p.x + (size_t)row * D : p.ctx + (size_t)(row - NLAT) * D;
    int mr = row < NLAT ? (row >> 14) : 2;
    const float* md = mods + (size_t)mr * 6144;
    float4 v[8];
    float s = 0;
#pragma unroll
    for (int i = 0; i < 8; ++i) { v[i] = *(const float4*)(src + i * 256 + lane * 4); s += v[i].x + v[i].y + v[i].z + v[i].w; }
    float mu = wave_sum(s) * (1.f / 2048.f);
    float q = 0;
#pragma unroll
    for (int i = 0; i < 8; ++i) { v[i].x -= mu; v[i].y -= mu; v[i].z -= mu; v[i].w -= mu; q += v[i].x * v[i].x + v[i].y * v[i].y + v[i].z * v[i].z + v[i].w * v[i].w; }
    float rstd = rsqrtf(wave_sum(q) * (1.f / 2048.f) + 1e-6f);
#pragma unroll
    for (int i = 0; i < 8; ++i) {
      int col = i * 256 + lane * 4;
      float4 sh = *(const float4*)(md + col), sc = *(const float4*)(md + 2048 + col);
      uint2 o;
      o.x = pack_bf2(v[i].x * rstd * (1.f + sc.x) + sh.x, v[i].y * rstd * (1.f + sc.y) + sh.y);
      o.y = pack_bf2(v[i].z * rstd * (1.f + sc.z) + sh.z, v[i].w * rstd * (1.f + sc.w) + sh.w);
      *(uint2*)(hbuf + (size_t)row * D + col) = o;
    }
  }
}

DEV void phase_finln(const Params& p, const Ctx& cx, int l) {
  const float* mods = (const float*)(p.ws + OFF_MODS);
  bf16_t* hbuf = (bf16_t*)(p.ws + OFF_H);
  float* prec = (float*)(p.ws + OFF_PREC);
  int lane = cx.tid & 63;
  int gw = cx.bid * 8 + (cx.tid >> 6), nw = cx.nblk * 8;
  const int nrows = (l == 0) ? MTOT : NLAT;
  for (int row = gw; row < nrows; row += nw) {
    float* src = row < NLAT ? p.out + (size_t)row * D : prec + (size_t)(row - NLAT) * D;
    float4 v[8];
    float s = 0;
#pragma unroll
    for (int i = 0; i < 8; ++i) { v[i] = *(const float4*)(src + i * 256 + lane * 4); s += v[i].x + v[i].y + v[i].z + v[i].w; }
    float mu = wave_sum(s) * (1.f / 2048.f);
    float q = 0;
#pragma unroll
    for (int i = 0; i < 8; ++i) { v[i].x -= mu; v[i].y -= mu; v[i].z -= mu; v[i].w -= mu; q += v[i].x * v[i].x + v[i].y * v[i].y + v[i].z * v[i].z + v[i].w * v[i].w; }
    float rstd = rsqrtf(wave_sum(q) * (1.f / 2048.f) + 1e-5f);
    float s2 = 0;
#pragma unroll
    for (int i = 0; i < 8; ++i) {
      int col = i * 256 + lane * 4;
      float4 g = *(const float4*)(p.ln_g + (size_t)l * D + col), b = *(const float4*)(p.ln_b + (size_t)l * D + col);
      v[i].x = v[i].x * rstd * g.x + b.x; v[i].y = v[i].y * rstd * g.y + b.y; v[i].z = v[i].z * rstd * g.z + b.z; v[i].w = v[i].w * rstd * g.w + b.w;
      if (row < NLAT) *(float4*)(src + col) = v[i];
      s2 += v[i].x + v[i].y + v[i].z + v[i].w;
    }
    if (l == 0) {
      int mr = row < NLAT ? (row >> 14) : 2;
      const float* md = mods + (size_t)(3 + mr) * 6144;
      float mu2 = wave_sum(s2) * (1.f / 2048.f);
      float q2 = 0;
#pragma unroll
      for (int i = 0; i < 8; ++i) { v[i].x -= mu2; v[i].y -= mu2; v[i].z -= mu2; v[i].w -= mu2; q2 += v[i].x * v[i].x + v[i].y * v[i].y + v[i].z * v[i].z + v[i].w * v[i].w; }
      float rstd2 = rsqrtf(wave_sum(q2) * (1.f / 2048.f) + 1e-6f);
#pragma unroll
      for (int i = 0; i < 8; ++i) {
        int col = i * 256 + lane * 4;
        float4 sh = *(const float4*)(md + col), sc = *(const float4*)(md + 2048 + col);
        uint2 o;
        o.x = pack_bf2(v[i].x * rstd2 * (1.f + sc.x) + sh.x, v[i].y * rstd2 * (1.f + sc.y) + sh.y);
        o.y = pack_bf2(v[i].z * rstd2 * (1.f + sc.z) + sh.z, v[i].w * rstd2 * (1.f + sc.w) + sh.w);
        *(uint2*)(hbuf + (size_t)row * D + col) = o;
      }
    }
  }
}

template <class Epi>
DEV void gemm_phase(const Params& p, const Ctx& cx, const bf16_t* __restrict__ A, const bf16_t* __restrict__ Bt, int K, int nM, int nN, char* smem, Epi epi) {
  const int tid = cx.tid, lane = tid & 63, wid = tid >> 6;
  const int wr = wid >> 2, wc = wid & 3, fr = lane & 15, fq = lane >> 4;
  const int nt = K / 64;
  const int ntiles = nM * nN;
  const int srow = tid >> 3, sc16 = tid & 7;
  const int nxcd = (cx.nblk & 7) == 0 ? 8 : 1;
  const int xcd = cx.bid % nxcd, xidx = cx.bid / nxcd, xper = cx.nblk / nxcd;
  const int t_lo = (int)(((long)ntiles * xcd) / nxcd), t_hi = (int)(((long)ntiles * (xcd + 1)) / nxcd);
  for (int tt = t_lo + xidx; tt < t_hi; tt += xper) {
    const int band = tt / (16 * nN);
    const int brows = min(16, nM - band * 16);
    const int rem = tt - band * 16 * nN;
    const int pn = rem / brows, pm = band * 16 + rem % brows;
    const int brow = pm * 256, bcol = pn * 256;
    const char* Ab = (const char*)(A + (size_t)brow * K);
    const char* Bb = (const char*)(Bt + (size_t)bcol * K);
    const unsigned voff = (unsigned)(srow * K + sc16 * 8) * 2u;
    const size_t rs = (size_t)64 * K * 2;
    f32x4 acc[8][4];
#pragma unroll
    for (int i = 0; i < 8; ++i)
#pragma unroll
      for (int j = 0; j < 4; ++j) acc[i][j] = f32x4{0.f, 0.f, 0.f, 0.f};
    uint4 ra0, ra1, ra2, ra3, rb0, rb1, rb2, rb3;
#define G_LD(ko) { const char* a_ = Ab + (size_t)(ko) * 2; const char* b_ = Bb + (size_t)(ko) * 2; \
                 ra0 = *(const uint4*)(a_ + voff); ra1 = *(const uint4*)(a_ + rs + voff); ra2 = *(const uint4*)(a_ + 2 * rs + voff); ra3 = *(const uint4*)(a_ + 3 * rs + voff); \
                 rb0 = *(const uint4*)(b_ + voff); rb1 = *(const uint4*)(b_ + rs + voff); rb2 = *(const uint4*)(b_ + 2 * rs + voff); rb3 = *(const uint4*)(b_ + 3 * rs + voff); }
#define G_ST(sp) { *(uint4*)(sp) = ra0; *(uint4*)((sp) + 64 * 144) = ra1; *(uint4*)((sp) + 128 * 144) = ra2; *(uint4*)((sp) + 192 * 144) = ra3; \
                 *(uint4*)((sp) + 36864) = rb0; *(uint4*)((sp) + 36864 + 64 * 144) = rb1; *(uint4*)((sp) + 36864 + 128 * 144) = rb2; *(uint4*)((sp) + 36864 + 192 * 144) = rb3; }
    char* const sbase = smem + srow * 144 + sc16 * 16;
    G_LD(0);
    G_ST(sbase);
    if (nt > 1) G_LD(64);
    for (int kt = 0; kt < nt; ++kt) {
      __syncthreads();
      if (kt + 1 < nt) { char* s1 = sbase + ((kt + 1) & 1) * 73728; G_ST(s1); }
      if (kt + 2 < nt) G_LD((kt + 2) * 64);
      const char* As = smem + (kt & 1) * 73728;
      const char* Bs = As + 36864;
#pragma unroll
      for (int kh = 0; kh < 2; ++kh) {
        bf16x8 bfr[4];
#pragma unroll
        for (int jn = 0; jn < 4; ++jn) bfr[jn] = *(const bf16x8*)(Bs + (wc * 64 + jn * 16 + fr) * 144 + kh * 64 + fq * 16);
#pragma unroll
        for (int i = 0; i < 8; ++i) {
          bf16x8 af = *(const bf16x8*)(As + (wr * 128 + i * 16 + fr) * 144 + kh * 64 + fq * 16);
#pragma unroll
          for (int jn = 0; jn < 4; ++jn) acc[i][jn] = __builtin_amdgcn_mfma_f32_16x16x32_f16(bfr[jn], af, acc[i][jn], 0, 0, 0);
        }
      }
    }
    __syncthreads();
#pragma unroll
    for (int i = 0; i < 8; ++i)
#pragma unroll
      for (int jn = 0; jn < 4; ++jn) epi(brow + wr * 128 + i * 16 + fr, bcol + wc * 64 + jn * 16 + fq * 4, acc[i][jn]);
  }
}

#define LAS3 __attribute__((address_space(3)))
DEV int g2_lds_byte(int r, int c) { const int st = (r >> 4) * 2 + (c >> 5), rr = r & 15, cc = c & 31, ob = rr * 64 + cc * 2; return st * 1024 + (ob ^ (((ob >> 9) & 1) << 5)); }
DEV void g2_stage_rc(int b, int& R, int& C) { const int st = b / 1024, sb = b % 1024, swz = sb ^ (((sb >> 9) & 1) << 5); R = (st >> 1) * 16 + swz / 64; C = (st & 1) * 32 + (swz % 64) / 2; }

template <class Epi>
DEV void gemm_phase2(const Params& p, const Ctx& cx, const bf16_t* __restrict__ A, const bf16_t* __restrict__ Bt, int K, int nM, int nN, char* smem, Epi epi) {
  constexpr int HTB = 128 * 64 * 2;
  LAS3 unsigned char* lds = (LAS3 unsigned char*)smem;
  const int tid = cx.tid, wid = __builtin_amdgcn_readfirstlane(tid >> 6), lane = tid & 63, wr = wid >> 2, wc = wid & 3, fr = lane & 15, fq = lane >> 4;
  const int nt = K / 64;
  const int ntiles = nM * nN;
  const int nxcd = (cx.nblk & 7) == 0 ? 8 : 1;
  const int xcd = cx.bid % nxcd, xidx = cx.bid / nxcd, xper = cx.nblk / nxcd;
  const int t_lo = (int)(((long)ntiles * xcd) / nxcd), t_hi = (int)(((long)ntiles * (xcd + 1)) / nxcd);
  auto unit_at = [&](int i, int& pm, int& pn) -> bool {
    const int tt = t_lo + xidx + i * xper;
    if (tt >= t_hi) return false;
    const int band = tt / (8 * nN);
    const int brows = min(8, nM - band * 8);
    const int rem = tt - band * 8 * nN;
    pn = rem / brows; pm = band * 8 + rem % brows;
    return true;
  };
  unsigned voffA[2], voffB[2];
#pragma unroll
  for (int i = 0; i < 2; ++i) {
    int R, C; g2_stage_rc(tid * 16 + i * 8192, R, C);
    const int rho = R & 31, Rb = (R & ~31) + 8 * ((rho & 15) >> 2) + 4 * (rho >> 4) + (rho & 3);
    voffA[i] = (unsigned)(R * K + C) * 2u; voffB[i] = (unsigned)(Rb * K + C) * 2u;
  }
  const size_t kstep = (size_t)(64 * 2);
  const size_t hstep = (size_t)128 * K * 2;
  const size_t tstep = 2 * hstep;
  const unsigned ldsw = (unsigned)wid * 1024u;
  const int aoff = g2_lds_byte(wr * 64 + fr, fq * 8), boff = g2_lds_byte(wc * 32 + fr, fq * 8);
#define G2_SA(b, h) (((b) * 2 + (h)) * HTB)
#define G2_SB(b, h) ((4 + (b) * 2 + (h)) * HTB)
#define G2_STAGE_(bufoff, gbase, vo_) do { _Pragma("unroll") for (int _i = 0; _i < 2; ++_i) \
    __builtin_amdgcn_global_load_lds((const unsigned*)((const char*)(gbase) + vo_[_i]), (LAS3 unsigned*)(lds + (bufoff) + ldsw + _i * 8192), 16, 0, 0); } while (0)
#define G2_STAGE(bufoff, gbase) G2_STAGE_(bufoff, gbase, voffA)
#define G2_STAGEB(bufoff, gbase) G2_STAGE_(bufoff, gbase, voffB)
#define G2_LDA(dst, b, h) do { _Pragma("unroll") for (int m = 0; m < 4; ++m) _Pragma("unroll") for (int k = 0; k < 2; ++k) dst[m][k] = *(const LAS3 bf16x8*)(lds + G2_SA(b, h) + aoff + m * 2048 + k * 1024); } while (0)
#define G2_LDB(dst, b, h) do { _Pragma("unroll") for (int n = 0; n < 2; ++n) _Pragma("unroll") for (int k = 0; k < 2; ++k) dst[n][k] = *(const LAS3 bf16x8*)(lds + G2_SB(b, h) + boff + n * 2048 + k * 1024); } while (0)
#define G2_MMA(ai, bj, At_, Bt_) do { __builtin_amdgcn_s_setprio(1); _Pragma("unroll") for (int m = 0; m < 4; ++m) _Pragma("unroll") for (int n = 0; n < 2; ++n) _Pragma("unroll") for (int k = 0; k < 2; ++k) \
    acc[ai][bj][m][n] = __builtin_amdgcn_mfma_f32_16x16x32_f16(Bt_[n][k], At_[m][k], acc[ai][bj][m][n], 0, 0, 0); __builtin_amdgcn_s_setprio(0); } while (0)
#define G2_WAIT_V(n) asm volatile("s_waitcnt vmcnt(" #n ")" ::: "memory")
#define G2_WAIT_L(n) asm volatile("s_waitcnt lgkmcnt(" #n ")" ::: "memory")
#define G2_BAR __builtin_amdgcn_s_barrier()
#define G2_SCHED __builtin_amdgcn_sched_barrier(0)
  int cpm, cpn, npm = 0, npn = 0, ui = 0;
  if (!unit_at(0, cpm, cpn)) return;
  f32x4 acc[2][2][4][2];
#pragma unroll
  for (int a = 0; a < 2; ++a)
#pragma unroll
    for (int b = 0; b < 2; ++b)
#pragma unroll
      for (int m = 0; m < 4; ++m)
#pragma unroll
        for (int n = 0; n < 2; ++n) acc[a][b][m][n] = f32x4{0.f, 0.f, 0.f, 0.f};
  bf16x8 At[4][2], B0[2][2], B1[2][2];
  const char* cA = (const char*)A + (size_t)cpm * tstep;
  const char* cB = (const char*)Bt + (size_t)cpn * tstep;
  G2_STAGEB(G2_SB(0, 0), cB); G2_STAGE(G2_SA(0, 0), cA); G2_STAGEB(G2_SB(0, 1), cB + hstep); G2_STAGE(G2_SA(0, 1), cA + hstep);
  if (wr == 1) G2_BAR;
  G2_WAIT_V(4); G2_BAR;
  G2_STAGEB(G2_SB(1, 0), cB + kstep); G2_STAGE(G2_SA(1, 0), cA + kstep); G2_STAGEB(G2_SB(1, 1), cB + hstep + kstep);
  G2_WAIT_V(6); G2_BAR;
  for (;;) {
    const bool has_next = unit_at(ui + 1, npm, npn);
    const char* nA = has_next ? (const char*)A + (size_t)npm * tstep : cA;
    const char* nB = has_next ? (const char*)Bt + (size_t)npn * tstep : cB;
    for (int t = 0; t < nt; t += 2) {
      const bool last = (t == nt - 2);
      const char* a1 = cA + (size_t)(t + 1) * kstep;
      const char* a2 = last ? nA : cA + (size_t)(t + 2) * kstep;
      const char* b2 = last ? nB : cB + (size_t)(t + 2) * kstep;
      const char* a3 = a2 + kstep;
      const char* b3 = b2 + kstep;
      G2_LDB(B0, 0, 0); G2_SCHED; G2_LDA(At, 0, 0); G2_STAGE(G2_SA(1, 1), a1 + hstep);
      G2_WAIT_L(8); G2_BAR; G2_WAIT_L(0); G2_MMA(0, 0, At, B0); G2_BAR; G2_SCHED;
      G2_LDB(B1, 0, 1); G2_STAGEB(G2_SB(0, 0), b2);
      G2_BAR; G2_WAIT_L(0); G2_MMA(0, 1, At, B1); G2_BAR;
      G2_LDA(At, 0, 1); G2_STAGE(G2_SA(0, 0), a2);
      G2_BAR; G2_WAIT_L(0); G2_MMA(1, 0, At, B0); G2_BAR; G2_SCHED;
      G2_STAGEB(G2_SB(0, 1), b2 + hstep);
      G2_WAIT_V(6); G2_BAR; G2_MMA(1, 1, At, B1); G2_BAR;
      G2_LDB(B0, 1, 0); G2_SCHED; G2_LDA(At, 1, 0); G2_STAGE(G2_SA(0, 1), a2 + hstep);
      G2_WAIT_L(8); G2_BAR; G2_WAIT_L(0); G2_MMA(0, 0, At, B0); G2_BAR; G2_SCHED;
      G2_LDB(B1, 1, 1); G2_STAGEB(G2_SB(1, 0), b3);
      G2_BAR; G2_WAIT_L(0); G2_MMA(0, 1, At, B1); G2_BAR;
      G2_LDA(At, 1, 1); G2_STAGE(G2_SA(1, 0), a3);
      G2_BAR; G2_WAIT_L(0); G2_MMA(1, 0, At, B0); G2_BAR; G2_SCHED;
      G2_STAGEB(G2_SB(1, 1), b3 + hstep);
      G2_WAIT_V(6); G2_BAR; G2_MMA(1, 1, At, B1); G2_BAR;
    }
    {
      const int row0 = cpm * 256 + wr * 64 + fr, col0 = cpn * 256 + wc * 32 + 8 * fq;
#pragma unroll
      for (int ai = 0; ai < 2; ++ai)
#pragma unroll
        for (int m = 0; m < 4; ++m)
#pragma unroll
          for (int bj = 0; bj < 2; ++bj) epi(row0 + ai * 128 + m * 16, col0 + bj * 128, acc[ai][bj][m][0], acc[ai][bj][m][1]);
    }
    if (!has_next) break;
#pragma unroll
    for (int a = 0; a < 2; ++a)
#pragma unroll
      for (int b = 0; b < 2; ++b)
#pragma unroll
        for (int m = 0; m < 4; ++m)
#pragma unroll
          for (int n = 0; n < 2; ++n) acc[a][b][m][n] = f32x4{0.f, 0.f, 0.f, 0.f};
    cpm = npm; cpn = npn; cA = nA; cB = nB; ++ui;
  }
  G2_WAIT_V(0);
  if (wr == 0) G2_BAR;
  G2_BAR;
#undef G2_SA
#undef G2_SB
#undef G2_STAGE
#undef G2_STAGEB
#undef G2_STAGE_
#undef G2_LDA
#undef G2_LDB
#undef G2_MMA
#undef G2_WAIT_V
#undef G2_WAIT_L
#undef G2_BAR
#undef G2_SCHED
}

template <int K, int NT, class Epi>
DEV void small_gemm(const Params& p, const Ctx& cx, const char* As, int astride, const bf16_t* __restrict__ Bt, int n0, Epi epi) {
  const int lane = cx.tid & 63, fr = lane & 15, fq = lane >> 4;
  f32x4 acc[4][NT];
#pragma unroll
  for (int i = 0; i < 4; ++i)
#pragma unroll
    for (int j = 0; j < NT; ++j) acc[i][j] = f32x4{0.f, 0.f, 0.f, 0.f};
#pragma unroll 2
  for (int k0 = 0; k0 < K; k0 += 32) {
    bf16x8 af[4];
#pragma unroll
    for (int i = 0; i < 4; ++i) af[i] = *(const bf16x8*)(As + (i * 16 + fr) * astride + (k0 + fq * 8) * 2);
#pragma unroll
    for (int jn = 0; jn < NT; ++jn) {
      bf16x8 bf = *(const bf16x8*)(Bt + (size_t)(n0 + jn * 16 + fr) * K + k0 + fq * 8);
#pragma unroll
      for (int i = 0; i < 4; ++i) acc[i][jn] = __builtin_amdgcn_mfma_f32_16x16x32_f16(bf, af[i], acc[i][jn], 0, 0, 0);
    }
  }
#pragma unroll
  for (int i = 0; i < 4; ++i)
#pragma unroll
    for (int jn = 0; jn < NT; ++jn) epi(i * 16 + fr, n0 + jn * 16 + fq * 4, acc[i][jn]);
}

struct S5P { float ar, ai, br, bi; };
DEV S5P s5_params(const Params& p, const Ctx& cx, int l, int d, int g, int lane) {
  int idx = ((l * 2 + d) * 32 + g) * 64 + lane;
  float lr = fminf(p.s5_lam_re[idx], -1e-4f), li = p.s5_lam_im[idx];
  float step = expf(p.s5_log_step[(l * 2 + d) * 32 + g]);
  float xr = lr * step, xi = li * step;
  float e = expf(xr), cs = cosf(xi), sn = sinf(xi);
  S5P r;
  r.ar = e * cs; r.ai = e * sn;
  float sh = sinf(0.5f * xi);
  float nr = expm1f(xr) * cs - 2.f * sh * sh, ni = e * sn;
  float inv = 1.f / (lr * lr + li * li);
  r.br = (nr * lr + ni * li) * inv;
  r.bi = (ni * lr - nr * li) * inv;
  return r;
}

DEV void s5_load_u(const h16* zrest, int rowbase, int g, char* ulds, int lane) {
#pragma unroll
  for (int i = 0; i < 8; ++i) {
    int e = i * 64 + lane;
    int r = e >> 1, hf = e & 1;
    uint4 v = *(const uint4*)(zrest + (size_t)(rowbase + r) * ZR + g * 16 + hf * 8);
    *(uint4*)(ulds + r * 32 + hf * 16) = v;
  }
  lds_fence();
}

DEV int s5_rowbase(int b, int c) { return c == 0 ? NLAT + b * 256 : b * 16384 + (c - 1) * 256; }

DEV void s5_pass1_unit(const Params& p, const Ctx& cx, int l, int unit, char* wl, int lane) {
  int c = unit % 65, bg = unit / 65, g = bg & 31, b = bg >> 5;
  const h16* zrest = (const h16*)(p.ws + OFF_ZREST);
  float2* F = (float2*)(p.ws + OFF_S5F);
  s5_load_u(zrest, s5_rowbase(b, c), g, wl, lane);
  float Br[16], Bi[16];
  {
    const float* pr = p.s5_b_re + ((size_t)(l * 32 + g) * 64 + lane) * 16;
    const float* pi = p.s5_b_im + ((size_t)(l * 32 + g) * 64 + lane) * 16;
#pragma unroll
    for (int i = 0; i < 16; i += 4) {
      float4 a = *(const float4*)(pr + i), bq = *(const float4*)(pi + i);
      Br[i] = a.x; Br[i + 1] = a.y; Br[i + 2] = a.z; Br[i + 3] = a.w;
      Bi[i] = bq.x; Bi[i + 1] = bq.y; Bi[i + 2] = bq.z; Bi[i + 3] = bq.w;
    }
  }
  S5P pf = s5_params(p, cx, l, 0, g, lane), pb = s5_params(p, cx, l, 1, g, lane);
  float xr = 0, xi = 0, yr = 0, yi = 0, pwr = 1.f, pwi = 0.f;
#pragma unroll 4
  for (int t = 0; t < 256; ++t) {
    h16x8 u0 = *(const h16x8*)(wl + t * 32), u1 = *(const h16x8*)(wl + t * 32 + 16);
    float br = 0, bi = 0;
#pragma unroll
    for (int i = 0; i < 8; ++i) { float u = (float)u0[i]; br = fmaf(u, Br[i], br); bi = fmaf(u, Bi[i], bi); }
#pragma unroll
    for (int i = 0; i < 8; ++i) { float u = (float)u1[i]; br = fmaf(u, Br[8 + i], br); bi = fmaf(u, Bi[8 + i], bi); }
    float nxr = pf.ar * xr - pf.ai * xi + br, nxi = pf.ar * xi + pf.ai * xr + bi;
    xr = nxr; xi = nxi;
    yr += pwr * br - pwi * bi; yi += pwr * bi + pwi * br;
    float npr = pwr * pb.ar - pwi * pb.ai, npi = pwr * pb.ai + pwi * pb.ar;
    pwr = npr; pwi = npi;
  }
  size_t fi = (((size_t)(b * 32 + g) * 65 + c) * 2) * 64 + lane;
  F[fi] = make_float2(pf.br * xr - pf.bi * xi, pf.br * xi + pf.bi * xr);
  F[fi + 64] = make_float2(pb.br * yr - pb.bi * yi, pb.br * yi + pb.bi * yr);
}

DEV void s5_pass3_unit(const Params& p, const Ctx& cx, int l, int unit, char* wl, int lane) {
  int c = unit % 65, bg = unit / 65, g = bg & 31, b = bg >> 5;
  const int fr = lane & 15, fq = lane >> 4;
  const h16* zrest = (const h16*)(p.ws + OFF_ZREST);
  const float2* F = (const float2*)(p.ws + OFF_S5F);
  float* S5Y = (float*)(p.ws + OFF_S5Y);
  const int rowbase = s5_rowbase(b, c);
  char* ulds = wl;
  char* tile = wl + 8192;
  s5_load_u(zrest, rowbase, g, ulds, lane);
  float Br[16], Bi[16];
  {
    const float* pr = p.s5_b_re + ((size_t)(l * 32 + g) * 64 + lane) * 16;
    const float* pi = p.s5_b_im + ((size_t)(l * 32 + g) * 64 + lane) * 16;
#pragma unroll
    for (int i = 0; i < 16; i += 4) {
      float4 a = *(const float4*)(pr + i), bq = *(const float4*)(pi + i);
      Br[i] = a.x; Br[i + 1] = a.y; Br[i + 2] = a.z; Br[i + 3] = a.w;
      Bi[i] = bq.x; Bi[i + 1] = bq.y; Bi[i + 2] = bq.z; Bi[i + 3] = bq.w;
    }
  }
  const float dsk = p.s5_d[(size_t)l * 512 + g * 16 + fr];
  const size_t fbase = ((size_t)(b * 32 + g) * 65) * 2 * 64 + lane;
#pragma unroll 1
  for (int d = 0; d < 2; ++d) {
    S5P pp = s5_params(p, cx, l, d, g, lane);
    float qr = pp.ar, qi = pp.ai;
#pragma unroll
    for (int i = 0; i < 8; ++i) { float t = qr * qr - qi * qi; qi = 2.f * qr * qi; qr = t; }
    float xr = 0, xi = 0;
    if (d == 0) {
      for (int cc = 0; cc < c; ++cc) {
        float2 f = F[fbase + (size_t)(cc * 2 + 0) * 64];
        float t = qr * xr - qi * xi + f.x; xi = qr * xi + qi * xr + f.y; xr = t;
      }
    } else if (c > 0) {
      float2 f0 = F[fbase + (size_t)(0 * 2 + 1) * 64];
      xr = f0.x; xi = f0.y;
      for (int cc = 64; cc > c; --cc) {
        float2 f = F[fbase + (size_t)(cc * 2 + 1) * 64];
        float t = qr * xr - qi * xi + f.x; xi = qr * xi + qi * xr + f.y; xr = t;
      }
    }
    bf16x8 chi[4], clo[4];
    {
      const float* cr = p.s5_c_re + ((size_t)((l * 2 + d) * 32 + g) * 16 + fr) * 64;
      const float* ci = p.s5_c_im + ((size_t)((l * 2 + d) * 32 + g) * 16 + fr) * 64;
#pragma unroll
      for (int ks = 0; ks < 4; ++ks) {
        float4 a = *(const float4*)(cr + ks * 16 + fq * 4), bq = *(const float4*)(ci + ks * 16 + fq * 4);
        float vals[8] = {a.x, -bq.x, a.y, -bq.y, a.z, -bq.z, a.w, -bq.w};
#pragma unroll
        for (int j = 0; j < 8; ++j) {
          h16 hh = (h16)vals[j];
          chi[ks][j] = hh;
          clo[ks][j] = (h16)(vals[j] - (float)hh);
        }
      }
    }
#pragma unroll 1
    for (int sb = 0; sb < 16; ++sb) {
      const int sub = d == 0 ? sb : 15 - sb;
#pragma unroll 4
      for (int q = 0; q < 16; ++q) {
        const int tt = d == 0 ? q : 15 - q;
        const int t = sub * 16 + tt;
        h16x8 u0 = *(const h16x8*)(ulds + t * 32), u1 = *(const h16x8*)(ulds + t * 32 + 16);
        float br = 0, bi = 0;
#pragma unroll
        for (int i = 0; i < 8; ++i) { float u = (float)u0[i]; br = fmaf(u, Br[i], br); bi = fmaf(u, Bi[i], bi); }
#pragma unroll
        for (int i = 0; i < 8; ++i) { float u = (float)u1[i]; br = fmaf(u, Br[8 + i], br); bi = fmaf(u, Bi[8 + i], bi); }
        float vr = pp.br * br - pp.bi * bi, vi = pp.br * bi + pp.bi * br;
        float nxr = pp.ar * xr - pp.ai * xi + vr, nxi = pp.ar * xi + pp.ai * xr + vi;
        xr = nxr; xi = nxi;
        h16x2 hv2 = {(h16)xr, (h16)xi};
        *(unsigned*)(tile + tt * 272 + lane * 4) = __builtin_bit_cast(unsigned, hv2);
      }
      lds_fence();
      f32x4 acc = f32x4{0.f, 0.f, 0.f, 0.f};
#pragma unroll
      for (int ks = 0; ks < 4; ++ks) {
        bf16x8 ah = *(const bf16x8*)(tile + fr * 272 + ks * 64 + fq * 16);
        acc = __builtin_amdgcn_mfma_f32_16x16x32_f16(ah, chi[ks], acc, 0, 0, 0);
        acc = __builtin_amdgcn_mfma_f32_16x16x32_f16(ah, clo[ks], acc, 0, 0, 0);
      }
      lds_fence();
#pragma unroll
      for (int r = 0; r < 4; ++r) {
        int tl = sub * 16 + fq * 4 + r;
        float* yp = S5Y + (size_t)(rowbase + tl) * 512 + g * 16 + fr;
        if (d == 0) {
          float u = (float)*(const h16*)(ulds + tl * 32 + fr * 2);
          *yp = acc[r] + dsk * u;
        } else {
          *yp = gelu_f(*yp + acc[r]);
        }
      }
    }
  }
}

DEV void prep_item(const Params& p, const Ctx& cx, int l, int item, char* smem) {
  const int tile = item >> 2, q = item & 3;
  const int row0 = tile * 64;
  const int tid = cx.tid;
  const h16* zc = (const h16*)(p.ws + OFF_REG2);
  h16* SC = (h16*)(p.ws + OFF_SCAN);
  const char* wt = p.ws + OFF_WT + (size_t)l * WT_SIZE;
  {
    const int d = q >> 1, isA = q & 1;
    const int coff = isA ? 3200 + d * 64 : 3072 + d * 64;
    int tok = tid >> 3, c8 = tid & 7;
    h16x8 cv = *(const h16x8*)(zc + (size_t)(row0 + tok) * ZC + coff + c8 * 8);
    float f[8];
#pragma unroll
    for (int j = 0; j < 8; ++j) { f[j] = (float)cv[j]; if (!isA) f[j] = tanh_f(f[j]); }
    uint4 o;
    o.x = pack_bf2(f[0], f[1]); o.y = pack_bf2(f[2], f[3]); o.z = pack_bf2(f[4], f[5]); o.w = pack_bf2(f[6], f[7]);
    *(uint4*)(smem + tok * 144 + c8 * 16) = o;
    __syncthreads();
    const bf16_t* Bt = (const bf16_t*)(wt + (isA ? WT_A2 : WT_W2)) + (size_t)d * 1024 * 64;
    const float* biasw = p.rwkv_w0 + (size_t)(l * 2 + d) * 1024;
    const float* biasa = p.rwkv_a0 + (size_t)(l * 2 + d) * 1024;
    h16* dst = SC + (size_t)(isA ? 4 + d : 6 + d) * ARR;
#pragma unroll 1
    for (int hf = 0; hf < 2; ++hf) small_gemm<64, 4>(p, cx, smem, 144, Bt, (tid >> 6) * 128 + hf * 64, [&](int m, int n, f32x4 v) {
      float4 bbw = *(const float4*)(biasw + n), bba = *(const float4*)(biasa + n);
      float4 bb = isA ? bba : bbw;
      float r0 = sigmoid_f(v[0] + bb.x), r1 = sigmoid_f(v[1] + bb.y), r2 = sigmoid_f(v[2] + bb.z), r3 = sigmoid_f(v[3] + bb.w);
      if (!isA) { r0 = __expf(-DECAY_SCALE * r0); r1 = __expf(-DECAY_SCALE * r1); r2 = __expf(-DECAY_SCALE * r2); r3 = __expf(-DECAY_SCALE * r3); }
      h16x4 o4 = {(h16)r0, (h16)r1, (h16)r2, (h16)r3};
      *(h16x4*)(dst + (size_t)(row0 + m) * 1024 + n) = o4;
    });
  }
  {
    const float* cw = p.conv_rkv + (size_t)l * 3 * 3072;
    const int grp = tid & 7, hh = (tid >> 3) & 3;
    const int c0 = (4 * q + hh) * 64 + grp * 8;
    float cwt[3][3][8];
#pragma unroll
    for (int s = 0; s < 3; ++s)
#pragma unroll
      for (int tp = 0; tp < 3; ++tp)
#pragma unroll
        for (int j = 0; j < 8; j += 4) {
          float4 a = *(const float4*)(cw + tp * 3072 + s * 1024 + c0 + j);
          cwt[s][tp][j] = a.x; cwt[s][tp][j + 1] = a.y; cwt[s][tp][j + 2] = a.z; cwt[s][tp][j + 3] = a.w;
        }
    float kkw[8];
#pragma unroll
    for (int j = 0; j < 8; j += 4) {
      float4 kq = *(const float4*)(p.rwkv_k_k + (size_t)l * 1024 + c0 + j);
      kkw[j] = kq.x; kkw[j + 1] = kq.y; kkw[j + 2] = kq.z; kkw[j + 3] = kq.w;
    }
#pragma unroll 1
    for (int it = 0; it < 4; ++it) {
      const int tok = (tid >> 5) + it * 16;
      const int row = row0 + tok;
      bool hasp, hasn;
      if (row < NLAT) { hasp = (row & 16383) != 0; hasn = (row & 16383) != 16383; }
      else { hasp = (row & 255) != 0; hasn = (row & 255) != 255; }
      const size_t off = (size_t)row * 1024 + c0;
      const h16* zp = zc + (size_t)row * ZC + c0;
      const h16* zpp = hasp ? zp - ZC : zp;
      const h16* zpn = hasn ? zp + ZC : zp;
      h16x8 cur[3], prv[3], nxt[3];
#pragma unroll
      for (int s = 0; s < 3; ++s) { cur[s] = *(const h16x8*)(zp + s * 1024); prv[s] = *(const h16x8*)(zpp + s * 1024); nxt[s] = *(const h16x8*)(zpn + s * 1024); }
      const float fp = hasp ? 1.f : 0.f, fn = hasn ? 1.f : 0.f;
      float kv[8];
#pragma unroll
      for (int s = 0; s < 3; ++s) {
        h16x8 o;
#pragma unroll
        for (int j = 0; j < 8; ++j) {
          float ov = cwt[s][0][j] * (fp * (float)prv[s][j]) + cwt[s][1][j] * (float)cur[s][j] + cwt[s][2][j] * (fn * (float)nxt[s][j]);
          o[j] = (h16)ov;
          if (s == 1) kv[j] = ov;
        }
        *(h16x8*)(SC + (size_t)s * ARR + off) = o;
      }
      float kk[8], ss = 0;
#pragma unroll
      for (int j = 0; j < 8; ++j) { kk[j] = kv[j] * kkw[j]; ss += kk[j] * kk[j]; }
      ss = allreduce8(ss);
      float inv = rcp_f(fmaxf(sqrtf(ss), 1e-12f));
      h16x8 o;
#pragma unroll
      for (int j = 0; j < 8; ++j) o[j] = (h16)(kk[j] * inv);
      *(h16x8*)(SC + 3 * ARR + off) = o;
    }
  }
}

DEV void phase_prep(const Params& p, const Ctx& cx0, int l, char* smem) {
  const int NPREP = 520 * 4, NS5 = 520;
  const Ctx& cx_ = cx0;
  for (int item = cx_.bid; item < NPREP + NS5; item += cx_.nblk) {
    __syncthreads();
    Ctx cx = cx0; asm volatile("" : "+v"(cx.tid));
    const int lane = cx.tid & 63, wid = cx.tid >> 6;
#ifndef NO_PREPITEM
    if (item < NPREP) prep_item(p, cx, l, item, smem);
    else
#endif
#ifndef NO_S5P1
      s5_pass1_unit(p, cx, l, (item - NPREP) * 8 + wid, smem + wid * 8192, lane);
#else
    {}
#endif
  }
}

typedef unsigned u2v __attribute__((ext_vector_type(2)));
struct RG { u2v w, a, kk, k, r; h16 v; };

constexpr int RW_NSLOT = 8, RW_SLOTB = 3072;
constexpr int RW_FLAGS = RW_NSLOT * RW_SLOTB;
constexpr int RW_NG = 16640 / 4;
typedef float f4v __attribute__((ext_vector_type(4)));

#define RW_RLO(gq, rlo)                                                            \
  {                                                                                \
    const int gg = (gq) < RW_NG ? (gq) : RW_NG - 1;                                \
    const int q0_ = gg * 4;                                                        \
    const int isl = q0_ >= 256;                                                    \
    const int base_ = isl ? b * 16384 : NLAT + b * 256;                            \
    const int t0_ = isl ? q0_ - 256 : q0_;                                         \
    const int last_ = isl ? 16383 : 255;                                           \
    rlo = base_ + (d ? last_ - t0_ - 3 : t0_);                                     \
  }

DEV void rwkv_helper(const Params& p, const Ctx& cx, int l, int unit, int lane, char* ring) {
  const int d = unit & 1, h = (unit >> 1) & 15, b = unit >> 5;
  const int j = lane >> 4, s = lane & 15;
  const h16* SC = (const h16*)(p.ws + OFF_SCAN);
  const char* pR = (const char*)(SC + 0 * ARR + h * 64);
  const char* pK = (const char*)(SC + 1 * ARR + h * 64);
  const char* pV = (const char*)(SC + 2 * ARR + h * 64);
  const char* pKK = (const char*)(SC + 3 * ARR + h * 64);
  const char* pA = (const char*)(SC + (size_t)(4 + d) * ARR + h * 64);
  const char* pW = (const char*)(SC + (size_t)(6 + d) * ARR + h * 64);
  const int jm = d ? 3 - j : j;
  const unsigned vo0 = (unsigned)(jm * 2048 + s * 8);
  f4v ka4, om4;
  {
    float4 t = *(const float4*)(p.rwkv_k_a + (size_t)l * 1024 + h * 64 + 4 * s);
    ka4 = f4v{t.x, t.y, t.z, t.w};
    om4 = 1.f - ka4;
  }
  struct RGH { u2v w, a, kk, k, r, v; };
  RGH q0, q1, q2, q3, q4, q5, q6, q7;
  const unsigned wofs = (unsigned)(j * 128 + s * 8);
  const unsigned vwofs = (unsigned)(2560 + j * 128 + s * 8);
  LAS3 volatile int* pflag = (LAS3 volatile int*)(ring + RW_FLAGS);
  LAS3 volatile int* cflag = (LAS3 volatile int*)(ring + RW_FLAGS + 64);
  int cmin = 0;
#define CV4(uv) __builtin_convertvector(__builtin_bit_cast(h16x4, uv), f4v)
#define RH_LOAD(q, gq)                                                             \
  {                                                                                \
    int rlo; RW_RLO(gq, rlo);                                                      \
    unsigned vo = vo0; asm volatile("" : "+v"(vo));                                \
    const size_t off = (size_t)rlo * 2048;                                         \
    q.w = *(const u2v*)(pW + off + vo); q.a = *(const u2v*)(pA + off + vo);        \
    q.kk = *(const u2v*)(pKK + off + vo); q.k = *(const u2v*)(pK + off + vo);      \
    q.r = *(const u2v*)(pR + off + vo); q.v = *(const u2v*)(pV + off + vo);        \
  }
#define RH_STEP(q, gq)                                                             \
  {                                                                                \
    if ((gq) >= RW_NSLOT && cmin < (gq) - RW_NSLOT + 1) {                          \
      do {                                                                         \
        const int c0_ = cflag[0], c1_ = cflag[1], c2_ = cflag[2], c3_ = cflag[3];  \
        cmin = __builtin_amdgcn_readfirstlane(min(min(c0_, c1_), min(c2_, c3_)));  \
        if (cmin < (gq) - RW_NSLOT + 1) __builtin_amdgcn_s_sleep(1);               \
      } while (cmin < (gq) - RW_NSLOT + 1);                                        \
    }                                                                              \
    asm volatile("" ::: "memory");                                                 \
    char* sl = ring + ((gq) % RW_NSLOT) * RW_SLOTB;                                \
    const f4v a_ = CV4(q.a), kk_ = CV4(q.kk);                                      \
    const f4v kka_ = kk_ * a_, kd_ = CV4(q.k) * (a_ * ka4 + om4);                  \
    *(u2v*)(sl + 0 * 512 + wofs) = q.w;                                            \
    *(u2v*)(sl + 1 * 512 + wofs) = q.kk;                                           \
    *(u2v*)(sl + 2 * 512 + wofs) = __builtin_bit_cast(u2v, __builtin_convertvector(kka_, h16x4)); \
    *(u2v*)(sl + 3 * 512 + wofs) = __builtin_bit_cast(u2v, __builtin_convertvector(kd_, h16x4));  \
    *(u2v*)(sl + 4 * 512 + wofs) = q.r;                                            \
    *(u2v*)(sl + vwofs) = q.v;                                                     \
    asm volatile("s_waitcnt lgkmcnt(0)" ::: "memory");     \
    *pflag = (gq) + 1;                                                             \
  }
  RH_LOAD(q0, 0); RH_LOAD(q1, 1); RH_LOAD(q2, 2); RH_LOAD(q3, 3); RH_LOAD(q4, 4); RH_LOAD(q5, 5); RH_LOAD(q6, 6); RH_LOAD(q7, 7);
#pragma unroll 1
  for (int g = 0; g < RW_NG; g += 8) {
    RH_STEP(q0, g); RH_LOAD(q0, g + 8); __builtin_amdgcn_sched_barrier(0);
    RH_STEP(q1, g + 1); RH_LOAD(q1, g + 9); __builtin_amdgcn_sched_barrier(0);
    RH_STEP(q2, g + 2); RH_LOAD(q2, g + 10); __builtin_amdgcn_sched_barrier(0);
    RH_STEP(q3, g + 3); RH_LOAD(q3, g + 11); __builtin_amdgcn_sched_barrier(0);
    RH_STEP(q4, g + 4); RH_LOAD(q4, g + 12); __builtin_amdgcn_sched_barrier(0);
    RH_STEP(q5, g + 5); RH_LOAD(q5, g + 13); __builtin_amdgcn_sched_barrier(0);
    RH_STEP(q6, g + 6); RH_LOAD(q6, g + 14); __builtin_amdgcn_sched_barrier(0);
    RH_STEP(q7, g + 7); RH_LOAD(q7, g + 15); __builtin_amdgcn_sched_barrier(0);
  }
#undef RH_LOAD
#undef RH_STEP
#undef CV4
}

DEV void rwkv_consumer(const Params& p, const Ctx& cx, int l, int task, int lane, const char* ring, int widx) {
  const int unit = task >> 4, d = unit & 1, h = (unit >> 1) & 15, b = unit >> 5;
  const int j = lane >> 4, s = lane & 15;
  const int myrow = (task & 15) * 4 + j;
  char* pO = (char*)((h16*)(p.ws + OFF_REG2) + (size_t)d * ARR + h * 64);
  const int sm = d ? 3 - (s & 3) : (s & 3);
  const unsigned vov0 = (unsigned)(sm * 2048 + myrow * 2);
  const unsigned rofs = (unsigned)(s * 8);
  const unsigned vrofs = (unsigned)(2560 + myrow * 2);
  LAS3 volatile int* pflag = (LAS3 volatile int*)(ring + RW_FLAGS);
  LAS3 volatile int* cflag = (LAS3 volatile int*)(ring + RW_FLAGS + 64) + widx;
  float S0 = 0.f, S1 = 0.f, S2 = 0.f, S3 = 0.f;
  int pseen = 0;
  struct GD { u2v w[4], kk[4], kka[4], kd[4], r[4]; unsigned v[4]; };
  GD A, B;
#define RC_WAIT(gq) { if (pseen <= (gq)) { do { pseen = __builtin_amdgcn_readfirstlane(*pflag); if (pseen <= (gq)) __builtin_amdgcn_s_sleep(1); } while (pseen <= (gq)); } asm volatile("" ::: "memory"); }
#define RC_LOAD(G, gq)                                                             \
  {                                                                                \
    const char* sl = ring + ((gq) % RW_NSLOT) * RW_SLOTB;                          \
    _Pragma("unroll") for (int u = 0; u < 4; ++u) {                                \
      G.w[u] = *(const u2v*)(sl + 0 * 512 + u * 128 + rofs);                       \
      G.kk[u] = *(const u2v*)(sl + 1 * 512 + u * 128 + rofs);                      \
      G.kka[u] = *(const u2v*)(sl + 2 * 512 + u * 128 + rofs);                     \
      G.kd[u] = *(const u2v*)(sl + 3 * 512 + u * 128 + rofs);                      \
      G.r[u] = *(const u2v*)(sl + 4 * 512 + u * 128 + rofs);                       \
      G.v[u] = *(const unsigned short*)(sl + u * 128 + vrofs);                     \
    }                                                                              \
  }
#define RC_COMP(G, gq)                                                             \
  {                                                                                \
    float dres[4];                                                                 \
    _Pragma("unroll") for (int u = 0; u < 4; ++u) {                                \
        \
        \
      float ea, eb, x_, y_, t0, t1, t2, t3;                                        \
      asm("v_fma_mix_f32 %6, %0, %12, 0 op_sel:[0,0,0] op_sel_hi:[0,1,0]\n\t"      \
          "v_fma_mix_f32 %7, %2, %13, 0 op_sel:[0,0,0] op_sel_hi:[0,1,0]\n\t"      \
          "v_fma_mix_f32 %6, %1, %12, %6 op_sel:[0,1,0] op_sel_hi:[0,1,0]\n\t"     \
          "v_fma_mix_f32 %7, %3, %13, %7 op_sel:[0,1,0] op_sel_hi:[0,1,0]\n\t"     \
          "v_fma_mix_f32 %8, %22, %16, 0 op_sel:[0,0,0] op_sel_hi:[1,1,0]\n\t"     \
          "v_add_f32 %6, %6, %7\n\t"                                               \
          "v_fma_mix_f32 %9, %22, %16, 0 op_sel:[0,1,0] op_sel_hi:[1,1,0]\n\t"     \
          "v_fma_mix_f32 %10, %22, %17, 0 op_sel:[0,0,0] op_sel_hi:[1,1,0]\n\t"    \
          "v_add_f32_dpp %6, %6, %6 quad_perm:[1,0,3,2] row_mask:0xf bank_mask:0xf bound_ctrl:1\n\t" \
          "v_fma_mix_f32 %11, %22, %17, 0 op_sel:[0,1,0] op_sel_hi:[1,1,0]\n\t"    \
          "v_fma_mix_f32 %0, %0, %14, %8 op_sel:[0,0,0] op_sel_hi:[0,1,0]\n\t"     \
          "v_add_f32_dpp %6, %6, %6 quad_perm:[2,3,0,1] row_mask:0xf bank_mask:0xf bound_ctrl:1\n\t" \
          "v_fma_mix_f32 %1, %1, %14, %9 op_sel:[0,1,0] op_sel_hi:[0,1,0]\n\t"     \
          "v_fma_mix_f32 %2, %2, %15, %10 op_sel:[0,0,0] op_sel_hi:[0,1,0]\n\t"    \
          "v_add_f32_dpp %6, %6, %6 row_half_mirror row_mask:0xf bank_mask:0xf bound_ctrl:1\n\t" \
          "v_fma_mix_f32 %3, %3, %15, %11 op_sel:[0,1,0] op_sel_hi:[0,1,0]\n\t"    \
          "s_nop 0\n\t"                                                            \
          "v_add_f32_dpp %6, %6, %6 row_mirror row_mask:0xf bank_mask:0xf bound_ctrl:1\n\t" \
          "v_fma_mix_f32 %0, -%6, %18, %0 op_sel:[0,0,0] op_sel_hi:[0,1,0]\n\t"    \
          "v_fma_mix_f32 %1, -%6, %18, %1 op_sel:[0,1,0] op_sel_hi:[0,1,0]\n\t"    \
          "v_fma_mix_f32 %2, -%6, %19, %2 op_sel:[0,0,0] op_sel_hi:[0,1,0]\n\t"    \
          "v_fma_mix_f32 %3, -%6, %19, %3 op_sel:[0,1,0] op_sel_hi:[0,1,0]\n\t"    \
          "v_fma_mix_f32 %4, %0, %20, 0 op_sel:[0,0,0] op_sel_hi:[0,1,0]\n\t"      \
          "v_fma_mix_f32 %5, %2, %21, 0 op_sel:[0,0,0] op_sel_hi:[0,1,0]\n\t"      \
          "v_fma_mix_f32 %4, %1, %20, %4 op_sel:[0,1,0] op_sel_hi:[0,1,0]\n\t"     \
          "v_fma_mix_f32 %5, %3, %21, %5 op_sel:[0,1,0] op_sel_hi:[0,1,0]"         \
          : "+v"(S0), "+v"(S1), "+v"(S2), "+v"(S3), "=&v"(ea), "=&v"(eb), "=&v"(x_), "=&v"(y_),                     \
            "=&v"(t0), "=&v"(t1), "=&v"(t2), "=&v"(t3)                                                              \
          : "v"(G.kk[u].x), "v"(G.kk[u].y), "v"(G.w[u].x), "v"(G.w[u].y), "v"(G.kd[u].x), "v"(G.kd[u].y),           \
            "v"(G.kka[u].x), "v"(G.kka[u].y), "v"(G.r[u].x), "v"(G.r[u].y), "v"(G.v[u]));                           \
      dres[u] = ea + eb;     \
    }                                                                              \
    asm volatile("" ::: "memory");                                                 \
    *cflag = (gq) + 1;     \
    {                                                                              \
      int rlo; RW_RLO(gq, rlo);                                                    \
      unsigned vov = vov0; asm volatile("" : "+v"(vov));                           \
        \
      const bool p1_ = (s & 1) != 0, p2_ = (s & 2) != 0;                           \
      const float a_ = (p1_ ? dres[1] : dres[0]) + dpp_mov<0xB1>(p1_ ? dres[0] : dres[1]); \
      const float b_ = (p1_ ? dres[3] : dres[2]) + dpp_mov<0xB1>(p1_ ? dres[2] : dres[3]); \
      float val = (p2_ ? b_ : a_) + dpp_mov<0x4E>(p2_ ? a_ : b_);                  \
      val += dpp_mov<0x124>(val);                                                  \
      val += dpp_mov<0x128>(val);                                                  \
      *(h16*)(pO + (size_t)rlo * 2048 + vov) = (h16)val;                           \
    }                                                                              \
  }
  RC_WAIT(0); RC_LOAD(A, 0);
#pragma unroll 1
  for (int g = 0; g < RW_NG; g += 2) {
    RC_WAIT(g + 1); RC_LOAD(B, g + 1);
    RC_COMP(A, g);
    if (g + 2 < RW_NG) { RC_WAIT(g + 2); RC_LOAD(A, g + 2); }
    RC_COMP(B, g + 1);
  }
#undef RC_WAIT
#undef RC_LOAD
#undef RC_COMP
}
#undef RW_RLO

DEV void phase_scan(const Params& p, const Ctx& cx, int l, char* smem) {
  const int lane = cx.tid & 63, wid = __builtin_amdgcn_readfirstlane(cx.tid >> 6);
  for (int slot = cx.bid; slot < 256; slot += cx.nblk) {
    __syncthreads();
    if (wid == 4 && lane < 8) *(LAS3 volatile int*)(smem + RW_FLAGS + (lane == 0 ? 0 : 64 + (lane & 3) * 4)) = 0;
    __syncthreads();
    const int unit = slot & 63;
#ifndef NO_RWKV
    if (wid < 4) { __builtin_amdgcn_s_setprio(3); rwkv_consumer(p, cx, l, (unit << 4) | ((slot >> 6) << 2) | wid, lane, smem, wid); __builtin_amdgcn_s_setprio(0); }
    else if (wid == 4) { __builtin_amdgcn_s_setprio(1); rwkv_helper(p, cx, l, unit, lane, smem); __builtin_amdgcn_s_setprio(0); }
#endif
  }
  if (wid >= 5) {
    char* wl = smem + 32768 + (wid - 5) * 17408;
    for (int u = cx.bid * 3 + (wid - 5); u < 2 * 32 * 65; u += cx.nblk * 3) {
      if (l == 1 && (u % 65) == 0) continue;
#ifndef NO_S5P3
      s5_pass3_unit(p, cx, l, u, wl, lane);
#endif
    }
  }
}

DEV void pool_item(const Params& p, const Ctx& cx, int l, int item, char* smem) {
  const int tid = cx.tid;
  const h16* zrest = (const h16*)(p.ws + OFF_ZREST);
  bf16_t* ym = (bf16_t*)(p.ws + OFF_YM);
  const char* wt = p.ws + OFF_WT + (size_t)l * WT_SIZE;
  float* V = (float*)smem;
  char* At = smem + 43008;
  int g, rowout0, Lseq, p0, rlo, rhi, rstride, rowsrc0;
  if (item < 2048) {
    g = item & 3; int r = (item >> 2) & 255, b = item >> 10;
    int w = 2 << g;
    rlo = max(r - w / 2, 0); rhi = min(r + w / 2 - 1, 255);
    rowsrc0 = b * 16384; rstride = 64;
    rowout0 = b * 16384 + r * 64; Lseq = 64; p0 = 0;
  } else {
    int it = item - 2048;
    g = it & 3; int tq = (it >> 2) & 3, b = it >> 4;
    rlo = 0; rhi = 0; rowsrc0 = NLAT + b * 256; rstride = 0;
    rowout0 = NLAT + b * 256 + tq * 64; Lseq = 256; p0 = tq * 64;
  }
  const int w = 2 << g;
  const float invr = 1.f / (float)(rhi - rlo + 1);
  for (int unit = tid; unit < 80 * 16; unit += NTHREADS) {
    int lp = unit >> 4, ch8 = unit & 15;
    int pos = p0 - 8 + lp;
    float acc[8] = {0, 0, 0, 0, 0, 0, 0, 0};
    if (pos >= 0 && pos < Lseq) {
      const h16* bp = zrest + (size_t)(rowsrc0 + pos) * ZR + 1024 + g * 128 + ch8 * 8;
      const int nr = rhi - rlo + 1;
      for (int k0 = 0; k0 < nr; k0 += 4) {
        h16x8 v[4]; float wv[4];
#pragma unroll
        for (int i = 0; i < 4; ++i) {
          const int kk_ = min(k0 + i, nr - 1);
          wv[i] = (k0 + i < nr) ? 1.f : 0.f;
          v[i] = *(const h16x8*)(bp + (size_t)((rlo + kk_) * rstride) * ZR);
        }
#pragma unroll
        for (int i = 0; i < 4; ++i)
#pragma unroll
          for (int j = 0; j < 8; ++j) acc[j] += wv[i] * (float)v[i][j];
      }
    }
    float* vp = V + lp * 132 + ch8 * 8;
#pragma unroll
    for (int j = 0; j < 8; ++j) vp[j] = acc[j] * invr;
  }
  __syncthreads();
  for (int unit = tid; unit < 64 * 16; unit += NTHREADS) {
    int c = unit >> 4, ch8 = unit & 15;
    int pos = p0 + c;
    int lo = max(pos - w / 2, 0), hi = min(pos + w / 2 - 1, Lseq - 1);
    float acc[8] = {0, 0, 0, 0, 0, 0, 0, 0};
    for (int pp = lo; pp <= hi; ++pp) {
      const float* vp = V + (pp - p0 + 8) * 132 + ch8 * 8;
#pragma unroll
      for (int j = 0; j < 8; ++j) acc[j] += vp[j];
    }
    float invc = 1.f / (float)(hi - lo + 1);
    h16x8 uc = *(const h16x8*)(zrest + (size_t)(rowout0 + c) * ZR + 1024 + g * 128 + ch8 * 8);
    uint4 o;
    o.x = pack_bf2(acc[0] * invc - (float)uc[0], acc[1] * invc - (float)uc[1]);
    o.y = pack_bf2(acc[2] * invc - (float)uc[2], acc[3] * invc - (float)uc[3]);
    o.z = pack_bf2(acc[4] * invc - (float)uc[4], acc[5] * invc - (float)uc[5]);
    o.w = pack_bf2(acc[6] * invc - (float)uc[6], acc[7] * invc - (float)uc[7]);
    *(uint4*)(At + c * 272 + ch8 * 16) = o;
  }
  __syncthreads();
  const bf16_t* Bt = (const bf16_t*)(wt + WT_POOL) + (size_t)g * 128 * 128;
  const float* ps = p.pool_scale + (size_t)l * 512 + g * 128;
  small_gemm<128, 1>(p, cx, At, 272, Bt, (tid >> 6) * 16, [&](int m, int n, f32x4 v) {
    int row = rowout0 + m;
    float4 sc = *(const float4*)(ps + n);
    h16x4 gt = *(const h16x4*)(zrest + (size_t)row * ZR + 1536 + g * 128 + n);
    uint2 o;
    o.x = pack_bf2(v[0] * sc.x * silu_f((float)gt[0]), v[1] * sc.y * silu_f((float)gt[1]));
    o.y = pack_bf2(v[2] * sc.z * silu_f((float)gt[2]), v[3] * sc.w * silu_f((float)gt[3]));
    *(uint2*)(ym + (size_t)row * D + 512 + g * 128 + n) = o;
  });
}

DEV void glu_item(const Params& p, const Ctx& cx, int l, int tile, char* smem) {
  const int tid = cx.tid;
  const int row0 = tile * 64;
  const float* S5Y = (const float*)(p.ws + OFF_S5Y);
  const h16* zrest = (const h16*)(p.ws + OFF_ZREST);
  bf16_t* ym = (bf16_t*)(p.ws + OFF_YM);
  const char* wt = p.ws + OFF_WT + (size_t)l * WT_SIZE;
#pragma unroll
  for (int it = 0; it < 8; ++it) {
    int unit = tid + it * NTHREADS;
    int r = unit >> 6, c8 = unit & 63;
    const float* sp = S5Y + (size_t)(row0 + r) * 512 + c8 * 8;
    float4 a = *(const float4*)sp, bq = *(const float4*)(sp + 4);
    uint4 o;
    o.x = pack_bf2(a.x, a.y); o.y = pack_bf2(a.z, a.w); o.z = pack_bf2(bq.x, bq.y); o.w = pack_bf2(bq.z, bq.w);
    *(uint4*)(smem + r * 1040 + c8 * 16) = o;
  }
  __syncthreads();
  const bf16_t* Bt = (const bf16_t*)(wt + WT_GLU);
  const float* bg = p.b_glu + (size_t)l * 512;
  small_gemm<512, 4>(p, cx, smem, 1040, Bt, (tid >> 6) * 64, [&](int m, int n, f32x4 v) {
    int row = row0 + m;
    float4 y = *(const float4*)(S5Y + (size_t)row * 512 + n);
    float4 bb = *(const float4*)(bg + n);
    h16x4 gt = *(const h16x4*)(zrest + (size_t)row * ZR + 512 + n);
    uint2 o;
    o.x = pack_bf2(y.x * sigmoid_f(v[0] + bb.x) * silu_f((float)gt[0]), y.y * sigmoid_f(v[1] + bb.y) * silu_f((float)gt[1]));
    o.y = pack_bf2(y.z * sigmoid_f(v[2] + bb.z) * silu_f((float)gt[2]), y.w * sigmoid_f(v[3] + bb.w) * silu_f((float)gt[3]));
    *(uint2*)(ym + (size_t)row * D + n) = o;
  });
}

DEV void rwkvmerge_item(const Params& p, const Ctx& cx, int l, int tile) {
  const int tid = cx.tid;
  const int row0 = tile * 64;
  const h16* SC = (const h16*)(p.ws + OFF_SCAN);
  const h16* O = (const h16*)(p.ws + OFF_REG2);
  const h16* zrest = (const h16*)(p.ws + OFF_ZREST);
  bf16_t* ym = (bf16_t*)(p.ws + OFF_YM);
  const int grp = tid & 7, h = (tid >> 3) & 15;
  const int c0 = h * 64 + grp * 8;
  float pk[8], rk[8], gw[8], gb[8];
#pragma unroll
  for (int j = 0; j < 8; j += 4) {
    float4 t0 = *(const float4*)(p.rwkv_k_a + (size_t)l * 1024 + c0 + j), t1 = *(const float4*)(p.rwkv_r_k + (size_t)l * 1024 + c0 + j);
    float4 t2 = *(const float4*)(p.gn_w + (size_t)l * 1024 + c0 + j), t3 = *(const float4*)(p.gn_b + (size_t)l * 1024 + c0 + j);
    pk[j] = t0.x; pk[j + 1] = t0.y; pk[j + 2] = t0.z; pk[j + 3] = t0.w;
    rk[j] = t1.x; rk[j + 1] = t1.y; rk[j + 2] = t1.z; rk[j + 3] = t1.w;
    gw[j] = t2.x; gw[j + 1] = t2.y; gw[j + 2] = t2.z; gw[j + 3] = t2.w;
    gb[j] = t3.x; gb[j + 1] = t3.y; gb[j + 2] = t3.z; gb[j + 3] = t3.w;
  }
#pragma unroll 2
  for (int it = 0; it < 16; ++it) {
    const int tok = (tid >> 7) + it * 4;
    int row = row0 + tok;
    size_t off = (size_t)row * 1024 + c0;
    h16x8 of = *(const h16x8*)(O + off), ob = *(const h16x8*)(O + ARR + off);
    h16x8 r8 = *(const h16x8*)(SC + 0 * ARR + off), k8 = *(const h16x8*)(SC + 1 * ARR + off), v8 = *(const h16x8*)(SC + 2 * ARR + off);
    h16x8 af = *(const h16x8*)(SC + 4 * ARR + off), ab = *(const h16x8*)(SC + 5 * ARR + off);
    h16x8 gt = *(const h16x8*)(zrest + (size_t)row * ZR + 2048 + c0);
    float o[8], sm = 0;
#pragma unroll
    for (int j = 0; j < 8; ++j) { o[j] = (float)of[j] + (float)ob[j]; sm += o[j]; }
    sm = allreduce8(sm);
    float mu = sm * (1.f / 64.f), vq = 0;
#pragma unroll
    for (int j = 0; j < 8; ++j) { o[j] -= mu; vq += o[j] * o[j]; }
    vq = allreduce8(vq);
    float rstd = rsqrtf(vq * (1.f / 64.f) + 64e-5f);
    float part = 0;
#pragma unroll
    for (int j = 0; j < 8; ++j) {
      float ksum = (float)k8[j] * (2.f + ((float)af[j] + (float)ab[j] - 2.f) * pk[j]);
      part += (float)r8[j] * ksum * rk[j];
    }
    part = allreduce8(part);
    float res[8];
#pragma unroll
    for (int j = 0; j < 8; ++j) {
      float y = o[j] * rstd * gw[j] + gb[j] + part * (float)v8[j];
      res[j] = y * silu_f((float)gt[j]);
    }
    uint4 ov;
    ov.x = pack_bf2(res[0], res[1]); ov.y = pack_bf2(res[2], res[3]); ov.z = pack_bf2(res[4], res[5]); ov.w = pack_bf2(res[6], res[7]);
    *(uint4*)(ym + (size_t)row * D + 1024 + c0) = ov;
  }
}

DEV void phase_merge(const Params& p, const Ctx& cx0, int l, char* smem) {
  const int ntile = (l == 0) ? 520 : 512;
  const int npool = (l == 0) ? 2048 + 32 : 2048;
  const int total = npool + 2 * ntile;
  for (int item = cx0.bid; item < total; item += cx0.nblk) {
    __syncthreads();
    Ctx cx = cx0; asm volatile("" : "+v"(cx.tid));
    const int grp6 = item / 6, pos6 = item - grp6 * 6;
    if (pos6 < 4) pool_item(p, cx, l, grp6 * 4 + pos6, smem);
    else if (pos6 == 4) glu_item(p, cx, l, grp6, smem);
    else rwkvmerge_item(p, cx, l, grp6);
  }
}

#define XB_TMO      128
#define XB_XCNT(j)  (256  + 64 * (j))
#define XB_XSUB(j)  (1280 + 64 * (j))
#define XB_XGEN(j)  (2304 + 64 * (j))
#define XB_TOP      3328
#define XB_TOPGEN   3392
#define XCD_BAR_WORDS 3456
#define XB_SPIN_CAP (1u << 18)
DEV unsigned xb_ld(unsigned* p) { return __hip_atomic_load(p, __ATOMIC_RELAXED, __HIP_MEMORY_SCOPE_AGENT); }
DEV unsigned xb_add(unsigned* p, unsigned v) { return __hip_atomic_fetch_add(p, v, __ATOMIC_RELAXED, __HIP_MEMORY_SCOPE_AGENT); }
DEV unsigned xb_xcc_id() { return (unsigned)__builtin_amdgcn_s_getreg((3 << 11) | 20) & 0xFu; }
#define XB_SPIN(cond, bar) do { unsigned _sp = 0; while (cond) { __builtin_amdgcn_s_sleep(1); \
    if ((++_sp & 255u) == 0u) { if (xb_ld(&(bar)[XB_TMO])) break; if (_sp > XB_SPIN_CAP) { atomicAdd(&(bar)[XB_TMO], 1u); break; } } } } while (0)
struct XcdBarrier { unsigned* bar; unsigned x; volatile LAS3 unsigned* st; };
DEV XcdBarrier xcd_barrier_post(unsigned* bar, volatile LAS3 unsigned* st) {
  XcdBarrier b; b.bar = bar; b.x = xb_xcc_id(); b.st = st;
  if (threadIdx.x == 0) (void)xb_add(&bar[XB_XCNT(b.x)], 1u);
  return b;
}
DEV void xcd_barrier_complete(unsigned* bar, unsigned x, unsigned& nloc, unsigned& nx) {
  const unsigned G = gridDim.x * gridDim.y * gridDim.z;
  unsigned sum, cnt, mine, sp = 0u;
  for (;;) {
    sum = 0u; cnt = 0u; mine = 0u;
#pragma unroll
    for (unsigned j = 0; j < 16; ++j) { const unsigned c = xb_ld(&bar[XB_XCNT(j)]); sum += c; cnt += (c > 0u) ? 1u : 0u; mine = (j == x) ? c : mine; }
    if (sum == G) break;
    __builtin_amdgcn_s_sleep(1);
    if ((++sp & 255u) == 0u) { if (xb_ld(&bar[XB_TMO])) break; if (sp > XB_SPIN_CAP) { atomicAdd(&bar[XB_TMO], 1u); break; } }
  }
  nloc = mine > 0u ? mine : 1u; nx = cnt > 0u ? cnt : 1u;
}
DEV void xcd_barrier(const XcdBarrier& b) {
  asm volatile("s_waitcnt vmcnt(0)" ::: "memory");
  __syncthreads();
  if (threadIdx.x == 0) {
    unsigned* bar = b.bar;
    __builtin_amdgcn_s_waitcnt(0);
    unsigned nloc = b.st[0], nx = b.st[1];
    if (nloc == 0u) { xcd_barrier_complete(bar, b.x, nloc, nx); b.st[0] = nloc; b.st[1] = nx; }
    const unsigned old = xb_add(&bar[XB_XSUB(b.x)], 1u);
    const unsigned gen = old / nloc;
    if (old + 1u == (gen + 1u) * nloc) {
      __builtin_amdgcn_fence(__ATOMIC_RELEASE, "agent");
      asm volatile("s_waitcnt vmcnt(0)" ::: "memory");
      const unsigned og = xb_add(&bar[XB_TOP], 1u);
      const unsigned tg = og / nx;
      if (og + 1u == (tg + 1u) * nx) xb_add(&bar[XB_TOPGEN], 1u);
      else XB_SPIN(xb_ld(&bar[XB_TOPGEN]) == tg, bar);
      __builtin_amdgcn_fence(__ATOMIC_ACQUIRE, "agent");
      xb_add(&bar[XB_XGEN(b.x)], 1u);
      asm volatile("s_waitcnt vmcnt(0)" ::: "memory");
    } else {
      XB_SPIN(xb_ld(&bar[XB_XGEN(b.x)]) == gen, bar);
      __builtin_amdgcn_fence(__ATOMIC_ACQUIRE, "agent");
      asm volatile("s_waitcnt vmcnt(0)" ::: "memory");
    }
  }
  __syncthreads();
}

#define LCX Ctx c2 = cx; asm volatile("" : "+v"(c2.tid))
#ifndef GEMM_FN
#define GEMM_FN gemm_phase2
#endif
__global__ void __launch_bounds__(NTHREADS) mega_fwd(Params p, int ph0, int ph1) {
  extern __shared__ __attribute__((aligned(16))) char smem[];
  cg::grid_group grid = cg::this_grid();
  __shared__ uint4 xb_words;
  if (threadIdx.x == 0) xb_words = make_uint4(0u, 0u, 0u, 0u);
  __syncthreads();
  XcdBarrier xb; xb.bar = (unsigned*)(p.ws + OFF_BAR); xb.x = xb_xcc_id(); xb.st = (volatile LAS3 unsigned*)&xb_words;
  if (blockIdx.x == 0) for (int i = threadIdx.x; i < XCD_BAR_WORDS; i += NTHREADS) xb.bar[i] = 0u;
  const int wave_s = __builtin_amdgcn_readfirstlane((int)(threadIdx.x >> 6));
  for (int step = ph0; step < ph1; ++step) {
    if (step == ph0 + 1) { grid.sync(); if (threadIdx.x == 0) (void)xb_add(&xb.bar[XB_XCNT(xb.x)], 1u); } else if (step > ph0) xcd_barrier(xb);
    const int ph = (int)((PH_SEQ >> (4 * step)) & 15ull);
    Ctx cx;
    {
      int t_, b_ = blockIdx.x, n_ = gridDim.x;
      asm volatile("v_mbcnt_lo_u32_b32 %0, -1, 0\n\tv_mbcnt_hi_u32_b32 %0, -1, %0\n\tv_lshl_add_u32 %0, %1, 6, %0" : "=&v"(t_) : "s"(wave_s));
      asm volatile("" : "+s"(b_), "+s"(n_));
      cx.tid = t_; cx.bid = b_; cx.nblk = n_;
    }
    const int l = ph >= 8 ? 1 : 0;
    const int lp = ph >= 8 ? ph - 6 : ph;
#ifndef PHMASK
#define PHMASK 0xff
#endif
    if (ph == 0) { if (PHMASK & 1) { LCX; phase0(p, c2, smem); } }
    else if (ph == 1) { if (PHMASK & 2) { LCX; phase_adaln0(p, c2); } }
    else if (lp == 2 && (PHMASK & 4)) {
      LCX;
      h16* zrest = (h16*)(p.ws + OFF_ZREST);
      h16* zc = (h16*)(p.ws + OFF_REG2);
      GEMM_FN(p, c2, (const bf16_t*)(p.ws + OFF_H), (const bf16_t*)(p.ws + OFF_WT + (size_t)l * WT_SIZE + WT_IN), 2048, 130, 25, smem,
                 [&](int row, int col, f32x4 v, f32x4 u) {
                   h16* dst;
                   if (col < 2048) dst = zrest + (size_t)row * ZR + col;
                   else if (col < 5120) dst = zc + (size_t)row * ZC + (col - 2048);
                   else if (col < 6144) dst = zrest + (size_t)row * ZR + 2048 + (col - 5120);
                   else dst = zc + (size_t)row * ZC + 3072 + (col - 6144);
                   h16x8 o = {(h16)v[0], (h16)v[1], (h16)v[2], (h16)v[3], (h16)u[0], (h16)u[1], (h16)u[2], (h16)u[3]};
                   *(h16x8*)dst = o;
                 });
    } else if (lp == 3) { if (PHMASK & 8) { LCX; phase_prep(p, c2, l, smem); } }
    else if (lp == 4) { if (PHMASK & 16) { LCX; phase_scan(p, c2, l, smem); } }
    else if (lp == 5) { if (PHMASK & 32) { LCX; phase_merge(p, c2, l, smem); } }
    else if (lp == 6 && (PHMASK & 64)) {
      LCX;
      const float* mods = (const float*)(p.ws + OFF_MODS);
      float* prec = (float*)(p.ws + OFF_PREC);
      const float* xin = (l == 0) ? p.x : p.out;
      GEMM_FN(p, c2, (const bf16_t*)(p.ws + OFF_YM), (const bf16_t*)(p.ws + OFF_WT + (size_t)l * WT_SIZE + WT_OUT), 2048, l == 0 ? 130 : 128, 8, smem,
                 [&](int row, int col, f32x4 v, f32x4 u) {
                   const float* xr; const float* gr; float* dr;
                   if (row < NLAT) {
                     xr = xin + (size_t)row * D + col; gr = mods + (size_t)(l * 3 + (row >> 14)) * 6144 + 4096 + col; dr = p.out + (size_t)row * D + col;
                   } else {
                     xr = p.ctx + (size_t)(row - NLAT) * D + col; gr = mods + (size_t)(l * 3 + 2) * 6144 + 4096 + col; dr = prec + (size_t)(row - NLAT) * D + col;
                   }
                   const float4 x0 = *(const float4*)xr, x1 = *(const float4*)(xr + 4), g0 = *(const float4*)gr, g1 = *(const float4*)(gr + 4);
                   float4 r0, r1;
                   r0.x = ALPHA * x0.x + g0.x * v[0]; r0.y = ALPHA * x0.y + g0.y * v[1]; r0.z = ALPHA * x0.z + g0.z * v[2]; r0.w = ALPHA * x0.w + g0.w * v[3];
                   r1.x = ALPHA * x1.x + g1.x * u[0]; r1.y = ALPHA * x1.y + g1.y * u[1]; r1.z = ALPHA * x1.z + g1.z * u[2]; r1.w = ALPHA * x1.w + g1.w * u[3];
                   *(float4*)dr = r0; *(float4*)(dr + 4) = r1;
                 });
    } else if (lp == 7) { if (PHMASK & 128) { LCX; phase_finln(p, c2, l); } }
  }
}

constexpr int NPHASES = PH_NSTEPS;

extern "C" void kernel_launch(void* const* d_in, const int* in_sizes, int n_in, void* d_out, int out_size, void* d_ws, size_t ws_size,
                              hipStream_t stream) {
  static int grid_blocks = 0;
  if (grid_blocks == 0) {
    if (n_in != 32 || ws_size < WS_END) { fprintf(stderr, "kernel_launch: unexpected n_in %d / ws %zu (need %zu)\n", n_in, ws_size, (size_t)WS_END); grid_blocks = -1; return; }
    int dev = 0, cus = 0, per_cu = 0;
    hipGetDevice(&dev);
    hipDeviceGetAttribute(&cus, hipDeviceAttributeMultiprocessorCount, dev);
    if (hipFuncSetAttribute((const void*)mega_fwd, hipFuncAttributeMaxDynamicSharedMemorySize, LDS_BYTES) != hipSuccess) { fprintf(stderr, "hipFuncSetAttribute failed\n"); grid_blocks = -1; return; }
    if (hipOccupancyMaxActiveBlocksPerMultiprocessor(&per_cu, (const void*)mega_fwd, NTHREADS, LDS_BYTES) != hipSuccess || per_cu < 1) {
      fprintf(stderr, "occupancy query gave %d\n", per_cu); (void)hipGetLastError(); per_cu = 1;
    }
    grid_blocks = cus * per_cu;
  }
  if (grid_blocks < 0) return;
  Params p{};
  const float** pp = (const float**)&p;
  for (int i = 0; i < 32; ++i) pp[i] = (const float*)d_in[i];
  p.out = (float*)d_out;
  p.ws = (char*)d_ws;
  int ph0 = 0, ph1 = NPHASES;
  void* args[] = {&p, &ph0, &ph1};
  hipError_t e = hipLaunchCooperativeKernel((const void*)mega_fwd, dim3(grid_blocks), dim3(NTHREADS), args, LDS_BYTES, stream);
  if (e != hipSuccess) fprintf(stderr, "cooperative launch failed: %s (grid %d)\n", hipGetErrorString(e), grid_blocks);
}
```

```cpp
#include <hip/hip_runtime.h>
#include <hip/hip_cooperative_groups.h>
#include <cstdio>
namespace cg = cooperative_groups;

typedef unsigned short bf16_t;
typedef _Float16 h16;
using bf16x8 = __attribute__((ext_vector_type(8))) _Float16;
using f32x4 = __attribute__((ext_vector_type(4))) float;
using h16x4 = __attribute__((ext_vector_type(4))) _Float16;
using h16x8 = __attribute__((ext_vector_type(8))) _Float16;

#define DEV __device__ __forceinline__

constexpr int D = 2048, NLAT = 32768, MTOT = 33280, ZR = 3072, ZC = 3328;
constexpr int NTHREADS = 512;
constexpr int LDS_BYTES = 147456;
constexpr float ALPHA = 1.41421356237f;
constexpr float DECAY_SCALE = 0.606531f;

constexpr size_t al256(size_t x) { return (x + 255) & ~size_t(255); }
constexpr size_t ARR = (size_t)MTOT * 1024;
constexpr size_t OFF_MODS = 0;
constexpr size_t OFF_S5F = al256(OFF_MODS + 2 * 3 * 6144 * 4);
constexpr size_t OFF_PREC = al256(OFF_S5F + (size_t)2 * 32 * 65 * 2 * 64 * 8);
constexpr size_t OFF_WT = al256(OFF_PREC + (size_t)512 * 2048 * 4);
constexpr size_t WT_IN = 0, WT_OUT = 26214400, WT_W2 = 34603008, WT_A2 = 34865152, WT_POOL = 35127296, WT_GLU = 35258368, WT_SIZE = 35782656;
constexpr size_t OFF_ZREST = al256(OFF_WT + 2 * WT_SIZE);
constexpr size_t OFF_REG2 = al256(OFF_ZREST + (size_t)MTOT * ZR * 2);
constexpr size_t OFF_S5Y = OFF_REG2 + 2 * ARR * 2;
constexpr size_t OFF_SCAN = al256(OFF_REG2 + (size_t)MTOT * ZC * 2);
constexpr size_t OFF_H = OFF_SCAN;
constexpr size_t OFF_YM = OFF_SCAN + 6 * ARR * 2;
constexpr size_t OFF_BAR = al256(OFF_SCAN + 8 * ARR * 2);
constexpr size_t WS_END = OFF_BAR + 16384;

#ifndef PH_SEQ
#define PH_SEQ 0xDCBA9876543210ull
#define PH_NSTEPS 14
#endif
struct Params {
  const float *x, *c, *ctx, *c_ctx, *w_ada, *b_ada, *w_in, *conv_rkv, *s5_lam_re, *s5_lam_im, *s5_log_step,
      *s5_b_re, *s5_b_im, *s5_c_re, *s5_c_im, *s5_d, *w_glu, *b_glu, *w_pool, *pool_scale,
      *rwkv_w0, *rwkv_w2, *rwkv_a0, *rwkv_a2, *rwkv_k_k, *rwkv_k_a, *rwkv_r_k, *gn_w, *gn_b,
      *w_out, *ln_g, *ln_b;
  float* out;
  char* ws;
};
struct Ctx { int tid, bid, nblk; };

DEV float rcp_f(float x) { return __builtin_amdgcn_rcpf(x); }
DEV float sigmoid_f(float x) { return rcp_f(1.f + __expf(-x)); }
DEV float silu_f(float x) { return x * rcp_f(1.f + __expf(-x)); }
DEV float tanh_f(float x) { float e = __expf(2.f * x); return 1.f - 2.f * rcp_f(e + 1.f); }
DEV float gelu_f(float y) { return 0.5f * y * (1.f + tanh_f(0.7978845608f * (y + 0.044715f * y * y * y))); }
using h16x2 = __attribute__((ext_vector_type(2))) _Float16;
DEV unsigned pack_bf2(float a, float b) { h16x2 v = {(h16)a, (h16)b}; return __builtin_bit_cast(unsigned, v); }
template <int CTRL> DEV float dpp_mov(float v) {
  return __int_as_float(__builtin_amdgcn_update_dpp(0, __float_as_int(v), CTRL, 0xf, 0xf, true));
}
DEV float allreduce16(float v) {
  v += dpp_mov<0xB1>(v);
  v += dpp_mov<0x4E>(v);
  v += dpp_mov<0x141>(v);
  v += dpp_mov<0x140>(v);
  return v;
}
DEV float wave_sum(float v) {
  v = allreduce16(v);
  return __builtin_amdgcn_readlane(__float_as_int(v), 0) == 0 && false ? 0.f :
         __int_as_float(__builtin_amdgcn_readlane(__float_as_int(v), 0)) + __int_as_float(__builtin_amdgcn_readlane(__float_as_int(v), 16)) +
         __int_as_float(__builtin_amdgcn_readlane(__float_as_int(v), 32)) + __int_as_float(__builtin_amdgcn_readlane(__float_as_int(v), 48));
}
DEV float allreduce8(float v) {
  v += dpp_mov<0xB1>(v);
  v += dpp_mov<0x4E>(v);
  v += dpp_mov<0x141>(v);
  return v;
}
DEV void lds_fence() { asm volatile("s_waitcnt lgkmcnt(0)" ::: "memory"); }

DEV void p0_mods_item(const Params& p, const Ctx& cx, int item, char* smem) {
  float* red = (float*)smem;
  float* mods = (float*)(p.ws + OFF_MODS);
  int l = item / 96, chunk = item % 96;
  int tid = cx.tid, kq = tid >> 6, col = tid & 63;
  int n = chunk * 64 + col;
  const float* W = p.w_ada + (size_t)l * 2048 * 6144;
  float a0 = 0, a1 = 0, a2 = 0;
#pragma unroll 8
  for (int k = kq; k < 2048; k += 8) {
    float w = W[(size_t)k * 6144 + n];
    a0 += silu_f(p.c[k]) * w;
    a1 += silu_f(p.c[2048 + k]) * w;
    a2 += silu_f(p.c_ctx[k]) * w;
  }
  red[(kq * 3 + 0) * 64 + col] = a0;
  red[(kq * 3 + 1) * 64 + col] = a1;
  red[(kq * 3 + 2) * 64 + col] = a2;
  __syncthreads();
  if (tid < 192) {
    int r = tid >> 6, cc = tid & 63;
    float s = 0;
#pragma unroll
    for (int q = 0; q < 8; ++q) s += red[(q * 3 + r) * 64 + cc];
    mods[(size_t)(l * 3 + r) * 6144 + chunk * 64 + cc] = s + p.b_ada[(size_t)l * 6144 + chunk * 64 + cc];
  }
}

DEV void p0_transpose_tile(const Params& p, const Ctx& cx, const float* __restrict__ src, bf16_t* __restrict__ dst, int K, int N, int tk, int tn, char* smem) {
  float* T = (float*)smem;
  int tid = cx.tid;
  int k0 = tk * 64, n0 = tn * 64;
  int kk = tid >> 4, n4 = tid & 15;
#pragma unroll
  for (int i = 0; i < 2; ++i) {
    int k = kk + 32 * i;
    float4 v = *(const float4*)(src + (size_t)(k0 + k) * N + n0 + n4 * 4);
    T[k * 65 + n4 * 4 + 0] = v.x; T[k * 65 + n4 * 4 + 1] = v.y; T[k * 65 + n4 * 4 + 2] = v.z; T[k * 65 + n4 * 4 + 3] = v.w;
  }
  __syncthreads();
  int n = tid >> 3, k8 = tid & 7;
  uint4 o;
  o.x = pack_bf2(T[(k8 * 8 + 0) * 65 + n], T[(k8 * 8 + 1) * 65 + n]);
  o.y = pack_bf2(T[(k8 * 8 + 2) * 65 + n], T[(k8 * 8 + 3) * 65 + n]);
  o.z = pack_bf2(T[(k8 * 8 + 4) * 65 + n], T[(k8 * 8 + 5) * 65 + n]);
  o.w = pack_bf2(T[(k8 * 8 + 6) * 65 + n], T[(k8 * 8 + 7) * 65 + n]);
  *(uint4*)(dst + (size_t)(n0 + n) * K + k0 + k8 * 8) = o;
}

DEV void phase0(const Params& p, const Ctx& cx0, char* smem, int part) {
  const int NTR = 4368;
  const int total = part == 0 ? 192 : 192 + 2 * NTR;
  for (int item = (part == 0 ? 0 : 192) + cx0.bid; item < total; item += cx0.nblk) {
    __syncthreads();
    Ctx cx = cx0; asm volatile("" : "+v"(cx.tid));
    if (item < 192) { p0_mods_item(p, cx, item, smem); continue; }
    int it = item - 192;
    int l = it / NTR, i = it % NTR;
    char* wt = p.ws + OFF_WT + (size_t)l * WT_SIZE;
    if (i < 3200) {
      p0_transpose_tile(p, cx, p.w_in + (size_t)l * 2048 * 6400, (bf16_t*)(wt + WT_IN), 2048, 6400, i / 100, i % 100, smem);
    } else if (i < 4224) {
      int j = i - 3200;
      p0_transpose_tile(p, cx, p.w_out + (size_t)l * 2048 * 2048, (bf16_t*)(wt + WT_OUT), 2048, 2048, j / 32, j % 32, smem);
    } else if (i < 4256) {
      int j = i - 4224, d = j / 16;
      p0_transpose_tile(p, cx, p.rwkv_w2 + (size_t)(l * 2 + d) * 64 * 1024, (bf16_t*)(wt + WT_W2) + (size_t)d * 1024 * 64, 64, 1024, 0, j % 16, smem);
    } else if (i < 4288) {
      int j = i - 4256, d = j / 16;
      p0_transpose_tile(p, cx, p.rwkv_a2 + (size_t)(l * 2 + d) * 64 * 1024, (bf16_t*)(wt + WT_A2) + (size_t)d * 1024 * 64, 64, 1024, 0, j % 16, smem);
    } else if (i < 4304) {
      int j = i - 4288, g = j / 4;
      p0_transpose_tile(p, cx, p.w_pool + (size_t)(l * 4 + g) * 128 * 128, (bf16_t*)(wt + WT_POOL) + (size_t)g * 128 * 128, 128, 128, (j % 4) / 2, j % 2, smem);
    } else {
      int j = i - 4304;
      p0_transpose_tile(p, cx, p.w_glu + (size_t)l * 512 * 512, (bf16_t*)(wt + WT_GLU), 512, 512, j / 8, j % 8, smem);
    }
  }
}

DEV void phase_adaln0(const Params& p, const Ctx& cx) {
  const float* mods = (const float*)(p.ws + OFF_MODS);
  bf16_t* hbuf = (bf16_t*)(p.ws + OFF_H);
  int lane = cx.tid & 63;
  int gw = cx.bid * 8 + (cx.tid >> 6), nw = cx.nblk * 8;
  for (int row = gw; row < MTOT; row += nw) {
    const float* src = row < NLAT ? p.x + (size_t)row * D : p.ctx + (size_t)(row - NLAT) * D;
    int mr = row < NLAT ? (row >> 14) : 2;
    const float* md = mods + (size_t)mr * 6144;
    float4 v[8];
    float s = 0;
#pragma unroll
    for (int i = 0; i < 8; ++i) { v[i] = *(const float4*)(src + i * 256 + lane * 4); s += v[i].x + v[i].y + v[i].z + v[i].w; }
    float mu = wave_sum(s) * (1.f / 2048.f);
    float q = 0;
#pragma unroll
    for (int i = 0; i < 8; ++i) { v[i].x -= mu; v[i].y -= mu; v[i].z -= mu; v[i].w -= mu; q += v[i].x * v[i].x + v[i].y * v[i].y + v[i].z * v[i].z + v[i].w * v[i].w; }
    float rstd = rsqrtf(wave_sum(q) * (1.f / 2048.f) + 1e-6f);
#pragma unroll
    for (int i = 0; i < 8; ++i) {
      int col = i * 256 + lane * 4;
      float4 sh = *(const float4*)(md + col), sc = *(const float4*)(md + 2048 + col);
      uint2 o;
      o.x = pack_bf2(v[i].x * rstd * (1.f + sc.x) + sh.x, v[i].y * rstd * (1.f + sc.y) + sh.y);
      o.y = pack_bf2(v[i].z * rstd * (1.f + sc.z) + sh.z, v[i].w * rstd * (1.f + sc.w) + sh.w);
      *(uint2*)(hbuf + (size_t)row * D + col) = o;
    }
  }
}

DEV void phase_finln(const Params& p, const Ctx& cx, int l) {
  const float* mods = (const float*)(p.ws + OFF_MODS);
  bf16_t* hbuf = (bf16_t*)(p.ws + OFF_H);
  float* prec = (float*)(p.ws + OFF_PREC);
  int lane = cx.tid & 63;
  int gw = cx.bid * 8 + (cx.tid >> 6), nw = cx.nblk * 8;
  const int nrows = (l == 0) ? MTOT : NLAT;
  for (int row = gw; row < nrows; row += nw) {
    float* src = row < NLAT ? p.out + (size_t)row * D : prec + (size_t)(row - NLAT) * D;
    float4 v[8];
    float s = 0;
#pragma unroll
    for (int i = 0; i < 8; ++i) { v[i] = *(const float4*)(src + i * 256 + lane * 4); s += v[i].x + v[i].y + v[i].z + v[i].w; }
    float mu = wave_sum(s) * (1.f / 2048.f);
    float q = 0;
#pragma unroll
    for (int i = 0; i < 8; ++i) { v[i].x -= mu; v[i].y -= mu; v[i].z -= mu; v[i].w -= mu; q += v[i].x * v[i].x + v[i].y * v[i].y + v[i].z * v[i].z + v[i].w * v[i].w; }
    float rstd = rsqrtf(wave_sum(q) * (1.f / 2048.f) + 1e-5f);
    float s2 = 0;
#pragma unroll
    for (int i = 0; i < 8; ++i) {
      int col = i * 256 + lane * 4;
      float4 g = *(const float4*)(p.ln_g + (size_t)l * D + col), b = *(const float4*)(p.ln_b + (size_t)l * D + col);
      v[i].x = v[i].x * rstd * g.x + b.x; v[i].y = v[i].y * rstd * g.y + b.y; v[i].z = v[i].z * rstd * g.z + b.z; v[i].w = v[i].w * rstd * g.w + b.w;
      if (row < NLAT) *(float4*)(src + col) = v[i];
      s2 += v[i].x + v[i].y + v[i].z + v[i].w;
    }
    if (l == 0) {
      int mr = row < NLAT ? (row >> 14) : 2;
      const float* md = mods + (size_t)(3 + mr) * 6144;
      float mu2 = wave_sum(s2) * (1.f / 2048.f);
      float q2 = 0;
#pragma unroll
      for (int i = 0; i < 8; ++i) { v[i].x -= mu2; v[i].y -= mu2; v[i].z -= mu2; v[i].w -= mu2; q2 += v[i].x * v[i].x + v[i].y * v[i].y + v[i].z * v[i].z + v[i].w * v[i].w; }
      float rstd2 = rsqrtf(wave_sum(q2) * (1.f / 2048.f) + 1e-6f);
#pragma unroll
      for (int i = 0; i < 8; ++i) {
        int col = i * 256 + lane * 4;
        float4 sh = *(const float4*)(md + col), sc = *(const float4*)(md + 2048 + col);
        uint2 o;
        o.x = pack_bf2(v[i].x * rstd2 * (1.f + sc.x) + sh.x, v[i].y * rstd2 * (1.f + sc.y) + sh.y);
        o.y = pack_bf2(v[i].z * rstd2 * (1.f + sc.z) + sh.z, v[i].w * rstd2 * (1.f + sc.w) + sh.w);
        *(uint2*)(hbuf + (size_t)row * D + col) = o;
      }
    }
  }
}

template <class Epi>
DEV void gemm_phase(const Params& p, const Ctx& cx, const bf16_t* __restrict__ A, const bf16_t* __restrict__ Bt, int K, int nM, int nN, char* smem, Epi epi) {
  const int tid = cx.tid, lane = tid & 63, wid = tid >> 6;
  const int wr = wid >> 2, wc = wid & 3, fr = lane & 15, fq = lane >> 4;
  const int nt = K / 64;
  const int ntiles = nM * nN;
  const int srow = tid >> 3, sc16 = tid & 7;
  const int nxcd = (cx.nblk & 7) == 0 ? 8 : 1;
  const int xcd = cx.bid % nxcd, xidx = cx.bid / nxcd, xper = cx.nblk / nxcd;
  const int t_lo = (int)(((long)ntiles * xcd) / nxcd), t_hi = (int)(((long)ntiles * (xcd + 1)) / nxcd);
  for (int tt = t_lo + xidx; tt < t_hi; tt += xper) {
    const int band = tt / (16 * nN);
    const int brows = min(16, nM - band * 16);
    const int rem = tt - band * 16 * nN;
    const int pn = rem / brows, pm = band * 16 + rem % brows;
    const int brow = pm * 256, bcol = pn * 256;
    const char* Ab = (const char*)(A + (size_t)brow * K);
    const char* Bb = (const char*)(Bt + (size_t)bcol * K);
    const unsigned voff = (unsigned)(srow * K + sc16 * 8) * 2u;
    const size_t rs = (size_t)64 * K * 2;
    f32x4 acc[8][4];
#pragma unroll
    for (int i = 0; i < 8; ++i)
#pragma unroll
      for (int j = 0; j < 4; ++j) acc[i][j] = f32x4{0.f, 0.f, 0.f, 0.f};
    uint4 ra0, ra1, ra2, ra3, rb0, rb1, rb2, rb3;
#define G_LD(ko) { const char* a_ = Ab + (size_t)(ko) * 2; const char* b_ = Bb + (size_t)(ko) * 2; \
                 ra0 = *(const uint4*)(a_ + voff); ra1 = *(const uint4*)(a_ + rs + voff); ra2 = *(const uint4*)(a_ + 2 * rs + voff); ra3 = *(const uint4*)(a_ + 3 * rs + voff); \
                 rb0 = *(const uint4*)(b_ + voff); rb1 = *(const uint4*)(b_ + rs + voff); rb2 = *(const uint4*)(b_ + 2 * rs + voff); rb3 = *(const uint4*)(b_ + 3 * rs + voff); }
#define G_ST(sp) { *(uint4*)(sp) = ra0; *(uint4*)((sp) + 64 * 144) = ra1; *(uint4*)((sp) + 128 * 144) = ra2; *(uint4*)((sp) + 192 * 144) = ra3; \
                 *(uint4*)((sp) + 36864) = rb0; *(uint4*)((sp) + 36864 + 64 * 144) = rb1; *(uint4*)((sp) + 36864 + 128 * 144) = rb2; *(uint4*)((sp) + 36864 + 192 * 144) = rb3; }
    char* const sbase = smem + srow * 144 + sc16 * 16;
    G_LD(0);
    G_ST(sbase);
    if (nt > 1) G_LD(64);
    for (int kt = 0; kt < nt; ++kt) {
      __syncthreads();
      if (kt + 1 < nt) { char* s1 = sbase + ((kt + 1) & 1) * 73728; G_ST(s1); }
      if (kt + 2 < nt) G_LD((kt + 2) * 64);
      const char* As = smem + (kt & 1) * 73728;
      const char* Bs = As + 36864;
#pragma unroll
      for (int kh = 0; kh < 2; ++kh) {
        bf16x8 bfr[4];
#pragma unroll
        for (int jn = 0; jn < 4; ++jn) bfr[jn] = *(const bf16x8*)(Bs + (wc * 64 + jn * 16 + fr) * 144 + kh * 64 + fq * 16);
#pragma unroll
        for (int i = 0; i < 8; ++i) {
          bf16x8 af = *(const bf16x8*)(As + (wr * 128 + i * 16 + fr) * 144 + kh * 64 + fq * 16);
#pragma unroll
          for (int jn = 0; jn < 4; ++jn) acc[i][jn] = __builtin_amdgcn_mfma_f32_16x16x32_f16(bfr[jn], af, acc[i][jn], 0, 0, 0);
        }
      }
    }
    __syncthreads();
#pragma unroll
    for (int i = 0; i < 8; ++i)
#pragma unroll
      for (int jn = 0; jn < 4; ++jn) epi(brow + wr * 128 + i * 16 + fr, bcol + wc * 64 + jn * 16 + fq * 4, acc[i][jn]);
  }
}

#define LAS3 __attribute__((address_space(3)))
DEV int g2_lds_byte(int r, int c) { const int st = (r >> 4) * 2 + (c >> 5), rr = r & 15, cc = c & 31, ob = rr * 64 + cc * 2; return st * 1024 + (ob ^ (((ob >> 9) & 1) << 5)); }
DEV void g2_stage_rc(int b, int& R, int& C) { const int st = b / 1024, sb = b % 1024, swz = sb ^ (((sb >> 9) & 1) << 5); R = (st >> 1) * 16 + swz / 64; C = (st & 1) * 32 + (swz % 64) / 2; }

template <class Epi>
DEV void gemm_phase2(const Params& p, const Ctx& cx, const bf16_t* __restrict__ A, const bf16_t* __restrict__ Bt, int K, int nM, int nN, char* smem, Epi epi) {
  constexpr int HTB = 128 * 64 * 2;
  LAS3 unsigned char* lds = (LAS3 unsigned char*)smem;
  const int tid = cx.tid, wid = __builtin_amdgcn_readfirstlane(tid >> 6), lane = tid & 63, wr = wid >> 2, wc = wid & 3, fr = lane & 15, fq = lane >> 4;
  const int nt = K / 64;
  const int ntiles = nM * nN;
  const int nxcd = (cx.nblk & 7) == 0 ? 8 : 1;
  const int xcd = cx.bid % nxcd, xidx = cx.bid / nxcd, xper = cx.nblk / nxcd;
  const int t_lo = (int)(((long)ntiles * xcd) / nxcd), t_hi = (int)(((long)ntiles * (xcd + 1)) / nxcd);
  auto unit_at = [&](int i, int& pm, int& pn) -> bool {
    const int tt = t_lo + xidx + i * xper;
    if (tt >= t_hi) return false;
    const int band = tt / (8 * nN);
    const int brows = min(8, nM - band * 8);
    const int rem = tt - band * 8 * nN;
    pn = rem / brows; pm = band * 8 + rem % brows;
    return true;
  };
  unsigned voffA[2], voffB[2];
#pragma unroll
  for (int i = 0; i < 2; ++i) {
    int R, C; g2_stage_rc(tid * 16 + i * 8192, R, C);
    const int rho = R & 31, Rb = (R & ~31) + 8 * ((rho & 15) >> 2) + 4 * (rho >> 4) + (rho & 3);
    voffA[i] = (unsigned)(R * K + C) * 2u; voffB[i] = (unsigned)(Rb * K + C) * 2u;
  }
  const size_t kstep = (size_t)(64 * 2);
  const size_t hstep = (size_t)128 * K * 2;
  const size_t tstep = 2 * hstep;
  const unsigned ldsw = (unsigned)wid * 1024u;
  const int aoff = g2_lds_byte(wr * 64 + fr, fq * 8), boff = g2_lds_byte(wc * 32 + fr, fq * 8);
#define G2_SA(b, h) (((b) * 2 + (h)) * HTB)
#define G2_SB(b, h) ((4 + (b) * 2 + (h)) * HTB)
#define G2_STAGE_(bufoff, gbase, vo_) do { _Pragma("unroll") for (int _i = 0; _i < 2; ++_i) \
    __builtin_amdgcn_global_load_lds((const unsigned*)((const char*)(gbase) + vo_[_i]), (LAS3 unsigned*)(lds + (bufoff) + ldsw + _i * 8192), 16, 0, 0); } while (0)
#define G2_STAGE(bufoff, gbase) G2_STAGE_(bufoff, gbase, voffA)
#define G2_STAGEB(bufoff, gbase) G2_STAGE_(bufoff, gbase, voffB)
#define G2_LDA(dst, b, h) do { _Pragma("unroll") for (int m = 0; m < 4; ++m) _Pragma("unroll") for (int k = 0; k < 2; ++k) dst[m][k] = *(const LAS3 bf16x8*)(lds + G2_SA(b, h) + aoff + m * 2048 + k * 1024); } while (0)
#define G2_LDB(dst, b, h) do { _Pragma("unroll") for (int n = 0; n < 2; ++n) _Pragma("unroll") for (int k = 0; k < 2; ++k) dst[n][k] = *(const LAS3 bf16x8*)(lds + G2_SB(b, h) + boff + n * 2048 + k * 1024); } while (0)
#define G2_MMA(ai, bj, At_, Bt_) do { __builtin_amdgcn_s_setprio(1); _Pragma("unroll") for (int m = 0; m < 4; ++m) _Pragma("unroll") for (int n = 0; n < 2; ++n) _Pragma("unroll") for (int k = 0; k < 2; ++k) \
    acc[ai][bj][m][n] = __builtin_amdgcn_mfma_f32_16x16x32_f16(Bt_[n][k], At_[m][k], acc[ai][bj][m][n], 0, 0, 0); __builtin_amdgcn_s_setprio(0); } while (0)
#define G2_WAIT_V(n) asm volatile("s_waitcnt vmcnt(" #n ")" ::: "memory")
#define G2_WAIT_L(n) asm volatile("s_waitcnt lgkmcnt(" #n ")" ::: "memory")
#define G2_BAR __builtin_amdgcn_s_barrier()
#define G2_SCHED __builtin_amdgcn_sched_barrier(0)
  int cpm, cpn, npm = 0, npn = 0, ui = 0;
  if (!unit_at(0, cpm, cpn)) return;
  f32x4 acc[2][2][4][2];
#pragma unroll
  for (int a = 0; a < 2; ++a)
#pragma unroll
    for (int b = 0; b < 2; ++b)
#pragma unroll
      for (int m = 0; m < 4; ++m)
#pragma unroll
        for (int n = 0; n < 2; ++n) acc[a][b][m][n] = f32x4{0.f, 0.f, 0.f, 0.f};
  bf16x8 At[4][2], B0[2][2], B1[2][2];
  const char* cA = (const char*)A + (size_t)cpm * tstep;
  const char* cB = (const char*)Bt + (size_t)cpn * tstep;
  G2_STAGEB(G2_SB(0, 0), cB); G2_STAGE(G2_SA(0, 0), cA); G2_STAGEB(G2_SB(0, 1), cB + hstep); G2_STAGE(G2_SA(0, 1), cA + hstep);
  if (wr == 1) G2_BAR;
  G2_WAIT_V(4); G2_BAR;
  G2_STAGEB(G2_SB(1, 0), cB + kstep); G2_STAGE(G2_SA(1, 0), cA + kstep); G2_STAGEB(G2_SB(1, 1), cB + hstep + kstep);
  G2_WAIT_V(6); G2_BAR;
  for (;;) {
    const bool has_next = unit_at(ui + 1, npm, npn);
    const char* nA = has_next ? (const char*)A + (size_t)npm * tstep : cA;
    const char* nB = has_next ? (const char*)Bt + (size_t)npn * tstep : cB;
    for (int t = 0; t < nt; t += 2) {
      const bool last = (t == nt - 2);
      const char* a1 = cA + (size_t)(t + 1) * kstep;
      const char* a2 = last ? nA : cA + (size_t)(t + 2) * kstep;
      const char* b2 = last ? nB : cB + (size_t)(t + 2) * kstep;
      const char* a3 = a2 + kstep;
      const char* b3 = b2 + kstep;
      G2_LDB(B0, 0, 0); G2_SCHED; G2_LDA(At, 0, 0); G2_STAGE(G2_SA(1, 1), a1 + hstep);
      G2_WAIT_L(8); G2_BAR; G2_WAIT_L(0); G2_MMA(0, 0, At, B0); G2_BAR; G2_SCHED;
      G2_LDB(B1, 0, 1); G2_STAGEB(G2_SB(0, 0), b2);
      G2_BAR; G2_WAIT_L(0); G2_MMA(0, 1, At, B1); G2_BAR;
      G2_LDA(At, 0, 1); G2_STAGE(G2_SA(0, 0), a2);
      G2_BAR; G2_WAIT_L(0); G2_MMA(1, 0, At, B0); G2_BAR; G2_SCHED;
      G2_STAGEB(G2_SB(0, 1), b2 + hstep);
      G2_WAIT_V(6); G2_BAR; G2_MMA(1, 1, At, B1); G2_BAR;
      G2_LDB(B0, 1, 0); G2_SCHED; G2_LDA(At, 1, 0); G2_STAGE(G2_SA(0, 1), a2 + hstep);
      G2_WAIT_L(8); G2_BAR; G2_WAIT_L(0); G2_MMA(0, 0, At, B0); G2_BAR; G2_SCHED;
      G2_LDB(B1, 1, 1); G2_STAGEB(G2_SB(1, 0), b3);
      G2_BAR; G2_WAIT_L(0); G2_MMA(0, 1, At, B1); G2_BAR;
      G2_LDA(At, 1, 1); G2_STAGE(G2_SA(1, 0), a3);
      G2_BAR; G2_WAIT_L(0); G2_MMA(1, 0, At, B0); G2_BAR; G2_SCHED;
      G2_STAGEB(G2_SB(1, 1), b3 + hstep);
      G2_WAIT_V(6); G2_BAR; G2_MMA(1, 1, At, B1); G2_BAR;
    }
    {
      const int row0 = cpm * 256 + wr * 64 + fr, col0 = cpn * 256 + wc * 32 + 8 * fq;
#pragma unroll
      for (int ai = 0; ai < 2; ++ai)
#pragma unroll
        for (int m = 0; m < 4; ++m)
#pragma unroll
          for (int bj = 0; bj < 2; ++bj) epi(row0 + ai * 128 + m * 16, col0 + bj * 128, acc[ai][bj][m][0], acc[ai][bj][m][1]);
    }
    if (!has_next) break;
#pragma unroll
    for (int a = 0; a < 2; ++a)
#pragma unroll
      for (int b = 0; b < 2; ++b)
#pragma unroll
        for (int m = 0; m < 4; ++m)
#pragma unroll
          for (int n = 0; n < 2; ++n) acc[a][b][m][n] = f32x4{0.f, 0.f, 0.f, 0.f};
    cpm = npm; cpn = npn; cA = nA; cB = nB; ++ui;
  }
  G2_WAIT_V(0);
  if (wr == 0) G2_BAR;
  G2_BAR;
#undef G2_SA
#undef G2_SB
#undef G2_STAGE
#undef G2_STAGEB
#undef G2_STAGE_
#undef G2_LDA
#undef G2_LDB
#undef G2_MMA
#undef G2_WAIT_V
#undef G2_WAIT_L
#undef G2_BAR
#undef G2_SCHED
}

template <int K, int NT, class Epi>
DEV void small_gemm(const Params& p, const Ctx& cx, const char* As, int astride, const bf16_t* __restrict__ Bt, int n0, Epi epi) {
  const int lane = cx.tid & 63, fr = lane & 15, fq = lane >> 4;
  f32x4 acc[4][NT];
#pragma unroll
  for (int i = 0; i < 4; ++i)
#pragma unroll
    for (int j = 0; j < NT; ++j) acc[i][j] = f32x4{0.f, 0.f, 0.f, 0.f};
#pragma unroll 2
  for (int k0 = 0; k0 < K; k0 += 32) {
    bf16x8 af[4];
#pragma unroll
    for (int i = 0; i < 4; ++i) af[i] = *(const bf16x8*)(As + (i * 16 + fr) * astride + (k0 + fq * 8) * 2);
#pragma unroll
    for (int jn = 0; jn < NT; ++jn) {
      bf16x8 bf = *(const bf16x8*)(Bt + (size_t)(n0 + jn * 16 + fr) * K + k0 + fq * 8);
#pragma unroll
      for (int i = 0; i < 4; ++i) acc[i][jn] = __builtin_amdgcn_mfma_f32_16x16x32_f16(bf, af[i], acc[i][jn], 0, 0, 0);
    }
  }
#pragma unroll
  for (int i = 0; i < 4; ++i)
#pragma unroll
    for (int jn = 0; jn < NT; ++jn) epi(i * 16 + fr, n0 + jn * 16 + fq * 4, acc[i][jn]);
}

struct S5P { float ar, ai, br, bi; };
DEV S5P s5_params(const Params& p, const Ctx& cx, int l, int d, int g, int lane) {
  int idx = ((l * 2 + d) * 32 + g) * 64 + lane;
  float lr = fminf(p.s5_lam_re[idx], -1e-4f), li = p.s5_lam_im[idx];
  float step = expf(p.s5_log_step[(l * 2 + d) * 32 + g]);
  float xr = lr * step, xi = li * step;
  float e = expf(xr), cs = cosf(xi), sn = sinf(xi);
  S5P r;
  r.ar = e * cs; r.ai = e * sn;
  float sh = sinf(0.5f * xi);
  float nr = expm1f(xr) * cs - 2.f * sh * sh, ni = e * sn;
  float inv = 1.f / (lr * lr + li * li);
  r.br = (nr * lr + ni * li) * inv;
  r.bi = (ni * lr - nr * li) * inv;
  return r;
}

DEV void s5_load_u(const h16* zrest, int rowbase, int g, char* ulds, int lane) {
#pragma unroll
  for (int i = 0; i < 8; ++i) {
    int e = i * 64 + lane;
    int r = e >> 1, hf = e & 1;
    uint4 v = *(const uint4*)(zrest + (size_t)(rowbase + r) * ZR + g * 16 + hf * 8);
    *(uint4*)(ulds + r * 32 + hf * 16) = v;
  }
  lds_fence();
}

DEV int s5_rowbase(int b, int c) { return c == 0 ? NLAT + b * 256 : b * 16384 + (c - 1) * 256; }

DEV void s5_pass1_unit(const Params& p, const Ctx& cx, int l, int unit, char* wl, int lane) {
  int c = unit % 65, bg = unit / 65, g = bg & 31, b = bg >> 5;
  const h16* zrest = (const h16*)(p.ws + OFF_ZREST);
  float2* F = (float2*)(p.ws + OFF_S5F);
  s5_load_u(zrest, s5_rowbase(b, c), g, wl, lane);
  float Br[16], Bi[16];
  {
    const float* pr = p.s5_b_re + ((size_t)(l * 32 + g) * 64 + lane) * 16;
    const float* pi = p.s5_b_im + ((size_t)(l * 32 + g) * 64 + lane) * 16;
#pragma unroll
    for (int i = 0; i < 16; i += 4) {
      float4 a = *(const float4*)(pr + i), bq = *(const float4*)(pi + i);
      Br[i] = a.x; Br[i + 1] = a.y; Br[i + 2] = a.z; Br[i + 3] = a.w;
      Bi[i] = bq.x; Bi[i + 1] = bq.y; Bi[i + 2] = bq.z; Bi[i + 3] = bq.w;
    }
  }
  S5P pf = s5_params(p, cx, l, 0, g, lane), pb = s5_params(p, cx, l, 1, g, lane);
  float xr = 0, xi = 0, yr = 0, yi = 0, pwr = 1.f, pwi = 0.f;
#pragma unroll 4
  for (int t = 0; t < 256; ++t) {
    h16x8 u0 = *(const h16x8*)(wl + t * 32), u1 = *(const h16x8*)(wl + t * 32 + 16);
    float br = 0, bi = 0;
#pragma unroll
    for (int i = 0; i < 8; ++i) { float u = (float)u0[i]; br = fmaf(u, Br[i], br); bi = fmaf(u, Bi[i], bi); }
#pragma unroll
    for (int i = 0; i < 8; ++i) { float u = (float)u1[i]; br = fmaf(u, Br[8 + i], br); bi = fmaf(u, Bi[8 + i], bi); }
    float nxr = pf.ar * xr - pf.ai * xi + br, nxi = pf.ar * xi + pf.ai * xr + bi;
    xr = nxr; xi = nxi;
    yr += pwr * br - pwi * bi; yi += pwr * bi + pwi * br;
    float npr = pwr * pb.ar - pwi * pb.ai, npi = pwr * pb.ai + pwi * pb.ar;
    pwr = npr; pwi = npi;
  }
  size_t fi = (((size_t)(b * 32 + g) * 65 + c) * 2) * 64 + lane;
  F[fi] = make_float2(pf.br * xr - pf.bi * xi, pf.br * xi + pf.bi * xr);
  F[fi + 64] = make_float2(pb.br * yr - pb.bi * yi, pb.br * yi + pb.bi * yr);
}

DEV void s5_pass3_unit(const Params& p, const Ctx& cx, int l, int unit, char* wl, int lane) {
  int c = unit % 65, bg = unit / 65, g = bg & 31, b = bg >> 5;
  const int fr = lane & 15, fq = lane >> 4;
  const h16* zrest = (const h16*)(p.ws + OFF_ZREST);
  const float2* F = (const float2*)(p.ws + OFF_S5F);
  float* S5Y = (float*)(p.ws + OFF_S5Y);
  const int rowbase = s5_rowbase(b, c);
  char* ulds = wl;
  char* tile = wl + 8192;
  s5_load_u(zrest, rowbase, g, ulds, lane);
  float Br[16], Bi[16];
  {
    const float* pr = p.s5_b_re + ((size_t)(l * 32 + g) * 64 + lane) * 16;
    const float* pi = p.s5_b_im + ((size_t)(l * 32 + g) * 64 + lane) * 16;
#pragma unroll
    for (int i = 0; i < 16; i += 4) {
      float4 a = *(const float4*)(pr + i), bq = *(const float4*)(pi + i);
      Br[i] = a.x; Br[i + 1] = a.y; Br[i + 2] = a.z; Br[i + 3] = a.w;
      Bi[i] = bq.x; Bi[i + 1] = bq.y; Bi[i + 2] = bq.z; Bi[i + 3] = bq.w;
    }
  }
  const float dsk = p.s5_d[(size_t)l * 512 + g * 16 + fr];
  const size_t fbase = ((size_t)(b * 32 + g) * 65) * 2 * 64 + lane;
#pragma unroll 1
  for (int d = 0; d < 2; ++d) {
    S5P pp = s5_params(p, cx, l, d, g, lane);
    float qr = pp.ar, qi = pp.ai;
#pragma unroll
    for (int i = 0; i < 8; ++i) { float t = qr * qr - qi * qi; qi = 2.f * qr * qi; qr = t; }
    float xr = 0, xi = 0;
    if (d == 0) {
      for (int cc = 0; cc < c; ++cc) {
        float2 f = F[fbase + (size_t)(cc * 2 + 0) * 64];
        float t = qr * xr - qi * xi + f.x; xi = qr * xi + qi * xr + f.y; xr = t;
      }
    } else if (c > 0) {
      float2 f0 = F[fbase + (size_t)(0 * 2 + 1) * 64];
      xr = f0.x; xi = f0.y;
      for (int cc = 64; cc > c; --cc) {
        float2 f = F[fbase + (size_t)(cc * 2 + 1) * 64];
        float t = qr * xr - qi * xi + f.x; xi = qr * xi + qi * xr + f.y; xr = t;
      }
    }
    bf16x8 chi[4], clo[4];
    {
      const float* cr = p.s5_c_re + ((size_t)((l * 2 + d) * 32 + g) * 16 + fr) * 64;
      const float* ci = p.s5_c_im + ((size_t)((l * 2 + d) * 32 + g) * 16 + fr) * 64;
#pragma unroll
      for (int ks = 0; ks < 4; ++ks) {
        float4 a = *(const float4*)(cr + ks * 16 + fq * 4), bq = *(const float4*)(ci + ks * 16 + fq * 4);
        float vals[8] = {a.x, -bq.x, a.y, -bq.y, a.z, -bq.z, a.w, -bq.w};
#pragma unroll
        for (int j = 0; j < 8; ++j) {
          h16 hh = (h16)vals[j];
          chi[ks][j] = hh;
          clo[ks][j] = (h16)(vals[j] - (float)hh);
        }
      }
    }
#pragma unroll 1
    for (int sb = 0; sb < 16; ++sb) {
      const int sub = d == 0 ? sb : 15 - sb;
#pragma unroll 4
      for (int q = 0; q < 16; ++q) {
        const int tt = d == 0 ? q : 15 - q;
        const int t = sub * 16 + tt;
        h16x8 u0 = *(const h16x8*)(ulds + t * 32), u1 = *(const h16x8*)(ulds + t * 32 + 16);
        float br = 0, bi = 0;
#pragma unroll
        for (int i = 0; i < 8; ++i) { float u = (float)u0[i]; br = fmaf(u, Br[i], br); bi = fmaf(u, Bi[i], bi); }
#pragma unroll
        for (int i = 0; i < 8; ++i) { float u = (float)u1[i]; br = fmaf(u, Br[8 + i], br); bi = fmaf(u, Bi[8 + i], bi); }
        float vr = pp.br * br - pp.bi * bi, vi = pp.br * bi + pp.bi * br;
        float nxr = pp.ar * xr - pp.ai * xi + vr, nxi = pp.ar * xi + pp.ai * xr + vi;
        xr = nxr; xi = nxi;
        h16x2 hv2 = {(h16)xr, (h16)xi};
        *(unsigned*)(tile + tt * 272 + lane * 4) = __builtin_bit_cast(unsigned, hv2);
      }
      lds_fence();
      f32x4 acc = f32x4{0.f, 0.f, 0.f, 0.f};
#pragma unroll
      for (int ks = 0; ks < 4; ++ks) {
        bf16x8 ah = *(const bf16x8*)(tile + fr * 272 + ks * 64 + fq * 16);
        acc = __builtin_amdgcn_mfma_f32_16x16x32_f16(ah, chi[ks], acc, 0, 0, 0);
        acc = __builtin_amdgcn_mfma_f32_16x16x32_f16(ah, clo[ks], acc, 0, 0, 0);
      }
      lds_fence();
#pragma unroll
      for (int r = 0; r < 4; ++r) {
        int tl = sub * 16 + fq * 4 + r;
        float* yp = S5Y + (size_t)(rowbase + tl) * 512 + g * 16 + fr;
        if (d == 0) {
          float u = (float)*(const h16*)(ulds + tl * 32 + fr * 2);
          *yp = acc[r] + dsk * u;
        } else {
          *yp = gelu_f(*yp + acc[r]);
        }
      }
    }
  }
}

DEV void prep_item(const Params& p, const Ctx& cx, int l, int item, char* smem) {
  const int tile = item >> 2, q = item & 3;
  const int row0 = tile * 64;
  const int tid = cx.tid;
  const h16* zc = (const h16*)(p.ws + OFF_REG2);
  h16* SC = (h16*)(p.ws + OFF_SCAN);
  const char* wt = p.ws + OFF_WT + (size_t)l * WT_SIZE;
  {
    const int d = q >> 1, isA = q & 1;
    const int coff = isA ? 3200 + d * 64 : 3072 + d * 64;
    int tok = tid >> 3, c8 = tid & 7;
    h16x8 cv = *(const h16x8*)(zc + (size_t)(row0 + tok) * ZC + coff + c8 * 8);
    float f[8];
#pragma unroll
    for (int j = 0; j < 8; ++j) { f[j] = (float)cv[j]; if (!isA) f[j] = tanh_f(f[j]); }
    uint4 o;
    o.x = pack_bf2(f[0], f[1]); o.y = pack_bf2(f[2], f[3]); o.z = pack_bf2(f[4], f[5]); o.w = pack_bf2(f[6], f[7]);
    *(uint4*)(smem + tok * 144 + c8 * 16) = o;
    __syncthreads();
    const bf16_t* Bt = (const bf16_t*)(wt + (isA ? WT_A2 : WT_W2)) + (size_t)d * 1024 * 64;
    const float* biasw = p.rwkv_w0 + (size_t)(l * 2 + d) * 1024;
    const float* biasa = p.rwkv_a0 + (size_t)(l * 2 + d) * 1024;
    h16* dst = SC + (size_t)(isA ? 4 + d : 6 + d) * ARR;
#pragma unroll 1
    for (int hf = 0; hf < 2; ++hf) small_gemm<64, 4>(p, cx, smem, 144, Bt, (tid >> 6) * 128 + hf * 64, [&](int m, int n, f32x4 v) {
      float4 bbw = *(const float4*)(biasw + n), bba = *(const float4*)(biasa + n);
      float4 bb = isA ? bba : bbw;
      float r0 = sigmoid_f(v[0] + bb.x), r1 = sigmoid_f(v[1] + bb.y), r2 = sigmoid_f(v[2] + bb.z), r3 = sigmoid_f(v[3] + bb.w);
      if (!isA) { r0 = __expf(-DECAY_SCALE * r0); r1 = __expf(-DECAY_SCALE * r1); r2 = __expf(-DECAY_SCALE * r2); r3 = __expf(-DECAY_SCALE * r3); }
      h16x4 o4 = {(h16)r0, (h16)r1, (h16)r2, (h16)r3};
      *(h16x4*)(dst + (size_t)(row0 + m) * 1024 + n) = o4;
    });
  }
  {
    const float* cw = p.conv_rkv + (size_t)l * 3 * 3072;
    const int grp = tid & 7, hh = (tid >> 3) & 3;
    const int c0 = (4 * q + hh) * 64 + grp * 8;
    float cwt[3][3][8];
#pragma unroll
    for (int s = 0; s < 3; ++s)
#pragma unroll
      for (int tp = 0; tp < 3; ++tp)
#pragma unroll
        for (int j = 0; j < 8; j += 4) {
          float4 a = *(const float4*)(cw + tp * 3072 + s * 1024 + c0 + j);
          cwt[s][tp][j] = a.x; cwt[s][tp][j + 1] = a.y; cwt[s][tp][j + 2] = a.z; cwt[s][tp][j + 3] = a.w;
        }
    float kkw[8];
#pragma unroll
    for (int j = 0; j < 8; j += 4) {
      float4 kq = *(const float4*)(p.rwkv_k_k + (size_t)l * 1024 + c0 + j);
      kkw[j] = kq.x; kkw[j + 1] = kq.y; kkw[j + 2] = kq.z; kkw[j + 3] = kq.w;
    }
#pragma unroll 1
    for (int it = 0; it < 4; ++it) {
      const int tok = (tid >> 5) + it * 16;
      const int row = row0 + tok;
      bool hasp, hasn;
      if (row < NLAT) { hasp = (row & 16383) != 0; hasn = (row & 16383) != 16383; }
      else { hasp = (row & 255) != 0; hasn = (row & 255) != 255; }
      const size_t off = (size_t)row * 1024 + c0;
      const h16* zp = zc + (size_t)row * ZC + c0;
      const h16* zpp = hasp ? zp - ZC : zp;
      const h16* zpn = hasn ? zp + ZC : zp;
      h16x8 cur[3], prv[3], nxt[3];
#pragma unroll
      for (int s = 0; s < 3; ++s) { cur[s] = *(const h16x8*)(zp + s * 1024); prv[s] = *(const h16x8*)(zpp + s * 1024); nxt[s] = *(const h16x8*)(zpn + s * 1024); }
      const float fp = hasp ? 1.f : 0.f, fn = hasn ? 1.f : 0.f;
      float kv[8];
#pragma unroll
      for (int s = 0; s < 3; ++s) {
        h16x8 o;
#pragma unroll
        for (int j = 0; j < 8; ++j) {
          float ov = cwt[s][0][j] * (fp * (float)prv[s][j]) + cwt[s][1][j] * (float)cur[s][j] + cwt[s][2][j] * (fn * (float)nxt[s][j]);
          o[j] = (h16)ov;
          if (s == 1) kv[j] = ov;
        }
        *(h16x8*)(SC + (size_t)s * ARR + off) = o;
      }
      float kk[8], ss = 0;
#pragma unroll
      for (int j = 0; j < 8; ++j) { kk[j] = kv[j] * kkw[j]; ss += kk[j] * kk[j]; }
      ss = allreduce8(ss);
      float inv = rcp_f(fmaxf(sqrtf(ss), 1e-12f));
      h16x8 o;
#pragma unroll
      for (int j = 0; j < 8; ++j) o[j] = (h16)(kk[j] * inv);
      *(h16x8*)(SC + 3 * ARR + off) = o;
    }
  }
}

DEV void phase_prep(const Params& p, const Ctx& cx0, int l, char* smem) {
  const int NPREP = 520 * 4, NS5 = 520;
  const Ctx& cx_ = cx0;
  for (int item = cx_.bid; item < NPREP + NS5; item += cx_.nblk) {
    __syncthreads();
    Ctx cx = cx0; asm volatile("" : "+v"(cx.tid));
    const int lane = cx.tid & 63, wid = cx.tid >> 6;
#ifndef NO_PREPITEM
    if (item < NPREP) prep_item(p, cx, l, item, smem);
    else
#endif
#ifndef NO_S5P1
      s5_pass1_unit(p, cx, l, (item - NPREP) * 8 + wid, smem + wid * 8192, lane);
#else
    {}
#endif
  }
}

typedef unsigned u2v __attribute__((ext_vector_type(2)));
struct RG { u2v w, a, kk, k, r; h16 v; };

constexpr int RW_NSLOT = 8, RW_SLOTB = 3072;
constexpr int RW_FLAGS = RW_NSLOT * RW_SLOTB;
constexpr int RW_NG = 16640 / 4;
typedef float f4v __attribute__((ext_vector_type(4)));

#define RW_RLO(gq, rlo)                                                            \
  {                                                                                \
    const int gg = (gq) < RW_NG ? (gq) : RW_NG - 1;                                \
    const int q0_ = gg * 4;                                                        \
    const int isl = q0_ >= 256;                                                    \
    const int base_ = isl ? b * 16384 : NLAT + b * 256;                            \
    const int t0_ = isl ? q0_ - 256 : q0_;                                         \
    const int last_ = isl ? 16383 : 255;                                           \
    rlo = base_ + (d ? last_ - t0_ - 3 : t0_);                                     \
  }

DEV void rwkv_helper(const Params& p, const Ctx& cx, int l, int unit, int lane, char* ring) {
  const int d = unit & 1, h = (unit >> 1) & 15, b = unit >> 5;
  const int j = lane >> 4, s = lane & 15;
  const h16* SC = (const h16*)(p.ws + OFF_SCAN);
  const char* pR = (const char*)(SC + 0 * ARR + h * 64);
  const char* pK = (const char*)(SC + 1 * ARR + h * 64);
  const char* pV = (const char*)(SC + 2 * ARR + h * 64);
  const char* pKK = (const char*)(SC + 3 * ARR + h * 64);
  const char* pA = (const char*)(SC + (size_t)(4 + d) * ARR + h * 64);
  const char* pW = (const char*)(SC + (size_t)(6 + d) * ARR + h * 64);
  const int jm = d ? 3 - j : j;
  const unsigned vo0 = (unsigned)(jm * 2048 + s * 8);
  f4v ka4, om4;
  {
    float4 t = *(const float4*)(p.rwkv_k_a + (size_t)l * 1024 + h * 64 + 4 * s);
    ka4 = f4v{t.x, t.y, t.z, t.w};
    om4 = 1.f - ka4;
  }
  struct RGH { u2v w, a, kk, k, r, v; };
  RGH q0, q1, q2, q3, q4, q5, q6, q7;
  const unsigned wofs = (unsigned)(j * 128 + s * 8);
  const unsigned vwofs = (unsigned)(2560 + j * 128 + s * 8);
  LAS3 volatile int* pflag = (LAS3 volatile int*)(ring + RW_FLAGS);
  LAS3 volatile int* cflag = (LAS3 volatile int*)(ring + RW_FLAGS + 64);
  int cmin = 0;
#define CV4(uv) __builtin_convertvector(__builtin_bit_cast(h16x4, uv), f4v)
#define RH_LOAD(q, gq)                                                             \
  {                                                                                \
    int rlo; RW_RLO(gq, rlo);                                                      \
    unsigned vo = vo0; asm volatile("" : "+v"(vo));                                \
    const size_t off = (size_t)rlo * 2048;                                         \
    q.w = *(const u2v*)(pW + off + vo); q.a = *(const u2v*)(pA + off + vo);        \
    q.kk = *(const u2v*)(pKK + off + vo); q.k = *(const u2v*)(pK + off + vo);      \
    q.r = *(const u2v*)(pR + off + vo); q.v = *(const u2v*)(pV + off + vo);        \
  }
#define RH_STEP(q, gq)                                                             \
  {                                                                                \
    if ((gq) >= RW_NSLOT && cmin < (gq) - RW_NSLOT + 1) {                          \
      do {                                                                         \
        const int c0_ = cflag[0], c1_ = cflag[1], c2_ = cflag[2], c3_ = cflag[3];  \
        cmin = __builtin_amdgcn_readfirstlane(min(min(c0_, c1_), min(c2_, c3_)));  \
        if (cmin < (gq) - RW_NSLOT + 1) __builtin_amdgcn_s_sleep(1);               \
      } while (cmin < (gq) - RW_NSLOT + 1);                                        \
    }                                                                              \
    asm volatile("" ::: "memory");                                                 \
    char* sl = ring + ((gq) % RW_NSLOT) * RW_SLOTB;                                \
    const f4v a_ = CV4(q.a), kk_ = CV4(q.kk);                                      \
    const f4v kka_ = kk_ * a_, kd_ = CV4(q.k) * (a_ * ka4 + om4);                  \
    *(u2v*)(sl + 0 * 512 + wofs) = q.w;                                            \
    *(u2v*)(sl + 1 * 512 + wofs) = q.kk;                                           \
    *(u2v*)(sl + 2 * 512 + wofs) = __builtin_bit_cast(u2v, __builtin_convertvector(kka_, h16x4)); \
    *(u2v*)(sl + 3 * 512 + wofs) = __builtin_bit_cast(u2v, __builtin_convertvector(kd_, h16x4));  \
    *(u2v*)(sl + 4 * 512 + wofs) = q.r;                                            \
    *(u2v*)(sl + vwofs) = q.v;                                                     \
    asm volatile("s_waitcnt lgkmcnt(0)" ::: "memory");     \
    *pflag = (gq) + 1;                                                             \
  }
  RH_LOAD(q0, 0); RH_LOAD(q1, 1); RH_LOAD(q2, 2); RH_LOAD(q3, 3); RH_LOAD(q4, 4); RH_LOAD(q5, 5); RH_LOAD(q6, 6); RH_LOAD(q7, 7);
#pragma unroll 1
  for (int g = 0; g < RW_NG; g += 8) {
    RH_STEP(q0, g); RH_LOAD(q0, g + 8); __builtin_amdgcn_sched_barrier(0);
    RH_STEP(q1, g + 1); RH_LOAD(q1, g + 9); __builtin_amdgcn_sched_barrier(0);
    RH_STEP(q2, g + 2); RH_LOAD(q2, g + 10); __builtin_amdgcn_sched_barrier(0);
    RH_STEP(q3, g + 3); RH_LOAD(q3, g + 11); __builtin_amdgcn_sched_barrier(0);
    RH_STEP(q4, g + 4); RH_LOAD(q4, g + 12); __builtin_amdgcn_sched_barrier(0);
    RH_STEP(q5, g + 5); RH_LOAD(q5, g + 13); __builtin_amdgcn_sched_barrier(0);
    RH_STEP(q6, g + 6); RH_LOAD(q6, g + 14); __builtin_amdgcn_sched_barrier(0);
    RH_STEP(q7, g + 7); RH_LOAD(q7, g + 15); __builtin_amdgcn_sched_barrier(0);
  }
#undef RH_LOAD
#undef RH_STEP
#undef CV4
}

DEV void rwkv_consumer(const Params& p, const Ctx& cx, int l, int task, int lane, const char* ring, int widx) {
  const int unit = task >> 4, d = unit & 1, h = (unit >> 1) & 15, b = unit >> 5;
  const int j = lane >> 4, s = lane & 15;
  const int myrow = (task & 15) * 4 + j;
  char* pO = (char*)((h16*)(p.ws + OFF_REG2) + (size_t)d * ARR + h * 64);
  const int sm = d ? 3 - (s & 3) : (s & 3);
  const unsigned vov0 = (unsigned)(sm * 2048 + myrow * 2);
  const unsigned rofs = (unsigned)(s * 8);
  const unsigned vrofs = (unsigned)(2560 + myrow * 2);
  LAS3 volatile int* pflag = (LAS3 volatile int*)(ring + RW_FLAGS);
  LAS3 volatile int* cflag = (LAS3 volatile int*)(ring + RW_FLAGS + 64) + widx;
  float S0 = 0.f, S1 = 0.f, S2 = 0.f, S3 = 0.f;
  int pseen = 0;
  struct GD { u2v w[4], kk[4], kka[4], kd[4], r[4]; unsigned v[4]; };
  GD A, B;
#define RC_WAIT(gq) { if (pseen <= (gq)) { do { pseen = __builtin_amdgcn_readfirstlane(*pflag); if (pseen <= (gq)) __builtin_amdgcn_s_sleep(1); } while (pseen <= (gq)); } asm volatile("" ::: "memory"); }
#define RC_LOAD(G, gq)                                                             \
  {                                                                                \
    const char* sl = ring + ((gq) % RW_NSLOT) * RW_SLOTB;                          \
    _Pragma("unroll") for (int u = 0; u < 4; ++u) {                                \
      G.w[u] = *(const u2v*)(sl + 0 * 512 + u * 128 + rofs);                       \
      G.kk[u] = *(const u2v*)(sl + 1 * 512 + u * 128 + rofs);                      \
      G.kka[u] = *(const u2v*)(sl + 2 * 512 + u * 128 + rofs);                     \
      G.kd[u] = *(const u2v*)(sl + 3 * 512 + u * 128 + rofs);                      \
      G.r[u] = *(const u2v*)(sl + 4 * 512 + u * 128 + rofs);                       \
      G.v[u] = *(const unsigned short*)(sl + u * 128 + vrofs);                     \
    }                                                                              \
  }
#define RC_COMP(G, gq)                                                             \
  {                                                                                \
    float dres[4];                                                                 \
    _Pragma("unroll") for (int u = 0; u < 4; ++u) {                                \
        \
        \
      float ea, eb, x_, y_, t0, t1, t2, t3;                                        \
      asm("v_fma_mix_f32 %6, %0, %12, 0 op_sel:[0,0,0] op_sel_hi:[0,1,0]\n\t"      \
          "v_fma_mix_f32 %7, %2, %13, 0 op_sel:[0,0,0] op_sel_hi:[0,1,0]\n\t"      \
          "v_fma_mix_f32 %6, %1, %12, %6 op_sel:[0,1,0] op_sel_hi:[0,1,0]\n\t"     \
          "v_fma_mix_f32 %7, %3, %13, %7 op_sel:[0,1,0] op_sel_hi:[0,1,0]\n\t"     \
          "v_fma_mix_f32 %8, %22, %16, 0 op_sel:[0,0,0] op_sel_hi:[1,1,0]\n\t"     \
          "v_add_f32 %6, %6, %7\n\t"                                               \
          "v_fma_mix_f32 %9, %22, %16, 0 op_sel:[0,1,0] op_sel_hi:[1,1,0]\n\t"     \
          "v_fma_mix_f32 %10, %22, %17, 0 op_sel:[0,0,0] op_sel_hi:[1,1,0]\n\t"    \
          "v_add_f32_dpp %6, %6, %6 quad_perm:[1,0,3,2] row_mask:0xf bank_mask:0xf bound_ctrl:1\n\t" \
          "v_fma_mix_f32 %11, %22, %17, 0 op_sel:[0,1,0] op_sel_hi:[1,1,0]\n\t"    \
          "v_fma_mix_f32 %0, %0, %14, %8 op_sel:[0,0,0] op_sel_hi:[0,1,0]\n\t"     \
          "v_add_f32_dpp %6, %6, %6 quad_perm:[2,3,0,1] row_mask:0xf bank_mask:0xf bound_ctrl:1\n\t" \
          "v_fma_mix_f32 %1, %1, %14, %9 op_sel:[0,1,0] op_sel_hi:[0,1,0]\n\t"     \
          "v_fma_mix_f32 %2, %2, %15, %10 op_sel:[0,0,0] op_sel_hi:[0,1,0]\n\t"    \
          "v_add_f32_dpp %6, %6, %6 row_half_mirror row_mask:0xf bank_mask:0xf bound_ctrl:1\n\t" \
          "v_fma_mix_f32 %3, %3, %15, %11 op_sel:[0,1,0] op_sel_hi:[0,1,0]\n\t"    \
          "s_nop 0\n\t"                                                            \
          "v_add_f32_dpp %6, %6, %6 row_mirror row_mask:0xf bank_mask:0xf bound_ctrl:1\n\t" \
          "v_fma_mix_f32 %0, -%6, %18, %0 op_sel:[0,0,0] op_sel_hi:[0,1,0]\n\t"    \
          "v_fma_mix_f32 %1, -%6, %18, %1 op_sel:[0,1,0] op_sel_hi:[0,1,0]\n\t"    \
          "v_fma_mix_f32 %2, -%6, %19, %2 op_sel:[0,0,0] op_sel_hi:[0,1,0]\n\t"    \
          "v_fma_mix_f32 %3, -%6, %19, %3 op_sel:[0,1,0] op_sel_hi:[0,1,0]\n\t"    \
          "v_fma_mix_f32 %4, %0, %20, 0 op_sel:[0,0,0] op_sel_hi:[0,1,0]\n\t"      \
          "v_fma_mix_f32 %5, %2, %21, 0 op_sel:[0,0,0] op_sel_hi:[0,1,0]\n\t"      \
          "v_fma_mix_f32 %4, %1, %20, %4 op_sel:[0,1,0] op_sel_hi:[0,1,0]\n\t"     \
          "v_fma_mix_f32 %5, %3, %21, %5 op_sel:[0,1,0] op_sel_hi:[0,1,0]"         \
          : "+v"(S0), "+v"(S1), "+v"(S2), "+v"(S3), "=&v"(ea), "=&v"(eb), "=&v"(x_), "=&v"(y_),                     \
            "=&v"(t0), "=&v"(t1), "=&v"(t2), "=&v"(t3)                                                              \
          : "v"(G.kk[u].x), "v"(G.kk[u].y), "v"(G.w[u].x), "v"(G.w[u].y), "v"(G.kd[u].x), "v"(G.kd[u].y),           \
            "v"(G.kka[u].x), "v"(G.kka[u].y), "v"(G.r[u].x), "v"(G.r[u].y), "v"(G.v[u]));                           \
      dres[u] = ea + eb;     \
    }                                                                              \
    asm volatile("" ::: "memory");                                                 \
    *cflag = (gq) + 1;     \
    {                                                                              \
      int rlo; RW_RLO(gq, rlo);                                                    \
      unsigned vov = vov0; asm volatile("" : "+v"(vov));                           \
        \
      const bool p1_ = (s & 1) != 0, p2_ = (s & 2) != 0;                           \
      const float a_ = (p1_ ? dres[1] : dres[0]) + dpp_mov<0xB1>(p1_ ? dres[0] : dres[1]); \
      const float b_ = (p1_ ? dres[3] : dres[2]) + dpp_mov<0xB1>(p1_ ? dres[2] : dres[3]); \
      float val = (p2_ ? b_ : a_) + dpp_mov<0x4E>(p2_ ? a_ : b_);                  \
      val += dpp_mov<0x124>(val);                                                  \
      val += dpp_mov<0x128>(val);                                                  \
      *(h16*)(pO + (size_t)rlo * 2048 + vov) = (h16)val;                           \
    }                                                                              \
  }
  RC_WAIT(0); RC_LOAD(A, 0);
#pragma unroll 1
  for (int g = 0; g < RW_NG; g += 2) {
    RC_WAIT(g + 1); RC_LOAD(B, g + 1);
    RC_COMP(A, g);
    if (g + 2 < RW_NG) { RC_WAIT(g + 2); RC_LOAD(A, g + 2); }
    RC_COMP(B, g + 1);
  }
#undef RC_WAIT
#undef RC_LOAD
#undef RC_COMP
}
#undef RW_RLO

DEV void phase_scan(const Params& p, const Ctx& cx, int l, char* smem) {
  const int lane = cx.tid & 63, wid = __builtin_amdgcn_readfirstlane(cx.tid >> 6);
  for (int slot = cx.bid; slot < 256; slot += cx.nblk) {
    __syncthreads();
    if (wid == 4 && lane < 8) *(LAS3 volatile int*)(smem + RW_FLAGS + (lane == 0 ? 0 : 64 + (lane & 3) * 4)) = 0;
    __syncthreads();
    const int unit = slot & 63;
#ifndef NO_RWKV
    if (wid < 4) { __builtin_amdgcn_s_setprio(3); rwkv_consumer(p, cx, l, (unit << 4) | ((slot >> 6) << 2) | wid, lane, smem, wid); __builtin_amdgcn_s_setprio(0); }
    else if (wid == 4) { __builtin_amdgcn_s_setprio(1); rwkv_helper(p, cx, l, unit, lane, smem); __builtin_amdgcn_s_setprio(0); }
#endif
  }
  if (wid >= 5) {
    char* wl = smem + 32768 + (wid - 5) * 17408;
    for (int u = cx.bid * 3 + (wid - 5); u < 2 * 32 * 65; u += cx.nblk * 3) {
      if (l == 1 && (u % 65) == 0) continue;
#ifndef NO_S5P3
      s5_pass3_unit(p, cx, l, u, wl, lane);
#endif
    }
  }
}

DEV void pool_item(const Params& p, const Ctx& cx, int l, int item, char* smem) {
  const int tid = cx.tid;
  const h16* zrest = (const h16*)(p.ws + OFF_ZREST);
  bf16_t* ym = (bf16_t*)(p.ws + OFF_YM);
  const char* wt = p.ws + OFF_WT + (size_t)l * WT_SIZE;
  float* V = (float*)smem;
  char* At = smem + 43008;
  int g, rowout0, Lseq, p0, rlo, rhi, rstride, rowsrc0;
  if (item < 2048) {
    g = item & 3; int r = (item >> 2) & 255, b = item >> 10;
    int w = 2 << g;
    rlo = max(r - w / 2, 0); rhi = min(r + w / 2 - 1, 255);
    rowsrc0 = b * 16384; rstride = 64;
    rowout0 = b * 16384 + r * 64; Lseq = 64; p0 = 0;
  } else {
    int it = item - 2048;
    g = it & 3; int tq = (it >> 2) & 3, b = it >> 4;
    rlo = 0; rhi = 0; rowsrc0 = NLAT + b * 256; rstride = 0;
    rowout0 = NLAT + b * 256 + tq * 64; Lseq = 256; p0 = tq * 64;
  }
  const int w = 2 << g;
  const float invr = 1.f / (float)(rhi - rlo + 1);
  for (int unit = tid; unit < 80 * 16; unit += NTHREADS) {
    int lp = unit >> 4, ch8 = unit & 15;
    int pos = p0 - 8 + lp;
    float acc[8] = {0, 0, 0, 0, 0, 0, 0, 0};
    if (pos >= 0 && pos < Lseq) {
      const h16* bp = zrest + (size_t)(rowsrc0 + pos) * ZR + 1024 + g * 128 + ch8 * 8;
      const int nr = rhi - rlo + 1;
      for (int k0 = 0; k0 < nr; k0 += 4) {
        h16x8 v[4]; float wv[4];
#pragma unroll
        for (int i = 0; i < 4; ++i) {
          const int kk_ = min(k0 + i, nr - 1);
          wv[i] = (k0 + i < nr) ? 1.f : 0.f;
          v[i] = *(const h16x8*)(bp + (size_t)((rlo + kk_) * rstride) * ZR);
        }
#pragma unroll
        for (int i = 0; i < 4; ++i)
#pragma unroll
          for (int j = 0; j < 8; ++j) acc[j] += wv[i] * (float)v[i][j];
      }
    }
    float* vp = V + lp * 132 + ch8 * 8;
#pragma unroll
    for (int j = 0; j < 8; ++j) vp[j] = acc[j] * invr;
  }
  __syncthreads();
  for (int unit = tid; unit < 64 * 16; unit += NTHREADS) {
    int c = unit >> 4, ch8 = unit & 15;
    int pos = p0 + c;
    int lo = max(pos - w / 2, 0), hi = min(pos + w / 2 - 1, Lseq - 1);
    float acc[8] = {0, 0, 0, 0, 0, 0, 0, 0};
    for (int pp = lo; pp <= hi; ++pp) {
      const float* vp = V + (pp - p0 + 8) * 132 + ch8 * 8;
#pragma unroll
      for (int j = 0; j < 8; ++j) acc[j] += vp[j];
    }
    float invc = 1.f / (float)(hi - lo + 1);
    h16x8 uc = *(const h16x8*)(zrest + (size_t)(rowout0 + c) * ZR + 1024 + g * 128 + ch8 * 8);
    uint4 o;
    o.x = pack_bf2(acc[0] * invc - (float)uc[0], acc[1] * invc - (float)uc[1]);
    o.y = pack_bf2(acc[2] * invc - (float)uc[2], acc[3] * invc - (float)uc[3]);
    o.z = pack_bf2(acc[4] * invc - (float)uc[4], acc[5] * invc - (float)uc[5]);
    o.w = pack_bf2(acc[6] * invc - (float)uc[6], acc[7] * invc - (float)uc[7]);
    *(uint4*)(At + c * 272 + ch8 * 16) = o;
  }
  __syncthreads();
  const bf16_t* Bt = (const bf16_t*)(wt + WT_POOL) + (size_t)g * 128 * 128;
  const float* ps = p.pool_scale + (size_t)l * 512 + g * 128;
  small_gemm<128, 1>(p, cx, At, 272, Bt, (tid >> 6) * 16, [&](int m, int n, f32x4 v) {
    int row = rowout0 + m;
    float4 sc = *(const float4*)(ps + n);
    h16x4 gt = *(const h16x4*)(zrest + (size_t)row * ZR + 1536 + g * 128 + n);
    uint2 o;
    o.x = pack_bf2(v[0] * sc.x * silu_f((float)gt[0]), v[1] * sc.y * silu_f((float)gt[1]));
    o.y = pack_bf2(v[2] * sc.z * silu_f((float)gt[2]), v[3] * sc.w * silu_f((float)gt[3]));
    *(uint2*)(ym + (size_t)row * D + 512 + g * 128 + n) = o;
  });
}

DEV void glu_item(const Params& p, const Ctx& cx, int l, int tile, char* smem) {
  const int tid = cx.tid;
  const int row0 = tile * 64;
  const float* S5Y = (const float*)(p.ws + OFF_S5Y);
  const h16* zrest = (const h16*)(p.ws + OFF_ZREST);
  bf16_t* ym = (bf16_t*)(p.ws + OFF_YM);
  const char* wt = p.ws + OFF_WT + (size_t)l * WT_SIZE;
#pragma unroll
  for (int it = 0; it < 8; ++it) {
    int unit = tid + it * NTHREADS;
    int r = unit >> 6, c8 = unit & 63;
    const float* sp = S5Y + (size_t)(row0 + r) * 512 + c8 * 8;
    float4 a = *(const float4*)sp, bq = *(const float4*)(sp + 4);
    uint4 o;
    o.x = pack_bf2(a.x, a.y); o.y = pack_bf2(a.z, a.w); o.z = pack_bf2(bq.x, bq.y); o.w = pack_bf2(bq.z, bq.w);
    *(uint4*)(smem + r * 1040 + c8 * 16) = o;
  }
  __syncthreads();
  const bf16_t* Bt = (const bf16_t*)(wt + WT_GLU);
  const float* bg = p.b_glu + (size_t)l * 512;
  small_gemm<512, 4>(p, cx, smem, 1040, Bt, (tid >> 6) * 64, [&](int m, int n, f32x4 v) {
    int row = row0 + m;
    float4 y = *(const float4*)(S5Y + (size_t)row * 512 + n);
    float4 bb = *(const float4*)(bg + n);
    h16x4 gt = *(const h16x4*)(zrest + (size_t)row * ZR + 512 + n);
    uint2 o;
    o.x = pack_bf2(y.x * sigmoid_f(v[0] + bb.x) * silu_f((float)gt[0]), y.y * sigmoid_f(v[1] + bb.y) * silu_f((float)gt[1]));
    o.y = pack_bf2(y.z * sigmoid_f(v[2] + bb.z) * silu_f((float)gt[2]), y.w * sigmoid_f(v[3] + bb.w) * silu_f((float)gt[3]));
    *(uint2*)(ym + (size_t)row * D + n) = o;
  });
}

DEV void rwkvmerge_item(const Params& p, const Ctx& cx, int l, int tile) {
  const int tid = cx.tid;
  const int row0 = tile * 64;
  const h16* SC = (const h16*)(p.ws + OFF_SCAN);
  const h16* O = (const h16*)(p.ws + OFF_REG2);
  const h16* zrest = (const h16*)(p.ws + OFF_ZREST);
  bf16_t* ym = (bf16_t*)(p.ws + OFF_YM);
  const int grp = tid & 7, h = (tid >> 3) & 15;
  const int c0 = h * 64 + grp * 8;
  float pk[8], rk[8], gw[8], gb[8];
#pragma unroll
  for (int j = 0; j < 8; j += 4) {
    float4 t0 = *(const float4*)(p.rwkv_k_a + (size_t)l * 1024 + c0 + j), t1 = *(const float4*)(p.rwkv_r_k + (size_t)l * 1024 + c0 + j);
    float4 t2 = *(const float4*)(p.gn_w + (size_t)l * 1024 + c0 + j), t3 = *(const float4*)(p.gn_b + (size_t)l * 1024 + c0 + j);
    pk[j] = t0.x; pk[j + 1] = t0.y; pk[j + 2] = t0.z; pk[j + 3] = t0.w;
    rk[j] = t1.x; rk[j + 1] = t1.y; rk[j + 2] = t1.z; rk[j + 3] = t1.w;
    gw[j] = t2.x; gw[j + 1] = t2.y; gw[j + 2] = t2.z; gw[j + 3] = t2.w;
    gb[j] = t3.x; gb[j + 1] = t3.y; gb[j + 2] = t3.z; gb[j + 3] = t3.w;
  }
#pragma unroll 2
  for (int it = 0; it < 16; ++it) {
    const int tok = (tid >> 7) + it * 4;
    int row = row0 + tok;
    size_t off = (size_t)row * 1024 + c0;
    h16x8 of = *(const h16x8*)(O + off), ob = *(const h16x8*)(O + ARR + off);
    h16x8 r8 = *(const h16x8*)(SC + 0 * ARR + off), k8 = *(const h16x8*)(SC + 1 * ARR + off), v8 = *(const h16x8*)(SC + 2 * ARR + off);
    h16x8 af = *(const h16x8*)(SC + 4 * ARR + off), ab = *(const h16x8*)(SC + 5 * ARR + off);
    h16x8 gt = *(const h16x8*)(zrest + (size_t)row * ZR + 2048 + c0);
    float o[8], sm = 0;
#pragma unroll
    for (int j = 0; j < 8; ++j) { o[j] = (float)of[j] + (float)ob[j]; sm += o[j]; }
    sm = allreduce8(sm);
    float mu = sm * (1.f / 64.f), vq = 0;
#pragma unroll
    for (int j = 0; j < 8; ++j) { o[j] -= mu; vq += o[j] * o[j]; }
    vq = allreduce8(vq);
    float rstd = rsqrtf(vq * (1.f / 64.f) + 64e-5f);
    float part = 0;
#pragma unroll
    for (int j = 0; j < 8; ++j) {
      float ksum = (float)k8[j] * (2.f + ((float)af[j] + (float)ab[j] - 2.f) * pk[j]);
      part += (float)r8[j] * ksum * rk[j];
    }
    part = allreduce8(part);
    float res[8];
#pragma unroll
    for (int j = 0; j < 8; ++j) {
      float y = o[j] * rstd * gw[j] + gb[j] + part * (float)v8[j];
      res[j] = y * silu_f((float)gt[j]);
    }
    uint4 ov;
    ov.x = pack_bf2(res[0], res[1]); ov.y = pack_bf2(res[2], res[3]); ov.z = pack_bf2(res[4], res[5]); ov.w = pack_bf2(res[6], res[7]);
    *(uint4*)(ym + (size_t)row * D + 1024 + c0) = ov;
  }
}

DEV void phase_merge(const Params& p, const Ctx& cx0, int l, char* smem) {
  const int ntile = (l == 0) ? 520 : 512;
  const int npool = (l == 0) ? 2048 + 32 : 2048;
  const int total = npool + 2 * ntile;
  for (int item = cx0.bid; item < total; item += cx0.nblk) {
    __syncthreads();
    Ctx cx = cx0; asm volatile("" : "+v"(cx.tid));
    const int grp6 = item / 6, pos6 = item - grp6 * 6;
    if (pos6 < 4) pool_item(p, cx, l, grp6 * 4 + pos6, smem);
    else if (pos6 == 4) glu_item(p, cx, l, grp6, smem);
    else rwkvmerge_item(p, cx, l, grp6);
  }
}

#define XB_TMO      128
#define XB_XCNT(j)  (256  + 64 * (j))
#define XB_XSUB(j)  (1280 + 64 * (j))
#define XB_XGEN(j)  (2304 + 64 * (j))
#define XB_TOP      3328
#define XB_TOPGEN   3392
#define XCD_BAR_WORDS 3456
#define XB_SPIN_CAP (1u << 18)
DEV unsigned xb_ld(unsigned* p) { return __hip_atomic_load(p, __ATOMIC_RELAXED, __HIP_MEMORY_SCOPE_AGENT); }
DEV unsigned xb_add(unsigned* p, unsigned v) { return __hip_atomic_fetch_add(p, v, __ATOMIC_RELAXED, __HIP_MEMORY_SCOPE_AGENT); }
DEV unsigned xb_xcc_id() { return (unsigned)__builtin_amdgcn_s_getreg((3 << 11) | 20) & 0xFu; }
#define XB_SPIN(cond, bar) do { unsigned _sp = 0; while (cond) { __builtin_amdgcn_s_sleep(1); \
    if ((++_sp & 255u) == 0u) { if (xb_ld(&(bar)[XB_TMO])) break; if (_sp > XB_SPIN_CAP) { atomicAdd(&(bar)[XB_TMO], 1u); break; } } } } while (0)
struct XcdBarrier { unsigned* bar; unsigned x; volatile LAS3 unsigned* st; };
DEV XcdBarrier xcd_barrier_post(unsigned* bar, volatile LAS3 unsigned* st) {
  XcdBarrier b; b.bar = bar; b.x = xb_xcc_id(); b.st = st;
  if (threadIdx.x == 0) (void)xb_add(&bar[XB_XCNT(b.x)], 1u);
  return b;
}
DEV void xcd_barrier_complete(unsigned* bar, unsigned x, unsigned& nloc, unsigned& nx) {
  const unsigned G = gridDim.x * gridDim.y * gridDim.z;
  unsigned sum, cnt, mine, sp = 0u;
  for (;;) {
    sum = 0u; cnt = 0u; mine = 0u;
#pragma unroll
    for (unsigned j = 0; j < 16; ++j) { const unsigned c = xb_ld(&bar[XB_XCNT(j)]); sum += c; cnt += (c > 0u) ? 1u : 0u; mine = (j == x) ? c : mine; }
    if (sum == G) break;
    __builtin_amdgcn_s_sleep(1);
    if ((++sp & 255u) == 0u) { if (xb_ld(&bar[XB_TMO])) break; if (sp > XB_SPIN_CAP) { atomicAdd(&bar[XB_TMO], 1u); break; } }
  }
  nloc = mine > 0u ? mine : 1u; nx = cnt > 0u ? cnt : 1u;
}
DEV void xcd_barrier(const XcdBarrier& b) {
  asm volatile("s_waitcnt vmcnt(0)" ::: "memory");
  __syncthreads();
  if (threadIdx.x == 0) {
    unsigned* bar = b.bar;
    __builtin_amdgcn_s_waitcnt(0);
    unsigned nloc = b.st[0], nx = b.st[1];
    if (nloc == 0u) { xcd_barrier_complete(bar, b.x, nloc, nx); b.st[0] = nloc; b.st[1] = nx; }
    const unsigned old = xb_add(&bar[XB_XSUB(b.x)], 1u);
    const unsigned gen = old / nloc;
    if (old + 1u == (gen + 1u) * nloc) {
      __builtin_amdgcn_fence(__ATOMIC_RELEASE, "agent");
      asm volatile("s_waitcnt vmcnt(0)" ::: "memory");
      const unsigned og = xb_add(&bar[XB_TOP], 1u);
      const unsigned tg = og / nx;
      if (og + 1u == (tg + 1u) * nx) xb_add(&bar[XB_TOPGEN], 1u);
      else XB_SPIN(xb_ld(&bar[XB_TOPGEN]) == tg, bar);
      __builtin_amdgcn_fence(__ATOMIC_ACQUIRE, "agent");
      xb_add(&bar[XB_XGEN(b.x)], 1u);
      asm volatile("s_waitcnt vmcnt(0)" ::: "memory");
    } else {
      XB_SPIN(xb_ld(&bar[XB_XGEN(b.x)]) == gen, bar);
      __builtin_amdgcn_fence(__ATOMIC_ACQUIRE, "agent");
      asm volatile("s_waitcnt vmcnt(0)" ::: "memory");
    }
  }
  __syncthreads();
}

#define LCX Ctx c2 = cx; asm volatile("" : "+v"(c2.tid))
#ifndef GEMM_FN
#define GEMM_FN gemm_phase2
#endif
__global__ void __launch_bounds__(NTHREADS) mega_fwd(Params p, int ph0, int ph1) {
  extern __shared__ __attribute__((aligned(16))) char smem[];
  cg::grid_group grid = cg::this_grid();
  __shared__ uint4 xb_words;
  if (threadIdx.x == 0) xb_words = make_uint4(0u, 0u, 0u, 0u);
  __syncthreads();
  XcdBarrier xb; xb.bar = (unsigned*)(p.ws + OFF_BAR); xb.x = xb_xcc_id(); xb.st = (volatile LAS3 unsigned*)&xb_words;
  if (blockIdx.x == 0) for (int i = threadIdx.x; i < XCD_BAR_WORDS; i += NTHREADS) xb.bar[i] = 0u;
  const int wave_s = __builtin_amdgcn_readfirstlane((int)(threadIdx.x >> 6));
  for (int step = ph0; step < ph1; ++step) {
    if (step == ph0 + 1) { grid.sync(); if (threadIdx.x == 0) (void)xb_add(&xb.bar[XB_XCNT(xb.x)], 1u); } else if (step > ph0) xcd_barrier(xb);
    const int ph = (int)((PH_SEQ >> (4 * step)) & 15ull);
    Ctx cx;
    {
      int t_, b_ = blockIdx.x, n_ = gridDim.x;
      asm volatile("v_mbcnt_lo_u32_b32 %0, -1, 0\n\tv_mbcnt_hi_u32_b32 %0, -1, %0\n\tv_lshl_add_u32 %0, %1, 6, %0" : "=&v"(t_) : "s"(wave_s));
      asm volatile("" : "+s"(b_), "+s"(n_));
      cx.tid = t_; cx.bid = b_; cx.nblk = n_;
    }
    const int l = ph >= 8 ? 1 : 0;
    const int lp = ph >= 8 ? ph - 6 : ph;
#ifndef PHMASK
#define PHMASK 0xff
#endif
    if (ph == 0) { if (PHMASK & 1) { LCX; phase0(p, c2, smem, 0); } }
    else if (ph == 1) {
      if (PHMASK & 2) { LCX; if (c2.bid & 1) { phase_adaln0(p, c2); phase0(p, c2, smem, 1); } else { phase0(p, c2, smem, 1); phase_adaln0(p, c2); } }
    }
    else if (lp == 2 && (PHMASK & 4)) {
      LCX;
      h16* zrest = (h16*)(p.ws + OFF_ZREST);
      h16* zc = (h16*)(p.ws + OFF_REG2);
      GEMM_FN(p, c2, (const bf16_t*)(p.ws + OFF_H), (const bf16_t*)(p.ws + OFF_WT + (size_t)l * WT_SIZE + WT_IN), 2048, 130, 25, smem,
                 [&](int row, int col, f32x4 v, f32x4 u) {
                   h16* dst;
                   if (col < 2048) dst = zrest + (size_t)row * ZR + col;
                   else if (col < 5120) dst = zc + (size_t)row * ZC + (col - 2048);
                   else if (col < 6144) dst = zrest + (size_t)row * ZR + 2048 + (col - 5120);
                   else dst = zc + (size_t)row * ZC + 3072 + (col - 6144);
                   h16x8 o = {(h16)v[0], (h16)v[1], (h16)v[2], (h16)v[3], (h16)u[0], (h16)u[1], (h16)u[2], (h16)u[3]};
                   *(h16x8*)dst = o;
                 });
    } else if (lp == 3) { if (PHMASK & 8) { LCX; phase_prep(p, c2, l, smem); } }
    else if (lp == 4) { if (PHMASK & 16) { LCX; phase_scan(p, c2, l, smem); } }
    else if (lp == 5) { if (PHMASK & 32) { LCX; phase_merge(p, c2, l, smem); } }
    else if (lp == 6 && (PHMASK & 64)) {
      LCX;
      const float* mods = (const float*)(p.ws + OFF_MODS);
      float* prec = (float*)(p.ws + OFF_PREC);
      const float* xin = (l == 0) ? p.x : p.out;
      GEMM_FN(p, c2, (const bf16_t*)(p.ws + OFF_YM), (const bf16_t*)(p.ws + OFF_WT + (size_t)l * WT_SIZE + WT_OUT), 2048, l == 0 ? 130 : 128, 8, smem,
                 [&](int row, int col, f32x4 v, f32x4 u) {
                   const float* xr; const float* gr; float* dr;
                   if (row < NLAT) {
                     xr = xin + (size_t)row * D + col; gr = mods + (size_t)(l * 3 + (row >> 14)) * 6144 + 4096 + col; dr = p.out + (size_t)row * D + col;
                   } else {
                     xr = p.ctx + (size_t)(row - NLAT) * D + col; gr = mods + (size_t)(l * 3 + 2) * 6144 + 4096 + col; dr = prec + (size_t)(row - NLAT) * D + col;
                   }
                   const float4 x0 = *(const float4*)xr, x1 = *(const float4*)(xr + 4), g0 = *(const float4*)gr, g1 = *(const float4*)(gr + 4);
                   float4 r0, r1;
                   r0.x = ALPHA * x0.x + g0.x * v[0]; r0.y = ALPHA * x0.y + g0.y * v[1]; r0.z = ALPHA * x0.z + g0.z * v[2]; r0.w = ALPHA * x0.w + g0.w * v[3];
                   r1.x = ALPHA * x1.x + g1.x * u[0]; r1.y = ALPHA * x1.y + g1.y * u[1]; r1.z = ALPHA * x1.z + g1.z * u[2]; r1.w = ALPHA * x1.w + g1.w * u[3];
                   *(float4*)dr = r0; *(float4*)(dr + 4) = r1;
                 });
    } else if (lp == 7) { if (PHMASK & 128) { LCX; phase_finln(p, c2, l); } }
  }
}

constexpr int NPHASES = PH_NSTEPS;

extern "C" void kernel_launch(void* const* d_in, const int* in_sizes, int n_in, void* d_out, int out_size, void* d_ws, size_t ws_size,
                              hipStream_t stream) {
  static int grid_blocks = 0;
  if (grid_blocks == 0) {
    if (n_in != 32 || ws_size < WS_END) { fprintf(stderr, "kernel_launch: unexpected n_in %d / ws %zu (need %zu)\n", n_in, ws_size, (size_t)WS_END); grid_blocks = -1; return; }
    int dev = 0, cus = 0, per_cu = 0;
    hipGetDevice(&dev);
    hipDeviceGetAttribute(&cus, hipDeviceAttributeMultiprocessorCount, dev);
    if (hipFuncSetAttribute((const void*)mega_fwd, hipFuncAttributeMaxDynamicSharedMemorySize, LDS_BYTES) != hipSuccess) { fprintf(stderr, "hipFuncSetAttribute failed\n"); grid_blocks = -1; return; }
    if (hipOccupancyMaxActiveBlocksPerMultiprocessor(&per_cu, (const void*)mega_fwd, NTHREADS, LDS_BYTES) != hipSuccess || per_cu < 1) {
      fprintf(stderr, "occupancy query gave %d\n", per_cu); (void)hipGetLastError(); per_cu = 1;
    }
    grid_blocks = cus * per_cu;
  }
  if (grid_blocks < 0) return;
  Params p{};
  const float** pp = (const float**)&p;
  for (int i = 0; i < 32; ++i) pp[i] = (const float*)d_in[i];
  p.out = (float*)d_out;
  p.ws = (char*)d_ws;
  int ph0 = 0, ph1 = NPHASES;
  void* args[] = {&p, &ph0, &ph1};
  hipError_t e = hipLaunchCooperativeKernel((const void*)mega_fwd, dim3(grid_blocks), dim3(NTHREADS), args, LDS_BYTES, stream);
  if (e != hipSuccess) fprintf(stderr, "cooperative launch failed: %s (grid %d)\n", hipGetErrorString(e), grid_blocks);
}
```

```cpp
#include <hip/hip_runtime.h>
#include <hip/hip_cooperative_groups.h>
#include <cstdio>
namespace cg = cooperative_groups;

typedef unsigned short bf16_t;
typedef _Float16 h16;
using bf16x8 = __attribute__((ext_vector_type(8))) _Float16;
using f32x4 = __attribute__((ext_vector_type(4))) float;
using h16x4 = __attribute__((ext_vector_type(4))) _Float16;
using h16x8 = __attribute__((ext_vector_type(8))) _Float16;

#define DEV __device__ __forceinline__

constexpr int D = 2048, NLAT = 32768, MTOT = 33280, ZR = 3072, ZC = 3328;
constexpr int NTHREADS = 512;
constexpr int LDS_BYTES = 147456;
constexpr float ALPHA = 1.41421356237f;
constexpr float DECAY_SCALE = 0.606531f;

constexpr size_t al256(size_t x) { return (x + 255) & ~size_t(255); }
constexpr size_t ARR = (size_t)MTOT * 1024;
constexpr size_t OFF_MODS = 0;
constexpr size_t OFF_S5F = al256(OFF_MODS + 2 * 3 * 6144 * 4);
constexpr size_t OFF_PREC = al256(OFF_S5F + (size_t)2 * 32 * 65 * 2 * 64 * 8);
constexpr size_t OFF_WT = al256(OFF_PREC + (size_t)512 * 2048 * 4);
constexpr size_t WT_IN = 0, WT_OUT = 26214400, WT_W2 = 34603008, WT_A2 = 34865152, WT_POOL = 35127296, WT_GLU = 35258368, WT_SIZE = 35782656;
constexpr size_t OFF_ZREST = al256(OFF_WT + 2 * WT_SIZE);
constexpr size_t OFF_REG2 = al256(OFF_ZREST + (size_t)MTOT * ZR * 2);
constexpr size_t OFF_S5Y = OFF_REG2 + 2 * ARR * 2;
constexpr size_t OFF_SCAN = al256(OFF_REG2 + (size_t)MTOT * ZC * 2);
constexpr size_t OFF_H = OFF_SCAN;
constexpr size_t OFF_YM = OFF_SCAN + 6 * ARR * 2;
constexpr size_t OFF_BAR = al256(OFF_SCAN + 8 * ARR * 2);
constexpr size_t WS_END = OFF_BAR + 16384;

#ifndef PH_SEQ
#define PH_SEQ 0xDCBA9876543210ull
#define PH_NSTEPS 14
#endif
struct Params {
  const float *x, *c, *ctx, *c_ctx, *w_ada, *b_ada, *w_in, *conv_rkv, *s5_lam_re, *s5_lam_im, *s5_log_step,
      *s5_b_re, *s5_b_im, *s5_c_re, *s5_c_im, *s5_d, *w_glu, *b_glu, *w_pool, *pool_scale,
      *rwkv_w0, *rwkv_w2, *rwkv_a0, *rwkv_a2, *rwkv_k_k, *rwkv_k_a, *rwkv_r_k, *gn_w, *gn_b,
      *w_out, *ln_g, *ln_b;
  float* out;
  char* ws;
};
struct Ctx { int tid, bid, nblk; };

DEV float rcp_f(float x) { return __builtin_amdgcn_rcpf(x); }
DEV float sigmoid_f(float x) { return rcp_f(1.f + __expf(-x)); }
DEV float silu_f(float x) { return x * rcp_f(1.f + __expf(-x)); }
DEV float tanh_f(float x) { float e = __expf(2.f * x); return 1.f - 2.f * rcp_f(e + 1.f); }
DEV float gelu_f(float y) { return 0.5f * y * (1.f + tanh_f(0.7978845608f * (y + 0.044715f * y * y * y))); }
using h16x2 = __attribute__((ext_vector_type(2))) _Float16;
DEV unsigned pack_bf2(float a, float b) { h16x2 v = {(h16)a, (h16)b}; return __builtin_bit_cast(unsigned, v); }
template <int CTRL> DEV float dpp_mov(float v) {
  return __int_as_float(__builtin_amdgcn_update_dpp(0, __float_as_int(v), CTRL, 0xf, 0xf, true));
}
DEV float allreduce16(float v) {
  v += dpp_mov<0xB1>(v);
  v += dpp_mov<0x4E>(v);
  v += dpp_mov<0x141>(v);
  v += dpp_mov<0x140>(v);
  return v;
}
DEV float wave_sum(float v) {
  v = allreduce16(v);
  return __builtin_amdgcn_readlane(__float_as_int(v), 0) == 0 && false ? 0.f :
         __int_as_float(__builtin_amdgcn_readlane(__float_as_int(v), 0)) + __int_as_float(__builtin_amdgcn_readlane(__float_as_int(v), 16)) +
         __int_as_float(__builtin_amdgcn_readlane(__float_as_int(v), 32)) + __int_as_float(__builtin_amdgcn_readlane(__float_as_int(v), 48));
}
DEV float allreduce8(float v) {
  v += dpp_mov<0xB1>(v);
  v += dpp_mov<0x4E>(v);
  v += dpp_mov<0x141>(v);
  return v;
}
DEV void lds_fence() { asm volatile("s_waitcnt lgkmcnt(0)" ::: "memory"); }

DEV void p0_mods_item(const Params& p, const Ctx& cx, int item, char* smem) {
  float* red = (float*)smem;
  float* mods = (float*)(p.ws + OFF_MODS);
  int l = item / 96, chunk = item % 96;
  int tid = cx.tid, kq = tid >> 6, col = tid & 63;
  int n = chunk * 64 + col;
  const float* W = p.w_ada + (size_t)l * 2048 * 6144;
  float a0 = 0, a1 = 0, a2 = 0;
#pragma unroll 8
  for (int k = kq; k < 2048; k += 8) {
    float w = W[(size_t)k * 6144 + n];
    a0 += silu_f(p.c[k]) * w;
    a1 += silu_f(p.c[2048 + k]) * w;
    a2 += silu_f(p.c_ctx[k]) * w;
  }
  red[(kq * 3 + 0) * 64 + col] = a0;
  red[(kq * 3 + 1) * 64 + col] = a1;
  red[(kq * 3 + 2) * 64 + col] = a2;
  __syncthreads();
  if (tid < 192) {
    int r = tid >> 6, cc = tid & 63;
    float s = 0;
#pragma unroll
    for (int q = 0; q < 8; ++q) s += red[(q * 3 + r) * 64 + cc];
    mods[(size_t)(l * 3 + r) * 6144 + chunk * 64 + cc] = s + p.b_ada[(size_t)l * 6144 + chunk * 64 + cc];
  }
}

DEV void p0_transpose_tile(const Params& p, const Ctx& cx, const float* __restrict__ src, bf16_t* __restrict__ dst, int K, int N, int tk, int tn, char* smem) {
  float* T = (float*)smem;
  int tid = cx.tid;
  int k0 = tk * 64, n0 = tn * 64;
  int kk = tid >> 4, n4 = tid & 15;
#pragma unroll
  for (int i = 0; i < 2; ++i) {
    int k = kk + 32 * i;
    float4 v = *(const float4*)(src + (size_t)(k0 + k) * N + n0 + n4 * 4);
    T[k * 65 + n4 * 4 + 0] = v.x; T[k * 65 + n4 * 4 + 1] = v.y; T[k * 65 + n4 * 4 + 2] = v.z; T[k * 65 + n4 * 4 + 3] = v.w;
  }
  __syncthreads();
  int n = tid >> 3, k8 = tid & 7;
  uint4 o;
  o.x = pack_bf2(T[(k8 * 8 + 0) * 65 + n], T[(k8 * 8 + 1) * 65 + n]);
  o.y = pack_bf2(T[(k8 * 8 + 2) * 65 + n], T[(k8 * 8 + 3) * 65 + n]);
  o.z = pack_bf2(T[(k8 * 8 + 4) * 65 + n], T[(k8 * 8 + 5) * 65 + n]);
  o.w = pack_bf2(T[(k8 * 8 + 6) * 65 + n], T[(k8 * 8 + 7) * 65 + n]);
  *(uint4*)(dst + (size_t)(n0 + n) * K + k0 + k8 * 8) = o;
}

DEV void phase0(const Params& p, const Ctx& cx0, char* smem, int part) {
  const int NTR = 4368;
  const int total = part == 0 ? 192 : 192 + 2 * NTR;
  for (int item = (part == 0 ? 0 : 192) + cx0.bid; item < total; item += cx0.nblk) {
    __syncthreads();
    Ctx cx = cx0; asm volatile("" : "+v"(cx.tid));
    if (item < 192) { p0_mods_item(p, cx, item, smem); continue; }
    int it = item - 192;
    int l = it / NTR, i = it % NTR;
    char* wt = p.ws + OFF_WT + (size_t)l * WT_SIZE;
    if (i < 3200) {
      p0_transpose_tile(p, cx, p.w_in + (size_t)l * 2048 * 6400, (bf16_t*)(wt + WT_IN), 2048, 6400, i / 100, i % 100, smem);
    } else if (i < 4224) {
      int j = i - 3200;
      p0_transpose_tile(p, cx, p.w_out + (size_t)l * 2048 * 2048, (bf16_t*)(wt + WT_OUT), 2048, 2048, j / 32, j % 32, smem);
    } else if (i < 4256) {
      int j = i - 4224, d = j / 16;
      p0_transpose_tile(p, cx, p.rwkv_w2 + (size_t)(l * 2 + d) * 64 * 1024, (bf16_t*)(wt + WT_W2) + (size_t)d * 1024 * 64, 64, 1024, 0, j % 16, smem);
    } else if (i < 4288) {
      int j = i - 4256, d = j / 16;
      p0_transpose_tile(p, cx, p.rwkv_a2 + (size_t)(l * 2 + d) * 64 * 1024, (bf16_t*)(wt + WT_A2) + (size_t)d * 1024 * 64, 64, 1024, 0, j % 16, smem);
    } else if (i < 4304) {
      int j = i - 4288, g = j / 4;
      p0_transpose_tile(p, cx, p.w_pool + (size_t)(l * 4 + g) * 128 * 128, (bf16_t*)(wt + WT_POOL) + (size_t)g * 128 * 128, 128, 128, (j % 4) / 2, j % 2, smem);
    } else {
      int j = i - 4304;
      p0_transpose_tile(p, cx, p.w_glu + (size_t)l * 512 * 512, (bf16_t*)(wt + WT_GLU), 512, 512, j / 8, j % 8, smem);
    }
  }
}

DEV void phase_adaln0(const Params& p, const Ctx& cx) {
  const float* mods = (const float*)(p.ws + OFF_MODS);
  bf16_t* hbuf = (bf16_t*)(p.ws + OFF_H);
  int lane = cx.tid & 63;
  int gw = cx.bid * 8 + (cx.tid >> 6), nw = cx.nblk * 8;
  for (int row = gw; row < MTOT; row += nw) {
    const float* src = row < NLAT ? p.x + (size_t)row * D : p.ctx + (size_t)(row - NLAT) * D;
    int mr = row < NLAT ? (row >> 14) : 2;
    const float* md = mods + (size_t)mr * 6144;
    float4 v[8];
    float s = 0;
#pragma unroll
    for (int i = 0; i < 8; ++i) { v[i] = *(const float4*)(src + i * 256 + lane * 4); s += v[i].x + v[i].y + v[i].z + v[i].w; }
    float mu = wave_sum(s) * (1.f / 2048.f);
    float q = 0;
#pragma unroll
    for (int i = 0; i < 8; ++i) { v[i].x -= mu; v[i].y -= mu; v[i].z -= mu; v[i].w -= mu; q += v[i].x * v[i].x + v[i].y * v[i].y + v[i].z * v[i].z + v[i].w * v[i].w; }
    float rstd = rsqrtf(wave_sum(q) * (1.f / 2048.f) + 1e-6f);
#pragma unroll
    for (int i = 0; i < 8; ++i) {
      int col = i * 256 + lane * 4;
      float4 sh = *(const float4*)(md + col), sc = *(const float4*)(md + 2048 + col);
      uint2 o;
      o.x = pack_bf2(v[i].x * rstd * (1.f + sc.x) + sh.x, v[i].y * rstd * (1.f + sc.y) + sh.y);
      o.y = pack_bf2(v[i].z * rstd * (1.f + sc.z) + sh.z, v[i].w * rstd * (1.f + sc.w) + sh.w);
      *(uint2*)(hbuf + (size_t)row * D + col) = o;
    }
  }
}

DEV void phase_finln(const Params& p, const Ctx& cx, int l) {
  const float* mods = (const float*)(p.ws + OFF_MODS);
  bf16_t* hbuf = (bf16_t*)(p.ws + OFF_H);
  float* prec = (float*)(p.ws + OFF_PREC);
  int lane = cx.tid & 63;
  int gw = cx.bid * 8 + (cx.tid >> 6), nw = cx.nblk * 8;
  const int nrows = (l == 0) ? MTOT : NLAT;
  for (int row = gw; row < nrows; row += nw) {
    float* src = row < NLAT ? p.out + (size_t)row * D : prec + (size_t)(row - NLAT) * D;
    float4 v[8];
    float s = 0;
#pragma unroll
    for (int i = 0; i < 8; ++i) { v[i] = *(const float4*)(src + i * 256 + lane * 4); s += v[i].x + v[i].y + v[i].z + v[i].w; }
    float mu = wave_sum(s) * (1.f / 2048.f);
    float q = 0;
#pragma unroll
    for (int i = 0; i < 8; ++i) { v[i].x -= mu; v[i].y -= mu; v[i].z -= mu; v[i].w -= mu; q += v[i].x * v[i].x + v[i].y * v[i].y + v[i].z * v[i].z + v[i].w * v[i].w; }
    float rstd = rsqrtf(wave_sum(q) * (1.f / 2048.f) + 1e-5f);
    float s2 = 0;
#pragma unroll
    for (int i = 0; i < 8; ++i) {
      int col = i * 256 + lane * 4;
      float4 g = *(const float4*)(p.ln_g + (size_t)l * D + col), b = *(const float4*)(p.ln_b + (size_t)l * D + col);
      v[i].x = v[i].x * rstd * g.x + b.x; v[i].y = v[i].y * rstd * g.y + b.y; v[i].z = v[i].z * rstd * g.z + b.z; v[i].w = v[i].w * rstd * g.w + b.w;
      if (row < NLAT) *(float4*)(src + col) = v[i];
      s2 += v[i].x + v[i].y + v[i].z + v[i].w;
    }
    if (l == 0) {
      int mr = row < NLAT ? (row >> 14) : 2;
      const float* md = mods + (size_t)(3 + mr) * 6144;
      float mu2 = wave_sum(s2) * (1.f / 2048.f);
      float q2 = 0;
#pragma unroll
      for (int i = 0; i < 8; ++i) { v[i].x -= mu2; v[i].y -= mu2; v[i].z -= mu2; v[i].w -= mu2; q2 += v[i].x * v[i].x + v[i].y * v[i].y + v[i].z * v[i].z + v[i].w * v[i].w; }
      float rstd2 = rsqrtf(wave_sum(q2) * (1.f / 2048.f) + 1e-6f);
#pragma unroll
      for (int i = 0; i < 8; ++i) {
        int col = i * 256 + lane * 4;
        float4 sh = *(const float4*)(md + col), sc = *(const float4*)(md + 2048 + col);
        uint2 o;
        o.x = pack_bf2(v[i].x * rstd2 * (1.f + sc.x) + sh.x, v[i].y * rstd2 * (1.f + sc.y) + sh.y);
        o.y = pack_bf2(v[i].z * rstd2 * (1.f + sc.z) + sh.z, v[i].w * rstd2 * (1.f + sc.w) + sh.w);
        *(uint2*)(hbuf + (size_t)row * D + col) = o;
      }
    }
  }
}

template <class Epi>
DEV void gemm_phase(const Params& p, const Ctx& cx, const bf16_t* __restrict__ A, const bf16_t* __restrict__ Bt, int K, int nM, int nN, char* smem, Epi epi) {
  const int tid = cx.tid, lane = tid & 63, wid = tid >> 6;
  const int wr = wid >> 2, wc = wid & 3, fr = lane & 15, fq = lane >> 4;
  const int nt = K / 64;
  const int ntiles = nM * nN;
  const int srow = tid >> 3, sc16 = tid & 7;
  const int nxcd = (cx.nblk & 7) == 0 ? 8 : 1;
  const int xcd = cx.bid % nxcd, xidx = cx.bid / nxcd, xper = cx.nblk / nxcd;
  const int t_lo = (int)(((long)ntiles * xcd) / nxcd), t_hi = (int)(((long)ntiles * (xcd + 1)) / nxcd);
  for (int tt = t_lo + xidx; tt < t_hi; tt += xper) {
    const int band = tt / (16 * nN);
    const int brows = min(16, nM - band * 16);
    const int rem = tt - band * 16 * nN;
    const int pn = rem / brows, pm = band * 16 + rem % brows;
    const int brow = pm * 256, bcol = pn * 256;
    const char* Ab = (const char*)(A + (size_t)brow * K);
    const char* Bb = (const char*)(Bt + (size_t)bcol * K);
    const unsigned voff = (unsigned)(srow * K + sc16 * 8) * 2u;
    const size_t rs = (size_t)64 * K * 2;
    f32x4 acc[8][4];
#pragma unroll
    for (int i = 0; i < 8; ++i)
#pragma unroll
      for (int j = 0; j < 4; ++j) acc[i][j] = f32x4{0.f, 0.f, 0.f, 0.f};
    uint4 ra0, ra1, ra2, ra3, rb0, rb1, rb2, rb3;
#define G_LD(ko) { const char* a_ = Ab + (size_t)(ko) * 2; const char* b_ = Bb + (size_t)(ko) * 2; \
                 ra0 = *(const uint4*)(a_ + voff); ra1 = *(const uint4*)(a_ + rs + voff); ra2 = *(const uint4*)(a_ + 2 * rs + voff); ra3 = *(const uint4*)(a_ + 3 * rs + voff); \
                 rb0 = *(const uint4*)(b_ + voff); rb1 = *(const uint4*)(b_ + rs + voff); rb2 = *(const uint4*)(b_ + 2 * rs + voff); rb3 = *(const uint4*)(b_ + 3 * rs + voff); }
#define G_ST(sp) { *(uint4*)(sp) = ra0; *(uint4*)((sp) + 64 * 144) = ra1; *(uint4*)((sp) + 128 * 144) = ra2; *(uint4*)((sp) + 192 * 144) = ra3; \
                 *(uint4*)((sp) + 36864) = rb0; *(uint4*)((sp) + 36864 + 64 * 144) = rb1; *(uint4*)((sp) + 36864 + 128 * 144) = rb2; *(uint4*)((sp) + 36864 + 192 * 144) = rb3; }
    char* const sbase = smem + srow * 144 + sc16 * 16;
    G_LD(0);
    G_ST(sbase);
    if (nt > 1) G_LD(64);
    for (int kt = 0; kt < nt; ++kt) {
      __syncthreads();
      if (kt + 1 < nt) { char* s1 = sbase + ((kt + 1) & 1) * 73728; G_ST(s1); }
      if (kt + 2 < nt) G_LD((kt + 2) * 64);
      const char* As = smem + (kt & 1) * 73728;
      const char* Bs = As + 36864;
#pragma unroll
      for (int kh = 0; kh < 2; ++kh) {
        bf16x8 bfr[4];
#pragma unroll
        for (int jn = 0; jn < 4; ++jn) bfr[jn] = *(const bf16x8*)(Bs + (wc * 64 + jn * 16 + fr) * 144 + kh * 64 + fq * 16);
#pragma unroll
        for (int i = 0; i < 8; ++i) {
          bf16x8 af = *(const bf16x8*)(As + (wr * 128 + i * 16 + fr) * 144 + kh * 64 + fq * 16);
#pragma unroll
          for (int jn = 0; jn < 4; ++jn) acc[i][jn] = __builtin_amdgcn_mfma_f32_16x16x32_f16(bfr[jn], af, acc[i][jn], 0, 0, 0);
        }
      }
    }
    __syncthreads();
#pragma unroll
    for (int i = 0; i < 8; ++i)
#pragma unroll
      for (int jn = 0; jn < 4; ++jn) epi(brow + wr * 128 + i * 16 + fr, bcol + wc * 64 + jn * 16 + fq * 4, acc[i][jn]);
  }
}

#define LAS3 __attribute__((address_space(3)))
DEV int g2_lds_byte(int r, int c) { const int st = (r >> 4) * 2 + (c >> 5), rr = r & 15, cc = c & 31, ob = rr * 64 + cc * 2; return st * 1024 + (ob ^ (((ob >> 9) & 1) << 5)); }
DEV void g2_stage_rc(int b, int& R, int& C) { const int st = b / 1024, sb = b % 1024, swz = sb ^ (((sb >> 9) & 1) << 5); R = (st >> 1) * 16 + swz / 64; C = (st & 1) * 32 + (swz % 64) / 2; }

template <class Epi>
DEV void gemm_phase2(const Params& p, const Ctx& cx, const bf16_t* __restrict__ A, const bf16_t* __restrict__ Bt, int K, int nM, int nN, char* smem, Epi epi) {
  constexpr int HTB = 128 * 64 * 2;
  LAS3 unsigned char* lds = (LAS3 unsigned char*)smem;
  const int tid = cx.tid, wid = __builtin_amdgcn_readfirstlane(tid >> 6), lane = tid & 63, wr = wid >> 2, wc = wid & 3, fr = lane & 15, fq = lane >> 4;
  const int nt = K / 64;
  const int ntiles = nM * nN;
  const int nxcd = (cx.nblk & 7) == 0 ? 8 : 1;
  const int xcd = cx.bid % nxcd, xidx = cx.bid / nxcd, xper = cx.nblk / nxcd;
  const int t_lo = (int)(((long)ntiles * xcd) / nxcd), t_hi = (int)(((long)ntiles * (xcd + 1)) / nxcd);
  auto unit_at = [&](int i, int& pm, int& pn) -> bool {
    const int tt = t_lo + xidx + i * xper;
    if (tt >= t_hi) return false;
    const int band = tt / (8 * nN);
    const int brows = min(8, nM - band * 8);
    const int rem = tt - band * 8 * nN;
    pn = rem / brows; pm = band * 8 + rem % brows;
    return true;
  };
  unsigned voffA[2], voffB[2];
#pragma unroll
  for (int i = 0; i < 2; ++i) {
    int R, C; g2_stage_rc(tid * 16 + i * 8192, R, C);
    const int rho = R & 31, Rb = (R & ~31) + 8 * ((rho & 15) >> 2) + 4 * (rho >> 4) + (rho & 3);
    voffA[i] = (unsigned)(R * K + C) * 2u; voffB[i] = (unsigned)(Rb * K + C) * 2u;
  }
  const size_t kstep = (size_t)(64 * 2);
  const size_t hstep = (size_t)128 * K * 2;
  const size_t tstep = 2 * hstep;
  const unsigned ldsw = (unsigned)wid * 1024u;
  const int aoff = g2_lds_byte(wr * 64 + fr, fq * 8), boff = g2_lds_byte(wc * 32 + fr, fq * 8);
#define G2_SA(b, h) (((b) * 2 + (h)) * HTB)
#define G2_SB(b, h) ((4 + (b) * 2 + (h)) * HTB)
#define G2_STAGE_(bufoff, gbase, vo_) do { _Pragma("unroll") for (int _i = 0; _i < 2; ++_i) \
    __builtin_amdgcn_global_load_lds((const unsigned*)((const char*)(gbase) + vo_[_i]), (LAS3 unsigned*)(lds + (bufoff) + ldsw + _i * 8192), 16, 0, 0); } while (0)
#define G2_STAGE(bufoff, gbase) G2_STAGE_(bufoff, gbase, voffA)
#define G2_STAGEB(bufoff, gbase) G2_STAGE_(bufoff, gbase, voffB)
#define G2_LDA(dst, b, h) do { _Pragma("unroll") for (int m = 0; m < 4; ++m) _Pragma("unroll") for (int k = 0; k < 2; ++k) dst[m][k] = *(const LAS3 bf16x8*)(lds + G2_SA(b, h) + aoff + m * 2048 + k * 1024); } while (0)
#define G2_LDB(dst, b, h) do { _Pragma("unroll") for (int n = 0; n < 2; ++n) _Pragma("unroll") for (int k = 0; k < 2; ++k) dst[n][k] = *(const LAS3 bf16x8*)(lds + G2_SB(b, h) + boff + n * 2048 + k * 1024); } while (0)
#define G2_MMA(ai, bj, At_, Bt_) do { __builtin_amdgcn_s_setprio(1); _Pragma("unroll") for (int m = 0; m < 4; ++m) _Pragma("unroll") for (int n = 0; n < 2; ++n) _Pragma("unroll") for (int k = 0; k < 2; ++k) \
    acc[ai][bj][m][n] = __builtin_amdgcn_mfma_f32_16x16x32_f16(Bt_[n][k], At_[m][k], acc[ai][bj][m][n], 0, 0, 0); __builtin_amdgcn_s_setprio(0); } while (0)
#define G2_WAIT_V(n) asm volatile("s_waitcnt vmcnt(" #n ")" ::: "memory")
#define G2_WAIT_L(n) asm volatile("s_waitcnt lgkmcnt(" #n ")" ::: "memory")
#define G2_BAR __builtin_amdgcn_s_barrier()
#define G2_SCHED __builtin_amdgcn_sched_barrier(0)
  int cpm, cpn, npm = 0, npn = 0, ui = 0;
  if (!unit_at(0, cpm, cpn)) return;
  f32x4 acc[2][2][4][2];
#pragma unroll
  for (int a = 0; a < 2; ++a)
#pragma unroll
    for (int b = 0; b < 2; ++b)
#pragma unroll
      for (int m = 0; m < 4; ++m)
#pragma unroll
        for (int n = 0; n < 2; ++n) acc[a][b][m][n] = f32x4{0.f, 0.f, 0.f, 0.f};
  bf16x8 At[4][2], B0[2][2], B1[2][2];
  const char* cA = (const char*)A + (size_t)cpm * tstep;
  const char* cB = (const char*)Bt + (size_t)cpn * tstep;
  G2_STAGEB(G2_SB(0, 0), cB); G2_STAGE(G2_SA(0, 0), cA); G2_STAGEB(G2_SB(0, 1), cB + hstep); G2_STAGE(G2_SA(0, 1), cA + hstep);
  if (wr == 1) G2_BAR;
  G2_WAIT_V(4); G2_BAR;
  G2_STAGEB(G2_SB(1, 0), cB + kstep); G2_STAGE(G2_SA(1, 0), cA + kstep); G2_STAGEB(G2_SB(1, 1), cB + hstep + kstep);
  G2_WAIT_V(6); G2_BAR;
  for (;;) {
    const bool has_next = unit_at(ui + 1, npm, npn);
    const char* nA = has_next ? (const char*)A + (size_t)npm * tstep : cA;
    const char* nB = has_next ? (const char*)Bt + (size_t)npn * tstep : cB;
    for (int t = 0; t < nt; t += 2) {
      const bool last = (t == nt - 2);
      const char* a1 = cA + (size_t)(t + 1) * kstep;
      const char* a2 = last ? nA : cA + (size_t)(t + 2) * kstep;
      const char* b2 = last ? nB : cB + (size_t)(t + 2) * kstep;
      const char* a3 = a2 + kstep;
      const char* b3 = b2 + kstep;
      G2_LDB(B0, 0, 0); G2_SCHED; G2_LDA(At, 0, 0); G2_STAGE(G2_SA(1, 1), a1 + hstep);
      G2_WAIT_L(8); G2_BAR; G2_WAIT_L(0); G2_MMA(0, 0, At, B0); G2_BAR; G2_SCHED;
      G2_LDB(B1, 0, 1); G2_STAGEB(G2_SB(0, 0), b2);
      G2_BAR; G2_WAIT_L(0); G2_MMA(0, 1, At, B1); G2_BAR;
      G2_LDA(At, 0, 1); G2_STAGE(G2_SA(0, 0), a2);
      G2_BAR; G2_WAIT_L(0); G2_MMA(1, 0, At, B0); G2_BAR; G2_SCHED;
      G2_STAGEB(G2_SB(0, 1), b2 + hstep);
      G2_WAIT_V(6); G2_BAR; G2_MMA(1, 1, At, B1); G2_BAR;
      G2_LDB(B0, 1, 0); G2_SCHED; G2_LDA(At, 1, 0); G2_STAGE(G2_SA(0, 1), a2 + hstep);
      G2_WAIT_L(8); G2_BAR; G2_WAIT_L(0); G2_MMA(0, 0, At, B0); G2_BAR; G2_SCHED;
      G2_LDB(B1, 1, 1); G2_STAGEB(G2_SB(1, 0), b3);
      G2_BAR; G2_WAIT_L(0); G2_MMA(0, 1, At, B1); G2_BAR;
      G2_LDA(At, 1, 1); G2_STAGE(G2_SA(1, 0), a3);
      G2_BAR; G2_WAIT_L(0); G2_MMA(1, 0, At, B0); G2_BAR; G2_SCHED;
      G2_STAGEB(G2_SB(1, 1), b3 + hstep);
      G2_WAIT_V(6); G2_BAR; G2_MMA(1, 1, At, B1); G2_BAR;
    }
    {
      const int row0 = cpm * 256 + wr * 64 + fr, col0 = cpn * 256 + wc * 32 + 8 * fq;
#pragma unroll
      for (int ai = 0; ai < 2; ++ai)
#pragma unroll
        for (int m = 0; m < 4; ++m)
#pragma unroll
          for (int bj = 0; bj < 2; ++bj) epi(row0 + ai * 128 + m * 16, col0 + bj * 128, acc[ai][bj][m][0], acc[ai][bj][m][1]);
    }
    if (!has_next) break;
#pragma unroll
    for (int a = 0; a < 2; ++a)
#pragma unroll
      for (int b = 0; b < 2; ++b)
#pragma unroll
        for (int m = 0; m < 4; ++m)
#pragma unroll
          for (int n = 0; n < 2; ++n) acc[a][b][m][n] = f32x4{0.f, 0.f, 0.f, 0.f};
    cpm = npm; cpn = npn; cA = nA; cB = nB; ++ui;
  }
  G2_WAIT_V(0);
  if (wr == 0) G2_BAR;
  G2_BAR;
#undef G2_SA
#undef G2_SB
#undef G2_STAGE
#undef G2_STAGEB
#undef G2_STAGE_
#undef G2_LDA
#undef G2_LDB
#undef G2_MMA
#undef G2_WAIT_V
#undef G2_WAIT_L
#undef G2_BAR
#undef G2_SCHED
}

template <int K, int NT, class Epi>
DEV void small_gemm(const Params& p, const Ctx& cx, const char* As, int astride, const bf16_t* __restrict__ Bt, int n0, Epi epi) {
  const int lane = cx.tid & 63, fr = lane & 15, fq = lane >> 4;
  f32x4 acc[4][NT];
#pragma unroll
  for (int i = 0; i < 4; ++i)
#pragma unroll
    for (int j = 0; j < NT; ++j) acc[i][j] = f32x4{0.f, 0.f, 0.f, 0.f};
#pragma unroll 2
  for (int k0 = 0; k0 < K; k0 += 32) {
    bf16x8 af[4];
#pragma unroll
    for (int i = 0; i < 4; ++i) af[i] = *(const bf16x8*)(As + (i * 16 + fr) * astride + (k0 + fq * 8) * 2);
#pragma unroll
    for (int jn = 0; jn < NT; ++jn) {
      bf16x8 bf = *(const bf16x8*)(Bt + (size_t)(n0 + jn * 16 + fr) * K + k0 + fq * 8);
#pragma unroll
      for (int i = 0; i < 4; ++i) acc[i][jn] = __builtin_amdgcn_mfma_f32_16x16x32_f16(bf, af[i], acc[i][jn], 0, 0, 0);
    }
  }
#pragma unroll
  for (int i = 0; i < 4; ++i)
#pragma unroll
    for (int jn = 0; jn < NT; ++jn) epi(i * 16 + fr, n0 + jn * 16 + fq * 4, acc[i][jn]);
}

struct S5P { float ar, ai, br, bi; };
DEV S5P s5_params(const Params& p, const Ctx& cx, int l, int d, int g, int lane) {
  int idx = ((l * 2 + d) * 32 + g) * 64 + lane;
  float lr = fminf(p.s5_lam_re[idx], -1e-4f), li = p.s5_lam_im[idx];
  float step = expf(p.s5_log_step[(l * 2 + d) * 32 + g]);
  float xr = lr * step, xi = li * step;
  float e = expf(xr), cs = cosf(xi), sn = sinf(xi);
  S5P r;
  r.ar = e * cs; r.ai = e * sn;
  float sh = sinf(0.5f * xi);
  float nr = expm1f(xr) * cs - 2.f * sh * sh, ni = e * sn;
  float inv = 1.f / (lr * lr + li * li);
  r.br = (nr * lr + ni * li) * inv;
  r.bi = (ni * lr - nr * li) * inv;
  return r;
}

DEV void s5_load_u(const h16* zrest, int rowbase, int g, char* ulds, int lane) {
#pragma unroll
  for (int i = 0; i < 8; ++i) {
    int e = i * 64 + lane;
    int r = e >> 1, hf = e & 1;
    uint4 v = *(const uint4*)(zrest + (size_t)(rowbase + r) * ZR + g * 16 + hf * 8);
    *(uint4*)(ulds + r * 32 + hf * 16) = v;
  }
  lds_fence();
}

DEV int s5_rowbase(int b, int c) { return c == 0 ? NLAT + b * 256 : b * 16384 + (c - 1) * 256; }

DEV void s5_pass1_unit(const Params& p, const Ctx& cx, int l, int unit, char* wl, int lane) {
  int c = unit % 65, bg = unit / 65, g = bg & 31, b = bg >> 5;
  const h16* zrest = (const h16*)(p.ws + OFF_ZREST);
  float2* F = (float2*)(p.ws + OFF_S5F);
  s5_load_u(zrest, s5_rowbase(b, c), g, wl, lane);
  float Br[16], Bi[16];
  {
    const float* pr = p.s5_b_re + ((size_t)(l * 32 + g) * 64 + lane) * 16;
    const float* pi = p.s5_b_im + ((size_t)(l * 32 + g) * 64 + lane) * 16;
#pragma unroll
    for (int i = 0; i < 16; i += 4) {
      float4 a = *(const float4*)(pr + i), bq = *(const float4*)(pi + i);
      Br[i] = a.x; Br[i + 1] = a.y; Br[i + 2] = a.z; Br[i + 3] = a.w;
      Bi[i] = bq.x; Bi[i + 1] = bq.y; Bi[i + 2] = bq.z; Bi[i + 3] = bq.w;
    }
  }
  S5P pf = s5_params(p, cx, l, 0, g, lane), pb = s5_params(p, cx, l, 1, g, lane);
  float xr = 0, xi = 0, yr = 0, yi = 0, pwr = 1.f, pwi = 0.f;
#pragma unroll 4
  for (int t = 0; t < 256; ++t) {
    h16x8 u0 = *(const h16x8*)(wl + t * 32), u1 = *(const h16x8*)(wl + t * 32 + 16);
    float br = 0, bi = 0;
#pragma unroll
    for (int i = 0; i < 8; ++i) { float u = (float)u0[i]; br = fmaf(u, Br[i], br); bi = fmaf(u, Bi[i], bi); }
#pragma unroll
    for (int i = 0; i < 8; ++i) { float u = (float)u1[i]; br = fmaf(u, Br[8 + i], br); bi = fmaf(u, Bi[8 + i], bi); }
    float nxr = pf.ar * xr - pf.ai * xi + br, nxi = pf.ar * xi + pf.ai * xr + bi;
    xr = nxr; xi = nxi;
    yr += pwr * br - pwi * bi; yi += pwr * bi + pwi * br;
    float npr = pwr * pb.ar - pwi * pb.ai, npi = pwr * pb.ai + pwi * pb.ar;
    pwr = npr; pwi = npi;
  }
  size_t fi = (((size_t)(b * 32 + g) * 65 + c) * 2) * 64 + lane;
  F[fi] = make_float2(pf.br * xr - pf.bi * xi, pf.br * xi + pf.bi * xr);
  F[fi + 64] = make_float2(pb.br * yr - pb.bi * yi, pb.br * yi + pb.bi * yr);
}

DEV void s5_pass3_unit(const Params& p, const Ctx& cx, int l, int unit, char* wl, int lane) {
  int c = unit % 65, bg = unit / 65, g = bg & 31, b = bg >> 5;
  const int fr = lane & 15, fq = lane >> 4;
  const h16* zrest = (const h16*)(p.ws + OFF_ZREST);
  const float2* F = (const float2*)(p.ws + OFF_S5F);
  float* S5Y = (float*)(p.ws + OFF_S5Y);
  const int rowbase = s5_rowbase(b, c);
  char* ulds = wl;
  char* tile = wl + 8192;
  s5_load_u(zrest, rowbase, g, ulds, lane);
  float Br[16], Bi[16];
  {
    const float* pr = p.s5_b_re + ((size_t)(l * 32 + g) * 64 + lane) * 16;
    const float* pi = p.s5_b_im + ((size_t)(l * 32 + g) * 64 + lane) * 16;
#pragma unroll
    for (int i = 0; i < 16; i += 4) {
      float4 a = *(const float4*)(pr + i), bq = *(const float4*)(pi + i);
      Br[i] = a.x; Br[i + 1] = a.y; Br[i + 2] = a.z; Br[i + 3] = a.w;
      Bi[i] = bq.x; Bi[i + 1] = bq.y; Bi[i + 2] = bq.z; Bi[i + 3] = bq.w;
    }
  }
  const float dsk = p.s5_d[(size_t)l * 512 + g * 16 + fr];
  const size_t fbase = ((size_t)(b * 32 + g) * 65) * 2 * 64 + lane;
#pragma unroll 1
  for (int d = 0; d < 2; ++d) {
    S5P pp = s5_params(p, cx, l, d, g, lane);
    float qr = pp.ar, qi = pp.ai;
#pragma unroll
    for (int i = 0; i < 8; ++i) { float t = qr * qr - qi * qi; qi = 2.f * qr * qi; qr = t; }
    float xr = 0, xi = 0;
    if (d == 0) {
      for (int cc = 0; cc < c; ++cc) {
        float2 f = F[fbase + (size_t)(cc * 2 + 0) * 64];
        float t = qr * xr - qi * xi + f.x; xi = qr * xi + qi * xr + f.y; xr = t;
      }
    } else if (c > 0) {
      float2 f0 = F[fbase + (size_t)(0 * 2 + 1) * 64];
      xr = f0.x; xi = f0.y;
      for (int cc = 64; cc > c; --cc) {
        float2 f = F[fbase + (size_t)(cc * 2 + 1) * 64];
        float t = qr * xr - qi * xi + f.x; xi = qr * xi + qi * xr + f.y; xr = t;
      }
    }
    bf16x8 chi[4], clo[4];
    {
      const float* cr = p.s5_c_re + ((size_t)((l * 2 + d) * 32 + g) * 16 + fr) * 64;
      const float* ci = p.s5_c_im + ((size_t)((l * 2 + d) * 32 + g) * 16 + fr) * 64;
#pragma unroll
      for (int ks = 0; ks < 4; ++ks) {
        float4 a = *(const float4*)(cr + ks * 16 + fq * 4), bq = *(const float4*)(ci + ks * 16 + fq * 4);
        float vals[8] = {a.x, -bq.x, a.y, -bq.y, a.z, -bq.z, a.w, -bq.w};
#pragma unroll
        for (int j = 0; j < 8; ++j) {
          h16 hh = (h16)vals[j];
          chi[ks][j] = hh;
          clo[ks][j] = (h16)(vals[j] - (float)hh);
        }
      }
    }
#pragma unroll 1
    for (int sb = 0; sb < 16; ++sb) {
      const int sub = d == 0 ? sb : 15 - sb;
#pragma unroll 4
      for (int q = 0; q < 16; ++q) {
        const int tt = d == 0 ? q : 15 - q;
        const int t = sub * 16 + tt;
        h16x8 u0 = *(const h16x8*)(ulds + t * 32), u1 = *(const h16x8*)(ulds + t * 32 + 16);
        float br = 0, bi = 0;
#pragma unroll
        for (int i = 0; i < 8; ++i) { float u = (float)u0[i]; br = fmaf(u, Br[i], br); bi = fmaf(u, Bi[i], bi); }
#pragma unroll
        for (int i = 0; i < 8; ++i) { float u = (float)u1[i]; br = fmaf(u, Br[8 + i], br); bi = fmaf(u, Bi[8 + i], bi); }
        float vr = pp.br * br - pp.bi * bi, vi = pp.br * bi + pp.bi * br;
        float nxr = pp.ar * xr - pp.ai * xi + vr, nxi = pp.ar * xi + pp.ai * xr + vi;
        xr = nxr; xi = nxi;
        h16x2 hv2 = {(h16)xr, (h16)xi};
        *(unsigned*)(tile + tt * 272 + lane * 4) = __builtin_bit_cast(unsigned, hv2);
      }
      lds_fence();
      f32x4 acc = f32x4{0.f, 0.f, 0.f, 0.f};
#pragma unroll
      for (int ks = 0; ks < 4; ++ks) {
        bf16x8 ah = *(const bf16x8*)(tile + fr * 272 + ks * 64 + fq * 16);
        acc = __builtin_amdgcn_mfma_f32_16x16x32_f16(ah, chi[ks], acc, 0, 0, 0);
        acc = __builtin_amdgcn_mfma_f32_16x16x32_f16(ah, clo[ks], acc, 0, 0, 0);
      }
      lds_fence();
#pragma unroll
      for (int r = 0; r < 4; ++r) {
        int tl = sub * 16 + fq * 4 + r;
        float* yp = S5Y + (size_t)(rowbase + tl) * 512 + g * 16 + fr;
        if (d == 0) {
          float u = (float)*(const h16*)(ulds + tl * 32 + fr * 2);
          *yp = acc[r] + dsk * u;
        } else {
          *yp = gelu_f(*yp + acc[r]);
        }
      }
    }
  }
}

DEV void prep_item(const Params& p, const Ctx& cx, int l, int item, char* smem) {
  const int tile = item >> 2, q = item & 3;
  const int row0 = tile * 64;
  const int tid = cx.tid;
  const h16* zc = (const h16*)(p.ws + OFF_REG2);
  h16* SC = (h16*)(p.ws + OFF_SCAN);
  const char* wt = p.ws + OFF_WT + (size_t)l * WT_SIZE;
  {
    const int d = q >> 1, isA = q & 1;
    const int coff = isA ? 3200 + d * 64 : 3072 + d * 64;
    int tok = tid >> 3, c8 = tid & 7;
    h16x8 cv = *(const h16x8*)(zc + (size_t)(row0 + tok) * ZC + coff + c8 * 8);
    float f[8];
#pragma unroll
    for (int j = 0; j < 8; ++j) { f[j] = (float)cv[j]; if (!isA) f[j] = tanh_f(f[j]); }
    uint4 o;
    o.x = pack_bf2(f[0], f[1]); o.y = pack_bf2(f[2], f[3]); o.z = pack_bf2(f[4], f[5]); o.w = pack_bf2(f[6], f[7]);
    *(uint4*)(smem + tok * 144 + c8 * 16) = o;
    __syncthreads();
    const bf16_t* Bt = (const bf16_t*)(wt + (isA ? WT_A2 : WT_W2)) + (size_t)d * 1024 * 64;
    const float* biasw = p.rwkv_w0 + (size_t)(l * 2 + d) * 1024;
    const float* biasa = p.rwkv_a0 + (size_t)(l * 2 + d) * 1024;
    h16* dst = SC + (size_t)(isA ? 4 + d : 6 + d) * ARR;
#pragma unroll 1
    for (int hf = 0; hf < 2; ++hf) small_gemm<64, 4>(p, cx, smem, 144, Bt, (tid >> 6) * 128 + hf * 64, [&](int m, int n, f32x4 v) {
      float4 bbw = *(const float4*)(biasw + n), bba = *(const float4*)(biasa + n);
      float4 bb = isA ? bba : bbw;
      float r0 = sigmoid_f(v[0] + bb.x), r1 = sigmoid_f(v[1] + bb.y), r2 = sigmoid_f(v[2] + bb.z), r3 = sigmoid_f(v[3] + bb.w);
      if (!isA) { r0 = __expf(-DECAY_SCALE * r0); r1 = __expf(-DECAY_SCALE * r1); r2 = __expf(-DECAY_SCALE * r2); r3 = __expf(-DECAY_SCALE * r3); }
      h16x4 o4 = {(h16)r0, (h16)r1, (h16)r2, (h16)r3};
      *(h16x4*)(dst + (size_t)(row0 + m) * 1024 + n) = o4;
    });
  }
  {
    const float* cw = p.conv_rkv + (size_t)l * 3 * 3072;
    const int grp = tid & 7, hh = (tid >> 3) & 3;
    const int c0 = (4 * q + hh) * 64 + grp * 8;
    float cwt[3][3][8];
#pragma unroll
    for (int s = 0; s < 3; ++s)
#pragma unroll
      for (int tp = 0; tp < 3; ++tp)
#pragma unroll
        for (int j = 0; j < 8; j += 4) {
          float4 a = *(const float4*)(cw + tp * 3072 + s * 1024 + c0 + j);
          cwt[s][tp][j] = a.x; cwt[s][tp][j + 1] = a.y; cwt[s][tp][j + 2] = a.z; cwt[s][tp][j + 3] = a.w;
        }
    float kkw[8];
#pragma unroll
    for (int j = 0; j < 8; j += 4) {
      float4 kq = *(const float4*)(p.rwkv_k_k + (size_t)l * 1024 + c0 + j);
      kkw[j] = kq.x; kkw[j + 1] = kq.y; kkw[j + 2] = kq.z; kkw[j + 3] = kq.w;
    }
#pragma unroll 1
    for (int it = 0; it < 4; ++it) {
      const int tok = (tid >> 5) + it * 16;
      const int row = row0 + tok;
      bool hasp, hasn;
      if (row < NLAT) { hasp = (row & 16383) != 0; hasn = (row & 16383) != 16383; }
      else { hasp = (row & 255) != 0; hasn = (row & 255) != 255; }
      const size_t off = (size_t)row * 1024 + c0;
      const h16* zp = zc + (size_t)row * ZC + c0;
      const h16* zpp = hasp ? zp - ZC : zp;
      const h16* zpn = hasn ? zp + ZC : zp;
      h16x8 cur[3], prv[3], nxt[3];
#pragma unroll
      for (int s = 0; s < 3; ++s) { cur[s] = *(const h16x8*)(zp + s * 1024); prv[s] = *(const h16x8*)(zpp + s * 1024); nxt[s] = *(const h16x8*)(zpn + s * 1024); }
      const float fp = hasp ? 1.f : 0.f, fn = hasn ? 1.f : 0.f;
      float kv[8];
#pragma unroll
      for (int s = 0; s < 3; ++s) {
        h16x8 o;
#pragma unroll
        for (int j = 0; j < 8; ++j) {
          float ov = cwt[s][0][j] * (fp * (float)prv[s][j]) + cwt[s][1][j] * (float)cur[s][j] + cwt[s][2][j] * (fn * (float)nxt[s][j]);
          o[j] = (h16)ov;
          if (s == 1) kv[j] = ov;
        }
        *(h16x8*)(SC + (size_t)s * ARR + off) = o;
      }
      float kk[8], ss = 0;
#pragma unroll
      for (int j = 0; j < 8; ++j) { kk[j] = kv[j] * kkw[j]; ss += kk[j] * kk[j]; }
      ss = allreduce8(ss);
      float inv = rcp_f(fmaxf(sqrtf(ss), 1e-12f));
      h16x8 o;
#pragma unroll
      for (int j = 0; j < 8; ++j) o[j] = (h16)(kk[j] * inv);
      *(h16x8*)(SC + 3 * ARR + off) = o;
    }
  }
}

DEV void phase_prep(const Params& p, const Ctx& cx0, int l, char* smem) {
  const int NPREP = 520 * 4, NS5 = 520;
  const Ctx& cx_ = cx0;
  for (int item = cx_.bid; item < NPREP + NS5; item += cx_.nblk) {
    __syncthreads();
    Ctx cx = cx0; asm volatile("" : "+v"(cx.tid));
    const int lane = cx.tid & 63, wid = cx.tid >> 6;
#ifndef NO_PREPITEM
    if (item < NPREP) prep_item(p, cx, l, item, smem);
    else
#endif
#ifndef NO_S5P1
      s5_pass1_unit(p, cx, l, (item - NPREP) * 8 + wid, smem + wid * 8192, lane);
#else
    {}
#endif
  }
}

typedef unsigned u2v __attribute__((ext_vector_type(2)));
typedef unsigned u4v __attribute__((ext_vector_type(4)));
struct RG { u2v w, a, kk, k, r; h16 v; };

constexpr int RW_NSLOT = 8, RW_SLOTB = 3072;
constexpr int RW_FLAGS = RW_NSLOT * RW_SLOTB;
constexpr int RW_NG = 16640 / 4;
typedef float f4v __attribute__((ext_vector_type(4)));

#define RW_RLO(gq, rlo)                                                            \
  {                                                                                \
    const int gg = (gq) < RW_NG ? (gq) : RW_NG - 1;                                \
    const int q0_ = gg * 4;                                                        \
    const int isl = q0_ >= 256;                                                    \
    const int base_ = isl ? b * 16384 : NLAT + b * 256;                            \
    const int t0_ = isl ? q0_ - 256 : q0_;                                         \
    const int last_ = isl ? 16383 : 255;                                           \
    rlo = base_ + (d ? last_ - t0_ - 3 : t0_);                                     \
  }

DEV void rwkv_helper(const Params& p, const Ctx& cx, int l, int unit, int lane, char* ring) {
  const int d = unit & 1, h = (unit >> 1) & 15, b = unit >> 5;
  const int j = lane >> 4, s = lane & 15;
  const h16* SC = (const h16*)(p.ws + OFF_SCAN);
  const char* pR = (const char*)(SC + 0 * ARR + h * 64);
  const char* pK = (const char*)(SC + 1 * ARR + h * 64);
  const char* pV = (const char*)(SC + 2 * ARR + h * 64);
  const char* pKK = (const char*)(SC + 3 * ARR + h * 64);
  const char* pA = (const char*)(SC + (size_t)(4 + d) * ARR + h * 64);
  const char* pW = (const char*)(SC + (size_t)(6 + d) * ARR + h * 64);
  const int jm = d ? 3 - j : j;
  const unsigned vo0 = (unsigned)(jm * 2048 + s * 8);
  f4v ka4, om4;
  {
    float4 t = *(const float4*)(p.rwkv_k_a + (size_t)l * 1024 + h * 64 + 4 * s);
    ka4 = f4v{t.x, t.y, t.z, t.w};
    om4 = 1.f - ka4;
  }
  struct RGH { u2v w, a, kk, k, r, v; };
  RGH q0, q1, q2, q3, q4, q5, q6, q7;
  const unsigned wofs = (unsigned)(j * 128 + s * 8);
  const unsigned vwofs = (unsigned)(2560 + j * 128 + s * 8);
  LAS3 volatile int* pflag = (LAS3 volatile int*)(ring + RW_FLAGS);
  LAS3 volatile int* cflag = (LAS3 volatile int*)(ring + RW_FLAGS + 64);
  int cmin = 0;
#define CV4(uv) __builtin_convertvector(__builtin_bit_cast(h16x4, uv), f4v)
#define RH_LOAD(q, gq)                                                             \
  {                                                                                \
    int rlo; RW_RLO(gq, rlo);                                                      \
    unsigned vo = vo0; asm volatile("" : "+v"(vo));                                \
    const size_t off = (size_t)rlo * 2048;                                         \
    q.w = *(const u2v*)(pW + off + vo); q.a = *(const u2v*)(pA + off + vo);        \
    q.kk = *(const u2v*)(pKK + off + vo); q.k = *(const u2v*)(pK + off + vo);      \
    q.r = *(const u2v*)(pR + off + vo); q.v = *(const u2v*)(pV + off + vo);        \
  }
#define RH_STEP(q, gq)                                                             \
  {                                                                                \
    if ((gq) >= RW_NSLOT && cmin < (gq) - RW_NSLOT + 1) {                          \
      do {                                                                         \
        const int c0_ = cflag[0], c1_ = cflag[1], c2_ = cflag[2], c3_ = cflag[3];  \
        cmin = __builtin_amdgcn_readfirstlane(min(min(c0_, c1_), min(c2_, c3_)));  \
        if (cmin < (gq) - RW_NSLOT + 1) __builtin_amdgcn_s_sleep(1);               \
      } while (cmin < (gq) - RW_NSLOT + 1);                                        \
    }                                                                              \
    asm volatile("" ::: "memory");                                                 \
    char* sl = ring + ((gq) % RW_NSLOT) * RW_SLOTB;                                \
    const f4v a_ = CV4(q.a), kk_ = CV4(q.kk);                                      \
    const f4v kka_ = kk_ * a_, kd_ = CV4(q.k) * (a_ * ka4 + om4);                  \
    {     \
      const u2v kka2_ = __builtin_bit_cast(u2v, __builtin_convertvector(kka_, h16x4));                      \
      const u2v kd2_ = __builtin_bit_cast(u2v, __builtin_convertvector(kd_, h16x4));                        \
      *(u4v*)(sl + 0 + j * 256 + s * 16) = u4v{q.w.x, q.w.y, q.kk.x, q.kk.y};      \
      *(u4v*)(sl + 1024 + j * 256 + s * 16) = u4v{kka2_.x, kka2_.y, kd2_.x, kd2_.y}; \
      *(u2v*)(sl + 2048 + wofs) = q.r;                                             \
    }                                                                              \
    *(u2v*)(sl + vwofs) = q.v;                                                     \
    asm volatile("s_waitcnt lgkmcnt(0)" ::: "memory");     \
    *pflag = (gq) + 1;                                                             \
  }
  RH_LOAD(q0, 0); RH_LOAD(q1, 1); RH_LOAD(q2, 2); RH_LOAD(q3, 3); RH_LOAD(q4, 4); RH_LOAD(q5, 5); RH_LOAD(q6, 6); RH_LOAD(q7, 7);
#pragma unroll 1
  for (int g = 0; g < RW_NG; g += 8) {
    RH_STEP(q0, g); RH_LOAD(q0, g + 8); __builtin_amdgcn_sched_barrier(0);
    RH_STEP(q1, g + 1); RH_LOAD(q1, g + 9); __builtin_amdgcn_sched_barrier(0);
    RH_STEP(q2, g + 2); RH_LOAD(q2, g + 10); __builtin_amdgcn_sched_barrier(0);
    RH_STEP(q3, g + 3); RH_LOAD(q3, g + 11); __builtin_amdgcn_sched_barrier(0);
    RH_STEP(q4, g + 4); RH_LOAD(q4, g + 12); __builtin_amdgcn_sched_barrier(0);
    RH_STEP(q5, g + 5); RH_LOAD(q5, g + 13); __builtin_amdgcn_sched_barrier(0);
    RH_STEP(q6, g + 6); RH_LOAD(q6, g + 14); __builtin_amdgcn_sched_barrier(0);
    RH_STEP(q7, g + 7); RH_LOAD(q7, g + 15); __builtin_amdgcn_sched_barrier(0);
  }
#undef RH_LOAD
#undef RH_STEP
#undef CV4
}

DEV void rwkv_consumer(const Params& p, const Ctx& cx, int l, int task, int lane, const char* ring, int widx) {
  const int unit = task >> 4, d = unit & 1, h = (unit >> 1) & 15, b = unit >> 5;
  const int j = lane >> 4, s = lane & 15;
  const int myrow = (task & 15) * 4 + j;
  char* pO = (char*)((h16*)(p.ws + OFF_REG2) + (size_t)d * ARR + h * 64);
  const int sm = d ? 3 - (s & 3) : (s & 3);
  const unsigned vov0 = (unsigned)(sm * 2048 + myrow * 2);
  const unsigned rofs = (unsigned)(s * 8);
  const unsigned vrofs = (unsigned)(2560 + myrow * 2);
  LAS3 volatile int* pflag = (LAS3 volatile int*)(ring + RW_FLAGS);
  LAS3 volatile int* cflag = (LAS3 volatile int*)(ring + RW_FLAGS + 64) + widx;
  float S0 = 0.f, S1 = 0.f, S2 = 0.f, S3 = 0.f;
  int pseen = 0;
  struct GD { u2v w[4], kk[4], kka[4], kd[4], r[4]; unsigned v[4]; };
  GD A, B;
#define RC_WAIT(gq) { if (pseen <= (gq)) { do { pseen = __builtin_amdgcn_readfirstlane(*pflag); if (pseen <= (gq)) __builtin_amdgcn_s_sleep(1); } while (pseen <= (gq)); } asm volatile("" ::: "memory"); }
#define RC_LOAD(G, gq)                                                             \
  {                                                                                \
    const char* sl = ring + ((gq) % RW_NSLOT) * RW_SLOTB;                          \
    _Pragma("unroll") for (int u = 0; u < 4; ++u) {                                \
      const u4v p0_ = *(const u4v*)(sl + 0 + u * 256 + 2 * rofs);                  \
      const u4v p1_ = *(const u4v*)(sl + 1024 + u * 256 + 2 * rofs);               \
      G.w[u] = u2v{p0_.x, p0_.y}; G.kk[u] = u2v{p0_.z, p0_.w};                     \
      G.kka[u] = u2v{p1_.x, p1_.y}; G.kd[u] = u2v{p1_.z, p1_.w};                   \
      G.r[u] = *(const u2v*)(sl + 2048 + u * 128 + rofs);                          \
      G.v[u] = *(const unsigned short*)(sl + u * 128 + vrofs);                     \
    }                                                                              \
  }
#define RC_COMP(G, gq)                                                             \
  {                                                                                \
    float dres[4];                                                                 \
    _Pragma("unroll") for (int u = 0; u < 4; ++u) {                                \
        \
        \
      float ea, eb, x_, y_, t0, t1, t2, t3;                                        \
      asm("v_fma_mix_f32 %6, %0, %12, 0 op_sel:[0,0,0] op_sel_hi:[0,1,0]\n\t"      \
          "v_fma_mix_f32 %7, %2, %13, 0 op_sel:[0,0,0] op_sel_hi:[0,1,0]\n\t"      \
          "v_fma_mix_f32 %6, %1, %12, %6 op_sel:[0,1,0] op_sel_hi:[0,1,0]\n\t"     \
          "v_fma_mix_f32 %7, %3, %13, %7 op_sel:[0,1,0] op_sel_hi:[0,1,0]\n\t"     \
          "v_fma_mix_f32 %8, %22, %16, 0 op_sel:[0,0,0] op_sel_hi:[1,1,0]\n\t"     \
          "v_add_f32 %6, %6, %7\n\t"                                               \
          "v_fma_mix_f32 %9, %22, %16, 0 op_sel:[0,1,0] op_sel_hi:[1,1,0]\n\t"     \
          "v_fma_mix_f32 %10, %22, %17, 0 op_sel:[0,0,0] op_sel_hi:[1,1,0]\n\t"    \
          "v_add_f32_dpp %6, %6, %6 quad_perm:[1,0,3,2] row_mask:0xf bank_mask:0xf bound_ctrl:1\n\t" \
          "v_fma_mix_f32 %11, %22, %17, 0 op_sel:[0,1,0] op_sel_hi:[1,1,0]\n\t"    \
          "v_fma_mix_f32 %0, %0, %14, %8 op_sel:[0,0,0] op_sel_hi:[0,1,0]\n\t"     \
          "v_add_f32_dpp %6, %6, %6 quad_perm:[2,3,0,1] row_mask:0xf bank_mask:0xf bound_ctrl:1\n\t" \
          "v_fma_mix_f32 %1, %1, %14, %9 op_sel:[0,1,0] op_sel_hi:[0,1,0]\n\t"     \
          "v_fma_mix_f32 %2, %2, %15, %10 op_sel:[0,0,0] op_sel_hi:[0,1,0]\n\t"    \
          "v_add_f32_dpp %6, %6, %6 row_half_mirror row_mask:0xf bank_mask:0xf bound_ctrl:1\n\t" \
          "v_fma_mix_f32 %3, %3, %15, %11 op_sel:[0,1,0] op_sel_hi:[0,1,0]\n\t"    \
          "s_nop 0\n\t"                                                            \
          "v_add_f32_dpp %6, %6, %6 row_mirror row_mask:0xf bank_mask:0xf bound_ctrl:1\n\t" \
          "v_fma_mix_f32 %0, -%6, %18, %0 op_sel:[0,0,0] op_sel_hi:[0,1,0]\n\t"    \
          "v_fma_mix_f32 %1, -%6, %18, %1 op_sel:[0,1,0] op_sel_hi:[0,1,0]\n\t"    \
          "v_fma_mix_f32 %2, -%6, %19, %2 op_sel:[0,0,0] op_sel_hi:[0,1,0]\n\t"    \
          "v_fma_mix_f32 %3, -%6, %19, %3 op_sel:[0,1,0] op_sel_hi:[0,1,0]\n\t"    \
          "v_fma_mix_f32 %4, %0, %20, 0 op_sel:[0,0,0] op_sel_hi:[0,1,0]\n\t"      \
          "v_fma_mix_f32 %5, %2, %21, 0 op_sel:[0,0,0] op_sel_hi:[0,1,0]\n\t"      \
          "v_fma_mix_f32 %4, %1, %20, %4 op_sel:[0,1,0] op_sel_hi:[0,1,0]\n\t"     \
          "v_fma_mix_f32 %5, %3, %21, %5 op_sel:[0,1,0] op_sel_hi:[0,1,0]"         \
          : "+v"(S0), "+v"(S1), "+v"(S2), "+v"(S3), "=&v"(ea), "=&v"(eb), "=&v"(x_), "=&v"(y_),                     \
            "=&v"(t0), "=&v"(t1), "=&v"(t2), "=&v"(t3)                                                              \
          : "v"(G.kk[u].x), "v"(G.kk[u].y), "v"(G.w[u].x), "v"(G.w[u].y), "v"(G.kd[u].x), "v"(G.kd[u].y),           \
            "v"(G.kka[u].x), "v"(G.kka[u].y), "v"(G.r[u].x), "v"(G.r[u].y), "v"(G.v[u]));                           \
      dres[u] = ea + eb;     \
    }                                                                              \
    asm volatile("" ::: "memory");                                                 \
    *cflag = (gq) + 1;     \
    {                                                                              \
      int rlo; RW_RLO(gq, rlo);                                                    \
      unsigned vov = vov0; asm volatile("" : "+v"(vov));                           \
        \
      const bool p1_ = (s & 1) != 0, p2_ = (s & 2) != 0;                           \
      const float a_ = (p1_ ? dres[1] : dres[0]) + dpp_mov<0xB1>(p1_ ? dres[0] : dres[1]); \
      const float b_ = (p1_ ? dres[3] : dres[2]) + dpp_mov<0xB1>(p1_ ? dres[2] : dres[3]); \
      float val = (p2_ ? b_ : a_) + dpp_mov<0x4E>(p2_ ? a_ : b_);                  \
      val += dpp_mov<0x124>(val);                                                  \
      val += dpp_mov<0x128>(val);                                                  \
      *(h16*)(pO + (size_t)rlo * 2048 + vov) = (h16)val;                           \
    }                                                                              \
  }
  RC_WAIT(0); RC_LOAD(A, 0);
#pragma unroll 1
  for (int g = 0; g < RW_NG; g += 2) {
    RC_WAIT(g + 1); RC_LOAD(B, g + 1);
    RC_COMP(A, g);
    if (g + 2 < RW_NG) { RC_WAIT(g + 2); RC_LOAD(A, g + 2); }
    RC_COMP(B, g + 1);
  }
#undef RC_WAIT
#undef RC_LOAD
#undef RC_COMP
}
#undef RW_RLO

DEV void phase_scan(const Params& p, const Ctx& cx, int l, char* smem) {
  const int lane = cx.tid & 63, wid = __builtin_amdgcn_readfirstlane(cx.tid >> 6);
  for (int slot = cx.bid; slot < 256; slot += cx.nblk) {
    __syncthreads();
    if (wid == 4 && lane < 8) *(LAS3 volatile int*)(smem + RW_FLAGS + (lane == 0 ? 0 : 64 + (lane & 3) * 4)) = 0;
    __syncthreads();
    const int unit = slot & 63;
#ifndef NO_RWKV
    if (wid < 4) { __builtin_amdgcn_s_setprio(3); rwkv_consumer(p, cx, l, (unit << 4) | ((slot >> 6) << 2) | wid, lane, smem, wid); __builtin_amdgcn_s_setprio(0); }
    else if (wid == 4) { __builtin_amdgcn_s_setprio(1); rwkv_helper(p, cx, l, unit, lane, smem); __builtin_amdgcn_s_setprio(0); }
#endif
  }
  if (wid >= 5) {
    char* wl = smem + 32768 + (wid - 5) * 17408;
    for (int u = cx.bid * 3 + (wid - 5); u < 2 * 32 * 65; u += cx.nblk * 3) {
      if (l == 1 && (u % 65) == 0) continue;
#ifndef NO_S5P3
      s5_pass3_unit(p, cx, l, u, wl, lane);
#endif
    }
  }
}

DEV void pool_item(const Params& p, const Ctx& cx, int l, int item, char* smem) {
  const int tid = cx.tid;
  const h16* zrest = (const h16*)(p.ws + OFF_ZREST);
  bf16_t* ym = (bf16_t*)(p.ws + OFF_YM);
  const char* wt = p.ws + OFF_WT + (size_t)l * WT_SIZE;
  float* V = (float*)smem;
  char* At = smem + 43008;
  int g, rowout0, Lseq, p0, rlo, rhi, rstride, rowsrc0;
  if (item < 2048) {
    g = item & 3; int r = (item >> 2) & 255, b = item >> 10;
    int w = 2 << g;
    rlo = max(r - w / 2, 0); rhi = min(r + w / 2 - 1, 255);
    rowsrc0 = b * 16384; rstride = 64;
    rowout0 = b * 16384 + r * 64; Lseq = 64; p0 = 0;
  } else {
    int it = item - 2048;
    g = it & 3; int tq = (it >> 2) & 3, b = it >> 4;
    rlo = 0; rhi = 0; rowsrc0 = NLAT + b * 256; rstride = 0;
    rowout0 = NLAT + b * 256 + tq * 64; Lseq = 256; p0 = tq * 64;
  }
  const int w = 2 << g;
  const float invr = 1.f / (float)(rhi - rlo + 1);
  for (int unit = tid; unit < 80 * 16; unit += NTHREADS) {
    int lp = unit >> 4, ch8 = unit & 15;
    int pos = p0 - 8 + lp;
    float acc[8] = {0, 0, 0, 0, 0, 0, 0, 0};
    if (pos >= 0 && pos < Lseq) {
      const h16* bp = zrest + (size_t)(rowsrc0 + pos) * ZR + 1024 + g * 128 + ch8 * 8;
      const int nr = rhi - rlo + 1;
      for (int k0 = 0; k0 < nr; k0 += 4) {
        h16x8 v[4]; float wv[4];
#pragma unroll
        for (int i = 0; i < 4; ++i) {
          const int kk_ = min(k0 + i, nr - 1);
          wv[i] = (k0 + i < nr) ? 1.f : 0.f;
          v[i] = *(const h16x8*)(bp + (size_t)((rlo + kk_) * rstride) * ZR);
        }
#pragma unroll
        for (int i = 0; i < 4; ++i)
#pragma unroll
          for (int j = 0; j < 8; ++j) acc[j] += wv[i] * (float)v[i][j];
      }
    }
    float* vp = V + lp * 132 + ch8 * 8;
#pragma unroll
    for (int j = 0; j < 8; ++j) vp[j] = acc[j] * invr;
  }
  __syncthreads();
  for (int unit = tid; unit < 64 * 16; unit += NTHREADS) {
    int c = unit >> 4, ch8 = unit & 15;
    int pos = p0 + c;
    int lo = max(pos - w / 2, 0), hi = min(pos + w / 2 - 1, Lseq - 1);
    float acc[8] = {0, 0, 0, 0, 0, 0, 0, 0};
    for (int pp = lo; pp <= hi; ++pp) {
      const float* vp = V + (pp - p0 + 8) * 132 + ch8 * 8;
#pragma unroll
      for (int j = 0; j < 8; ++j) acc[j] += vp[j];
    }
    float invc = 1.f / (float)(hi - lo + 1);
    h16x8 uc = *(const h16x8*)(zrest + (size_t)(rowout0 + c) * ZR + 1024 + g * 128 + ch8 * 8);
    uint4 o;
    o.x = pack_bf2(acc[0] * invc - (float)uc[0], acc[1] * invc - (float)uc[1]);
    o.y = pack_bf2(acc[2] * invc - (float)uc[2], acc[3] * invc - (float)uc[3]);
    o.z = pack_bf2(acc[4] * invc - (float)uc[4], acc[5] * invc - (float)uc[5]);
    o.w = pack_bf2(acc[6] * invc - (float)uc[6], acc[7] * invc - (float)uc[7]);
    *(uint4*)(At + c * 272 + ch8 * 16) = o;
  }
  __syncthreads();
  const bf16_t* Bt = (const bf16_t*)(wt + WT_POOL) + (size_t)g * 128 * 128;
  const float* ps = p.pool_scale + (size_t)l * 512 + g * 128;
  small_gemm<128, 1>(p, cx, At, 272, Bt, (tid >> 6) * 16, [&](int m, int n, f32x4 v) {
    int row = rowout0 + m;
    float4 sc = *(const float4*)(ps + n);
    h16x4 gt = *(const h16x4*)(zrest + (size_t)row * ZR + 1536 + g * 128 + n);
    uint2 o;
    o.x = pack_bf2(v[0] * sc.x * silu_f((float)gt[0]), v[1] * sc.y * silu_f((float)gt[1]));
    o.y = pack_bf2(v[2] * sc.z * silu_f((float)gt[2]), v[3] * sc.w * silu_f((float)gt[3]));
    *(uint2*)(ym + (size_t)row * D + 512 + g * 128 + n) = o;
  });
}

DEV void glu_item(const Params& p, const Ctx& cx, int l, int tile, char* smem) {
  const int tid = cx.tid;
  const int row0 = tile * 64;
  const float* S5Y = (const float*)(p.ws + OFF_S5Y);
  const h16* zrest = (const h16*)(p.ws + OFF_ZREST);
  bf16_t* ym = (bf16_t*)(p.ws + OFF_YM);
  const char* wt = p.ws + OFF_WT + (size_t)l * WT_SIZE;
#pragma unroll
  for (int it = 0; it < 8; ++it) {
    int unit = tid + it * NTHREADS;
    int r = unit >> 6, c8 = unit & 63;
    const float* sp = S5Y + (size_t)(row0 + r) * 512 + c8 * 8;
    float4 a = *(const float4*)sp, bq = *(const float4*)(sp + 4);
    uint4 o;
    o.x = pack_bf2(a.x, a.y); o.y = pack_bf2(a.z, a.w); o.z = pack_bf2(bq.x, bq.y); o.w = pack_bf2(bq.z, bq.w);
    *(uint4*)(smem + r * 1040 + c8 * 16) = o;
  }
  __syncthreads();
  const bf16_t* Bt = (const bf16_t*)(wt + WT_GLU);
  const float* bg = p.b_glu + (size_t)l * 512;
  small_gemm<512, 4>(p, cx, smem, 1040, Bt, (tid >> 6) * 64, [&](int m, int n, f32x4 v) {
    int row = row0 + m;
    float4 y = *(const float4*)(S5Y + (size_t)row * 512 + n);
    float4 bb = *(const float4*)(bg + n);
    h16x4 gt = *(const h16x4*)(zrest + (size_t)row * ZR + 512 + n);
    uint2 o;
    o.x = pack_bf2(y.x * sigmoid_f(v[0] + bb.x) * silu_f((float)gt[0]), y.y * sigmoid_f(v[1] + bb.y) * silu_f((float)gt[1]));
    o.y = pack_bf2(y.z * sigmoid_f(v[2] + bb.z) * silu_f((float)gt[2]), y.w * sigmoid_f(v[3] + bb.w) * silu_f((float)gt[3]));
    *(uint2*)(ym + (size_t)row * D + n) = o;
  });
}

DEV void rwkvmerge_item(const Params& p, const Ctx& cx, int l, int tile) {
  const int tid = cx.tid;
  const int row0 = tile * 64;
  const h16* SC = (const h16*)(p.ws + OFF_SCAN);
  const h16* O = (const h16*)(p.ws + OFF_REG2);
  const h16* zrest = (const h16*)(p.ws + OFF_ZREST);
  bf16_t* ym = (bf16_t*)(p.ws + OFF_YM);
  const int grp = tid & 7, h = (tid >> 3) & 15;
  const int c0 = h * 64 + grp * 8;
  float pk[8], rk[8], gw[8], gb[8];
#pragma unroll
  for (int j = 0; j < 8; j += 4) {
    float4 t0 = *(const float4*)(p.rwkv_k_a + (size_t)l * 1024 + c0 + j), t1 = *(const float4*)(p.rwkv_r_k + (size_t)l * 1024 + c0 + j);
    float4 t2 = *(const float4*)(p.gn_w + (size_t)l * 1024 + c0 + j), t3 = *(const float4*)(p.gn_b + (size_t)l * 1024 + c0 + j);
    pk[j] = t0.x; pk[j + 1] = t0.y; pk[j + 2] = t0.z; pk[j + 3] = t0.w;
    rk[j] = t1.x; rk[j + 1] = t1.y; rk[j + 2] = t1.z; rk[j + 3] = t1.w;
    gw[j] = t2.x; gw[j + 1] = t2.y; gw[j + 2] = t2.z; gw[j + 3] = t2.w;
    gb[j] = t3.x; gb[j + 1] = t3.y; gb[j + 2] = t3.z; gb[j + 3] = t3.w;
  }
#pragma unroll 2
  for (int it = 0; it < 16; ++it) {
    const int tok = (tid >> 7) + it * 4;
    int row = row0 + tok;
    size_t off = (size_t)row * 1024 + c0;
    h16x8 of = *(const h16x8*)(O + off), ob = *(const h16x8*)(O + ARR + off);
    h16x8 r8 = *(const h16x8*)(SC + 0 * ARR + off), k8 = *(const h16x8*)(SC + 1 * ARR + off), v8 = *(const h16x8*)(SC + 2 * ARR + off);
    h16x8 af = *(const h16x8*)(SC + 4 * ARR + off), ab = *(const h16x8*)(SC + 5 * ARR + off);
    h16x8 gt = *(const h16x8*)(zrest + (size_t)row * ZR + 2048 + c0);
    float o[8], sm = 0;
#pragma unroll
    for (int j = 0; j < 8; ++j) { o[j] = (float)of[j] + (float)ob[j]; sm += o[j]; }
    sm = allreduce8(sm);
    float mu = sm * (1.f / 64.f), vq = 0;
#pragma unroll
    for (int j = 0; j < 8; ++j) { o[j] -= mu; vq += o[j] * o[j]; }
    vq = allreduce8(vq);
    float rstd = rsqrtf(vq * (1.f / 64.f) + 64e-5f);
    float part = 0;
#pragma unroll
    for (int j = 0; j < 8; ++j) {
      float ksum = (float)k8[j] * (2.f + ((float)af[j] + (float)ab[j] - 2.f) * pk[j]);
      part += (float)r8[j] * ksum * rk[j];
    }
    part = allreduce8(part);
    float res[8];
#pragma unroll
    for (int j = 0; j < 8; ++j) {
      float y = o[j] * rstd * gw[j] + gb[j] + part * (float)v8[j];
      res[j] = y * silu_f((float)gt[j]);
    }
    uint4 ov;
    ov.x = pack_bf2(res[0], res[1]); ov.y = pack_bf2(res[2], res[3]); ov.z = pack_bf2(res[4], res[5]); ov.w = pack_bf2(res[6], res[7]);
    *(uint4*)(ym + (size_t)row * D + 1024 + c0) = ov;
  }
}

DEV void phase_merge(const Params& p, const Ctx& cx0, int l, char* smem) {
  const int ntile = (l == 0) ? 520 : 512;
  const int npool = (l == 0) ? 2048 + 32 : 2048;
  const int total = npool + 2 * ntile;
  for (int item = cx0.bid; item < total; item += cx0.nblk) {
    __syncthreads();
    Ctx cx = cx0; asm volatile("" : "+v"(cx.tid));
    const int grp6 = item / 6, pos6 = item - grp6 * 6;
    if (pos6 < 4) pool_item(p, cx, l, grp6 * 4 + pos6, smem);
    else if (pos6 == 4) glu_item(p, cx, l, grp6, smem);
    else rwkvmerge_item(p, cx, l, grp6);
  }
}

#define XB_TMO      128
#define XB_XCNT(j)  (256  + 64 * (j))
#define XB_XSUB(j)  (1280 + 64 * (j))
#define XB_XGEN(j)  (2304 + 64 * (j))
#define XB_TOP      3328
#define XB_TOPGEN   3392
#define XCD_BAR_WORDS 3456
#define XB_SPIN_CAP (1u << 18)
DEV unsigned xb_ld(unsigned* p) { return __hip_atomic_load(p, __ATOMIC_RELAXED, __HIP_MEMORY_SCOPE_AGENT); }
DEV unsigned xb_add(unsigned* p, unsigned v) { return __hip_atomic_fetch_add(p, v, __ATOMIC_RELAXED, __HIP_MEMORY_SCOPE_AGENT); }
DEV unsigned xb_xcc_id() { return (unsigned)__builtin_amdgcn_s_getreg((3 << 11) | 20) & 0xFu; }
#define XB_SPIN(cond, bar) do { unsigned _sp = 0; while (cond) { __builtin_amdgcn_s_sleep(1); \
    if ((++_sp & 255u) == 0u) { if (xb_ld(&(bar)[XB_TMO])) break; if (_sp > XB_SPIN_CAP) { atomicAdd(&(bar)[XB_TMO], 1u); break; } } } } while (0)
struct XcdBarrier { unsigned* bar; unsigned x; volatile LAS3 unsigned* st; };
DEV XcdBarrier xcd_barrier_post(unsigned* bar, volatile LAS3 unsigned* st) {
  XcdBarrier b; b.bar = bar; b.x = xb_xcc_id(); b.st = st;
  if (threadIdx.x == 0) (void)xb_add(&bar[XB_XCNT(b.x)], 1u);
  return b;
}
DEV void xcd_barrier_complete(unsigned* bar, unsigned x, unsigned& nloc, unsigned& nx) {
  const unsigned G = gridDim.x * gridDim.y * gridDim.z;
  unsigned sum, cnt, mine, sp = 0u;
  for (;;) {
    sum = 0u; cnt = 0u; mine = 0u;
#pragma unroll
    for (unsigned j = 0; j < 16; ++j) { const unsigned c = xb_ld(&bar[XB_XCNT(j)]); sum += c; cnt += (c > 0u) ? 1u : 0u; mine = (j == x) ? c : mine; }
    if (sum == G) break;
    __builtin_amdgcn_s_sleep(1);
    if ((++sp & 255u) == 0u) { if (xb_ld(&bar[XB_TMO])) break; if (sp > XB_SPIN_CAP) { atomicAdd(&bar[XB_TMO], 1u); break; } }
  }
  nloc = mine > 0u ? mine : 1u; nx = cnt > 0u ? cnt : 1u;
}
DEV void xcd_barrier(const XcdBarrier& b) {
  asm volatile("s_waitcnt vmcnt(0)" ::: "memory");
  __syncthreads();
  if (threadIdx.x == 0) {
    unsigned* bar = b.bar;
    __builtin_amdgcn_s_waitcnt(0);
    unsigned nloc = b.st[0], nx = b.st[1];
    if (nloc == 0u) { xcd_barrier_complete(bar, b.x, nloc, nx); b.st[0] = nloc; b.st[1] = nx; }
    const unsigned old = xb_add(&bar[XB_XSUB(b.x)], 1u);
    const unsigned gen = old / nloc;
    if (old + 1u == (gen + 1u) * nloc) {
      __builtin_amdgcn_fence(__ATOMIC_RELEASE, "agent");
      asm volatile("s_waitcnt vmcnt(0)" ::: "memory");
      const unsigned og = xb_add(&bar[XB_TOP], 1u);
      const unsigned tg = og / nx;
      if (og + 1u == (tg + 1u) * nx) xb_add(&bar[XB_TOPGEN], 1u);
      else XB_SPIN(xb_ld(&bar[XB_TOPGEN]) == tg, bar);
      __builtin_amdgcn_fence(__ATOMIC_ACQUIRE, "agent");
      xb_add(&bar[XB_XGEN(b.x)], 1u);
      asm volatile("s_waitcnt vmcnt(0)" ::: "memory");
    } else {
      XB_SPIN(xb_ld(&bar[XB_XGEN(b.x)]) == gen, bar);
      __builtin_amdgcn_fence(__ATOMIC_ACQUIRE, "agent");
      asm volatile("s_waitcnt vmcnt(0)" ::: "memory");
    }
  }
  __syncthreads();
}

#define LCX Ctx c2 = cx; asm volatile("" : "+v"(c2.tid))
#ifndef GEMM_FN
#define GEMM_FN gemm_phase2
#endif
__global__ void __launch_bounds__(NTHREADS) mega_fwd(Params p, int ph0, int ph1) {
  extern __shared__ __attribute__((aligned(16))) char smem[];
  cg::grid_group grid = cg::this_grid();
  __shared__ uint4 xb_words;
  if (threadIdx.x == 0) xb_words = make_uint4(0u, 0u, 0u, 0u);
  __syncthreads();
  XcdBarrier xb; xb.bar = (unsigned*)(p.ws + OFF_BAR); xb.x = xb_xcc_id(); xb.st = (volatile LAS3 unsigned*)&xb_words;
  if (blockIdx.x == 0) for (int i = threadIdx.x; i < XCD_BAR_WORDS; i += NTHREADS) xb.bar[i] = 0u;
  const int wave_s = __builtin_amdgcn_readfirstlane((int)(threadIdx.x >> 6));
  for (int step = ph0; step < ph1; ++step) {
    if (step == ph0 + 1) { grid.sync(); if (threadIdx.x == 0) (void)xb_add(&xb.bar[XB_XCNT(xb.x)], 1u); } else if (step > ph0) xcd_barrier(xb);
    const int ph = (int)((PH_SEQ >> (4 * step)) & 15ull);
    Ctx cx;
    {
      int t_, b_ = blockIdx.x, n_ = gridDim.x;
      asm volatile("v_mbcnt_lo_u32_b32 %0, -1, 0\n\tv_mbcnt_hi_u32_b32 %0, -1, %0\n\tv_lshl_add_u32 %0, %1, 6, %0" : "=&v"(t_) : "s"(wave_s));
      asm volatile("" : "+s"(b_), "+s"(n_));
      cx.tid = t_; cx.bid = b_; cx.nblk = n_;
    }
    const int l = ph >= 8 ? 1 : 0;
    const int lp = ph >= 8 ? ph - 6 : ph;
#ifndef PHMASK
#define PHMASK 0xff
#endif
    if (ph == 0) { if (PHMASK & 1) { LCX; phase0(p, c2, smem, 0); } }
    else if (ph == 1) {
      if (PHMASK & 2) { LCX; if (c2.bid & 1) { phase_adaln0(p, c2); phase0(p, c2, smem, 1); } else { phase0(p, c2, smem, 1); phase_adaln0(p, c2); } }
    }
    else if (lp == 2 && (PHMASK & 4)) {
      LCX;
      h16* zrest = (h16*)(p.ws + OFF_ZREST);
      h16* zc = (h16*)(p.ws + OFF_REG2);
      GEMM_FN(p, c2, (const bf16_t*)(p.ws + OFF_H), (const bf16_t*)(p.ws + OFF_WT + (size_t)l * WT_SIZE + WT_IN), 2048, 130, 25, smem,
                 [&](int row, int col, f32x4 v, f32x4 u) {
                   h16* dst;
                   if (col < 2048) dst = zrest + (size_t)row * ZR + col;
                   else if (col < 5120) dst = zc + (size_t)row * ZC + (col - 2048);
                   else if (col < 6144) dst = zrest + (size_t)row * ZR + 2048 + (col - 5120);
                   else dst = zc + (size_t)row * ZC + 3072 + (col - 6144);
                   h16x8 o = {(h16)v[0], (h16)v[1], (h16)v[2], (h16)v[3], (h16)u[0], (h16)u[1], (h16)u[2], (h16)u[3]};
                   *(h16x8*)dst = o;
                 });
    } else if (lp == 3) { if (PHMASK & 8) { LCX; phase_prep(p, c2, l, smem); } }
    else if (lp == 4) { if (PHMASK & 16) { LCX; phase_scan(p, c2, l, smem); } }
    else if (lp == 5) { if (PHMASK & 32) { LCX; phase_merge(p, c2, l, smem); } }
    else if (lp == 6 && (PHMASK & 64)) {
      LCX;
      const float* mods = (const float*)(p.ws + OFF_MODS);
      float* prec = (float*)(p.ws + OFF_PREC);
      const float* xin = (l == 0) ? p.x : p.out;
      GEMM_FN(p, c2, (const bf16_t*)(p.ws + OFF_YM), (const bf16_t*)(p.ws + OFF_WT + (size_t)l * WT_SIZE + WT_OUT), 2048, l == 0 ? 130 : 128, 8, smem,
                 [&](int row, int col, f32x4 v, f32x4 u) {
                   const float* xr; const float* gr; float* dr;
                   if (row < NLAT) {
                     xr = xin + (size_t)row * D + col; gr = mods + (size_t)(l * 3 + (row >> 14)) * 6144 + 4096 + col; dr = p.out + (size_t)row * D + col;
                   } else {
                     xr = p.ctx + (size_t)(row - NLAT) * D + col; gr = mods + (size_t)(l * 3 + 2) * 6144 + 4096 + col; dr = prec + (size_t)(row - NLAT) * D + col;
                   }
                   const float4 x0 = *(const float4*)xr, x1 = *(const float4*)(xr + 4), g0 = *(const float4*)gr, g1 = *(const float4*)(gr + 4);
                   float4 r0, r1;
                   r0.x = ALPHA * x0.x + g0.x * v[0]; r0.y = ALPHA * x0.y + g0.y * v[1]; r0.z = ALPHA * x0.z + g0.z * v[2]; r0.w = ALPHA * x0.w + g0.w * v[3];
                   r1.x = ALPHA * x1.x + g1.x * u[0]; r1.y = ALPHA * x1.y + g1.y * u[1]; r1.z = ALPHA * x1.z + g1.z * u[2]; r1.w = ALPHA * x1.w + g1.w * u[3];
                   *(float4*)dr = r0; *(float4*)(dr + 4) = r1;
                 });
    } else if (lp == 7) { if (PHMASK & 128) { LCX; phase_finln(p, c2, l); } }
  }
}

constexpr int NPHASES = PH_NSTEPS;

extern "C" void kernel_launch(void* const* d_in, const int* in_sizes, int n_in, void* d_out, int out_size, void* d_ws, size_t ws_size,
                              hipStream_t stream) {
  static int grid_blocks = 0;
  if (grid_blocks == 0) {
    if (n_in != 32 || ws_size < WS_END) { fprintf(stderr, "kernel_launch: unexpected n_in %d / ws %zu (need %zu)\n", n_in, ws_size, (size_t)WS_END); grid_blocks = -1; return; }
    int dev = 0, cus = 0, per_cu = 0;
    hipGetDevice(&dev);
    hipDeviceGetAttribute(&cus, hipDeviceAttributeMultiprocessorCount, dev);
    if (hipFuncSetAttribute((const void*)mega_fwd, hipFuncAttributeMaxDynamicSharedMemorySize, LDS_BYTES) != hipSuccess) { fprintf(stderr, "hipFuncSetAttribute failed\n"); grid_blocks = -1; return; }
    if (hipOccupancyMaxActiveBlocksPerMultiprocessor(&per_cu, (const void*)mega_fwd, NTHREADS, LDS_BYTES) != hipSuccess || per_cu < 1) {
      fprintf(stderr, "occupancy query gave %d\n", per_cu); (void)hipGetLastError(); per_cu = 1;
    }
    grid_blocks = cus * per_cu;
  }
  if (grid_blocks < 0) return;
  Params p{};
  const float** pp = (const float**)&p;
  for (int i = 0; i < 32; ++i) pp[i] = (const float*)d_in[i];
  p.out = (float*)d_out;
  p.ws = (char*)d_ws;
  int ph0 = 0, ph1 = NPHASES;
  void* args[] = {&p, &ph0, &ph1};
  hipError_t e = hipLaunchCooperativeKernel((const void*)mega_fwd, dim3(grid_blocks), dim3(NTHREADS), args, LDS_BYTES, stream);
  if (e != hipSuccess) fprintf(stderr, "cooperative launch failed: %s (grid %d)\n", hipGetErrorString(e), grid_blocks);
}
```

```cpp
#include <hip/hip_runtime.h>
#include <hip/hip_cooperative_groups.h>
#include <cstdio>
namespace cg = cooperative_groups;

typedef unsigned short bf16_t;
typedef _Float16 h16;
using bf16x8 = __attribute__((ext_vector_type(8))) _Float16;
using f32x4 = __attribute__((ext_vector_type(4))) float;
using h16x4 = __attribute__((ext_vector_type(4))) _Float16;
using h16x8 = __attribute__((ext_vector_type(8))) _Float16;

#define DEV __device__ __forceinline__

constexpr int D = 2048, NLAT = 32768, MTOT = 33280, ZR = 3072, ZC = 3328;
constexpr int NTHREADS = 512;
constexpr int LDS_BYTES = 147456;
constexpr float ALPHA = 1.41421356237f;
constexpr float DECAY_SCALE = 0.606531f;

constexpr size_t al256(size_t x) { return (x + 255) & ~size_t(255); }
constexpr size_t ARR = (size_t)MTOT * 1024;
constexpr size_t OFF_MODS = 0;
constexpr size_t OFF_S5F = al256(OFF_MODS + 2 * 3 * 6144 * 4);
constexpr size_t OFF_PREC = al256(OFF_S5F + (size_t)2 * 32 * 65 * 2 * 64 * 8);
constexpr size_t OFF_WT = al256(OFF_PREC + (size_t)512 * 2048 * 4);
constexpr size_t WT_IN = 0, WT_OUT = 26214400, WT_W2 = 34603008, WT_A2 = 34865152, WT_POOL = 35127296, WT_GLU = 35258368, WT_SIZE = 35782656;
constexpr size_t OFF_ZREST = al256(OFF_WT + 2 * WT_SIZE);
constexpr size_t OFF_REG2 = al256(OFF_ZREST + (size_t)MTOT * ZR * 2);
constexpr size_t OFF_S5Y = OFF_REG2 + 2 * ARR * 2;
constexpr size_t OFF_SCAN = al256(OFF_REG2 + (size_t)MTOT * ZC * 2);
constexpr size_t OFF_H = OFF_SCAN;
constexpr size_t OFF_YM = OFF_SCAN + 6 * ARR * 2;
constexpr size_t OFF_BAR = al256(OFF_SCAN + 8 * ARR * 2);
constexpr size_t WS_END = OFF_BAR + 16384;

#ifndef PH_SEQ
#define PH_SEQ 0xDCBA9876543210ull
#define PH_NSTEPS 14
#endif
struct Params {
  const float *x, *c, *ctx, *c_ctx, *w_ada, *b_ada, *w_in, *conv_rkv, *s5_lam_re, *s5_lam_im, *s5_log_step,
      *s5_b_re, *s5_b_im, *s5_c_re, *s5_c_im, *s5_d, *w_glu, *b_glu, *w_pool, *pool_scale,
      *rwkv_w0, *rwkv_w2, *rwkv_a0, *rwkv_a2, *rwkv_k_k, *rwkv_k_a, *rwkv_r_k, *gn_w, *gn_b,
      *w_out, *ln_g, *ln_b;
  float* out;
  char* ws;
};
struct Ctx { int tid, bid, nblk; };

DEV float rcp_f(float x) { return __builtin_amdgcn_rcpf(x); }
DEV float sigmoid_f(float x) { return rcp_f(1.f + __expf(-x)); }
DEV float silu_f(float x) { return x * rcp_f(1.f + __expf(-x)); }
DEV float tanh_f(float x) { float e = __expf(2.f * x); return 1.f - 2.f * rcp_f(e + 1.f); }
DEV float gelu_f(float y) { return 0.5f * y * (1.f + tanh_f(0.7978845608f * (y + 0.044715f * y * y * y))); }
using h16x2 = __attribute__((ext_vector_type(2))) _Float16;
DEV unsigned pack_bf2(float a, float b) { h16x2 v = {(h16)a, (h16)b}; return __builtin_bit_cast(unsigned, v); }
template <int CTRL> DEV float dpp_mov(float v) {
  return __int_as_float(__builtin_amdgcn_update_dpp(0, __float_as_int(v), CTRL, 0xf, 0xf, true));
}
DEV float allreduce16(float v) {
  v += dpp_mov<0xB1>(v);
  v += dpp_mov<0x4E>(v);
  v += dpp_mov<0x141>(v);
  v += dpp_mov<0x140>(v);
  return v;
}
DEV float wave_sum(float v) {
  v = allreduce16(v);
  return __builtin_amdgcn_readlane(__float_as_int(v), 0) == 0 && false ? 0.f :
         __int_as_float(__builtin_amdgcn_readlane(__float_as_int(v), 0)) + __int_as_float(__builtin_amdgcn_readlane(__float_as_int(v), 16)) +
         __int_as_float(__builtin_amdgcn_readlane(__float_as_int(v), 32)) + __int_as_float(__builtin_amdgcn_readlane(__float_as_int(v), 48));
}
DEV float allreduce8(float v) {
  v += dpp_mov<0xB1>(v);
  v += dpp_mov<0x4E>(v);
  v += dpp_mov<0x141>(v);
  return v;
}
DEV void lds_fence() { asm volatile("s_waitcnt lgkmcnt(0)" ::: "memory"); }

DEV void p0_mods_item(const Params& p, const Ctx& cx, int item, char* smem) {
  float* red = (float*)smem;
  float* mods = (float*)(p.ws + OFF_MODS);
  int l = item / 96, chunk = item % 96;
  int tid = cx.tid, kq = tid >> 6, col = tid & 63;
  int n = chunk * 64 + col;
  const float* W = p.w_ada + (size_t)l * 2048 * 6144;
  float a0 = 0, a1 = 0, a2 = 0;
#pragma unroll 8
  for (int k = kq; k < 2048; k += 8) {
    float w = W[(size_t)k * 6144 + n];
    a0 += silu_f(p.c[k]) * w;
    a1 += silu_f(p.c[2048 + k]) * w;
    a2 += silu_f(p.c_ctx[k]) * w;
  }
  red[(kq * 3 + 0) * 64 + col] = a0;
  red[(kq * 3 + 1) * 64 + col] = a1;
  red[(kq * 3 + 2) * 64 + col] = a2;
  __syncthreads();
  if (tid < 192) {
    int r = tid >> 6, cc = tid & 63;
    float s = 0;
#pragma unroll
    for (int q = 0; q < 8; ++q) s += red[(q * 3 + r) * 64 + cc];
    mods[(size_t)(l * 3 + r) * 6144 + chunk * 64 + cc] = s + p.b_ada[(size_t)l * 6144 + chunk * 64 + cc];
  }
}

DEV void p0_transpose_tile(const Params& p, const Ctx& cx, const float* __restrict__ src, bf16_t* __restrict__ dst, int K, int N, int tk, int tn, char* smem) {
  float* T = (float*)smem;
  int tid = cx.tid;
  int k0 = tk * 64, n0 = tn * 64;
  int kk = tid >> 4, n4 = tid & 15;
#pragma unroll
  for (int i = 0; i < 2; ++i) {
    int k = kk + 32 * i;
    float4 v = *(const float4*)(src + (size_t)(k0 + k) * N + n0 + n4 * 4);
    T[k * 65 + n4 * 4 + 0] = v.x; T[k * 65 + n4 * 4 + 1] = v.y; T[k * 65 + n4 * 4 + 2] = v.z; T[k * 65 + n4 * 4 + 3] = v.w;
  }
  __syncthreads();
  int n = tid >> 3, k8 = tid & 7;
  uint4 o;
  o.x = pack_bf2(T[(k8 * 8 + 0) * 65 + n], T[(k8 * 8 + 1) * 65 + n]);
  o.y = pack_bf2(T[(k8 * 8 + 2) * 65 + n], T[(k8 * 8 + 3) * 65 + n]);
  o.z = pack_bf2(T[(k8 * 8 + 4) * 65 + n], T[(k8 * 8 + 5) * 65 + n]);
  o.w = pack_bf2(T[(k8 * 8 + 6) * 65 + n], T[(k8 * 8 + 7) * 65 + n]);
  *(uint4*)(dst + (size_t)(n0 + n) * K + k0 + k8 * 8) = o;
}

DEV void phase0(const Params& p, const Ctx& cx0, char* smem, int part) {
  const int NTR = 4368;
  const int total = part == 0 ? 192 : 192 + 2 * NTR;
  for (int item = (part == 0 ? 0 : 192) + cx0.bid; item < total; item += cx0.nblk) {
    __syncthreads();
    Ctx cx = cx0; asm volatile("" : "+v"(cx.tid));
    if (item < 192) { p0_mods_item(p, cx, item, smem); continue; }
    int it = item - 192;
    int l = it / NTR, i = it % NTR;
    char* wt = p.ws + OFF_WT + (size_t)l * WT_SIZE;
    if (i < 3200) {
      p0_transpose_tile(p, cx, p.w_in + (size_t)l * 2048 * 6400, (bf16_t*)(wt + WT_IN), 2048, 6400, i / 100, i % 100, smem);
    } else if (i < 4224) {
      int j = i - 3200;
      p0_transpose_tile(p, cx, p.w_out + (size_t)l * 2048 * 2048, (bf16_t*)(wt + WT_OUT), 2048, 2048, j / 32, j % 32, smem);
    } else if (i < 4256) {
      int j = i - 4224, d = j / 16;
      p0_transpose_tile(p, cx, p.rwkv_w2 + (size_t)(l * 2 + d) * 64 * 1024, (bf16_t*)(wt + WT_W2) + (size_t)d * 1024 * 64, 64, 1024, 0, j % 16, smem);
    } else if (i < 4288) {
      int j = i - 4256, d = j / 16;
      p0_transpose_tile(p, cx, p.rwkv_a2 + (size_t)(l * 2 + d) * 64 * 1024, (bf16_t*)(wt + WT_A2) + (size_t)d * 1024 * 64, 64, 1024, 0, j % 16, smem);
    } else if (i < 4304) {
      int j = i - 4288, g = j / 4;
      p0_transpose_tile(p, cx, p.w_pool + (size_t)(l * 4 + g) * 128 * 128, (bf16_t*)(wt + WT_POOL) + (size_t)g * 128 * 128, 128, 128, (j % 4) / 2, j % 2, smem);
    } else {
      int j = i - 4304;
      p0_transpose_tile(p, cx, p.w_glu + (size_t)l * 512 * 512, (bf16_t*)(wt + WT_GLU), 512, 512, j / 8, j % 8, smem);
    }
  }
}

DEV void phase_adaln0(const Params& p, const Ctx& cx) {
  const float* mods = (const float*)(p.ws + OFF_MODS);
  bf16_t* hbuf = (bf16_t*)(p.ws + OFF_H);
  int lane = cx.tid & 63;
  int gw = cx.bid * 8 + (cx.tid >> 6), nw = cx.nblk * 8;
  for (int row = gw; row < MTOT; row += nw) {
    const float* src = row < NLAT ? p.x + (size_t)row * D : p.ctx + (size_t)(row - NLAT) * D;
    int mr = row < NLAT ? (row >> 14) : 2;
    const float* md = mods + (size_t)mr * 6144;
    float4 v[8];
    float s = 0;
#pragma unroll
    for (int i = 0; i < 8; ++i) { v[i] = *(const float4*)(src + i * 256 + lane * 4); s += v[i].x + v[i].y + v[i].z + v[i].w; }
    float mu = wave_sum(s) * (1.f / 2048.f);
    float q = 0;
#pragma unroll
    for (int i = 0; i < 8; ++i) { v[i].x -= mu; v[i].y -= mu; v[i].z -= mu; v[i].w -= mu; q += v[i].x * v[i].x + v[i].y * v[i].y + v[i].z * v[i].z + v[i].w * v[i].w; }
    float rstd = rsqrtf(wave_sum(q) * (1.f / 2048.f) + 1e-6f);
#pragma unroll
    for (int i = 0; i < 8; ++i) {
      int col = i * 256 + lane * 4;
      float4 sh = *(const float4*)(md + col), sc = *(const float4*)(md + 2048 + col);
      uint2 o;
      o.x = pack_bf2(v[i].x * rstd * (1.f + sc.x) + sh.x, v[i].y * rstd * (1.f + sc.y) + sh.y);
      o.y = pack_bf2(v[i].z * rstd * (1.f + sc.z) + sh.z, v[i].w * rstd * (1.f + sc.w) + sh.w);
      *(uint2*)(hbuf + (size_t)row * D + col) = o;
    }
  }
}

DEV void phase_finln(const Params& p, const Ctx& cx, int l) {
  const float* mods = (const float*)(p.ws + OFF_MODS);
  bf16_t* hbuf = (bf16_t*)(p.ws + OFF_H);
  float* prec = (float*)(p.ws + OFF_PREC);
  int lane = cx.tid & 63;
  int gw = cx.bid * 8 + (cx.tid >> 6), nw = cx.nblk * 8;
  const int nrows = (l == 0) ? MTOT : NLAT;
  for (int row = gw; row < nrows; row += nw) {
    float* src = row < NLAT ? p.out + (size_t)row * D : prec + (size_t)(row - NLAT) * D;
    float4 v[8];
    float s = 0;
#pragma unroll
    for (int i = 0; i < 8; ++i) { v[i] = *(const float4*)(src + i * 256 + lane * 4); s += v[i].x + v[i].y + v[i].z + v[i].w; }
    float mu = wave_sum(s) * (1.f / 2048.f);
    float q = 0;
#pragma unroll
    for (int i = 0; i < 8; ++i) { v[i].x -= mu; v[i].y -= mu; v[i].z -= mu; v[i].w -= mu; q += v[i].x * v[i].x + v[i].y * v[i].y + v[i].z * v[i].z + v[i].w * v[i].w; }
    float rstd = rsqrtf(wave_sum(q) * (1.f / 2048.f) + 1e-5f);
    float s2 = 0;
#pragma unroll
    for (int i = 0; i < 8; ++i) {
      int col = i * 256 + lane * 4;
      float4 g = *(const float4*)(p.ln_g + (size_t)l * D + col), b = *(const float4*)(p.ln_b + (size_t)l * D + col);
      v[i].x = v[i].x * rstd * g.x + b.x; v[i].y = v[i].y * rstd * g.y + b.y; v[i].z = v[i].z * rstd * g.z + b.z; v[i].w = v[i].w * rstd * g.w + b.w;
      if (row < NLAT) *(float4*)(src + col) = v[i];
      s2 += v[i].x + v[i].y + v[i].z + v[i].w;
    }
    if (l == 0) {
      int mr = row < NLAT ? (row >> 14) : 2;
      const float* md = mods + (size_t)(3 + mr) * 6144;
      float mu2 = wave_sum(s2) * (1.f / 2048.f);
      float q2 = 0;
#pragma unroll
      for (int i = 0; i < 8; ++i) { v[i].x -= mu2; v[i].y -= mu2; v[i].z -= mu2; v[i].w -= mu2; q2 += v[i].x * v[i].x + v[i].y * v[i].y + v[i].z * v[i].z + v[i].w * v[i].w; }
      float rstd2 = rsqrtf(wave_sum(q2) * (1.f / 2048.f) + 1e-6f);
#pragma unroll
      for (int i = 0; i < 8; ++i) {
        int col = i * 256 + lane * 4;
        float4 sh = *(const float4*)(md + col), sc = *(const float4*)(md + 2048 + col);
        uint2 o;
        o.x = pack_bf2(v[i].x * rstd2 * (1.f + sc.x) + sh.x, v[i].y * rstd2 * (1.f + sc.y) + sh.y);
        o.y = pack_bf2(v[i].z * rstd2 * (1.f + sc.z) + sh.z, v[i].w * rstd2 * (1.f + sc.w) + sh.w);
        *(uint2*)(hbuf + (size_t)row * D + col) = o;
      }
    }
  }
}

template <class Epi>
DEV void gemm_phase(const Params& p, const Ctx& cx, const bf16_t* __restrict__ A, const bf16_t* __restrict__ Bt, int K, int nM, int nN, char* smem, Epi epi) {
  const int tid = cx.tid, lane = tid & 63, wid = tid >> 6;
  const int wr = wid >> 2, wc = wid & 3, fr = lane & 15, fq = lane >> 4;
  const int nt = K / 64;
  const int ntiles = nM * nN;
  const int srow = tid >> 3, sc16 = tid & 7;
  const int nxcd = (cx.nblk & 7) == 0 ? 8 : 1;
  const int xcd = cx.bid % nxcd, xidx = cx.bid / nxcd, xper = cx.nblk / nxcd;
  const int t_lo = (int)(((long)ntiles * xcd) / nxcd), t_hi = (int)(((long)ntiles * (xcd + 1)) / nxcd);
  for (int tt = t_lo + xidx; tt < t_hi; tt += xper) {
    const int band = tt / (16 * nN);
    const int brows = min(16, nM - band * 16);
    const int rem = tt - band * 16 * nN;
    const int pn = rem / brows, pm = band * 16 + rem % brows;
    const int brow = pm * 256, bcol = pn * 256;
    const char* Ab = (const char*)(A + (size_t)brow * K);
    const char* Bb = (const char*)(Bt + (size_t)bcol * K);
    const unsigned voff = (unsigned)(srow * K + sc16 * 8) * 2u;
    const size_t rs = (size_t)64 * K * 2;
    f32x4 acc[8][4];
#pragma unroll
    for (int i = 0; i < 8; ++i)
#pragma unroll
      for (int j = 0; j < 4; ++j) acc[i][j] = f32x4{0.f, 0.f, 0.f, 0.f};
    uint4 ra0, ra1, ra2, ra3, rb0, rb1, rb2, rb3;
#define G_LD(ko) { const char* a_ = Ab + (size_t)(ko) * 2; const char* b_ = Bb + (size_t)(ko) * 2; \
                 ra0 = *(const uint4*)(a_ + voff); ra1 = *(const uint4*)(a_ + rs + voff); ra2 = *(const uint4*)(a_ + 2 * rs + voff); ra3 = *(const uint4*)(a_ + 3 * rs + voff); \
                 rb0 = *(const uint4*)(b_ + voff); rb1 = *(const uint4*)(b_ + rs + voff); rb2 = *(const uint4*)(b_ + 2 * rs + voff); rb3 = *(const uint4*)(b_ + 3 * rs + voff); }
#define G_ST(sp) { *(uint4*)(sp) = ra0; *(uint4*)((sp) + 64 * 144) = ra1; *(uint4*)((sp) + 128 * 144) = ra2; *(uint4*)((sp) + 192 * 144) = ra3; \
                 *(uint4*)((sp) + 36864) = rb0; *(uint4*)((sp) + 36864 + 64 * 144) = rb1; *(uint4*)((sp) + 36864 + 128 * 144) = rb2; *(uint4*)((sp) + 36864 + 192 * 144) = rb3; }
    char* const sbase = smem + srow * 144 + sc16 * 16;
    G_LD(0);
    G_ST(sbase);
    if (nt > 1) G_LD(64);
    for (int kt = 0; kt < nt; ++kt) {
      __syncthreads();
      if (kt + 1 < nt) { char* s1 = sbase + ((kt + 1) & 1) * 73728; G_ST(s1); }
      if (kt + 2 < nt) G_LD((kt + 2) * 64);
      const char* As = smem + (kt & 1) * 73728;
      const char* Bs = As + 36864;
#pragma unroll
      for (int kh = 0; kh < 2; ++kh) {
        bf16x8 bfr[4];
#pragma unroll
        for (int jn = 0; jn < 4; ++jn) bfr[jn] = *(const bf16x8*)(Bs + (wc * 64 + jn * 16 + fr) * 144 + kh * 64 + fq * 16);
#pragma unroll
        for (int i = 0; i < 8; ++i) {
          bf16x8 af = *(const bf16x8*)(As + (wr * 128 + i * 16 + fr) * 144 + kh * 64 + fq * 16);
#pragma unroll
          for (int jn = 0; jn < 4; ++jn) acc[i][jn] = __builtin_amdgcn_mfma_f32_16x16x32_f16(bfr[jn], af, acc[i][jn], 0, 0, 0);
        }
      }
    }
    __syncthreads();
#pragma unroll
    for (int i = 0; i < 8; ++i)
#pragma unroll
      for (int jn = 0; jn < 4; ++jn) epi(brow + wr * 128 + i * 16 + fr, bcol + wc * 64 + jn * 16 + fq * 4, acc[i][jn]);
  }
}

#define LAS3 __attribute__((address_space(3)))
DEV int g2_lds_byte(int r, int c) { const int st = (r >> 4) * 2 + (c >> 5), rr = r & 15, cc = c & 31, ob = rr * 64 + cc * 2; return st * 1024 + (ob ^ (((ob >> 9) & 1) << 5)); }
DEV void g2_stage_rc(int b, int& R, int& C) { const int st = b / 1024, sb = b % 1024, swz = sb ^ (((sb >> 9) & 1) << 5); R = (st >> 1) * 16 + swz / 64; C = (st & 1) * 32 + (swz % 64) / 2; }

template <class Epi>
DEV void gemm_phase2(const Params& p, const Ctx& cx, const bf16_t* __restrict__ A, const bf16_t* __restrict__ Bt, int K, int nM, int nN, char* smem, Epi epi) {
  constexpr int HTB = 128 * 64 * 2;
  LAS3 unsigned char* lds = (LAS3 unsigned char*)smem;
  const int tid = cx.tid, wid = __builtin_amdgcn_readfirstlane(tid >> 6), lane = tid & 63, wr = wid >> 2, wc = wid & 3, fr = lane & 15, fq = lane >> 4;
  const int nt = K / 64;
  const int ntiles = nM * nN;
  const int nxcd = (cx.nblk & 7) == 0 ? 8 : 1;
  const int xcd = cx.bid % nxcd, xidx = cx.bid / nxcd, xper = cx.nblk / nxcd;
  const int t_lo = (int)(((long)ntiles * xcd) / nxcd), t_hi = (int)(((long)ntiles * (xcd + 1)) / nxcd);
  auto unit_at = [&](int i, int& pm, int& pn) -> bool {
    const int tt = t_lo + xidx + i * xper;
    if (tt >= t_hi) return false;
    const int band = tt / (8 * nN);
    const int brows = min(8, nM - band * 8);
    const int rem = tt - band * 8 * nN;
    pn = rem / brows; pm = band * 8 + rem % brows;
    return true;
  };
  unsigned voffA[2], voffB[2];
#pragma unroll
  for (int i = 0; i < 2; ++i) {
    int R, C; g2_stage_rc(tid * 16 + i * 8192, R, C);
    const int rho = R & 31, Rb = (R & ~31) + 8 * ((rho & 15) >> 2) + 4 * (rho >> 4) + (rho & 3);
    voffA[i] = (unsigned)(R * K + C) * 2u; voffB[i] = (unsigned)(Rb * K + C) * 2u;
  }
  const size_t kstep = (size_t)(64 * 2);
  const size_t hstep = (size_t)128 * K * 2;
  const size_t tstep = 2 * hstep;
  const unsigned ldsw = (unsigned)wid * 1024u;
  const int aoff = g2_lds_byte(wr * 64 + fr, fq * 8), boff = g2_lds_byte(wc * 32 + fr, fq * 8);
#define G2_SA(b, h) (((b) * 2 + (h)) * HTB)
#define G2_SB(b, h) ((4 + (b) * 2 + (h)) * HTB)
#define G2_STAGE_(bufoff, gbase, vo_) do { _Pragma("unroll") for (int _i = 0; _i < 2; ++_i) \
    __builtin_amdgcn_global_load_lds((const unsigned*)((const char*)(gbase) + vo_[_i]), (LAS3 unsigned*)(lds + (bufoff) + ldsw + _i * 8192), 16, 0, 0); } while (0)
#define G2_STAGE(bufoff, gbase) G2_STAGE_(bufoff, gbase, voffA)
#define G2_STAGEB(bufoff, gbase) G2_STAGE_(bufoff, gbase, voffB)
#define G2_LDA(dst, b, h) do { _Pragma("unroll") for (int m = 0; m < 4; ++m) _Pragma("unroll") for (int k = 0; k < 2; ++k) dst[m][k] = *(const LAS3 bf16x8*)(lds + G2_SA(b, h) + aoff + m * 2048 + k * 1024); } while (0)
#define G2_LDB(dst, b, h) do { _Pragma("unroll") for (int n = 0; n < 2; ++n) _Pragma("unroll") for (int k = 0; k < 2; ++k) dst[n][k] = *(const LAS3 bf16x8*)(lds + G2_SB(b, h) + boff + n * 2048 + k * 1024); } while (0)
#define G2_MMA(ai, bj, At_, Bt_) do { __builtin_amdgcn_s_setprio(1); _Pragma("unroll") for (int m = 0; m < 4; ++m) _Pragma("unroll") for (int n = 0; n < 2; ++n) _Pragma("unroll") for (int k = 0; k < 2; ++k) \
    acc[ai][bj][m][n] = __builtin_amdgcn_mfma_f32_16x16x32_f16(Bt_[n][k], At_[m][k], acc[ai][bj][m][n], 0, 0, 0); __builtin_amdgcn_s_setprio(0); } while (0)
#define G2_WAIT_V(n) asm volatile("s_waitcnt vmcnt(" #n ")" ::: "memory")
#define G2_WAIT_L(n) asm volatile("s_waitcnt lgkmcnt(" #n ")" ::: "memory")
#define G2_BAR __builtin_amdgcn_s_barrier()
#define G2_SCHED __builtin_amdgcn_sched_barrier(0)
  int cpm, cpn, npm = 0, npn = 0, ui = 0;
  if (!unit_at(0, cpm, cpn)) return;
  f32x4 acc[2][2][4][2];
#pragma unroll
  for (int a = 0; a < 2; ++a)
#pragma unroll
    for (int b = 0; b < 2; ++b)
#pragma unroll
      for (int m = 0; m < 4; ++m)
#pragma unroll
        for (int n = 0; n < 2; ++n) acc[a][b][m][n] = f32x4{0.f, 0.f, 0.f, 0.f};
  bf16x8 At[4][2], B0[2][2], B1[2][2];
  const char* cA = (const char*)A + (size_t)cpm * tstep;
  const char* cB = (const char*)Bt + (size_t)cpn * tstep;
  G2_STAGEB(G2_SB(0, 0), cB); G2_STAGE(G2_SA(0, 0), cA); G2_STAGEB(G2_SB(0, 1), cB + hstep); G2_STAGE(G2_SA(0, 1), cA + hstep);
  if (wr == 1) G2_BAR;
  G2_WAIT_V(4); G2_BAR;
  G2_STAGEB(G2_SB(1, 0), cB + kstep); G2_STAGE(G2_SA(1, 0), cA + kstep); G2_STAGEB(G2_SB(1, 1), cB + hstep + kstep);
  G2_WAIT_V(6); G2_BAR;
  for (;;) {
    const bool has_next = unit_at(ui + 1, npm, npn);
    const char* nA = has_next ? (const char*)A + (size_t)npm * tstep : cA;
    const char* nB = has_next ? (const char*)Bt + (size_t)npn * tstep : cB;
    for (int t = 0; t < nt; t += 2) {
      const bool last = (t == nt - 2);
      const char* a1 = cA + (size_t)(t + 1) * kstep;
      const char* a2 = last ? nA : cA + (size_t)(t + 2) * kstep;
      const char* b2 = last ? nB : cB + (size_t)(t + 2) * kstep;
      const char* a3 = a2 + kstep;
      const char* b3 = b2 + kstep;
      G2_LDB(B0, 0, 0); G2_SCHED; G2_LDA(At, 0, 0); G2_STAGE(G2_SA(1, 1), a1 + hstep);
      G2_WAIT_L(8); G2_BAR; G2_WAIT_L(0); G2_MMA(0, 0, At, B0); G2_BAR; G2_SCHED;
      G2_LDB(B1, 0, 1); G2_STAGEB(G2_SB(0, 0), b2);
      G2_BAR; G2_WAIT_L(0); G2_MMA(0, 1, At, B1); G2_BAR;
      G2_LDA(At, 0, 1); G2_STAGE(G2_SA(0, 0), a2);
      G2_BAR; G2_WAIT_L(0); G2_MMA(1, 0, At, B0); G2_BAR; G2_SCHED;
      G2_STAGEB(G2_SB(0, 1), b2 + hstep);
      G2_WAIT_V(6); G2_BAR; G2_MMA(1, 1, At, B1); G2_BAR;
      G2_LDB(B0, 1, 0); G2_SCHED; G2_LDA(At, 1, 0); G2_STAGE(G2_SA(0, 1), a2 + hstep);
      G2_WAIT_L(8); G2_BAR; G2_WAIT_L(0); G2_MMA(0, 0, At, B0); G2_BAR; G2_SCHED;
      G2_LDB(B1, 1, 1); G2_STAGEB(G2_SB(1, 0), b3);
      G2_BAR; G2_WAIT_L(0); G2_MMA(0, 1, At, B1); G2_BAR;
      G2_LDA(At, 1, 1); G2_STAGE(G2_SA(1, 0), a3);
      G2_BAR; G2_WAIT_L(0); G2_MMA(1, 0, At, B0); G2_BAR; G2_SCHED;
      G2_STAGEB(G2_SB(1, 1), b3 + hstep);
      G2_WAIT_V(6); G2_BAR; G2_MMA(1, 1, At, B1); G2_BAR;
    }
    {
      const int row0 = cpm * 256 + wr * 64 + fr, col0 = cpn * 256 + wc * 32 + 8 * fq;
#pragma unroll
      for (int ai = 0; ai < 2; ++ai)
#pragma unroll
        for (int m = 0; m < 4; ++m)
#pragma unroll
          for (int bj = 0; bj < 2; ++bj) epi(row0 + ai * 128 + m * 16, col0 + bj * 128, acc[ai][bj][m][0], acc[ai][bj][m][1]);
    }
    if (!has_next) break;
#pragma unroll
    for (int a = 0; a < 2; ++a)
#pragma unroll
      for (int b = 0; b < 2; ++b)
#pragma unroll
        for (int m = 0; m < 4; ++m)
#pragma unroll
          for (int n = 0; n < 2; ++n) acc[a][b][m][n] = f32x4{0.f, 0.f, 0.f, 0.f};
    cpm = npm; cpn = npn; cA = nA; cB = nB; ++ui;
  }
  G2_WAIT_V(0);
  if (wr == 0) G2_BAR;
  G2_BAR;
#undef G2_SA
#undef G2_SB
#undef G2_STAGE
#undef G2_STAGEB
#undef G2_STAGE_
#undef G2_LDA
#undef G2_LDB
#undef G2_MMA
#undef G2_WAIT_V
#undef G2_WAIT_L
#undef G2_BAR
#undef G2_SCHED
}

template <int K, int NT, class Epi>
DEV void small_gemm(const Params& p, const Ctx& cx, const char* As, int astride, const bf16_t* __restrict__ Bt, int n0, Epi epi) {
  const int lane = cx.tid & 63, fr = lane & 15, fq = lane >> 4;
  f32x4 acc[4][NT];
#pragma unroll
  for (int i = 0; i < 4; ++i)
#pragma unroll
    for (int j = 0; j < NT; ++j) acc[i][j] = f32x4{0.f, 0.f, 0.f, 0.f};
#pragma unroll 2
  for (int k0 = 0; k0 < K; k0 += 32) {
    bf16x8 af[4];
#pragma unroll
    for (int i = 0; i < 4; ++i) af[i] = *(const bf16x8*)(As + (i * 16 + fr) * astride + (k0 + fq * 8) * 2);
#pragma unroll
    for (int jn = 0; jn < NT; ++jn) {
      bf16x8 bf = *(const bf16x8*)(Bt + (size_t)(n0 + jn * 16 + fr) * K + k0 + fq * 8);
#pragma unroll
      for (int i = 0; i < 4; ++i) acc[i][jn] = __builtin_amdgcn_mfma_f32_16x16x32_f16(bf, af[i], acc[i][jn], 0, 0, 0);
    }
  }
#pragma unroll
  for (int i = 0; i < 4; ++i)
#pragma unroll
    for (int jn = 0; jn < NT; ++jn) epi(i * 16 + fr, n0 + jn * 16 + fq * 4, acc[i][jn]);
}

struct S5P { float ar, ai, br, bi; };
DEV S5P s5_params(const Params& p, const Ctx& cx, int l, int d, int g, int lane) {
  int idx = ((l * 2 + d) * 32 + g) * 64 + lane;
  float lr = fminf(p.s5_lam_re[idx], -1e-4f), li = p.s5_lam_im[idx];
  float step = expf(p.s5_log_step[(l * 2 + d) * 32 + g]);
  float xr = lr * step, xi = li * step;
  float e = expf(xr), cs = cosf(xi), sn = sinf(xi);
  S5P r;
  r.ar = e * cs; r.ai = e * sn;
  float sh = sinf(0.5f * xi);
  float nr = expm1f(xr) * cs - 2.f * sh * sh, ni = e * sn;
  float inv = 1.f / (lr * lr + li * li);
  r.br = (nr * lr + ni * li) * inv;
  r.bi = (ni * lr - nr * li) * inv;
  return r;
}

DEV void s5_load_u(const h16* zrest, int rowbase, int g, char* ulds, int lane) {
#pragma unroll
  for (int i = 0; i < 8; ++i) {
    int e = i * 64 + lane;
    int r = e >> 1, hf = e & 1;
    uint4 v = *(const uint4*)(zrest + (size_t)(rowbase + r) * ZR + g * 16 + hf * 8);
    *(uint4*)(ulds + r * 32 + hf * 16) = v;
  }
  lds_fence();
}

DEV int s5_rowbase(int b, int c) { return c == 0 ? NLAT + b * 256 : b * 16384 + (c - 1) * 256; }

DEV void s5_pass1_unit(const Params& p, const Ctx& cx, int l, int unit, char* wl, int lane) {
  int c = unit % 65, bg = unit / 65, g = bg & 31, b = bg >> 5;
  const h16* zrest = (const h16*)(p.ws + OFF_ZREST);
  float2* F = (float2*)(p.ws + OFF_S5F);
  s5_load_u(zrest, s5_rowbase(b, c), g, wl, lane);
  float Br[16], Bi[16];
  {
    const float* pr = p.s5_b_re + ((size_t)(l * 32 + g) * 64 + lane) * 16;
    const float* pi = p.s5_b_im + ((size_t)(l * 32 + g) * 64 + lane) * 16;
#pragma unroll
    for (int i = 0; i < 16; i += 4) {
      float4 a = *(const float4*)(pr + i), bq = *(const float4*)(pi + i);
      Br[i] = a.x; Br[i + 1] = a.y; Br[i + 2] = a.z; Br[i + 3] = a.w;
      Bi[i] = bq.x; Bi[i + 1] = bq.y; Bi[i + 2] = bq.z; Bi[i + 3] = bq.w;
    }
  }
  S5P pf = s5_params(p, cx, l, 0, g, lane), pb = s5_params(p, cx, l, 1, g, lane);
  float xr = 0, xi = 0, yr = 0, yi = 0, pwr = 1.f, pwi = 0.f;
#pragma unroll 4
  for (int t = 0; t < 256; ++t) {
    h16x8 u0 = *(const h16x8*)(wl + t * 32), u1 = *(const h16x8*)(wl + t * 32 + 16);
    float br = 0, bi = 0;
#pragma unroll
    for (int i = 0; i < 8; ++i) { float u = (float)u0[i]; br = fmaf(u, Br[i], br); bi = fmaf(u, Bi[i], bi); }
#pragma unroll
    for (int i = 0; i < 8; ++i) { float u = (float)u1[i]; br = fmaf(u, Br[8 + i], br); bi = fmaf(u, Bi[8 + i], bi); }
    float nxr = pf.ar * xr - pf.ai * xi + br, nxi = pf.ar * xi + pf.ai * xr + bi;
    xr = nxr; xi = nxi;
    yr += pwr * br - pwi * bi; yi += pwr * bi + pwi * br;
    float npr = pwr * pb.ar - pwi * pb.ai, npi = pwr * pb.ai + pwi * pb.ar;
    pwr = npr; pwi = npi;
  }
  size_t fi = (((size_t)(b * 32 + g) * 65 + c) * 2) * 64 + lane;
  F[fi] = make_float2(pf.br * xr - pf.bi * xi, pf.br * xi + pf.bi * xr);
  F[fi + 64] = make_float2(pb.br * yr - pb.bi * yi, pb.br * yi + pb.bi * yr);
}

DEV void s5_pass3_unit(const Params& p, const Ctx& cx, int l, int unit, char* wl, int lane) {
  int c = unit % 65, bg = unit / 65, g = bg & 31, b = bg >> 5;
  const int fr = lane & 15, fq = lane >> 4;
  const h16* zrest = (const h16*)(p.ws + OFF_ZREST);
  const float2* F = (const float2*)(p.ws + OFF_S5F);
  float* S5Y = (float*)(p.ws + OFF_S5Y);
  const int rowbase = s5_rowbase(b, c);
  char* ulds = wl;
  char* tile = wl + 8192;
  s5_load_u(zrest, rowbase, g, ulds, lane);
  float Br[16], Bi[16];
  {
    const float* pr = p.s5_b_re + ((size_t)(l * 32 + g) * 64 + lane) * 16;
    const float* pi = p.s5_b_im + ((size_t)(l * 32 + g) * 64 + lane) * 16;
#pragma unroll
    for (int i = 0; i < 16; i += 4) {
      float4 a = *(const float4*)(pr + i), bq = *(const float4*)(pi + i);
      Br[i] = a.x; Br[i + 1] = a.y; Br[i + 2] = a.z; Br[i + 3] = a.w;
      Bi[i] = bq.x; Bi[i + 1] = bq.y; Bi[i + 2] = bq.z; Bi[i + 3] = bq.w;
    }
  }
  const float dsk = p.s5_d[(size_t)l * 512 + g * 16 + fr];
  const size_t fbase = ((size_t)(b * 32 + g) * 65) * 2 * 64 + lane;
#pragma unroll 1
  for (int d = 0; d < 2; ++d) {
    S5P pp = s5_params(p, cx, l, d, g, lane);
    float qr = pp.ar, qi = pp.ai;
#pragma unroll
    for (int i = 0; i < 8; ++i) { float t = qr * qr - qi * qi; qi = 2.f * qr * qi; qr = t; }
    float xr = 0, xi = 0;
    if (d == 0) {
      for (int cc = 0; cc < c; ++cc) {
        float2 f = F[fbase + (size_t)(cc * 2 + 0) * 64];
        float t = qr * xr - qi * xi + f.x; xi = qr * xi + qi * xr + f.y; xr = t;
      }
    } else if (c > 0) {
      float2 f0 = F[fbase + (size_t)(0 * 2 + 1) * 64];
      xr = f0.x; xi = f0.y;
      for (int cc = 64; cc > c; --cc) {
        float2 f = F[fbase + (size_t)(cc * 2 + 1) * 64];
        float t = qr * xr - qi * xi + f.x; xi = qr * xi + qi * xr + f.y; xr = t;
      }
    }
    bf16x8 chi[4], clo[4];
    {
      const float* cr = p.s5_c_re + ((size_t)((l * 2 + d) * 32 + g) * 16 + fr) * 64;
      const float* ci = p.s5_c_im + ((size_t)((l * 2 + d) * 32 + g) * 16 + fr) * 64;
#pragma unroll
      for (int ks = 0; ks < 4; ++ks) {
        float4 a = *(const float4*)(cr + ks * 16 + fq * 4), bq = *(const float4*)(ci + ks * 16 + fq * 4);
        float vals[8] = {a.x, -bq.x, a.y, -bq.y, a.z, -bq.z, a.w, -bq.w};
#pragma unroll
        for (int j = 0; j < 8; ++j) {
          h16 hh = (h16)vals[j];
          chi[ks][j] = hh;
          clo[ks][j] = (h16)(vals[j] - (float)hh);
        }
      }
    }
#pragma unroll 1
    for (int sb = 0; sb < 16; ++sb) {
      const int sub = d == 0 ? sb : 15 - sb;
#pragma unroll 4
      for (int q = 0; q < 16; ++q) {
        const int tt = d == 0 ? q : 15 - q;
        const int t = sub * 16 + tt;
        h16x8 u0 = *(const h16x8*)(ulds + t * 32), u1 = *(const h16x8*)(ulds + t * 32 + 16);
        float br = 0, bi = 0;
#pragma unroll
        for (int i = 0; i < 8; ++i) { float u = (float)u0[i]; br = fmaf(u, Br[i], br); bi = fmaf(u, Bi[i], bi); }
#pragma unroll
        for (int i = 0; i < 8; ++i) { float u = (float)u1[i]; br = fmaf(u, Br[8 + i], br); bi = fmaf(u, Bi[8 + i], bi); }
        float vr = pp.br * br - pp.bi * bi, vi = pp.br * bi + pp.bi * br;
        float nxr = pp.ar * xr - pp.ai * xi + vr, nxi = pp.ar * xi + pp.ai * xr + vi;
        xr = nxr; xi = nxi;
        h16x2 hv2 = {(h16)xr, (h16)xi};
        *(unsigned*)(tile + tt * 272 + lane * 4) = __builtin_bit_cast(unsigned, hv2);
      }
      lds_fence();
      f32x4 acc = f32x4{0.f, 0.f, 0.f, 0.f};
#pragma unroll
      for (int ks = 0; ks < 4; ++ks) {
        bf16x8 ah = *(const bf16x8*)(tile + fr * 272 + ks * 64 + fq * 16);
        acc = __builtin_amdgcn_mfma_f32_16x16x32_f16(ah, chi[ks], acc, 0, 0, 0);
        acc = __builtin_amdgcn_mfma_f32_16x16x32_f16(ah, clo[ks], acc, 0, 0, 0);
      }
      lds_fence();
#pragma unroll
      for (int r = 0; r < 4; ++r) {
        int tl = sub * 16 + fq * 4 + r;
        float* yp = S5Y + (size_t)(rowbase + tl) * 512 + g * 16 + fr;
        if (d == 0) {
          float u = (float)*(const h16*)(ulds + tl * 32 + fr * 2);
          *yp = acc[r] + dsk * u;
        } else {
          *yp = gelu_f(*yp + acc[r]);
        }
      }
    }
  }
}

DEV void prep_item(const Params& p, const Ctx& cx, int l, int item, char* smem) {
  const int tile = item >> 2, q = item & 3;
  const int row0 = tile * 64;
  const int tid = cx.tid;
  const h16* zc = (const h16*)(p.ws + OFF_REG2);
  h16* SC = (h16*)(p.ws + OFF_SCAN);
  const char* wt = p.ws + OFF_WT + (size_t)l * WT_SIZE;
  {
    const int d = q >> 1, isA = q & 1;
    const int coff = isA ? 3200 + d * 64 : 3072 + d * 64;
    int tok = tid >> 3, c8 = tid & 7;
    h16x8 cv = *(const h16x8*)(zc + (size_t)(row0 + tok) * ZC + coff + c8 * 8);
    float f[8];
#pragma unroll
    for (int j = 0; j < 8; ++j) { f[j] = (float)cv[j]; if (!isA) f[j] = tanh_f(f[j]); }
    uint4 o;
    o.x = pack_bf2(f[0], f[1]); o.y = pack_bf2(f[2], f[3]); o.z = pack_bf2(f[4], f[5]); o.w = pack_bf2(f[6], f[7]);
    *(uint4*)(smem + tok * 144 + c8 * 16) = o;
    __syncthreads();
    const bf16_t* Bt = (const bf16_t*)(wt + (isA ? WT_A2 : WT_W2)) + (size_t)d * 1024 * 64;
    const float* biasw = p.rwkv_w0 + (size_t)(l * 2 + d) * 1024;
    const float* biasa = p.rwkv_a0 + (size_t)(l * 2 + d) * 1024;
    h16* dst = SC + (size_t)(isA ? 4 + d : 6 + d) * ARR;
#pragma unroll 1
    for (int hf = 0; hf < 2; ++hf) small_gemm<64, 4>(p, cx, smem, 144, Bt, (tid >> 6) * 128 + hf * 64, [&](int m, int n, f32x4 v) {
      float4 bbw = *(const float4*)(biasw + n), bba = *(const float4*)(biasa + n);
      float4 bb = isA ? bba : bbw;
      float r0 = sigmoid_f(v[0] + bb.x), r1 = sigmoid_f(v[1] + bb.y), r2 = sigmoid_f(v[2] + bb.z), r3 = sigmoid_f(v[3] + bb.w);
      if (!isA) { r0 = __expf(-DECAY_SCALE * r0); r1 = __expf(-DECAY_SCALE * r1); r2 = __expf(-DECAY_SCALE * r2); r3 = __expf(-DECAY_SCALE * r3); }
      h16x4 o4 = {(h16)r0, (h16)r1, (h16)r2, (h16)r3};
      *(h16x4*)(dst + (size_t)(row0 + m) * 1024 + n) = o4;
    });
  }
  {
    const float* cw = p.conv_rkv + (size_t)l * 3 * 3072;
    const int grp = tid & 7, hh = (tid >> 3) & 3;
    const int c0 = (4 * q + hh) * 64 + grp * 8;
    float cwt[3][3][8];
#pragma unroll
    for (int s = 0; s < 3; ++s)
#pragma unroll
      for (int tp = 0; tp < 3; ++tp)
#pragma unroll
        for (int j = 0; j < 8; j += 4) {
          float4 a = *(const float4*)(cw + tp * 3072 + s * 1024 + c0 + j);
          cwt[s][tp][j] = a.x; cwt[s][tp][j + 1] = a.y; cwt[s][tp][j + 2] = a.z; cwt[s][tp][j + 3] = a.w;
        }
    float kkw[8];
#pragma unroll
    for (int j = 0; j < 8; j += 4) {
      float4 kq = *(const float4*)(p.rwkv_k_k + (size_t)l * 1024 + c0 + j);
      kkw[j] = kq.x; kkw[j + 1] = kq.y; kkw[j + 2] = kq.z; kkw[j + 3] = kq.w;
    }
#pragma unroll 1
    for (int it = 0; it < 4; ++it) {
      const int tok = (tid >> 5) + it * 16;
      const int row = row0 + tok;
      bool hasp, hasn;
      if (row < NLAT) { hasp = (row & 16383) != 0; hasn = (row & 16383) != 16383; }
      else { hasp = (row & 255) != 0; hasn = (row & 255) != 255; }
      const size_t off = (size_t)row * 1024 + c0;
      const h16* zp = zc + (size_t)row * ZC + c0;
      const h16* zpp = hasp ? zp - ZC : zp;
      const h16* zpn = hasn ? zp + ZC : zp;
      h16x8 cur[3], prv[3], nxt[3];
#pragma unroll
      for (int s = 0; s < 3; ++s) { cur[s] = *(const h16x8*)(zp + s * 1024); prv[s] = *(const h16x8*)(zpp + s * 1024); nxt[s] = *(const h16x8*)(zpn + s * 1024); }
      const float fp = hasp ? 1.f : 0.f, fn = hasn ? 1.f : 0.f;
      float kv[8];
#pragma unroll
      for (int s = 0; s < 3; ++s) {
        h16x8 o;
#pragma unroll
        for (int j = 0; j < 8; ++j) {
          float ov = cwt[s][0][j] * (fp * (float)prv[s][j]) + cwt[s][1][j] * (float)cur[s][j] + cwt[s][2][j] * (fn * (float)nxt[s][j]);
          o[j] = (h16)ov;
          if (s == 1) kv[j] = ov;
        }
        *(h16x8*)(SC + (size_t)s * ARR + off) = o;
      }
      float kk[8], ss = 0;
#pragma unroll
      for (int j = 0; j < 8; ++j) { kk[j] = kv[j] * kkw[j]; ss += kk[j] * kk[j]; }
      ss = allreduce8(ss);
      float inv = rcp_f(fmaxf(sqrtf(ss), 1e-12f));
      h16x8 o;
#pragma unroll
      for (int j = 0; j < 8; ++j) o[j] = (h16)(kk[j] * inv);
      *(h16x8*)(SC + 3 * ARR + off) = o;
    }
  }
}

DEV void phase_prep(const Params& p, const Ctx& cx0, int l, char* smem) {
  const int NPREP = 520 * 4, NS5 = 520;
  const Ctx& cx_ = cx0;
  for (int item = cx_.bid; item < NPREP + NS5; item += cx_.nblk) {
    __syncthreads();
    Ctx cx = cx0; asm volatile("" : "+v"(cx.tid));
    const int lane = cx.tid & 63, wid = cx.tid >> 6;
#ifndef NO_PREPITEM
    if (item < NPREP) prep_item(p, cx, l, item, smem);
    else
#endif
#ifndef NO_S5P1
      s5_pass1_unit(p, cx, l, (item - NPREP) * 8 + wid, smem + wid * 8192, lane);
#else
    {}
#endif
  }
}

typedef unsigned u2v __attribute__((ext_vector_type(2)));
typedef unsigned u4v __attribute__((ext_vector_type(4)));
struct RG { u2v w, a, kk, k, r; h16 v; };

constexpr int RW_NSLOT = 16, RW_SLOTB = 3072;
constexpr int RW_FLAGS = RW_NSLOT * RW_SLOTB;
constexpr int RW_NG = 16640 / 4;
typedef float f4v __attribute__((ext_vector_type(4)));

#define RW_RLO(gq, rlo)                                                            \
  {                                                                                \
    const int gg = (gq) < RW_NG ? (gq) : RW_NG - 1;                                \
    const int q0_ = gg * 4;                                                        \
    const int isl = q0_ >= 256;                                                    \
    const int base_ = isl ? b * 16384 : NLAT + b * 256;                            \
    const int t0_ = isl ? q0_ - 256 : q0_;                                         \
    const int last_ = isl ? 16383 : 255;                                           \
    rlo = base_ + (d ? last_ - t0_ - 3 : t0_);                                     \
  }

DEV void rwkv_helper(const Params& p, const Ctx& cx, int l, int unit, int lane, char* ring) {
  const int d = unit & 1, h = (unit >> 1) & 15, b = unit >> 5;
  const int j = lane >> 4, s = lane & 15;
  const h16* SC = (const h16*)(p.ws + OFF_SCAN);
  const char* pR = (const char*)(SC + 0 * ARR + h * 64);
  const char* pK = (const char*)(SC + 1 * ARR + h * 64);
  const char* pV = (const char*)(SC + 2 * ARR + h * 64);
  const char* pKK = (const char*)(SC + 3 * ARR + h * 64);
  const char* pA = (const char*)(SC + (size_t)(4 + d) * ARR + h * 64);
  const char* pW = (const char*)(SC + (size_t)(6 + d) * ARR + h * 64);
  const int jm = d ? 3 - j : j;
  const unsigned vo0 = (unsigned)(jm * 2048 + s * 8);
  f4v ka4, om4;
  {
    float4 t = *(const float4*)(p.rwkv_k_a + (size_t)l * 1024 + h * 64 + 4 * s);
    ka4 = f4v{t.x, t.y, t.z, t.w};
    om4 = 1.f - ka4;
  }
  struct RGH { u2v w, a, kk, k, r, v; };
  RGH q0, q1, q2, q3, q4, q5, q6, q7;
  const unsigned wofs = (unsigned)(j * 128 + s * 8);
  const unsigned vwofs = (unsigned)(2560 + j * 128 + s * 8);
  LAS3 volatile int* pflag = (LAS3 volatile int*)(ring + RW_FLAGS);
  LAS3 volatile int* cflag = (LAS3 volatile int*)(ring + RW_FLAGS + 64);
  int cmin = 0;
#define CV4(uv) __builtin_convertvector(__builtin_bit_cast(h16x4, uv), f4v)
#define RH_LOAD(q, gq)                                                             \
  {                                                                                \
    int rlo; RW_RLO(gq, rlo);                                                      \
    unsigned vo = vo0; asm volatile("" : "+v"(vo));                                \
    const size_t off = (size_t)rlo * 2048;                                         \
    q.w = *(const u2v*)(pW + off + vo); q.a = *(const u2v*)(pA + off + vo);        \
    q.kk = *(const u2v*)(pKK + off + vo); q.k = *(const u2v*)(pK + off + vo);      \
    q.r = *(const u2v*)(pR + off + vo); q.v = *(const u2v*)(pV + off + vo);        \
  }
#define RH_STEP(q, gq)                                                             \
  {                                                                                \
    if ((gq) >= RW_NSLOT && cmin < (gq) - RW_NSLOT + 1) {                          \
      do {                                                                         \
        const int c0_ = cflag[0], c1_ = cflag[1], c2_ = cflag[2], c3_ = cflag[3];  \
        cmin = __builtin_amdgcn_readfirstlane(min(min(c0_, c1_), min(c2_, c3_)));  \
        if (cmin < (gq) - RW_NSLOT + 1) __builtin_amdgcn_s_sleep(1);               \
      } while (cmin < (gq) - RW_NSLOT + 1);                                        \
    }                                                                              \
    asm volatile("" ::: "memory");                                                 \
    char* sl = ring + ((gq) % RW_NSLOT) * RW_SLOTB;                                \
    const f4v a_ = CV4(q.a), kk_ = CV4(q.kk);                                      \
    const f4v kka_ = kk_ * a_, kd_ = CV4(q.k) * (a_ * ka4 + om4);                  \
    {     \
      const u2v kka2_ = __builtin_bit_cast(u2v, __builtin_convertvector(kka_, h16x4));                      \
      const u2v kd2_ = __builtin_bit_cast(u2v, __builtin_convertvector(kd_, h16x4));                        \
      *(u4v*)(sl + 0 + j * 256 + s * 16) = u4v{q.w.x, q.w.y, q.kk.x, q.kk.y};      \
      *(u4v*)(sl + 1024 + j * 256 + s * 16) = u4v{kka2_.x, kka2_.y, kd2_.x, kd2_.y}; \
      *(u2v*)(sl + 2048 + wofs) = q.r;                                             \
    }                                                                              \
    *(u2v*)(sl + vwofs) = q.v;                                                     \
    asm volatile("s_waitcnt lgkmcnt(0)" ::: "memory");     \
    *pflag = (gq) + 1;                                                             \
  }
  RH_LOAD(q0, 0); RH_LOAD(q1, 1); RH_LOAD(q2, 2); RH_LOAD(q3, 3); RH_LOAD(q4, 4); RH_LOAD(q5, 5); RH_LOAD(q6, 6); RH_LOAD(q7, 7);
#pragma unroll 1
  for (int g = 0; g < RW_NG; g += 8) {
    RH_STEP(q0, g); RH_LOAD(q0, g + 8); __builtin_amdgcn_sched_barrier(0);
    RH_STEP(q1, g + 1); RH_LOAD(q1, g + 9); __builtin_amdgcn_sched_barrier(0);
    RH_STEP(q2, g + 2); RH_LOAD(q2, g + 10); __builtin_amdgcn_sched_barrier(0);
    RH_STEP(q3, g + 3); RH_LOAD(q3, g + 11); __builtin_amdgcn_sched_barrier(0);
    RH_STEP(q4, g + 4); RH_LOAD(q4, g + 12); __builtin_amdgcn_sched_barrier(0);
    RH_STEP(q5, g + 5); RH_LOAD(q5, g + 13); __builtin_amdgcn_sched_barrier(0);
    RH_STEP(q6, g + 6); RH_LOAD(q6, g + 14); __builtin_amdgcn_sched_barrier(0);
    RH_STEP(q7, g + 7); RH_LOAD(q7, g + 15); __builtin_amdgcn_sched_barrier(0);
  }
#undef RH_LOAD
#undef RH_STEP
#undef CV4
}

DEV void rwkv_consumer(const Params& p, const Ctx& cx, int l, int task, int lane, const char* ring, int widx) {
  const int unit = task >> 4, d = unit & 1, h = (unit >> 1) & 15, b = unit >> 5;
  const int j = lane >> 4, s = lane & 15;
  const int myrow = (task & 15) * 4 + j;
  char* pO = (char*)((h16*)(p.ws + OFF_REG2) + (size_t)d * ARR + h * 64);
  const int sm = d ? 3 - (s & 3) : (s & 3);
  const unsigned vov0 = (unsigned)(sm * 2048 + myrow * 2);
  const unsigned rofs = (unsigned)(s * 8);
  const unsigned vrofs = (unsigned)(2560 + myrow * 2);
  LAS3 volatile int* pflag = (LAS3 volatile int*)(ring + RW_FLAGS);
  LAS3 volatile int* cflag = (LAS3 volatile int*)(ring + RW_FLAGS + 64) + widx;
  float S0 = 0.f, S1 = 0.f, S2 = 0.f, S3 = 0.f;
  int pseen = 0;
  struct GD { u2v w[4], kk[4], kka[4], kd[4], r[4]; unsigned v[4]; };
  GD A, B;
#define RC_WAIT(gq) { if (pseen <= (gq)) { do { pseen = __builtin_amdgcn_readfirstlane(*pflag); if (pseen <= (gq)) __builtin_amdgcn_s_sleep(1); } while (pseen <= (gq)); } asm volatile("" ::: "memory"); }
#define RC_LOAD(G, gq)                                                             \
  {                                                                                \
    const char* sl = ring + ((gq) % RW_NSLOT) * RW_SLOTB;                          \
    _Pragma("unroll") for (int u = 0; u < 4; ++u) {                                \
      const u4v p0_ = *(const u4v*)(sl + 0 + u * 256 + 2 * rofs);                  \
      const u4v p1_ = *(const u4v*)(sl + 1024 + u * 256 + 2 * rofs);               \
      G.w[u] = u2v{p0_.x, p0_.y}; G.kk[u] = u2v{p0_.z, p0_.w};                     \
      G.kka[u] = u2v{p1_.x, p1_.y}; G.kd[u] = u2v{p1_.z, p1_.w};                   \
      G.r[u] = *(const u2v*)(sl + 2048 + u * 128 + rofs);                          \
      G.v[u] = *(const unsigned short*)(sl + u * 128 + vrofs);                     \
    }                                                                              \
  }
#define RC_COMP(G, gq)                                                             \
  {                                                                                \
    float dres[4];                                                                 \
    _Pragma("unroll") for (int u = 0; u < 4; ++u) {                                \
        \
        \
      float ea, eb, x_, y_, t0, t1, t2, t3;                                        \
      asm("v_fma_mix_f32 %6, %0, %12, 0 op_sel:[0,0,0] op_sel_hi:[0,1,0]\n\t"      \
          "v_fma_mix_f32 %7, %2, %13, 0 op_sel:[0,0,0] op_sel_hi:[0,1,0]\n\t"      \
          "v_fma_mix_f32 %6, %1, %12, %6 op_sel:[0,1,0] op_sel_hi:[0,1,0]\n\t"     \
          "v_fma_mix_f32 %7, %3, %13, %7 op_sel:[0,1,0] op_sel_hi:[0,1,0]\n\t"     \
          "v_fma_mix_f32 %8, %22, %16, 0 op_sel:[0,0,0] op_sel_hi:[1,1,0]\n\t"     \
          "v_add_f32 %6, %6, %7\n\t"                                               \
          "v_fma_mix_f32 %9, %22, %16, 0 op_sel:[0,1,0] op_sel_hi:[1,1,0]\n\t"     \
          "v_fma_mix_f32 %10, %22, %17, 0 op_sel:[0,0,0] op_sel_hi:[1,1,0]\n\t"    \
          "v_add_f32_dpp %6, %6, %6 quad_perm:[1,0,3,2] row_mask:0xf bank_mask:0xf bound_ctrl:1\n\t" \
          "v_fma_mix_f32 %11, %22, %17, 0 op_sel:[0,1,0] op_sel_hi:[1,1,0]\n\t"    \
          "v_fma_mix_f32 %0, %0, %14, %8 op_sel:[0,0,0] op_sel_hi:[0,1,0]\n\t"     \
          "v_add_f32_dpp %6, %6, %6 quad_perm:[2,3,0,1] row_mask:0xf bank_mask:0xf bound_ctrl:1\n\t" \
          "v_fma_mix_f32 %1, %1, %14, %9 op_sel:[0,1,0] op_sel_hi:[0,1,0]\n\t"     \
          "v_fma_mix_f32 %2, %2, %15, %10 op_sel:[0,0,0] op_sel_hi:[0,1,0]\n\t"    \
          "v_add_f32_dpp %6, %6, %6 row_half_mirror row_mask:0xf bank_mask:0xf bound_ctrl:1\n\t" \
          "v_fma_mix_f32 %3, %3, %15, %11 op_sel:[0,1,0] op_sel_hi:[0,1,0]\n\t"    \
          "s_nop 0\n\t"                                                            \
          "v_add_f32_dpp %6, %6, %6 row_mirror row_mask:0xf bank_mask:0xf bound_ctrl:1\n\t" \
          "v_fma_mix_f32 %0, -%6, %18, %0 op_sel:[0,0,0] op_sel_hi:[0,1,0]\n\t"    \
          "v_fma_mix_f32 %1, -%6, %18, %1 op_sel:[0,1,0] op_sel_hi:[0,1,0]\n\t"    \
          "v_fma_mix_f32 %2, -%6, %19, %2 op_sel:[0,0,0] op_sel_hi:[0,1,0]\n\t"    \
          "v_fma_mix_f32 %3, -%6, %19, %3 op_sel:[0,1,0] op_sel_hi:[0,1,0]\n\t"    \
          "v_fma_mix_f32 %4, %0, %20, 0 op_sel:[0,0,0] op_sel_hi:[0,1,0]\n\t"      \
          "v_fma_mix_f32 %5, %2, %21, 0 op_sel:[0,0,0] op_sel_hi:[0,1,0]\n\t"      \
          "v_fma_mix_f32 %4, %1, %20, %4 op_sel:[0,1,0] op_sel_hi:[0,1,0]\n\t"     \
          "v_fma_mix_f32 %5, %3, %21, %5 op_sel:[0,1,0] op_sel_hi:[0,1,0]"         \
          : "+v"(S0), "+v"(S1), "+v"(S2), "+v"(S3), "=&v"(ea), "=&v"(eb), "=&v"(x_), "=&v"(y_),                     \
            "=&v"(t0), "=&v"(t1), "=&v"(t2), "=&v"(t3)                                                              \
          : "v"(G.kk[u].x), "v"(G.kk[u].y), "v"(G.w[u].x), "v"(G.w[u].y), "v"(G.kd[u].x), "v"(G.kd[u].y),           \
            "v"(G.kka[u].x), "v"(G.kka[u].y), "v"(G.r[u].x), "v"(G.r[u].y), "v"(G.v[u]));                           \
      dres[u] = ea + eb;     \
    }                                                                              \
    asm volatile("" ::: "memory");                                                 \
    *cflag = (gq) + 1;     \
    {                                                                              \
      int rlo; RW_RLO(gq, rlo);                                                    \
      unsigned vov = vov0; asm volatile("" : "+v"(vov));                           \
        \
      const bool p1_ = (s & 1) != 0, p2_ = (s & 2) != 0;                           \
      const float a_ = (p1_ ? dres[1] : dres[0]) + dpp_mov<0xB1>(p1_ ? dres[0] : dres[1]); \
      const float b_ = (p1_ ? dres[3] : dres[2]) + dpp_mov<0xB1>(p1_ ? dres[2] : dres[3]); \
      float val = (p2_ ? b_ : a_) + dpp_mov<0x4E>(p2_ ? a_ : b_);                  \
      val += dpp_mov<0x124>(val);                                                  \
      val += dpp_mov<0x128>(val);                                                  \
      *(h16*)(pO + (size_t)rlo * 2048 + vov) = (h16)val;                           \
    }                                                                              \
  }
  RC_WAIT(0); RC_LOAD(A, 0);
#pragma unroll 1
  for (int g = 0; g < RW_NG; g += 2) {
    RC_WAIT(g + 1); RC_LOAD(B, g + 1);
    RC_COMP(A, g);
    if (g + 2 < RW_NG) { RC_WAIT(g + 2); RC_LOAD(A, g + 2); }
    RC_COMP(B, g + 1);
  }
#undef RC_WAIT
#undef RC_LOAD
#undef RC_COMP
}
#undef RW_RLO

DEV void phase_scan(const Params& p, const Ctx& cx, int l, char* smem) {
  const int lane = cx.tid & 63, wid = __builtin_amdgcn_readfirstlane(cx.tid >> 6);
  for (int slot = cx.bid; slot < 256; slot += cx.nblk) {
    __syncthreads();
    if (wid == 4 && lane < 8) *(LAS3 volatile int*)(smem + RW_FLAGS + (lane == 0 ? 0 : 64 + (lane & 3) * 4)) = 0;
    __syncthreads();
    const int unit = slot & 63;
#ifndef NO_RWKV
    if (wid < 4) { __builtin_amdgcn_s_setprio(3); rwkv_consumer(p, cx, l, (unit << 4) | ((slot >> 6) << 2) | wid, lane, smem, wid); __builtin_amdgcn_s_setprio(0); }
    else if (wid == 4) { __builtin_amdgcn_s_setprio(1); rwkv_helper(p, cx, l, unit, lane, smem); __builtin_amdgcn_s_setprio(0); }
#endif
  }
  if (wid >= 5) {
    char* wl = smem + 50176 + (wid - 5) * 17408;
    for (int u = cx.bid * 3 + (wid - 5); u < 2 * 32 * 65; u += cx.nblk * 3) {
      if (l == 1 && (u % 65) == 0) continue;
#ifndef NO_S5P3
      s5_pass3_unit(p, cx, l, u, wl, lane);
#endif
    }
  }
}

DEV void pool_item(const Params& p, const Ctx& cx, int l, int item, char* smem) {
  const int tid = cx.tid;
  const h16* zrest = (const h16*)(p.ws + OFF_ZREST);
  bf16_t* ym = (bf16_t*)(p.ws + OFF_YM);
  const char* wt = p.ws + OFF_WT + (size_t)l * WT_SIZE;
  float* V = (float*)smem;
  char* At = smem + 43008;
  int g, rowout0, Lseq, p0, rlo, rhi, rstride, rowsrc0;
  if (item < 2048) {
    g = item & 3; int r = (item >> 2) & 255, b = item >> 10;
    int w = 2 << g;
    rlo = max(r - w / 2, 0); rhi = min(r + w / 2 - 1, 255);
    rowsrc0 = b * 16384; rstride = 64;
    rowout0 = b * 16384 + r * 64; Lseq = 64; p0 = 0;
  } else {
    int it = item - 2048;
    g = it & 3; int tq = (it >> 2) & 3, b = it >> 4;
    rlo = 0; rhi = 0; rowsrc0 = NLAT + b * 256; rstride = 0;
    rowout0 = NLAT + b * 256 + tq * 64; Lseq = 256; p0 = tq * 64;
  }
  const int w = 2 << g;
  const float invr = 1.f / (float)(rhi - rlo + 1);
  for (int unit = tid; unit < 80 * 16; unit += NTHREADS) {
    int lp = unit >> 4, ch8 = unit & 15;
    int pos = p0 - 8 + lp;
    float acc[8] = {0, 0, 0, 0, 0, 0, 0, 0};
    if (pos >= 0 && pos < Lseq) {
      const h16* bp = zrest + (size_t)(rowsrc0 + pos) * ZR + 1024 + g * 128 + ch8 * 8;
      const int nr = rhi - rlo + 1;
      for (int k0 = 0; k0 < nr; k0 += 4) {
        h16x8 v[4]; float wv[4];
#pragma unroll
        for (int i = 0; i < 4; ++i) {
          const int kk_ = min(k0 + i, nr - 1);
          wv[i] = (k0 + i < nr) ? 1.f : 0.f;
          v[i] = *(const h16x8*)(bp + (size_t)((rlo + kk_) * rstride) * ZR);
        }
#pragma unroll
        for (int i = 0; i < 4; ++i)
#pragma unroll
          for (int j = 0; j < 8; ++j) acc[j] += wv[i] * (float)v[i][j];
      }
    }
    float* vp = V + lp * 132 + ch8 * 8;
#pragma unroll
    for (int j = 0; j < 8; ++j) vp[j] = acc[j] * invr;
  }
  __syncthreads();
  for (int unit = tid; unit < 64 * 16; unit += NTHREADS) {
    int c = unit >> 4, ch8 = unit & 15;
    int pos = p0 + c;
    int lo = max(pos - w / 2, 0), hi = min(pos + w / 2 - 1, Lseq - 1);
    float acc[8] = {0, 0, 0, 0, 0, 0, 0, 0};
    for (int pp = lo; pp <= hi; ++pp) {
      const float* vp = V + (pp - p0 + 8) * 132 + ch8 * 8;
#pragma unroll
      for (int j = 0; j < 8; ++j) acc[j] += vp[j];
    }
    float invc = 1.f / (float)(hi - lo + 1);
    h16x8 uc = *(const h16x8*)(zrest + (size_t)(rowout0 + c) * ZR + 1024 + g * 128 + ch8 * 8);
    uint4 o;
    o.x = pack_bf2(acc[0] * invc - (float)uc[0], acc[1] * invc - (float)uc[1]);
    o.y = pack_bf2(acc[2] * invc - (float)uc[2], acc[3] * invc - (float)uc[3]);
    o.z = pack_bf2(acc[4] * invc - (float)uc[4], acc[5] * invc - (float)uc[5]);
    o.w = pack_bf2(acc[6] * invc - (float)uc[6], acc[7] * invc - (float)uc[7]);
    *(uint4*)(At + c * 272 + ch8 * 16) = o;
  }
  __syncthreads();
  const bf16_t* Bt = (const bf16_t*)(wt + WT_POOL) + (size_t)g * 128 * 128;
  const float* ps = p.pool_scale + (size_t)l * 512 + g * 128;
  small_gemm<128, 1>(p, cx, At, 272, Bt, (tid >> 6) * 16, [&](int m, int n, f32x4 v) {
    int row = rowout0 + m;
    float4 sc = *(const float4*)(ps + n);
    h16x4 gt = *(const h16x4*)(zrest + (size_t)row * ZR + 1536 + g * 128 + n);
    uint2 o;
    o.x = pack_bf2(v[0] * sc.x * silu_f((float)gt[0]), v[1] * sc.y * silu_f((float)gt[1]));
    o.y = pack_bf2(v[2] * sc.z * silu_f((float)gt[2]), v[3] * sc.w * silu_f((float)gt[3]));
    *(uint2*)(ym + (size_t)row * D + 512 + g * 128 + n) = o;
  });
}

DEV void glu_item(const Params& p, const Ctx& cx, int l, int tile, char* smem) {
  const int tid = cx.tid;
  const int row0 = tile * 64;
  const float* S5Y = (const float*)(p.ws + OFF_S5Y);
  const h16* zrest = (const h16*)(p.ws + OFF_ZREST);
  bf16_t* ym = (bf16_t*)(p.ws + OFF_YM);
  const char* wt = p.ws + OFF_WT + (size_t)l * WT_SIZE;
#pragma unroll
  for (int it = 0; it < 8; ++it) {
    int unit = tid + it * NTHREADS;
    int r = unit >> 6, c8 = unit & 63;
    const float* sp = S5Y + (size_t)(row0 + r) * 512 + c8 * 8;
    float4 a = *(const float4*)sp, bq = *(const float4*)(sp + 4);
    uint4 o;
    o.x = pack_bf2(a.x, a.y); o.y = pack_bf2(a.z, a.w); o.z = pack_bf2(bq.x, bq.y); o.w = pack_bf2(bq.z, bq.w);
    *(uint4*)(smem + r * 1040 + c8 * 16) = o;
  }
  __syncthreads();
  const bf16_t* Bt = (const bf16_t*)(wt + WT_GLU);
  const float* bg = p.b_glu + (size_t)l * 512;
  small_gemm<512, 4>(p, cx, smem, 1040, Bt, (tid >> 6) * 64, [&](int m, int n, f32x4 v) {
    int row = row0 + m;
    float4 y = *(const float4*)(S5Y + (size_t)row * 512 + n);
    float4 bb = *(const float4*)(bg + n);
    h16x4 gt = *(const h16x4*)(zrest + (size_t)row * ZR + 512 + n);
    uint2 o;
    o.x = pack_bf2(y.x * sigmoid_f(v[0] + bb.x) * silu_f((float)gt[0]), y.y * sigmoid_f(v[1] + bb.y) * silu_f((float)gt[1]));
    o.y = pack_bf2(y.z * sigmoid_f(v[2] + bb.z) * silu_f((float)gt[2]), y.w * sigmoid_f(v[3] + bb.w) * silu_f((float)gt[3]));
    *(uint2*)(ym + (size_t)row * D + n) = o;
  });
}

DEV void rwkvmerge_item(const Params& p, const Ctx& cx, int l, int tile) {
  const int tid = cx.tid;
  const int row0 = tile * 64;
  const h16* SC = (const h16*)(p.ws + OFF_SCAN);
  const h16* O = (const h16*)(p.ws + OFF_REG2);
  const h16* zrest = (const h16*)(p.ws + OFF_ZREST);
  bf16_t* ym = (bf16_t*)(p.ws + OFF_YM);
  const int grp = tid & 7, h = (tid >> 3) & 15;
  const int c0 = h * 64 + grp * 8;
  float pk[8], rk[8], gw[8], gb[8];
#pragma unroll
  for (int j = 0; j < 8; j += 4) {
    float4 t0 = *(const float4*)(p.rwkv_k_a + (size_t)l * 1024 + c0 + j), t1 = *(const float4*)(p.rwkv_r_k + (size_t)l * 1024 + c0 + j);
    float4 t2 = *(const float4*)(p.gn_w + (size_t)l * 1024 + c0 + j), t3 = *(const float4*)(p.gn_b + (size_t)l * 1024 + c0 + j);
    pk[j] = t0.x; pk[j + 1] = t0.y; pk[j + 2] = t0.z; pk[j + 3] = t0.w;
    rk[j] = t1.x; rk[j + 1] = t1.y; rk[j + 2] = t1.z; rk[j + 3] = t1.w;
    gw[j] = t2.x; gw[j + 1] = t2.y; gw[j + 2] = t2.z; gw[j + 3] = t2.w;
    gb[j] = t3.x; gb[j + 1] = t3.y; gb[j + 2] = t3.z; gb[j + 3] = t3.w;
  }
#pragma unroll 2
  for (int it = 0; it < 16; ++it) {
    const int tok = (tid >> 7) + it * 4;
    int row = row0 + tok;
    size_t off = (size_t)row * 1024 + c0;
    h16x8 of = *(const h16x8*)(O + off), ob = *(const h16x8*)(O + ARR + off);
    h16x8 r8 = *(const h16x8*)(SC + 0 * ARR + off), k8 = *(const h16x8*)(SC + 1 * ARR + off), v8 = *(const h16x8*)(SC + 2 * ARR + off);
    h16x8 af = *(const h16x8*)(SC + 4 * ARR + off), ab = *(const h16x8*)(SC + 5 * ARR + off);
    h16x8 gt = *(const h16x8*)(zrest + (size_t)row * ZR + 2048 + c0);
    float o[8], sm = 0;
#pragma unroll
    for (int j = 0; j < 8; ++j) { o[j] = (float)of[j] + (float)ob[j]; sm += o[j]; }
    sm = allreduce8(sm);
    float mu = sm * (1.f / 64.f), vq = 0;
#pragma unroll
    for (int j = 0; j < 8; ++j) { o[j] -= mu; vq += o[j] * o[j]; }
    vq = allreduce8(vq);
    float rstd = rsqrtf(vq * (1.f / 64.f) + 64e-5f);
    float part = 0;
#pragma unroll
    for (int j = 0; j < 8; ++j) {
      float ksum = (float)k8[j] * (2.f + ((float)af[j] + (float)ab[j] - 2.f) * pk[j]);
      part += (float)r8[j] * ksum * rk[j];
    }
    part = allreduce8(part);
    float res[8];
#pragma unroll
    for (int j = 0; j < 8; ++j) {
      float y = o[j] * rstd * gw[j] + gb[j] + part * (float)v8[j];
      res[j] = y * silu_f((float)gt[j]);
    }
    uint4 ov;
    ov.x = pack_bf2(res[0], res[1]); ov.y = pack_bf2(res[2], res[3]); ov.z = pack_bf2(res[4], res[5]); ov.w = pack_bf2(res[6], res[7]);
    *(uint4*)(ym + (size_t)row * D + 1024 + c0) = ov;
  }
}

DEV void phase_merge(const Params& p, const Ctx& cx0, int l, char* smem) {
  const int ntile = (l == 0) ? 520 : 512;
  const int npool = (l == 0) ? 2048 + 32 : 2048;
  const int total = npool + 2 * ntile;
  for (int item = cx0.bid; item < total; item += cx0.nblk) {
    __syncthreads();
    Ctx cx = cx0; asm volatile("" : "+v"(cx.tid));
    const int grp6 = item / 6, pos6 = item - grp6 * 6;
    if (pos6 < 4) pool_item(p, cx, l, grp6 * 4 + pos6, smem);
    else if (pos6 == 4) glu_item(p, cx, l, grp6, smem);
    else rwkvmerge_item(p, cx, l, grp6);
  }
}

#define XB_TMO      128
#define XB_XCNT(j)  (256  + 64 * (j))
#define XB_XSUB(j)  (1280 + 64 * (j))
#define XB_XGEN(j)  (2304 + 64 * (j))
#define XB_TOP      3328
#define XB_TOPGEN   3392
#define XCD_BAR_WORDS 3456
#define XB_SPIN_CAP (1u << 18)
DEV unsigned xb_ld(unsigned* p) { return __hip_atomic_load(p, __ATOMIC_RELAXED, __HIP_MEMORY_SCOPE_AGENT); }
DEV unsigned xb_add(unsigned* p, unsigned v) { return __hip_atomic_fetch_add(p, v, __ATOMIC_RELAXED, __HIP_MEMORY_SCOPE_AGENT); }
DEV unsigned xb_xcc_id() { return (unsigned)__builtin_amdgcn_s_getreg((3 << 11) | 20) & 0xFu; }
#define XB_SPIN(cond, bar) do { unsigned _sp = 0; while (cond) { __builtin_amdgcn_s_sleep(1); \
    if ((++_sp & 255u) == 0u) { if (xb_ld(&(bar)[XB_TMO])) break; if (_sp > XB_SPIN_CAP) { atomicAdd(&(bar)[XB_TMO], 1u); break; } } } } while (0)
struct XcdBarrier { unsigned* bar; unsigned x; volatile LAS3 unsigned* st; };
DEV XcdBarrier xcd_barrier_post(unsigned* bar, volatile LAS3 unsigned* st) {
  XcdBarrier b; b.bar = bar; b.x = xb_xcc_id(); b.st = st;
  if (threadIdx.x == 0) (void)xb_add(&bar[XB_XCNT(b.x)], 1u);
  return b;
}
DEV void xcd_barrier_complete(unsigned* bar, unsigned x, unsigned& nloc, unsigned& nx) {
  const unsigned G = gridDim.x * gridDim.y * gridDim.z;
  unsigned sum, cnt, mine, sp = 0u;
  for (;;) {
    sum = 0u; cnt = 0u; mine = 0u;
#pragma unroll
    for (unsigned j = 0; j < 16; ++j) { const unsigned c = xb_ld(&bar[XB_XCNT(j)]); sum += c; cnt += (c > 0u) ? 1u : 0u; mine = (j == x) ? c : mine; }
    if (sum == G) break;
    __builtin_amdgcn_s_sleep(1);
    if ((++sp & 255u) == 0u) { if (xb_ld(&bar[XB_TMO])) break; if (sp > XB_SPIN_CAP) { atomicAdd(&bar[XB_TMO], 1u); break; } }
  }
  nloc = mine > 0u ? mine : 1u; nx = cnt > 0u ? cnt : 1u;
}
DEV void xcd_barrier(const XcdBarrier& b) {
  asm volatile("s_waitcnt vmcnt(0)" ::: "memory");
  __syncthreads();
  if (threadIdx.x == 0) {
    unsigned* bar = b.bar;
    __builtin_amdgcn_s_waitcnt(0);
    unsigned nloc = b.st[0], nx = b.st[1];
    if (nloc == 0u) { xcd_barrier_complete(bar, b.x, nloc, nx); b.st[0] = nloc; b.st[1] = nx; }
    const unsigned old = xb_add(&bar[XB_XSUB(b.x)], 1u);
    const unsigned gen = old / nloc;
    if (old + 1u == (gen + 1u) * nloc) {
      __builtin_amdgcn_fence(__ATOMIC_RELEASE, "agent");
      asm volatile("s_waitcnt vmcnt(0)" ::: "memory");
      const unsigned og = xb_add(&bar[XB_TOP], 1u);
      const unsigned tg = og / nx;
      if (og + 1u == (tg + 1u) * nx) xb_add(&bar[XB_TOPGEN], 1u);
      else XB_SPIN(xb_ld(&bar[XB_TOPGEN]) == tg, bar);
      __builtin_amdgcn_fence(__ATOMIC_ACQUIRE, "agent");
      xb_add(&bar[XB_XGEN(b.x)], 1u);
      asm volatile("s_waitcnt vmcnt(0)" ::: "memory");
    } else {
      XB_SPIN(xb_ld(&bar[XB_XGEN(b.x)]) == gen, bar);
      __builtin_amdgcn_fence(__ATOMIC_ACQUIRE, "agent");
      asm volatile("s_waitcnt vmcnt(0)" ::: "memory");
    }
  }
  __syncthreads();
}

#define LCX Ctx c2 = cx; asm volatile("" : "+v"(c2.tid))
#ifndef GEMM_FN
#define GEMM_FN gemm_phase2
#endif
__global__ void __launch_bounds__(NTHREADS) mega_fwd(Params p, int ph0, int ph1) {
  extern __shared__ __attribute__((aligned(16))) char smem[];
  cg::grid_group grid = cg::this_grid();
  __shared__ uint4 xb_words;
  if (threadIdx.x == 0) xb_words = make_uint4(0u, 0u, 0u, 0u);
  __syncthreads();
  XcdBarrier xb; xb.bar = (unsigned*)(p.ws + OFF_BAR); xb.x = xb_xcc_id(); xb.st = (volatile LAS3 unsigned*)&xb_words;
  if (blockIdx.x == 0) for (int i = threadIdx.x; i < XCD_BAR_WORDS; i += NTHREADS) xb.bar[i] = 0u;
  const int wave_s = __builtin_amdgcn_readfirstlane((int)(threadIdx.x >> 6));
  for (int step = ph0; step < ph1; ++step) {
    if (step == ph0 + 1) { grid.sync(); if (threadIdx.x == 0) (void)xb_add(&xb.bar[XB_XCNT(xb.x)], 1u); } else if (step > ph0) xcd_barrier(xb);
    const int ph = (int)((PH_SEQ >> (4 * step)) & 15ull);
    Ctx cx;
    {
      int t_, b_ = blockIdx.x, n_ = gridDim.x;
      asm volatile("v_mbcnt_lo_u32_b32 %0, -1, 0\n\tv_mbcnt_hi_u32_b32 %0, -1, %0\n\tv_lshl_add_u32 %0, %1, 6, %0" : "=&v"(t_) : "s"(wave_s));
      asm volatile("" : "+s"(b_), "+s"(n_));
      cx.tid = t_; cx.bid = b_; cx.nblk = n_;
    }
    const int l = ph >= 8 ? 1 : 0;
    const int lp = ph >= 8 ? ph - 6 : ph;
#ifndef PHMASK
#define PHMASK 0xff
#endif
    if (ph == 0) { if (PHMASK & 1) { LCX; phase0(p, c2, smem, 0); } }
    else if (ph == 1) {
      if (PHMASK & 2) { LCX; if (c2.bid & 1) { phase_adaln0(p, c2); phase0(p, c2, smem, 1); } else { phase0(p, c2, smem, 1); phase_adaln0(p, c2); } }
    }
    else if (lp == 2 && (PHMASK & 4)) {
      LCX;
      h16* zrest = (h16*)(p.ws + OFF_ZREST);
      h16* zc = (h16*)(p.ws + OFF_REG2);
      GEMM_FN(p, c2, (const bf16_t*)(p.ws + OFF_H), (const bf16_t*)(p.ws + OFF_WT + (size_t)l * WT_SIZE + WT_IN), 2048, 130, 25, smem,
                 [&](int row, int col, f32x4 v, f32x4 u) {
                   h16* dst;
                   if (col < 2048) dst = zrest + (size_t)row * ZR + col;
                   else if (col < 5120) dst = zc + (size_t)row * ZC + (col - 2048);
                   else if (col < 6144) dst = zrest + (size_t)row * ZR + 2048 + (col - 5120);
                   else dst = zc + (size_t)row * ZC + 3072 + (col - 6144);
                   h16x8 o = {(h16)v[0], (h16)v[1], (h16)v[2], (h16)v[3], (h16)u[0], (h16)u[1], (h16)u[2], (h16)u[3]};
                   *(h16x8*)dst = o;
                 });
    } else if (lp == 3) { if (PHMASK & 8) { LCX; phase_prep(p, c2, l, smem); } }
    else if (lp == 4) { if (PHMASK & 16) { LCX; phase_scan(p, c2, l, smem); } }
    else if (lp == 5) { if (PHMASK & 32) { LCX; phase_merge(p, c2, l, smem); } }
    else if (lp == 6 && (PHMASK & 64)) {
      LCX;
      const float* mods = (const float*)(p.ws + OFF_MODS);
      float* prec = (float*)(p.ws + OFF_PREC);
      const float* xin = (l == 0) ? p.x : p.out;
      GEMM_FN(p, c2, (const bf16_t*)(p.ws + OFF_YM), (const bf16_t*)(p.ws + OFF_WT + (size_t)l * WT_SIZE + WT_OUT), 2048, l == 0 ? 130 : 128, 8, smem,
                 [&](int row, int col, f32x4 v, f32x4 u) {
                   const float* xr; const float* gr; float* dr;
                   if (row < NLAT) {
                     xr = xin + (size_t)row * D + col; gr = mods + (size_t)(l * 3 + (row >> 14)) * 6144 + 4096 + col; dr = p.out + (size_t)row * D + col;
                   } else {
                     xr = p.ctx + (size_t)(row - NLAT) * D + col; gr = mods + (size_t)(l * 3 + 2) * 6144 + 4096 + col; dr = prec + (size_t)(row - NLAT) * D + col;
                   }
                   const float4 x0 = *(const float4*)xr, x1 = *(const float4*)(xr + 4), g0 = *(const float4*)gr, g1 = *(const float4*)(gr + 4);
                   float4 r0, r1;
                   r0.x = ALPHA * x0.x + g0.x * v[0]; r0.y = ALPHA * x0.y + g0.y * v[1]; r0.z = ALPHA * x0.z + g0.z * v[2]; r0.w = ALPHA * x0.w + g0.w * v[3];
                   r1.x = ALPHA * x1.x + g1.x * u[0]; r1.y = ALPHA * x1.y + g1.y * u[1]; r1.z = ALPHA * x1.z + g1.z * u[2]; r1.w = ALPHA * x1.w + g1.w * u[3];
                   *(float4*)dr = r0; *(float4*)(dr + 4) = r1;
                 });
    } else if (lp == 7) { if (PHMASK & 128) { LCX; phase_finln(p, c2, l); } }
  }
}

constexpr int NPHASES = PH_NSTEPS;

extern "C" void kernel_launch(void* const* d_in, const int* in_sizes, int n_in, void* d_out, int out_size, void* d_ws, size_t ws_size,
                              hipStream_t stream) {
  static int grid_blocks = 0;
  if (grid_blocks == 0) {
    if (n_in != 32 || ws_size < WS_END) { fprintf(stderr, "kernel_launch: unexpected n_in %d / ws %zu (need %zu)\n", n_in, ws_size, (size_t)WS_END); grid_blocks = -1; return; }
    int dev = 0, cus = 0, per_cu = 0;
    hipGetDevice(&dev);
    hipDeviceGetAttribute(&cus, hipDeviceAttributeMultiprocessorCount, dev);
    if (hipFuncSetAttribute((const void*)mega_fwd, hipFuncAttributeMaxDynamicSharedMemorySize, LDS_BYTES) != hipSuccess) { fprintf(stderr, "hipFuncSetAttribute failed\n"); grid_blocks = -1; return; }
    if (hipOccupancyMaxActiveBlocksPerMultiprocessor(&per_cu, (const void*)mega_fwd, NTHREADS, LDS_BYTES) != hipSuccess || per_cu < 1) {
      fprintf(stderr, "occupancy query gave %d\n", per_cu); (void)hipGetLastError(); per_cu = 1;
    }
    grid_blocks = cus * per_cu;
  }
  if (grid_blocks < 0) return;
  Params p{};
  const float** pp = (const float**)&p;
  for (int i = 0; i < 32; ++i) pp[i] = (const float*)d_in[i];
  p.out = (float*)d_out;
  p.ws = (char*)d_ws;
  int ph0 = 0, ph1 = NPHASES;
  void* args[] = {&p, &ph0, &ph1};
  hipError_t e = hipLaunchCooperativeKernel((const void*)mega_fwd, dim3(grid_blocks), dim3(NTHREADS), args, LDS_BYTES, stream);
  if (e != hipSuccess) fprintf(stderr, "cooperative launch failed: %s (grid %d)\n", hipGetErrorString(e), grid_blocks);
}
```
